# Optimizing an MI355X kernel written in HIP

```python
import math
import jax, jax.numpy as jnp
from jax import lax
import numpy as np

D_MODEL = 2048
BATCH = 2
SEQ = 8192
DEPTH = 4

HEAD_DIM = 64
N_MIXERS = 4
GROUP_HEADS = D_MODEL // (N_MIXERS * HEAD_DIM)
GROUP_WIDTH = GROUP_HEADS * HEAD_DIM
MIX_WIDTH = N_MIXERS * GROUP_WIDTH
IDX_HEADS = 16
IDX_DIM = 64
TOPK_MAX = 256
WINDOW = 128
BLOCK_Q = 128
REL_BUCKETS = 32
REL_MAX_DIST = 128
D_FF = 11 * D_MODEL // 4
EPS = 1e-6

SPLIT_SIZES = (
    GROUP_WIDTH, HEAD_DIM, HEAD_DIM, IDX_HEADS * IDX_DIM, IDX_DIM, IDX_HEADS,
    GROUP_WIDTH, HEAD_DIM, HEAD_DIM,
    GROUP_WIDTH, GROUP_WIDTH, GROUP_WIDTH, GROUP_HEADS, GROUP_WIDTH,
    GROUP_WIDTH, GROUP_WIDTH, GROUP_WIDTH,
)
IN_COLS = sum(SPLIT_SIZES)

kernel_name = 'hybrid_dsa_swa_fox_stickbreak_macaron'


def _rms(x, g):
    xf = x.astype(jnp.float32)
    y = xf * lax.rsqrt(jnp.mean(jnp.square(xf), axis=-1, keepdims=True) + EPS)
    return (y * g.astype(jnp.float32)).astype(x.dtype)


def _modulate(x, g, shift, scale):
    return _rms(x, g) * (1 + scale[:, None, :]) + shift[:, None, :]


def _swiglu(h, w_gate, w_up, w_down):
    return (jax.nn.silu(h @ w_gate) * (h @ w_up)) @ w_down


def _to_blocks(a):
    b, s = a.shape[:2]
    a = a.reshape((b, s // BLOCK_Q, BLOCK_Q) + a.shape[2:])
    return jnp.moveaxis(a, 1, 0)


def _from_blocks(a):
    a = jnp.moveaxis(a, 0, 1)
    return a.reshape((a.shape[0], a.shape[1] * a.shape[2]) + a.shape[3:])


def _rel_bucket(dist):
    n = jnp.maximum(dist, 0)
    max_exact = REL_BUCKETS // 2
    nf = jnp.maximum(n, 1).astype(jnp.float32)
    large = max_exact + (jnp.log(nf / max_exact) / math.log(REL_MAX_DIST / max_exact)
                         * (REL_BUCKETS - max_exact)).astype(jnp.int32)
    large = jnp.minimum(large, REL_BUCKETS - 1)
    return jnp.where(n < max_exact, n, large)


def _dsa_attention(q, k, v, iq, ik, iw, rel_tab):
    seq = k.shape[1]
    k_top = min(TOPK_MAX, seq // 4)
    kpos = jnp.arange(seq)
    scale = HEAD_DIM ** -0.5
    gather = jax.vmap(lambda t, i: t[i])

    def block(args):
        blk, q_b, iq_b, iw_b = args
        qpos = blk * BLOCK_Q + jnp.arange(BLOCK_Q)
        rel = jax.nn.relu(jnp.einsum('bqhd,bsd->bqhs', iq_b, ik).astype(jnp.float32) * IDX_DIM ** -0.5)
        score = jnp.einsum('bqhs,bqh->bqs', rel, iw_b.astype(jnp.float32))
        score = jnp.where(kpos[None, None, :] <= qpos[None, :, None], score, -jnp.inf)
        _, sel = lax.top_k(score, k_top)
        k_sel = gather(k, sel)
        v_sel = gather(v, sel)
        logits = jnp.einsum('bqhd,bqkd->bhqk', q_b, k_sel).astype(jnp.float32) * scale
        dist = qpos[None, :, None] - sel
        bias = jnp.moveaxis(rel_tab[_rel_bucket(dist)], -1, 1).astype(jnp.float32)
        logits = jnp.where((dist >= 0)[:, None], logits + bias, -jnp.inf)
        p = jax.nn.softmax(logits, axis=-1).astype(v.dtype)
        return jnp.einsum('bhqk,bqkd->bqhd', p, v_sel)

    nblk = seq // BLOCK_Q
    out = lax.map(block, (jnp.arange(nblk), _to_blocks(q), _to_blocks(iq), _to_blocks(iw)))
    return _from_blocks(out)


def _swa_sink_attention(q, k, v, sinks, rel_tab):
    b, seq, h, dh = q.shape
    n = seq // BLOCK_Q
    qb = q.reshape(b, n, BLOCK_Q, h, dh)

    def band(t):
        tb = t.reshape(b, n, BLOCK_Q, dh)
        prev = jnp.pad(tb, ((0, 0), (1, 0), (0, 0), (0, 0)))[:, :-1]
        return jnp.concatenate([prev, tb], axis=2)

    kk, vv = band(k), band(v)
    logits = jnp.einsum('bnqhd,bnkd->bnhqk', qb, kk).astype(jnp.float32) * HEAD_DIM ** -0.5
    dist = jnp.arange(BLOCK_Q)[:, None] + BLOCK_Q - jnp.arange(2 * BLOCK_Q)[None, :]
    kpos = jnp.arange(n)[:, None] * BLOCK_Q - BLOCK_Q + jnp.arange(2 * BLOCK_Q)[None, :]
    valid = ((dist >= 0) & (dist < WINDOW))[None] & (kpos >= 0)[:, None, :]
    bias = jnp.moveaxis(rel_tab[_rel_bucket(dist)], -1, 0).astype(jnp.float32)
    logits = jnp.where(valid[None, :, None], logits + bias, -jnp.inf)
    sink = jnp.broadcast_to(sinks.astype(jnp.float32)[None, None, :, None, None], logits.shape[:-1] + (1,))
    p = jax.nn.softmax(jnp.concatenate([logits, sink], axis=-1), axis=-1)[..., :-1]
    o = jnp.einsum('bnhqk,bnkd->bnqhd', p.astype(v.dtype), vv)
    return o.reshape(b, seq, h, dh)


def _forgetting_attention(q, k, v, log_f):
    seq = k.shape[1]
    cum = jnp.cumsum(log_f, axis=1)
    cum_k = jnp.moveaxis(cum, 1, 2)
    kpos = jnp.arange(seq)

    def block(args):
        blk, q_b, cum_q = args
        qpos = blk * BLOCK_Q + jnp.arange(BLOCK_Q)
        logits = jnp.einsum('bqhd,bshd->bhqs', q_b, k).astype(jnp.float32) * HEAD_DIM ** -0.5
        logits = logits + jnp.moveaxis(cum_q, 1, 2)[..., None] - cum_k[:, :, None, :]
        logits = jnp.where(kpos[None, :] <= qpos[:, None], logits, -jnp.inf)
        p = jax.nn.softmax(logits, axis=-1).astype(v.dtype)
        return jnp.einsum('bhqs,bshd->bqhd', p, v)

    nblk = seq // BLOCK_Q
    out = lax.map(block, (jnp.arange(nblk), _to_blocks(q), _to_blocks(cum)))
    return _from_blocks(out)


def _stick_breaking_attention(q, k, v):
    seq = k.shape[1]
    kpos = jnp.arange(seq)

    def block(args):
        blk, q_b = args
        qpos = blk * BLOCK_Q + jnp.arange(BLOCK_Q)
        z = jnp.einsum('bqhd,bshd->bhqs', q_b, k).astype(jnp.float32) * HEAD_DIM ** -0.5
        before = kpos[None, :] < qpos[:, None]
        u = jnp.where(before, jax.nn.log_sigmoid(-z), 0.0)
        between = lax.cumsum(u, axis=3, reverse=True) - u
        w = jnp.where(before, jnp.exp(jax.nn.log_sigmoid(z) + between), 0.0)
        return jnp.einsum('bhqs,bshd->bqhd', w.astype(v.dtype), v)

    nblk = seq // BLOCK_Q
    out = lax.map(block, (jnp.arange(nblk), _to_blocks(q)))
    return _from_blocks(out)


def _mixer(h, w_in, qk_g, forget_b, sinks, rel_table, group_g, w_out):
    b, seq, _ = h.shape
    points = [int(p) for p in np.cumsum(SPLIT_SIZES)[:-1]]
    (a_q, a_k, a_v, a_iq, a_ik, a_iw,
     b_q, b_k, b_v,
     c_q, c_k, c_v, c_f, c_g,
     d_q, d_k, d_v) = jnp.split(h @ w_in, points, axis=-1)
    heads = lambda t: t.reshape(b, seq, GROUP_HEADS, HEAD_DIM)
    o_a = _dsa_attention(_rms(heads(a_q), qk_g[0]), _rms(a_k, qk_g[1]), a_v,
                         a_iq.reshape(b, seq, IDX_HEADS, IDX_DIM), a_ik, a_iw * IDX_HEADS ** -0.5,
                         rel_table[:, :GROUP_HEADS])
    o_b = _swa_sink_attention(_rms(heads(b_q), qk_g[2]), _rms(b_k, qk_g[3]), b_v, sinks,
                              rel_table[:, GROUP_HEADS:])
    log_f = jax.nn.log_sigmoid(c_f.astype(jnp.float32) + forget_b.astype(jnp.float32))
    o_c = _forgetting_attention(_rms(heads(c_q), qk_g[4]), _rms(heads(c_k), qk_g[5]), heads(c_v), log_f)
    o_c = o_c * jax.nn.sigmoid(heads(c_g))
    o_d = _stick_breaking_attention(heads(d_q), heads(d_k), heads(d_v))
    y = jnp.stack([o.reshape(b, seq, GROUP_WIDTH) for o in (o_a, o_b, o_c, o_d)], axis=2)
    y = _rms(y, group_g.reshape(N_MIXERS, GROUP_WIDTH)).reshape(b, seq, MIX_WIDTH)
    return y @ w_out


def setup_inputs(seed: int = 0) -> dict:
    key = jax.random.key(seed)
    ks = jax.random.split(key, 16)
    nrm = lambda k, shape, s: jax.random.normal(k, shape, jnp.float32) * s
    return {
        'x': nrm(ks[0], (BATCH, SEQ, D_MODEL), 1.0),
        'c': nrm(ks[1], (BATCH, D_MODEL), 1.0),
        'w_ada': nrm(ks[2], (DEPTH, D_MODEL, 9 * D_MODEL), 0.5 * D_MODEL ** -0.5),
        'b_ada': nrm(ks[3], (DEPTH, 9 * D_MODEL), 0.02),
        'norm_g': 1.0 + nrm(ks[4], (DEPTH, 3, D_MODEL), 0.02),
        'w_in': nrm(ks[5], (DEPTH, D_MODEL, IN_COLS), D_MODEL ** -0.5),
        'qk_g': 1.0 + nrm(ks[6], (DEPTH, 6, HEAD_DIM), 0.02),
        'forget_b': 4.0 + nrm(ks[7], (DEPTH, GROUP_HEADS), 0.5),
        'sinks': nrm(ks[8], (DEPTH, GROUP_HEADS), 0.5),
        'rel_table': nrm(ks[9], (REL_BUCKETS, 2 * GROUP_HEADS), 0.5),
        'group_g': 1.0 + nrm(ks[10], (DEPTH, MIX_WIDTH), 0.02),
        'w_out': nrm(ks[11], (DEPTH, MIX_WIDTH, D_MODEL), MIX_WIDTH ** -0.5),
        'w_ffn_gate': nrm(ks[12], (DEPTH, 2, D_MODEL, D_FF), D_MODEL ** -0.5),
        'w_ffn_up': nrm(ks[13], (DEPTH, 2, D_MODEL, D_FF), D_MODEL ** -0.5),
        'w_ffn_down': nrm(ks[14], (DEPTH, 2, D_FF, D_MODEL), D_FF ** -0.5),
    }


def reference(x, c, w_ada, b_ada, norm_g, w_in, qk_g, forget_b, sinks, rel_table, group_g, w_out,
              w_ffn_gate, w_ffn_up, w_ffn_down):
    cond = jax.nn.silu(c)
    for l in range(DEPTH):
        mod = cond @ w_ada[l] + b_ada[l]
        sh1, sc1, g1, sh2, sc2, g2, sh3, sc3, g3 = jnp.split(mod, 9, axis=-1)
        h = _modulate(x, norm_g[l, 0], sh1, sc1)
        x = x + 0.5 * g1[:, None] * _swiglu(h, w_ffn_gate[l, 0], w_ffn_up[l, 0], w_ffn_down[l, 0])
        h = _modulate(x, norm_g[l, 1], sh2, sc2)
        x = x + g2[:, None] * _mixer(h, w_in[l], qk_g[l], forget_b[l], sinks[l], rel_table,
                                     group_g[l], w_out[l])
        h = _modulate(x, norm_g[l, 2], sh3, sc3)
        x = x + 0.5 * g3[:, None] * _swiglu(h, w_ffn_gate[l, 1], w_ffn_up[l, 1], w_ffn_down[l, 1])
    return x
```

```cpp
#include <hip/hip_runtime.h>
#include <cstdio>
#include <cstdint>

namespace pg8 {
#define PG8_LAS __attribute__((address_space(3)))
typedef unsigned short bf16_t;
typedef short bf16x8 __attribute__((ext_vector_type(8)));
typedef float f32x4 __attribute__((ext_vector_type(4)));
typedef unsigned u32x4 __attribute__((ext_vector_type(4)));
constexpr int BM = 256, BK = 64, HALF = 128, HTB = HALF * BK * 2  , STAGE_BYTES = 8 * HTB, NXCD = 8, WGM = 8;

__host__ __device__ __forceinline__ int lds_byte(int r, int c) { const int st = (r >> 4) * 2 + (c >> 5), rr = r & 15, cc = c & 31, ob = rr * 64 + cc * 2; return st * 1024 + (ob ^ (((ob >> 9) & 1) << 5)); }
__host__ __device__ __forceinline__ void stage_rc(int b, int& R, int& C) { const int st = b / 1024, sb = b % 1024, swz = sb ^ (((sb >> 9) & 1) << 5); R = (st >> 1) * 16 + swz / 64; C = (st & 1) * 32 + (swz % 64) / 2; }
__host__ __device__ __forceinline__ int perm32(int rho) { const int n = rho >> 4, i = rho & 15; return 8 * (i >> 2) + 4 * n + (i & 3); }

struct Unit { int pm, pn; };
struct Gemm { const bf16_t* A; const bf16_t* Bt; int M, N, K; int scaleA = 127, scaleB = 127; int lda = 0, ldb = 0; int blk = 0; };
typedef int i32x8 __attribute__((ext_vector_type(8))); typedef int i32x4v __attribute__((ext_vector_type(4)));
__device__ __forceinline__ i32x8 pg8_cat(bf16x8 lo, bf16x8 hi) { return __builtin_shufflevector(__builtin_bit_cast(i32x4v, lo), __builtin_bit_cast(i32x4v, hi), 0, 1, 2, 3, 4, 5, 6, 7); }

struct StaticOrder {
    int nM, nN, nwg, G, c;
    __host__ __device__ void init(int M, int N, int G_, int c_) { nM = M / BM; nN = N / BM; nwg = nM * nN; G = G_; c = c_; }
    __host__ __device__ bool next(int i, Unit& u) const {
        const long L = (long)i * G + c; if (L >= nwg) return false;
        int wgid = (int)L; { const int q = nwg / NXCD, r = nwg % NXCD, xcd = wgid % NXCD, off = wgid / NXCD; wgid = (xcd < r ? xcd * (q + 1) : r * (q + 1) + (xcd - r) * q) + off; }
        const int nig = WGM * nN, gid = wgid / nig, fm = gid * WGM, gsz = (nM - fm) < WGM ? (nM - fm) : WGM;
        u.pm = fm + ((wgid % nig) % gsz); u.pn = (wgid % nig) / gsz; return true;
    }
    __device__ __forceinline__ void a_ready(const Unit&) const {}
    __device__ __forceinline__ void done(const Unit&) const {}
};
typedef __bf16 pg8_bfpair __attribute__((ext_vector_type(2))); typedef float pg8_f32pair __attribute__((ext_vector_type(2)));
__device__ __forceinline__ unsigned cvt_pk_bf16(float lo, float hi) { const pg8_f32pair v = {lo, hi}; return __builtin_bit_cast(unsigned, __builtin_convertvector(v, pg8_bfpair)); }
__device__ __forceinline__ unsigned cvt_pk_bf16_nv(float lo, float hi) { return cvt_pk_bf16(lo, hi); }
__device__ __forceinline__ const char* uptr(const char* p) { const unsigned long long v = (unsigned long long)p; const unsigned lo = __builtin_amdgcn_readfirstlane((unsigned)v), hi = __builtin_amdgcn_readfirstlane((unsigned)(v >> 32)); return (const char*)(((unsigned long long)hi << 32) | lo); }
struct EpiBf16 {
    static constexpr bool PERM = true, AFTER_DRAIN = false;
    bf16_t* O; int ldc;
    __device__ __forceinline__ void operator()(const f32x4 (&acc)[2][2][4][2], const Unit& u, int wr, int wc, int fr, int fq) const {
        asm volatile("" : "+v"(fr), "+v"(fq));
        const int row0 = u.pm * BM + wr * 64 + fr; const int col0 = u.pn * BM + wc * 32 + 8 * fq;
#pragma unroll
        for (int ai = 0; ai < 2; ++ai)
#pragma unroll
            for (int m = 0; m < 4; ++m) { bf16_t* rowp = O + (size_t)(row0 + ai * HALF + m * 16) * ldc + col0;
#pragma unroll
                for (int bj = 0; bj < 2; ++bj) { const f32x4 v0 = acc[ai][bj][m][0], v1 = acc[ai][bj][m][1];
                    u32x4 w; w.x = cvt_pk_bf16(v0[0], v0[1]); w.y = cvt_pk_bf16(v0[2], v0[3]); w.z = cvt_pk_bf16(v1[0], v1[1]); w.w = cvt_pk_bf16(v1[2], v1[3]);
                    *(u32x4*)(rowp + bj * HALF) = w; } }
    }
};
__device__ __forceinline__ float silu_mul(float g, float u) { return g * u * __builtin_amdgcn_rcpf(1.0f + __builtin_amdgcn_exp2f(-1.4426950408889634f * g)); }
struct EpiSwiGLU {
    static constexpr bool PERM = true, AFTER_DRAIN = false;
    bf16_t* O; int ldc;
    __device__ __forceinline__ void operator()(const f32x4 (&acc)[2][2][4][2], const Unit& u, int wr, int wc, int fr, int fq) const {
        asm volatile("" : "+v"(fr), "+v"(fq));
        const int row0 = u.pm * BM + wr * 64 + fr; const int col0 = u.pn * HALF + wc * 32 + 8 * fq;
#pragma unroll
        for (int ai = 0; ai < 2; ++ai)
#pragma unroll
            for (int m = 0; m < 4; ++m) { bf16_t* rowp = O + (size_t)(row0 + ai * HALF + m * 16) * ldc + col0;
                const f32x4 g0 = acc[ai][0][m][0], g1 = acc[ai][0][m][1], u0 = acc[ai][1][m][0], u1 = acc[ai][1][m][1];
                u32x4 w; w.x = cvt_pk_bf16(silu_mul(g0[0], u0[0]), silu_mul(g0[1], u0[1])); w.y = cvt_pk_bf16(silu_mul(g0[2], u0[2]), silu_mul(g0[3], u0[3]));
                w.z = cvt_pk_bf16(silu_mul(g1[0], u1[0]), silu_mul(g1[1], u1[1])); w.w = cvt_pk_bf16(silu_mul(g1[2], u1[2]), silu_mul(g1[3], u1[3]));
                *(u32x4*)rowp = w; }
    }
};
template <bool OUT16> struct EpiResid {
    static constexpr bool PERM = false, AFTER_DRAIN = false;
    const bf16_t* base; void* out; int ldc; const float* gv; int gstride; int rows_per_batch; float coef;
    __device__ __forceinline__ void operator()(const f32x4 (&acc)[2][2][4][2], const Unit& u, int wr, int wc, int fr, int fq) const {
        typedef unsigned v2u_ __attribute__((ext_vector_type(2)));
        asm volatile("" : "+v"(fr), "+v"(fq));
        const int row0 = u.pm * BM + wr * 64 + fr; const int col0 = u.pn * BM + wc * 32 + 4 * fq;
        const float* gvec = gv + (size_t)((u.pm * BM) / rows_per_batch) * gstride + col0;
        f32x4 gg[2][2];
#pragma unroll
        for (int bj = 0; bj < 2; ++bj)
#pragma unroll
            for (int n = 0; n < 2; ++n) gg[bj][n] = *(const f32x4*)(gvec + bj * HALF + n * 16) * coef;
#pragma unroll
        for (int ai = 0; ai < 2; ++ai) {
            v2u_ bwv[4][2][2];
#pragma unroll
            for (int m = 0; m < 4; ++m) { const size_t off = (size_t)(row0 + ai * HALF + m * 16) * ldc + col0;
#pragma unroll
                for (int bj = 0; bj < 2; ++bj)
#pragma unroll
                    for (int n = 0; n < 2; ++n) bwv[m][bj][n] = *(const v2u_*)(base + off + bj * HALF + n * 16); }
#pragma unroll
            for (int m = 0; m < 4; ++m) { const size_t off = (size_t)(row0 + ai * HALF + m * 16) * ldc + col0;
#pragma unroll
                for (int bj = 0; bj < 2; ++bj)
#pragma unroll
                    for (int n = 0; n < 2; ++n) { const v2u_ bw = bwv[m][bj][n];
                        f32x4 bs; bs[0] = __builtin_bit_cast(float, bw.x << 16); bs[1] = __builtin_bit_cast(float, bw.x & 0xffff0000u); bs[2] = __builtin_bit_cast(float, bw.y << 16); bs[3] = __builtin_bit_cast(float, bw.y & 0xffff0000u);
                        const f32x4 r = bs + gg[bj][n] * acc[ai][bj][m][n];
                        if constexpr (OUT16) { v2u_ w; w.x = cvt_pk_bf16_nv(r[0], r[1]); w.y = cvt_pk_bf16_nv(r[2], r[3]); *(v2u_*)((bf16_t*)out + off + bj * HALF + n * 16) = w; }
                        else *(f32x4*)((float*)out + off + bj * HALF + n * 16) = r; } }
        }
    }
};
__device__ __forceinline__ unsigned pack_fp8x4(float a, float b, float c, float d) {
    a = fminf(fmaxf(a, -448.f), 448.f); b = fminf(fmaxf(b, -448.f), 448.f); c = fminf(fmaxf(c, -448.f), 448.f); d = fminf(fmaxf(d, -448.f), 448.f);
    int w = 0; w = __builtin_amdgcn_cvt_pk_fp8_f32(a, b, w, false); w = __builtin_amdgcn_cvt_pk_fp8_f32(c, d, w, true); return (unsigned)w; }
struct EpiSwiGLU8 {
    static constexpr bool PERM = true, AFTER_DRAIN = false;
    unsigned char* O; int ldc;
    __device__ __forceinline__ void operator()(const f32x4 (&acc)[2][2][4][2], const Unit& u, int wr, int wc, int fr, int fq) const {
        asm volatile("" : "+v"(fr), "+v"(fq));
        const int row0 = u.pm * BM + wr * 64 + fr; const int col0 = u.pn * HALF + wc * 32 + 8 * fq;
#pragma unroll
        for (int ai = 0; ai < 2; ++ai)
#pragma unroll
            for (int m = 0; m < 4; ++m) { unsigned char* rowp = O + (size_t)(row0 + ai * HALF + m * 16) * ldc + col0;
                const f32x4 g0 = acc[ai][0][m][0], g1 = acc[ai][0][m][1], u0 = acc[ai][1][m][0], u1 = acc[ai][1][m][1];
                typedef unsigned u32x2v __attribute__((ext_vector_type(2))); u32x2v w;
                w.x = pack_fp8x4(silu_mul(g0[0], u0[0]), silu_mul(g0[1], u0[1]), silu_mul(g0[2], u0[2]), silu_mul(g0[3], u0[3]));
                w.y = pack_fp8x4(silu_mul(g1[0], u1[0]), silu_mul(g1[1], u1[1]), silu_mul(g1[2], u1[2]), silu_mul(g1[3], u1[3]));
                *(u32x2v*)rowp = w; }
    }
};
template <class Epi, class Sched, bool ALIGN_EPI = false, bool SP2 = false, bool FP8 = false>
__device__ __forceinline__ void gemm_phase(PG8_LAS unsigned char* lds, const Gemm g, const Sched& S, const Epi& E, int tid_in) {
    int tid_ = tid_in; asm volatile("" : "+v"(tid_));
    const int tid = tid_, wid = __builtin_amdgcn_readfirstlane(tid >> 6), lane = tid & 63, wr = wid >> 2, wc = wid & 3, fr = lane & 15, fq = lane >> 4;
    const int K = g.K, nt = FP8 ? K / (2 * BK) : K / BK;
    const int pitchA = g.blk ? 2 * BK : g.lda ? g.lda : (FP8 ? K : 2 * K), pitchB = g.blk ? 2 * BK : g.ldb ? g.ldb : (FP8 ? K : 2 * K);
    unsigned voffA[2], voffB[2];
#pragma unroll
    for (int i = 0; i < 2; ++i) { int R, C; stage_rc(tid * 16 + i * 8192, R, C); const int Rb = Epi::PERM ? ((R & ~31) + perm32(R & 31)) : R;
        voffA[i] = (unsigned)(R * pitchA + C * 2); voffB[i] = (unsigned)(Rb * pitchB + C * 2); }
    const size_t kstep = g.blk ? (size_t)(512 * BK) : (size_t)(BK * 2);
    const size_t hstepA = (size_t)HALF * pitchA, hstepB = (size_t)HALF * pitchB;
    const size_t tstepA = g.blk ? (size_t)(FP8 ? K / (2 * BK) : K / BK) * kstep : 2 * hstepA, tstepB = g.blk ? tstepA : 2 * hstepB;
    const unsigned ldsw = (unsigned)wid * 1024u;
    const int aoff = lds_byte(wr * 64 + fr, fq * 8), boff = lds_byte(wc * 32 + fr, fq * 8);
    PG8_LAS unsigned char* abase = lds + aoff; PG8_LAS unsigned char* bbase = lds + boff + 4 * HTB;
#define PG8_SA(b, h) (((b) * 2 + (h)) * HTB)
#define PG8_SB(b, h) ((4 + (b) * 2 + (h)) * HTB)
#define PG8_STAGE(bufoff, gbase, voff) do { _Pragma("unroll") for (int _i = 0; _i < 2; ++_i) \
        __builtin_amdgcn_global_load_lds((const unsigned*)((const char*)(gbase) + (voff)[_i]), (PG8_LAS unsigned*)(lds + (bufoff) + ldsw + _i * 8192), 16, 0, 0); } while (0)
#define PG8_RDA(off) (*(const PG8_LAS bf16x8*)(abase + (off)))
#define PG8_RDB(off) (*(const PG8_LAS bf16x8*)(bbase + ((off) - 4 * HTB)))
#define PG8_LDA(dst, b, h) do { if constexpr (FP8) { _Pragma("unroll") for (int m = 0; m < 4; ++m) dst##8[m] = pg8_cat(PG8_RDA(PG8_SA(b, h) + m * 2048), PG8_RDA(PG8_SA(b, h) + m * 2048 + 1024)); } \
    else { _Pragma("unroll") for (int m = 0; m < 4; ++m) _Pragma("unroll") for (int k = 0; k < 2; ++k) dst[m][k] = PG8_RDA(PG8_SA(b, h) + m * 2048 + k * 1024); } } while (0)
#define PG8_LDB(dst, b, h) do { if constexpr (FP8) { _Pragma("unroll") for (int n = 0; n < 2; ++n) dst##8[n] = pg8_cat(PG8_RDB(PG8_SB(b, h) + n * 2048), PG8_RDB(PG8_SB(b, h) + n * 2048 + 1024)); } \
    else { _Pragma("unroll") for (int n = 0; n < 2; ++n) _Pragma("unroll") for (int k = 0; k < 2; ++k) dst[n][k] = PG8_RDB(PG8_SB(b, h) + n * 2048 + k * 1024); } } while (0)
#define PG8_MMA(ai, bj, At, Bt) do { __builtin_amdgcn_s_setprio(1); if constexpr (FP8) { \
        _Pragma("unroll") for (int m = 0; m < 4; ++m) _Pragma("unroll") for (int n = 0; n < 2; ++n) \
            asm volatile("v_mfma_scale_f32_16x16x128_f8f6f4 %0, %1, %2, %0, %3, %4 op_sel_hi:[0,0,0]" : "+v"(acc[ai][bj][m][n]) : "v"(Bt##8[n]), "v"(At##8[m]), "v"(sclB), "v"(sclA)); \
        } else { _Pragma("unroll") for (int m = 0; m < 4; ++m) _Pragma("unroll") for (int n = 0; n < 2; ++n) _Pragma("unroll") for (int k = 0; k < 2; ++k) \
        acc[ai][bj][m][n] = __builtin_amdgcn_mfma_f32_16x16x32_bf16(Bt[n][k], At[m][k], acc[ai][bj][m][n], 0, 0, 0); } __builtin_amdgcn_s_setprio(0); } while (0)
#define PG8_WAIT_V(n) asm volatile("s_waitcnt vmcnt(" #n ")" ::: "memory")
#define PG8_WAIT_L(n) asm volatile("s_waitcnt lgkmcnt(" #n ")" ::: "memory")
#define PG8_BAR __builtin_amdgcn_s_barrier()
#define PG8_SCHED __builtin_amdgcn_sched_barrier(0)
    Unit cur, nxt; int ui = 0;
    if (!S.next(0, cur)) return;
    f32x4 acc[2][2][4][2];
#pragma unroll
    for (int a = 0; a < 2; ++a)
#pragma unroll
        for (int b = 0; b < 2; ++b)
#pragma unroll
            for (int m = 0; m < 4; ++m)
#pragma unroll
                for (int n = 0; n < 2; ++n) acc[a][b][m][n] = (f32x4){0.f, 0.f, 0.f, 0.f};
    const int sclA = g.scaleA, sclB = g.scaleB;
    bf16x8 At[4][2], B0[2][2], B1[2][2]; i32x8 At8[4], B08[2], B18[2];
    const char* cA = uptr((const char*)g.A + (size_t)cur.pm * tstepA); const char* cB = uptr((const char*)g.Bt + (size_t)cur.pn * tstepB);
    S.a_ready(cur);
    if constexpr (SP2) {
        PG8_STAGE(PG8_SB(0, 0), cB, voffB); PG8_STAGE(PG8_SB(0, 1), cB + hstepB, voffB); PG8_STAGE(PG8_SA(0, 0), cA, voffA); PG8_STAGE(PG8_SA(0, 1), cA + hstepA, voffA);
        if (wr == 1) PG8_BAR;
        PG8_WAIT_V(2); PG8_BAR;
        PG8_STAGE(PG8_SB(1, 0), cB + kstep, voffB); PG8_STAGE(PG8_SA(1, 0), cA + kstep, voffA); PG8_STAGE(PG8_SB(1, 1), cB + hstepB + kstep, voffB);
        PG8_WAIT_V(6); PG8_BAR;
    } else {
        PG8_STAGE(PG8_SB(0, 0), cB, voffB); PG8_STAGE(PG8_SA(0, 0), cA, voffA); PG8_STAGE(PG8_SB(0, 1), cB + hstepB, voffB); PG8_STAGE(PG8_SA(0, 1), cA + hstepA, voffA);
        if (wr == 1) PG8_BAR;
        PG8_WAIT_V(4); PG8_BAR;
        PG8_STAGE(PG8_SB(1, 0), cB + kstep, voffB); PG8_STAGE(PG8_SA(1, 0), cA + kstep, voffA); PG8_STAGE(PG8_SB(1, 1), cB + hstepB + kstep, voffB);
        PG8_WAIT_V(6); PG8_BAR;
    }
    for (;;) {
        const bool has_next = S.next(ui + 1, nxt);
        const char* nA = uptr(has_next ? (const char*)g.A + (size_t)nxt.pm * tstepA : cA); const char* nB = uptr(has_next ? (const char*)g.Bt + (size_t)nxt.pn * tstepB : cB);
        for (int t = 0; t < nt; t += 2) {
            asm volatile("" : "+v"(abase), "+v"(bbase));
            const bool last = (t == nt - 2);
            const char* a1 = cA + (size_t)(t + 1) * kstep;
            const char* a2 = uptr(last ? nA : cA + (size_t)(t + 2) * kstep); const char* b2 = uptr(last ? nB : cB + (size_t)(t + 2) * kstep);
            const char* a3 = a2 + kstep; const char* b3 = b2 + kstep;
            if (last && has_next) S.a_ready(nxt);
            if constexpr (SP2) {
            PG8_LDB(B0, 0, 0); PG8_LDB(B1, 0, 1); PG8_SCHED; PG8_LDA(At, 0, 0); PG8_STAGE(PG8_SA(1, 1), a1 + hstepA, voffA);
            PG8_WAIT_V(8); PG8_WAIT_L(0); PG8_BAR; PG8_MMA(0, 0, At, B0); PG8_MMA(0, 1, At, B1); PG8_BAR; PG8_SCHED;
            PG8_LDA(At, 0, 1); PG8_STAGE(PG8_SB(0, 0), b2, voffB); PG8_STAGE(PG8_SB(0, 1), b2 + hstepB, voffB); PG8_STAGE(PG8_SA(0, 0), a2, voffA);
            PG8_WAIT_V(8); PG8_WAIT_L(0); PG8_BAR; PG8_MMA(1, 0, At, B0); PG8_MMA(1, 1, At, B1); PG8_BAR; PG8_SCHED;
            PG8_LDB(B0, 1, 0); PG8_LDB(B1, 1, 1); PG8_SCHED; PG8_LDA(At, 1, 0); PG8_STAGE(PG8_SA(0, 1), a2 + hstepA, voffA);
            PG8_WAIT_V(8); PG8_WAIT_L(0); PG8_BAR; PG8_MMA(0, 0, At, B0); PG8_MMA(0, 1, At, B1); PG8_BAR; PG8_SCHED;
            PG8_LDA(At, 1, 1); PG8_STAGE(PG8_SB(1, 0), b3, voffB); PG8_STAGE(PG8_SB(1, 1), b3 + hstepB, voffB); PG8_STAGE(PG8_SA(1, 0), a3, voffA);
            PG8_WAIT_V(8); PG8_WAIT_L(0); PG8_BAR; PG8_MMA(1, 0, At, B0); PG8_MMA(1, 1, At, B1); PG8_BAR; PG8_SCHED;
            } else {
            PG8_LDB(B0, 0, 0); PG8_SCHED; PG8_LDA(At, 0, 0); PG8_STAGE(PG8_SA(1, 1), a1 + hstepA, voffA);
            PG8_WAIT_L(8); PG8_BAR; PG8_WAIT_L(0); PG8_MMA(0, 0, At, B0); PG8_BAR; PG8_SCHED;
            PG8_LDB(B1, 0, 1); PG8_STAGE(PG8_SB(0, 0), b2, voffB);
            PG8_BAR; PG8_WAIT_L(0); PG8_MMA(0, 1, At, B1); PG8_BAR;
            PG8_LDA(At, 0, 1); PG8_STAGE(PG8_SA(0, 0), a2, voffA);
            PG8_BAR; PG8_WAIT_L(0); PG8_MMA(1, 0, At, B0); PG8_BAR; PG8_SCHED;
            PG8_STAGE(PG8_SB(0, 1), b2 + hstepB, voffB);
            PG8_WAIT_V(6); PG8_BAR; PG8_MMA(1, 1, At, B1); PG8_BAR;
            PG8_LDB(B0, 1, 0); PG8_SCHED; PG8_LDA(At, 1, 0); PG8_STAGE(PG8_SA(0, 1), a2 + hstepA, voffA);
            PG8_WAIT_L(8); PG8_BAR; PG8_WAIT_L(0); PG8_MMA(0, 0, At, B0); PG8_BAR; PG8_SCHED;
            PG8_LDB(B1, 1, 1); PG8_STAGE(PG8_SB(1, 0), b3, voffB);
            PG8_BAR; PG8_WAIT_L(0); PG8_MMA(0, 1, At, B1); PG8_BAR;
            PG8_LDA(At, 1, 1); PG8_STAGE(PG8_SA(1, 0), a3, voffA);
            PG8_BAR; PG8_WAIT_L(0); PG8_MMA(1, 0, At, B0); PG8_BAR; PG8_SCHED;
            PG8_STAGE(PG8_SB(1, 1), b3 + hstepB, voffB);
            PG8_WAIT_V(6); PG8_BAR; PG8_MMA(1, 1, At, B1); PG8_BAR;
            }
        }
        if constexpr (FP8) asm volatile("s_nop 15\n\ts_nop 7" ::: "memory");
        if constexpr (ALIGN_EPI) { if (wr == 0) PG8_BAR; }
        if constexpr (!Epi::AFTER_DRAIN) { E(acc, cur, wr, wc, fr, fq); S.done(cur); }
        if (!has_next) break;
#pragma unroll
        for (int a = 0; a < 2; ++a)
#pragma unroll
            for (int b = 0; b < 2; ++b)
#pragma unroll
                for (int m = 0; m < 4; ++m)
#pragma unroll
                    for (int n = 0; n < 2; ++n) acc[a][b][m][n] = (f32x4){0.f, 0.f, 0.f, 0.f};
        cur = nxt; cA = nA; cB = nB; ++ui;
        if constexpr (ALIGN_EPI) { if (wr == 1) PG8_BAR; }
    }
    PG8_WAIT_V(0);
    if constexpr (!ALIGN_EPI) { if (wr == 0) PG8_BAR; }
    PG8_BAR;
    if constexpr (Epi::AFTER_DRAIN) { E.fused(acc, cur, wr, wc, fr, fq, lds, wid, lane); S.done(cur); }
#undef PG8_SA
#undef PG8_SB
#undef PG8_STAGE
#undef PG8_RDA
#undef PG8_RDB
#undef PG8_LDA
#undef PG8_LDB
#undef PG8_MMA
#undef PG8_WAIT_V
#undef PG8_WAIT_L
#undef PG8_BAR
#undef PG8_SCHED
}
}

#ifndef MK_FFN_FP8
#define MK_FFN_FP8 1
#endif
constexpr bool FFN_FP8 = MK_FFN_FP8;
constexpr int NWAVES = 8, NTHREADS = NWAVES * 64;
constexpr int BATCH = 2, SEQ = 8192, M = BATCH * SEQ, DM = 2048, DEPTH = 4, DFF = 5632, NGU = 2 * DFF, INC = 5976, NIN = 6144, NMOD = 9 * DM;
constexpr int DFFP = DFF + 128;
constexpr int NH = 8, HD = 64, GWID = 512, TOPK = 256, WINDOW = 128;
constexpr int PA_Q = 0, PA_K = 512, PA_V = 576, PA_IQ = 640, PA_IK = 1664, PB_Q = 1728, PB_K = 2240, PB_V = 2304, PC_Q = 2368, PC_K = 2880, PC_V = 3392, PC_G = 3904,
              PD_Q = 4416, PD_K = 4928, PD_V = 5440, PA_IW = 5952, PC_F = 5968;
constexpr float RMS_EPS = 1e-6f, LOG2E = 1.4426950408889634f, QSCALE = 0.125f * LOG2E;

constexpr size_t MiB = 1u << 20;
constexpr size_t WS_CTL = 0, CTL_ZERO_BYTES = 1 * MiB;
constexpr size_t WS_MOD = 1 * MiB;
constexpr size_t WS_LF = 2 * MiB;
constexpr size_t WS_KB2 = 3 * MiB;
constexpr size_t WS_WGU = 4 * MiB;
constexpr size_t SZ_WGU = (size_t)NGU * DM * 2;
constexpr size_t WS_WD = WS_WGU + 8 * SZ_WGU;
constexpr size_t SZ_WD = (size_t)DM * DFF * 2;
constexpr size_t WS_WIN = WS_WD + 8 * SZ_WD;
constexpr size_t SZ_WIN = (size_t)NIN * DM * 2;
constexpr size_t WS_WOUT = WS_WIN + 4 * SZ_WIN;
constexpr size_t SZ_WOUT = (size_t)DM * DM * 2;
constexpr size_t WS_H = WS_WOUT + 4 * SZ_WOUT;
constexpr size_t WS_P = WS_H + (size_t)M * DM * 2;
constexpr size_t WS_Y = WS_P + (size_t)M * NIN * 2;
constexpr size_t WS_IDX = WS_Y + (size_t)M * DM * 2;
constexpr size_t WS_SC = WS_IDX + (size_t)M * TOPK * 4;
constexpr size_t WS_XB = WS_SC + (size_t)BATCH * SEQ * SEQ * 2;
constexpr size_t WS_END = WS_XB + (size_t)M * DM * 2;
static_assert(WS_WGU % MiB == 0 && WS_WD % MiB == 0 && WS_WIN % MiB == 0 && WS_WOUT % MiB == 0 && WS_H % MiB == 0 && WS_P % MiB == 0 && WS_Y % MiB == 0 && WS_IDX % MiB == 0 && WS_SC % MiB == 0, "d_ws map alignment");
constexpr int CW_BAR = 4096;

constexpr int RING_OFF = 0, RING_BYTES = 131072;
constexpr int AUX_OFF = RING_BYTES, AUX_BYTES = 16384;
constexpr int LDSCTL_OFF = AUX_OFF + AUX_BYTES;
constexpr int LDS_BYTES = LDSCTL_OFF + 256;

#define GAS __attribute__((address_space(1)))
#define LAS __attribute__((address_space(3)))
typedef unsigned short bf16;
typedef unsigned v4u __attribute__((ext_vector_type(4)));
typedef unsigned v2u __attribute__((ext_vector_type(2)));
typedef int v4i __attribute__((ext_vector_type(4)));
typedef float f32x4 __attribute__((ext_vector_type(4)));
typedef float f32x16 __attribute__((ext_vector_type(16)));
typedef short bf16x8 __attribute__((ext_vector_type(8)));
typedef short s16x4 __attribute__((ext_vector_type(4)));
typedef GAS unsigned gu32;
#define RLX_AGENT __ATOMIC_RELAXED, __HIP_MEMORY_SCOPE_AGENT
#define LDS_WAIT() asm volatile("s_waitcnt lgkmcnt(0)" ::: "memory")
#define VM_WAIT() asm volatile("s_waitcnt vmcnt(0)" ::: "memory")
__device__ __forceinline__ unsigned f2bf(float f) { unsigned u = __builtin_bit_cast(unsigned, f); return (u + 0x7fffu + ((u >> 16) & 1u)) >> 16; }
__device__ __forceinline__ unsigned pk2(float lo, float hi) { return f2bf(lo) | (f2bf(hi) << 16); }
__device__ __forceinline__ float bf_lo(unsigned w) { return __builtin_bit_cast(float, w << 16); }
__device__ __forceinline__ float bf_hi(unsigned w) { return __builtin_bit_cast(float, w & 0xffff0000u); }
__device__ __forceinline__ float bf2f(bf16 h) { return __builtin_bit_cast(float, (unsigned)h << 16); }
__device__ __forceinline__ float wave_sum(float v) {
#pragma unroll
    for (int o = 1; o < 64; o <<= 1) v += __shfl_xor(v, o);
    return v;
}
__device__ __forceinline__ float fexp2(float x) { return __builtin_amdgcn_exp2f(x); }
__device__ __forceinline__ float frcp(float x) { return __builtin_amdgcn_rcpf(x); }
__device__ const unsigned char kBucketLut[128] = {0, 1, 2, 3, 4, 5, 6, 7, 8, 9, 10, 11, 12, 13, 14, 15, 16, 16, 16, 17, 17, 18, 18, 18, 19, 19, 19, 20, 20, 20, 20, 21, 21, 21, 21, 22, 22, 22, 22, 22,
    23, 23, 23, 23, 23, 23, 24, 24, 24, 24, 24, 24, 25, 25, 25, 25, 25, 25, 25, 26, 26, 26, 26, 26, 26, 26, 26, 27, 27, 27, 27, 27, 27, 27, 27, 27, 27, 28, 28, 28, 28, 28, 28, 28, 28, 28, 28,
    29, 29, 29, 29, 29, 29, 29, 29, 29, 29, 29, 29, 30, 30, 30, 30, 30, 30, 30, 30, 30, 30, 30, 30, 30, 30, 31, 31, 31, 31, 31, 31, 31, 31, 31, 31, 31, 31, 31, 31, 31};

#define XB_TMO      128
#define XB_XCNT(j)  (256  + 64 * (j))
#define XB_XSUB(j)  (1280 + 64 * (j))
#define XB_XGEN(j)  (2304 + 64 * (j))
#define XB_TOP      3328
#define XB_TOPGEN   3392
#define XCD_BAR_WORDS 3456
#define XB_SPIN_CAP (1u << 18)

__device__ __forceinline__ unsigned xb_ld(unsigned* p)              { return __hip_atomic_load((GAS unsigned*)p, __ATOMIC_RELAXED, __HIP_MEMORY_SCOPE_AGENT); }
__device__ __forceinline__ unsigned xb_add(unsigned* p, unsigned v) { return __hip_atomic_fetch_add((GAS unsigned*)p, v, __ATOMIC_RELAXED, __HIP_MEMORY_SCOPE_AGENT); }
__device__ __forceinline__ unsigned xb_xcc_id() { return (unsigned)__builtin_amdgcn_s_getreg((3 << 11) | 20) & 0xFu; }
#define XB_SPIN(cond, bar) do { unsigned _sp = 0; while (cond) { __builtin_amdgcn_s_sleep(1); \
    if ((++_sp & 255u) == 0u) { if (xb_ld(&(bar)[XB_TMO])) break; if (_sp > XB_SPIN_CAP) { xb_add(&(bar)[XB_TMO], 1u); break; } } } } while (0)

struct XcdBarrier {
    unsigned* bar; unsigned x;
    volatile LAS unsigned* st;
};

__device__ __forceinline__ XcdBarrier xcd_barrier_post(unsigned* bar, volatile LAS unsigned* st) {
    XcdBarrier b; b.bar = bar; b.x = xb_xcc_id(); b.st = st;
    if (threadIdx.x == 0) (void)xb_add(&bar[XB_XCNT(b.x)], 1u);
    return b;
}
__device__ __forceinline__ void xcd_barrier_complete(unsigned* bar, unsigned x, unsigned& nloc, unsigned& nx) {
    const unsigned G = gridDim.x * gridDim.y * gridDim.z;
    unsigned sum, cnt, mine, sp = 0u;
    for (;;) {
        sum = 0u; cnt = 0u; mine = 0u;
#pragma unroll
        for (unsigned j = 0; j < 16; ++j) { const unsigned c = xb_ld(&bar[XB_XCNT(j)]); sum += c; cnt += (c > 0u) ? 1u : 0u; mine = (j == x) ? c : mine; }
        if (sum == G) break;
        __builtin_amdgcn_s_sleep(1);
        if ((++sp & 255u) == 0u) { if (xb_ld(&bar[XB_TMO])) break; if (sp > XB_SPIN_CAP) { xb_add(&bar[XB_TMO], 1u); break; } }
    }
    nloc = mine > 0u ? mine : 1u; nx = cnt > 0u ? cnt : 1u;
}

__device__ __forceinline__ void xcd_barrier(const XcdBarrier& b) {
    asm volatile("s_waitcnt vmcnt(0)" ::: "memory");
    __syncthreads();
    if (threadIdx.x == 0) {
        unsigned* bar = b.bar; asm volatile("" : "+s"(bar));
        __builtin_amdgcn_s_waitcnt(0);
        unsigned nloc = b.st[0], nx = b.st[1];
        if (nloc == 0u) { xcd_barrier_complete(bar, b.x, nloc, nx); b.st[0] = nloc; b.st[1] = nx; }
        const unsigned old = xb_add(&bar[XB_XSUB(b.x)], 1u);
        const unsigned gen = old / nloc;
        if (old + 1u == (gen + 1u) * nloc) {
            __builtin_amdgcn_fence(__ATOMIC_RELEASE, "agent");
            asm volatile("s_waitcnt vmcnt(0)" ::: "memory");
            const unsigned og = xb_add(&bar[XB_TOP], 1u);
            const unsigned tg = og / nx;
            if (og + 1u == (tg + 1u) * nx) xb_add(&bar[XB_TOPGEN], 1u);
            else XB_SPIN(xb_ld(&bar[XB_TOPGEN]) == tg, bar);
            __builtin_amdgcn_fence(__ATOMIC_ACQUIRE, "agent");
            xb_add(&bar[XB_XGEN(b.x)], 1u);
            asm volatile("s_waitcnt vmcnt(0)" ::: "memory");
        } else {
            XB_SPIN(xb_ld(&bar[XB_XGEN(b.x)]) == gen, bar);
            __builtin_amdgcn_fence(__ATOMIC_ACQUIRE, "agent");
            asm volatile("s_waitcnt vmcnt(0)" ::: "memory");
        }
    }
    __syncthreads();
}

struct Frame {
    LAS unsigned char* lds;
    gu32* ctl;
    int tid, lane, wave, G, gw, NGW;
    const float *x, *c, *w_ada, *b_ada, *norm_g, *w_in, *qk_g, *forget_b, *sinks, *rel_table, *group_g, *w_out, *w_gate, *w_up, *w_down;
    float* out;
    float *MOD, *LF, *KB2; unsigned short* SC; int* IDX;
    bf16 *WGU, *WD, *WIN, *WOUT, *H, *P, *Y, *XB;
};

template <int MAP> __device__ __forceinline__ int w_rowmap(int n) {
    if (MAP == 1) return 256 * (n >> 7) + (n & 127);
    if (MAP == 2) return 256 * (n >> 7) + 128 + (n & 127);
    if (MAP == 3) { if (n < 1728) return n; if (n < 1744) return PA_IW + (n - 1728); if (n < 3920) return n - 16; if (n < 3928) return PC_F + (n - 3920); return n - 24; }
    return n;
}
template <int MAP> __device__ __forceinline__ void p0_transpose_item(const float* W, int K, int N, bf16* WT, LAS unsigned* T, int item, int lane) {
    const int nblk = (N + 63) / 64, kb = item / nblk, nb = item % nblk, k0 = 64 * kb, n0 = 64 * nb;
    const int r = lane >> 4, c = lane & 15;
    const bool nok = (n0 + 4 * c) < N;
    const float* src = W + (size_t)(k0 + 2 * r) * N + n0 + 4 * c;
    f32x4 a[8], b[8];
#pragma unroll
    for (int i = 0; i < 8; ++i) { a[i] = nok ? *(const GAS f32x4*)(src + (size_t)(8 * i) * N) : (f32x4){0.f, 0.f, 0.f, 0.f}; b[i] = nok ? *(const GAS f32x4*)(src + (size_t)(8 * i + 1) * N) : (f32x4){0.f, 0.f, 0.f, 0.f}; }
#pragma unroll
    for (int i = 0; i < 8; ++i)
#pragma unroll
        for (int e = 0; e < 4; ++e) T[(4 * c + e) * 36 + 4 * i + r] = pk2(a[i][e], b[i][e]);
    LDS_WAIT(); asm volatile("" ::: "memory");
    const int rr = lane >> 3, ch = lane & 7;
#pragma unroll
    for (int j = 0; j < 8; ++j) { const int n = 8 * j + rr; const v4u o = *(const LAS v4u*)(T + n * 36 + 4 * ch);
        if (n0 + n < N) *(GAS v4u*)(WT + (size_t)w_rowmap<MAP>(n0 + n) * K + k0 + 8 * ch) = o; }
    LDS_WAIT(); asm volatile("" ::: "memory");
}
constexpr float W8_SCALE = 64.0f; constexpr int W8_E8M0 = 127 - 6;
__device__ __forceinline__ unsigned pk_fp8x4(float a, float b, float c, float d) {
    a = fminf(fmaxf(a, -448.f), 448.f); b = fminf(fmaxf(b, -448.f), 448.f); c = fminf(fmaxf(c, -448.f), 448.f); d = fminf(fmaxf(d, -448.f), 448.f);
    int w = 0; w = __builtin_amdgcn_cvt_pk_fp8_f32(a, b, w, false); w = __builtin_amdgcn_cvt_pk_fp8_f32(c, d, w, true); return (unsigned)w; }
template <int MAP> __device__ __forceinline__ void p0_transpose8_item(const float* W, int K, int N, unsigned char* WT, int ldw, LAS unsigned* T, int item, int lane) {
    const int nblk = (N + 63) / 64, kb = item / nblk, nb = item % nblk, k0 = 64 * kb, n0 = 64 * nb;
    const int r = lane >> 4, c = lane & 15;
    const bool nok = (n0 + 4 * c) < N;
    const float* src = W + (size_t)(k0 + 4 * r) * N + n0 + 4 * c;
    f32x4 q[4][4];
#pragma unroll
    for (int i = 0; i < 4; ++i)
#pragma unroll
        for (int d = 0; d < 4; ++d) q[i][d] = nok ? *(const GAS f32x4*)(src + (size_t)(16 * i + d) * N) : (f32x4){0.f, 0.f, 0.f, 0.f};
#pragma unroll
    for (int i = 0; i < 4; ++i)
#pragma unroll
        for (int e = 0; e < 4; ++e) T[(4 * c + e) * 20 + 4 * i + r] = pk_fp8x4(q[i][0][e] * W8_SCALE, q[i][1][e] * W8_SCALE, q[i][2][e] * W8_SCALE, q[i][3][e] * W8_SCALE);
    LDS_WAIT(); asm volatile("" ::: "memory");
    const int rr = lane >> 2, ch = lane & 3;
#pragma unroll
    for (int j = 0; j < 4; ++j) { const int n = 16 * j + rr; const v4u o = *(const LAS v4u*)(T + n * 20 + 4 * ch);
        if (n0 + n < N) *(GAS v4u*)(WT + (size_t)w_rowmap<MAP>(n0 + n) * ldw + k0 + 16 * ch) = o; }
    LDS_WAIT(); asm volatile("" ::: "memory");
}
template <int MAP> __device__ __forceinline__ void p0_transpose8(const Frame& F, const float* W, int K, int N, unsigned char* WT, int ldw, LAS unsigned* scr) {
    const int nitems = (K / 64) * ((N + 63) / 64);
    for (int it = F.gw; it < nitems; it += F.NGW) p0_transpose8_item<MAP>(W, K, N, WT, ldw, scr, it, F.lane);
}
template <int MAP> __device__ __forceinline__ void p0_transpose(const Frame& F, const float* W, int K, int N, bf16* WT, LAS unsigned* scr) {
    const int nitems = (K / 64) * ((N + 63) / 64);
    for (int it = F.gw; it < nitems; it += F.NGW) p0_transpose_item<MAP>(W, K, N, WT, scr, it, F.lane);
}
__device__ __forceinline__ void p0_prologue(const Frame& F) {
    LAS unsigned* scr = (LAS unsigned*)(F.lds + RING_OFF + F.wave * 16384);
    LAS float* cond = (LAS float*)(F.lds + AUX_OFF);
    LAS float* red = (LAS float*)(F.lds + RING_OFF);
    for (int i = F.tid; i < BATCH * DM; i += NTHREADS) { const float v = F.c[i]; cond[i] = v / (1.0f + __expf(-v)); }
    __syncthreads();
    for (int it = blockIdx.x; it < DEPTH * (NMOD / 64); it += F.G) {
        const int l = it / (NMOD / 64), n = (it % (NMOD / 64)) * 64 + F.lane;
        const float* w = F.w_ada + (size_t)l * DM * NMOD + (size_t)(256 * F.wave) * NMOD + n;
        const LAS float* c0 = cond + 256 * F.wave; const LAS float* c1 = cond + DM + 256 * F.wave;
        float a0 = 0.f, a1 = 0.f;
#pragma unroll 32
        for (int k = 0; k < 256; ++k) { const float wv = w[(size_t)k * NMOD]; a0 += c0[k] * wv; a1 += c1[k] * wv; }
        red[F.wave * 128 + F.lane] = a0; red[F.wave * 128 + 64 + F.lane] = a1;
        __syncthreads();
        if (F.tid < 128) { float sacc = 0.f;
#pragma unroll
            for (int wv = 0; wv < 8; ++wv) sacc += red[wv * 128 + F.tid];
            const int bsel = F.tid >> 6, nn = (it % (NMOD / 64)) * 64 + (F.tid & 63);
            F.MOD[((size_t)l * BATCH + bsel) * NMOD + nn] = sacc + F.b_ada[(size_t)l * NMOD + nn]; }
        __syncthreads();
    }
    for (int lf = 0; lf < DEPTH * 2; ++lf) {
        if (FFN_FP8) {
            p0_transpose8<1>(F, F.w_gate + (size_t)lf * DM * DFF, DM, DFF, (unsigned char*)F.WGU + (size_t)lf * NGU * DM, DM, scr);
            p0_transpose8<2>(F, F.w_up + (size_t)lf * DM * DFF, DM, DFF, (unsigned char*)F.WGU + (size_t)lf * NGU * DM, DM, scr);
            p0_transpose8<0>(F, F.w_down + (size_t)lf * DFF * DM, DFF, DM, (unsigned char*)F.WD + (size_t)lf * DM * DFFP, DFFP, scr);
        } else {
            p0_transpose<1>(F, F.w_gate + (size_t)lf * DM * DFF, DM, DFF, F.WGU + (size_t)lf * NGU * DM, scr);
            p0_transpose<2>(F, F.w_up + (size_t)lf * DM * DFF, DM, DFF, F.WGU + (size_t)lf * NGU * DM, scr);
            p0_transpose<0>(F, F.w_down + (size_t)lf * DFF * DM, DFF, DM, F.WD + (size_t)lf * DM * DFF, scr);
        }
    }
    for (int l = 0; l < DEPTH; ++l) {
        p0_transpose<3>(F, F.w_in + (size_t)l * DM * INC, DM, INC, F.WIN + (size_t)l * NIN * DM, scr);
        p0_transpose<0>(F, F.w_out + (size_t)l * DM * DM, DM, DM, F.WOUT + (size_t)l * DM * DM, scr);
        GAS v4u* z = (GAS v4u*)(F.WIN + (size_t)l * NIN * DM + (size_t)INC * DM);
        for (int i = F.gw * 64 + F.lane; i < (NIN - INC) * DM / 8; i += F.NGW * 64) z[i] = (v4u){0u, 0u, 0u, 0u};
    }
}

template <bool OUT8, bool IN16> __device__ __forceinline__ void ph_modulate(const Frame& F, const void* xin, const float* g, const float* shift, const float* scale) {
    for (int m = F.gw; m < M; m += F.NGW) {
        const int b = m / SEQ;
        float x[4][8]; float s = 0.f;
        if constexpr (IN16) {
            const GAS v4u* xr = (const GAS v4u*)((const bf16*)xin + (size_t)m * DM) + F.lane;
            v4u w[4];
#pragma unroll
            for (int j = 0; j < 4; ++j) w[j] = xr[64 * j];
#pragma unroll
            for (int j = 0; j < 4; ++j) { x[j][0] = bf_lo(w[j].x); x[j][1] = bf_hi(w[j].x); x[j][2] = bf_lo(w[j].y); x[j][3] = bf_hi(w[j].y); x[j][4] = bf_lo(w[j].z); x[j][5] = bf_hi(w[j].z); x[j][6] = bf_lo(w[j].w); x[j][7] = bf_hi(w[j].w); }
        } else {
            const GAS f32x4* xr = (const GAS f32x4*)((const float*)xin + (size_t)m * DM) + 2 * F.lane;
            f32x4 a[4][2];
#pragma unroll
            for (int j = 0; j < 4; ++j) { a[j][0] = xr[128 * j]; a[j][1] = xr[128 * j + 1]; }
            GAS v4u* xo = (GAS v4u*)(F.XB + (size_t)m * DM) + F.lane;
#pragma unroll
            for (int j = 0; j < 4; ++j) { x[j][0] = a[j][0].x; x[j][1] = a[j][0].y; x[j][2] = a[j][0].z; x[j][3] = a[j][0].w; x[j][4] = a[j][1].x; x[j][5] = a[j][1].y; x[j][6] = a[j][1].z; x[j][7] = a[j][1].w;
                v4u w; w.x = pk2(x[j][0], x[j][1]); w.y = pk2(x[j][2], x[j][3]); w.z = pk2(x[j][4], x[j][5]); w.w = pk2(x[j][6], x[j][7]); xo[64 * j] = w; }
        }
#pragma unroll
        for (int j = 0; j < 4; ++j) s += ((x[j][0] * x[j][0] + x[j][1] * x[j][1]) + (x[j][2] * x[j][2] + x[j][3] * x[j][3])) + ((x[j][4] * x[j][4] + x[j][5] * x[j][5]) + (x[j][6] * x[j][6] + x[j][7] * x[j][7]));
        const float rstd = 1.0f / sqrtf(wave_sum(s) * (1.f / DM) + RMS_EPS);
        const GAS f32x4* gp = (const GAS f32x4*)g + 2 * F.lane; const GAS f32x4* sh = (const GAS f32x4*)(shift + (size_t)b * NMOD) + 2 * F.lane; const GAS f32x4* sc = (const GAS f32x4*)(scale + (size_t)b * NMOD) + 2 * F.lane;
        GAS v4u* o16 = (GAS v4u*)(F.H + (size_t)m * DM) + F.lane;
        GAS v2u* o8 = (GAS v2u*)((unsigned char*)F.H + (size_t)m * DM) + F.lane;
#pragma unroll
        for (int j = 0; j < 4; ++j) { float y[8];
#pragma unroll
            for (int h = 0; h < 2; ++h) { const f32x4 gg = gp[128 * j + h], ss = sc[128 * j + h], hh = sh[128 * j + h];
                y[4 * h + 0] = x[j][4 * h + 0] * rstd * gg.x * (ss.x + 1.0f) + hh.x; y[4 * h + 1] = x[j][4 * h + 1] * rstd * gg.y * (ss.y + 1.0f) + hh.y;
                y[4 * h + 2] = x[j][4 * h + 2] * rstd * gg.z * (ss.z + 1.0f) + hh.z; y[4 * h + 3] = x[j][4 * h + 3] * rstd * gg.w * (ss.w + 1.0f) + hh.w; }
            if (OUT8) { v2u w; w.x = pk_fp8x4(y[0], y[1], y[2], y[3]); w.y = pk_fp8x4(y[4], y[5], y[6], y[7]); o8[64 * j] = w; }
            else { v4u w; w.x = pk2(y[0], y[1]); w.y = pk2(y[2], y[3]); w.z = pk2(y[4], y[5]); w.w = pk2(y[6], y[7]); o16[64 * j] = w; } }
    }
}
__device__ __forceinline__ v4u headnorm8(v4u w, const float* g, float mul, int lane, bool normalize) {
    float x[8] = {bf_lo(w.x), bf_hi(w.x), bf_lo(w.y), bf_hi(w.y), bf_lo(w.z), bf_hi(w.z), bf_lo(w.w), bf_hi(w.w)};
    float r = mul;
    if (normalize) {
        float s = 0.f;
#pragma unroll
        for (int i = 0; i < 8; ++i) s += x[i] * x[i];
        s += __shfl_xor(s, 1); s += __shfl_xor(s, 2); s += __shfl_xor(s, 4);
        r = mul / sqrtf(s * (1.f / 64.f) + RMS_EPS);
        const f32x4 g0 = *(const GAS f32x4*)(g + 8 * (lane & 7)), g1 = *(const GAS f32x4*)(g + 8 * (lane & 7) + 4);
        x[0] *= g0.x; x[1] *= g0.y; x[2] *= g0.z; x[3] *= g0.w; x[4] *= g1.x; x[5] *= g1.y; x[6] *= g1.z; x[7] *= g1.w;
    }
    w.x = pk2(x[0] * r, x[1] * r); w.y = pk2(x[2] * r, x[3] * r); w.z = pk2(x[4] * r, x[5] * r); w.w = pk2(x[6] * r, x[7] * r);
    return w;
}
__device__ __forceinline__ void ph_post(const Frame& F, int l) {
    const float* qg = F.qk_g + (size_t)l * 6 * HD;
    for (int m = F.gw; m < M; m += F.NGW) {
        bf16* row = F.P + (size_t)m * NIN; const int lane = F.lane;
        GAS v4u* paq = (GAS v4u*)(row + PA_Q + 8 * lane); GAS v4u* pbq = (GAS v4u*)(row + PB_Q + 8 * lane); GAS v4u* pcq = (GAS v4u*)(row + PC_Q + 8 * lane);
        GAS v4u* pck = (GAS v4u*)(row + PC_K + 8 * lane); GAS v4u* pdq = (GAS v4u*)(row + PD_Q + 8 * lane);
        GAS v4u* pkk = (GAS v4u*)(row + (lane < 8 ? PA_K : PB_K) + 8 * (lane & 7));
        const v4u waq = *paq, wbq = *pbq, wcq = *pcq, wck = *pck, wdq = *pdq;
        v4u wkk = {0u, 0u, 0u, 0u}; if (lane < 16) wkk = *pkk;
        *paq = headnorm8(waq, qg + 0 * HD, QSCALE, lane, true);
        *pbq = headnorm8(wbq, qg + 2 * HD, QSCALE, lane, true);
        *pcq = headnorm8(wcq, qg + 4 * HD, QSCALE, lane, true);
        *pck = headnorm8(wck, qg + 5 * HD, 1.0f, lane, true);
        *pdq = headnorm8(wdq, qg, QSCALE, lane, false);
        if (lane < 16) *pkk = headnorm8(wkk, qg + (lane < 8 ? 1 : 3) * HD, 1.0f, lane, true);
    }
}
__device__ __forceinline__ void ph_scan(const Frame& F, int l) {
    LAS float* wtot = (LAS float*)(F.lds + RING_OFF);
    for (int sq = blockIdx.x; sq < BATCH * NH; sq += F.G) {
        const int b = sq / NH, h = sq % NH; const float fb = F.forget_b[(size_t)l * NH + h];
        const GAS unsigned short* src = (const GAS unsigned short*)(F.P + ((size_t)b * SEQ + 16 * F.tid) * NIN + PC_F + h); float* dst = F.KB2 + (size_t)sq * SEQ + 16 * F.tid;
        float v[16]; unsigned short raw[16];
#pragma unroll
        for (int i = 0; i < 16; ++i) raw[i] = src[(size_t)i * NIN];
#pragma unroll
        for (int i = 0; i < 16; ++i) { const float y = __builtin_bit_cast(float, (unsigned)raw[i] << 16) + fb; v[i] = (y >= 0.f) ? -log1pf(__expf(-y)) : (y - log1pf(__expf(y))); }
#pragma unroll
        for (int i = 1; i < 16; ++i) v[i] += v[i - 1];
        float incl = v[15];
#pragma unroll
        for (int o = 1; o < 64; o <<= 1) { const float t = __shfl_up(incl, o); if (F.lane >= o) incl += t; }
        if (F.lane == 63) wtot[F.wave] = incl;
        __syncthreads();
        float base = incl - v[15];
        for (int w = 0; w < F.wave; ++w) base += wtot[w];
#pragma unroll
        for (int i = 0; i < 4; ++i) *(GAS f32x4*)(dst + 4 * i) = (f32x4){-(v[4 * i] + base) * LOG2E, -(v[4 * i + 1] + base) * LOG2E, -(v[4 * i + 2] + base) * LOG2E, -(v[4 * i + 3] + base) * LOG2E};
        __syncthreads();
    }
}
__device__ __forceinline__ void ph_gnorm(const Frame& F, int l) {
    const float* gg = F.group_g + (size_t)l * DM;
    for (int m = F.gw; m < M; m += F.NGW) {
        v4u w[4];
#pragma unroll
        for (int g = 0; g < 4; ++g) w[g] = *(GAS v4u*)(F.Y + (size_t)m * DM + g * GWID + 8 * F.lane);
#pragma unroll
        for (int g = 0; g < 4; ++g) {
            bf16* p = F.Y + (size_t)m * DM + g * GWID + 8 * F.lane;
            float x[8] = {bf_lo(w[g].x), bf_hi(w[g].x), bf_lo(w[g].y), bf_hi(w[g].y), bf_lo(w[g].z), bf_hi(w[g].z), bf_lo(w[g].w), bf_hi(w[g].w)};
            float s = 0.f;
#pragma unroll
            for (int i = 0; i < 8; ++i) s += x[i] * x[i];
            const float r = 1.0f / sqrtf(wave_sum(s) * (1.f / GWID) + RMS_EPS);
            const f32x4 g0 = *(const GAS f32x4*)(gg + g * GWID + 8 * F.lane), g1 = *(const GAS f32x4*)(gg + g * GWID + 8 * F.lane + 4);
            v4u o; o.x = pk2(x[0] * r * g0.x, x[1] * r * g0.y); o.y = pk2(x[2] * r * g0.z, x[3] * r * g0.w); o.z = pk2(x[4] * r * g1.x, x[5] * r * g1.y); o.w = pk2(x[6] * r * g1.z, x[7] * r * g1.w);
            *(GAS v4u*)p = o;
        }
    }
}


__device__ __forceinline__ unsigned short score_key(float sc) {
    const _Float16 hf = (_Float16)fminf(fmaxf(sc, -60000.f), 60000.f);
    const unsigned h = (unsigned)__builtin_bit_cast(unsigned short, hf);
    return (unsigned short)((h & 0x8000u) ? (~h & 0xffffu) : (h | 0x8000u));
}
__device__ __forceinline__ void glds16x(const void* gsrc, unsigned lds_dst) { unsigned keep;
    asm volatile("s_mov_b32 %0, m0\n\ts_mov_b32 m0, %2\n\ts_nop 0\n\tglobal_load_lds_dwordx4 %1, off\n\ts_mov_b32 m0, %0" : "=&s"(keep) : "v"(gsrc), "s"(lds_dst) : "memory"); }
__device__ __forceinline__ void ph_idx_scores(const Frame& F) {
    constexpr int UPB = 8 * (16 * 17 / 2), NU = BATCH * UPB;
    const int lane = F.lane, r32 = lane & 31, hi = lane >> 5;
    const int u_lo = (int)(((long)blockIdx.x * NU) / F.G), u_hi = (int)(((long)(blockIdx.x + 1) * NU) / F.G);
    if (u_lo >= u_hi) return;
    int b = u_lo / UPB, qb = 127, kc = 0; { int r = u_lo % UPB; for (;;) { const int n = (qb >> 3) + 1; if (r < n) { kc = r; break; } r -= n; --qb; } }
    LAS unsigned char* KL = F.lds + RING_OFF;
    const unsigned kl_lds = (unsigned)(size_t)KL;
#define X1_STAGE(bb, kk, buf) do { const bf16* ksrc_ = F.P + ((size_t)(bb) * SEQ + 512 * (kk) + 64 * F.wave + lane) * NIN + PA_IK; \
        _Pragma("unroll") for (int c_ = 0; c_ < 8; ++c_) glds16x(ksrc_ + 8 * c_, (unsigned)__builtin_amdgcn_readfirstlane(kl_lds + (buf) * 65536 + c_ * 8192 + F.wave * 1024)); } while (0)
    X1_STAGE(b, kc, 0);
    asm volatile("s_waitcnt vmcnt(0)" ::: "memory"); __syncthreads();
    bf16x8 af[4][4]; float wq[4][16]; int cb = -1, cqb = -1;
    for (int u = u_lo; u < u_hi; ++u) {
        const int cur = (u - u_lo) & 1;
        int nb = b, nqb = qb, nkc = kc + 1; if (nkc > (qb >> 3)) { nkc = 0; --nqb; if (nqb < 0) { nqb = 127; ++nb; } }
        if (u + 1 < u_hi) X1_STAGE(nb, nkc, cur ^ 1);
        const size_t rowb = (size_t)b * SEQ; const int t0 = 64 * qb + 8 * F.wave;
        if (b != cb || qb != cqb) { cb = b; cqb = qb;
#pragma unroll
            for (int pr = 0; pr < 4; ++pr) {
                const bf16* qrow = F.P + (rowb + t0 + 2 * pr + ((r32 >> 2) & 1)) * NIN + PA_IQ + ((r32 & 3) + 4 * (r32 >> 3)) * 64 + 8 * hi;
#pragma unroll
                for (int s = 0; s < 4; ++s) af[pr][s] = *(const GAS bf16x8*)(qrow + 16 * s);
                const bf16* wrow = F.P + (rowb + t0 + 2 * pr + hi) * NIN + PA_IW;
                const v4u w0 = *(const GAS v4u*)wrow, w1 = *(const GAS v4u*)(wrow + 8);
                const unsigned ww[8] = {w0.x, w0.y, w0.z, w0.w, w1.x, w1.y, w1.z, w1.w};
#pragma unroll
                for (int i = 0; i < 8; ++i) { wq[pr][2 * i] = bf_lo(ww[i]) * 0.015625f; wq[pr][2 * i + 1] = bf_hi(ww[i]) * 0.015625f; }
            }
        }
        const int kend = 64 * (qb + 1) - 512 * kc;
        const int nkt = kend >= 512 ? 16 : (kend + 31) / 32;
        const LAS unsigned char* kl = KL + cur * 65536 + hi * 8192 + r32 * 16;
        for (int kt = 0; kt < nkt; ++kt) {
            bf16x8 bfr[4];
#pragma unroll
            for (int s = 0; s < 4; ++s) bfr[s] = *(const LAS bf16x8*)(kl + s * 16384 + kt * 512);
            const int s0 = 512 * kc + 32 * kt;
#pragma unroll
            for (int pr = 0; pr < 4; ++pr) {
                f32x16 acc = {};
#pragma unroll
                for (int s = 0; s < 4; ++s) acc = __builtin_amdgcn_mfma_f32_32x32x16_bf16(af[pr][s], bfr[s], acc, 0, 0, 0);
                float sc0 = 0.f, sc1 = 0.f;
#pragma unroll
                for (int r = 0; r < 16; ++r) { sc0 = __builtin_fmaf(wq[pr][r], acc[r], sc0); sc1 = __builtin_fmaf(wq[pr][r], __builtin_fabsf(acc[r]), sc1); if ((r & 3) == 3) asm("" : "+v"(sc1)); }
                ((GAS unsigned short*)F.SC)[(rowb + t0 + 2 * pr + hi) * SEQ + s0 + r32] = score_key(sc0 + sc1);
                __builtin_amdgcn_sched_barrier(0);
            }
        }
        asm volatile("s_waitcnt vmcnt(0)" ::: "memory");
        __syncthreads();
        b = nb; qb = nqb; kc = nkc;
    }
#undef X1_STAGE
}

__device__ __forceinline__ unsigned mbcnt64(unsigned long long m) { return __builtin_amdgcn_mbcnt_hi((unsigned)(m >> 32), __builtin_amdgcn_mbcnt_lo((unsigned)m, 0u)); }
template <int SH, int PSH> __device__ __forceinline__ void sel_level(const unsigned (&v)[64], int nreg, unsigned pval, unsigned need, LAS unsigned* hist, int lane, unsigned& bin_out, unsigned& above_out) {
#pragma unroll
    for (int i = 0; i < 8; ++i) ((LAS v4u*)hist)[lane + 64 * i] = (v4u){0u, 0u, 0u, 0u};
    LDS_WAIT(); __builtin_amdgcn_wave_barrier();
#pragma unroll
    for (int g = 0; g < 8; ++g) if (8 * g < nreg) {
#pragma unroll
        for (int jj = 0; jj < 8; ++jj) { const int j = 8 * g + jj;
#pragma unroll
            for (int e = 0; e < 2; ++e) { const unsigned k = e ? (v[j] >> 16) : (v[j] & 0xffffu);
                const bool pred = (k != 0u) && (PSH >= 16 || (k >> (PSH & 15)) == pval);
                if (pred) __hip_atomic_fetch_add(hist + ((k >> SH) & 2047u), 1u, __ATOMIC_RELAXED, __HIP_MEMORY_SCOPE_WAVEFRONT); }
            if ((jj & 1) == 1) __builtin_amdgcn_sched_barrier(0); }
    }
    LDS_WAIT(); __builtin_amdgcn_wave_barrier();
    unsigned S = 0u;
#pragma unroll
    for (int i = 0; i < 8; ++i) { const v4u q = ((LAS v4u*)hist)[lane * 8 + i]; S += (q.x + q.y) + (q.z + q.w); }
    unsigned T = S;
#pragma unroll
    for (int o = 1; o < 64; o <<= 1) { const unsigned t = __shfl_down(T, o); if (lane + o < 64) T += t; }
    const unsigned above_lane = T - S;
    const bool cross = (T >= need) && (above_lane < need);
    unsigned run = above_lane, bin = 0u, ab = 0u; bool found = false;
#pragma unroll
    for (int i = 7; i >= 0; --i) { const v4u q = ((LAS v4u*)hist)[lane * 8 + i]; const unsigned c4[4] = {q.x, q.y, q.z, q.w};
#pragma unroll
        for (int e = 3; e >= 0; --e) { const bool hit = !found && (run + c4[e] >= need); if (hit) { bin = 32u * lane + 4 * i + e; ab = run; found = true; } run += c4[e]; } }
    const unsigned long long cm = __ballot(cross);
    const int src = cm ? (int)__builtin_ctzll(cm) : 0;
    bin_out = __builtin_amdgcn_readlane(bin, src); above_out = __builtin_amdgcn_readlane(ab, src);
    LDS_WAIT(); __builtin_amdgcn_wave_barrier();
}
__device__ __forceinline__ void select_row(const Frame& F, int m, LAS unsigned* hist, LAS int* out) {
    int lane = F.lane; asm volatile("" : "+v"(lane));
    const int t = m % SEQ, n = t + 1;
    if (n <= TOPK) { for (int j = lane; j < TOPK; j += 64) out[j] = (j < n) ? j : 0; return; }
    const int nreg = (n + 127) >> 7;
    unsigned v[64];
    const GAS unsigned* pr = (const GAS unsigned*)(F.SC + (size_t)m * SEQ) + lane;
#pragma unroll
    for (int g = 0; g < 8; ++g) {
        if (8 * g < nreg) {
#pragma unroll
            for (int jj = 0; jj < 8; ++jj) v[8 * g + jj] = pr[jj * 64];
        } else {
#pragma unroll
            for (int jj = 0; jj < 8; ++jj) v[8 * g + jj] = 0u;
        }
        pr += 512; asm volatile("" : "+v"(pr));
    }
#pragma unroll
    for (int g = 0; g < 8; ++g) if (8 * g < nreg) {
#pragma unroll
        for (int jj = 0; jj < 8; ++jj) { const int j = 8 * g + jj; const int e0 = 128 * j + 2 * lane; const unsigned w = v[j];
            v[j] = ((e0 < n) ? (w & 0xffffu) : 0u) | ((e0 + 1 < n) ? (w & 0xffff0000u) : 0u); asm volatile("" : "+v"(v[j])); }
    }
    unsigned b1, a1, b2, a2;
    sel_level<5, 16>(v, nreg, 0u, (unsigned)TOPK, hist, lane, b1, a1);
    sel_level<0, 5>(v, nreg, b1, (unsigned)TOPK - a1, hist, lane, b2, a2);
    const unsigned tau = (b1 << 5) | (b2 & 31u);
    const unsigned quota = (unsigned)TOPK - a1 - a2;
    unsigned cnt = 0u, ties = 0u;
    int ibase = 2 * lane;
#pragma unroll
    for (int g = 0; g < 8; ++g) if (8 * g < nreg) {
#pragma unroll
      for (int jj = 0; jj < 8; ++jj) { const int j = 8 * g + jj; asm volatile("" : "+v"(ibase));
#pragma unroll
        for (int e = 0; e < 2; ++e) { const unsigned k = e ? (v[j] >> 16) : (v[j] & 0xffffu); const int i = ibase + e;
            const bool gt = k > tau;
            bool sel = gt;
            unsigned long long msel = __ballot(gt);
            const unsigned long long meq = __ballot(k == tau);
            if (__builtin_expect(meq != 0ull, 0)) {
                if (ties < quota) { sel = gt || ((k == tau) && (ties + mbcnt64(meq)) < quota); msel = __ballot(sel); }
                ties += (unsigned)__builtin_popcountll(meq); }
            const unsigned pos = cnt + mbcnt64(msel);
            if (sel && pos < (unsigned)TOPK) out[pos] = i;
            cnt += (unsigned)__builtin_popcountll(msel); }
        ibase += 128;
        if ((jj & 1) == 1) __builtin_amdgcn_sched_barrier(0); }
    }
}


constexpr int AT_K = 0, AT_V = 16384, AT_KB = 32768, AT_WSF = 33280, AT_BT = 35328, AT_DEAD = 35840, AT_SV = 36864;
typedef short v4i16_t __attribute__((ext_vector_type(4)));
__device__ __forceinline__ s16x4 vtr(const LAS unsigned char* p) { return __builtin_bit_cast(s16x4, __builtin_amdgcn_ds_read_tr16_b64_v4i16((LAS v4i16_t*)p)); }
typedef __bf16 bfpair_t __attribute__((ext_vector_type(2))); typedef float f32pair_t __attribute__((ext_vector_type(2)));
__device__ __forceinline__ unsigned cvtpk(float lo, float hi) { const f32pair_t v = {lo, hi}; return __builtin_bit_cast(unsigned, __builtin_convertvector(v, bfpair_t)); }
#define NEG_INF (-__builtin_inff())

template <int TYPE>
__device__ __forceinline__ void dense_attn_unit(const Frame& F, int l, int b, int h, int qb) {
    constexpr int QOFF = TYPE == 1 ? PB_Q : TYPE == 2 ? PC_Q : PD_Q, KOFF = TYPE == 1 ? PB_K : TYPE == 2 ? PC_K : PD_K, VOFF = TYPE == 1 ? PB_V : TYPE == 2 ? PC_V : PD_V;
    constexpr bool MQA = TYPE == 1; constexpr int YOFF = TYPE * GWID;
    const int tid = F.tid, lane = F.lane, wid = F.wave, r32 = lane & 31, hi = lane >> 5;
    LAS unsigned char* L = F.lds + RING_OFF;
    LAS float* wsf = (LAS float*)(L + AT_WSF + wid * 256);
    LAS float* BT = (LAS float*)(L + AT_BT);
    const size_t rowb = (size_t)b * SEQ; const int q0 = qb * 256;
    const bf16* Pk = F.P + rowb * NIN + KOFF + (MQA ? 0 : h * 64);
    const bf16* Pv = F.P + rowb * NIN + VOFF + (MQA ? 0 : h * 64);
    const bf16* Pq = F.P + (rowb + q0 + wid * 32 + r32) * NIN + QOFF + h * 64 + hi * 8;
    bf16x8 qr[4];
#pragma unroll
    for (int d0 = 0; d0 < 4; ++d0) qr[d0] = *(const GAS bf16x8*)(Pq + 16 * d0);
    const int jt_hi = 4 * qb + 3, jt_lo = (TYPE == 1) ? ((4 * qb - 2) > 0 ? (4 * qb - 2) : 0) : 0, nt = jt_hi - jt_lo + 1;
    if (TYPE == 1) { if (tid < 128) BT[tid] = F.rel_table[(int)kBucketLut[tid] * 16 + 8 + h] * LOG2E; }
    const bf16* kgp = Pk + (size_t)lane * NIN + wid * 8;
    const int vkey = tid >> 3, vch = tid & 7;
    const bf16* vgp = Pv + (size_t)vkey * NIN + vch * 8;
    const int kl = wid * 1024 + lane * 16;
    const int vl = (vch >> 2) * 4096 + (vkey >> 3) * 512 + (vkey & 7) * 64 + (vch & 3) * 16;
    const float* kb2 = F.KB2 + ((size_t)b * NH + h) * SEQ;
    v4u kreg = *(const GAS v4u*)(kgp + (size_t)jt_hi * 64 * NIN), vreg = *(const GAS v4u*)(vgp + (size_t)jt_hi * 64 * NIN);
    float kbreg = 0.f; if (TYPE == 2 && tid < 64) kbreg = kb2[jt_hi * 64 + tid];
    *(LAS v4u*)(L + AT_K + kl) = kreg; *(LAS v4u*)(L + AT_V + vl) = vreg; if (TYPE == 2 && tid < 64) ((LAS float*)(L + AT_KB))[tid] = kbreg;
    __syncthreads();
    f32x16 o[2]; o[0] = f32x16{}; o[1] = f32x16{};
    float mrun = NEG_INF, lsum = 0.f, carry = 1.f;
    float qbound = 0.f;
    if (TYPE == 2) {
        float ss = 0.f;
#pragma unroll
        for (int d0 = 0; d0 < 4; ++d0)
#pragma unroll
            for (int j = 0; j < 8; ++j) { const float x = bf2f((bf16)qr[d0][j]); ss += x * x; }
        ss += __shfl_xor(ss, 32);
        float gm = fabsf(F.qk_g[((size_t)l * 6 + 5) * HD + lane]);
#pragma unroll
        for (int o = 1; o < 64; o <<= 1) gm = fmaxf(gm, __shfl_xor(gm, o));
        qbound = sqrtf(ss) * 8.08f * gm;
    }
    const int qrel = 32 * wid + r32;
    const int vb = ((lane >> 4) & 1) * 32 + (lane & 3) * 8 + (4 * hi + ((lane & 15) >> 2)) * 64;
    LAS unsigned* deadf = (LAS unsigned*)(L + AT_DEAD);
    for (int i = 0; i < nt; ++i) {
        const int jt = jt_hi - i, cur = i & 1, jb = jt - 4 * qb; const bool more = (i + 1 < nt);
        float kbnext = 0.f;
        if (more) { kreg = *(const GAS v4u*)(kgp + (size_t)(jt - 1) * 64 * NIN); vreg = *(const GAS v4u*)(vgp + (size_t)(jt - 1) * 64 * NIN); if (TYPE == 2 && tid < 64) kbreg = kb2[(jt - 1) * 64 + tid]; if (TYPE == 2) kbnext = kb2[jt * 64 - 1]; }
        const bool active = (jb <= (wid >> 1)) && (TYPE != 1 || (64 * jb + 63 >= 32 * wid - (WINDOW - 1)));
        if (active) {
            const LAS unsigned char* Kb = L + AT_K + cur * 8192; const LAS unsigned char* Vb = L + AT_V + cur * 8192;
            f32x16 p0 = f32x16{}, p1 = f32x16{};
            bf16x8 ka[4], kc[4];
#pragma unroll
            for (int d0 = 0; d0 < 4; ++d0) { ka[d0] = *(const LAS bf16x8*)(Kb + (2 * d0 + hi) * 1024 + r32 * 16); kc[d0] = *(const LAS bf16x8*)(Kb + (2 * d0 + hi) * 1024 + 512 + r32 * 16); }
            __builtin_amdgcn_sched_barrier(0);
#pragma unroll
            for (int d0 = 0; d0 < 4; ++d0) { p0 = __builtin_amdgcn_mfma_f32_32x32x16_bf16(ka[d0], qr[d0], p0, 0, 0, 0); p1 = __builtin_amdgcn_mfma_f32_32x32x16_bf16(kc[d0], qr[d0], p1, 0, 0, 0); }
            bf16x8 vfr[2][4];
#pragma unroll
            for (int d0 = 0; d0 < 2; ++d0)
#pragma unroll
                for (int ks = 0; ks < 4; ++ks) { const s16x4 lo = vtr(Vb + vb + d0 * 4096 + ks * 1024), hh = vtr(Vb + vb + d0 * 4096 + ks * 1024 + 512);
                    vfr[d0][ks] = (bf16x8){lo[0], lo[1], lo[2], lo[3], hh[0], hh[1], hh[2], hh[3]}; }
            __builtin_amdgcn_sched_barrier(0);
            const int kv0 = 64 * jb + 4 * hi;
            if (TYPE == 3) {
                float b0[16], b1[16];
#pragma unroll
                for (int r = 0; r < 16; ++r) { const int kv = kv0 + (r & 3) + 8 * (r >> 2);
                    const float e0 = fexp2(fminf(p0[r], 80.f)), e1 = fexp2(fminf(p1[r], 80.f));
                    const float m0 = frcp(1.0f + e0), m1 = frcp(1.0f + e1);
                    const bool ok0 = kv < qrel, ok1 = (kv + 32) < qrel;
                    b0[r] = ok0 ? e0 * m0 : 0.f; b1[r] = ok1 ? e1 * m1 : 0.f; p0[r] = ok0 ? m0 : 1.0f; p1[r] = ok1 ? m1 : 1.0f; }
                float gp[8], go[8], pp[8];
#pragma unroll
                for (int g = 0; g < 4; ++g) { gp[g] = (p0[4 * g] * p0[4 * g + 1]) * (p0[4 * g + 2] * p0[4 * g + 3]); gp[4 + g] = (p1[4 * g] * p1[4 * g + 1]) * (p1[4 * g + 2] * p1[4 * g + 3]); }
#pragma unroll
                for (int g = 0; g < 8; ++g) { const float oth = __shfl_xor(gp[g], 32); pp[g] = gp[g] * oth; go[g] = hi ? 1.0f : oth; }
                float sp = 1.0f;
#pragma unroll
                for (int g = 7; g >= 0; --g) { const float sg = sp * go[g] * carry;
                    if (g < 4) { const float c3 = p0[4 * g + 3], c2 = p0[4 * g + 2], c1 = p0[4 * g + 1];
                        p0[4 * g + 3] = b0[4 * g + 3] * sg; const float s2 = sg * c3; p0[4 * g + 2] = b0[4 * g + 2] * s2; const float s1 = s2 * c2; p0[4 * g + 1] = b0[4 * g + 1] * s1; p0[4 * g] = b0[4 * g] * (s1 * c1); }
                    else { const int q = g - 4; const float c3 = p1[4 * q + 3], c2 = p1[4 * q + 2], c1 = p1[4 * q + 1];
                        p1[4 * q + 3] = b1[4 * q + 3] * sg; const float s2 = sg * c3; p1[4 * q + 2] = b1[4 * q + 2] * s2; const float s1 = s2 * c2; p1[4 * q + 1] = b1[4 * q + 1] * s1; p1[4 * q] = b1[4 * q] * (s1 * c1); }
                    sp *= pp[g]; }
                carry *= sp;
            } else {
                if (TYPE == 2) {
                    const LAS f32x4* kbp = (const LAS f32x4*)(L + AT_KB + cur * 256);
#pragma unroll
                    for (int g = 0; g < 4; ++g) { const f32x4 a = kbp[2 * g + hi], c = kbp[8 + 2 * g + hi];
#pragma unroll
                        for (int e = 0; e < 4; ++e) { p0[4 * g + e] += a[e]; p1[4 * g + e] += c[e]; } }
                    if (jb >= 0) {
#pragma unroll
                        for (int r = 0; r < 16; ++r) { const int kv = kv0 + (r & 3) + 8 * (r >> 2); if (kv > qrel) p0[r] = NEG_INF; if (kv + 32 > qrel) p1[r] = NEG_INF; }
                    }
                } else {
#pragma unroll
                    for (int r = 0; r < 16; ++r) { const int d0_ = qrel - (kv0 + (r & 3) + 8 * (r >> 2)), d1_ = d0_ - 32;
                        const bool ok0 = (d0_ >= 0) && (d0_ < WINDOW), ok1 = (d1_ >= 0) && (d1_ < WINDOW);
                        const float t0 = BT[ok0 ? d0_ : 0], t1 = BT[ok1 ? d1_ : 0];
                        p0[r] = ok0 ? p0[r] + t0 : NEG_INF; p1[r] = ok1 ? p1[r] + t1 : NEG_INF; }
                }
                float rm = fmaxf(p0[0], p1[0]);
#pragma unroll
                for (int r = 1; r < 16; ++r) rm = fmaxf(rm, fmaxf(p0[r], p1[r]));
                { auto rr = __builtin_amdgcn_permlane32_swap(__float_as_uint(rm), __float_as_uint(rm), false, false); rm = fmaxf(__uint_as_float(rr[0]), __uint_as_float(rr[1])); }
                const float mn = fmaxf(mrun, rm);
                if (__any(mn > mrun)) {
                    const float f = (mn > mrun) ? fexp2(mrun - mn) : 1.0f;
                    lsum *= f; mrun = mn;
                    if (hi == 0) wsf[r32] = f;
                    LDS_WAIT(); __builtin_amdgcn_wave_barrier();
#pragma unroll
                    for (int g = 0; g < 4; ++g) { const f32x4 fv = ((const LAS f32x4*)wsf)[2 * g + hi];
#pragma unroll
                        for (int e = 0; e < 4; ++e) { o[0][4 * g + e] *= fv[e]; o[1][4 * g + e] *= fv[e]; } }
                    LDS_WAIT(); __builtin_amdgcn_wave_barrier();
                }
                const float ms = (mrun == NEG_INF) ? 0.f : mrun;
                float ps = 0.f;
#pragma unroll
                for (int r = 0; r < 16; ++r) { p0[r] = fexp2(p0[r] - ms); p1[r] = fexp2(p1[r] - ms); ps += p0[r] + p1[r]; }
                lsum += ps;
            }
            bf16x8 pa[4];
#pragma unroll
            for (int ks = 0; ks < 4; ++ks) { v4u w;
                if (ks < 2) { w.x = cvtpk(p0[8 * ks], p0[8 * ks + 1]); w.y = cvtpk(p0[8 * ks + 2], p0[8 * ks + 3]); w.z = cvtpk(p0[8 * ks + 4], p0[8 * ks + 5]); w.w = cvtpk(p0[8 * ks + 6], p0[8 * ks + 7]); }
                else { const int k2 = ks - 2; w.x = cvtpk(p1[8 * k2], p1[8 * k2 + 1]); w.y = cvtpk(p1[8 * k2 + 2], p1[8 * k2 + 3]); w.z = cvtpk(p1[8 * k2 + 4], p1[8 * k2 + 5]); w.w = cvtpk(p1[8 * k2 + 6], p1[8 * k2 + 7]); }
                pa[ks] = __builtin_bit_cast(bf16x8, w); }
#pragma unroll
            for (int d0 = 0; d0 < 2; ++d0)
#pragma unroll
                for (int ks = 0; ks < 4; ++ks) o[d0] = __builtin_amdgcn_mfma_f32_32x32x16_bf16(pa[ks], vfr[d0][ks], o[d0], 0, 0, 0);
        }
        if (TYPE == 2) {
            bool wdead = false;
            if (active && more) wdead = __all(qbound + kbnext - mrun < -40.f);
            if (lane == 0) deadf[cur * 8 + wid] = wdead ? 1u : 0u; }
        if (TYPE == 3) { const bool wdead = active && __all(carry < 2.3e-10f);
            if (lane == 0) deadf[cur * 8 + wid] = wdead ? 1u : 0u; }
        if (more) { *(LAS v4u*)(L + AT_K + (cur ^ 1) * 8192 + kl) = kreg; *(LAS v4u*)(L + AT_V + (cur ^ 1) * 8192 + vl) = vreg; if (TYPE == 2 && tid < 64) ((LAS float*)(L + AT_KB + (cur ^ 1) * 256))[tid] = kbreg; }
        __syncthreads();
        if (TYPE >= 2) { const v4u d0 = *(const LAS v4u*)(deadf + cur * 8), d1 = *(const LAS v4u*)(deadf + cur * 8 + 4);
            if ((d0.x & d0.y & d0.z & d0.w & d1.x & d1.y & d1.z & d1.w) != 0u) break; }
    }
    float inv[16];
    if (TYPE != 3) {
        { auto rr = __builtin_amdgcn_permlane32_swap(__float_as_uint(lsum), __float_as_uint(lsum), false, false); lsum = __uint_as_float(rr[0]) + __uint_as_float(rr[1]); }
        if (TYPE == 1) lsum += fexp2(F.sinks[l * NH + h] * LOG2E - mrun);
        const float il = 1.0f / lsum;
        if (hi == 0) wsf[r32] = il;
        LDS_WAIT(); __builtin_amdgcn_wave_barrier();
#pragma unroll
        for (int g = 0; g < 4; ++g) { const f32x4 fv = ((const LAS f32x4*)wsf)[2 * g + hi]; inv[4 * g] = fv[0]; inv[4 * g + 1] = fv[1]; inv[4 * g + 2] = fv[2]; inv[4 * g + 3] = fv[3]; }
        LDS_WAIT(); __builtin_amdgcn_wave_barrier();
    } else {
#pragma unroll
        for (int r = 0; r < 16; ++r) inv[r] = 1.0f;
    }
    unsigned short gte[2][16];
    if (TYPE == 2) {
#pragma unroll
        for (int d0 = 0; d0 < 2; ++d0)
#pragma unroll
            for (int r = 0; r < 16; ++r) { const int q = (r & 3) + 8 * (r >> 2) + 4 * hi; const size_t mrow = rowb + q0 + wid * 32 + q; gte[d0][r] = ((const GAS unsigned short*)F.P)[mrow * NIN + PC_G + h * 64 + 32 * d0 + r32]; }
    }
#pragma unroll
    for (int d0 = 0; d0 < 2; ++d0)
#pragma unroll
        for (int r = 0; r < 16; ++r) { const int q = (r & 3) + 8 * (r >> 2) + 4 * hi; const size_t mrow = rowb + q0 + wid * 32 + q; const int col = h * 64 + 32 * d0 + r32;
            float val = o[d0][r] * inv[r];
            if (TYPE == 2) val *= frcp(1.0f + fexp2(-LOG2E * __builtin_bit_cast(float, (unsigned)gte[d0][r] << 16)));
            F.Y[mrow * DM + YOFF + col] = (bf16)f2bf(val); }
}

__device__ __forceinline__ void sparse_attn_query(const Frame& F, int m, LAS unsigned char* vch, const LAS float* TBA, const LAS int* idx) {
    int lane = F.lane; asm volatile("" : "+v"(lane));
    const int hh = lane & 15, kg = lane >> 4, t = m % SEQ, b = m / SEQ;
    const size_t rowb = (size_t)b * SEQ;
    const int nsel = (t + 1) < TOPK ? (t + 1) : TOPK, nch = (nsel + 63) >> 6;
    const bf16* qp = F.P + (size_t)m * NIN + PA_Q + (hh & 7) * 64 + 8 * kg;
    const bf16x8 qf0 = *(const GAS bf16x8*)qp, qf1 = *(const GAS bf16x8*)(qp + 32);
    float s[4][4][4];
#pragma unroll
    for (int cp = 0; cp < 2; ++cp) {
        if (2 * cp < nch) {
            bf16x8 kf[8][2];
#pragma unroll
            for (int bb = 0; bb < 8; ++bb) { const int keyA = idx[128 * cp + 16 * bb + hh];
                const bf16* kp = F.P + (rowb + keyA) * NIN + PA_K + 8 * kg;
                kf[bb][0] = *(const GAS bf16x8*)kp; kf[bb][1] = *(const GAS bf16x8*)(kp + 32); }
            __builtin_amdgcn_sched_barrier(0);
#pragma unroll
            for (int bb = 0; bb < 8; ++bb) { const int c = 2 * cp + (bb >> 2), blk = bb & 3, j0 = 64 * c + 16 * blk;
                f32x4 acc = {0.f, 0.f, 0.f, 0.f};
                acc = __builtin_amdgcn_mfma_f32_16x16x32_bf16(kf[bb][0], qf0, acc, 0, 0, 0); acc = __builtin_amdgcn_mfma_f32_16x16x32_bf16(kf[bb][1], qf1, acc, 0, 0, 0);
                const v4i id4 = *(const LAS v4i*)(idx + j0 + 4 * kg);
#pragma unroll
                for (int r = 0; r < 4; ++r) { const int j = j0 + 4 * kg + r; int dist = t - id4[r]; dist = dist < 0 ? 0 : (dist > 128 ? 128 : dist);
                    const float bias = TBA[dist * 8 + (hh & 7)];
                    s[c][blk][r] = (j < nsel) ? acc[r] + bias : NEG_INF; }
            }
        } else {
#pragma unroll
            for (int c = 2 * cp; c < 2 * cp + 2; ++c)
#pragma unroll
                for (int blk = 0; blk < 4; ++blk)
#pragma unroll
                    for (int r = 0; r < 4; ++r) s[c][blk][r] = NEG_INF;
        }
    }
    v4u xv[2][8];
#define SP_VLOAD(c_, X) do { const int keyV_ = idx[64 * (c_) + lane]; const bf16* vp_ = F.P + (rowb + keyV_) * NIN + PA_V; \
        _Pragma("unroll") for (int i_ = 0; i_ < 8; ++i_) X[i_] = *(const GAS v4u*)(vp_ + 8 * i_); } while (0)
    SP_VLOAD(0, xv[0]);
    if (1 < nch) SP_VLOAD(1, xv[1]);
    __builtin_amdgcn_sched_barrier(0);
    float mx = NEG_INF;
#pragma unroll
    for (int c = 0; c < 4; ++c)
#pragma unroll
        for (int blk = 0; blk < 4; ++blk)
#pragma unroll
            for (int r = 0; r < 4; ++r) mx = fmaxf(mx, s[c][blk][r]);
    mx = fmaxf(mx, __shfl_xor(mx, 16)); mx = fmaxf(mx, __shfl_xor(mx, 32));
    float sum = 0.f;
#pragma unroll
    for (int c = 0; c < 4; ++c)
#pragma unroll
        for (int blk = 0; blk < 4; ++blk)
#pragma unroll
            for (int r = 0; r < 4; ++r) { const float p = fexp2(s[c][blk][r] - mx); s[c][blk][r] = p; sum += p; }
    sum += __shfl_xor(sum, 16); sum += __shfl_xor(sum, 32);
    const float inv = 1.0f / sum;
    f32x4 oacc[4];
#pragma unroll
    for (int d = 0; d < 4; ++d) oacc[d] = (f32x4){0.f, 0.f, 0.f, 0.f};
    const int q4 = (lane & 15) >> 2, p4 = lane & 3;
#pragma unroll
    for (int c = 0; c < 4; ++c) {
        if (c < nch) {
#pragma unroll
            for (int i = 0; i < 8; ++i) *(LAS v4u*)(vch + (i >> 2) * 4096 + lane * 64 + (i & 3) * 16) = xv[c & 1][i];
            LDS_WAIT(); __builtin_amdgcn_wave_barrier();
            if (c + 2 < nch) SP_VLOAD(c + 2, xv[c & 1]);
            __builtin_amdgcn_sched_barrier(0);
#pragma unroll
            for (int kp = 0; kp < 2; ++kp) { v4u w; w.x = cvtpk(s[c][2 * kp][0], s[c][2 * kp][1]); w.y = cvtpk(s[c][2 * kp][2], s[c][2 * kp][3]); w.z = cvtpk(s[c][2 * kp + 1][0], s[c][2 * kp + 1][1]); w.w = cvtpk(s[c][2 * kp + 1][2], s[c][2 * kp + 1][3]);
                const bf16x8 pf = __builtin_bit_cast(bf16x8, w);
#pragma unroll
                for (int d = 0; d < 4; ++d) { const LAS unsigned char* a = vch + (d >> 1) * 4096 + (32 * kp + 4 * kg + q4) * 64 + ((d & 1) * 16 + 4 * p4) * 2;
                    const s16x4 lo = vtr(a), hv = vtr(a + 16 * 64);
                    const bf16x8 vf = {lo[0], lo[1], lo[2], lo[3], hv[0], hv[1], hv[2], hv[3]};
                    oacc[d] = __builtin_amdgcn_mfma_f32_16x16x32_bf16(vf, pf, oacc[d], 0, 0, 0); } }
            LDS_WAIT(); __builtin_amdgcn_wave_barrier();
        }
    }
#undef SP_VLOAD
    if (hh < 8) {
#pragma unroll
        for (int d = 0; d < 4; ++d) { v2u w; w.x = pk2(oacc[d][0] * inv, oacc[d][1] * inv); w.y = pk2(oacc[d][2] * inv, oacc[d][3] * inv);
            *(GAS v2u*)(F.Y + (size_t)m * DM + hh * 64 + 16 * d + 4 * kg) = w; }
    }
}

constexpr int CW_QUEUE = 8192;
constexpr int MIX_ITEMS = 2560;
template <unsigned EN> __device__ __forceinline__ void ph_attention(const Frame& F, int l, int qsel = 0) {
    LAS float* TBA = (LAS float*)(F.lds + AUX_OFF);
    for (int i = F.tid; i < 129 * 8; i += NTHREADS) { const int d = i >> 3, hq = i & 7; const int bk = d < 128 ? (int)kBucketLut[d] : 31; TBA[i] = F.rel_table[bk * 16 + hq] * LOG2E; }
    LAS unsigned* qslot = (LAS unsigned*)(F.lds + LDSCTL_OFF + 64);
    LAS unsigned char* wbuf = F.lds + RING_OFF + AT_SV + F.wave * 9216;
    LAS int* idxl = (LAS int*)(wbuf + 8192);
    __syncthreads();
#define MIX_FETCH(it) do { if (F.tid == 0) *qslot = __hip_atomic_fetch_add((unsigned*)(F.ctl + CW_QUEUE + 64 * l + 32 * qsel), 1u, __ATOMIC_RELAXED, __HIP_MEMORY_SCOPE_AGENT); \
        __syncthreads(); it = (int)*qslot; __syncthreads(); } while (0)
    int it; MIX_FETCH(it);
    while (it < 1024) { const int r = it;
        if (EN & 0x800) {
            const int b = r >> 9, blk = r & 511;
#pragma unroll 1
            for (int k = 0; k < 2; ++k) { const int u = 8 * blk + F.wave; const int t = k ? (SEQ - 1 - u) : u; const int m = b * SEQ + t;
                select_row(F, m, (LAS unsigned*)wbuf, idxl);
                LDS_WAIT(); __builtin_amdgcn_wave_barrier();
#ifdef PROBE_SEL2
                select_row(F, m, (LAS unsigned*)wbuf, idxl); LDS_WAIT(); __builtin_amdgcn_wave_barrier();
#endif
#ifdef PROBE_ATT2
                sparse_attn_query(F, m, wbuf, TBA, idxl); LDS_WAIT(); __builtin_amdgcn_wave_barrier();
#endif
                sparse_attn_query(F, m, wbuf, TBA, idxl);
                LDS_WAIT(); __builtin_amdgcn_wave_barrier(); }
        }
        MIX_FETCH(it); }
    while (it < 1536) { const int r = it & 511; if (EN & 0x100) dense_attn_unit<2>(F, l, (r & 15) >> 3, r & 7, 31 - (r >> 4)); MIX_FETCH(it); }
    while (it < 2048) { const int r = it & 511; if (EN & 0x200) dense_attn_unit<3>(F, l, (r & 15) >> 3, r & 7, 31 - (r >> 4)); MIX_FETCH(it); }
    while (it < MIX_ITEMS) { const int r = it & 511; if (EN & 0x400) dense_attn_unit<1>(F, l, (r & 15) >> 3, r & 7, 31 - (r >> 4)); MIX_FETCH(it); }
#undef MIX_FETCH
}


__device__ __forceinline__ const float* gp_(const float* p) {
#if defined(__HIP_DEVICE_COMPILE__)
    __builtin_assume(!__builtin_amdgcn_is_shared((const __attribute__((address_space(0))) void*)p)); __builtin_assume(!__builtin_amdgcn_is_private((const __attribute__((address_space(0))) void*)p));
#endif
    return p; }
#ifndef PROBE_KINDS
#define PROBE_KINDS 0u
#endif
#ifndef PROBE_ATT
#define PROBE_ATT 0xF00u
#endif
#ifndef PROBE_REPS
#define PROBE_REPS 1
#endif
#ifndef MK_ONE_LAUNCH
#define MK_ONE_LAUNCH 1
#endif
constexpr int PH_PER_LAYER = 14, N_PHASES = 1 + DEPTH * PH_PER_LAYER;
struct Args { const float* in[15]; float* out; unsigned char* ws; int ph_lo, ph_hi; };
struct ArgsG { const GAS float* in[15]; GAS float* out; GAS unsigned char* ws; int ph_lo, ph_hi; };
template <unsigned EN> __global__ void __launch_bounds__(NTHREADS, 2) trunk_fwd(Args args) {
    extern __shared__ __attribute__((aligned(16))) unsigned char lds[];
    LAS unsigned char* const ldsb = (LAS unsigned char*)lds;
    const int wave0 = __builtin_amdgcn_readfirstlane((int)threadIdx.x >> 6);
    for (int u = threadIdx.x; u < (LDS_BYTES - LDSCTL_OFF) / 4; u += NTHREADS) ((LAS unsigned*)(ldsb + LDSCTL_OFF))[u] = 0u;
    __syncthreads();
#if MK_ONE_LAUNCH
    constexpr int lo = 0, hi = N_PHASES;
#else
    const int lo = args.ph_lo, hi = args.ph_hi;
#endif
    XcdBarrier bar; bar.bar = (unsigned*)(args.ws + WS_CTL) + CW_BAR; bar.x = 0; bar.st = nullptr;
    if (hi - lo > 1) bar = xcd_barrier_post((unsigned*)(args.ws + WS_CTL) + CW_BAR, (volatile LAS unsigned*)(ldsb + LDSCTL_OFF));
#define GP(p) ((const float*)(p))
#define PH_BEGIN(k, kind) if (lo <= (k) && (k) < hi) { _Pragma("unroll 1") for (int rep_ = 0; rep_ < (((PROBE_KINDS >> (kind)) & 1u) ? PROBE_REPS : 1); ++rep_) { Frame F; { \
        const ArgsG* ka = (const ArgsG*)__builtin_amdgcn_kernarg_segment_ptr(); asm volatile("" : "+s"(ka)); \
        unsigned o_ = ~0u; asm volatile("" : "+s"(o_)); int t_ = wave0 * 64 + (int)__builtin_amdgcn_mbcnt_hi(o_, __builtin_amdgcn_mbcnt_lo(o_, 0u)); asm volatile("" : "+v"(t_)); \
        F.lds = ldsb; F.tid = t_; F.lane = t_ & 63; F.wave = wave0; int gw_ = blockIdx.x * NWAVES + wave0; asm volatile("" : "+s"(gw_)); F.G = gridDim.x; F.gw = gw_; F.NGW = F.G * NWAVES; \
        unsigned char* ws = (unsigned char*)ka->ws; F.ctl = (gu32*)(ws + WS_CTL);     \
        F.x = GP(ka->in[0]); F.c = GP(ka->in[1]); F.w_ada = GP(ka->in[2]); F.b_ada = GP(ka->in[3]); F.norm_g = GP(ka->in[4]); F.w_in = GP(ka->in[5]); F.qk_g = GP(ka->in[6]); F.forget_b = GP(ka->in[7]); \
        F.sinks = GP(ka->in[8]); F.rel_table = GP(ka->in[9]); F.group_g = GP(ka->in[10]); F.w_out = GP(ka->in[11]); F.w_gate = GP(ka->in[12]); F.w_up = GP(ka->in[13]); F.w_down = GP(ka->in[14]); F.out = (float*)ka->out; \
        F.MOD = (float*)(ws + WS_MOD); F.LF = (float*)(ws + WS_LF); F.KB2 = (float*)(ws + WS_KB2); F.SC = (unsigned short*)(ws + WS_SC); F.IDX = (int*)(ws + WS_IDX); \
        F.WGU = (bf16*)(ws + WS_WGU); F.WD = (bf16*)(ws + WS_WD); F.WIN = (bf16*)(ws + WS_WIN); F.WOUT = (bf16*)(ws + WS_WOUT); \
        F.H = (bf16*)(ws + WS_H); F.P = (bf16*)(ws + WS_P); F.Y = (bf16*)(ws + WS_Y); F.XB = (bf16*)(ws + WS_XB); }
#define PH_END(k) if ((k) + 1 < hi) xcd_barrier(bar); } }

    PH_BEGIN(0, 31) if (EN & 1) p0_prologue(F); PH_END(0)

    for (int l = 0; l < DEPTH; ++l) {
        const int base = 1 + l * PH_PER_LAYER;
        for (int sub = 0; sub < 3; ++sub) {
            if (sub != 1) {
                const int f = sub >> 1, pb = base + (f ? 11 : 0), ni = f ? 2 : 0, lf = l * 2 + f;
                PH_BEGIN(pb, (f ? 11 : 0)) if (EN & 2) { const float* modl = F.MOD + (size_t)l * BATCH * NMOD;
                    if (l == 0 && f == 0) ph_modulate<FFN_FP8, false>(F, F.x, F.norm_g + ((size_t)l * 3 + ni) * DM, modl + (3 * ni + 0) * DM, modl + (3 * ni + 1) * DM);
                    else ph_modulate<FFN_FP8, true>(F, F.XB, F.norm_g + ((size_t)l * 3 + ni) * DM, modl + (3 * ni + 0) * DM, modl + (3 * ni + 1) * DM); } PH_END(pb)
                PH_BEGIN(pb + 1, (f ? 12 : 1)) if (EN & 4) {
                    pg8::StaticOrder S; S.init(M, NGU, F.G, (int)blockIdx.x);
                    if constexpr (FFN_FP8) { pg8::Gemm g{F.H, (const bf16*)((const unsigned char*)F.WGU + (size_t)lf * NGU * DM), M, NGU, DM, 127, W8_E8M0};
                        pg8::EpiSwiGLU8 E{(unsigned char*)F.P, DFFP};
                        pg8::gemm_phase<pg8::EpiSwiGLU8, pg8::StaticOrder, true, true, true>(F.lds + RING_OFF, g, S, E, F.tid); }
                    else { pg8::Gemm g{F.H, F.WGU + (size_t)lf * NGU * DM, M, NGU, DM};
                        pg8::EpiSwiGLU E{F.P, DFF};
                        pg8::gemm_phase<pg8::EpiSwiGLU, pg8::StaticOrder, true, true>(F.lds + RING_OFF, g, S, E, F.tid); } } PH_END(pb + 1)
                PH_BEGIN(pb + 2, (f ? 13 : 2)) if (EN & 8) {
                    pg8::Gemm g{F.P, FFN_FP8 ? (const bf16*)((const unsigned char*)F.WD + (size_t)lf * DM * DFFP) : F.WD + (size_t)lf * DM * DFF, M, DM, DFF, 127, FFN_FP8 ? W8_E8M0 : 127, FFN_FP8 ? DFFP : 0, FFN_FP8 ? DFFP : 0}; pg8::StaticOrder S; S.init(M, DM, F.G, (int)blockIdx.x);
                    const float* modl = F.MOD + (size_t)l * BATCH * NMOD;
                    if (l == DEPTH - 1 && f == 1) { pg8::EpiResid<false> E{F.XB, rep_ ? (void*)F.SC : (void*)F.out, DM, modl + (3 * ni + 2) * DM, NMOD, SEQ, 0.5f};
                        pg8::gemm_phase<pg8::EpiResid<false>, pg8::StaticOrder, true, true, FFN_FP8>(F.lds + RING_OFF, g, S, E, F.tid); }
                    else { pg8::EpiResid<true> E{F.XB, rep_ ? (void*)F.SC : (void*)F.XB, DM, modl + (3 * ni + 2) * DM, NMOD, SEQ, 0.5f};
                        pg8::gemm_phase<pg8::EpiResid<true>, pg8::StaticOrder, true, true, FFN_FP8>(F.lds + RING_OFF, g, S, E, F.tid); } } PH_END(pb + 2)
            } else {
                PH_BEGIN(base + 3, 3) if (EN & 2) { const float* modl = F.MOD + (size_t)l * BATCH * NMOD; ph_modulate<false, true>(F, F.XB, F.norm_g + ((size_t)l * 3 + 1) * DM, modl + 3 * DM, modl + 4 * DM); } PH_END(base + 3)
                PH_BEGIN(base + 4, 4) if (EN & 16) {
                    pg8::Gemm g{F.H, F.WIN + (size_t)l * NIN * DM, M, NIN, DM}; pg8::StaticOrder S; S.init(M, NIN, F.G, (int)blockIdx.x);
                    pg8::EpiBf16 E{F.P, NIN};
                    pg8::gemm_phase<pg8::EpiBf16, pg8::StaticOrder, true, true>(F.lds + RING_OFF, g, S, E, F.tid); } PH_END(base + 4)
                PH_BEGIN(base + 6, 6) if (EN & 64) { ph_scan(F, l);
                    int par_ = (int)(blockIdx.x & 1u); asm volatile("" : "+s"(par_));
                    _Pragma("unroll 1") for (int st_ = 0; st_ < 2; ++st_) { if ((st_ ^ par_) == 0) { if (EN & 32) ph_post(F, l); } else ph_idx_scores(F); } } PH_END(base + 6)
                PH_BEGIN(base + 8, 8) if (EN & 0xF00) { if (rep_ == 0) ph_attention<EN>(F, l, 0); else ph_attention<(PROBE_ATT)>(F, l, 1); } PH_END(base + 8)
                PH_BEGIN(base + 9, 9) if (EN & 0x1000) ph_gnorm(F, l); PH_END(base + 9)
                PH_BEGIN(base + 10, 10) if (EN & 0x2000) {
                    pg8::Gemm g{F.Y, F.WOUT + (size_t)l * DM * DM, M, DM, DM}; pg8::StaticOrder S; S.init(M, DM, F.G, (int)blockIdx.x);
                    const float* modl = F.MOD + (size_t)l * BATCH * NMOD;
                    pg8::EpiResid<true> E{F.XB, rep_ ? (void*)F.SC : (void*)F.XB, DM, modl + 5 * DM, NMOD, SEQ, 1.0f};
                    pg8::gemm_phase<pg8::EpiResid<true>, pg8::StaticOrder, true, true>(F.lds + RING_OFF, g, S, E, F.tid); } PH_END(base + 10)
            }
        }
    }
#undef PH_BEGIN
#undef PH_END
}

#ifndef EN_MASK
#define EN_MASK 0xFFFFu
#endif
template <unsigned EN> static int setup_kernel() {
    if (hipFuncSetAttribute((const void*)trunk_fwd<EN>, hipFuncAttributeMaxDynamicSharedMemorySize, LDS_BYTES) != hipSuccess) { fprintf(stderr, "kernel_launch: hipFuncSetAttribute failed\n"); return -1; }
    int per_cu = 0;
    if (hipOccupancyMaxActiveBlocksPerMultiprocessor(&per_cu, (const void*)trunk_fwd<EN>, NTHREADS, LDS_BYTES) != hipSuccess || per_cu < 1) { fprintf(stderr, "kernel_launch: occupancy query says %d\n", per_cu); }
    (void)hipGetLastError();
    return 0;
}
template <unsigned EN> static void launch_range(const Args& a0, int lo, int hi, int grid, hipStream_t stream) {
    Args a = a0; a.ph_lo = lo; a.ph_hi = hi;
    hipLaunchKernelGGL(trunk_fwd<EN>, dim3(grid), dim3(NTHREADS), LDS_BYTES, stream, a);
}
extern "C" void kernel_launch(void* const* d_in, const int* in_sizes, int n_in, void* d_out, int out_size, void* d_ws, size_t ws_size, hipStream_t stream) {
    static int grid = 0;
    if (grid == 0) {
        if (n_in != 15 || in_sizes[0] != M * DM || out_size != M * DM || ws_size < WS_END) {
            fprintf(stderr, "kernel_launch: shape/workspace mismatch: n_in %d in0 %d out %d ws %zu (need %zu); nothing launched\n", n_in, n_in > 0 ? in_sizes[0] : -1, out_size, ws_size, (size_t)WS_END); grid = -1; return; }
        int dev = 0, cus = 0;
        if (hipGetDevice(&dev) != hipSuccess || hipDeviceGetAttribute(&cus, hipDeviceAttributeMultiprocessorCount, dev) != hipSuccess) { grid = -1; return; }
#if MK_ONE_LAUNCH
        if (setup_kernel<EN_MASK>()) { grid = -1; return; }
#else
        if (setup_kernel<0x1u>() || setup_kernel<0x2u>() || setup_kernel<0x4u>() || setup_kernel<0x8u>() || setup_kernel<0x10u>() || setup_kernel<0x20u>() || setup_kernel<0x40u>() || setup_kernel<0x80u>() ||
            setup_kernel<0x100u>() || setup_kernel<0x200u>() || setup_kernel<0x400u>() || setup_kernel<0x800u>() || setup_kernel<0x1000u>() || setup_kernel<0x2000u>()) { grid = -1; return; }
#endif
        grid = cus;
    }
    if (grid < 0) return;
    if (hipMemsetAsync((char*)d_ws + WS_CTL, 0, CTL_ZERO_BYTES, stream) != hipSuccess) return;
    Args a{};
    for (int i = 0; i < 15; ++i) a.in[i] = (const float*)d_in[i];
    a.out = (float*)d_out; a.ws = (unsigned char*)d_ws;
#if MK_ONE_LAUNCH
    launch_range<EN_MASK>(a, 0, N_PHASES, grid, stream);
#else
    launch_range<0x1u>(a, 0, 1, grid, stream);
    for (int l = 0; l < DEPTH; ++l) { const int base = 1 + l * PH_PER_LAYER;
        for (int f = 0; f < 2; ++f) { const int pb = base + (f ? 11 : 0);
            if (f == 1) {
                launch_range<0x2u>(a, base + 3, base + 4, grid, stream); launch_range<0x10u>(a, base + 4, base + 5, grid, stream); launch_range<0x20u>(a, base + 5, base + 6, grid, stream);
                launch_range<0x40u>(a, base + 6, base + 7, grid, stream); launch_range<0x80u>(a, base + 7, base + 8, grid, stream);
                launch_range<0x100u>(a, base + 8, base + 9, grid, stream); launch_range<0x200u>(a, base + 8, base + 9, grid, stream); launch_range<0x400u>(a, base + 8, base + 9, grid, stream); launch_range<0x800u>(a, base + 8, base + 9, grid, stream);
                launch_range<0x1000u>(a, base + 9, base + 10, grid, stream); launch_range<0x2000u>(a, base + 10, base + 11, grid, stream);
            }
            launch_range<0x2u>(a, pb, pb + 1, grid, stream); launch_range<0x4u>(a, pb + 1, pb + 2, grid, stream); launch_range<0x8u>(a, pb + 2, pb + 3, grid, stream);
        }
    }
#endif
}
```

```cpp
#include <hip/hip_runtime.h>
#include <cstdio>
#include <cstdint>

namespace pg8 {
#define PG8_LAS __attribute__((address_space(3)))
typedef unsigned short bf16_t;
typedef short bf16x8 __attribute__((ext_vector_type(8)));
typedef float f32x4 __attribute__((ext_vector_type(4)));
typedef unsigned u32x4 __attribute__((ext_vector_type(4)));
constexpr int BM = 256, BK = 64, HALF = 128, HTB = HALF * BK * 2  , STAGE_BYTES = 8 * HTB, NXCD = 8, WGM = 8;

__host__ __device__ __forceinline__ int lds_byte(int r, int c) { const int st = (r >> 4) * 2 + (c >> 5), rr = r & 15, cc = c & 31, ob = rr * 64 + cc * 2; return st * 1024 + (ob ^ (((ob >> 9) & 1) << 5)); }
__host__ __device__ __forceinline__ void stage_rc(int b, int& R, int& C) { const int st = b / 1024, sb = b % 1024, swz = sb ^ (((sb >> 9) & 1) << 5); R = (st >> 1) * 16 + swz / 64; C = (st & 1) * 32 + (swz % 64) / 2; }
__host__ __device__ __forceinline__ int perm32(int rho) { const int n = rho >> 4, i = rho & 15; return 8 * (i >> 2) + 4 * n + (i & 3); }

struct Unit { int pm, pn; };
struct Gemm { const bf16_t* A; const bf16_t* Bt; int M, N, K; int scaleA = 127, scaleB = 127; int lda = 0, ldb = 0; int blk = 0; };
typedef int i32x8 __attribute__((ext_vector_type(8))); typedef int i32x4v __attribute__((ext_vector_type(4)));
__device__ __forceinline__ i32x8 pg8_cat(bf16x8 lo, bf16x8 hi) { return __builtin_shufflevector(__builtin_bit_cast(i32x4v, lo), __builtin_bit_cast(i32x4v, hi), 0, 1, 2, 3, 4, 5, 6, 7); }

struct StaticOrder {
    int nM, nN, nwg, G, c;
    __host__ __device__ void init(int M, int N, int G_, int c_) { nM = M / BM; nN = N / BM; nwg = nM * nN; G = G_; c = c_; }
    __host__ __device__ bool next(int i, Unit& u) const {
        const long L = (long)i * G + c; if (L >= nwg) return false;
        int wgid = (int)L; { const int q = nwg / NXCD, r = nwg % NXCD, xcd = wgid % NXCD, off = wgid / NXCD; wgid = (xcd < r ? xcd * (q + 1) : r * (q + 1) + (xcd - r) * q) + off; }
        const int nig = WGM * nN, gid = wgid / nig, fm = gid * WGM, gsz = (nM - fm) < WGM ? (nM - fm) : WGM;
        u.pm = fm + ((wgid % nig) % gsz); u.pn = (wgid % nig) / gsz; return true;
    }
    __device__ __forceinline__ void a_ready(const Unit&) const {}
    __device__ __forceinline__ void done(const Unit&) const {}
};
typedef __bf16 pg8_bfpair __attribute__((ext_vector_type(2))); typedef float pg8_f32pair __attribute__((ext_vector_type(2)));
__device__ __forceinline__ unsigned cvt_pk_bf16(float lo, float hi) { const pg8_f32pair v = {lo, hi}; return __builtin_bit_cast(unsigned, __builtin_convertvector(v, pg8_bfpair)); }
__device__ __forceinline__ unsigned cvt_pk_bf16_nv(float lo, float hi) { return cvt_pk_bf16(lo, hi); }
__device__ __forceinline__ const char* uptr(const char* p) { const unsigned long long v = (unsigned long long)p; const unsigned lo = __builtin_amdgcn_readfirstlane((unsigned)v), hi = __builtin_amdgcn_readfirstlane((unsigned)(v >> 32)); return (const char*)(((unsigned long long)hi << 32) | lo); }
struct EpiBf16 {
    static constexpr bool PERM = true, AFTER_DRAIN = false;
    bf16_t* O; int ldc;
    __device__ __forceinline__ void operator()(const f32x4 (&acc)[2][2][4][2], const Unit& u, int wr, int wc, int fr, int fq) const {
        asm volatile("" : "+v"(fr), "+v"(fq));
        const int row0 = u.pm * BM + wr * 64 + fr; const int col0 = u.pn * BM + wc * 32 + 8 * fq;
#pragma unroll
        for (int ai = 0; ai < 2; ++ai)
#pragma unroll
            for (int m = 0; m < 4; ++m) { bf16_t* rowp = O + (size_t)(row0 + ai * HALF + m * 16) * ldc + col0;
#pragma unroll
                for (int bj = 0; bj < 2; ++bj) { const f32x4 v0 = acc[ai][bj][m][0], v1 = acc[ai][bj][m][1];
                    u32x4 w; w.x = cvt_pk_bf16(v0[0], v0[1]); w.y = cvt_pk_bf16(v0[2], v0[3]); w.z = cvt_pk_bf16(v1[0], v1[1]); w.w = cvt_pk_bf16(v1[2], v1[3]);
                    *(u32x4*)(rowp + bj * HALF) = w; } }
    }
};
__device__ __forceinline__ float silu_mul(float g, float u) { return g * u * __builtin_amdgcn_rcpf(1.0f + __builtin_amdgcn_exp2f(-1.4426950408889634f * g)); }
struct EpiSwiGLU {
    static constexpr bool PERM = true, AFTER_DRAIN = false;
    bf16_t* O; int ldc;
    __device__ __forceinline__ void operator()(const f32x4 (&acc)[2][2][4][2], const Unit& u, int wr, int wc, int fr, int fq) const {
        asm volatile("" : "+v"(fr), "+v"(fq));
        const int row0 = u.pm * BM + wr * 64 + fr; const int col0 = u.pn * HALF + wc * 32 + 8 * fq;
#pragma unroll
        for (int ai = 0; ai < 2; ++ai)
#pragma unroll
            for (int m = 0; m < 4; ++m) { bf16_t* rowp = O + (size_t)(row0 + ai * HALF + m * 16) * ldc + col0;
                const f32x4 g0 = acc[ai][0][m][0], g1 = acc[ai][0][m][1], u0 = acc[ai][1][m][0], u1 = acc[ai][1][m][1];
                u32x4 w; w.x = cvt_pk_bf16(silu_mul(g0[0], u0[0]), silu_mul(g0[1], u0[1])); w.y = cvt_pk_bf16(silu_mul(g0[2], u0[2]), silu_mul(g0[3], u0[3]));
                w.z = cvt_pk_bf16(silu_mul(g1[0], u1[0]), silu_mul(g1[1], u1[1])); w.w = cvt_pk_bf16(silu_mul(g1[2], u1[2]), silu_mul(g1[3], u1[3]));
                *(u32x4*)rowp = w; }
    }
};
template <bool OUT16> struct EpiResid {
    static constexpr bool PERM = false, AFTER_DRAIN = false;
    const bf16_t* base; void* out; int ldc; const float* gv; int gstride; int rows_per_batch; float coef;
    __device__ __forceinline__ void operator()(const f32x4 (&acc)[2][2][4][2], const Unit& u, int wr, int wc, int fr, int fq) const {
        typedef unsigned v2u_ __attribute__((ext_vector_type(2)));
        asm volatile("" : "+v"(fr), "+v"(fq));
        const int row0 = u.pm * BM + wr * 64 + fr; const int col0 = u.pn * BM + wc * 32 + 4 * fq;
        const float* gvec = gv + (size_t)((u.pm * BM) / rows_per_batch) * gstride + col0;
        f32x4 gg[2][2];
#pragma unroll
        for (int bj = 0; bj < 2; ++bj)
#pragma unroll
            for (int n = 0; n < 2; ++n) gg[bj][n] = *(const f32x4*)(gvec + bj * HALF + n * 16) * coef;
#pragma unroll
        for (int ai = 0; ai < 2; ++ai) {
            v2u_ bwv[4][2][2];
#pragma unroll
            for (int m = 0; m < 4; ++m) { const size_t off = (size_t)(row0 + ai * HALF + m * 16) * ldc + col0;
#pragma unroll
                for (int bj = 0; bj < 2; ++bj)
#pragma unroll
                    for (int n = 0; n < 2; ++n) bwv[m][bj][n] = *(const v2u_*)(base + off + bj * HALF + n * 16); }
#pragma unroll
            for (int m = 0; m < 4; ++m) { const size_t off = (size_t)(row0 + ai * HALF + m * 16) * ldc + col0;
#pragma unroll
                for (int bj = 0; bj < 2; ++bj)
#pragma unroll
                    for (int n = 0; n < 2; ++n) { const v2u_ bw = bwv[m][bj][n];
                        f32x4 bs; bs[0] = __builtin_bit_cast(float, bw.x << 16); bs[1] = __builtin_bit_cast(float, bw.x & 0xffff0000u); bs[2] = __builtin_bit_cast(float, bw.y << 16); bs[3] = __builtin_bit_cast(float, bw.y & 0xffff0000u);
                        const f32x4 r = bs + gg[bj][n] * acc[ai][bj][m][n];
                        if constexpr (OUT16) { v2u_ w; w.x = cvt_pk_bf16_nv(r[0], r[1]); w.y = cvt_pk_bf16_nv(r[2], r[3]); *(v2u_*)((bf16_t*)out + off + bj * HALF + n * 16) = w; }
                        else *(f32x4*)((float*)out + off + bj * HALF + n * 16) = r; } }
        }
    }
};
__device__ __forceinline__ unsigned pack_fp8x4(float a, float b, float c, float d) {
    a = fminf(fmaxf(a, -448.f), 448.f); b = fminf(fmaxf(b, -448.f), 448.f); c = fminf(fmaxf(c, -448.f), 448.f); d = fminf(fmaxf(d, -448.f), 448.f);
    int w = 0; w = __builtin_amdgcn_cvt_pk_fp8_f32(a, b, w, false); w = __builtin_amdgcn_cvt_pk_fp8_f32(c, d, w, true); return (unsigned)w; }
struct EpiSwiGLU8 {
    static constexpr bool PERM = true, AFTER_DRAIN = false;
    unsigned char* O; int ldc;
    __device__ __forceinline__ void operator()(const f32x4 (&acc)[2][2][4][2], const Unit& u, int wr, int wc, int fr, int fq) const {
        asm volatile("" : "+v"(fr), "+v"(fq));
        const int row0 = u.pm * BM + wr * 64 + fr; const int col0 = u.pn * HALF + wc * 32 + 8 * fq;
#pragma unroll
        for (int ai = 0; ai < 2; ++ai)
#pragma unroll
            for (int m = 0; m < 4; ++m) { unsigned char* rowp = O + (size_t)(row0 + ai * HALF + m * 16) * ldc + col0;
                const f32x4 g0 = acc[ai][0][m][0], g1 = acc[ai][0][m][1], u0 = acc[ai][1][m][0], u1 = acc[ai][1][m][1];
                typedef unsigned u32x2v __attribute__((ext_vector_type(2))); u32x2v w;
                w.x = pack_fp8x4(silu_mul(g0[0], u0[0]), silu_mul(g0[1], u0[1]), silu_mul(g0[2], u0[2]), silu_mul(g0[3], u0[3]));
                w.y = pack_fp8x4(silu_mul(g1[0], u1[0]), silu_mul(g1[1], u1[1]), silu_mul(g1[2], u1[2]), silu_mul(g1[3], u1[3]));
                *(u32x2v*)rowp = w; }
    }
};
template <class Epi, class Sched, bool ALIGN_EPI = false, bool SP2 = false, bool FP8 = false>
__device__ __forceinline__ void gemm_phase(PG8_LAS unsigned char* lds, const Gemm g, const Sched& S, const Epi& E, int tid_in) {
    int tid_ = tid_in; asm volatile("" : "+v"(tid_));
    const int tid = tid_, wid = __builtin_amdgcn_readfirstlane(tid >> 6), lane = tid & 63, wr = wid >> 2, wc = wid & 3, fr = lane & 15, fq = lane >> 4;
    const int K = g.K, nt = FP8 ? K / (2 * BK) : K / BK;
    const int pitchA = g.blk ? 2 * BK : g.lda ? g.lda : (FP8 ? K : 2 * K), pitchB = g.blk ? 2 * BK : g.ldb ? g.ldb : (FP8 ? K : 2 * K);
    unsigned voffA[2], voffB[2];
#pragma unroll
    for (int i = 0; i < 2; ++i) { int R, C; stage_rc(tid * 16 + i * 8192, R, C); const int Rb = Epi::PERM ? ((R & ~31) + perm32(R & 31)) : R;
        voffA[i] = (unsigned)(R * pitchA + C * 2); voffB[i] = (unsigned)(Rb * pitchB + C * 2); }
    const size_t kstep = g.blk ? (size_t)(512 * BK) : (size_t)(BK * 2);
    const size_t hstepA = (size_t)HALF * pitchA, hstepB = (size_t)HALF * pitchB;
    const size_t tstepA = g.blk ? (size_t)(FP8 ? K / (2 * BK) : K / BK) * kstep : 2 * hstepA, tstepB = g.blk ? tstepA : 2 * hstepB;
    const unsigned ldsw = (unsigned)wid * 1024u;
    const int aoff = lds_byte(wr * 64 + fr, fq * 8), boff = lds_byte(wc * 32 + fr, fq * 8);
    PG8_LAS unsigned char* abase = lds + aoff; PG8_LAS unsigned char* bbase = lds + boff + 4 * HTB;
#define PG8_SA(b, h) (((b) * 2 + (h)) * HTB)
#define PG8_SB(b, h) ((4 + (b) * 2 + (h)) * HTB)
#define PG8_STAGE(bufoff, gbase, voff) do { _Pragma("unroll") for (int _i = 0; _i < 2; ++_i) \
        __builtin_amdgcn_global_load_lds((const unsigned*)((const char*)(gbase) + (voff)[_i]), (PG8_LAS unsigned*)(lds + (bufoff) + ldsw + _i * 8192), 16, 0, 0); } while (0)
#define PG8_RDA(off) (*(const PG8_LAS bf16x8*)(abase + (off)))
#define PG8_RDB(off) (*(const PG8_LAS bf16x8*)(bbase + ((off) - 4 * HTB)))
#define PG8_LDA(dst, b, h) do { if constexpr (FP8) { _Pragma("unroll") for (int m = 0; m < 4; ++m) dst##8[m] = pg8_cat(PG8_RDA(PG8_SA(b, h) + m * 2048), PG8_RDA(PG8_SA(b, h) + m * 2048 + 1024)); } \
    else { _Pragma("unroll") for (int m = 0; m < 4; ++m) _Pragma("unroll") for (int k = 0; k < 2; ++k) dst[m][k] = PG8_RDA(PG8_SA(b, h) + m * 2048 + k * 1024); } } while (0)
#define PG8_LDB(dst, b, h) do { if constexpr (FP8) { _Pragma("unroll") for (int n = 0; n < 2; ++n) dst##8[n] = pg8_cat(PG8_RDB(PG8_SB(b, h) + n * 2048), PG8_RDB(PG8_SB(b, h) + n * 2048 + 1024)); } \
    else { _Pragma("unroll") for (int n = 0; n < 2; ++n) _Pragma("unroll") for (int k = 0; k < 2; ++k) dst[n][k] = PG8_RDB(PG8_SB(b, h) + n * 2048 + k * 1024); } } while (0)
#define PG8_MMA(ai, bj, At, Bt) do { __builtin_amdgcn_s_setprio(1); if constexpr (FP8) { \
        _Pragma("unroll") for (int m = 0; m < 4; ++m) _Pragma("unroll") for (int n = 0; n < 2; ++n) \
            asm volatile("v_mfma_scale_f32_16x16x128_f8f6f4 %0, %1, %2, %0, %3, %4 op_sel_hi:[0,0,0]" : "+v"(acc[ai][bj][m][n]) : "v"(Bt##8[n]), "v"(At##8[m]), "v"(sclB), "v"(sclA)); \
        } else { _Pragma("unroll") for (int m = 0; m < 4; ++m) _Pragma("unroll") for (int n = 0; n < 2; ++n) _Pragma("unroll") for (int k = 0; k < 2; ++k) \
        acc[ai][bj][m][n] = __builtin_amdgcn_mfma_f32_16x16x32_bf16(Bt[n][k], At[m][k], acc[ai][bj][m][n], 0, 0, 0); } __builtin_amdgcn_s_setprio(0); } while (0)
#define PG8_WAIT_V(n) asm volatile("s_waitcnt vmcnt(" #n ")" ::: "memory")
#define PG8_WAIT_L(n) asm volatile("s_waitcnt lgkmcnt(" #n ")" ::: "memory")
#define PG8_BAR __builtin_amdgcn_s_barrier()
#define PG8_SCHED __builtin_amdgcn_sched_barrier(0)
    Unit cur, nxt; int ui = 0;
    if (!S.next(0, cur)) return;
    f32x4 acc[2][2][4][2];
#pragma unroll
    for (int a = 0; a < 2; ++a)
#pragma unroll
        for (int b = 0; b < 2; ++b)
#pragma unroll
            for (int m = 0; m < 4; ++m)
#pragma unroll
                for (int n = 0; n < 2; ++n) acc[a][b][m][n] = (f32x4){0.f, 0.f, 0.f, 0.f};
    const int sclA = g.scaleA, sclB = g.scaleB;
    bf16x8 At[4][2], B0[2][2], B1[2][2]; i32x8 At8[4], B08[2], B18[2];
    const char* cA = uptr((const char*)g.A + (size_t)cur.pm * tstepA); const char* cB = uptr((const char*)g.Bt + (size_t)cur.pn * tstepB);
    S.a_ready(cur);
    if constexpr (SP2) {
        PG8_STAGE(PG8_SB(0, 0), cB, voffB); PG8_STAGE(PG8_SB(0, 1), cB + hstepB, voffB); PG8_STAGE(PG8_SA(0, 0), cA, voffA); PG8_STAGE(PG8_SA(0, 1), cA + hstepA, voffA);
        if (wr == 1) PG8_BAR;
        PG8_WAIT_V(2); PG8_BAR;
        PG8_STAGE(PG8_SB(1, 0), cB + kstep, voffB); PG8_STAGE(PG8_SA(1, 0), cA + kstep, voffA); PG8_STAGE(PG8_SB(1, 1), cB + hstepB + kstep, voffB);
        PG8_WAIT_V(6); PG8_BAR;
    } else {
        PG8_STAGE(PG8_SB(0, 0), cB, voffB); PG8_STAGE(PG8_SA(0, 0), cA, voffA); PG8_STAGE(PG8_SB(0, 1), cB + hstepB, voffB); PG8_STAGE(PG8_SA(0, 1), cA + hstepA, voffA);
        if (wr == 1) PG8_BAR;
        PG8_WAIT_V(4); PG8_BAR;
        PG8_STAGE(PG8_SB(1, 0), cB + kstep, voffB); PG8_STAGE(PG8_SA(1, 0), cA + kstep, voffA); PG8_STAGE(PG8_SB(1, 1), cB + hstepB + kstep, voffB);
        PG8_WAIT_V(6); PG8_BAR;
    }
    for (;;) {
        const bool has_next = S.next(ui + 1, nxt);
        const char* nA = uptr(has_next ? (const char*)g.A + (size_t)nxt.pm * tstepA : cA); const char* nB = uptr(has_next ? (const char*)g.Bt + (size_t)nxt.pn * tstepB : cB);
        for (int t = 0; t < nt; t += 2) {
            asm volatile("" : "+v"(abase), "+v"(bbase));
            const bool last = (t == nt - 2);
            const char* a1 = cA + (size_t)(t + 1) * kstep;
            const char* a2 = uptr(last ? nA : cA + (size_t)(t + 2) * kstep); const char* b2 = uptr(last ? nB : cB + (size_t)(t + 2) * kstep);
            const char* a3 = a2 + kstep; const char* b3 = b2 + kstep;
            if (last && has_next) S.a_ready(nxt);
            if constexpr (SP2) {
            PG8_LDB(B0, 0, 0); PG8_LDB(B1, 0, 1); PG8_SCHED; PG8_LDA(At, 0, 0); PG8_STAGE(PG8_SA(1, 1), a1 + hstepA, voffA);
            PG8_WAIT_V(8); PG8_WAIT_L(0); PG8_BAR; PG8_MMA(0, 0, At, B0); PG8_MMA(0, 1, At, B1); PG8_BAR; PG8_SCHED;
            PG8_LDA(At, 0, 1); PG8_STAGE(PG8_SB(0, 0), b2, voffB); PG8_STAGE(PG8_SB(0, 1), b2 + hstepB, voffB); PG8_STAGE(PG8_SA(0, 0), a2, voffA);
            PG8_WAIT_V(8); PG8_WAIT_L(0); PG8_BAR; PG8_MMA(1, 0, At, B0); PG8_MMA(1, 1, At, B1); PG8_BAR; PG8_SCHED;
            PG8_LDB(B0, 1, 0); PG8_LDB(B1, 1, 1); PG8_SCHED; PG8_LDA(At, 1, 0); PG8_STAGE(PG8_SA(0, 1), a2 + hstepA, voffA);
            PG8_WAIT_V(8); PG8_WAIT_L(0); PG8_BAR; PG8_MMA(0, 0, At, B0); PG8_MMA(0, 1, At, B1); PG8_BAR; PG8_SCHED;
            PG8_LDA(At, 1, 1); PG8_STAGE(PG8_SB(1, 0), b3, voffB); PG8_STAGE(PG8_SB(1, 1), b3 + hstepB, voffB); PG8_STAGE(PG8_SA(1, 0), a3, voffA);
            PG8_WAIT_V(8); PG8_WAIT_L(0); PG8_BAR; PG8_MMA(1, 0, At, B0); PG8_MMA(1, 1, At, B1); PG8_BAR; PG8_SCHED;
            } else {
            PG8_LDB(B0, 0, 0); PG8_SCHED; PG8_LDA(At, 0, 0); PG8_STAGE(PG8_SA(1, 1), a1 + hstepA, voffA);
            PG8_WAIT_L(8); PG8_BAR; PG8_WAIT_L(0); PG8_MMA(0, 0, At, B0); PG8_BAR; PG8_SCHED;
            PG8_LDB(B1, 0, 1); PG8_STAGE(PG8_SB(0, 0), b2, voffB);
            PG8_BAR; PG8_WAIT_L(0); PG8_MMA(0, 1, At, B1); PG8_BAR;
            PG8_LDA(At, 0, 1); PG8_STAGE(PG8_SA(0, 0), a2, voffA);
            PG8_BAR; PG8_WAIT_L(0); PG8_MMA(1, 0, At, B0); PG8_BAR; PG8_SCHED;
            PG8_STAGE(PG8_SB(0, 1), b2 + hstepB, voffB);
            PG8_WAIT_V(6); PG8_BAR; PG8_MMA(1, 1, At, B1); PG8_BAR;
            PG8_LDB(B0, 1, 0); PG8_SCHED; PG8_LDA(At, 1, 0); PG8_STAGE(PG8_SA(0, 1), a2 + hstepA, voffA);
            PG8_WAIT_L(8); PG8_BAR; PG8_WAIT_L(0); PG8_MMA(0, 0, At, B0); PG8_BAR; PG8_SCHED;
            PG8_LDB(B1, 1, 1); PG8_STAGE(PG8_SB(1, 0), b3, voffB);
            PG8_BAR; PG8_WAIT_L(0); PG8_MMA(0, 1, At, B1); PG8_BAR;
            PG8_LDA(At, 1, 1); PG8_STAGE(PG8_SA(1, 0), a3, voffA);
            PG8_BAR; PG8_WAIT_L(0); PG8_MMA(1, 0, At, B0); PG8_BAR; PG8_SCHED;
            PG8_STAGE(PG8_SB(1, 1), b3 + hstepB, voffB);
            PG8_WAIT_V(6); PG8_BAR; PG8_MMA(1, 1, At, B1); PG8_BAR;
            }
        }
        if constexpr (FP8) asm volatile("s_nop 15\n\ts_nop 7" ::: "memory");
        if constexpr (ALIGN_EPI) { if (wr == 0) PG8_BAR; }
        if constexpr (!Epi::AFTER_DRAIN) { E(acc, cur, wr, wc, fr, fq); S.done(cur); }
        if (!has_next) break;
#pragma unroll
        for (int a = 0; a < 2; ++a)
#pragma unroll
            for (int b = 0; b < 2; ++b)
#pragma unroll
                for (int m = 0; m < 4; ++m)
#pragma unroll
                    for (int n = 0; n < 2; ++n) acc[a][b][m][n] = (f32x4){0.f, 0.f, 0.f, 0.f};
        cur = nxt; cA = nA; cB = nB; ++ui;
        if constexpr (ALIGN_EPI) { if (wr == 1) PG8_BAR; }
    }
    PG8_WAIT_V(0);
    if constexpr (!ALIGN_EPI) { if (wr == 0) PG8_BAR; }
    PG8_BAR;
    if constexpr (Epi::AFTER_DRAIN) { E.fused(acc, cur, wr, wc, fr, fq, lds, wid, lane); S.done(cur); }
#undef PG8_SA
#undef PG8_SB
#undef PG8_STAGE
#undef PG8_RDA
#undef PG8_RDB
#undef PG8_LDA
#undef PG8_LDB
#undef PG8_MMA
#undef PG8_WAIT_V
#undef PG8_WAIT_L
#undef PG8_BAR
#undef PG8_SCHED
}
}

#ifndef MK_FFN_FP8
#define MK_FFN_FP8 1
#endif
constexpr bool FFN_FP8 = MK_FFN_FP8;
constexpr int NWAVES = 8, NTHREADS = NWAVES * 64;
constexpr int BATCH = 2, SEQ = 8192, M = BATCH * SEQ, DM = 2048, DEPTH = 4, DFF = 5632, NGU = 2 * DFF, INC = 5976, NIN = 6144, NMOD = 9 * DM;
constexpr int DFFP = DFF + 128;
constexpr int NH = 8, HD = 64, GWID = 512, TOPK = 256, WINDOW = 128;
constexpr int PA_Q = 0, PA_K = 512, PA_V = 576, PA_IQ = 640, PA_IK = 1664, PB_Q = 1728, PB_K = 2240, PB_V = 2304, PC_Q = 2368, PC_K = 2880, PC_V = 3392, PC_G = 3904,
              PD_Q = 4416, PD_K = 4928, PD_V = 5440, PA_IW = 5952, PC_F = 5968;
constexpr float RMS_EPS = 1e-6f, LOG2E = 1.4426950408889634f, QSCALE = 0.125f * LOG2E;

constexpr size_t MiB = 1u << 20;
constexpr size_t WS_CTL = 0, CTL_ZERO_BYTES = 1 * MiB;
constexpr size_t WS_MOD = 1 * MiB;
constexpr size_t WS_LF = 2 * MiB;
constexpr size_t WS_KB2 = 3 * MiB;
constexpr size_t WS_WGU = 4 * MiB;
constexpr size_t SZ_WGU = (size_t)NGU * DM * 2;
constexpr size_t WS_WD = WS_WGU + 8 * SZ_WGU;
constexpr size_t SZ_WD = (size_t)DM * DFF * 2;
constexpr size_t WS_WIN = WS_WD + 8 * SZ_WD;
constexpr size_t SZ_WIN = (size_t)NIN * DM * 2;
constexpr size_t WS_WOUT = WS_WIN + 4 * SZ_WIN;
constexpr size_t SZ_WOUT = (size_t)DM * DM * 2;
constexpr size_t WS_H = WS_WOUT + 4 * SZ_WOUT;
constexpr size_t WS_P = WS_H + (size_t)M * DM * 2;
constexpr size_t WS_Y = WS_P + (size_t)M * NIN * 2;
constexpr size_t WS_IDX = WS_Y + (size_t)M * DM * 2;
constexpr size_t WS_SC = WS_IDX + (size_t)M * TOPK * 4;
constexpr size_t WS_XB = WS_SC + (size_t)BATCH * SEQ * SEQ * 2;
constexpr size_t WS_END = WS_XB + (size_t)M * DM * 2;
static_assert(WS_WGU % MiB == 0 && WS_WD % MiB == 0 && WS_WIN % MiB == 0 && WS_WOUT % MiB == 0 && WS_H % MiB == 0 && WS_P % MiB == 0 && WS_Y % MiB == 0 && WS_IDX % MiB == 0 && WS_SC % MiB == 0, "d_ws map alignment");
constexpr int CW_BAR = 4096;

constexpr int RING_OFF = 0, RING_BYTES = 131072;
constexpr int AUX_OFF = RING_BYTES, AUX_BYTES = 16384;
constexpr int LDSCTL_OFF = AUX_OFF + AUX_BYTES;
constexpr int LDS_BYTES = LDSCTL_OFF + 256;

#define GAS __attribute__((address_space(1)))
#define LAS __attribute__((address_space(3)))
typedef unsigned short bf16;
typedef unsigned v4u __attribute__((ext_vector_type(4)));
typedef unsigned v2u __attribute__((ext_vector_type(2)));
typedef int v4i __attribute__((ext_vector_type(4)));
typedef float f32x4 __attribute__((ext_vector_type(4)));
typedef float f32x16 __attribute__((ext_vector_type(16)));
typedef short bf16x8 __attribute__((ext_vector_type(8)));
typedef short s16x4 __attribute__((ext_vector_type(4)));
typedef GAS unsigned gu32;
#define RLX_AGENT __ATOMIC_RELAXED, __HIP_MEMORY_SCOPE_AGENT
#define LDS_WAIT() asm volatile("s_waitcnt lgkmcnt(0)" ::: "memory")
#define VM_WAIT() asm volatile("s_waitcnt vmcnt(0)" ::: "memory")
__device__ __forceinline__ unsigned f2bf(float f) { unsigned u = __builtin_bit_cast(unsigned, f); return (u + 0x7fffu + ((u >> 16) & 1u)) >> 16; }
__device__ __forceinline__ unsigned pk2(float lo, float hi) { return f2bf(lo) | (f2bf(hi) << 16); }
__device__ __forceinline__ float bf_lo(unsigned w) { return __builtin_bit_cast(float, w << 16); }
__device__ __forceinline__ float bf_hi(unsigned w) { return __builtin_bit_cast(float, w & 0xffff0000u); }
__device__ __forceinline__ float bf2f(bf16 h) { return __builtin_bit_cast(float, (unsigned)h << 16); }
__device__ __forceinline__ float wave_sum(float v) {
#pragma unroll
    for (int o = 1; o < 64; o <<= 1) v += __shfl_xor(v, o);
    return v;
}
__device__ __forceinline__ float fexp2(float x) { return __builtin_amdgcn_exp2f(x); }
__device__ __forceinline__ float frcp(float x) { return __builtin_amdgcn_rcpf(x); }
__device__ const unsigned char kBucketLut[128] = {0, 1, 2, 3, 4, 5, 6, 7, 8, 9, 10, 11, 12, 13, 14, 15, 16, 16, 16, 17, 17, 18, 18, 18, 19, 19, 19, 20, 20, 20, 20, 21, 21, 21, 21, 22, 22, 22, 22, 22,
    23, 23, 23, 23, 23, 23, 24, 24, 24, 24, 24, 24, 25, 25, 25, 25, 25, 25, 25, 26, 26, 26, 26, 26, 26, 26, 26, 27, 27, 27, 27, 27, 27, 27, 27, 27, 27, 28, 28, 28, 28, 28, 28, 28, 28, 28, 28,
    29, 29, 29, 29, 29, 29, 29, 29, 29, 29, 29, 29, 30, 30, 30, 30, 30, 30, 30, 30, 30, 30, 30, 30, 30, 30, 31, 31, 31, 31, 31, 31, 31, 31, 31, 31, 31, 31, 31, 31, 31};

#define XB_TMO      128
#define XB_XCNT(j)  (256  + 64 * (j))
#define XB_XSUB(j)  (1280 + 64 * (j))
#define XB_XGEN(j)  (2304 + 64 * (j))
#define XB_TOP      3328
#define XB_TOPGEN   3392
#define XCD_BAR_WORDS 3456
#define XB_SPIN_CAP (1u << 18)

__device__ __forceinline__ unsigned xb_ld(unsigned* p)              { return __hip_atomic_load((GAS unsigned*)p, __ATOMIC_RELAXED, __HIP_MEMORY_SCOPE_AGENT); }
__device__ __forceinline__ unsigned xb_add(unsigned* p, unsigned v) { return __hip_atomic_fetch_add((GAS unsigned*)p, v, __ATOMIC_RELAXED, __HIP_MEMORY_SCOPE_AGENT); }
__device__ __forceinline__ unsigned xb_xcc_id() { return (unsigned)__builtin_amdgcn_s_getreg((3 << 11) | 20) & 0xFu; }
#define XB_SPIN(cond, bar) do { unsigned _sp = 0; while (cond) { __builtin_amdgcn_s_sleep(1); \
    if ((++_sp & 255u) == 0u) { if (xb_ld(&(bar)[XB_TMO])) break; if (_sp > XB_SPIN_CAP) { xb_add(&(bar)[XB_TMO], 1u); break; } } } } while (0)

struct XcdBarrier {
    unsigned* bar; unsigned x;
    volatile LAS unsigned* st;
};

__device__ __forceinline__ XcdBarrier xcd_barrier_post(unsigned* bar, volatile LAS unsigned* st) {
    XcdBarrier b; b.bar = bar; b.x = xb_xcc_id(); b.st = st;
    if (threadIdx.x == 0) (void)xb_add(&bar[XB_XCNT(b.x)], 1u);
    return b;
}
__device__ __forceinline__ void xcd_barrier_complete(unsigned* bar, unsigned x, unsigned& nloc, unsigned& nx) {
    const unsigned G = gridDim.x * gridDim.y * gridDim.z;
    unsigned sum, cnt, mine, sp = 0u;
    for (;;) {
        sum = 0u; cnt = 0u; mine = 0u;
#pragma unroll
        for (unsigned j = 0; j < 16; ++j) { const unsigned c = xb_ld(&bar[XB_XCNT(j)]); sum += c; cnt += (c > 0u) ? 1u : 0u; mine = (j == x) ? c : mine; }
        if (sum == G) break;
        __builtin_amdgcn_s_sleep(1);
        if ((++sp & 255u) == 0u) { if (xb_ld(&bar[XB_TMO])) break; if (sp > XB_SPIN_CAP) { xb_add(&bar[XB_TMO], 1u); break; } }
    }
    nloc = mine > 0u ? mine : 1u; nx = cnt > 0u ? cnt : 1u;
}

__device__ __forceinline__ void xcd_barrier(const XcdBarrier& b) {
    asm volatile("s_waitcnt vmcnt(0)" ::: "memory");
    __syncthreads();
    if (threadIdx.x == 0) {
        unsigned* bar = b.bar; asm volatile("" : "+s"(bar));
        __builtin_amdgcn_s_waitcnt(0);
        unsigned nloc = b.st[0], nx = b.st[1];
        if (nloc == 0u) { xcd_barrier_complete(bar, b.x, nloc, nx); b.st[0] = nloc; b.st[1] = nx; }
        const unsigned old = xb_add(&bar[XB_XSUB(b.x)], 1u);
        const unsigned gen = old / nloc;
        if (old + 1u == (gen + 1u) * nloc) {
            __builtin_amdgcn_fence(__ATOMIC_RELEASE, "agent");
            asm volatile("s_waitcnt vmcnt(0)" ::: "memory");
            const unsigned og = xb_add(&bar[XB_TOP], 1u);
            const unsigned tg = og / nx;
            if (og + 1u == (tg + 1u) * nx) xb_add(&bar[XB_TOPGEN], 1u);
            else XB_SPIN(xb_ld(&bar[XB_TOPGEN]) == tg, bar);
            __builtin_amdgcn_fence(__ATOMIC_ACQUIRE, "agent");
            xb_add(&bar[XB_XGEN(b.x)], 1u);
            asm volatile("s_waitcnt vmcnt(0)" ::: "memory");
        } else {
            XB_SPIN(xb_ld(&bar[XB_XGEN(b.x)]) == gen, bar);
            __builtin_amdgcn_fence(__ATOMIC_ACQUIRE, "agent");
            asm volatile("s_waitcnt vmcnt(0)" ::: "memory");
        }
    }
    __syncthreads();
}

struct Frame {
    LAS unsigned char* lds;
    gu32* ctl;
    int tid, lane, wave, G, gw, NGW;
    const float *x, *c, *w_ada, *b_ada, *norm_g, *w_in, *qk_g, *forget_b, *sinks, *rel_table, *group_g, *w_out, *w_gate, *w_up, *w_down;
    float* out;
    float *MOD, *LF, *KB2; unsigned short* SC; int* IDX;
    bf16 *WGU, *WD, *WIN, *WOUT, *H, *P, *Y, *XB;
};

template <int MAP> __device__ __forceinline__ int w_rowmap(int n) {
    if (MAP == 1) return 256 * (n >> 7) + (n & 127);
    if (MAP == 2) return 256 * (n >> 7) + 128 + (n & 127);
    if (MAP == 3) { if (n < 1728) return n; if (n < 1744) return PA_IW + (n - 1728); if (n < 3920) return n - 16; if (n < 3928) return PC_F + (n - 3920); return n - 24; }
    return n;
}
template <int MAP> __device__ __forceinline__ void p0_transpose_item(const float* W, int K, int N, bf16* WT, LAS unsigned* T, int item, int lane) {
    const int nblk = (N + 63) / 64, kb = item / nblk, nb = item % nblk, k0 = 64 * kb, n0 = 64 * nb;
    const int r = lane >> 4, c = lane & 15;
    const bool nok = (n0 + 4 * c) < N;
    const float* src = W + (size_t)(k0 + 2 * r) * N + n0 + 4 * c;
    f32x4 a[8], b[8];
#pragma unroll
    for (int i = 0; i < 8; ++i) { a[i] = nok ? *(const GAS f32x4*)(src + (size_t)(8 * i) * N) : (f32x4){0.f, 0.f, 0.f, 0.f}; b[i] = nok ? *(const GAS f32x4*)(src + (size_t)(8 * i + 1) * N) : (f32x4){0.f, 0.f, 0.f, 0.f}; }
#pragma unroll
    for (int i = 0; i < 8; ++i)
#pragma unroll
        for (int e = 0; e < 4; ++e) T[(4 * c + e) * 36 + 4 * i + r] = pk2(a[i][e], b[i][e]);
    LDS_WAIT(); asm volatile("" ::: "memory");
    const int rr = lane >> 3, ch = lane & 7;
#pragma unroll
    for (int j = 0; j < 8; ++j) { const int n = 8 * j + rr; const v4u o = *(const LAS v4u*)(T + n * 36 + 4 * ch);
        if (n0 + n < N) *(GAS v4u*)(WT + (size_t)w_rowmap<MAP>(n0 + n) * K + k0 + 8 * ch) = o; }
    LDS_WAIT(); asm volatile("" ::: "memory");
}
constexpr float W8_SCALE = 64.0f; constexpr int W8_E8M0 = 127 - 6;
__device__ __forceinline__ unsigned pk_fp8x4(float a, float b, float c, float d) {
    a = fminf(fmaxf(a, -448.f), 448.f); b = fminf(fmaxf(b, -448.f), 448.f); c = fminf(fmaxf(c, -448.f), 448.f); d = fminf(fmaxf(d, -448.f), 448.f);
    int w = 0; w = __builtin_amdgcn_cvt_pk_fp8_f32(a, b, w, false); w = __builtin_amdgcn_cvt_pk_fp8_f32(c, d, w, true); return (unsigned)w; }
template <int MAP> __device__ __forceinline__ void p0_transpose8_item(const float* W, int K, int N, unsigned char* WT, int ldw, LAS unsigned* T, int item, int lane) {
    const int nblk = (N + 63) / 64, kb = item / nblk, nb = item % nblk, k0 = 64 * kb, n0 = 64 * nb;
    const int r = lane >> 4, c = lane & 15;
    const bool nok = (n0 + 4 * c) < N;
    const float* src = W + (size_t)(k0 + 4 * r) * N + n0 + 4 * c;
    f32x4 q[4][4];
#pragma unroll
    for (int i = 0; i < 4; ++i)
#pragma unroll
        for (int d = 0; d < 4; ++d) q[i][d] = nok ? *(const GAS f32x4*)(src + (size_t)(16 * i + d) * N) : (f32x4){0.f, 0.f, 0.f, 0.f};
#pragma unroll
    for (int i = 0; i < 4; ++i)
#pragma unroll
        for (int e = 0; e < 4; ++e) T[(4 * c + e) * 20 + 4 * i + r] = pk_fp8x4(q[i][0][e] * W8_SCALE, q[i][1][e] * W8_SCALE, q[i][2][e] * W8_SCALE, q[i][3][e] * W8_SCALE);
    LDS_WAIT(); asm volatile("" ::: "memory");
    const int rr = lane >> 2, ch = lane & 3;
#pragma unroll
    for (int j = 0; j < 4; ++j) { const int n = 16 * j + rr; const v4u o = *(const LAS v4u*)(T + n * 20 + 4 * ch);
        if (n0 + n < N) *(GAS v4u*)(WT + (size_t)w_rowmap<MAP>(n0 + n) * ldw + k0 + 16 * ch) = o; }
    LDS_WAIT(); asm volatile("" ::: "memory");
}
template <int MAP> __device__ __forceinline__ void p0_transpose8(const Frame& F, const float* W, int K, int N, unsigned char* WT, int ldw, LAS unsigned* scr) {
    const int nitems = (K / 64) * ((N + 63) / 64);
    for (int it = F.gw; it < nitems; it += F.NGW) p0_transpose8_item<MAP>(W, K, N, WT, ldw, scr, it, F.lane);
}
template <int MAP> __device__ __forceinline__ void p0_transpose(const Frame& F, const float* W, int K, int N, bf16* WT, LAS unsigned* scr) {
    const int nitems = (K / 64) * ((N + 63) / 64);
    for (int it = F.gw; it < nitems; it += F.NGW) p0_transpose_item<MAP>(W, K, N, WT, scr, it, F.lane);
}
__device__ __forceinline__ void p0_prologue(const Frame& F) {
    LAS unsigned* scr = (LAS unsigned*)(F.lds + RING_OFF + F.wave * 16384);
    LAS float* cond = (LAS float*)(F.lds + AUX_OFF);
    LAS float* red = (LAS float*)(F.lds + RING_OFF);
    for (int i = F.tid; i < BATCH * DM; i += NTHREADS) { const float v = F.c[i]; cond[i] = v / (1.0f + __expf(-v)); }
    __syncthreads();
    for (int it = blockIdx.x; it < DEPTH * (NMOD / 64); it += F.G) {
        const int l = it / (NMOD / 64), n = (it % (NMOD / 64)) * 64 + F.lane;
        const float* w = F.w_ada + (size_t)l * DM * NMOD + (size_t)(256 * F.wave) * NMOD + n;
        const LAS float* c0 = cond + 256 * F.wave; const LAS float* c1 = cond + DM + 256 * F.wave;
        float a0 = 0.f, a1 = 0.f;
#pragma unroll 32
        for (int k = 0; k < 256; ++k) { const float wv = w[(size_t)k * NMOD]; a0 += c0[k] * wv; a1 += c1[k] * wv; }
        red[F.wave * 128 + F.lane] = a0; red[F.wave * 128 + 64 + F.lane] = a1;
        __syncthreads();
        if (F.tid < 128) { float sacc = 0.f;
#pragma unroll
            for (int wv = 0; wv < 8; ++wv) sacc += red[wv * 128 + F.tid];
            const int bsel = F.tid >> 6, nn = (it % (NMOD / 64)) * 64 + (F.tid & 63);
            F.MOD[((size_t)l * BATCH + bsel) * NMOD + nn] = sacc + F.b_ada[(size_t)l * NMOD + nn]; }
        __syncthreads();
    }
    for (int lf = 0; lf < DEPTH * 2; ++lf) {
        if (FFN_FP8) {
            p0_transpose8<1>(F, F.w_gate + (size_t)lf * DM * DFF, DM, DFF, (unsigned char*)F.WGU + (size_t)lf * NGU * DM, DM, scr);
            p0_transpose8<2>(F, F.w_up + (size_t)lf * DM * DFF, DM, DFF, (unsigned char*)F.WGU + (size_t)lf * NGU * DM, DM, scr);
            p0_transpose8<0>(F, F.w_down + (size_t)lf * DFF * DM, DFF, DM, (unsigned char*)F.WD + (size_t)lf * DM * DFFP, DFFP, scr);
        } else {
            p0_transpose<1>(F, F.w_gate + (size_t)lf * DM * DFF, DM, DFF, F.WGU + (size_t)lf * NGU * DM, scr);
            p0_transpose<2>(F, F.w_up + (size_t)lf * DM * DFF, DM, DFF, F.WGU + (size_t)lf * NGU * DM, scr);
            p0_transpose<0>(F, F.w_down + (size_t)lf * DFF * DM, DFF, DM, F.WD + (size_t)lf * DM * DFF, scr);
        }
    }
    for (int l = 0; l < DEPTH; ++l) {
        p0_transpose<3>(F, F.w_in + (size_t)l * DM * INC, DM, INC, F.WIN + (size_t)l * NIN * DM, scr);
        p0_transpose<0>(F, F.w_out + (size_t)l * DM * DM, DM, DM, F.WOUT + (size_t)l * DM * DM, scr);
        GAS v4u* z = (GAS v4u*)(F.WIN + (size_t)l * NIN * DM + (size_t)INC * DM);
        for (int i = F.gw * 64 + F.lane; i < (NIN - INC) * DM / 8; i += F.NGW * 64) z[i] = (v4u){0u, 0u, 0u, 0u};
    }
}

template <bool OUT8, bool IN16> __device__ __forceinline__ void ph_modulate(const Frame& F, const void* xin, const float* g, const float* shift, const float* scale) {
    for (int m = F.gw; m < M; m += F.NGW) {
        const int b = m / SEQ;
        float x[4][8]; float s = 0.f;
        if constexpr (IN16) {
            const GAS v4u* xr = (const GAS v4u*)((const bf16*)xin + (size_t)m * DM) + F.lane;
            v4u w[4];
#pragma unroll
            for (int j = 0; j < 4; ++j) w[j] = xr[64 * j];
#pragma unroll
            for (int j = 0; j < 4; ++j) { x[j][0] = bf_lo(w[j].x); x[j][1] = bf_hi(w[j].x); x[j][2] = bf_lo(w[j].y); x[j][3] = bf_hi(w[j].y); x[j][4] = bf_lo(w[j].z); x[j][5] = bf_hi(w[j].z); x[j][6] = bf_lo(w[j].w); x[j][7] = bf_hi(w[j].w); }
        } else {
            const GAS f32x4* xr = (const GAS f32x4*)((const float*)xin + (size_t)m * DM) + 2 * F.lane;
            f32x4 a[4][2];
#pragma unroll
            for (int j = 0; j < 4; ++j) { a[j][0] = xr[128 * j]; a[j][1] = xr[128 * j + 1]; }
            GAS v4u* xo = (GAS v4u*)(F.XB + (size_t)m * DM) + F.lane;
#pragma unroll
            for (int j = 0; j < 4; ++j) { x[j][0] = a[j][0].x; x[j][1] = a[j][0].y; x[j][2] = a[j][0].z; x[j][3] = a[j][0].w; x[j][4] = a[j][1].x; x[j][5] = a[j][1].y; x[j][6] = a[j][1].z; x[j][7] = a[j][1].w;
                v4u w; w.x = pk2(x[j][0], x[j][1]); w.y = pk2(x[j][2], x[j][3]); w.z = pk2(x[j][4], x[j][5]); w.w = pk2(x[j][6], x[j][7]); xo[64 * j] = w; }
        }
#pragma unroll
        for (int j = 0; j < 4; ++j) s += ((x[j][0] * x[j][0] + x[j][1] * x[j][1]) + (x[j][2] * x[j][2] + x[j][3] * x[j][3])) + ((x[j][4] * x[j][4] + x[j][5] * x[j][5]) + (x[j][6] * x[j][6] + x[j][7] * x[j][7]));
        const float rstd = 1.0f / sqrtf(wave_sum(s) * (1.f / DM) + RMS_EPS);
        const GAS f32x4* gp = (const GAS f32x4*)g + 2 * F.lane; const GAS f32x4* sh = (const GAS f32x4*)(shift + (size_t)b * NMOD) + 2 * F.lane; const GAS f32x4* sc = (const GAS f32x4*)(scale + (size_t)b * NMOD) + 2 * F.lane;
        GAS v4u* o16 = (GAS v4u*)(F.H + (size_t)m * DM) + F.lane;
        GAS v2u* o8 = (GAS v2u*)((unsigned char*)F.H + (size_t)m * DM) + F.lane;
#pragma unroll
        for (int j = 0; j < 4; ++j) { float y[8];
#pragma unroll
            for (int h = 0; h < 2; ++h) { const f32x4 gg = gp[128 * j + h], ss = sc[128 * j + h], hh = sh[128 * j + h];
                y[4 * h + 0] = x[j][4 * h + 0] * rstd * gg.x * (ss.x + 1.0f) + hh.x; y[4 * h + 1] = x[j][4 * h + 1] * rstd * gg.y * (ss.y + 1.0f) + hh.y;
                y[4 * h + 2] = x[j][4 * h + 2] * rstd * gg.z * (ss.z + 1.0f) + hh.z; y[4 * h + 3] = x[j][4 * h + 3] * rstd * gg.w * (ss.w + 1.0f) + hh.w; }
            if (OUT8) { v2u w; w.x = pk_fp8x4(y[0], y[1], y[2], y[3]); w.y = pk_fp8x4(y[4], y[5], y[6], y[7]); o8[64 * j] = w; }
            else { v4u w; w.x = pk2(y[0], y[1]); w.y = pk2(y[2], y[3]); w.z = pk2(y[4], y[5]); w.w = pk2(y[6], y[7]); o16[64 * j] = w; } }
    }
}
__device__ __forceinline__ v4u headnorm8(v4u w, const float* g, float mul, int lane, bool normalize) {
    float x[8] = {bf_lo(w.x), bf_hi(w.x), bf_lo(w.y), bf_hi(w.y), bf_lo(w.z), bf_hi(w.z), bf_lo(w.w), bf_hi(w.w)};
    float r = mul;
    if (normalize) {
        float s = 0.f;
#pragma unroll
        for (int i = 0; i < 8; ++i) s += x[i] * x[i];
        s += __shfl_xor(s, 1); s += __shfl_xor(s, 2); s += __shfl_xor(s, 4);
        r = mul / sqrtf(s * (1.f / 64.f) + RMS_EPS);
        const f32x4 g0 = *(const GAS f32x4*)(g + 8 * (lane & 7)), g1 = *(const GAS f32x4*)(g + 8 * (lane & 7) + 4);
        x[0] *= g0.x; x[1] *= g0.y; x[2] *= g0.z; x[3] *= g0.w; x[4] *= g1.x; x[5] *= g1.y; x[6] *= g1.z; x[7] *= g1.w;
    }
    w.x = pk2(x[0] * r, x[1] * r); w.y = pk2(x[2] * r, x[3] * r); w.z = pk2(x[4] * r, x[5] * r); w.w = pk2(x[6] * r, x[7] * r);
    return w;
}
__device__ __forceinline__ void ph_post(const Frame& F, int l) {
    const float* qg = F.qk_g + (size_t)l * 6 * HD;
    for (int m = F.gw; m < M; m += F.NGW) {
        bf16* row = F.P + (size_t)m * NIN; const int lane = F.lane;
        GAS v4u* paq = (GAS v4u*)(row + PA_Q + 8 * lane); GAS v4u* pbq = (GAS v4u*)(row + PB_Q + 8 * lane); GAS v4u* pcq = (GAS v4u*)(row + PC_Q + 8 * lane);
        GAS v4u* pck = (GAS v4u*)(row + PC_K + 8 * lane); GAS v4u* pdq = (GAS v4u*)(row + PD_Q + 8 * lane);
        GAS v4u* pkk = (GAS v4u*)(row + (lane < 8 ? PA_K : PB_K) + 8 * (lane & 7));
        const v4u waq = *paq, wbq = *pbq, wcq = *pcq, wck = *pck, wdq = *pdq;
        v4u wkk = {0u, 0u, 0u, 0u}; if (lane < 16) wkk = *pkk;
        *paq = headnorm8(waq, qg + 0 * HD, QSCALE, lane, true);
        *pbq = headnorm8(wbq, qg + 2 * HD, QSCALE, lane, true);
        *pcq = headnorm8(wcq, qg + 4 * HD, QSCALE, lane, true);
        *pck = headnorm8(wck, qg + 5 * HD, 1.0f, lane, true);
        *pdq = headnorm8(wdq, qg, QSCALE, lane, false);
        if (lane < 16) *pkk = headnorm8(wkk, qg + (lane < 8 ? 1 : 3) * HD, 1.0f, lane, true);
    }
}
__device__ __forceinline__ void ph_scan(const Frame& F, int l) {
    LAS float* wtot = (LAS float*)(F.lds + RING_OFF);
    for (int sq = blockIdx.x; sq < BATCH * NH; sq += F.G) {
        const int b = sq / NH, h = sq % NH; const float fb = F.forget_b[(size_t)l * NH + h];
        const GAS unsigned short* src = (const GAS unsigned short*)(F.P + ((size_t)b * SEQ + 16 * F.tid) * NIN + PC_F + h); float* dst = F.KB2 + (size_t)sq * SEQ + 16 * F.tid;
        float v[16]; unsigned short raw[16];
#pragma unroll
        for (int i = 0; i < 16; ++i) raw[i] = src[(size_t)i * NIN];
#pragma unroll
        for (int i = 0; i < 16; ++i) { const float y = __builtin_bit_cast(float, (unsigned)raw[i] << 16) + fb; v[i] = (y >= 0.f) ? -log1pf(__expf(-y)) : (y - log1pf(__expf(y))); }
#pragma unroll
        for (int i = 1; i < 16; ++i) v[i] += v[i - 1];
        float incl = v[15];
#pragma unroll
        for (int o = 1; o < 64; o <<= 1) { const float t = __shfl_up(incl, o); if (F.lane >= o) incl += t; }
        if (F.lane == 63) wtot[F.wave] = incl;
        __syncthreads();
        float base = incl - v[15];
        for (int w = 0; w < F.wave; ++w) base += wtot[w];
#pragma unroll
        for (int i = 0; i < 4; ++i) *(GAS f32x4*)(dst + 4 * i) = (f32x4){-(v[4 * i] + base) * LOG2E, -(v[4 * i + 1] + base) * LOG2E, -(v[4 * i + 2] + base) * LOG2E, -(v[4 * i + 3] + base) * LOG2E};
        __syncthreads();
    }
}
__device__ __forceinline__ void ph_gnorm(const Frame& F, int l) {
    const float* gg = F.group_g + (size_t)l * DM;
    for (int m = F.gw; m < M; m += F.NGW) {
        v4u w[4];
#pragma unroll
        for (int g = 0; g < 4; ++g) w[g] = *(GAS v4u*)(F.Y + (size_t)m * DM + g * GWID + 8 * F.lane);
#pragma unroll
        for (int g = 0; g < 4; ++g) {
            bf16* p = F.Y + (size_t)m * DM + g * GWID + 8 * F.lane;
            float x[8] = {bf_lo(w[g].x), bf_hi(w[g].x), bf_lo(w[g].y), bf_hi(w[g].y), bf_lo(w[g].z), bf_hi(w[g].z), bf_lo(w[g].w), bf_hi(w[g].w)};
            float s = 0.f;
#pragma unroll
            for (int i = 0; i < 8; ++i) s += x[i] * x[i];
            const float r = 1.0f / sqrtf(wave_sum(s) * (1.f / GWID) + RMS_EPS);
            const f32x4 g0 = *(const GAS f32x4*)(gg + g * GWID + 8 * F.lane), g1 = *(const GAS f32x4*)(gg + g * GWID + 8 * F.lane + 4);
            v4u o; o.x = pk2(x[0] * r * g0.x, x[1] * r * g0.y); o.y = pk2(x[2] * r * g0.z, x[3] * r * g0.w); o.z = pk2(x[4] * r * g1.x, x[5] * r * g1.y); o.w = pk2(x[6] * r * g1.z, x[7] * r * g1.w);
            *(GAS v4u*)p = o;
        }
    }
}


__device__ __forceinline__ unsigned short score_key(float sc) {
    const _Float16 hf = (_Float16)fminf(fmaxf(sc, -60000.f), 60000.f);
    const unsigned h = (unsigned)__builtin_bit_cast(unsigned short, hf);
    return (unsigned short)((h & 0x8000u) ? (~h & 0xffffu) : (h | 0x8000u));
}
__device__ __forceinline__ void glds16x(const void* gsrc, unsigned lds_dst) { unsigned keep;
    asm volatile("s_mov_b32 %0, m0\n\ts_mov_b32 m0, %2\n\ts_nop 0\n\tglobal_load_lds_dwordx4 %1, off\n\ts_mov_b32 m0, %0" : "=&s"(keep) : "v"(gsrc), "s"(lds_dst) : "memory"); }
__device__ __forceinline__ void ph_idx_scores(const Frame& F) {
    constexpr int UPB = 8 * (16 * 17 / 2), NU = BATCH * UPB;
    const int lane = F.lane, r32 = lane & 31, hi = lane >> 5;
    const int u_lo = (int)(((long)blockIdx.x * NU) / F.G), u_hi = (int)(((long)(blockIdx.x + 1) * NU) / F.G);
    if (u_lo >= u_hi) return;
    int b = u_lo / UPB, qb = 127, kc = 0; { int r = u_lo % UPB; for (;;) { const int n = (qb >> 3) + 1; if (r < n) { kc = r; break; } r -= n; --qb; } }
    LAS unsigned char* KL = F.lds + RING_OFF;
    const unsigned kl_lds = (unsigned)(size_t)KL;
#define X1_STAGE(bb, kk, buf) do { const bf16* ksrc_ = F.P + ((size_t)(bb) * SEQ + 512 * (kk) + 64 * F.wave + lane) * NIN + PA_IK; \
        _Pragma("unroll") for (int c_ = 0; c_ < 8; ++c_) glds16x(ksrc_ + 8 * c_, (unsigned)__builtin_amdgcn_readfirstlane(kl_lds + (buf) * 65536 + c_ * 8192 + F.wave * 1024)); } while (0)
    X1_STAGE(b, kc, 0);
    asm volatile("s_waitcnt vmcnt(0)" ::: "memory"); __syncthreads();
    bf16x8 af[4][4]; float wq[4][16]; int cb = -1, cqb = -1;
    for (int u = u_lo; u < u_hi; ++u) {
        const int cur = (u - u_lo) & 1;
        int nb = b, nqb = qb, nkc = kc + 1; if (nkc > (qb >> 3)) { nkc = 0; --nqb; if (nqb < 0) { nqb = 127; ++nb; } }
        if (u + 1 < u_hi) X1_STAGE(nb, nkc, cur ^ 1);
        const size_t rowb = (size_t)b * SEQ; const int t0 = 64 * qb + 8 * F.wave;
        if (b != cb || qb != cqb) { cb = b; cqb = qb;
#pragma unroll
            for (int pr = 0; pr < 4; ++pr) {
                const bf16* qrow = F.P + (rowb + t0 + 2 * pr + ((r32 >> 2) & 1)) * NIN + PA_IQ + ((r32 & 3) + 4 * (r32 >> 3)) * 64 + 8 * hi;
#pragma unroll
                for (int s = 0; s < 4; ++s) af[pr][s] = *(const GAS bf16x8*)(qrow + 16 * s);
                const bf16* wrow = F.P + (rowb + t0 + 2 * pr + hi) * NIN + PA_IW;
                const v4u w0 = *(const GAS v4u*)wrow, w1 = *(const GAS v4u*)(wrow + 8);
                const unsigned ww[8] = {w0.x, w0.y, w0.z, w0.w, w1.x, w1.y, w1.z, w1.w};
#pragma unroll
                for (int i = 0; i < 8; ++i) { wq[pr][2 * i] = bf_lo(ww[i]) * 0.015625f; wq[pr][2 * i + 1] = bf_hi(ww[i]) * 0.015625f; }
            }
        }
        const int kend = 64 * (qb + 1) - 512 * kc;
        const int nkt = kend >= 512 ? 16 : (kend + 31) / 32;
        const LAS unsigned char* kl = KL + cur * 65536 + hi * 8192 + r32 * 16;
        for (int kt = 0; kt < nkt; ++kt) {
            bf16x8 bfr[4];
#pragma unroll
            for (int s = 0; s < 4; ++s) bfr[s] = *(const LAS bf16x8*)(kl + s * 16384 + kt * 512);
            const int s0 = 512 * kc + 32 * kt;
#pragma unroll
            for (int pr = 0; pr < 4; ++pr) {
                f32x16 acc = {};
#pragma unroll
                for (int s = 0; s < 4; ++s) acc = __builtin_amdgcn_mfma_f32_32x32x16_bf16(af[pr][s], bfr[s], acc, 0, 0, 0);
                float sc0 = 0.f, sc1 = 0.f;
#pragma unroll
                for (int r = 0; r < 16; ++r) { sc0 = __builtin_fmaf(wq[pr][r], acc[r], sc0); sc1 = __builtin_fmaf(wq[pr][r], __builtin_fabsf(acc[r]), sc1); if ((r & 3) == 3) asm("" : "+v"(sc1)); }
                ((GAS unsigned short*)F.SC)[(rowb + t0 + 2 * pr + hi) * SEQ + s0 + r32] = score_key(sc0 + sc1);
                __builtin_amdgcn_sched_barrier(0);
            }
        }
        asm volatile("s_waitcnt vmcnt(0)" ::: "memory");
        __syncthreads();
        b = nb; qb = nqb; kc = nkc;
    }
#undef X1_STAGE
}

__device__ __forceinline__ unsigned mbcnt64(unsigned long long m) { return __builtin_amdgcn_mbcnt_hi((unsigned)(m >> 32), __builtin_amdgcn_mbcnt_lo((unsigned)m, 0u)); }
template <int SH, int PSH> __device__ __forceinline__ void sel_level(const unsigned (&v)[64], int nreg, unsigned pval, unsigned need, LAS unsigned* hist, int lane, unsigned& bin_out, unsigned& above_out) {
#pragma unroll
    for (int i = 0; i < 8; ++i) ((LAS v4u*)hist)[lane + 64 * i] = (v4u){0u, 0u, 0u, 0u};
    LDS_WAIT(); __builtin_amdgcn_wave_barrier();
    const unsigned hb = (unsigned)(size_t)hist, sink = hb + 9216u + 4u * (unsigned)lane;
#pragma unroll
    for (int g = 0; g < 8; ++g) if (8 * g < nreg) {
#pragma unroll
        for (int jj = 0; jj < 8; ++jj) { const int j = 8 * g + jj;
#pragma unroll
            for (int e = 0; e < 2; ++e) { const unsigned k = e ? (v[j] >> 16) : (v[j] & 0xffffu);
                const bool pred = (k != 0u) && (PSH >= 16 || (k >> (PSH & 15)) == pval);
                const unsigned tgt = pred ? hb + (((k >> SH) & 2047u) << 2) : sink;
                __hip_atomic_fetch_add((LAS unsigned*)tgt, 1u, __ATOMIC_RELAXED, __HIP_MEMORY_SCOPE_WAVEFRONT); }
            if ((jj & 1) == 1) __builtin_amdgcn_sched_barrier(0); }
    }
    LDS_WAIT(); __builtin_amdgcn_wave_barrier();
    unsigned S = 0u;
#pragma unroll
    for (int i = 0; i < 8; ++i) { const v4u q = ((LAS v4u*)hist)[lane * 8 + i]; S += (q.x + q.y) + (q.z + q.w); }
    unsigned T = S;
#pragma unroll
    for (int o = 1; o < 64; o <<= 1) { const unsigned t = __shfl_down(T, o); if (lane + o < 64) T += t; }
    const unsigned above_lane = T - S;
    const bool cross = (T >= need) && (above_lane < need);
    unsigned run = above_lane, bin = 0u, ab = 0u; bool found = false;
#pragma unroll
    for (int i = 7; i >= 0; --i) { const v4u q = ((LAS v4u*)hist)[lane * 8 + i]; const unsigned c4[4] = {q.x, q.y, q.z, q.w};
#pragma unroll
        for (int e = 3; e >= 0; --e) { const bool hit = !found && (run + c4[e] >= need); if (hit) { bin = 32u * lane + 4 * i + e; ab = run; found = true; } run += c4[e]; } }
    const unsigned long long cm = __ballot(cross);
    const int src = cm ? (int)__builtin_ctzll(cm) : 0;
    bin_out = __builtin_amdgcn_readlane(bin, src); above_out = __builtin_amdgcn_readlane(ab, src);
    LDS_WAIT(); __builtin_amdgcn_wave_barrier();
}
__device__ __forceinline__ void select_row(const Frame& F, int m, LAS unsigned* hist, LAS int* out) {
    int lane = F.lane; asm volatile("" : "+v"(lane));
    const int t = m % SEQ, n = t + 1;
    if (n <= TOPK) { for (int j = lane; j < TOPK; j += 64) out[j] = (j < n) ? j : 0; return; }
    const int nreg = (n + 127) >> 7;
    unsigned v[64];
    const GAS unsigned* pr = (const GAS unsigned*)(F.SC + (size_t)m * SEQ) + lane;
#pragma unroll
    for (int g = 0; g < 8; ++g) {
        if (8 * g < nreg) {
#pragma unroll
            for (int jj = 0; jj < 8; ++jj) v[8 * g + jj] = pr[jj * 64];
        } else {
#pragma unroll
            for (int jj = 0; jj < 8; ++jj) v[8 * g + jj] = 0u;
        }
        pr += 512; asm volatile("" : "+v"(pr));
    }
    const int nfull = n >> 7;
#pragma unroll
    for (int g = 0; g < 8; ++g) if (8 * g < nreg && 8 * g + 8 > nfull) {
#pragma unroll
        for (int jj = 0; jj < 8; ++jj) { const int j = 8 * g + jj; const int e0 = 128 * j + 2 * lane; const unsigned w = v[j];
            v[j] = ((e0 < n) ? (w & 0xffffu) : 0u) | ((e0 + 1 < n) ? (w & 0xffff0000u) : 0u); asm volatile("" : "+v"(v[j])); }
    }
    unsigned b1, a1, b2, a2;
    sel_level<5, 16>(v, nreg, 0u, (unsigned)TOPK, hist, lane, b1, a1);
    sel_level<0, 5>(v, nreg, b1, (unsigned)TOPK - a1, hist, lane, b2, a2);
    const unsigned tau = (b1 << 5) | (b2 & 31u);
    const unsigned quota = (unsigned)TOPK - a1 - a2;
    unsigned mg[4] = {0u, 0u, 0u, 0u}, me[4] = {0u, 0u, 0u, 0u};
#pragma unroll
    for (int g = 0; g < 8; ++g) {
        if (8 * g < nreg) {
#pragma unroll
            for (int jj = 0; jj < 8; ++jj) { const int j = 8 * g + jj;
#pragma unroll
                for (int e = 0; e < 2; ++e) { const unsigned k = e ? (v[j] >> 16) : (v[j] & 0xffffu);
                    mg[g >> 1] = mg[g >> 1] + mg[g >> 1] + ((k > tau) ? 1u : 0u); me[g >> 1] = me[g >> 1] + me[g >> 1] + ((k == tau) ? 1u : 0u); }
                if ((jj & 3) == 3) __builtin_amdgcn_sched_barrier(0); }
        } else { mg[g >> 1] <<= 16; me[g >> 1] <<= 16; }
    }
    const unsigned cg = (unsigned)(__builtin_popcount(mg[0]) + __builtin_popcount(mg[1]) + __builtin_popcount(mg[2]) + __builtin_popcount(mg[3]));
    unsigned ce = (unsigned)(__builtin_popcount(me[0]) + __builtin_popcount(me[1]) + __builtin_popcount(me[2]) + __builtin_popcount(me[3]));
    unsigned incl = cg | (ce << 16);
#pragma unroll
    for (int o = 1; o < 64; o <<= 1) { const unsigned t = (unsigned)__shfl_up((int)incl, o); if (lane >= o) incl += t; }
    const unsigned excl = incl - (cg | (ce << 16));
    const unsigned pre_g = excl & 0xffffu, pre_e = excl >> 16;
    const unsigned keep = pre_e >= quota ? 0u : ((quota - pre_e) < ce ? (quota - pre_e) : ce);
#pragma unroll
    for (int q = 3; q >= 0; --q) { while (ce > keep && me[q] != 0u) { me[q] &= me[q] - 1u; --ce; } }
    unsigned pos = pre_g + (pre_e < quota ? pre_e : quota);
    const int ilane = 2 * lane;
#pragma unroll
    for (int q = 0; q < 4; ++q) { unsigned mm = mg[q] | me[q];
        while (mm != 0u) { const int bpos = 31 - (int)__builtin_clz(mm); const int sl = 31 - bpos; mm &= ~(1u << bpos);
            const int i = 128 * (16 * q + (sl >> 1)) + ilane + (sl & 1);
            if (pos < (unsigned)TOPK) out[pos] = i;
            ++pos; } }
}


constexpr int AT_K = 0, AT_V = 16384, AT_KB = 32768, AT_WSF = 33280, AT_BT = 35328, AT_DEAD = 35840, AT_SV = 36864;
typedef short v4i16_t __attribute__((ext_vector_type(4)));
__device__ __forceinline__ s16x4 vtr(const LAS unsigned char* p) { return __builtin_bit_cast(s16x4, __builtin_amdgcn_ds_read_tr16_b64_v4i16((LAS v4i16_t*)p)); }
typedef __bf16 bfpair_t __attribute__((ext_vector_type(2))); typedef float f32pair_t __attribute__((ext_vector_type(2)));
__device__ __forceinline__ unsigned cvtpk(float lo, float hi) { const f32pair_t v = {lo, hi}; return __builtin_bit_cast(unsigned, __builtin_convertvector(v, bfpair_t)); }
#define NEG_INF (-__builtin_inff())

template <int TYPE>
__device__ __forceinline__ void dense_attn_unit(const Frame& F, int l, int b, int h, int qb) {
    constexpr int QOFF = TYPE == 1 ? PB_Q : TYPE == 2 ? PC_Q : PD_Q, KOFF = TYPE == 1 ? PB_K : TYPE == 2 ? PC_K : PD_K, VOFF = TYPE == 1 ? PB_V : TYPE == 2 ? PC_V : PD_V;
    constexpr bool MQA = TYPE == 1; constexpr int YOFF = TYPE * GWID;
    const int tid = F.tid, lane = F.lane, wid = F.wave, r32 = lane & 31, hi = lane >> 5;
    LAS unsigned char* L = F.lds + RING_OFF;
    LAS float* wsf = (LAS float*)(L + AT_WSF + wid * 256);
    LAS float* BT = (LAS float*)(L + AT_BT);
    const size_t rowb = (size_t)b * SEQ; const int q0 = qb * 256;
    const bf16* Pk = F.P + rowb * NIN + KOFF + (MQA ? 0 : h * 64);
    const bf16* Pv = F.P + rowb * NIN + VOFF + (MQA ? 0 : h * 64);
    const bf16* Pq = F.P + (rowb + q0 + wid * 32 + r32) * NIN + QOFF + h * 64 + hi * 8;
    bf16x8 qr[4];
#pragma unroll
    for (int d0 = 0; d0 < 4; ++d0) qr[d0] = *(const GAS bf16x8*)(Pq + 16 * d0);
    const int jt_hi = 4 * qb + 3, jt_lo = (TYPE == 1) ? ((4 * qb - 2) > 0 ? (4 * qb - 2) : 0) : 0, nt = jt_hi - jt_lo + 1;
    if (TYPE == 1) { if (tid < 128) BT[tid] = F.rel_table[(int)kBucketLut[tid] * 16 + 8 + h] * LOG2E; }
    const bf16* kgp = Pk + (size_t)lane * NIN + wid * 8;
    const int vkey = tid >> 3, vch = tid & 7;
    const bf16* vgp = Pv + (size_t)vkey * NIN + vch * 8;
    const int kl = wid * 1024 + lane * 16;
    const int vl = (vch >> 2) * 4096 + (vkey >> 3) * 512 + (vkey & 7) * 64 + (vch & 3) * 16;
    const float* kb2 = F.KB2 + ((size_t)b * NH + h) * SEQ;
    v4u kreg = *(const GAS v4u*)(kgp + (size_t)jt_hi * 64 * NIN), vreg = *(const GAS v4u*)(vgp + (size_t)jt_hi * 64 * NIN);
    float kbreg = 0.f; if (TYPE == 2 && tid < 64) kbreg = kb2[jt_hi * 64 + tid];
    *(LAS v4u*)(L + AT_K + kl) = kreg; *(LAS v4u*)(L + AT_V + vl) = vreg; if (TYPE == 2 && tid < 64) ((LAS float*)(L + AT_KB))[tid] = kbreg;
    __syncthreads();
    f32x16 o[2]; o[0] = f32x16{}; o[1] = f32x16{};
    float mrun = NEG_INF, lsum = 0.f, carry = 1.f;
    float qbound = 0.f;
    if (TYPE == 2) {
        float ss = 0.f;
#pragma unroll
        for (int d0 = 0; d0 < 4; ++d0)
#pragma unroll
            for (int j = 0; j < 8; ++j) { const float x = bf2f((bf16)qr[d0][j]); ss += x * x; }
        ss += __shfl_xor(ss, 32);
        float gm = fabsf(F.qk_g[((size_t)l * 6 + 5) * HD + lane]);
#pragma unroll
        for (int o = 1; o < 64; o <<= 1) gm = fmaxf(gm, __shfl_xor(gm, o));
        qbound = sqrtf(ss) * 8.08f * gm;
    }
    const int qrel = 32 * wid + r32;
    const int vb = ((lane >> 4) & 1) * 32 + (lane & 3) * 8 + (4 * hi + ((lane & 15) >> 2)) * 64;
    LAS unsigned* deadf = (LAS unsigned*)(L + AT_DEAD);
    for (int i = 0; i < nt; ++i) {
        const int jt = jt_hi - i, cur = i & 1, jb = jt - 4 * qb; const bool more = (i + 1 < nt);
        float kbnext = 0.f;
        if (more) { kreg = *(const GAS v4u*)(kgp + (size_t)(jt - 1) * 64 * NIN); vreg = *(const GAS v4u*)(vgp + (size_t)(jt - 1) * 64 * NIN); if (TYPE == 2 && tid < 64) kbreg = kb2[(jt - 1) * 64 + tid]; if (TYPE == 2) kbnext = kb2[jt * 64 - 1]; }
        const bool active = (jb <= (wid >> 1)) && (TYPE != 1 || (64 * jb + 63 >= 32 * wid - (WINDOW - 1)));
        if (active) {
            const LAS unsigned char* Kb = L + AT_K + cur * 8192; const LAS unsigned char* Vb = L + AT_V + cur * 8192;
            f32x16 p0 = f32x16{}, p1 = f32x16{};
            bf16x8 ka[4], kc[4];
#pragma unroll
            for (int d0 = 0; d0 < 4; ++d0) { ka[d0] = *(const LAS bf16x8*)(Kb + (2 * d0 + hi) * 1024 + r32 * 16); kc[d0] = *(const LAS bf16x8*)(Kb + (2 * d0 + hi) * 1024 + 512 + r32 * 16); }
            __builtin_amdgcn_sched_barrier(0);
#pragma unroll
            for (int d0 = 0; d0 < 4; ++d0) { p0 = __builtin_amdgcn_mfma_f32_32x32x16_bf16(ka[d0], qr[d0], p0, 0, 0, 0); p1 = __builtin_amdgcn_mfma_f32_32x32x16_bf16(kc[d0], qr[d0], p1, 0, 0, 0); }
            bf16x8 vfr[2][4];
#pragma unroll
            for (int d0 = 0; d0 < 2; ++d0)
#pragma unroll
                for (int ks = 0; ks < 4; ++ks) { const s16x4 lo = vtr(Vb + vb + d0 * 4096 + ks * 1024), hh = vtr(Vb + vb + d0 * 4096 + ks * 1024 + 512);
                    vfr[d0][ks] = (bf16x8){lo[0], lo[1], lo[2], lo[3], hh[0], hh[1], hh[2], hh[3]}; }
            __builtin_amdgcn_sched_barrier(0);
            const int kv0 = 64 * jb + 4 * hi;
            if (TYPE == 3) {
                float b0[16], b1[16];
#pragma unroll
                for (int r = 0; r < 16; ++r) { const int kv = kv0 + (r & 3) + 8 * (r >> 2);
                    const float e0 = fexp2(fminf(p0[r], 80.f)), e1 = fexp2(fminf(p1[r], 80.f));
                    const float m0 = frcp(1.0f + e0), m1 = frcp(1.0f + e1);
                    const bool ok0 = kv < qrel, ok1 = (kv + 32) < qrel;
                    b0[r] = ok0 ? e0 * m0 : 0.f; b1[r] = ok1 ? e1 * m1 : 0.f; p0[r] = ok0 ? m0 : 1.0f; p1[r] = ok1 ? m1 : 1.0f; }
                float gp[8], go[8], pp[8];
#pragma unroll
                for (int g = 0; g < 4; ++g) { gp[g] = (p0[4 * g] * p0[4 * g + 1]) * (p0[4 * g + 2] * p0[4 * g + 3]); gp[4 + g] = (p1[4 * g] * p1[4 * g + 1]) * (p1[4 * g + 2] * p1[4 * g + 3]); }
#pragma unroll
                for (int g = 0; g < 8; ++g) { const float oth = __shfl_xor(gp[g], 32); pp[g] = gp[g] * oth; go[g] = hi ? 1.0f : oth; }
                float sp = 1.0f;
#pragma unroll
                for (int g = 7; g >= 0; --g) { const float sg = sp * go[g] * carry;
                    if (g < 4) { const float c3 = p0[4 * g + 3], c2 = p0[4 * g + 2], c1 = p0[4 * g + 1];
                        p0[4 * g + 3] = b0[4 * g + 3] * sg; const float s2 = sg * c3; p0[4 * g + 2] = b0[4 * g + 2] * s2; const float s1 = s2 * c2; p0[4 * g + 1] = b0[4 * g + 1] * s1; p0[4 * g] = b0[4 * g] * (s1 * c1); }
                    else { const int q = g - 4; const float c3 = p1[4 * q + 3], c2 = p1[4 * q + 2], c1 = p1[4 * q + 1];
                        p1[4 * q + 3] = b1[4 * q + 3] * sg; const float s2 = sg * c3; p1[4 * q + 2] = b1[4 * q + 2] * s2; const float s1 = s2 * c2; p1[4 * q + 1] = b1[4 * q + 1] * s1; p1[4 * q] = b1[4 * q] * (s1 * c1); }
                    sp *= pp[g]; }
                carry *= sp;
            } else {
                if (TYPE == 2) {
                    const LAS f32x4* kbp = (const LAS f32x4*)(L + AT_KB + cur * 256);
#pragma unroll
                    for (int g = 0; g < 4; ++g) { const f32x4 a = kbp[2 * g + hi], c = kbp[8 + 2 * g + hi];
#pragma unroll
                        for (int e = 0; e < 4; ++e) { p0[4 * g + e] += a[e]; p1[4 * g + e] += c[e]; } }
                    if (jb >= 0) {
#pragma unroll
                        for (int r = 0; r < 16; ++r) { const int kv = kv0 + (r & 3) + 8 * (r >> 2); if (kv > qrel) p0[r] = NEG_INF; if (kv + 32 > qrel) p1[r] = NEG_INF; }
                    }
                } else {
#pragma unroll
                    for (int r = 0; r < 16; ++r) { const int d0_ = qrel - (kv0 + (r & 3) + 8 * (r >> 2)), d1_ = d0_ - 32;
                        const bool ok0 = (d0_ >= 0) && (d0_ < WINDOW), ok1 = (d1_ >= 0) && (d1_ < WINDOW);
                        const float t0 = BT[ok0 ? d0_ : 0], t1 = BT[ok1 ? d1_ : 0];
                        p0[r] = ok0 ? p0[r] + t0 : NEG_INF; p1[r] = ok1 ? p1[r] + t1 : NEG_INF; }
                }
                float rm = fmaxf(p0[0], p1[0]);
#pragma unroll
                for (int r = 1; r < 16; ++r) rm = fmaxf(rm, fmaxf(p0[r], p1[r]));
                { auto rr = __builtin_amdgcn_permlane32_swap(__float_as_uint(rm), __float_as_uint(rm), false, false); rm = fmaxf(__uint_as_float(rr[0]), __uint_as_float(rr[1])); }
                const float mn = fmaxf(mrun, rm);
                if (__any(mn > mrun)) {
                    const float f = (mn > mrun) ? fexp2(mrun - mn) : 1.0f;
                    lsum *= f; mrun = mn;
                    if (hi == 0) wsf[r32] = f;
                    LDS_WAIT(); __builtin_amdgcn_wave_barrier();
#pragma unroll
                    for (int g = 0; g < 4; ++g) { const f32x4 fv = ((const LAS f32x4*)wsf)[2 * g + hi];
#pragma unroll
                        for (int e = 0; e < 4; ++e) { o[0][4 * g + e] *= fv[e]; o[1][4 * g + e] *= fv[e]; } }
                    LDS_WAIT(); __builtin_amdgcn_wave_barrier();
                }
                const float ms = (mrun == NEG_INF) ? 0.f : mrun;
                float ps = 0.f;
#pragma unroll
                for (int r = 0; r < 16; ++r) { p0[r] = fexp2(p0[r] - ms); p1[r] = fexp2(p1[r] - ms); ps += p0[r] + p1[r]; }
                lsum += ps;
            }
            bf16x8 pa[4];
#pragma unroll
            for (int ks = 0; ks < 4; ++ks) { v4u w;
                if (ks < 2) { w.x = cvtpk(p0[8 * ks], p0[8 * ks + 1]); w.y = cvtpk(p0[8 * ks + 2], p0[8 * ks + 3]); w.z = cvtpk(p0[8 * ks + 4], p0[8 * ks + 5]); w.w = cvtpk(p0[8 * ks + 6], p0[8 * ks + 7]); }
                else { const int k2 = ks - 2; w.x = cvtpk(p1[8 * k2], p1[8 * k2 + 1]); w.y = cvtpk(p1[8 * k2 + 2], p1[8 * k2 + 3]); w.z = cvtpk(p1[8 * k2 + 4], p1[8 * k2 + 5]); w.w = cvtpk(p1[8 * k2 + 6], p1[8 * k2 + 7]); }
                pa[ks] = __builtin_bit_cast(bf16x8, w); }
#pragma unroll
            for (int d0 = 0; d0 < 2; ++d0)
#pragma unroll
                for (int ks = 0; ks < 4; ++ks) o[d0] = __builtin_amdgcn_mfma_f32_32x32x16_bf16(pa[ks], vfr[d0][ks], o[d0], 0, 0, 0);
        }
        if (TYPE == 2) {
            bool wdead = false;
            if (active && more) wdead = __all(qbound + kbnext - mrun < -40.f);
            if (lane == 0) deadf[cur * 8 + wid] = wdead ? 1u : 0u; }
        if (TYPE == 3) { const bool wdead = active && __all(carry < 2.3e-10f);
            if (lane == 0) deadf[cur * 8 + wid] = wdead ? 1u : 0u; }
        if (more) { *(LAS v4u*)(L + AT_K + (cur ^ 1) * 8192 + kl) = kreg; *(LAS v4u*)(L + AT_V + (cur ^ 1) * 8192 + vl) = vreg; if (TYPE == 2 && tid < 64) ((LAS float*)(L + AT_KB + (cur ^ 1) * 256))[tid] = kbreg; }
        __syncthreads();
        if (TYPE >= 2) { const v4u d0 = *(const LAS v4u*)(deadf + cur * 8), d1 = *(const LAS v4u*)(deadf + cur * 8 + 4);
            if ((d0.x & d0.y & d0.z & d0.w & d1.x & d1.y & d1.z & d1.w) != 0u) break; }
    }
    float inv[16];
    if (TYPE != 3) {
        { auto rr = __builtin_amdgcn_permlane32_swap(__float_as_uint(lsum), __float_as_uint(lsum), false, false); lsum = __uint_as_float(rr[0]) + __uint_as_float(rr[1]); }
        if (TYPE == 1) lsum += fexp2(F.sinks[l * NH + h] * LOG2E - mrun);
        const float il = 1.0f / lsum;
        if (hi == 0) wsf[r32] = il;
        LDS_WAIT(); __builtin_amdgcn_wave_barrier();
#pragma unroll
        for (int g = 0; g < 4; ++g) { const f32x4 fv = ((const LAS f32x4*)wsf)[2 * g + hi]; inv[4 * g] = fv[0]; inv[4 * g + 1] = fv[1]; inv[4 * g + 2] = fv[2]; inv[4 * g + 3] = fv[3]; }
        LDS_WAIT(); __builtin_amdgcn_wave_barrier();
    } else {
#pragma unroll
        for (int r = 0; r < 16; ++r) inv[r] = 1.0f;
    }
    unsigned short gte[2][16];
    if (TYPE == 2) {
#pragma unroll
        for (int d0 = 0; d0 < 2; ++d0)
#pragma unroll
            for (int r = 0; r < 16; ++r) { const int q = (r & 3) + 8 * (r >> 2) + 4 * hi; const size_t mrow = rowb + q0 + wid * 32 + q; gte[d0][r] = ((const GAS unsigned short*)F.P)[mrow * NIN + PC_G + h * 64 + 32 * d0 + r32]; }
    }
#pragma unroll
    for (int d0 = 0; d0 < 2; ++d0)
#pragma unroll
        for (int r = 0; r < 16; ++r) { const int q = (r & 3) + 8 * (r >> 2) + 4 * hi; const size_t mrow = rowb + q0 + wid * 32 + q; const int col = h * 64 + 32 * d0 + r32;
            float val = o[d0][r] * inv[r];
            if (TYPE == 2) val *= frcp(1.0f + fexp2(-LOG2E * __builtin_bit_cast(float, (unsigned)gte[d0][r] << 16)));
            F.Y[mrow * DM + YOFF + col] = (bf16)f2bf(val); }
}

__device__ __forceinline__ void sparse_attn_query(const Frame& F, int m, LAS unsigned char* vch, const LAS float* TBA, const LAS int* idx) {
    int lane = F.lane; asm volatile("" : "+v"(lane));
    const int hh = lane & 15, kg = lane >> 4, t = m % SEQ, b = m / SEQ;
    const size_t rowb = (size_t)b * SEQ;
    const int nsel = (t + 1) < TOPK ? (t + 1) : TOPK, nch = (nsel + 63) >> 6;
    const bf16* qp = F.P + (size_t)m * NIN + PA_Q + (hh & 7) * 64 + 8 * kg;
    const bf16x8 qf0 = *(const GAS bf16x8*)qp, qf1 = *(const GAS bf16x8*)(qp + 32);
    float s[4][4][4];
#pragma unroll
    for (int cp = 0; cp < 2; ++cp) {
        if (2 * cp < nch) {
            bf16x8 kf[8][2];
#pragma unroll
            for (int bb = 0; bb < 8; ++bb) { const int keyA = idx[128 * cp + 16 * bb + hh];
                const bf16* kp = F.P + (rowb + keyA) * NIN + PA_K + 8 * kg;
                kf[bb][0] = *(const GAS bf16x8*)kp; kf[bb][1] = *(const GAS bf16x8*)(kp + 32); }
            __builtin_amdgcn_sched_barrier(0);
#pragma unroll
            for (int bb = 0; bb < 8; ++bb) { const int c = 2 * cp + (bb >> 2), blk = bb & 3, j0 = 64 * c + 16 * blk;
                f32x4 acc = {0.f, 0.f, 0.f, 0.f};
                acc = __builtin_amdgcn_mfma_f32_16x16x32_bf16(kf[bb][0], qf0, acc, 0, 0, 0); acc = __builtin_amdgcn_mfma_f32_16x16x32_bf16(kf[bb][1], qf1, acc, 0, 0, 0);
                const v4i id4 = *(const LAS v4i*)(idx + j0 + 4 * kg);
#pragma unroll
                for (int r = 0; r < 4; ++r) { const int j = j0 + 4 * kg + r; int dist = t - id4[r]; dist = dist < 0 ? 0 : (dist > 128 ? 128 : dist);
                    const float bias = TBA[dist * 8 + (hh & 7)];
                    s[c][blk][r] = (j < nsel) ? acc[r] + bias : NEG_INF; }
            }
        } else {
#pragma unroll
            for (int c = 2 * cp; c < 2 * cp + 2; ++c)
#pragma unroll
                for (int blk = 0; blk < 4; ++blk)
#pragma unroll
                    for (int r = 0; r < 4; ++r) s[c][blk][r] = NEG_INF;
        }
    }
    v4u xv[2][8];
#define SP_VLOAD(c_, X) do { const int keyV_ = idx[64 * (c_) + lane]; const bf16* vp_ = F.P + (rowb + keyV_) * NIN + PA_V; \
        _Pragma("unroll") for (int i_ = 0; i_ < 8; ++i_) X[i_] = *(const GAS v4u*)(vp_ + 8 * i_); } while (0)
    SP_VLOAD(0, xv[0]);
    if (1 < nch) SP_VLOAD(1, xv[1]);
    __builtin_amdgcn_sched_barrier(0);
    float mx = NEG_INF;
#pragma unroll
    for (int c = 0; c < 4; ++c)
#pragma unroll
        for (int blk = 0; blk < 4; ++blk)
#pragma unroll
            for (int r = 0; r < 4; ++r) mx = fmaxf(mx, s[c][blk][r]);
    mx = fmaxf(mx, __shfl_xor(mx, 16)); mx = fmaxf(mx, __shfl_xor(mx, 32));
    float sum = 0.f;
#pragma unroll
    for (int c = 0; c < 4; ++c)
#pragma unroll
        for (int blk = 0; blk < 4; ++blk)
#pragma unroll
            for (int r = 0; r < 4; ++r) { const float p = fexp2(s[c][blk][r] - mx); s[c][blk][r] = p; sum += p; }
    sum += __shfl_xor(sum, 16); sum += __shfl_xor(sum, 32);
    const float inv = 1.0f / sum;
    f32x4 oacc[4];
#pragma unroll
    for (int d = 0; d < 4; ++d) oacc[d] = (f32x4){0.f, 0.f, 0.f, 0.f};
    const int q4 = (lane & 15) >> 2, p4 = lane & 3;
#pragma unroll
    for (int c = 0; c < 4; ++c) {
        if (c < nch) {
#pragma unroll
            for (int i = 0; i < 8; ++i) *(LAS v4u*)(vch + (i >> 2) * 4096 + lane * 64 + (i & 3) * 16) = xv[c & 1][i];
            LDS_WAIT(); __builtin_amdgcn_wave_barrier();
            if (c + 2 < nch) SP_VLOAD(c + 2, xv[c & 1]);
            __builtin_amdgcn_sched_barrier(0);
#pragma unroll
            for (int kp = 0; kp < 2; ++kp) { v4u w; w.x = cvtpk(s[c][2 * kp][0], s[c][2 * kp][1]); w.y = cvtpk(s[c][2 * kp][2], s[c][2 * kp][3]); w.z = cvtpk(s[c][2 * kp + 1][0], s[c][2 * kp + 1][1]); w.w = cvtpk(s[c][2 * kp + 1][2], s[c][2 * kp + 1][3]);
                const bf16x8 pf = __builtin_bit_cast(bf16x8, w);
#pragma unroll
                for (int d = 0; d < 4; ++d) { const LAS unsigned char* a = vch + (d >> 1) * 4096 + (32 * kp + 4 * kg + q4) * 64 + ((d & 1) * 16 + 4 * p4) * 2;
                    const s16x4 lo = vtr(a), hv = vtr(a + 16 * 64);
                    const bf16x8 vf = {lo[0], lo[1], lo[2], lo[3], hv[0], hv[1], hv[2], hv[3]};
                    oacc[d] = __builtin_amdgcn_mfma_f32_16x16x32_bf16(vf, pf, oacc[d], 0, 0, 0); } }
            LDS_WAIT(); __builtin_amdgcn_wave_barrier();
        }
    }
#undef SP_VLOAD
    if (hh < 8) {
#pragma unroll
        for (int d = 0; d < 4; ++d) { v2u w; w.x = pk2(oacc[d][0] * inv, oacc[d][1] * inv); w.y = pk2(oacc[d][2] * inv, oacc[d][3] * inv);
            *(GAS v2u*)(F.Y + (size_t)m * DM + hh * 64 + 16 * d + 4 * kg) = w; }
    }
}

constexpr int CW_QUEUE = 8192;
constexpr int MIX_ITEMS = 2560;
template <unsigned EN> __device__ __forceinline__ void ph_attention(const Frame& F, int l, int qsel = 0) {
    LAS float* TBA = (LAS float*)(F.lds + AUX_OFF);
    for (int i = F.tid; i < 129 * 8; i += NTHREADS) { const int d = i >> 3, hq = i & 7; const int bk = d < 128 ? (int)kBucketLut[d] : 31; TBA[i] = F.rel_table[bk * 16 + hq] * LOG2E; }
    LAS unsigned* qslot = (LAS unsigned*)(F.lds + LDSCTL_OFF + 64);
    LAS unsigned char* wbuf = F.lds + RING_OFF + AT_SV + F.wave * 9472;
    LAS int* idxl = (LAS int*)(wbuf + 8192);
    __syncthreads();
#define MIX_FETCH(it) do { if (F.tid == 0) *qslot = __hip_atomic_fetch_add((unsigned*)(F.ctl + CW_QUEUE + 64 * l + 32 * qsel), 1u, __ATOMIC_RELAXED, __HIP_MEMORY_SCOPE_AGENT); \
        __syncthreads(); it = (int)*qslot; __syncthreads(); } while (0)
    int it; MIX_FETCH(it);
    while (it < 1024) { const int r = it;
        if (EN & 0x800) {
            const int b = r >> 9, blk = r & 511;
#pragma unroll 1
            for (int k = 0; k < 2; ++k) { const int u = 8 * blk + F.wave; const int t = k ? (SEQ - 1 - u) : u; const int m = b * SEQ + t;
                select_row(F, m, (LAS unsigned*)wbuf, idxl);
                LDS_WAIT(); __builtin_amdgcn_wave_barrier();
#ifdef PROBE_SEL2
                select_row(F, m, (LAS unsigned*)wbuf, idxl); LDS_WAIT(); __builtin_amdgcn_wave_barrier();
#endif
#ifdef PROBE_ATT2
                sparse_attn_query(F, m, wbuf, TBA, idxl); LDS_WAIT(); __builtin_amdgcn_wave_barrier();
#endif
                sparse_attn_query(F, m, wbuf, TBA, idxl);
                LDS_WAIT(); __builtin_amdgcn_wave_barrier(); }
        }
        MIX_FETCH(it); }
    while (it < 1536) { const int r = it & 511; if (EN & 0x100) dense_attn_unit<2>(F, l, (r & 15) >> 3, r & 7, 31 - (r >> 4)); MIX_FETCH(it); }
    while (it < 2048) { const int r = it & 511; if (EN & 0x200) dense_attn_unit<3>(F, l, (r & 15) >> 3, r & 7, 31 - (r >> 4)); MIX_FETCH(it); }
    while (it < MIX_ITEMS) { const int r = it & 511; if (EN & 0x400) dense_attn_unit<1>(F, l, (r & 15) >> 3, r & 7, 31 - (r >> 4)); MIX_FETCH(it); }
#undef MIX_FETCH
}


__device__ __forceinline__ const float* gp_(const float* p) {
#if defined(__HIP_DEVICE_COMPILE__)
    __builtin_assume(!__builtin_amdgcn_is_shared((const __attribute__((address_space(0))) void*)p)); __builtin_assume(!__builtin_amdgcn_is_private((const __attribute__((address_space(0))) void*)p));
#endif
    return p; }
#ifndef PROBE_KINDS
#define PROBE_KINDS 0u
#endif
#ifndef PROBE_ATT
#define PROBE_ATT 0xF00u
#endif
#ifndef PROBE_REPS
#define PROBE_REPS 1
#endif
#ifndef MK_ONE_LAUNCH
#define MK_ONE_LAUNCH 1
#endif
constexpr int PH_PER_LAYER = 14, N_PHASES = 1 + DEPTH * PH_PER_LAYER;
struct Args { const float* in[15]; float* out; unsigned char* ws; int ph_lo, ph_hi; };
struct ArgsG { const GAS float* in[15]; GAS float* out; GAS unsigned char* ws; int ph_lo, ph_hi; };
template <unsigned EN> __global__ void __launch_bounds__(NTHREADS, 2) trunk_fwd(Args args) {
    extern __shared__ __attribute__((aligned(16))) unsigned char lds[];
    LAS unsigned char* const ldsb = (LAS unsigned char*)lds;
    const int wave0 = __builtin_amdgcn_readfirstlane((int)threadIdx.x >> 6);
    for (int u = threadIdx.x; u < (LDS_BYTES - LDSCTL_OFF) / 4; u += NTHREADS) ((LAS unsigned*)(ldsb + LDSCTL_OFF))[u] = 0u;
    __syncthreads();
#if MK_ONE_LAUNCH
    constexpr int lo = 0, hi = N_PHASES;
#else
    const int lo = args.ph_lo, hi = args.ph_hi;
#endif
    XcdBarrier bar; bar.bar = (unsigned*)(args.ws + WS_CTL) + CW_BAR; bar.x = 0; bar.st = nullptr;
    if (hi - lo > 1) bar = xcd_barrier_post((unsigned*)(args.ws + WS_CTL) + CW_BAR, (volatile LAS unsigned*)(ldsb + LDSCTL_OFF));
#define GP(p) ((const float*)(p))
#define PH_BEGIN(k, kind) if (lo <= (k) && (k) < hi) { _Pragma("unroll 1") for (int rep_ = 0; rep_ < (((PROBE_KINDS >> (kind)) & 1u) ? PROBE_REPS : 1); ++rep_) { Frame F; { \
        const ArgsG* ka = (const ArgsG*)__builtin_amdgcn_kernarg_segment_ptr(); asm volatile("" : "+s"(ka)); \
        unsigned o_ = ~0u; asm volatile("" : "+s"(o_)); int t_ = wave0 * 64 + (int)__builtin_amdgcn_mbcnt_hi(o_, __builtin_amdgcn_mbcnt_lo(o_, 0u)); asm volatile("" : "+v"(t_)); \
        F.lds = ldsb; F.tid = t_; F.lane = t_ & 63; F.wave = wave0; int gw_ = blockIdx.x * NWAVES + wave0; asm volatile("" : "+s"(gw_)); F.G = gridDim.x; F.gw = gw_; F.NGW = F.G * NWAVES; \
        unsigned char* ws = (unsigned char*)ka->ws; F.ctl = (gu32*)(ws + WS_CTL);     \
        F.x = GP(ka->in[0]); F.c = GP(ka->in[1]); F.w_ada = GP(ka->in[2]); F.b_ada = GP(ka->in[3]); F.norm_g = GP(ka->in[4]); F.w_in = GP(ka->in[5]); F.qk_g = GP(ka->in[6]); F.forget_b = GP(ka->in[7]); \
        F.sinks = GP(ka->in[8]); F.rel_table = GP(ka->in[9]); F.group_g = GP(ka->in[10]); F.w_out = GP(ka->in[11]); F.w_gate = GP(ka->in[12]); F.w_up = GP(ka->in[13]); F.w_down = GP(ka->in[14]); F.out = (float*)ka->out; \
        F.MOD = (float*)(ws + WS_MOD); F.LF = (float*)(ws + WS_LF); F.KB2 = (float*)(ws + WS_KB2); F.SC = (unsigned short*)(ws + WS_SC); F.IDX = (int*)(ws + WS_IDX); \
        F.WGU = (bf16*)(ws + WS_WGU); F.WD = (bf16*)(ws + WS_WD); F.WIN = (bf16*)(ws + WS_WIN); F.WOUT = (bf16*)(ws + WS_WOUT); \
        F.H = (bf16*)(ws + WS_H); F.P = (bf16*)(ws + WS_P); F.Y = (bf16*)(ws + WS_Y); F.XB = (bf16*)(ws + WS_XB); }
#define PH_END(k) if ((k) + 1 < hi) xcd_barrier(bar); } }

    PH_BEGIN(0, 31) if (EN & 1) p0_prologue(F); PH_END(0)

    for (int l = 0; l < DEPTH; ++l) {
        const int base = 1 + l * PH_PER_LAYER;
        for (int sub = 0; sub < 3; ++sub) {
            if (sub != 1) {
                const int f = sub >> 1, pb = base + (f ? 11 : 0), ni = f ? 2 : 0, lf = l * 2 + f;
                PH_BEGIN(pb, (f ? 11 : 0)) if (EN & 2) { const float* modl = F.MOD + (size_t)l * BATCH * NMOD;
                    if (l == 0 && f == 0) ph_modulate<FFN_FP8, false>(F, F.x, F.norm_g + ((size_t)l * 3 + ni) * DM, modl + (3 * ni + 0) * DM, modl + (3 * ni + 1) * DM);
                    else ph_modulate<FFN_FP8, true>(F, F.XB, F.norm_g + ((size_t)l * 3 + ni) * DM, modl + (3 * ni + 0) * DM, modl + (3 * ni + 1) * DM); } PH_END(pb)
                PH_BEGIN(pb + 1, (f ? 12 : 1)) if (EN & 4) {
                    pg8::StaticOrder S; S.init(M, NGU, F.G, (int)blockIdx.x);
                    if constexpr (FFN_FP8) { pg8::Gemm g{F.H, (const bf16*)((const unsigned char*)F.WGU + (size_t)lf * NGU * DM), M, NGU, DM, 127, W8_E8M0};
                        pg8::EpiSwiGLU8 E{(unsigned char*)F.P, DFFP};
                        pg8::gemm_phase<pg8::EpiSwiGLU8, pg8::StaticOrder, true, true, true>(F.lds + RING_OFF, g, S, E, F.tid); }
                    else { pg8::Gemm g{F.H, F.WGU + (size_t)lf * NGU * DM, M, NGU, DM};
                        pg8::EpiSwiGLU E{F.P, DFF};
                        pg8::gemm_phase<pg8::EpiSwiGLU, pg8::StaticOrder, true, true>(F.lds + RING_OFF, g, S, E, F.tid); } } PH_END(pb + 1)
                PH_BEGIN(pb + 2, (f ? 13 : 2)) if (EN & 8) {
                    pg8::Gemm g{F.P, FFN_FP8 ? (const bf16*)((const unsigned char*)F.WD + (size_t)lf * DM * DFFP) : F.WD + (size_t)lf * DM * DFF, M, DM, DFF, 127, FFN_FP8 ? W8_E8M0 : 127, FFN_FP8 ? DFFP : 0, FFN_FP8 ? DFFP : 0}; pg8::StaticOrder S; S.init(M, DM, F.G, (int)blockIdx.x);
                    const float* modl = F.MOD + (size_t)l * BATCH * NMOD;
                    if (l == DEPTH - 1 && f == 1) { pg8::EpiResid<false> E{F.XB, rep_ ? (void*)F.SC : (void*)F.out, DM, modl + (3 * ni + 2) * DM, NMOD, SEQ, 0.5f};
                        pg8::gemm_phase<pg8::EpiResid<false>, pg8::StaticOrder, true, true, FFN_FP8>(F.lds + RING_OFF, g, S, E, F.tid); }
                    else { pg8::EpiResid<true> E{F.XB, rep_ ? (void*)F.SC : (void*)F.XB, DM, modl + (3 * ni + 2) * DM, NMOD, SEQ, 0.5f};
                        pg8::gemm_phase<pg8::EpiResid<true>, pg8::StaticOrder, true, true, FFN_FP8>(F.lds + RING_OFF, g, S, E, F.tid); } } PH_END(pb + 2)
            } else {
                PH_BEGIN(base + 3, 3) if (EN & 2) { const float* modl = F.MOD + (size_t)l * BATCH * NMOD; ph_modulate<false, true>(F, F.XB, F.norm_g + ((size_t)l * 3 + 1) * DM, modl + 3 * DM, modl + 4 * DM); } PH_END(base + 3)
                PH_BEGIN(base + 4, 4) if (EN & 16) {
                    pg8::Gemm g{F.H, F.WIN + (size_t)l * NIN * DM, M, NIN, DM}; pg8::StaticOrder S; S.init(M, NIN, F.G, (int)blockIdx.x);
                    pg8::EpiBf16 E{F.P, NIN};
                    pg8::gemm_phase<pg8::EpiBf16, pg8::StaticOrder, true, true>(F.lds + RING_OFF, g, S, E, F.tid); } PH_END(base + 4)
                PH_BEGIN(base + 6, 6) if (EN & 64) { ph_scan(F, l);
                    int par_ = (int)(blockIdx.x & 1u); asm volatile("" : "+s"(par_));
                    _Pragma("unroll 1") for (int st_ = 0; st_ < 2; ++st_) { if ((st_ ^ par_) == 0) { if (EN & 32) ph_post(F, l); } else ph_idx_scores(F); } } PH_END(base + 6)
                PH_BEGIN(base + 8, 8) if (EN & 0xF00) { if (rep_ == 0) ph_attention<EN>(F, l, 0); else ph_attention<(PROBE_ATT)>(F, l, 1); } PH_END(base + 8)
                PH_BEGIN(base + 9, 9) if (EN & 0x1000) ph_gnorm(F, l); PH_END(base + 9)
                PH_BEGIN(base + 10, 10) if (EN & 0x2000) {
                    pg8::Gemm g{F.Y, F.WOUT + (size_t)l * DM * DM, M, DM, DM}; pg8::StaticOrder S; S.init(M, DM, F.G, (int)blockIdx.x);
                    const float* modl = F.MOD + (size_t)l * BATCH * NMOD;
                    pg8::EpiResid<true> E{F.XB, rep_ ? (void*)F.SC : (void*)F.XB, DM, modl + 5 * DM, NMOD, SEQ, 1.0f};
                    pg8::gemm_phase<pg8::EpiResid<true>, pg8::StaticOrder, true, true>(F.lds + RING_OFF, g, S, E, F.tid); } PH_END(base + 10)
            }
        }
    }
#undef PH_BEGIN
#undef PH_END
}

#ifndef EN_MASK
#define EN_MASK 0xFFFFu
#endif
template <unsigned EN> static int setup_kernel() {
    if (hipFuncSetAttribute((const void*)trunk_fwd<EN>, hipFuncAttributeMaxDynamicSharedMemorySize, LDS_BYTES) != hipSuccess) { fprintf(stderr, "kernel_launch: hipFuncSetAttribute failed\n"); return -1; }
    int per_cu = 0;
    if (hipOccupancyMaxActiveBlocksPerMultiprocessor(&per_cu, (const void*)trunk_fwd<EN>, NTHREADS, LDS_BYTES) != hipSuccess || per_cu < 1) { fprintf(stderr, "kernel_launch: occupancy query says %d\n", per_cu); }
    (void)hipGetLastError();
    return 0;
}
template <unsigned EN> static void launch_range(const Args& a0, int lo, int hi, int grid, hipStream_t stream) {
    Args a = a0; a.ph_lo = lo; a.ph_hi = hi;
    hipLaunchKernelGGL(trunk_fwd<EN>, dim3(grid), dim3(NTHREADS), LDS_BYTES, stream, a);
}
extern "C" void kernel_launch(void* const* d_in, const int* in_sizes, int n_in, void* d_out, int out_size, void* d_ws, size_t ws_size, hipStream_t stream) {
    static int grid = 0;
    if (grid == 0) {
        if (n_in != 15 || in_sizes[0] != M * DM || out_size != M * DM || ws_size < WS_END) {
            fprintf(stderr, "kernel_launch: shape/workspace mismatch: n_in %d in0 %d out %d ws %zu (need %zu); nothing launched\n", n_in, n_in > 0 ? in_sizes[0] : -1, out_size, ws_size, (size_t)WS_END); grid = -1; return; }
        int dev = 0, cus = 0;
        if (hipGetDevice(&dev) != hipSuccess || hipDeviceGetAttribute(&cus, hipDeviceAttributeMultiprocessorCount, dev) != hipSuccess) { grid = -1; return; }
#if MK_ONE_LAUNCH
        if (setup_kernel<EN_MASK>()) { grid = -1; return; }
#else
        if (setup_kernel<0x1u>() || setup_kernel<0x2u>() || setup_kernel<0x4u>() || setup_kernel<0x8u>() || setup_kernel<0x10u>() || setup_kernel<0x20u>() || setup_kernel<0x40u>() || setup_kernel<0x80u>() ||
            setup_kernel<0x100u>() || setup_kernel<0x200u>() || setup_kernel<0x400u>() || setup_kernel<0x800u>() || setup_kernel<0x1000u>() || setup_kernel<0x2000u>()) { grid = -1; return; }
#endif
        grid = cus;
    }
    if (grid < 0) return;
    if (hipMemsetAsync((char*)d_ws + WS_CTL, 0, CTL_ZERO_BYTES, stream) != hipSuccess) return;
    Args a{};
    for (int i = 0; i < 15; ++i) a.in[i] = (const float*)d_in[i];
    a.out = (float*)d_out; a.ws = (unsigned char*)d_ws;
#if MK_ONE_LAUNCH
    launch_range<EN_MASK>(a, 0, N_PHASES, grid, stream);
#else
    launch_range<0x1u>(a, 0, 1, grid, stream);
    for (int l = 0; l < DEPTH; ++l) { const int base = 1 + l * PH_PER_LAYER;
        for (int f = 0; f < 2; ++f) { const int pb = base + (f ? 11 : 0);
            if (f == 1) {
                launch_range<0x2u>(a, base + 3, base + 4, grid, stream); launch_range<0x10u>(a, base + 4, base + 5, grid, stream); launch_range<0x20u>(a, base + 5, base + 6, grid, stream);
                launch_range<0x40u>(a, base + 6, base + 7, grid, stream); launch_range<0x80u>(a, base + 7, base + 8, grid, stream);
                launch_range<0x100u>(a, base + 8, base + 9, grid, stream); launch_range<0x200u>(a, base + 8, base + 9, grid, stream); launch_range<0x400u>(a, base + 8, base + 9, grid, stream); launch_range<0x800u>(a, base + 8, base + 9, grid, stream);
                launch_range<0x1000u>(a, base + 9, base + 10, grid, stream); launch_range<0x2000u>(a, base + 10, base + 11, grid, stream);
            }
            launch_range<0x2u>(a, pb, pb + 1, grid, stream); launch_range<0x4u>(a, pb + 1, pb + 2, grid, stream); launch_range<0x8u>(a, pb + 2, pb + 3, grid, stream);
        }
    }
#endif
}
```

```cpp
#include <hip/hip_runtime.h>
#include <cstdio>
#include <cstdint>

namespace pg8 {
#define PG8_LAS __attribute__((address_space(3)))
typedef unsigned short bf16_t;
typedef short bf16x8 __attribute__((ext_vector_type(8)));
typedef float f32x4 __attribute__((ext_vector_type(4)));
typedef unsigned u32x4 __attribute__((ext_vector_type(4)));
constexpr int BM = 256, BK = 64, HALF = 128, HTB = HALF * BK * 2  , STAGE_BYTES = 8 * HTB, NXCD = 8, WGM = 8;

__host__ __device__ __forceinline__ int lds_byte(int r, int c) { const int st = (r >> 4) * 2 + (c >> 5), rr = r & 15, cc = c & 31, ob = rr * 64 + cc * 2; return st * 1024 + (ob ^ (((ob >> 9) & 1) << 5)); }
__host__ __device__ __forceinline__ void stage_rc(int b, int& R, int& C) { const int st = b / 1024, sb = b % 1024, swz = sb ^ (((sb >> 9) & 1) << 5); R = (st >> 1) * 16 + swz / 64; C = (st & 1) * 32 + (swz % 64) / 2; }
__host__ __device__ __forceinline__ int perm32(int rho) { const int n = rho >> 4, i = rho & 15; return 8 * (i >> 2) + 4 * n + (i & 3); }

struct Unit { int pm, pn; };
struct Gemm { const bf16_t* A; const bf16_t* Bt; int M, N, K; int scaleA = 127, scaleB = 127; int lda = 0, ldb = 0; int blk = 0; };
typedef int i32x8 __attribute__((ext_vector_type(8))); typedef int i32x4v __attribute__((ext_vector_type(4)));
__device__ __forceinline__ i32x8 pg8_cat(bf16x8 lo, bf16x8 hi) { return __builtin_shufflevector(__builtin_bit_cast(i32x4v, lo), __builtin_bit_cast(i32x4v, hi), 0, 1, 2, 3, 4, 5, 6, 7); }

struct StaticOrder {
    int nM, nN, nwg, G, c;
    __host__ __device__ void init(int M, int N, int G_, int c_) { nM = M / BM; nN = N / BM; nwg = nM * nN; G = G_; c = c_; }
    __host__ __device__ bool next(int i, Unit& u) const {
        const long L = (long)i * G + c; if (L >= nwg) return false;
        int wgid = (int)L; { const int q = nwg / NXCD, r = nwg % NXCD, xcd = wgid % NXCD, off = wgid / NXCD; wgid = (xcd < r ? xcd * (q + 1) : r * (q + 1) + (xcd - r) * q) + off; }
        const int nig = WGM * nN, gid = wgid / nig, fm = gid * WGM, gsz = (nM - fm) < WGM ? (nM - fm) : WGM;
        u.pm = fm + ((wgid % nig) % gsz); u.pn = (wgid % nig) / gsz; return true;
    }
    __device__ __forceinline__ void a_ready(const Unit&) const {}
    __device__ __forceinline__ void done(const Unit&) const {}
};
typedef __bf16 pg8_bfpair __attribute__((ext_vector_type(2))); typedef float pg8_f32pair __attribute__((ext_vector_type(2)));
__device__ __forceinline__ unsigned cvt_pk_bf16(float lo, float hi) { const pg8_f32pair v = {lo, hi}; return __builtin_bit_cast(unsigned, __builtin_convertvector(v, pg8_bfpair)); }
__device__ __forceinline__ unsigned cvt_pk_bf16_nv(float lo, float hi) { return cvt_pk_bf16(lo, hi); }
__device__ __forceinline__ const char* uptr(const char* p) { const unsigned long long v = (unsigned long long)p; const unsigned lo = __builtin_amdgcn_readfirstlane((unsigned)v), hi = __builtin_amdgcn_readfirstlane((unsigned)(v >> 32)); return (const char*)(((unsigned long long)hi << 32) | lo); }
struct EpiBf16 {
    static constexpr bool PERM = true, AFTER_DRAIN = false;
    bf16_t* O; int ldc;
    __device__ __forceinline__ void operator()(const f32x4 (&acc)[2][2][4][2], const Unit& u, int wr, int wc, int fr, int fq) const {
        asm volatile("" : "+v"(fr), "+v"(fq));
        const int row0 = u.pm * BM + wr * 64 + fr; const int col0 = u.pn * BM + wc * 32 + 8 * fq;
#pragma unroll
        for (int ai = 0; ai < 2; ++ai)
#pragma unroll
            for (int m = 0; m < 4; ++m) { bf16_t* rowp = O + (size_t)(row0 + ai * HALF + m * 16) * ldc + col0;
#pragma unroll
                for (int bj = 0; bj < 2; ++bj) { const f32x4 v0 = acc[ai][bj][m][0], v1 = acc[ai][bj][m][1];
                    u32x4 w; w.x = cvt_pk_bf16(v0[0], v0[1]); w.y = cvt_pk_bf16(v0[2], v0[3]); w.z = cvt_pk_bf16(v1[0], v1[1]); w.w = cvt_pk_bf16(v1[2], v1[3]);
                    *(u32x4*)(rowp + bj * HALF) = w; } }
    }
};
__device__ __forceinline__ float silu_mul(float g, float u) { return g * u * __builtin_amdgcn_rcpf(1.0f + __builtin_amdgcn_exp2f(-1.4426950408889634f * g)); }
struct EpiSwiGLU {
    static constexpr bool PERM = true, AFTER_DRAIN = false;
    bf16_t* O; int ldc;
    __device__ __forceinline__ void operator()(const f32x4 (&acc)[2][2][4][2], const Unit& u, int wr, int wc, int fr, int fq) const {
        asm volatile("" : "+v"(fr), "+v"(fq));
        const int row0 = u.pm * BM + wr * 64 + fr; const int col0 = u.pn * HALF + wc * 32 + 8 * fq;
#pragma unroll
        for (int ai = 0; ai < 2; ++ai)
#pragma unroll
            for (int m = 0; m < 4; ++m) { bf16_t* rowp = O + (size_t)(row0 + ai * HALF + m * 16) * ldc + col0;
                const f32x4 g0 = acc[ai][0][m][0], g1 = acc[ai][0][m][1], u0 = acc[ai][1][m][0], u1 = acc[ai][1][m][1];
                u32x4 w; w.x = cvt_pk_bf16(silu_mul(g0[0], u0[0]), silu_mul(g0[1], u0[1])); w.y = cvt_pk_bf16(silu_mul(g0[2], u0[2]), silu_mul(g0[3], u0[3]));
                w.z = cvt_pk_bf16(silu_mul(g1[0], u1[0]), silu_mul(g1[1], u1[1])); w.w = cvt_pk_bf16(silu_mul(g1[2], u1[2]), silu_mul(g1[3], u1[3]));
                *(u32x4*)rowp = w; }
    }
};
template <bool OUT16> struct EpiResid {
    static constexpr bool PERM = false, AFTER_DRAIN = false;
    const bf16_t* base; void* out; int ldc; const float* gv; int gstride; int rows_per_batch; float coef;
    __device__ __forceinline__ void operator()(const f32x4 (&acc)[2][2][4][2], const Unit& u, int wr, int wc, int fr, int fq) const {
        typedef unsigned v2u_ __attribute__((ext_vector_type(2)));
        asm volatile("" : "+v"(fr), "+v"(fq));
        const int row0 = u.pm * BM + wr * 64 + fr; const int col0 = u.pn * BM + wc * 32 + 4 * fq;
        const float* gvec = gv + (size_t)((u.pm * BM) / rows_per_batch) * gstride + col0;
        f32x4 gg[2][2];
#pragma unroll
        for (int bj = 0; bj < 2; ++bj)
#pragma unroll
            for (int n = 0; n < 2; ++n) gg[bj][n] = *(const f32x4*)(gvec + bj * HALF + n * 16) * coef;
#pragma unroll
        for (int ai = 0; ai < 2; ++ai) {
            v2u_ bwv[4][2][2];
#pragma unroll
            for (int m = 0; m < 4; ++m) { const size_t off = (size_t)(row0 + ai * HALF + m * 16) * ldc + col0;
#pragma unroll
                for (int bj = 0; bj < 2; ++bj)
#pragma unroll
                    for (int n = 0; n < 2; ++n) bwv[m][bj][n] = *(const v2u_*)(base + off + bj * HALF + n * 16); }
#pragma unroll
            for (int m = 0; m < 4; ++m) { const size_t off = (size_t)(row0 + ai * HALF + m * 16) * ldc + col0;
#pragma unroll
                for (int bj = 0; bj < 2; ++bj)
#pragma unroll
                    for (int n = 0; n < 2; ++n) { const v2u_ bw = bwv[m][bj][n];
                        f32x4 bs; bs[0] = __builtin_bit_cast(float, bw.x << 16); bs[1] = __builtin_bit_cast(float, bw.x & 0xffff0000u); bs[2] = __builtin_bit_cast(float, bw.y << 16); bs[3] = __builtin_bit_cast(float, bw.y & 0xffff0000u);
                        const f32x4 r = bs + gg[bj][n] * acc[ai][bj][m][n];
                        if constexpr (OUT16) { v2u_ w; w.x = cvt_pk_bf16_nv(r[0], r[1]); w.y = cvt_pk_bf16_nv(r[2], r[3]); *(v2u_*)((bf16_t*)out + off + bj * HALF + n * 16) = w; }
                        else *(f32x4*)((float*)out + off + bj * HALF + n * 16) = r; } }
        }
    }
};
__device__ __forceinline__ unsigned pack_fp8x4(float a, float b, float c, float d) {
    a = fminf(fmaxf(a, -448.f), 448.f); b = fminf(fmaxf(b, -448.f), 448.f); c = fminf(fmaxf(c, -448.f), 448.f); d = fminf(fmaxf(d, -448.f), 448.f);
    int w = 0; w = __builtin_amdgcn_cvt_pk_fp8_f32(a, b, w, false); w = __builtin_amdgcn_cvt_pk_fp8_f32(c, d, w, true); return (unsigned)w; }
struct EpiSwiGLU8 {
    static constexpr bool PERM = true, AFTER_DRAIN = false;
    unsigned char* O; int ldc;
    __device__ __forceinline__ void operator()(const f32x4 (&acc)[2][2][4][2], const Unit& u, int wr, int wc, int fr, int fq) const {
        asm volatile("" : "+v"(fr), "+v"(fq));
        const int row0 = u.pm * BM + wr * 64 + fr; const int col0 = u.pn * HALF + wc * 32 + 8 * fq;
#pragma unroll
        for (int ai = 0; ai < 2; ++ai)
#pragma unroll
            for (int m = 0; m < 4; ++m) { unsigned char* rowp = O + (size_t)(row0 + ai * HALF + m * 16) * ldc + col0;
                const f32x4 g0 = acc[ai][0][m][0], g1 = acc[ai][0][m][1], u0 = acc[ai][1][m][0], u1 = acc[ai][1][m][1];
                typedef unsigned u32x2v __attribute__((ext_vector_type(2))); u32x2v w;
                w.x = pack_fp8x4(silu_mul(g0[0], u0[0]), silu_mul(g0[1], u0[1]), silu_mul(g0[2], u0[2]), silu_mul(g0[3], u0[3]));
                w.y = pack_fp8x4(silu_mul(g1[0], u1[0]), silu_mul(g1[1], u1[1]), silu_mul(g1[2], u1[2]), silu_mul(g1[3], u1[3]));
                *(u32x2v*)rowp = w; }
    }
};
template <class Epi, class Sched, bool ALIGN_EPI = false, bool SP2 = false, bool FP8 = false>
__device__ __forceinline__ void gemm_phase(PG8_LAS unsigned char* lds, const Gemm g, const Sched& S, const Epi& E, int tid_in) {
    int tid_ = tid_in; asm volatile("" : "+v"(tid_));
    const int tid = tid_, wid = __builtin_amdgcn_readfirstlane(tid >> 6), lane = tid & 63, wr = wid >> 2, wc = wid & 3, fr = lane & 15, fq = lane >> 4;
    const int K = g.K, nt = FP8 ? K / (2 * BK) : K / BK;
    const int pitchA = g.blk ? 2 * BK : g.lda ? g.lda : (FP8 ? K : 2 * K), pitchB = g.blk ? 2 * BK : g.ldb ? g.ldb : (FP8 ? K : 2 * K);
    unsigned voffA[2], voffB[2];
#pragma unroll
    for (int i = 0; i < 2; ++i) { int R, C; stage_rc(tid * 16 + i * 8192, R, C); const int Rb = Epi::PERM ? ((R & ~31) + perm32(R & 31)) : R;
        voffA[i] = (unsigned)(R * pitchA + C * 2); voffB[i] = (unsigned)(Rb * pitchB + C * 2); }
    const size_t kstep = g.blk ? (size_t)(512 * BK) : (size_t)(BK * 2);
    const size_t hstepA = (size_t)HALF * pitchA, hstepB = (size_t)HALF * pitchB;
    const size_t tstepA = g.blk ? (size_t)(FP8 ? K / (2 * BK) : K / BK) * kstep : 2 * hstepA, tstepB = g.blk ? tstepA : 2 * hstepB;
    const unsigned ldsw = (unsigned)wid * 1024u;
    const int aoff = lds_byte(wr * 64 + fr, fq * 8), boff = lds_byte(wc * 32 + fr, fq * 8);
    PG8_LAS unsigned char* abase = lds + aoff; PG8_LAS unsigned char* bbase = lds + boff + 4 * HTB;
#define PG8_SA(b, h) (((b) * 2 + (h)) * HTB)
#define PG8_SB(b, h) ((4 + (b) * 2 + (h)) * HTB)
#define PG8_STAGE(bufoff, gbase, voff) do { _Pragma("unroll") for (int _i = 0; _i < 2; ++_i) \
        __builtin_amdgcn_global_load_lds((const unsigned*)((const char*)(gbase) + (voff)[_i]), (PG8_LAS unsigned*)(lds + (bufoff) + ldsw + _i * 8192), 16, 0, 0); } while (0)
#define PG8_RDA(off) (*(const PG8_LAS bf16x8*)(abase + (off)))
#define PG8_RDB(off) (*(const PG8_LAS bf16x8*)(bbase + ((off) - 4 * HTB)))
#define PG8_LDA(dst, b, h) do { if constexpr (FP8) { _Pragma("unroll") for (int m = 0; m < 4; ++m) dst##8[m] = pg8_cat(PG8_RDA(PG8_SA(b, h) + m * 2048), PG8_RDA(PG8_SA(b, h) + m * 2048 + 1024)); } \
    else { _Pragma("unroll") for (int m = 0; m < 4; ++m) _Pragma("unroll") for (int k = 0; k < 2; ++k) dst[m][k] = PG8_RDA(PG8_SA(b, h) + m * 2048 + k * 1024); } } while (0)
#define PG8_LDB(dst, b, h) do { if constexpr (FP8) { _Pragma("unroll") for (int n = 0; n < 2; ++n) dst##8[n] = pg8_cat(PG8_RDB(PG8_SB(b, h) + n * 2048), PG8_RDB(PG8_SB(b, h) + n * 2048 + 1024)); } \
    else { _Pragma("unroll") for (int n = 0; n < 2; ++n) _Pragma("unroll") for (int k = 0; k < 2; ++k) dst[n][k] = PG8_RDB(PG8_SB(b, h) + n * 2048 + k * 1024); } } while (0)
#define PG8_MMA(ai, bj, At, Bt) do { __builtin_amdgcn_s_setprio(1); if constexpr (FP8) { \
        _Pragma("unroll") for (int m = 0; m < 4; ++m) _Pragma("unroll") for (int n = 0; n < 2; ++n) \
            asm volatile("v_mfma_scale_f32_16x16x128_f8f6f4 %0, %1, %2, %0, %3, %4 op_sel_hi:[0,0,0]" : "+v"(acc[ai][bj][m][n]) : "v"(Bt##8[n]), "v"(At##8[m]), "v"(sclB), "v"(sclA)); \
        } else { _Pragma("unroll") for (int m = 0; m < 4; ++m) _Pragma("unroll") for (int n = 0; n < 2; ++n) _Pragma("unroll") for (int k = 0; k < 2; ++k) \
        acc[ai][bj][m][n] = __builtin_amdgcn_mfma_f32_16x16x32_bf16(Bt[n][k], At[m][k], acc[ai][bj][m][n], 0, 0, 0); } __builtin_amdgcn_s_setprio(0); } while (0)
#define PG8_WAIT_V(n) asm volatile("s_waitcnt vmcnt(" #n ")" ::: "memory")
#define PG8_WAIT_L(n) asm volatile("s_waitcnt lgkmcnt(" #n ")" ::: "memory")
#define PG8_BAR __builtin_amdgcn_s_barrier()
#define PG8_SCHED __builtin_amdgcn_sched_barrier(0)
    Unit cur, nxt; int ui = 0;
    if (!S.next(0, cur)) return;
    f32x4 acc[2][2][4][2];
#pragma unroll
    for (int a = 0; a < 2; ++a)
#pragma unroll
        for (int b = 0; b < 2; ++b)
#pragma unroll
            for (int m = 0; m < 4; ++m)
#pragma unroll
                for (int n = 0; n < 2; ++n) acc[a][b][m][n] = (f32x4){0.f, 0.f, 0.f, 0.f};
    const int sclA = g.scaleA, sclB = g.scaleB;
    bf16x8 At[4][2], B0[2][2], B1[2][2]; i32x8 At8[4], B08[2], B18[2];
    const char* cA = uptr((const char*)g.A + (size_t)cur.pm * tstepA); const char* cB = uptr((const char*)g.Bt + (size_t)cur.pn * tstepB);
    S.a_ready(cur);
    if constexpr (SP2) {
        PG8_STAGE(PG8_SB(0, 0), cB, voffB); PG8_STAGE(PG8_SB(0, 1), cB + hstepB, voffB); PG8_STAGE(PG8_SA(0, 0), cA, voffA); PG8_STAGE(PG8_SA(0, 1), cA + hstepA, voffA);
        if (wr == 1) PG8_BAR;
        PG8_WAIT_V(2); PG8_BAR;
        PG8_STAGE(PG8_SB(1, 0), cB + kstep, voffB); PG8_STAGE(PG8_SA(1, 0), cA + kstep, voffA); PG8_STAGE(PG8_SB(1, 1), cB + hstepB + kstep, voffB);
        PG8_WAIT_V(6); PG8_BAR;
    } else {
        PG8_STAGE(PG8_SB(0, 0), cB, voffB); PG8_STAGE(PG8_SA(0, 0), cA, voffA); PG8_STAGE(PG8_SB(0, 1), cB + hstepB, voffB); PG8_STAGE(PG8_SA(0, 1), cA + hstepA, voffA);
        if (wr == 1) PG8_BAR;
        PG8_WAIT_V(4); PG8_BAR;
        PG8_STAGE(PG8_SB(1, 0), cB + kstep, voffB); PG8_STAGE(PG8_SA(1, 0), cA + kstep, voffA); PG8_STAGE(PG8_SB(1, 1), cB + hstepB + kstep, voffB);
        PG8_WAIT_V(6); PG8_BAR;
    }
    for (;;) {
        const bool has_next = S.next(ui + 1, nxt);
        const char* nA = uptr(has_next ? (const char*)g.A + (size_t)nxt.pm * tstepA : cA); const char* nB = uptr(has_next ? (const char*)g.Bt + (size_t)nxt.pn * tstepB : cB);
        for (int t = 0; t < nt; t += 2) {
            asm volatile("" : "+v"(abase), "+v"(bbase));
            const bool last = (t == nt - 2);
            const char* a1 = cA + (size_t)(t + 1) * kstep;
            const char* a2 = uptr(last ? nA : cA + (size_t)(t + 2) * kstep); const char* b2 = uptr(last ? nB : cB + (size_t)(t + 2) * kstep);
            const char* a3 = a2 + kstep; const char* b3 = b2 + kstep;
            if (last && has_next) S.a_ready(nxt);
            if constexpr (SP2) {
            PG8_LDB(B0, 0, 0); PG8_LDB(B1, 0, 1); PG8_SCHED; PG8_LDA(At, 0, 0); PG8_STAGE(PG8_SA(1, 1), a1 + hstepA, voffA);
            PG8_WAIT_V(8); PG8_WAIT_L(0); PG8_BAR; PG8_MMA(0, 0, At, B0); PG8_MMA(0, 1, At, B1); PG8_BAR; PG8_SCHED;
            PG8_LDA(At, 0, 1); PG8_STAGE(PG8_SB(0, 0), b2, voffB); PG8_STAGE(PG8_SB(0, 1), b2 + hstepB, voffB); PG8_STAGE(PG8_SA(0, 0), a2, voffA);
            PG8_WAIT_V(8); PG8_WAIT_L(0); PG8_BAR; PG8_MMA(1, 0, At, B0); PG8_MMA(1, 1, At, B1); PG8_BAR; PG8_SCHED;
            PG8_LDB(B0, 1, 0); PG8_LDB(B1, 1, 1); PG8_SCHED; PG8_LDA(At, 1, 0); PG8_STAGE(PG8_SA(0, 1), a2 + hstepA, voffA);
            PG8_WAIT_V(8); PG8_WAIT_L(0); PG8_BAR; PG8_MMA(0, 0, At, B0); PG8_MMA(0, 1, At, B1); PG8_BAR; PG8_SCHED;
            PG8_LDA(At, 1, 1); PG8_STAGE(PG8_SB(1, 0), b3, voffB); PG8_STAGE(PG8_SB(1, 1), b3 + hstepB, voffB); PG8_STAGE(PG8_SA(1, 0), a3, voffA);
            PG8_WAIT_V(8); PG8_WAIT_L(0); PG8_BAR; PG8_MMA(1, 0, At, B0); PG8_MMA(1, 1, At, B1); PG8_BAR; PG8_SCHED;
            } else {
            PG8_LDB(B0, 0, 0); PG8_SCHED; PG8_LDA(At, 0, 0); PG8_STAGE(PG8_SA(1, 1), a1 + hstepA, voffA);
            PG8_WAIT_L(8); PG8_BAR; PG8_WAIT_L(0); PG8_MMA(0, 0, At, B0); PG8_BAR; PG8_SCHED;
            PG8_LDB(B1, 0, 1); PG8_STAGE(PG8_SB(0, 0), b2, voffB);
            PG8_BAR; PG8_WAIT_L(0); PG8_MMA(0, 1, At, B1); PG8_BAR;
            PG8_LDA(At, 0, 1); PG8_STAGE(PG8_SA(0, 0), a2, voffA);
            PG8_BAR; PG8_WAIT_L(0); PG8_MMA(1, 0, At, B0); PG8_BAR; PG8_SCHED;
            PG8_STAGE(PG8_SB(0, 1), b2 + hstepB, voffB);
            PG8_WAIT_V(6); PG8_BAR; PG8_MMA(1, 1, At, B1); PG8_BAR;
            PG8_LDB(B0, 1, 0); PG8_SCHED; PG8_LDA(At, 1, 0); PG8_STAGE(PG8_SA(0, 1), a2 + hstepA, voffA);
            PG8_WAIT_L(8); PG8_BAR; PG8_WAIT_L(0); PG8_MMA(0, 0, At, B0); PG8_BAR; PG8_SCHED;
            PG8_LDB(B1, 1, 1); PG8_STAGE(PG8_SB(1, 0), b3, voffB);
            PG8_BAR; PG8_WAIT_L(0); PG8_MMA(0, 1, At, B1); PG8_BAR;
            PG8_LDA(At, 1, 1); PG8_STAGE(PG8_SA(1, 0), a3, voffA);
            PG8_BAR; PG8_WAIT_L(0); PG8_MMA(1, 0, At, B0); PG8_BAR; PG8_SCHED;
            PG8_STAGE(PG8_SB(1, 1), b3 + hstepB, voffB);
            PG8_WAIT_V(6); PG8_BAR; PG8_MMA(1, 1, At, B1); PG8_BAR;
            }
        }
        if constexpr (FP8) asm volatile("s_nop 15\n\ts_nop 7" ::: "memory");
        if constexpr (ALIGN_EPI) { if (wr == 0) PG8_BAR; }
        if constexpr (!Epi::AFTER_DRAIN) { E(acc, cur, wr, wc, fr, fq); S.done(cur); }
        if (!has_next) break;
#pragma unroll
        for (int a = 0; a < 2; ++a)
#pragma unroll
            for (int b = 0; b < 2; ++b)
#pragma unroll
                for (int m = 0; m < 4; ++m)
#pragma unroll
                    for (int n = 0; n < 2; ++n) acc[a][b][m][n] = (f32x4){0.f, 0.f, 0.f, 0.f};
        cur = nxt; cA = nA; cB = nB; ++ui;
        if constexpr (ALIGN_EPI) { if (wr == 1) PG8_BAR; }
    }
    PG8_WAIT_V(0);
    if constexpr (!ALIGN_EPI) { if (wr == 0) PG8_BAR; }
    PG8_BAR;
    if constexpr (Epi::AFTER_DRAIN) { E.fused(acc, cur, wr, wc, fr, fq, lds, wid, lane); S.done(cur); }
#undef PG8_SA
#undef PG8_SB
#undef PG8_STAGE
#undef PG8_RDA
#undef PG8_RDB
#undef PG8_LDA
#undef PG8_LDB
#undef PG8_MMA
#undef PG8_WAIT_V
#undef PG8_WAIT_L
#undef PG8_BAR
#undef PG8_SCHED
}
}

#ifndef MK_FFN_FP8
#define MK_FFN_FP8 1
#endif
constexpr bool FFN_FP8 = MK_FFN_FP8;
constexpr int NWAVES = 8, NTHREADS = NWAVES * 64;
constexpr int BATCH = 2, SEQ = 8192, M = BATCH * SEQ, DM = 2048, DEPTH = 4, DFF = 5632, NGU = 2 * DFF, INC = 5976, NIN = 6144, NMOD = 9 * DM;
constexpr int DFFP = DFF + 128;
constexpr int NH = 8, HD = 64, GWID = 512, TOPK = 256, WINDOW = 128;
constexpr int PA_Q = 0, PA_K = 512, PA_V = 576, PA_IQ = 640, PA_IK = 1664, PB_Q = 1728, PB_K = 2240, PB_V = 2304, PC_Q = 2368, PC_K = 2880, PC_V = 3392, PC_G = 3904,
              PD_Q = 4416, PD_K = 4928, PD_V = 5440, PA_IW = 5952, PC_F = 5968;
constexpr float RMS_EPS = 1e-6f, LOG2E = 1.4426950408889634f, QSCALE = 0.125f * LOG2E;

constexpr size_t MiB = 1u << 20;
constexpr size_t WS_CTL = 0, CTL_ZERO_BYTES = 1 * MiB;
constexpr size_t WS_MOD = 1 * MiB;
constexpr size_t WS_LF = 2 * MiB;
constexpr size_t WS_KB2 = 3 * MiB;
constexpr size_t WS_WGU = 4 * MiB;
constexpr size_t SZ_WGU = (size_t)NGU * DM * 2;
constexpr size_t WS_WD = WS_WGU + 8 * SZ_WGU;
constexpr size_t SZ_WD = (size_t)DM * DFF * 2;
constexpr size_t WS_WIN = WS_WD + 8 * SZ_WD;
constexpr size_t SZ_WIN = (size_t)NIN * DM * 2;
constexpr size_t WS_WOUT = WS_WIN + 4 * SZ_WIN;
constexpr size_t SZ_WOUT = (size_t)DM * DM * 2;
constexpr size_t WS_H = WS_WOUT + 4 * SZ_WOUT;
constexpr size_t WS_P = WS_H + (size_t)M * DM * 2;
constexpr size_t WS_Y = WS_P + (size_t)M * NIN * 2;
constexpr size_t WS_IDX = WS_Y + (size_t)M * DM * 2;
constexpr size_t WS_SC = WS_IDX + (size_t)M * TOPK * 4;
constexpr size_t WS_XB = WS_SC + (size_t)BATCH * SEQ * SEQ * 2;
constexpr size_t WS_END = WS_XB + (size_t)M * DM * 2;
static_assert(WS_WGU % MiB == 0 && WS_WD % MiB == 0 && WS_WIN % MiB == 0 && WS_WOUT % MiB == 0 && WS_H % MiB == 0 && WS_P % MiB == 0 && WS_Y % MiB == 0 && WS_IDX % MiB == 0 && WS_SC % MiB == 0, "d_ws map alignment");
constexpr int CW_BAR = 4096;

constexpr int RING_OFF = 0, RING_BYTES = 131072;
constexpr int AUX_OFF = RING_BYTES, AUX_BYTES = 16384;
constexpr int LDSCTL_OFF = AUX_OFF + AUX_BYTES;
constexpr int LDS_BYTES = LDSCTL_OFF + 256;

#define GAS __attribute__((address_space(1)))
#define LAS __attribute__((address_space(3)))
typedef unsigned short bf16;
typedef unsigned v4u __attribute__((ext_vector_type(4)));
typedef unsigned v2u __attribute__((ext_vector_type(2)));
typedef int v4i __attribute__((ext_vector_type(4)));
typedef float f32x4 __attribute__((ext_vector_type(4)));
typedef float f32x16 __attribute__((ext_vector_type(16)));
typedef short bf16x8 __attribute__((ext_vector_type(8)));
typedef short s16x4 __attribute__((ext_vector_type(4)));
typedef GAS unsigned gu32;
#define RLX_AGENT __ATOMIC_RELAXED, __HIP_MEMORY_SCOPE_AGENT
#define LDS_WAIT() asm volatile("s_waitcnt lgkmcnt(0)" ::: "memory")
#define VM_WAIT() asm volatile("s_waitcnt vmcnt(0)" ::: "memory")
__device__ __forceinline__ unsigned f2bf(float f) { unsigned u = __builtin_bit_cast(unsigned, f); return (u + 0x7fffu + ((u >> 16) & 1u)) >> 16; }
__device__ __forceinline__ unsigned pk2(float lo, float hi) { return f2bf(lo) | (f2bf(hi) << 16); }
__device__ __forceinline__ float bf_lo(unsigned w) { return __builtin_bit_cast(float, w << 16); }
__device__ __forceinline__ float bf_hi(unsigned w) { return __builtin_bit_cast(float, w & 0xffff0000u); }
__device__ __forceinline__ float bf2f(bf16 h) { return __builtin_bit_cast(float, (unsigned)h << 16); }
__device__ __forceinline__ float wave_sum(float v) {
#pragma unroll
    for (int o = 1; o < 64; o <<= 1) v += __shfl_xor(v, o);
    return v;
}
__device__ __forceinline__ float fexp2(float x) { return __builtin_amdgcn_exp2f(x); }
__device__ __forceinline__ float frcp(float x) { return __builtin_amdgcn_rcpf(x); }
__device__ const unsigned char kBucketLut[128] = {0, 1, 2, 3, 4, 5, 6, 7, 8, 9, 10, 11, 12, 13, 14, 15, 16, 16, 16, 17, 17, 18, 18, 18, 19, 19, 19, 20, 20, 20, 20, 21, 21, 21, 21, 22, 22, 22, 22, 22,
    23, 23, 23, 23, 23, 23, 24, 24, 24, 24, 24, 24, 25, 25, 25, 25, 25, 25, 25, 26, 26, 26, 26, 26, 26, 26, 26, 27, 27, 27, 27, 27, 27, 27, 27, 27, 27, 28, 28, 28, 28, 28, 28, 28, 28, 28, 28,
    29, 29, 29, 29, 29, 29, 29, 29, 29, 29, 29, 29, 30, 30, 30, 30, 30, 30, 30, 30, 30, 30, 30, 30, 30, 30, 31, 31, 31, 31, 31, 31, 31, 31, 31, 31, 31, 31, 31, 31, 31};

#define XB_TMO      128
#define XB_XCNT(j)  (256  + 64 * (j))
#define XB_XSUB(j)  (1280 + 64 * (j))
#define XB_XGEN(j)  (2304 + 64 * (j))
#define XB_TOP      3328
#define XB_TOPGEN   3392
#define XCD_BAR_WORDS 3456
#define XB_SPIN_CAP (1u << 18)

__device__ __forceinline__ unsigned xb_ld(unsigned* p)              { return __hip_atomic_load((GAS unsigned*)p, __ATOMIC_RELAXED, __HIP_MEMORY_SCOPE_AGENT); }
__device__ __forceinline__ unsigned xb_add(unsigned* p, unsigned v) { return __hip_atomic_fetch_add((GAS unsigned*)p, v, __ATOMIC_RELAXED, __HIP_MEMORY_SCOPE_AGENT); }
__device__ __forceinline__ unsigned xb_xcc_id() { return (unsigned)__builtin_amdgcn_s_getreg((3 << 11) | 20) & 0xFu; }
#define XB_SPIN(cond, bar) do { unsigned _sp = 0; while (cond) { __builtin_amdgcn_s_sleep(1); \
    if ((++_sp & 255u) == 0u) { if (xb_ld(&(bar)[XB_TMO])) break; if (_sp > XB_SPIN_CAP) { xb_add(&(bar)[XB_TMO], 1u); break; } } } } while (0)

struct XcdBarrier {
    unsigned* bar; unsigned x;
    volatile LAS unsigned* st;
};

__device__ __forceinline__ XcdBarrier xcd_barrier_post(unsigned* bar, volatile LAS unsigned* st) {
    XcdBarrier b; b.bar = bar; b.x = xb_xcc_id(); b.st = st;
    if (threadIdx.x == 0) (void)xb_add(&bar[XB_XCNT(b.x)], 1u);
    return b;
}
__device__ __forceinline__ void xcd_barrier_complete(unsigned* bar, unsigned x, unsigned& nloc, unsigned& nx) {
    const unsigned G = gridDim.x * gridDim.y * gridDim.z;
    unsigned sum, cnt, mine, sp = 0u;
    for (;;) {
        sum = 0u; cnt = 0u; mine = 0u;
#pragma unroll
        for (unsigned j = 0; j < 16; ++j) { const unsigned c = xb_ld(&bar[XB_XCNT(j)]); sum += c; cnt += (c > 0u) ? 1u : 0u; mine = (j == x) ? c : mine; }
        if (sum == G) break;
        __builtin_amdgcn_s_sleep(1);
        if ((++sp & 255u) == 0u) { if (xb_ld(&bar[XB_TMO])) break; if (sp > XB_SPIN_CAP) { xb_add(&bar[XB_TMO], 1u); break; } }
    }
    nloc = mine > 0u ? mine : 1u; nx = cnt > 0u ? cnt : 1u;
}

__device__ __forceinline__ void xcd_barrier(const XcdBarrier& b) {
    asm volatile("s_waitcnt vmcnt(0)" ::: "memory");
    __syncthreads();
    if (threadIdx.x == 0) {
        unsigned* bar = b.bar; asm volatile("" : "+s"(bar));
        __builtin_amdgcn_s_waitcnt(0);
        unsigned nloc = b.st[0], nx = b.st[1];
        if (nloc == 0u) { xcd_barrier_complete(bar, b.x, nloc, nx); b.st[0] = nloc; b.st[1] = nx; }
        const unsigned old = xb_add(&bar[XB_XSUB(b.x)], 1u);
        const unsigned gen = old / nloc;
        if (old + 1u == (gen + 1u) * nloc) {
            __builtin_amdgcn_fence(__ATOMIC_RELEASE, "agent");
            asm volatile("s_waitcnt vmcnt(0)" ::: "memory");
            const unsigned og = xb_add(&bar[XB_TOP], 1u);
            const unsigned tg = og / nx;
            if (og + 1u == (tg + 1u) * nx) xb_add(&bar[XB_TOPGEN], 1u);
            else XB_SPIN(xb_ld(&bar[XB_TOPGEN]) == tg, bar);
            __builtin_amdgcn_fence(__ATOMIC_ACQUIRE, "agent");
            xb_add(&bar[XB_XGEN(b.x)], 1u);
            asm volatile("s_waitcnt vmcnt(0)" ::: "memory");
        } else {
            XB_SPIN(xb_ld(&bar[XB_XGEN(b.x)]) == gen, bar);
            __builtin_amdgcn_fence(__ATOMIC_ACQUIRE, "agent");
            asm volatile("s_waitcnt vmcnt(0)" ::: "memory");
        }
    }
    __syncthreads();
}

struct Frame {
    LAS unsigned char* lds;
    gu32* ctl;
    int tid, lane, wave, G, gw, NGW;
    const float *x, *c, *w_ada, *b_ada, *norm_g, *w_in, *qk_g, *forget_b, *sinks, *rel_table, *group_g, *w_out, *w_gate, *w_up, *w_down;
    float* out;
    float *MOD, *LF, *KB2; unsigned short* SC; int* IDX;
    bf16 *WGU, *WD, *WIN, *WOUT, *H, *P, *Y, *XB;
};

template <int MAP> __device__ __forceinline__ int w_rowmap(int n) {
    if (MAP == 1) return 256 * (n >> 7) + (n & 127);
    if (MAP == 2) return 256 * (n >> 7) + 128 + (n & 127);
    if (MAP == 3) { if (n < 1728) return n; if (n < 1744) return PA_IW + (n - 1728); if (n < 3920) return n - 16; if (n < 3928) return PC_F + (n - 3920); return n - 24; }
    return n;
}
template <int MAP> __device__ __forceinline__ void p0_transpose_item(const float* W, int K, int N, bf16* WT, LAS unsigned* T, int item, int lane) {
    const int nblk = (N + 63) / 64, kb = item / nblk, nb = item % nblk, k0 = 64 * kb, n0 = 64 * nb;
    const int r = lane >> 4, c = lane & 15;
    const bool nok = (n0 + 4 * c) < N;
    const float* src = W + (size_t)(k0 + 2 * r) * N + n0 + 4 * c;
    f32x4 a[8], b[8];
#pragma unroll
    for (int i = 0; i < 8; ++i) { a[i] = nok ? *(const GAS f32x4*)(src + (size_t)(8 * i) * N) : (f32x4){0.f, 0.f, 0.f, 0.f}; b[i] = nok ? *(const GAS f32x4*)(src + (size_t)(8 * i + 1) * N) : (f32x4){0.f, 0.f, 0.f, 0.f}; }
#pragma unroll
    for (int i = 0; i < 8; ++i)
#pragma unroll
        for (int e = 0; e < 4; ++e) T[(4 * c + e) * 36 + 4 * i + r] = pk2(a[i][e], b[i][e]);
    LDS_WAIT(); asm volatile("" ::: "memory");
    const int rr = lane >> 3, ch = lane & 7;
#pragma unroll
    for (int j = 0; j < 8; ++j) { const int n = 8 * j + rr; const v4u o = *(const LAS v4u*)(T + n * 36 + 4 * ch);
        if (n0 + n < N) *(GAS v4u*)(WT + (size_t)w_rowmap<MAP>(n0 + n) * K + k0 + 8 * ch) = o; }
    LDS_WAIT(); asm volatile("" ::: "memory");
}
constexpr float W8_SCALE = 64.0f; constexpr int W8_E8M0 = 127 - 6;
__device__ __forceinline__ unsigned pk_fp8x4(float a, float b, float c, float d) {
    a = fminf(fmaxf(a, -448.f), 448.f); b = fminf(fmaxf(b, -448.f), 448.f); c = fminf(fmaxf(c, -448.f), 448.f); d = fminf(fmaxf(d, -448.f), 448.f);
    int w = 0; w = __builtin_amdgcn_cvt_pk_fp8_f32(a, b, w, false); w = __builtin_amdgcn_cvt_pk_fp8_f32(c, d, w, true); return (unsigned)w; }
template <int MAP> __device__ __forceinline__ void p0_transpose8_item(const float* W, int K, int N, unsigned char* WT, int ldw, LAS unsigned* T, int item, int lane) {
    const int nblk = (N + 63) / 64, kb = item / nblk, nb = item % nblk, k0 = 64 * kb, n0 = 64 * nb;
    const int r = lane >> 4, c = lane & 15;
    const bool nok = (n0 + 4 * c) < N;
    const float* src = W + (size_t)(k0 + 4 * r) * N + n0 + 4 * c;
    f32x4 q[4][4];
#pragma unroll
    for (int i = 0; i < 4; ++i)
#pragma unroll
        for (int d = 0; d < 4; ++d) q[i][d] = nok ? *(const GAS f32x4*)(src + (size_t)(16 * i + d) * N) : (f32x4){0.f, 0.f, 0.f, 0.f};
#pragma unroll
    for (int i = 0; i < 4; ++i)
#pragma unroll
        for (int e = 0; e < 4; ++e) T[(4 * c + e) * 20 + 4 * i + r] = pk_fp8x4(q[i][0][e] * W8_SCALE, q[i][1][e] * W8_SCALE, q[i][2][e] * W8_SCALE, q[i][3][e] * W8_SCALE);
    LDS_WAIT(); asm volatile("" ::: "memory");
    const int rr = lane >> 2, ch = lane & 3;
#pragma unroll
    for (int j = 0; j < 4; ++j) { const int n = 16 * j + rr; const v4u o = *(const LAS v4u*)(T + n * 20 + 4 * ch);
        if (n0 + n < N) *(GAS v4u*)(WT + (size_t)w_rowmap<MAP>(n0 + n) * ldw + k0 + 16 * ch) = o; }
    LDS_WAIT(); asm volatile("" ::: "memory");
}
template <int MAP> __device__ __forceinline__ void p0_transpose8(const Frame& F, const float* W, int K, int N, unsigned char* WT, int ldw, LAS unsigned* scr) {
    const int nitems = (K / 64) * ((N + 63) / 64);
    for (int it = F.gw; it < nitems; it += F.NGW) p0_transpose8_item<MAP>(W, K, N, WT, ldw, scr, it, F.lane);
}
template <int MAP> __device__ __forceinline__ void p0_transpose(const Frame& F, const float* W, int K, int N, bf16* WT, LAS unsigned* scr) {
    const int nitems = (K / 64) * ((N + 63) / 64);
    for (int it = F.gw; it < nitems; it += F.NGW) p0_transpose_item<MAP>(W, K, N, WT, scr, it, F.lane);
}
__device__ __forceinline__ void p0_prologue(const Frame& F) {
    LAS unsigned* scr = (LAS unsigned*)(F.lds + RING_OFF + F.wave * 16384);
    LAS float* cond = (LAS float*)(F.lds + AUX_OFF);
    LAS float* red = (LAS float*)(F.lds + RING_OFF);
    for (int i = F.tid; i < BATCH * DM; i += NTHREADS) { const float v = F.c[i]; cond[i] = v / (1.0f + __expf(-v)); }
    __syncthreads();
    for (int it = blockIdx.x; it < DEPTH * (NMOD / 64); it += F.G) {
        const int l = it / (NMOD / 64), n = (it % (NMOD / 64)) * 64 + F.lane;
        const float* w = F.w_ada + (size_t)l * DM * NMOD + (size_t)(256 * F.wave) * NMOD + n;
        const LAS float* c0 = cond + 256 * F.wave; const LAS float* c1 = cond + DM + 256 * F.wave;
        float a0 = 0.f, a1 = 0.f;
#pragma unroll 32
        for (int k = 0; k < 256; ++k) { const float wv = w[(size_t)k * NMOD]; a0 += c0[k] * wv; a1 += c1[k] * wv; }
        red[F.wave * 128 + F.lane] = a0; red[F.wave * 128 + 64 + F.lane] = a1;
        __syncthreads();
        if (F.tid < 128) { float sacc = 0.f;
#pragma unroll
            for (int wv = 0; wv < 8; ++wv) sacc += red[wv * 128 + F.tid];
            const int bsel = F.tid >> 6, nn = (it % (NMOD / 64)) * 64 + (F.tid & 63);
            F.MOD[((size_t)l * BATCH + bsel) * NMOD + nn] = sacc + F.b_ada[(size_t)l * NMOD + nn]; }
        __syncthreads();
    }
    for (int lf = 0; lf < DEPTH * 2; ++lf) {
        if (FFN_FP8) {
            p0_transpose8<1>(F, F.w_gate + (size_t)lf * DM * DFF, DM, DFF, (unsigned char*)F.WGU + (size_t)lf * NGU * DM, DM, scr);
            p0_transpose8<2>(F, F.w_up + (size_t)lf * DM * DFF, DM, DFF, (unsigned char*)F.WGU + (size_t)lf * NGU * DM, DM, scr);
            p0_transpose8<0>(F, F.w_down + (size_t)lf * DFF * DM, DFF, DM, (unsigned char*)F.WD + (size_t)lf * DM * DFFP, DFFP, scr);
        } else {
            p0_transpose<1>(F, F.w_gate + (size_t)lf * DM * DFF, DM, DFF, F.WGU + (size_t)lf * NGU * DM, scr);
            p0_transpose<2>(F, F.w_up + (size_t)lf * DM * DFF, DM, DFF, F.WGU + (size_t)lf * NGU * DM, scr);
            p0_transpose<0>(F, F.w_down + (size_t)lf * DFF * DM, DFF, DM, F.WD + (size_t)lf * DM * DFF, scr);
        }
    }
    for (int l = 0; l < DEPTH; ++l) {
        p0_transpose<3>(F, F.w_in + (size_t)l * DM * INC, DM, INC, F.WIN + (size_t)l * NIN * DM, scr);
        p0_transpose<0>(F, F.w_out + (size_t)l * DM * DM, DM, DM, F.WOUT + (size_t)l * DM * DM, scr);
        GAS v4u* z = (GAS v4u*)(F.WIN + (size_t)l * NIN * DM + (size_t)INC * DM);
        for (int i = F.gw * 64 + F.lane; i < (NIN - INC) * DM / 8; i += F.NGW * 64) z[i] = (v4u){0u, 0u, 0u, 0u};
    }
}

template <bool OUT8, bool IN16> __device__ __forceinline__ void ph_modulate(const Frame& F, const void* xin, const float* g, const float* shift, const float* scale) {
    for (int m = F.gw; m < M; m += F.NGW) {
        const int b = m / SEQ;
        float x[4][8]; float s = 0.f;
        if constexpr (IN16) {
            const GAS v4u* xr = (const GAS v4u*)((const bf16*)xin + (size_t)m * DM) + F.lane;
            v4u w[4];
#pragma unroll
            for (int j = 0; j < 4; ++j) w[j] = xr[64 * j];
#pragma unroll
            for (int j = 0; j < 4; ++j) { x[j][0] = bf_lo(w[j].x); x[j][1] = bf_hi(w[j].x); x[j][2] = bf_lo(w[j].y); x[j][3] = bf_hi(w[j].y); x[j][4] = bf_lo(w[j].z); x[j][5] = bf_hi(w[j].z); x[j][6] = bf_lo(w[j].w); x[j][7] = bf_hi(w[j].w); }
        } else {
            const GAS f32x4* xr = (const GAS f32x4*)((const float*)xin + (size_t)m * DM) + 2 * F.lane;
            f32x4 a[4][2];
#pragma unroll
            for (int j = 0; j < 4; ++j) { a[j][0] = xr[128 * j]; a[j][1] = xr[128 * j + 1]; }
            GAS v4u* xo = (GAS v4u*)(F.XB + (size_t)m * DM) + F.lane;
#pragma unroll
            for (int j = 0; j < 4; ++j) { x[j][0] = a[j][0].x; x[j][1] = a[j][0].y; x[j][2] = a[j][0].z; x[j][3] = a[j][0].w; x[j][4] = a[j][1].x; x[j][5] = a[j][1].y; x[j][6] = a[j][1].z; x[j][7] = a[j][1].w;
                v4u w; w.x = pk2(x[j][0], x[j][1]); w.y = pk2(x[j][2], x[j][3]); w.z = pk2(x[j][4], x[j][5]); w.w = pk2(x[j][6], x[j][7]); xo[64 * j] = w; }
        }
#pragma unroll
        for (int j = 0; j < 4; ++j) s += ((x[j][0] * x[j][0] + x[j][1] * x[j][1]) + (x[j][2] * x[j][2] + x[j][3] * x[j][3])) + ((x[j][4] * x[j][4] + x[j][5] * x[j][5]) + (x[j][6] * x[j][6] + x[j][7] * x[j][7]));
        const float rstd = 1.0f / sqrtf(wave_sum(s) * (1.f / DM) + RMS_EPS);
        const GAS f32x4* gp = (const GAS f32x4*)g + 2 * F.lane; const GAS f32x4* sh = (const GAS f32x4*)(shift + (size_t)b * NMOD) + 2 * F.lane; const GAS f32x4* sc = (const GAS f32x4*)(scale + (size_t)b * NMOD) + 2 * F.lane;
        GAS v4u* o16 = (GAS v4u*)(F.H + (size_t)m * DM) + F.lane;
        GAS v2u* o8 = (GAS v2u*)((unsigned char*)F.H + (size_t)m * DM) + F.lane;
#pragma unroll
        for (int j = 0; j < 4; ++j) { float y[8];
#pragma unroll
            for (int h = 0; h < 2; ++h) { const f32x4 gg = gp[128 * j + h], ss = sc[128 * j + h], hh = sh[128 * j + h];
                y[4 * h + 0] = x[j][4 * h + 0] * rstd * gg.x * (ss.x + 1.0f) + hh.x; y[4 * h + 1] = x[j][4 * h + 1] * rstd * gg.y * (ss.y + 1.0f) + hh.y;
                y[4 * h + 2] = x[j][4 * h + 2] * rstd * gg.z * (ss.z + 1.0f) + hh.z; y[4 * h + 3] = x[j][4 * h + 3] * rstd * gg.w * (ss.w + 1.0f) + hh.w; }
            if (OUT8) { v2u w; w.x = pk_fp8x4(y[0], y[1], y[2], y[3]); w.y = pk_fp8x4(y[4], y[5], y[6], y[7]); o8[64 * j] = w; }
            else { v4u w; w.x = pk2(y[0], y[1]); w.y = pk2(y[2], y[3]); w.z = pk2(y[4], y[5]); w.w = pk2(y[6], y[7]); o16[64 * j] = w; } }
    }
}
__device__ __forceinline__ v4u headnorm8(v4u w, const float* g, float mul, int lane, bool normalize) {
    float x[8] = {bf_lo(w.x), bf_hi(w.x), bf_lo(w.y), bf_hi(w.y), bf_lo(w.z), bf_hi(w.z), bf_lo(w.w), bf_hi(w.w)};
    float r = mul;
    if (normalize) {
        float s = 0.f;
#pragma unroll
        for (int i = 0; i < 8; ++i) s += x[i] * x[i];
        s += __shfl_xor(s, 1); s += __shfl_xor(s, 2); s += __shfl_xor(s, 4);
        r = mul / sqrtf(s * (1.f / 64.f) + RMS_EPS);
        const f32x4 g0 = *(const GAS f32x4*)(g + 8 * (lane & 7)), g1 = *(const GAS f32x4*)(g + 8 * (lane & 7) + 4);
        x[0] *= g0.x; x[1] *= g0.y; x[2] *= g0.z; x[3] *= g0.w; x[4] *= g1.x; x[5] *= g1.y; x[6] *= g1.z; x[7] *= g1.w;
    }
    w.x = pk2(x[0] * r, x[1] * r); w.y = pk2(x[2] * r, x[3] * r); w.z = pk2(x[4] * r, x[5] * r); w.w = pk2(x[6] * r, x[7] * r);
    return w;
}
__device__ __forceinline__ void ph_post(const Frame& F, int l) {
    const float* qg = F.qk_g + (size_t)l * 6 * HD;
    for (int m = F.gw; m < M; m += F.NGW) {
        bf16* row = F.P + (size_t)m * NIN; const int lane = F.lane;
        GAS v4u* paq = (GAS v4u*)(row + PA_Q + 8 * lane); GAS v4u* pbq = (GAS v4u*)(row + PB_Q + 8 * lane); GAS v4u* pcq = (GAS v4u*)(row + PC_Q + 8 * lane);
        GAS v4u* pck = (GAS v4u*)(row + PC_K + 8 * lane); GAS v4u* pdq = (GAS v4u*)(row + PD_Q + 8 * lane);
        GAS v4u* pkk = (GAS v4u*)(row + (lane < 8 ? PA_K : PB_K) + 8 * (lane & 7));
        const v4u waq = *paq, wbq = *pbq, wcq = *pcq, wck = *pck, wdq = *pdq;
        v4u wkk = {0u, 0u, 0u, 0u}; if (lane < 16) wkk = *pkk;
        *paq = headnorm8(waq, qg + 0 * HD, QSCALE, lane, true);
        *pbq = headnorm8(wbq, qg + 2 * HD, QSCALE, lane, true);
        *pcq = headnorm8(wcq, qg + 4 * HD, QSCALE, lane, true);
        *pck = headnorm8(wck, qg + 5 * HD, 1.0f, lane, true);
        *pdq = headnorm8(wdq, qg, QSCALE, lane, false);
        if (lane < 16) *pkk = headnorm8(wkk, qg + (lane < 8 ? 1 : 3) * HD, 1.0f, lane, true);
    }
}
__device__ __forceinline__ void ph_scan(const Frame& F, int l) {
    LAS float* wtot = (LAS float*)(F.lds + RING_OFF);
    for (int sq = blockIdx.x; sq < BATCH * NH; sq += F.G) {
        const int b = sq / NH, h = sq % NH; const float fb = F.forget_b[(size_t)l * NH + h];
        const GAS unsigned short* src = (const GAS unsigned short*)(F.P + ((size_t)b * SEQ + 16 * F.tid) * NIN + PC_F + h); float* dst = F.KB2 + (size_t)sq * SEQ + 16 * F.tid;
        float v[16]; unsigned short raw[16];
#pragma unroll
        for (int i = 0; i < 16; ++i) raw[i] = src[(size_t)i * NIN];
#pragma unroll
        for (int i = 0; i < 16; ++i) { const float y = __builtin_bit_cast(float, (unsigned)raw[i] << 16) + fb; v[i] = (y >= 0.f) ? -log1pf(__expf(-y)) : (y - log1pf(__expf(y))); }
#pragma unroll
        for (int i = 1; i < 16; ++i) v[i] += v[i - 1];
        float incl = v[15];
#pragma unroll
        for (int o = 1; o < 64; o <<= 1) { const float t = __shfl_up(incl, o); if (F.lane >= o) incl += t; }
        if (F.lane == 63) wtot[F.wave] = incl;
        __syncthreads();
        float base = incl - v[15];
        for (int w = 0; w < F.wave; ++w) base += wtot[w];
#pragma unroll
        for (int i = 0; i < 4; ++i) *(GAS f32x4*)(dst + 4 * i) = (f32x4){-(v[4 * i] + base) * LOG2E, -(v[4 * i + 1] + base) * LOG2E, -(v[4 * i + 2] + base) * LOG2E, -(v[4 * i + 3] + base) * LOG2E};
        __syncthreads();
    }
}
__device__ __forceinline__ void ph_gnorm(const Frame& F, int l) {
    const float* gg = F.group_g + (size_t)l * DM;
    for (int m = F.gw; m < M; m += F.NGW) {
        v4u w[4];
#pragma unroll
        for (int g = 0; g < 4; ++g) w[g] = *(GAS v4u*)(F.Y + (size_t)m * DM + g * GWID + 8 * F.lane);
#pragma unroll
        for (int g = 0; g < 4; ++g) {
            bf16* p = F.Y + (size_t)m * DM + g * GWID + 8 * F.lane;
            float x[8] = {bf_lo(w[g].x), bf_hi(w[g].x), bf_lo(w[g].y), bf_hi(w[g].y), bf_lo(w[g].z), bf_hi(w[g].z), bf_lo(w[g].w), bf_hi(w[g].w)};
            float s = 0.f;
#pragma unroll
            for (int i = 0; i < 8; ++i) s += x[i] * x[i];
            const float r = 1.0f / sqrtf(wave_sum(s) * (1.f / GWID) + RMS_EPS);
            const f32x4 g0 = *(const GAS f32x4*)(gg + g * GWID + 8 * F.lane), g1 = *(const GAS f32x4*)(gg + g * GWID + 8 * F.lane + 4);
            v4u o; o.x = pk2(x[0] * r * g0.x, x[1] * r * g0.y); o.y = pk2(x[2] * r * g0.z, x[3] * r * g0.w); o.z = pk2(x[4] * r * g1.x, x[5] * r * g1.y); o.w = pk2(x[6] * r * g1.z, x[7] * r * g1.w);
            *(GAS v4u*)p = o;
        }
    }
}


__device__ __forceinline__ unsigned short score_key(float sc) {
    const _Float16 hf = (_Float16)fminf(fmaxf(sc, -60000.f), 60000.f);
    const unsigned h = (unsigned)__builtin_bit_cast(unsigned short, hf);
    return (unsigned short)((h & 0x8000u) ? (~h & 0xffffu) : (h | 0x8000u));
}
__device__ __forceinline__ void glds16x(const void* gsrc, unsigned lds_dst) { unsigned keep;
    asm volatile("s_mov_b32 %0, m0\n\ts_mov_b32 m0, %2\n\ts_nop 0\n\tglobal_load_lds_dwordx4 %1, off\n\ts_mov_b32 m0, %0" : "=&s"(keep) : "v"(gsrc), "s"(lds_dst) : "memory"); }
__device__ __forceinline__ void ph_idx_scores(const Frame& F) {
    constexpr int UPB = 8 * (16 * 17 / 2), NU = BATCH * UPB;
    const int lane = F.lane, r32 = lane & 31, hi = lane >> 5;
    const int u_lo = (int)(((long)blockIdx.x * NU) / F.G), u_hi = (int)(((long)(blockIdx.x + 1) * NU) / F.G);
    if (u_lo >= u_hi) return;
    int b = u_lo / UPB, qb = 127, kc = 0; { int r = u_lo % UPB; for (;;) { const int n = (qb >> 3) + 1; if (r < n) { kc = r; break; } r -= n; --qb; } }
    LAS unsigned char* KL = F.lds + RING_OFF;
    const unsigned kl_lds = (unsigned)(size_t)KL;
#define X1_STAGE(bb, kk, buf) do { const bf16* ksrc_ = F.P + ((size_t)(bb) * SEQ + 512 * (kk) + 64 * F.wave + lane) * NIN + PA_IK; \
        _Pragma("unroll") for (int c_ = 0; c_ < 8; ++c_) glds16x(ksrc_ + 8 * c_, (unsigned)__builtin_amdgcn_readfirstlane(kl_lds + (buf) * 65536 + c_ * 8192 + F.wave * 1024)); } while (0)
    X1_STAGE(b, kc, 0);
    asm volatile("s_waitcnt vmcnt(0)" ::: "memory"); __syncthreads();
    bf16x8 af[4][4]; float wq[4][16]; int cb = -1, cqb = -1;
    for (int u = u_lo; u < u_hi; ++u) {
        const int cur = (u - u_lo) & 1;
        int nb = b, nqb = qb, nkc = kc + 1; if (nkc > (qb >> 3)) { nkc = 0; --nqb; if (nqb < 0) { nqb = 127; ++nb; } }
        if (u + 1 < u_hi) X1_STAGE(nb, nkc, cur ^ 1);
        const size_t rowb = (size_t)b * SEQ; const int t0 = 64 * qb + 8 * F.wave;
        if (b != cb || qb != cqb) { cb = b; cqb = qb;
#pragma unroll
            for (int pr = 0; pr < 4; ++pr) {
                const bf16* qrow = F.P + (rowb + t0 + 2 * pr + ((r32 >> 2) & 1)) * NIN + PA_IQ + ((r32 & 3) + 4 * (r32 >> 3)) * 64 + 8 * hi;
#pragma unroll
                for (int s = 0; s < 4; ++s) af[pr][s] = *(const GAS bf16x8*)(qrow + 16 * s);
                const bf16* wrow = F.P + (rowb + t0 + 2 * pr + hi) * NIN + PA_IW;
                const v4u w0 = *(const GAS v4u*)wrow, w1 = *(const GAS v4u*)(wrow + 8);
                const unsigned ww[8] = {w0.x, w0.y, w0.z, w0.w, w1.x, w1.y, w1.z, w1.w};
#pragma unroll
                for (int i = 0; i < 8; ++i) { wq[pr][2 * i] = bf_lo(ww[i]) * 0.015625f; wq[pr][2 * i + 1] = bf_hi(ww[i]) * 0.015625f; }
            }
        }
        const int kend = 64 * (qb + 1) - 512 * kc;
        const int nkt = kend >= 512 ? 16 : (kend + 31) / 32;
        const LAS unsigned char* kl = KL + cur * 65536 + hi * 8192 + r32 * 16;
        for (int kt = 0; kt < nkt; ++kt) {
            bf16x8 bfr[4];
#pragma unroll
            for (int s = 0; s < 4; ++s) bfr[s] = *(const LAS bf16x8*)(kl + s * 16384 + kt * 512);
            const int s0 = 512 * kc + 32 * kt;
#pragma unroll
            for (int pr = 0; pr < 4; ++pr) {
                f32x16 acc = {};
#pragma unroll
                for (int s = 0; s < 4; ++s) acc = __builtin_amdgcn_mfma_f32_32x32x16_bf16(af[pr][s], bfr[s], acc, 0, 0, 0);
                float sc0 = 0.f, sc1 = 0.f;
#pragma unroll
                for (int r = 0; r < 16; ++r) { sc0 = __builtin_fmaf(wq[pr][r], acc[r], sc0); sc1 = __builtin_fmaf(wq[pr][r], __builtin_fabsf(acc[r]), sc1); if ((r & 3) == 3) asm("" : "+v"(sc1)); }
                ((GAS unsigned short*)F.SC)[(rowb + t0 + 2 * pr + hi) * SEQ + s0 + r32] = score_key(sc0 + sc1);
                __builtin_amdgcn_sched_barrier(0);
            }
        }
        asm volatile("s_waitcnt vmcnt(0)" ::: "memory");
        __syncthreads();
        b = nb; qb = nqb; kc = nkc;
    }
#undef X1_STAGE
}

__device__ __forceinline__ unsigned mbcnt64(unsigned long long m) { return __builtin_amdgcn_mbcnt_hi((unsigned)(m >> 32), __builtin_amdgcn_mbcnt_lo((unsigned)m, 0u)); }
template <int SH, int PSH> __device__ __forceinline__ void sel_level(const unsigned (&v)[64], int nreg, unsigned pval, unsigned need, LAS unsigned* hist, int lane, unsigned& bin_out, unsigned& above_out) {
#pragma unroll
    for (int i = 0; i < 8; ++i) ((LAS v4u*)hist)[lane + 64 * i] = (v4u){0u, 0u, 0u, 0u};
    LDS_WAIT(); __builtin_amdgcn_wave_barrier();
    const unsigned hb = (unsigned)(size_t)hist, sink = hb + 9216u + 4u * (unsigned)lane;
#pragma unroll
    for (int g = 0; g < 8; ++g) if (8 * g < nreg) {
#pragma unroll
        for (int jj = 0; jj < 8; ++jj) { const int j = 8 * g + jj;
#pragma unroll
            for (int e = 0; e < 2; ++e) { const unsigned k = e ? (v[j] >> 16) : (v[j] & 0xffffu);
                const bool pred = (k != 0u) && (PSH >= 16 || (k >> (PSH & 15)) == pval);
                const unsigned tgt = pred ? hb + (((k >> SH) & 2047u) << 2) : sink;
                __hip_atomic_fetch_add((LAS unsigned*)tgt, 1u, __ATOMIC_RELAXED, __HIP_MEMORY_SCOPE_WAVEFRONT); }
            if ((jj & 1) == 1) __builtin_amdgcn_sched_barrier(0); }
    }
    LDS_WAIT(); __builtin_amdgcn_wave_barrier();
    unsigned S = 0u;
#pragma unroll
    for (int i = 0; i < 8; ++i) { const v4u q = ((LAS v4u*)hist)[lane * 8 + i]; S += (q.x + q.y) + (q.z + q.w); }
    unsigned T = S;
#pragma unroll
    for (int o = 1; o < 64; o <<= 1) { const unsigned t = __shfl_down(T, o); if (lane + o < 64) T += t; }
    const unsigned above_lane = T - S;
    const bool cross = (T >= need) && (above_lane < need);
    unsigned run = above_lane, bin = 0u, ab = 0u; bool found = false;
#pragma unroll
    for (int i = 7; i >= 0; --i) { const v4u q = ((LAS v4u*)hist)[lane * 8 + i]; const unsigned c4[4] = {q.x, q.y, q.z, q.w};
#pragma unroll
        for (int e = 3; e >= 0; --e) { const bool hit = !found && (run + c4[e] >= need); if (hit) { bin = 32u * lane + 4 * i + e; ab = run; found = true; } run += c4[e]; } }
    const unsigned long long cm = __ballot(cross);
    const int src = cm ? (int)__builtin_ctzll(cm) : 0;
    bin_out = __builtin_amdgcn_readlane(bin, src); above_out = __builtin_amdgcn_readlane(ab, src);
    LDS_WAIT(); __builtin_amdgcn_wave_barrier();
}
__device__ __forceinline__ void select_row(const Frame& F, int m, LAS unsigned* hist, LAS int* out) {
    int lane = F.lane; asm volatile("" : "+v"(lane));
    const int t = m % SEQ, n = t + 1;
    if (n <= TOPK) { for (int j = lane; j < TOPK; j += 64) out[j] = (j < n) ? j : 0; return; }
    const int nreg = (n + 127) >> 7;
    unsigned v[64];
    const GAS unsigned* pr = (const GAS unsigned*)(F.SC + (size_t)m * SEQ) + lane;
#pragma unroll
    for (int g = 0; g < 8; ++g) {
        if (8 * g < nreg) {
#pragma unroll
            for (int jj = 0; jj < 8; ++jj) v[8 * g + jj] = pr[jj * 64];
        } else {
#pragma unroll
            for (int jj = 0; jj < 8; ++jj) v[8 * g + jj] = 0u;
        }
        pr += 512; asm volatile("" : "+v"(pr));
    }
    const int nfull = n >> 7;
#pragma unroll
    for (int g = 0; g < 8; ++g) if (8 * g < nreg && 8 * g + 8 > nfull) {
#pragma unroll
        for (int jj = 0; jj < 8; ++jj) { const int j = 8 * g + jj; const int e0 = 128 * j + 2 * lane; const unsigned w = v[j];
            v[j] = ((e0 < n) ? (w & 0xffffu) : 0u) | ((e0 + 1 < n) ? (w & 0xffff0000u) : 0u); asm volatile("" : "+v"(v[j])); }
    }
    unsigned b1, a1, b2, a2;
    sel_level<5, 16>(v, nreg, 0u, (unsigned)TOPK, hist, lane, b1, a1);
    sel_level<0, 5>(v, nreg, b1, (unsigned)TOPK - a1, hist, lane, b2, a2);
    const unsigned tau = (b1 << 5) | (b2 & 31u);
    const unsigned quota = (unsigned)TOPK - a1 - a2;
    unsigned mg[4] = {0u, 0u, 0u, 0u}, me[4] = {0u, 0u, 0u, 0u};
#pragma unroll
    for (int g = 0; g < 8; ++g) {
        if (8 * g < nreg) {
#pragma unroll
            for (int jj = 0; jj < 8; ++jj) { const int j = 8 * g + jj;
#pragma unroll
                for (int e = 0; e < 2; ++e) { const unsigned k = e ? (v[j] >> 16) : (v[j] & 0xffffu);
                    mg[g >> 1] = mg[g >> 1] + mg[g >> 1] + ((k > tau) ? 1u : 0u); me[g >> 1] = me[g >> 1] + me[g >> 1] + ((k == tau) ? 1u : 0u); }
                if ((jj & 3) == 3) __builtin_amdgcn_sched_barrier(0); }
        } else { mg[g >> 1] <<= 16; me[g >> 1] <<= 16; }
    }
    const unsigned cg = (unsigned)(__builtin_popcount(mg[0]) + __builtin_popcount(mg[1]) + __builtin_popcount(mg[2]) + __builtin_popcount(mg[3]));
    unsigned ce = (unsigned)(__builtin_popcount(me[0]) + __builtin_popcount(me[1]) + __builtin_popcount(me[2]) + __builtin_popcount(me[3]));
    unsigned incl = cg | (ce << 16);
#pragma unroll
    for (int o = 1; o < 64; o <<= 1) { const unsigned t = (unsigned)__shfl_up((int)incl, o); if (lane >= o) incl += t; }
    const unsigned excl = incl - (cg | (ce << 16));
    const unsigned pre_g = excl & 0xffffu, pre_e = excl >> 16;
    const unsigned keep = pre_e >= quota ? 0u : ((quota - pre_e) < ce ? (quota - pre_e) : ce);
#pragma unroll
    for (int q = 3; q >= 0; --q) { while (ce > keep && me[q] != 0u) { me[q] &= me[q] - 1u; --ce; } }
    unsigned pos = pre_g + (pre_e < quota ? pre_e : quota);
    const int ilane = 2 * lane;
#pragma unroll
    for (int q = 0; q < 4; ++q) { unsigned mm = mg[q] | me[q];
        while (mm != 0u) { const int bpos = 31 - (int)__builtin_clz(mm); const int sl = 31 - bpos; mm &= ~(1u << bpos);
            const int i = 128 * (16 * q + (sl >> 1)) + ilane + (sl & 1);
            if (pos < (unsigned)TOPK) out[pos] = i;
            ++pos; } }
}


constexpr int AT_K = 0, AT_V = 16384, AT_KB = 32768, AT_WSF = 33280, AT_BT = 35328, AT_DEAD = 35840, AT_SV = 36864;
typedef short v4i16_t __attribute__((ext_vector_type(4)));
__device__ __forceinline__ s16x4 vtr(const LAS unsigned char* p) { return __builtin_bit_cast(s16x4, __builtin_amdgcn_ds_read_tr16_b64_v4i16((LAS v4i16_t*)p)); }
typedef __bf16 bfpair_t __attribute__((ext_vector_type(2))); typedef float f32pair_t __attribute__((ext_vector_type(2)));
__device__ __forceinline__ unsigned cvtpk(float lo, float hi) { const f32pair_t v = {lo, hi}; return __builtin_bit_cast(unsigned, __builtin_convertvector(v, bfpair_t)); }
#define NEG_INF (-__builtin_inff())

template <int TYPE>
__device__ __forceinline__ void dense_attn_unit(const Frame& F, int l, int b, int h, int qb) {
    constexpr int QOFF = TYPE == 1 ? PB_Q : TYPE == 2 ? PC_Q : PD_Q, KOFF = TYPE == 1 ? PB_K : TYPE == 2 ? PC_K : PD_K, VOFF = TYPE == 1 ? PB_V : TYPE == 2 ? PC_V : PD_V;
    constexpr bool MQA = TYPE == 1; constexpr int YOFF = TYPE * GWID;
    const int tid = F.tid, lane = F.lane, wid = F.wave, r32 = lane & 31, hi = lane >> 5;
    LAS unsigned char* L = F.lds + RING_OFF;
    LAS float* wsf = (LAS float*)(L + AT_WSF + wid * 256);
    LAS float* BT = (LAS float*)(L + AT_BT);
    const size_t rowb = (size_t)b * SEQ; const int q0 = qb * 256;
    const bf16* Pk = F.P + rowb * NIN + KOFF + (MQA ? 0 : h * 64);
    const bf16* Pv = F.P + rowb * NIN + VOFF + (MQA ? 0 : h * 64);
    const bf16* Pq = F.P + (rowb + q0 + wid * 32 + r32) * NIN + QOFF + h * 64 + hi * 8;
    bf16x8 qr[4];
#pragma unroll
    for (int d0 = 0; d0 < 4; ++d0) qr[d0] = *(const GAS bf16x8*)(Pq + 16 * d0);
    const int jt_hi = 4 * qb + 3, jt_lo = (TYPE == 1) ? ((4 * qb - 2) > 0 ? (4 * qb - 2) : 0) : 0, nt = jt_hi - jt_lo + 1;
    if (TYPE == 1) { if (tid < 128) BT[tid] = F.rel_table[(int)kBucketLut[tid] * 16 + 8 + h] * LOG2E; }
    const bf16* kgp = Pk + (size_t)lane * NIN + wid * 8;
    const int vkey = tid >> 3, vch = tid & 7;
    const bf16* vgp = Pv + (size_t)vkey * NIN + vch * 8;
    const int kl = wid * 1024 + lane * 16;
    const int vl = (vch >> 2) * 4096 + (vkey >> 3) * 512 + (vkey & 7) * 64 + (vch & 3) * 16;
    const float* kb2 = F.KB2 + ((size_t)b * NH + h) * SEQ;
    v4u kreg = *(const GAS v4u*)(kgp + (size_t)jt_hi * 64 * NIN), vreg = *(const GAS v4u*)(vgp + (size_t)jt_hi * 64 * NIN);
    float kbreg = 0.f; if (TYPE == 2 && tid < 64) kbreg = kb2[jt_hi * 64 + tid];
    *(LAS v4u*)(L + AT_K + kl) = kreg; *(LAS v4u*)(L + AT_V + vl) = vreg; if (TYPE == 2 && tid < 64) ((LAS float*)(L + AT_KB))[tid] = kbreg;
    __syncthreads();
    f32x16 o[2]; o[0] = f32x16{}; o[1] = f32x16{};
    float mrun = NEG_INF, lsum = 0.f, carry = 1.f;
    float qbound = 0.f;
    if (TYPE == 2) {
        float ss = 0.f;
#pragma unroll
        for (int d0 = 0; d0 < 4; ++d0)
#pragma unroll
            for (int j = 0; j < 8; ++j) { const float x = bf2f((bf16)qr[d0][j]); ss += x * x; }
        ss += __shfl_xor(ss, 32);
        float gm = fabsf(F.qk_g[((size_t)l * 6 + 5) * HD + lane]);
#pragma unroll
        for (int o = 1; o < 64; o <<= 1) gm = fmaxf(gm, __shfl_xor(gm, o));
        qbound = sqrtf(ss) * 8.08f * gm;
    }
    const int qrel = 32 * wid + r32;
    const int vb = ((lane >> 4) & 1) * 32 + (lane & 3) * 8 + (4 * hi + ((lane & 15) >> 2)) * 64;
    LAS unsigned* deadf = (LAS unsigned*)(L + AT_DEAD);
    for (int i = 0; i < nt; ++i) {
        const int jt = jt_hi - i, cur = i & 1, jb = jt - 4 * qb; const bool more = (i + 1 < nt);
        float kbnext = 0.f;
        if (more) { kreg = *(const GAS v4u*)(kgp + (size_t)(jt - 1) * 64 * NIN); vreg = *(const GAS v4u*)(vgp + (size_t)(jt - 1) * 64 * NIN); if (TYPE == 2 && tid < 64) kbreg = kb2[(jt - 1) * 64 + tid]; if (TYPE == 2) kbnext = kb2[jt * 64 - 1]; }
        const bool active = (jb <= (wid >> 1)) && (TYPE != 1 || (64 * jb + 63 >= 32 * wid - (WINDOW - 1)));
        if (active) {
            const LAS unsigned char* Kb = L + AT_K + cur * 8192; const LAS unsigned char* Vb = L + AT_V + cur * 8192;
            f32x16 p0 = f32x16{}, p1 = f32x16{};
            bf16x8 ka[4], kc[4];
#pragma unroll
            for (int d0 = 0; d0 < 4; ++d0) { ka[d0] = *(const LAS bf16x8*)(Kb + (2 * d0 + hi) * 1024 + r32 * 16); kc[d0] = *(const LAS bf16x8*)(Kb + (2 * d0 + hi) * 1024 + 512 + r32 * 16); }
            __builtin_amdgcn_sched_barrier(0);
#pragma unroll
            for (int d0 = 0; d0 < 4; ++d0) { p0 = __builtin_amdgcn_mfma_f32_32x32x16_bf16(ka[d0], qr[d0], p0, 0, 0, 0); p1 = __builtin_amdgcn_mfma_f32_32x32x16_bf16(kc[d0], qr[d0], p1, 0, 0, 0); }
            bf16x8 vfr[2][4];
#pragma unroll
            for (int d0 = 0; d0 < 2; ++d0)
#pragma unroll
                for (int ks = 0; ks < 4; ++ks) { const s16x4 lo = vtr(Vb + vb + d0 * 4096 + ks * 1024), hh = vtr(Vb + vb + d0 * 4096 + ks * 1024 + 512);
                    vfr[d0][ks] = (bf16x8){lo[0], lo[1], lo[2], lo[3], hh[0], hh[1], hh[2], hh[3]}; }
            __builtin_amdgcn_sched_barrier(0);
            const int kv0 = 64 * jb + 4 * hi;
            if (TYPE == 3) {
                float b0[16], b1[16];
#pragma unroll
                for (int r = 0; r < 16; ++r) { const int kv = kv0 + (r & 3) + 8 * (r >> 2);
                    const float e0 = fexp2(fminf(p0[r], 80.f)), e1 = fexp2(fminf(p1[r], 80.f));
                    const float m0 = frcp(1.0f + e0), m1 = frcp(1.0f + e1);
                    const bool ok0 = kv < qrel, ok1 = (kv + 32) < qrel;
                    b0[r] = ok0 ? e0 * m0 : 0.f; b1[r] = ok1 ? e1 * m1 : 0.f; p0[r] = ok0 ? m0 : 1.0f; p1[r] = ok1 ? m1 : 1.0f; }
                float gp[8], go[8], pp[8];
#pragma unroll
                for (int g = 0; g < 4; ++g) { gp[g] = (p0[4 * g] * p0[4 * g + 1]) * (p0[4 * g + 2] * p0[4 * g + 3]); gp[4 + g] = (p1[4 * g] * p1[4 * g + 1]) * (p1[4 * g + 2] * p1[4 * g + 3]); }
#pragma unroll
                for (int g = 0; g < 8; ++g) { const float oth = __shfl_xor(gp[g], 32); pp[g] = gp[g] * oth; go[g] = hi ? 1.0f : oth; }
                float sp = 1.0f;
#pragma unroll
                for (int g = 7; g >= 0; --g) { const float sg = sp * go[g] * carry;
                    if (g < 4) { const float c3 = p0[4 * g + 3], c2 = p0[4 * g + 2], c1 = p0[4 * g + 1];
                        p0[4 * g + 3] = b0[4 * g + 3] * sg; const float s2 = sg * c3; p0[4 * g + 2] = b0[4 * g + 2] * s2; const float s1 = s2 * c2; p0[4 * g + 1] = b0[4 * g + 1] * s1; p0[4 * g] = b0[4 * g] * (s1 * c1); }
                    else { const int q = g - 4; const float c3 = p1[4 * q + 3], c2 = p1[4 * q + 2], c1 = p1[4 * q + 1];
                        p1[4 * q + 3] = b1[4 * q + 3] * sg; const float s2 = sg * c3; p1[4 * q + 2] = b1[4 * q + 2] * s2; const float s1 = s2 * c2; p1[4 * q + 1] = b1[4 * q + 1] * s1; p1[4 * q] = b1[4 * q] * (s1 * c1); }
                    sp *= pp[g]; }
                carry *= sp;
            } else {
                if (TYPE == 2) {
                    const LAS f32x4* kbp = (const LAS f32x4*)(L + AT_KB + cur * 256);
#pragma unroll
                    for (int g = 0; g < 4; ++g) { const f32x4 a = kbp[2 * g + hi], c = kbp[8 + 2 * g + hi];
#pragma unroll
                        for (int e = 0; e < 4; ++e) { p0[4 * g + e] += a[e]; p1[4 * g + e] += c[e]; } }
                    if (jb >= 0) {
#pragma unroll
                        for (int r = 0; r < 16; ++r) { const int kv = kv0 + (r & 3) + 8 * (r >> 2); if (kv > qrel) p0[r] = NEG_INF; if (kv + 32 > qrel) p1[r] = NEG_INF; }
                    }
                } else {
#pragma unroll
                    for (int r = 0; r < 16; ++r) { const int d0_ = qrel - (kv0 + (r & 3) + 8 * (r >> 2)), d1_ = d0_ - 32;
                        const bool ok0 = (d0_ >= 0) && (d0_ < WINDOW), ok1 = (d1_ >= 0) && (d1_ < WINDOW);
                        const float t0 = BT[ok0 ? d0_ : 0], t1 = BT[ok1 ? d1_ : 0];
                        p0[r] = ok0 ? p0[r] + t0 : NEG_INF; p1[r] = ok1 ? p1[r] + t1 : NEG_INF; }
                }
                float rm = fmaxf(p0[0], p1[0]);
#pragma unroll
                for (int r = 1; r < 16; ++r) rm = fmaxf(rm, fmaxf(p0[r], p1[r]));
                { auto rr = __builtin_amdgcn_permlane32_swap(__float_as_uint(rm), __float_as_uint(rm), false, false); rm = fmaxf(__uint_as_float(rr[0]), __uint_as_float(rr[1])); }
                const float mn = fmaxf(mrun, rm);
                if (__any(mn > mrun)) {
                    const float f = (mn > mrun) ? fexp2(mrun - mn) : 1.0f;
                    lsum *= f; mrun = mn;
                    if (hi == 0) wsf[r32] = f;
                    LDS_WAIT(); __builtin_amdgcn_wave_barrier();
#pragma unroll
                    for (int g = 0; g < 4; ++g) { const f32x4 fv = ((const LAS f32x4*)wsf)[2 * g + hi];
#pragma unroll
                        for (int e = 0; e < 4; ++e) { o[0][4 * g + e] *= fv[e]; o[1][4 * g + e] *= fv[e]; } }
                    LDS_WAIT(); __builtin_amdgcn_wave_barrier();
                }
                const float ms = (mrun == NEG_INF) ? 0.f : mrun;
                float ps = 0.f;
#pragma unroll
                for (int r = 0; r < 16; ++r) { p0[r] = fexp2(p0[r] - ms); p1[r] = fexp2(p1[r] - ms); ps += p0[r] + p1[r]; }
                lsum += ps;
            }
            bf16x8 pa[4];
#pragma unroll
            for (int ks = 0; ks < 4; ++ks) { v4u w;
                if (ks < 2) { w.x = cvtpk(p0[8 * ks], p0[8 * ks + 1]); w.y = cvtpk(p0[8 * ks + 2], p0[8 * ks + 3]); w.z = cvtpk(p0[8 * ks + 4], p0[8 * ks + 5]); w.w = cvtpk(p0[8 * ks + 6], p0[8 * ks + 7]); }
                else { const int k2 = ks - 2; w.x = cvtpk(p1[8 * k2], p1[8 * k2 + 1]); w.y = cvtpk(p1[8 * k2 + 2], p1[8 * k2 + 3]); w.z = cvtpk(p1[8 * k2 + 4], p1[8 * k2 + 5]); w.w = cvtpk(p1[8 * k2 + 6], p1[8 * k2 + 7]); }
                pa[ks] = __builtin_bit_cast(bf16x8, w); }
#pragma unroll
            for (int d0 = 0; d0 < 2; ++d0)
#pragma unroll
                for (int ks = 0; ks < 4; ++ks) o[d0] = __builtin_amdgcn_mfma_f32_32x32x16_bf16(pa[ks], vfr[d0][ks], o[d0], 0, 0, 0);
        }
        if (TYPE == 2) {
            bool wdead = false;
            if (active && more) wdead = __all(qbound + kbnext - mrun < -40.f);
            if (lane == 0) deadf[cur * 8 + wid] = wdead ? 1u : 0u; }
        if (TYPE == 3) { const bool wdead = active && __all(carry < 2.3e-10f);
            if (lane == 0) deadf[cur * 8 + wid] = wdead ? 1u : 0u; }
        if (more) { *(LAS v4u*)(L + AT_K + (cur ^ 1) * 8192 + kl) = kreg; *(LAS v4u*)(L + AT_V + (cur ^ 1) * 8192 + vl) = vreg; if (TYPE == 2 && tid < 64) ((LAS float*)(L + AT_KB + (cur ^ 1) * 256))[tid] = kbreg; }
        __syncthreads();
        if (TYPE >= 2) { const v4u d0 = *(const LAS v4u*)(deadf + cur * 8), d1 = *(const LAS v4u*)(deadf + cur * 8 + 4);
            if ((d0.x & d0.y & d0.z & d0.w & d1.x & d1.y & d1.z & d1.w) != 0u) break; }
    }
    float inv[16];
    if (TYPE != 3) {
        { auto rr = __builtin_amdgcn_permlane32_swap(__float_as_uint(lsum), __float_as_uint(lsum), false, false); lsum = __uint_as_float(rr[0]) + __uint_as_float(rr[1]); }
        if (TYPE == 1) lsum += fexp2(F.sinks[l * NH + h] * LOG2E - mrun);
        const float il = 1.0f / lsum;
        if (hi == 0) wsf[r32] = il;
        LDS_WAIT(); __builtin_amdgcn_wave_barrier();
#pragma unroll
        for (int g = 0; g < 4; ++g) { const f32x4 fv = ((const LAS f32x4*)wsf)[2 * g + hi]; inv[4 * g] = fv[0]; inv[4 * g + 1] = fv[1]; inv[4 * g + 2] = fv[2]; inv[4 * g + 3] = fv[3]; }
        LDS_WAIT(); __builtin_amdgcn_wave_barrier();
    } else {
#pragma unroll
        for (int r = 0; r < 16; ++r) inv[r] = 1.0f;
    }
    unsigned short gte[2][16];
    if (TYPE == 2) {
#pragma unroll
        for (int d0 = 0; d0 < 2; ++d0)
#pragma unroll
            for (int r = 0; r < 16; ++r) { const int q = (r & 3) + 8 * (r >> 2) + 4 * hi; const size_t mrow = rowb + q0 + wid * 32 + q; gte[d0][r] = ((const GAS unsigned short*)F.P)[mrow * NIN + PC_G + h * 64 + 32 * d0 + r32]; }
    }
#pragma unroll
    for (int d0 = 0; d0 < 2; ++d0)
#pragma unroll
        for (int r = 0; r < 16; ++r) { const int q = (r & 3) + 8 * (r >> 2) + 4 * hi; const size_t mrow = rowb + q0 + wid * 32 + q; const int col = h * 64 + 32 * d0 + r32;
            float val = o[d0][r] * inv[r];
            if (TYPE == 2) val *= frcp(1.0f + fexp2(-LOG2E * __builtin_bit_cast(float, (unsigned)gte[d0][r] << 16)));
            F.Y[mrow * DM + YOFF + col] = (bf16)f2bf(val); }
}

__device__ __forceinline__ void sparse_attn_query(const Frame& F, int m, LAS unsigned char* vch, const LAS float* TBA, const LAS int* idx) {
    int lane = F.lane; asm volatile("" : "+v"(lane));
    const int hh = lane & 15, kg = lane >> 4, t = m % SEQ, b = m / SEQ;
    const size_t rowb = (size_t)b * SEQ;
    const int nsel = (t + 1) < TOPK ? (t + 1) : TOPK, nch = (nsel + 63) >> 6;
    const bf16* qp = F.P + (size_t)m * NIN + PA_Q + (hh & 7) * 64 + 8 * kg;
    const bf16x8 qf0 = *(const GAS bf16x8*)qp, qf1 = *(const GAS bf16x8*)(qp + 32);
    float s[4][4][4];
#pragma unroll
    for (int cp = 0; cp < 2; ++cp) {
        if (2 * cp < nch) {
            bf16x8 kf[8][2];
#pragma unroll
            for (int bb = 0; bb < 8; ++bb) { const int keyA = idx[128 * cp + 16 * bb + hh];
                const bf16* kp = F.P + (rowb + keyA) * NIN + PA_K + 8 * kg;
                kf[bb][0] = *(const GAS bf16x8*)kp; kf[bb][1] = *(const GAS bf16x8*)(kp + 32); }
            __builtin_amdgcn_sched_barrier(0);
#pragma unroll
            for (int bb = 0; bb < 8; ++bb) { const int c = 2 * cp + (bb >> 2), blk = bb & 3, j0 = 64 * c + 16 * blk;
                f32x4 acc = {0.f, 0.f, 0.f, 0.f};
                acc = __builtin_amdgcn_mfma_f32_16x16x32_bf16(kf[bb][0], qf0, acc, 0, 0, 0); acc = __builtin_amdgcn_mfma_f32_16x16x32_bf16(kf[bb][1], qf1, acc, 0, 0, 0);
                const v4i id4 = *(const LAS v4i*)(idx + j0 + 4 * kg);
#pragma unroll
                for (int r = 0; r < 4; ++r) { const int j = j0 + 4 * kg + r; int dist = t - id4[r]; dist = dist < 0 ? 0 : (dist > 128 ? 128 : dist);
                    const float bias = TBA[dist * 8 + (hh & 7)];
                    s[c][blk][r] = (j < nsel) ? acc[r] + bias : NEG_INF; }
            }
        } else {
#pragma unroll
            for (int c = 2 * cp; c < 2 * cp + 2; ++c)
#pragma unroll
                for (int blk = 0; blk < 4; ++blk)
#pragma unroll
                    for (int r = 0; r < 4; ++r) s[c][blk][r] = NEG_INF;
        }
    }
    v4u xv[2][8];
#define SP_VLOAD(c_, X) do { const int keyV_ = idx[64 * (c_) + lane]; const bf16* vp_ = F.P + (rowb + keyV_) * NIN + PA_V; \
        _Pragma("unroll") for (int i_ = 0; i_ < 8; ++i_) X[i_] = *(const GAS v4u*)(vp_ + 8 * i_); } while (0)
    SP_VLOAD(0, xv[0]);
    if (1 < nch) SP_VLOAD(1, xv[1]);
    __builtin_amdgcn_sched_barrier(0);
    float mx = NEG_INF;
#pragma unroll
    for (int c = 0; c < 4; ++c)
#pragma unroll
        for (int blk = 0; blk < 4; ++blk)
#pragma unroll
            for (int r = 0; r < 4; ++r) mx = fmaxf(mx, s[c][blk][r]);
    mx = fmaxf(mx, __shfl_xor(mx, 16)); mx = fmaxf(mx, __shfl_xor(mx, 32));
    float sum = 0.f;
#pragma unroll
    for (int c = 0; c < 4; ++c)
#pragma unroll
        for (int blk = 0; blk < 4; ++blk)
#pragma unroll
            for (int r = 0; r < 4; ++r) { const float p = fexp2(s[c][blk][r] - mx); s[c][blk][r] = p; sum += p; }
    sum += __shfl_xor(sum, 16); sum += __shfl_xor(sum, 32);
    const float inv = 1.0f / sum;
    f32x4 oacc[4];
#pragma unroll
    for (int d = 0; d < 4; ++d) oacc[d] = (f32x4){0.f, 0.f, 0.f, 0.f};
    const int q4 = (lane & 15) >> 2, p4 = lane & 3;
#pragma unroll
    for (int c = 0; c < 4; ++c) {
        if (c < nch) {
#pragma unroll
            for (int i = 0; i < 8; ++i) *(LAS v4u*)(vch + (i >> 2) * 4096 + lane * 64 + (i & 3) * 16) = xv[c & 1][i];
            LDS_WAIT(); __builtin_amdgcn_wave_barrier();
            if (c + 2 < nch) SP_VLOAD(c + 2, xv[c & 1]);
            __builtin_amdgcn_sched_barrier(0);
#pragma unroll
            for (int kp = 0; kp < 2; ++kp) { v4u w; w.x = cvtpk(s[c][2 * kp][0], s[c][2 * kp][1]); w.y = cvtpk(s[c][2 * kp][2], s[c][2 * kp][3]); w.z = cvtpk(s[c][2 * kp + 1][0], s[c][2 * kp + 1][1]); w.w = cvtpk(s[c][2 * kp + 1][2], s[c][2 * kp + 1][3]);
                const bf16x8 pf = __builtin_bit_cast(bf16x8, w);
#pragma unroll
                for (int d = 0; d < 4; ++d) { const LAS unsigned char* a = vch + (d >> 1) * 4096 + (32 * kp + 4 * kg + q4) * 64 + ((d & 1) * 16 + 4 * p4) * 2;
                    const s16x4 lo = vtr(a), hv = vtr(a + 16 * 64);
                    const bf16x8 vf = {lo[0], lo[1], lo[2], lo[3], hv[0], hv[1], hv[2], hv[3]};
                    oacc[d] = __builtin_amdgcn_mfma_f32_16x16x32_bf16(vf, pf, oacc[d], 0, 0, 0); } }
            LDS_WAIT(); __builtin_amdgcn_wave_barrier();
        }
    }
#undef SP_VLOAD
    if (hh < 8) {
#pragma unroll
        for (int d = 0; d < 4; ++d) { v2u w; w.x = pk2(oacc[d][0] * inv, oacc[d][1] * inv); w.y = pk2(oacc[d][2] * inv, oacc[d][3] * inv);
            *(GAS v2u*)(F.Y + (size_t)m * DM + hh * 64 + 16 * d + 4 * kg) = w; }
    }
}

constexpr int CW_QUEUE = 8192;
constexpr int MIX_ITEMS = 2560;
template <unsigned EN> __device__ __forceinline__ void ph_attention(const Frame& F, int l, int qsel = 0) {
    LAS float* TBA = (LAS float*)(F.lds + AUX_OFF);
    for (int i = F.tid; i < 129 * 8; i += NTHREADS) { const int d = i >> 3, hq = i & 7; const int bk = d < 128 ? (int)kBucketLut[d] : 31; TBA[i] = F.rel_table[bk * 16 + hq] * LOG2E; }
    LAS unsigned* qslot = (LAS unsigned*)(F.lds + LDSCTL_OFF + 64);
    LAS unsigned char* wbuf = F.lds + RING_OFF + AT_SV + F.wave * 9472;
    LAS int* idxl = (LAS int*)(wbuf + 8192);
    __syncthreads();
#define MIX_FETCH(it) do { if (F.tid == 0) *qslot = __hip_atomic_fetch_add((unsigned*)(F.ctl + CW_QUEUE + 64 * l + 32 * qsel), 1u, __ATOMIC_RELAXED, __HIP_MEMORY_SCOPE_AGENT); \
        __syncthreads(); it = (int)*qslot; __syncthreads(); } while (0)
    for (int r = (int)blockIdx.x; r < 1024; r += F.G) {
        if (EN & 0x800) {
            const int b = r >> 9, blk = r & 511;
#pragma unroll 1
            for (int k = 0; k < 2; ++k) { const int u = 8 * blk + F.wave; const int t = k ? (SEQ - 1 - u) : u; const int m = b * SEQ + t;
                select_row(F, m, (LAS unsigned*)wbuf, idxl);
                LDS_WAIT(); __builtin_amdgcn_wave_barrier();
#ifdef PROBE_SEL2
                select_row(F, m, (LAS unsigned*)wbuf, idxl); LDS_WAIT(); __builtin_amdgcn_wave_barrier();
#endif
#ifdef PROBE_ATT2
                sparse_attn_query(F, m, wbuf, TBA, idxl); LDS_WAIT(); __builtin_amdgcn_wave_barrier();
#endif
                sparse_attn_query(F, m, wbuf, TBA, idxl);
                LDS_WAIT(); __builtin_amdgcn_wave_barrier(); }
        }
    }
    __syncthreads();
    int it; MIX_FETCH(it); it += 1024;
    while (it < 1536) { const int r = it & 511; if (EN & 0x100) dense_attn_unit<2>(F, l, (r & 15) >> 3, r & 7, 31 - (r >> 4)); MIX_FETCH(it); it += 1024; }
    while (it < 2048) { const int r = it & 511; if (EN & 0x200) dense_attn_unit<3>(F, l, (r & 15) >> 3, r & 7, 31 - (r >> 4)); MIX_FETCH(it); it += 1024; }
    while (it < MIX_ITEMS) { const int r = it & 511; if (EN & 0x400) dense_attn_unit<1>(F, l, (r & 15) >> 3, r & 7, 31 - (r >> 4)); MIX_FETCH(it); it += 1024; }
#undef MIX_FETCH
}


__device__ __forceinline__ const float* gp_(const float* p) {
#if defined(__HIP_DEVICE_COMPILE__)
    __builtin_assume(!__builtin_amdgcn_is_shared((const __attribute__((address_space(0))) void*)p)); __builtin_assume(!__builtin_amdgcn_is_private((const __attribute__((address_space(0))) void*)p));
#endif
    return p; }
#ifndef PROBE_KINDS
#define PROBE_KINDS 0u
#endif
#ifndef PROBE_ATT
#define PROBE_ATT 0xF00u
#endif
#ifndef PROBE_REPS
#define PROBE_REPS 1
#endif
#ifndef MK_ONE_LAUNCH
#define MK_ONE_LAUNCH 1
#endif
constexpr int PH_PER_LAYER = 14, N_PHASES = 1 + DEPTH * PH_PER_LAYER;
struct Args { const float* in[15]; float* out; unsigned char* ws; int ph_lo, ph_hi; };
struct ArgsG { const GAS float* in[15]; GAS float* out; GAS unsigned char* ws; int ph_lo, ph_hi; };
template <unsigned EN> __global__ void __launch_bounds__(NTHREADS, 2) trunk_fwd(Args args) {
    extern __shared__ __attribute__((aligned(16))) unsigned char lds[];
    LAS unsigned char* const ldsb = (LAS unsigned char*)lds;
    const int wave0 = __builtin_amdgcn_readfirstlane((int)threadIdx.x >> 6);
    for (int u = threadIdx.x; u < (LDS_BYTES - LDSCTL_OFF) / 4; u += NTHREADS) ((LAS unsigned*)(ldsb + LDSCTL_OFF))[u] = 0u;
    __syncthreads();
#if MK_ONE_LAUNCH
    constexpr int lo = 0, hi = N_PHASES;
#else
    const int lo = args.ph_lo, hi = args.ph_hi;
#endif
    XcdBarrier bar; bar.bar = (unsigned*)(args.ws + WS_CTL) + CW_BAR; bar.x = 0; bar.st = nullptr;
    if (hi - lo > 1) bar = xcd_barrier_post((unsigned*)(args.ws + WS_CTL) + CW_BAR, (volatile LAS unsigned*)(ldsb + LDSCTL_OFF));
#define GP(p) ((const float*)(p))
#define PH_BEGIN(k, kind) if (lo <= (k) && (k) < hi) { _Pragma("unroll 1") for (int rep_ = 0; rep_ < (((PROBE_KINDS >> (kind)) & 1u) ? PROBE_REPS : 1); ++rep_) { Frame F; { \
        const ArgsG* ka = (const ArgsG*)__builtin_amdgcn_kernarg_segment_ptr(); asm volatile("" : "+s"(ka)); \
        unsigned o_ = ~0u; asm volatile("" : "+s"(o_)); int t_ = wave0 * 64 + (int)__builtin_amdgcn_mbcnt_hi(o_, __builtin_amdgcn_mbcnt_lo(o_, 0u)); asm volatile("" : "+v"(t_)); \
        F.lds = ldsb; F.tid = t_; F.lane = t_ & 63; F.wave = wave0; int gw_ = blockIdx.x * NWAVES + wave0; asm volatile("" : "+s"(gw_)); F.G = gridDim.x; F.gw = gw_; F.NGW = F.G * NWAVES; \
        unsigned char* ws = (unsigned char*)ka->ws; F.ctl = (gu32*)(ws + WS_CTL);     \
        F.x = GP(ka->in[0]); F.c = GP(ka->in[1]); F.w_ada = GP(ka->in[2]); F.b_ada = GP(ka->in[3]); F.norm_g = GP(ka->in[4]); F.w_in = GP(ka->in[5]); F.qk_g = GP(ka->in[6]); F.forget_b = GP(ka->in[7]); \
        F.sinks = GP(ka->in[8]); F.rel_table = GP(ka->in[9]); F.group_g = GP(ka->in[10]); F.w_out = GP(ka->in[11]); F.w_gate = GP(ka->in[12]); F.w_up = GP(ka->in[13]); F.w_down = GP(ka->in[14]); F.out = (float*)ka->out; \
        F.MOD = (float*)(ws + WS_MOD); F.LF = (float*)(ws + WS_LF); F.KB2 = (float*)(ws + WS_KB2); F.SC = (unsigned short*)(ws + WS_SC); F.IDX = (int*)(ws + WS_IDX); \
        F.WGU = (bf16*)(ws + WS_WGU); F.WD = (bf16*)(ws + WS_WD); F.WIN = (bf16*)(ws + WS_WIN); F.WOUT = (bf16*)(ws + WS_WOUT); \
        F.H = (bf16*)(ws + WS_H); F.P = (bf16*)(ws + WS_P); F.Y = (bf16*)(ws + WS_Y); F.XB = (bf16*)(ws + WS_XB); }
#define PH_END(k) if ((k) + 1 < hi) xcd_barrier(bar); } }

    PH_BEGIN(0, 31) if (EN & 1) p0_prologue(F); PH_END(0)

    for (int l = 0; l < DEPTH; ++l) {
        const int base = 1 + l * PH_PER_LAYER;
        for (int sub = 0; sub < 3; ++sub) {
            if (sub != 1) {
                const int f = sub >> 1, pb = base + (f ? 11 : 0), ni = f ? 2 : 0, lf = l * 2 + f;
                PH_BEGIN(pb, (f ? 11 : 0)) if (EN & 2) { const float* modl = F.MOD + (size_t)l * BATCH * NMOD;
                    if (l == 0 && f == 0) ph_modulate<FFN_FP8, false>(F, F.x, F.norm_g + ((size_t)l * 3 + ni) * DM, modl + (3 * ni + 0) * DM, modl + (3 * ni + 1) * DM);
                    else ph_modulate<FFN_FP8, true>(F, F.XB, F.norm_g + ((size_t)l * 3 + ni) * DM, modl + (3 * ni + 0) * DM, modl + (3 * ni + 1) * DM); } PH_END(pb)
                PH_BEGIN(pb + 1, (f ? 12 : 1)) if (EN & 4) {
                    pg8::StaticOrder S; S.init(M, NGU, F.G, (int)blockIdx.x);
                    if constexpr (FFN_FP8) { pg8::Gemm g{F.H, (const bf16*)((const unsigned char*)F.WGU + (size_t)lf * NGU * DM), M, NGU, DM, 127, W8_E8M0};
                        pg8::EpiSwiGLU8 E{(unsigned char*)F.P, DFFP};
                        pg8::gemm_phase<pg8::EpiSwiGLU8, pg8::StaticOrder, true, true, true>(F.lds + RING_OFF, g, S, E, F.tid); }
                    else { pg8::Gemm g{F.H, F.WGU + (size_t)lf * NGU * DM, M, NGU, DM};
                        pg8::EpiSwiGLU E{F.P, DFF};
                        pg8::gemm_phase<pg8::EpiSwiGLU, pg8::StaticOrder, true, true>(F.lds + RING_OFF, g, S, E, F.tid); } } PH_END(pb + 1)
                PH_BEGIN(pb + 2, (f ? 13 : 2)) if (EN & 8) {
                    pg8::Gemm g{F.P, FFN_FP8 ? (const bf16*)((const unsigned char*)F.WD + (size_t)lf * DM * DFFP) : F.WD + (size_t)lf * DM * DFF, M, DM, DFF, 127, FFN_FP8 ? W8_E8M0 : 127, FFN_FP8 ? DFFP : 0, FFN_FP8 ? DFFP : 0}; pg8::StaticOrder S; S.init(M, DM, F.G, (int)blockIdx.x);
                    const float* modl = F.MOD + (size_t)l * BATCH * NMOD;
                    if (l == DEPTH - 1 && f == 1) { pg8::EpiResid<false> E{F.XB, rep_ ? (void*)F.SC : (void*)F.out, DM, modl + (3 * ni + 2) * DM, NMOD, SEQ, 0.5f};
                        pg8::gemm_phase<pg8::EpiResid<false>, pg8::StaticOrder, true, true, FFN_FP8>(F.lds + RING_OFF, g, S, E, F.tid); }
                    else { pg8::EpiResid<true> E{F.XB, rep_ ? (void*)F.SC : (void*)F.XB, DM, modl + (3 * ni + 2) * DM, NMOD, SEQ, 0.5f};
                        pg8::gemm_phase<pg8::EpiResid<true>, pg8::StaticOrder, true, true, FFN_FP8>(F.lds + RING_OFF, g, S, E, F.tid); } } PH_END(pb + 2)
            } else {
                PH_BEGIN(base + 3, 3) if (EN & 2) { const float* modl = F.MOD + (size_t)l * BATCH * NMOD; ph_modulate<false, true>(F, F.XB, F.norm_g + ((size_t)l * 3 + 1) * DM, modl + 3 * DM, modl + 4 * DM); } PH_END(base + 3)
                PH_BEGIN(base + 4, 4) if (EN & 16) {
                    pg8::Gemm g{F.H, F.WIN + (size_t)l * NIN * DM, M, NIN, DM}; pg8::StaticOrder S; S.init(M, NIN, F.G, (int)blockIdx.x);
                    pg8::EpiBf16 E{F.P, NIN};
                    pg8::gemm_phase<pg8::EpiBf16, pg8::StaticOrder, true, true>(F.lds + RING_OFF, g, S, E, F.tid); } PH_END(base + 4)
                PH_BEGIN(base + 6, 6) if (EN & 64) { ph_scan(F, l);
                    int par_ = (int)(blockIdx.x & 1u); asm volatile("" : "+s"(par_));
                    _Pragma("unroll 1") for (int st_ = 0; st_ < 2; ++st_) { if ((st_ ^ par_) == 0) { if (EN & 32) ph_post(F, l); } else ph_idx_scores(F); } } PH_END(base + 6)
                PH_BEGIN(base + 8, 8) if (EN & 0xF00) { if (rep_ == 0) ph_attention<EN>(F, l, 0); else ph_attention<(PROBE_ATT)>(F, l, 1); } PH_END(base + 8)
                PH_BEGIN(base + 9, 9) if (EN & 0x1000) ph_gnorm(F, l); PH_END(base + 9)
                PH_BEGIN(base + 10, 10) if (EN & 0x2000) {
                    pg8::Gemm g{F.Y, F.WOUT + (size_t)l * DM * DM, M, DM, DM}; pg8::StaticOrder S; S.init(M, DM, F.G, (int)blockIdx.x);
                    const float* modl = F.MOD + (size_t)l * BATCH * NMOD;
                    pg8::EpiResid<true> E{F.XB, rep_ ? (void*)F.SC : (void*)F.XB, DM, modl + 5 * DM, NMOD, SEQ, 1.0f};
                    pg8::gemm_phase<pg8::EpiResid<true>, pg8::StaticOrder, true, true>(F.lds + RING_OFF, g, S, E, F.tid); } PH_END(base + 10)
            }
        }
    }
#undef PH_BEGIN
#undef PH_END
}

#ifndef EN_MASK
#define EN_MASK 0xFFFFu
#endif
template <unsigned EN> static int setup_kernel() {
    if (hipFuncSetAttribute((const void*)trunk_fwd<EN>, hipFuncAttributeMaxDynamicSharedMemorySize, LDS_BYTES) != hipSuccess) { fprintf(stderr, "kernel_launch: hipFuncSetAttribute failed\n"); return -1; }
    int per_cu = 0;
    if (hipOccupancyMaxActiveBlocksPerMultiprocessor(&per_cu, (const void*)trunk_fwd<EN>, NTHREADS, LDS_BYTES) != hipSuccess || per_cu < 1) { fprintf(stderr, "kernel_launch: occupancy query says %d\n", per_cu); }
    (void)hipGetLastError();
    return 0;
}
template <unsigned EN> static void launch_range(const Args& a0, int lo, int hi, int grid, hipStream_t stream) {
    Args a = a0; a.ph_lo = lo; a.ph_hi = hi;
    hipLaunchKernelGGL(trunk_fwd<EN>, dim3(grid), dim3(NTHREADS), LDS_BYTES, stream, a);
}
extern "C" void kernel_launch(void* const* d_in, const int* in_sizes, int n_in, void* d_out, int out_size, void* d_ws, size_t ws_size, hipStream_t stream) {
    static int grid = 0;
    if (grid == 0) {
        if (n_in != 15 || in_sizes[0] != M * DM || out_size != M * DM || ws_size < WS_END) {
            fprintf(stderr, "kernel_launch: shape/workspace mismatch: n_in %d in0 %d out %d ws %zu (need %zu); nothing launched\n", n_in, n_in > 0 ? in_sizes[0] : -1, out_size, ws_size, (size_t)WS_END); grid = -1; return; }
        int dev = 0, cus = 0;
        if (hipGetDevice(&dev) != hipSuccess || hipDeviceGetAttribute(&cus, hipDeviceAttributeMultiprocessorCount, dev) != hipSuccess) { grid = -1; return; }
#if MK_ONE_LAUNCH
        if (setup_kernel<EN_MASK>()) { grid = -1; return; }
#else
        if (setup_kernel<0x1u>() || setup_kernel<0x2u>() || setup_kernel<0x4u>() || setup_kernel<0x8u>() || setup_kernel<0x10u>() || setup_kernel<0x20u>() || setup_kernel<0x40u>() || setup_kernel<0x80u>() ||
            setup_kernel<0x100u>() || setup_kernel<0x200u>() || setup_kernel<0x400u>() || setup_kernel<0x800u>() || setup_kernel<0x1000u>() || setup_kernel<0x2000u>()) { grid = -1; return; }
#endif
        grid = cus;
    }
    if (grid < 0) return;
    if (hipMemsetAsync((char*)d_ws + WS_CTL, 0, CTL_ZERO_BYTES, stream) != hipSuccess) return;
    Args a{};
    for (int i = 0; i < 15; ++i) a.in[i] = (const float*)d_in[i];
    a.out = (float*)d_out; a.ws = (unsigned char*)d_ws;
#if MK_ONE_LAUNCH
    launch_range<EN_MASK>(a, 0, N_PHASES, grid, stream);
#else
    launch_range<0x1u>(a, 0, 1, grid, stream);
    for (int l = 0; l < DEPTH; ++l) { const int base = 1 + l * PH_PER_LAYER;
        for (int f = 0; f < 2; ++f) { const int pb = base + (f ? 11 : 0);
            if (f == 1) {
                launch_range<0x2u>(a, base + 3, base + 4, grid, stream); launch_range<0x10u>(a, base + 4, base + 5, grid, stream); launch_range<0x20u>(a, base + 5, base + 6, grid, stream);
                launch_range<0x40u>(a, base + 6, base + 7, grid, stream); launch_range<0x80u>(a, base + 7, base + 8, grid, stream);
                launch_range<0x100u>(a, base + 8, base + 9, grid, stream); launch_range<0x200u>(a, base + 8, base + 9, grid, stream); launch_range<0x400u>(a, base + 8, base + 9, grid, stream); launch_range<0x800u>(a, base + 8, base + 9, grid, stream);
                launch_range<0x1000u>(a, base + 9, base + 10, grid, stream); launch_range<0x2000u>(a, base + 10, base + 11, grid, stream);
            }
            launch_range<0x2u>(a, pb, pb + 1, grid, stream); launch_range<0x4u>(a, pb + 1, pb + 2, grid, stream); launch_range<0x8u>(a, pb + 2, pb + 3, grid, stream);
        }
    }
#endif
}
```

```cpp
#include <hip/hip_runtime.h>
#include <cstdio>
#include <cstdint>

namespace pg8 {
#define PG8_LAS __attribute__((address_space(3)))
typedef unsigned short bf16_t;
typedef short bf16x8 __attribute__((ext_vector_type(8)));
typedef float f32x4 __attribute__((ext_vector_type(4)));
typedef unsigned u32x4 __attribute__((ext_vector_type(4)));
constexpr int BM = 256, BK = 64, HALF = 128, HTB = HALF * BK * 2  , STAGE_BYTES = 8 * HTB, NXCD = 8, WGM = 8;

__host__ __device__ __forceinline__ int lds_byte(int r, int c) { const int st = (r >> 4) * 2 + (c >> 5), rr = r & 15, cc = c & 31, ob = rr * 64 + cc * 2; return st * 1024 + (ob ^ (((ob >> 9) & 1) << 5)); }
__host__ __device__ __forceinline__ void stage_rc(int b, int& R, int& C) { const int st = b / 1024, sb = b % 1024, swz = sb ^ (((sb >> 9) & 1) << 5); R = (st >> 1) * 16 + swz / 64; C = (st & 1) * 32 + (swz % 64) / 2; }
__host__ __device__ __forceinline__ int perm32(int rho) { const int n = rho >> 4, i = rho & 15; return 8 * (i >> 2) + 4 * n + (i & 3); }

struct Unit { int pm, pn; };
struct Gemm { const bf16_t* A; const bf16_t* Bt; int M, N, K; int scaleA = 127, scaleB = 127; int lda = 0, ldb = 0; int blk = 0; };
typedef int i32x8 __attribute__((ext_vector_type(8))); typedef int i32x4v __attribute__((ext_vector_type(4)));
__device__ __forceinline__ i32x8 pg8_cat(bf16x8 lo, bf16x8 hi) { return __builtin_shufflevector(__builtin_bit_cast(i32x4v, lo), __builtin_bit_cast(i32x4v, hi), 0, 1, 2, 3, 4, 5, 6, 7); }

struct StaticOrder {
    int nM, nN, nwg, G, c;
    __host__ __device__ void init(int M, int N, int G_, int c_) { nM = M / BM; nN = N / BM; nwg = nM * nN; G = G_; c = c_; }
    __host__ __device__ bool next(int i, Unit& u) const {
        const long L = (long)i * G + c; if (L >= nwg) return false;
        int wgid = (int)L; { const int q = nwg / NXCD, r = nwg % NXCD, xcd = wgid % NXCD, off = wgid / NXCD; wgid = (xcd < r ? xcd * (q + 1) : r * (q + 1) + (xcd - r) * q) + off; }
        const int nig = WGM * nN, gid = wgid / nig, fm = gid * WGM, gsz = (nM - fm) < WGM ? (nM - fm) : WGM;
        u.pm = fm + ((wgid % nig) % gsz); u.pn = (wgid % nig) / gsz; return true;
    }
    __device__ __forceinline__ void a_ready(const Unit&) const {}
    __device__ __forceinline__ void done(const Unit&) const {}
};
typedef __bf16 pg8_bfpair __attribute__((ext_vector_type(2))); typedef float pg8_f32pair __attribute__((ext_vector_type(2)));
__device__ __forceinline__ unsigned cvt_pk_bf16(float lo, float hi) { const pg8_f32pair v = {lo, hi}; return __builtin_bit_cast(unsigned, __builtin_convertvector(v, pg8_bfpair)); }
__device__ __forceinline__ unsigned cvt_pk_bf16_nv(float lo, float hi) { return cvt_pk_bf16(lo, hi); }
__device__ __forceinline__ const char* uptr(const char* p) { const unsigned long long v = (unsigned long long)p; const unsigned lo = __builtin_amdgcn_readfirstlane((unsigned)v), hi = __builtin_amdgcn_readfirstlane((unsigned)(v >> 32)); return (const char*)(((unsigned long long)hi << 32) | lo); }
struct EpiBf16 {
    static constexpr bool PERM = true, AFTER_DRAIN = false;
    bf16_t* O; int ldc;
    __device__ __forceinline__ void operator()(const f32x4 (&acc)[2][2][4][2], const Unit& u, int wr, int wc, int fr, int fq) const {
        asm volatile("" : "+v"(fr), "+v"(fq));
        const int row0 = u.pm * BM + wr * 64 + fr; const int col0 = u.pn * BM + wc * 32 + 8 * fq;
#pragma unroll
        for (int ai = 0; ai < 2; ++ai)
#pragma unroll
            for (int m = 0; m < 4; ++m) { bf16_t* rowp = O + (size_t)(row0 + ai * HALF + m * 16) * ldc + col0;
#pragma unroll
                for (int bj = 0; bj < 2; ++bj) { const f32x4 v0 = acc[ai][bj][m][0], v1 = acc[ai][bj][m][1];
                    u32x4 w; w.x = cvt_pk_bf16(v0[0], v0[1]); w.y = cvt_pk_bf16(v0[2], v0[3]); w.z = cvt_pk_bf16(v1[0], v1[1]); w.w = cvt_pk_bf16(v1[2], v1[3]);
                    *(u32x4*)(rowp + bj * HALF) = w; } }
    }
};
__device__ __forceinline__ float silu_mul(float g, float u) { return g * u * __builtin_amdgcn_rcpf(1.0f + __builtin_amdgcn_exp2f(-1.4426950408889634f * g)); }
struct EpiSwiGLU {
    static constexpr bool PERM = true, AFTER_DRAIN = false;
    bf16_t* O; int ldc;
    __device__ __forceinline__ void operator()(const f32x4 (&acc)[2][2][4][2], const Unit& u, int wr, int wc, int fr, int fq) const {
        asm volatile("" : "+v"(fr), "+v"(fq));
        const int row0 = u.pm * BM + wr * 64 + fr; const int col0 = u.pn * HALF + wc * 32 + 8 * fq;
#pragma unroll
        for (int ai = 0; ai < 2; ++ai)
#pragma unroll
            for (int m = 0; m < 4; ++m) { bf16_t* rowp = O + (size_t)(row0 + ai * HALF + m * 16) * ldc + col0;
                const f32x4 g0 = acc[ai][0][m][0], g1 = acc[ai][0][m][1], u0 = acc[ai][1][m][0], u1 = acc[ai][1][m][1];
                u32x4 w; w.x = cvt_pk_bf16(silu_mul(g0[0], u0[0]), silu_mul(g0[1], u0[1])); w.y = cvt_pk_bf16(silu_mul(g0[2], u0[2]), silu_mul(g0[3], u0[3]));
                w.z = cvt_pk_bf16(silu_mul(g1[0], u1[0]), silu_mul(g1[1], u1[1])); w.w = cvt_pk_bf16(silu_mul(g1[2], u1[2]), silu_mul(g1[3], u1[3]));
                *(u32x4*)rowp = w; }
    }
};
template <bool OUT16> struct EpiResid {
    static constexpr bool PERM = false, AFTER_DRAIN = false;
    const bf16_t* base; void* out; int ldc; const float* gv; int gstride; int rows_per_batch; float coef;
    __device__ __forceinline__ void operator()(const f32x4 (&acc)[2][2][4][2], const Unit& u, int wr, int wc, int fr, int fq) const {
        typedef unsigned v2u_ __attribute__((ext_vector_type(2)));
        asm volatile("" : "+v"(fr), "+v"(fq));
        const int row0 = u.pm * BM + wr * 64 + fr; const int col0 = u.pn * BM + wc * 32 + 4 * fq;
        const float* gvec = gv + (size_t)((u.pm * BM) / rows_per_batch) * gstride + col0;
        f32x4 gg[2][2];
#pragma unroll
        for (int bj = 0; bj < 2; ++bj)
#pragma unroll
            for (int n = 0; n < 2; ++n) gg[bj][n] = *(const f32x4*)(gvec + bj * HALF + n * 16) * coef;
#pragma unroll
        for (int ai = 0; ai < 2; ++ai) {
            v2u_ bwv[4][2][2];
#pragma unroll
            for (int m = 0; m < 4; ++m) { const size_t off = (size_t)(row0 + ai * HALF + m * 16) * ldc + col0;
#pragma unroll
                for (int bj = 0; bj < 2; ++bj)
#pragma unroll
                    for (int n = 0; n < 2; ++n) bwv[m][bj][n] = *(const v2u_*)(base + off + bj * HALF + n * 16); }
#pragma unroll
            for (int m = 0; m < 4; ++m) { const size_t off = (size_t)(row0 + ai * HALF + m * 16) * ldc + col0;
#pragma unroll
                for (int bj = 0; bj < 2; ++bj)
#pragma unroll
                    for (int n = 0; n < 2; ++n) { const v2u_ bw = bwv[m][bj][n];
                        f32x4 bs; bs[0] = __builtin_bit_cast(float, bw.x << 16); bs[1] = __builtin_bit_cast(float, bw.x & 0xffff0000u); bs[2] = __builtin_bit_cast(float, bw.y << 16); bs[3] = __builtin_bit_cast(float, bw.y & 0xffff0000u);
                        const f32x4 r = bs + gg[bj][n] * acc[ai][bj][m][n];
                        if constexpr (OUT16) { v2u_ w; w.x = cvt_pk_bf16_nv(r[0], r[1]); w.y = cvt_pk_bf16_nv(r[2], r[3]); *(v2u_*)((bf16_t*)out + off + bj * HALF + n * 16) = w; }
                        else *(f32x4*)((float*)out + off + bj * HALF + n * 16) = r; } }
        }
    }
};
__device__ __forceinline__ unsigned pack_fp8x4(float a, float b, float c, float d) {
    a = fminf(fmaxf(a, -448.f), 448.f); b = fminf(fmaxf(b, -448.f), 448.f); c = fminf(fmaxf(c, -448.f), 448.f); d = fminf(fmaxf(d, -448.f), 448.f);
    int w = 0; w = __builtin_amdgcn_cvt_pk_fp8_f32(a, b, w, false); w = __builtin_amdgcn_cvt_pk_fp8_f32(c, d, w, true); return (unsigned)w; }
struct EpiSwiGLU8 {
    static constexpr bool PERM = true, AFTER_DRAIN = false;
    unsigned char* O; int ldc;
    __device__ __forceinline__ void operator()(const f32x4 (&acc)[2][2][4][2], const Unit& u, int wr, int wc, int fr, int fq) const {
        asm volatile("" : "+v"(fr), "+v"(fq));
        const int row0 = u.pm * BM + wr * 64 + fr; const int col0 = u.pn * HALF + wc * 32 + 8 * fq;
#pragma unroll
        for (int ai = 0; ai < 2; ++ai)
#pragma unroll
            for (int m = 0; m < 4; ++m) { unsigned char* rowp = O + (size_t)(row0 + ai * HALF + m * 16) * ldc + col0;
                const f32x4 g0 = acc[ai][0][m][0], g1 = acc[ai][0][m][1], u0 = acc[ai][1][m][0], u1 = acc[ai][1][m][1];
                typedef unsigned u32x2v __attribute__((ext_vector_type(2))); u32x2v w;
                w.x = pack_fp8x4(silu_mul(g0[0], u0[0]), silu_mul(g0[1], u0[1]), silu_mul(g0[2], u0[2]), silu_mul(g0[3], u0[3]));
                w.y = pack_fp8x4(silu_mul(g1[0], u1[0]), silu_mul(g1[1], u1[1]), silu_mul(g1[2], u1[2]), silu_mul(g1[3], u1[3]));
                *(u32x2v*)rowp = w; }
    }
};
template <class Epi, class Sched, bool ALIGN_EPI = false, bool SP2 = false, bool FP8 = false>
__device__ __forceinline__ void gemm_phase(PG8_LAS unsigned char* lds, const Gemm g, const Sched& S, const Epi& E, int tid_in) {
    int tid_ = tid_in; asm volatile("" : "+v"(tid_));
    const int tid = tid_, wid = __builtin_amdgcn_readfirstlane(tid >> 6), lane = tid & 63, wr = wid >> 2, wc = wid & 3, fr = lane & 15, fq = lane >> 4;
    const int K = g.K, nt = FP8 ? K / (2 * BK) : K / BK;
    const int pitchA = g.blk ? 2 * BK : g.lda ? g.lda : (FP8 ? K : 2 * K), pitchB = g.blk ? 2 * BK : g.ldb ? g.ldb : (FP8 ? K : 2 * K);
    unsigned voffA[2], voffB[2];
#pragma unroll
    for (int i = 0; i < 2; ++i) { int R, C; stage_rc(tid * 16 + i * 8192, R, C); const int Rb = Epi::PERM ? ((R & ~31) + perm32(R & 31)) : R;
        voffA[i] = (unsigned)(R * pitchA + C * 2); voffB[i] = (unsigned)(Rb * pitchB + C * 2); }
    const size_t kstep = g.blk ? (size_t)(512 * BK) : (size_t)(BK * 2);
    const size_t hstepA = (size_t)HALF * pitchA, hstepB = (size_t)HALF * pitchB;
    const size_t tstepA = g.blk ? (size_t)(FP8 ? K / (2 * BK) : K / BK) * kstep : 2 * hstepA, tstepB = g.blk ? tstepA : 2 * hstepB;
    const unsigned ldsw = (unsigned)wid * 1024u;
    const int aoff = lds_byte(wr * 64 + fr, fq * 8), boff = lds_byte(wc * 32 + fr, fq * 8);
    PG8_LAS unsigned char* abase = lds + aoff; PG8_LAS unsigned char* bbase = lds + boff + 4 * HTB;
#define PG8_SA(b, h) (((b) * 2 + (h)) * HTB)
#define PG8_SB(b, h) ((4 + (b) * 2 + (h)) * HTB)
#define PG8_STAGE(bufoff, gbase, voff) do { _Pragma("unroll") for (int _i = 0; _i < 2; ++_i) \
        __builtin_amdgcn_global_load_lds((const unsigned*)((const char*)(gbase) + (voff)[_i]), (PG8_LAS unsigned*)(lds + (bufoff) + ldsw + _i * 8192), 16, 0, 0); } while (0)
#define PG8_RDA(off) (*(const PG8_LAS bf16x8*)(abase + (off)))
#define PG8_RDB(off) (*(const PG8_LAS bf16x8*)(bbase + ((off) - 4 * HTB)))
#define PG8_LDA(dst, b, h) do { if constexpr (FP8) { _Pragma("unroll") for (int m = 0; m < 4; ++m) dst##8[m] = pg8_cat(PG8_RDA(PG8_SA(b, h) + m * 2048), PG8_RDA(PG8_SA(b, h) + m * 2048 + 1024)); } \
    else { _Pragma("unroll") for (int m = 0; m < 4; ++m) _Pragma("unroll") for (int k = 0; k < 2; ++k) dst[m][k] = PG8_RDA(PG8_SA(b, h) + m * 2048 + k * 1024); } } while (0)
#define PG8_LDB(dst, b, h) do { if constexpr (FP8) { _Pragma("unroll") for (int n = 0; n < 2; ++n) dst##8[n] = pg8_cat(PG8_RDB(PG8_SB(b, h) + n * 2048), PG8_RDB(PG8_SB(b, h) + n * 2048 + 1024)); } \
    else { _Pragma("unroll") for (int n = 0; n < 2; ++n) _Pragma("unroll") for (int k = 0; k < 2; ++k) dst[n][k] = PG8_RDB(PG8_SB(b, h) + n * 2048 + k * 1024); } } while (0)
#define PG8_MMA(ai, bj, At, Bt) do { __builtin_amdgcn_s_setprio(1); if constexpr (FP8) { \
        _Pragma("unroll") for (int m = 0; m < 4; ++m) _Pragma("unroll") for (int n = 0; n < 2; ++n) \
            asm volatile("v_mfma_scale_f32_16x16x128_f8f6f4 %0, %1, %2, %0, %3, %4 op_sel_hi:[0,0,0]" : "+v"(acc[ai][bj][m][n]) : "v"(Bt##8[n]), "v"(At##8[m]), "v"(sclB), "v"(sclA)); \
        } else { _Pragma("unroll") for (int m = 0; m < 4; ++m) _Pragma("unroll") for (int n = 0; n < 2; ++n) _Pragma("unroll") for (int k = 0; k < 2; ++k) \
        acc[ai][bj][m][n] = __builtin_amdgcn_mfma_f32_16x16x32_bf16(Bt[n][k], At[m][k], acc[ai][bj][m][n], 0, 0, 0); } __builtin_amdgcn_s_setprio(0); } while (0)
#define PG8_WAIT_V(n) asm volatile("s_waitcnt vmcnt(" #n ")" ::: "memory")
#define PG8_WAIT_L(n) asm volatile("s_waitcnt lgkmcnt(" #n ")" ::: "memory")
#define PG8_BAR __builtin_amdgcn_s_barrier()
#define PG8_SCHED __builtin_amdgcn_sched_barrier(0)
    Unit cur, nxt; int ui = 0;
    if (!S.next(0, cur)) return;
    f32x4 acc[2][2][4][2];
#pragma unroll
    for (int a = 0; a < 2; ++a)
#pragma unroll
        for (int b = 0; b < 2; ++b)
#pragma unroll
            for (int m = 0; m < 4; ++m)
#pragma unroll
                for (int n = 0; n < 2; ++n) acc[a][b][m][n] = (f32x4){0.f, 0.f, 0.f, 0.f};
    const int sclA = g.scaleA, sclB = g.scaleB;
    bf16x8 At[4][2], B0[2][2], B1[2][2]; i32x8 At8[4], B08[2], B18[2];
    const char* cA = uptr((const char*)g.A + (size_t)cur.pm * tstepA); const char* cB = uptr((const char*)g.Bt + (size_t)cur.pn * tstepB);
    S.a_ready(cur);
    if constexpr (SP2) {
        PG8_STAGE(PG8_SB(0, 0), cB, voffB); PG8_STAGE(PG8_SB(0, 1), cB + hstepB, voffB); PG8_STAGE(PG8_SA(0, 0), cA, voffA); PG8_STAGE(PG8_SA(0, 1), cA + hstepA, voffA);
        if (wr == 1) PG8_BAR;
        PG8_WAIT_V(2); PG8_BAR;
        PG8_STAGE(PG8_SB(1, 0), cB + kstep, voffB); PG8_STAGE(PG8_SA(1, 0), cA + kstep, voffA); PG8_STAGE(PG8_SB(1, 1), cB + hstepB + kstep, voffB);
        PG8_WAIT_V(6); PG8_BAR;
    } else {
        PG8_STAGE(PG8_SB(0, 0), cB, voffB); PG8_STAGE(PG8_SA(0, 0), cA, voffA); PG8_STAGE(PG8_SB(0, 1), cB + hstepB, voffB); PG8_STAGE(PG8_SA(0, 1), cA + hstepA, voffA);
        if (wr == 1) PG8_BAR;
        PG8_WAIT_V(4); PG8_BAR;
        PG8_STAGE(PG8_SB(1, 0), cB + kstep, voffB); PG8_STAGE(PG8_SA(1, 0), cA + kstep, voffA); PG8_STAGE(PG8_SB(1, 1), cB + hstepB + kstep, voffB);
        PG8_WAIT_V(6); PG8_BAR;
    }
    for (;;) {
        const bool has_next = S.next(ui + 1, nxt);
        const char* nA = uptr(has_next ? (const char*)g.A + (size_t)nxt.pm * tstepA : cA); const char* nB = uptr(has_next ? (const char*)g.Bt + (size_t)nxt.pn * tstepB : cB);
        for (int t = 0; t < nt; t += 2) {
            asm volatile("" : "+v"(abase), "+v"(bbase));
            const bool last = (t == nt - 2);
            const char* a1 = cA + (size_t)(t + 1) * kstep;
            const char* a2 = uptr(last ? nA : cA + (size_t)(t + 2) * kstep); const char* b2 = uptr(last ? nB : cB + (size_t)(t + 2) * kstep);
            const char* a3 = a2 + kstep; const char* b3 = b2 + kstep;
            if (last && has_next) S.a_ready(nxt);
            if constexpr (SP2) {
            PG8_LDB(B0, 0, 0); PG8_LDB(B1, 0, 1); PG8_SCHED; PG8_LDA(At, 0, 0); PG8_STAGE(PG8_SA(1, 1), a1 + hstepA, voffA);
            PG8_WAIT_V(8); PG8_WAIT_L(0); PG8_BAR; PG8_MMA(0, 0, At, B0); PG8_MMA(0, 1, At, B1); PG8_BAR; PG8_SCHED;
            PG8_LDA(At, 0, 1); PG8_STAGE(PG8_SB(0, 0), b2, voffB); PG8_STAGE(PG8_SB(0, 1), b2 + hstepB, voffB); PG8_STAGE(PG8_SA(0, 0), a2, voffA);
            PG8_WAIT_V(8); PG8_WAIT_L(0); PG8_BAR; PG8_MMA(1, 0, At, B0); PG8_MMA(1, 1, At, B1); PG8_BAR; PG8_SCHED;
            PG8_LDB(B0, 1, 0); PG8_LDB(B1, 1, 1); PG8_SCHED; PG8_LDA(At, 1, 0); PG8_STAGE(PG8_SA(0, 1), a2 + hstepA, voffA);
            PG8_WAIT_V(8); PG8_WAIT_L(0); PG8_BAR; PG8_MMA(0, 0, At, B0); PG8_MMA(0, 1, At, B1); PG8_BAR; PG8_SCHED;
            PG8_LDA(At, 1, 1); PG8_STAGE(PG8_SB(1, 0), b3, voffB); PG8_STAGE(PG8_SB(1, 1), b3 + hstepB, voffB); PG8_STAGE(PG8_SA(1, 0), a3, voffA);
            PG8_WAIT_V(8); PG8_WAIT_L(0); PG8_BAR; PG8_MMA(1, 0, At, B0); PG8_MMA(1, 1, At, B1); PG8_BAR; PG8_SCHED;
            } else {
            PG8_LDB(B0, 0, 0); PG8_SCHED; PG8_LDA(At, 0, 0); PG8_STAGE(PG8_SA(1, 1), a1 + hstepA, voffA);
            PG8_WAIT_L(8); PG8_BAR; PG8_WAIT_L(0); PG8_MMA(0, 0, At, B0); PG8_BAR; PG8_SCHED;
            PG8_LDB(B1, 0, 1); PG8_STAGE(PG8_SB(0, 0), b2, voffB);
            PG8_BAR; PG8_WAIT_L(0); PG8_MMA(0, 1, At, B1); PG8_BAR;
            PG8_LDA(At, 0, 1); PG8_STAGE(PG8_SA(0, 0), a2, voffA);
            PG8_BAR; PG8_WAIT_L(0); PG8_MMA(1, 0, At, B0); PG8_BAR; PG8_SCHED;
            PG8_STAGE(PG8_SB(0, 1), b2 + hstepB, voffB);
            PG8_WAIT_V(6); PG8_BAR; PG8_MMA(1, 1, At, B1); PG8_BAR;
            PG8_LDB(B0, 1, 0); PG8_SCHED; PG8_LDA(At, 1, 0); PG8_STAGE(PG8_SA(0, 1), a2 + hstepA, voffA);
            PG8_WAIT_L(8); PG8_BAR; PG8_WAIT_L(0); PG8_MMA(0, 0, At, B0); PG8_BAR; PG8_SCHED;
            PG8_LDB(B1, 1, 1); PG8_STAGE(PG8_SB(1, 0), b3, voffB);
            PG8_BAR; PG8_WAIT_L(0); PG8_MMA(0, 1, At, B1); PG8_BAR;
            PG8_LDA(At, 1, 1); PG8_STAGE(PG8_SA(1, 0), a3, voffA);
            PG8_BAR; PG8_WAIT_L(0); PG8_MMA(1, 0, At, B0); PG8_BAR; PG8_SCHED;
            PG8_STAGE(PG8_SB(1, 1), b3 + hstepB, voffB);
            PG8_WAIT_V(6); PG8_BAR; PG8_MMA(1, 1, At, B1); PG8_BAR;
            }
        }
        if constexpr (FP8) asm volatile("s_nop 15\n\ts_nop 7" ::: "memory");
        if constexpr (ALIGN_EPI) { if (wr == 0) PG8_BAR; }
        if constexpr (!Epi::AFTER_DRAIN) { E(acc, cur, wr, wc, fr, fq); S.done(cur); }
        if (!has_next) break;
#pragma unroll
        for (int a = 0; a < 2; ++a)
#pragma unroll
            for (int b = 0; b < 2; ++b)
#pragma unroll
                for (int m = 0; m < 4; ++m)
#pragma unroll
                    for (int n = 0; n < 2; ++n) acc[a][b][m][n] = (f32x4){0.f, 0.f, 0.f, 0.f};
        cur = nxt; cA = nA; cB = nB; ++ui;
        if constexpr (ALIGN_EPI) { if (wr == 1) PG8_BAR; }
    }
    PG8_WAIT_V(0);
    if constexpr (!ALIGN_EPI) { if (wr == 0) PG8_BAR; }
    PG8_BAR;
    if constexpr (Epi::AFTER_DRAIN) { E.fused(acc, cur, wr, wc, fr, fq, lds, wid, lane); S.done(cur); }
#undef PG8_SA
#undef PG8_SB
#undef PG8_STAGE
#undef PG8_RDA
#undef PG8_RDB
#undef PG8_LDA
#undef PG8_LDB
#undef PG8_MMA
#undef PG8_WAIT_V
#undef PG8_WAIT_L
#undef PG8_BAR
#undef PG8_SCHED
}
}

#ifndef MK_FFN_FP8
#define MK_FFN_FP8 1
#endif
constexpr bool FFN_FP8 = MK_FFN_FP8;
constexpr int NWAVES = 8, NTHREADS = NWAVES * 64;
constexpr int BATCH = 2, SEQ = 8192, M = BATCH * SEQ, DM = 2048, DEPTH = 4, DFF = 5632, NGU = 2 * DFF, INC = 5976, NIN = 6144, NMOD = 9 * DM;
constexpr int DFFP = DFF + 128;
constexpr int NH = 8, HD = 64, GWID = 512, TOPK = 256, WINDOW = 128;
constexpr int PA_Q = 0, PA_K = 512, PA_V = 576, PA_IQ = 640, PA_IK = 1664, PB_Q = 1728, PB_K = 2240, PB_V = 2304, PC_Q = 2368, PC_K = 2880, PC_V = 3392, PC_G = 3904,
              PD_Q = 4416, PD_K = 4928, PD_V = 5440, PA_IW = 5952, PC_F = 5968;
constexpr float RMS_EPS = 1e-6f, LOG2E = 1.4426950408889634f, QSCALE = 0.125f * LOG2E;

constexpr size_t MiB = 1u << 20;
constexpr size_t WS_CTL = 0, CTL_ZERO_BYTES = 1 * MiB;
constexpr size_t WS_MOD = 1 * MiB;
constexpr size_t WS_LF = 2 * MiB;
constexpr size_t WS_KB2 = 3 * MiB;
constexpr size_t WS_WGU = 4 * MiB;
constexpr size_t SZ_WGU = (size_t)NGU * DM * 2;
constexpr size_t WS_WD = WS_WGU + 8 * SZ_WGU;
constexpr size_t SZ_WD = (size_t)DM * DFF * 2;
constexpr size_t WS_WIN = WS_WD + 8 * SZ_WD;
constexpr size_t SZ_WIN = (size_t)NIN * DM * 2;
constexpr size_t WS_WOUT = WS_WIN + 4 * SZ_WIN;
constexpr size_t SZ_WOUT = (size_t)DM * DM * 2;
constexpr size_t WS_H = WS_WOUT + 4 * SZ_WOUT;
constexpr size_t WS_P = WS_H + (size_t)M * DM * 2;
constexpr size_t WS_Y = WS_P + (size_t)M * NIN * 2;
constexpr size_t WS_IDX = WS_Y + (size_t)M * DM * 2;
constexpr size_t WS_SC = WS_IDX + (size_t)M * TOPK * 4;
constexpr size_t WS_XB = WS_SC + (size_t)BATCH * SEQ * SEQ * 2;
constexpr size_t WS_END = WS_XB + (size_t)M * DM * 2;
static_assert(WS_WGU % MiB == 0 && WS_WD % MiB == 0 && WS_WIN % MiB == 0 && WS_WOUT % MiB == 0 && WS_H % MiB == 0 && WS_P % MiB == 0 && WS_Y % MiB == 0 && WS_IDX % MiB == 0 && WS_SC % MiB == 0, "d_ws map alignment");
constexpr int CW_BAR = 4096;

constexpr int RING_OFF = 0, RING_BYTES = 131072;
constexpr int AUX_OFF = RING_BYTES, AUX_BYTES = 16384;
constexpr int LDSCTL_OFF = AUX_OFF + AUX_BYTES;
constexpr int LDS_BYTES = LDSCTL_OFF + 256;

#define GAS __attribute__((address_space(1)))
#define LAS __attribute__((address_space(3)))
typedef unsigned short bf16;
typedef unsigned v4u __attribute__((ext_vector_type(4)));
typedef unsigned v2u __attribute__((ext_vector_type(2)));
typedef int v4i __attribute__((ext_vector_type(4)));
typedef float f32x4 __attribute__((ext_vector_type(4)));
typedef float f32x16 __attribute__((ext_vector_type(16)));
typedef short bf16x8 __attribute__((ext_vector_type(8)));
typedef short s16x4 __attribute__((ext_vector_type(4)));
typedef GAS unsigned gu32;
#define RLX_AGENT __ATOMIC_RELAXED, __HIP_MEMORY_SCOPE_AGENT
#define LDS_WAIT() asm volatile("s_waitcnt lgkmcnt(0)" ::: "memory")
#define VM_WAIT() asm volatile("s_waitcnt vmcnt(0)" ::: "memory")
__device__ __forceinline__ unsigned f2bf(float f) { unsigned u = __builtin_bit_cast(unsigned, f); return (u + 0x7fffu + ((u >> 16) & 1u)) >> 16; }
__device__ __forceinline__ unsigned pk2(float lo, float hi) { return f2bf(lo) | (f2bf(hi) << 16); }
__device__ __forceinline__ float bf_lo(unsigned w) { return __builtin_bit_cast(float, w << 16); }
__device__ __forceinline__ float bf_hi(unsigned w) { return __builtin_bit_cast(float, w & 0xffff0000u); }
__device__ __forceinline__ float bf2f(bf16 h) { return __builtin_bit_cast(float, (unsigned)h << 16); }
__device__ __forceinline__ float wave_sum(float v) {
#pragma unroll
    for (int o = 1; o < 64; o <<= 1) v += __shfl_xor(v, o);
    return v;
}
__device__ __forceinline__ float fexp2(float x) { return __builtin_amdgcn_exp2f(x); }
__device__ __forceinline__ float frcp(float x) { return __builtin_amdgcn_rcpf(x); }
__device__ const unsigned char kBucketLut[128] = {0, 1, 2, 3, 4, 5, 6, 7, 8, 9, 10, 11, 12, 13, 14, 15, 16, 16, 16, 17, 17, 18, 18, 18, 19, 19, 19, 20, 20, 20, 20, 21, 21, 21, 21, 22, 22, 22, 22, 22,
    23, 23, 23, 23, 23, 23, 24, 24, 24, 24, 24, 24, 25, 25, 25, 25, 25, 25, 25, 26, 26, 26, 26, 26, 26, 26, 26, 27, 27, 27, 27, 27, 27, 27, 27, 27, 27, 28, 28, 28, 28, 28, 28, 28, 28, 28, 28,
    29, 29, 29, 29, 29, 29, 29, 29, 29, 29, 29, 29, 30, 30, 30, 30, 30, 30, 30, 30, 30, 30, 30, 30, 30, 30, 31, 31, 31, 31, 31, 31, 31, 31, 31, 31, 31, 31, 31, 31, 31};

#define XB_TMO      128
#define XB_XCNT(j)  (256  + 64 * (j))
#define XB_XSUB(j)  (1280 + 64 * (j))
#define XB_XGEN(j)  (2304 + 64 * (j))
#define XB_TOP      3328
#define XB_TOPGEN   3392
#define XCD_BAR_WORDS 3456
#define XB_SPIN_CAP (1u << 18)

__device__ __forceinline__ unsigned xb_ld(unsigned* p)              { return __hip_atomic_load((GAS unsigned*)p, __ATOMIC_RELAXED, __HIP_MEMORY_SCOPE_AGENT); }
__device__ __forceinline__ unsigned xb_add(unsigned* p, unsigned v) { return __hip_atomic_fetch_add((GAS unsigned*)p, v, __ATOMIC_RELAXED, __HIP_MEMORY_SCOPE_AGENT); }
__device__ __forceinline__ unsigned xb_xcc_id() { return (unsigned)__builtin_amdgcn_s_getreg((3 << 11) | 20) & 0xFu; }
#define XB_SPIN(cond, bar) do { unsigned _sp = 0; while (cond) { __builtin_amdgcn_s_sleep(1); \
    if ((++_sp & 255u) == 0u) { if (xb_ld(&(bar)[XB_TMO])) break; if (_sp > XB_SPIN_CAP) { xb_add(&(bar)[XB_TMO], 1u); break; } } } } while (0)

struct XcdBarrier {
    unsigned* bar; unsigned x;
    volatile LAS unsigned* st;
};

__device__ __forceinline__ XcdBarrier xcd_barrier_post(unsigned* bar, volatile LAS unsigned* st) {
    XcdBarrier b; b.bar = bar; b.x = xb_xcc_id(); b.st = st;
    if (threadIdx.x == 0) (void)xb_add(&bar[XB_XCNT(b.x)], 1u);
    return b;
}
__device__ __forceinline__ void xcd_barrier_complete(unsigned* bar, unsigned x, unsigned& nloc, unsigned& nx) {
    const unsigned G = gridDim.x * gridDim.y * gridDim.z;
    unsigned sum, cnt, mine, sp = 0u;
    for (;;) {
        sum = 0u; cnt = 0u; mine = 0u;
#pragma unroll
        for (unsigned j = 0; j < 16; ++j) { const unsigned c = xb_ld(&bar[XB_XCNT(j)]); sum += c; cnt += (c > 0u) ? 1u : 0u; mine = (j == x) ? c : mine; }
        if (sum == G) break;
        __builtin_amdgcn_s_sleep(1);
        if ((++sp & 255u) == 0u) { if (xb_ld(&bar[XB_TMO])) break; if (sp > XB_SPIN_CAP) { xb_add(&bar[XB_TMO], 1u); break; } }
    }
    nloc = mine > 0u ? mine : 1u; nx = cnt > 0u ? cnt : 1u;
}

__device__ __forceinline__ void xcd_barrier(const XcdBarrier& b) {
    asm volatile("s_waitcnt vmcnt(0)" ::: "memory");
    __syncthreads();
    if (threadIdx.x == 0) {
        unsigned* bar = b.bar; asm volatile("" : "+s"(bar));
        __builtin_amdgcn_s_waitcnt(0);
        unsigned nloc = b.st[0], nx = b.st[1];
        if (nloc == 0u) { xcd_barrier_complete(bar, b.x, nloc, nx); b.st[0] = nloc; b.st[1] = nx; }
        const unsigned old = xb_add(&bar[XB_XSUB(b.x)], 1u);
        const unsigned gen = old / nloc;
        if (old + 1u == (gen + 1u) * nloc) {
            __builtin_amdgcn_fence(__ATOMIC_RELEASE, "agent");
            asm volatile("s_waitcnt vmcnt(0)" ::: "memory");
            const unsigned og = xb_add(&bar[XB_TOP], 1u);
            const unsigned tg = og / nx;
            if (og + 1u == (tg + 1u) * nx) xb_add(&bar[XB_TOPGEN], 1u);
            else XB_SPIN(xb_ld(&bar[XB_TOPGEN]) == tg, bar);
            __builtin_amdgcn_fence(__ATOMIC_ACQUIRE, "agent");
            xb_add(&bar[XB_XGEN(b.x)], 1u);
            asm volatile("s_waitcnt vmcnt(0)" ::: "memory");
        } else {
            XB_SPIN(xb_ld(&bar[XB_XGEN(b.x)]) == gen, bar);
            __builtin_amdgcn_fence(__ATOMIC_ACQUIRE, "agent");
            asm volatile("s_waitcnt vmcnt(0)" ::: "memory");
        }
    }
    __syncthreads();
}

struct Frame {
    LAS unsigned char* lds;
    gu32* ctl;
    int tid, lane, wave, G, gw, NGW;
    const float *x, *c, *w_ada, *b_ada, *norm_g, *w_in, *qk_g, *forget_b, *sinks, *rel_table, *group_g, *w_out, *w_gate, *w_up, *w_down;
    float* out;
    float *MOD, *LF, *KB2; unsigned short* SC; int* IDX;
    bf16 *WGU, *WD, *WIN, *WOUT, *H, *P, *Y, *XB;
};

template <int MAP> __device__ __forceinline__ int w_rowmap(int n) {
    if (MAP == 1) return 256 * (n >> 7) + (n & 127);
    if (MAP == 2) return 256 * (n >> 7) + 128 + (n & 127);
    if (MAP == 3) { if (n < 1728) return n; if (n < 1744) return PA_IW + (n - 1728); if (n < 3920) return n - 16; if (n < 3928) return PC_F + (n - 3920); return n - 24; }
    return n;
}
template <int MAP> __device__ __forceinline__ void p0_transpose_item(const float* W, int K, int N, bf16* WT, LAS unsigned* T, int item, int lane) {
    const int nblk = (N + 63) / 64, kb = item / nblk, nb = item % nblk, k0 = 64 * kb, n0 = 64 * nb;
    const int r = lane >> 4, c = lane & 15;
    const bool nok = (n0 + 4 * c) < N;
    const float* src = W + (size_t)(k0 + 2 * r) * N + n0 + 4 * c;
    f32x4 a[8], b[8];
#pragma unroll
    for (int i = 0; i < 8; ++i) { a[i] = nok ? *(const GAS f32x4*)(src + (size_t)(8 * i) * N) : (f32x4){0.f, 0.f, 0.f, 0.f}; b[i] = nok ? *(const GAS f32x4*)(src + (size_t)(8 * i + 1) * N) : (f32x4){0.f, 0.f, 0.f, 0.f}; }
#pragma unroll
    for (int i = 0; i < 8; ++i)
#pragma unroll
        for (int e = 0; e < 4; ++e) T[(4 * c + e) * 36 + 4 * i + r] = pk2(a[i][e], b[i][e]);
    LDS_WAIT(); asm volatile("" ::: "memory");
    const int rr = lane >> 3, ch = lane & 7;
#pragma unroll
    for (int j = 0; j < 8; ++j) { const int n = 8 * j + rr; const v4u o = *(const LAS v4u*)(T + n * 36 + 4 * ch);
        if (n0 + n < N) *(GAS v4u*)(WT + (size_t)w_rowmap<MAP>(n0 + n) * K + k0 + 8 * ch) = o; }
    LDS_WAIT(); asm volatile("" ::: "memory");
}
constexpr float W8_SCALE = 64.0f; constexpr int W8_E8M0 = 127 - 6;
__device__ __forceinline__ unsigned pk_fp8x4(float a, float b, float c, float d) {
    a = fminf(fmaxf(a, -448.f), 448.f); b = fminf(fmaxf(b, -448.f), 448.f); c = fminf(fmaxf(c, -448.f), 448.f); d = fminf(fmaxf(d, -448.f), 448.f);
    int w = 0; w = __builtin_amdgcn_cvt_pk_fp8_f32(a, b, w, false); w = __builtin_amdgcn_cvt_pk_fp8_f32(c, d, w, true); return (unsigned)w; }
template <int MAP> __device__ __forceinline__ void p0_transpose8_item(const float* W, int K, int N, unsigned char* WT, int ldw, LAS unsigned* T, int item, int lane) {
    const int nblk = (N + 63) / 64, kb = item / nblk, nb = item % nblk, k0 = 64 * kb, n0 = 64 * nb;
    const int r = lane >> 4, c = lane & 15;
    const bool nok = (n0 + 4 * c) < N;
    const float* src = W + (size_t)(k0 + 4 * r) * N + n0 + 4 * c;
    f32x4 q[4][4];
#pragma unroll
    for (int i = 0; i < 4; ++i)
#pragma unroll
        for (int d = 0; d < 4; ++d) q[i][d] = nok ? *(const GAS f32x4*)(src + (size_t)(16 * i + d) * N) : (f32x4){0.f, 0.f, 0.f, 0.f};
#pragma unroll
    for (int i = 0; i < 4; ++i)
#pragma unroll
        for (int e = 0; e < 4; ++e) T[(4 * c + e) * 20 + 4 * i + r] = pk_fp8x4(q[i][0][e] * W8_SCALE, q[i][1][e] * W8_SCALE, q[i][2][e] * W8_SCALE, q[i][3][e] * W8_SCALE);
    LDS_WAIT(); asm volatile("" ::: "memory");
    const int rr = lane >> 2, ch = lane & 3;
#pragma unroll
    for (int j = 0; j < 4; ++j) { const int n = 16 * j + rr; const v4u o = *(const LAS v4u*)(T + n * 20 + 4 * ch);
        if (n0 + n < N) *(GAS v4u*)(WT + (size_t)w_rowmap<MAP>(n0 + n) * ldw + k0 + 16 * ch) = o; }
    LDS_WAIT(); asm volatile("" ::: "memory");
}
template <int MAP> __device__ __forceinline__ void p0_transpose8(const Frame& F, const float* W, int K, int N, unsigned char* WT, int ldw, LAS unsigned* scr) {
    const int nitems = (K / 64) * ((N + 63) / 64);
    for (int it = F.gw; it < nitems; it += F.NGW) p0_transpose8_item<MAP>(W, K, N, WT, ldw, scr, it, F.lane);
}
template <int MAP> __device__ __forceinline__ void p0_transpose(const Frame& F, const float* W, int K, int N, bf16* WT, LAS unsigned* scr) {
    const int nitems = (K / 64) * ((N + 63) / 64);
    for (int it = F.gw; it < nitems; it += F.NGW) p0_transpose_item<MAP>(W, K, N, WT, scr, it, F.lane);
}
__device__ __forceinline__ void p0_prologue(const Frame& F) {
    LAS unsigned* scr = (LAS unsigned*)(F.lds + RING_OFF + F.wave * 16384);
    LAS float* cond = (LAS float*)(F.lds + AUX_OFF);
    LAS float* red = (LAS float*)(F.lds + RING_OFF);
    for (int i = F.tid; i < BATCH * DM; i += NTHREADS) { const float v = F.c[i]; cond[i] = v / (1.0f + __expf(-v)); }
    __syncthreads();
    for (int it = blockIdx.x; it < DEPTH * (NMOD / 64); it += F.G) {
        const int l = it / (NMOD / 64), n = (it % (NMOD / 64)) * 64 + F.lane;
        const float* w = F.w_ada + (size_t)l * DM * NMOD + (size_t)(256 * F.wave) * NMOD + n;
        const LAS float* c0 = cond + 256 * F.wave; const LAS float* c1 = cond + DM + 256 * F.wave;
        float a0 = 0.f, a1 = 0.f;
#pragma unroll 32
        for (int k = 0; k < 256; ++k) { const float wv = w[(size_t)k * NMOD]; a0 += c0[k] * wv; a1 += c1[k] * wv; }
        red[F.wave * 128 + F.lane] = a0; red[F.wave * 128 + 64 + F.lane] = a1;
        __syncthreads();
        if (F.tid < 128) { float sacc = 0.f;
#pragma unroll
            for (int wv = 0; wv < 8; ++wv) sacc += red[wv * 128 + F.tid];
            const int bsel = F.tid >> 6, nn = (it % (NMOD / 64)) * 64 + (F.tid & 63);
            F.MOD[((size_t)l * BATCH + bsel) * NMOD + nn] = sacc + F.b_ada[(size_t)l * NMOD + nn]; }
        __syncthreads();
    }
    for (int lf = 0; lf < DEPTH * 2; ++lf) {
        if (FFN_FP8) {
            p0_transpose8<1>(F, F.w_gate + (size_t)lf * DM * DFF, DM, DFF, (unsigned char*)F.WGU + (size_t)lf * NGU * DM, DM, scr);
            p0_transpose8<2>(F, F.w_up + (size_t)lf * DM * DFF, DM, DFF, (unsigned char*)F.WGU + (size_t)lf * NGU * DM, DM, scr);
            p0_transpose8<0>(F, F.w_down + (size_t)lf * DFF * DM, DFF, DM, (unsigned char*)F.WD + (size_t)lf * DM * DFFP, DFFP, scr);
        } else {
            p0_transpose<1>(F, F.w_gate + (size_t)lf * DM * DFF, DM, DFF, F.WGU + (size_t)lf * NGU * DM, scr);
            p0_transpose<2>(F, F.w_up + (size_t)lf * DM * DFF, DM, DFF, F.WGU + (size_t)lf * NGU * DM, scr);
            p0_transpose<0>(F, F.w_down + (size_t)lf * DFF * DM, DFF, DM, F.WD + (size_t)lf * DM * DFF, scr);
        }
    }
    for (int l = 0; l < DEPTH; ++l) {
        p0_transpose<3>(F, F.w_in + (size_t)l * DM * INC, DM, INC, F.WIN + (size_t)l * NIN * DM, scr);
        p0_transpose<0>(F, F.w_out + (size_t)l * DM * DM, DM, DM, F.WOUT + (size_t)l * DM * DM, scr);
        GAS v4u* z = (GAS v4u*)(F.WIN + (size_t)l * NIN * DM + (size_t)INC * DM);
        for (int i = F.gw * 64 + F.lane; i < (NIN - INC) * DM / 8; i += F.NGW * 64) z[i] = (v4u){0u, 0u, 0u, 0u};
    }
}

template <bool OUT8, bool IN16> __device__ __forceinline__ void ph_modulate(const Frame& F, const void* xin, const float* g, const float* shift, const float* scale) {
    for (int m = F.gw; m < M; m += F.NGW) {
        const int b = m / SEQ;
        float x[4][8]; float s = 0.f;
        if constexpr (IN16) {
            const GAS v4u* xr = (const GAS v4u*)((const bf16*)xin + (size_t)m * DM) + F.lane;
            v4u w[4];
#pragma unroll
            for (int j = 0; j < 4; ++j) w[j] = xr[64 * j];
#pragma unroll
            for (int j = 0; j < 4; ++j) { x[j][0] = bf_lo(w[j].x); x[j][1] = bf_hi(w[j].x); x[j][2] = bf_lo(w[j].y); x[j][3] = bf_hi(w[j].y); x[j][4] = bf_lo(w[j].z); x[j][5] = bf_hi(w[j].z); x[j][6] = bf_lo(w[j].w); x[j][7] = bf_hi(w[j].w); }
        } else {
            const GAS f32x4* xr = (const GAS f32x4*)((const float*)xin + (size_t)m * DM) + 2 * F.lane;
            f32x4 a[4][2];
#pragma unroll
            for (int j = 0; j < 4; ++j) { a[j][0] = xr[128 * j]; a[j][1] = xr[128 * j + 1]; }
            GAS v4u* xo = (GAS v4u*)(F.XB + (size_t)m * DM) + F.lane;
#pragma unroll
            for (int j = 0; j < 4; ++j) { x[j][0] = a[j][0].x; x[j][1] = a[j][0].y; x[j][2] = a[j][0].z; x[j][3] = a[j][0].w; x[j][4] = a[j][1].x; x[j][5] = a[j][1].y; x[j][6] = a[j][1].z; x[j][7] = a[j][1].w;
                v4u w; w.x = pk2(x[j][0], x[j][1]); w.y = pk2(x[j][2], x[j][3]); w.z = pk2(x[j][4], x[j][5]); w.w = pk2(x[j][6], x[j][7]); xo[64 * j] = w; }
        }
#pragma unroll
        for (int j = 0; j < 4; ++j) s += ((x[j][0] * x[j][0] + x[j][1] * x[j][1]) + (x[j][2] * x[j][2] + x[j][3] * x[j][3])) + ((x[j][4] * x[j][4] + x[j][5] * x[j][5]) + (x[j][6] * x[j][6] + x[j][7] * x[j][7]));
        const float rstd = 1.0f / sqrtf(wave_sum(s) * (1.f / DM) + RMS_EPS);
        const GAS f32x4* gp = (const GAS f32x4*)g + 2 * F.lane; const GAS f32x4* sh = (const GAS f32x4*)(shift + (size_t)b * NMOD) + 2 * F.lane; const GAS f32x4* sc = (const GAS f32x4*)(scale + (size_t)b * NMOD) + 2 * F.lane;
        GAS v4u* o16 = (GAS v4u*)(F.H + (size_t)m * DM) + F.lane;
        GAS v2u* o8 = (GAS v2u*)((unsigned char*)F.H + (size_t)m * DM) + F.lane;
#pragma unroll
        for (int j = 0; j < 4; ++j) { float y[8];
#pragma unroll
            for (int h = 0; h < 2; ++h) { const f32x4 gg = gp[128 * j + h], ss = sc[128 * j + h], hh = sh[128 * j + h];
                y[4 * h + 0] = x[j][4 * h + 0] * rstd * gg.x * (ss.x + 1.0f) + hh.x; y[4 * h + 1] = x[j][4 * h + 1] * rstd * gg.y * (ss.y + 1.0f) + hh.y;
                y[4 * h + 2] = x[j][4 * h + 2] * rstd * gg.z * (ss.z + 1.0f) + hh.z; y[4 * h + 3] = x[j][4 * h + 3] * rstd * gg.w * (ss.w + 1.0f) + hh.w; }
            if (OUT8) { v2u w; w.x = pk_fp8x4(y[0], y[1], y[2], y[3]); w.y = pk_fp8x4(y[4], y[5], y[6], y[7]); o8[64 * j] = w; }
            else { v4u w; w.x = pk2(y[0], y[1]); w.y = pk2(y[2], y[3]); w.z = pk2(y[4], y[5]); w.w = pk2(y[6], y[7]); o16[64 * j] = w; } }
    }
}
__device__ __forceinline__ v4u headnorm8(v4u w, const float* g, float mul, int lane, bool normalize) {
    float x[8] = {bf_lo(w.x), bf_hi(w.x), bf_lo(w.y), bf_hi(w.y), bf_lo(w.z), bf_hi(w.z), bf_lo(w.w), bf_hi(w.w)};
    float r = mul;
    if (normalize) {
        float s = 0.f;
#pragma unroll
        for (int i = 0; i < 8; ++i) s += x[i] * x[i];
        s += __shfl_xor(s, 1); s += __shfl_xor(s, 2); s += __shfl_xor(s, 4);
        r = mul / sqrtf(s * (1.f / 64.f) + RMS_EPS);
        const f32x4 g0 = *(const GAS f32x4*)(g + 8 * (lane & 7)), g1 = *(const GAS f32x4*)(g + 8 * (lane & 7) + 4);
        x[0] *= g0.x; x[1] *= g0.y; x[2] *= g0.z; x[3] *= g0.w; x[4] *= g1.x; x[5] *= g1.y; x[6] *= g1.z; x[7] *= g1.w;
    }
    w.x = pk2(x[0] * r, x[1] * r); w.y = pk2(x[2] * r, x[3] * r); w.z = pk2(x[4] * r, x[5] * r); w.w = pk2(x[6] * r, x[7] * r);
    return w;
}
__device__ __forceinline__ void ph_post(const Frame& F, int l) {
    const float* qg = F.qk_g + (size_t)l * 6 * HD;
    for (int m = F.gw; m < M; m += F.NGW) {
        bf16* row = F.P + (size_t)m * NIN; const int lane = F.lane;
        GAS v4u* paq = (GAS v4u*)(row + PA_Q + 8 * lane); GAS v4u* pbq = (GAS v4u*)(row + PB_Q + 8 * lane); GAS v4u* pcq = (GAS v4u*)(row + PC_Q + 8 * lane);
        GAS v4u* pck = (GAS v4u*)(row + PC_K + 8 * lane); GAS v4u* pdq = (GAS v4u*)(row + PD_Q + 8 * lane);
        GAS v4u* pkk = (GAS v4u*)(row + (lane < 8 ? PA_K : PB_K) + 8 * (lane & 7));
        const v4u waq = *paq, wbq = *pbq, wcq = *pcq, wck = *pck, wdq = *pdq;
        v4u wkk = {0u, 0u, 0u, 0u}; if (lane < 16) wkk = *pkk;
        *paq = headnorm8(waq, qg + 0 * HD, QSCALE, lane, true);
        *pbq = headnorm8(wbq, qg + 2 * HD, QSCALE, lane, true);
        *pcq = headnorm8(wcq, qg + 4 * HD, QSCALE, lane, true);
        *pck = headnorm8(wck, qg + 5 * HD, 1.0f, lane, true);
        *pdq = headnorm8(wdq, qg, QSCALE, lane, false);
        if (lane < 16) *pkk = headnorm8(wkk, qg + (lane < 8 ? 1 : 3) * HD, 1.0f, lane, true);
    }
}
__device__ __forceinline__ void ph_scan(const Frame& F, int l) {
    LAS float* wtot = (LAS float*)(F.lds + RING_OFF);
    for (int sq = blockIdx.x; sq < BATCH * NH; sq += F.G) {
        const int b = sq / NH, h = sq % NH; const float fb = F.forget_b[(size_t)l * NH + h];
        const GAS unsigned short* src = (const GAS unsigned short*)(F.P + ((size_t)b * SEQ + 16 * F.tid) * NIN + PC_F + h); float* dst = F.KB2 + (size_t)sq * SEQ + 16 * F.tid;
        float v[16]; unsigned short raw[16];
#pragma unroll
        for (int i = 0; i < 16; ++i) raw[i] = src[(size_t)i * NIN];
#pragma unroll
        for (int i = 0; i < 16; ++i) { const float y = __builtin_bit_cast(float, (unsigned)raw[i] << 16) + fb; v[i] = (y >= 0.f) ? -log1pf(__expf(-y)) : (y - log1pf(__expf(y))); }
#pragma unroll
        for (int i = 1; i < 16; ++i) v[i] += v[i - 1];
        float incl = v[15];
#pragma unroll
        for (int o = 1; o < 64; o <<= 1) { const float t = __shfl_up(incl, o); if (F.lane >= o) incl += t; }
        if (F.lane == 63) wtot[F.wave] = incl;
        __syncthreads();
        float base = incl - v[15];
        for (int w = 0; w < F.wave; ++w) base += wtot[w];
#pragma unroll
        for (int i = 0; i < 4; ++i) *(GAS f32x4*)(dst + 4 * i) = (f32x4){-(v[4 * i] + base) * LOG2E, -(v[4 * i + 1] + base) * LOG2E, -(v[4 * i + 2] + base) * LOG2E, -(v[4 * i + 3] + base) * LOG2E};
        __syncthreads();
    }
}
__device__ __forceinline__ void ph_gnorm(const Frame& F, int l) {
    const float* gg = F.group_g + (size_t)l * DM;
    for (int m = F.gw; m < M; m += F.NGW) {
        v4u w[4];
#pragma unroll
        for (int g = 0; g < 4; ++g) w[g] = *(GAS v4u*)(F.Y + (size_t)m * DM + g * GWID + 8 * F.lane);
#pragma unroll
        for (int g = 0; g < 4; ++g) {
            bf16* p = F.Y + (size_t)m * DM + g * GWID + 8 * F.lane;
            float x[8] = {bf_lo(w[g].x), bf_hi(w[g].x), bf_lo(w[g].y), bf_hi(w[g].y), bf_lo(w[g].z), bf_hi(w[g].z), bf_lo(w[g].w), bf_hi(w[g].w)};
            float s = 0.f;
#pragma unroll
            for (int i = 0; i < 8; ++i) s += x[i] * x[i];
            const float r = 1.0f / sqrtf(wave_sum(s) * (1.f / GWID) + RMS_EPS);
            const f32x4 g0 = *(const GAS f32x4*)(gg + g * GWID + 8 * F.lane), g1 = *(const GAS f32x4*)(gg + g * GWID + 8 * F.lane + 4);
            v4u o; o.x = pk2(x[0] * r * g0.x, x[1] * r * g0.y); o.y = pk2(x[2] * r * g0.z, x[3] * r * g0.w); o.z = pk2(x[4] * r * g1.x, x[5] * r * g1.y); o.w = pk2(x[6] * r * g1.z, x[7] * r * g1.w);
            *(GAS v4u*)p = o;
        }
    }
}


__device__ __forceinline__ unsigned short score_key(float sc) {
    const _Float16 hf = (_Float16)fminf(fmaxf(sc, -60000.f), 60000.f);
    const unsigned h = (unsigned)__builtin_bit_cast(unsigned short, hf);
    return (unsigned short)((h & 0x8000u) ? (~h & 0xffffu) : (h | 0x8000u));
}
__device__ __forceinline__ void glds16x(const void* gsrc, unsigned lds_dst) { unsigned keep;
    asm volatile("s_mov_b32 %0, m0\n\ts_mov_b32 m0, %2\n\ts_nop 0\n\tglobal_load_lds_dwordx4 %1, off\n\ts_mov_b32 m0, %0" : "=&s"(keep) : "v"(gsrc), "s"(lds_dst) : "memory"); }
__device__ __forceinline__ void ph_idx_scores(const Frame& F) {
    constexpr int UPB = 8 * (16 * 17 / 2), NU = BATCH * UPB;
    const int lane = F.lane, r32 = lane & 31, hi = lane >> 5;
    const int u_lo = (int)(((long)blockIdx.x * NU) / F.G), u_hi = (int)(((long)(blockIdx.x + 1) * NU) / F.G);
    if (u_lo >= u_hi) return;
    int b = u_lo / UPB, qb = 127, kc = 0; { int r = u_lo % UPB; for (;;) { const int n = (qb >> 3) + 1; if (r < n) { kc = r; break; } r -= n; --qb; } }
    LAS unsigned char* KL = F.lds + RING_OFF;
    const unsigned kl_lds = (unsigned)(size_t)KL;
#define X1_STAGE(bb, kk, buf) do { const bf16* ksrc_ = F.P + ((size_t)(bb) * SEQ + 512 * (kk) + 64 * F.wave + lane) * NIN + PA_IK; \
        _Pragma("unroll") for (int c_ = 0; c_ < 8; ++c_) glds16x(ksrc_ + 8 * c_, (unsigned)__builtin_amdgcn_readfirstlane(kl_lds + (buf) * 65536 + c_ * 8192 + F.wave * 1024)); } while (0)
    X1_STAGE(b, kc, 0);
    asm volatile("s_waitcnt vmcnt(0)" ::: "memory"); __syncthreads();
    bf16x8 af[4][4]; float wq[4][16]; int cb = -1, cqb = -1;
    for (int u = u_lo; u < u_hi; ++u) {
        const int cur = (u - u_lo) & 1;
        int nb = b, nqb = qb, nkc = kc + 1; if (nkc > (qb >> 3)) { nkc = 0; --nqb; if (nqb < 0) { nqb = 127; ++nb; } }
        if (u + 1 < u_hi) X1_STAGE(nb, nkc, cur ^ 1);
        const size_t rowb = (size_t)b * SEQ; const int t0 = 64 * qb + 8 * F.wave;
        if (b != cb || qb != cqb) { cb = b; cqb = qb;
#pragma unroll
            for (int pr = 0; pr < 4; ++pr) {
                const bf16* qrow = F.P + (rowb + t0 + 2 * pr + ((r32 >> 2) & 1)) * NIN + PA_IQ + ((r32 & 3) + 4 * (r32 >> 3)) * 64 + 8 * hi;
#pragma unroll
                for (int s = 0; s < 4; ++s) af[pr][s] = *(const GAS bf16x8*)(qrow + 16 * s);
                const bf16* wrow = F.P + (rowb + t0 + 2 * pr + hi) * NIN + PA_IW;
                const v4u w0 = *(const GAS v4u*)wrow, w1 = *(const GAS v4u*)(wrow + 8);
                const unsigned ww[8] = {w0.x, w0.y, w0.z, w0.w, w1.x, w1.y, w1.z, w1.w};
#pragma unroll
                for (int i = 0; i < 8; ++i) { wq[pr][2 * i] = bf_lo(ww[i]) * 0.015625f; wq[pr][2 * i + 1] = bf_hi(ww[i]) * 0.015625f; }
            }
        }
        const int kend = 64 * (qb + 1) - 512 * kc;
        const int nkt = kend >= 512 ? 16 : (kend + 31) / 32;
        const LAS unsigned char* kl = KL + cur * 65536 + hi * 8192 + r32 * 16;
        for (int kt = 0; kt < nkt; ++kt) {
            bf16x8 bfr[4];
#pragma unroll
            for (int s = 0; s < 4; ++s) bfr[s] = *(const LAS bf16x8*)(kl + s * 16384 + kt * 512);
            const int s0 = 512 * kc + 32 * kt;
#pragma unroll
            for (int pr = 0; pr < 4; ++pr) {
                f32x16 acc = {};
#pragma unroll
                for (int s = 0; s < 4; ++s) acc = __builtin_amdgcn_mfma_f32_32x32x16_bf16(af[pr][s], bfr[s], acc, 0, 0, 0);
                float sc0 = 0.f, sc1 = 0.f;
#pragma unroll
                for (int r = 0; r < 16; ++r) { sc0 = __builtin_fmaf(wq[pr][r], acc[r], sc0); sc1 = __builtin_fmaf(wq[pr][r], __builtin_fabsf(acc[r]), sc1); if ((r & 3) == 3) asm("" : "+v"(sc1)); }
                ((GAS unsigned short*)F.SC)[(rowb + t0 + 2 * pr + hi) * SEQ + s0 + r32] = score_key(sc0 + sc1);
                __builtin_amdgcn_sched_barrier(0);
            }
        }
        asm volatile("s_waitcnt vmcnt(0)" ::: "memory");
        __syncthreads();
        b = nb; qb = nqb; kc = nkc;
    }
#undef X1_STAGE
}

__device__ __forceinline__ unsigned mbcnt64(unsigned long long m) { return __builtin_amdgcn_mbcnt_hi((unsigned)(m >> 32), __builtin_amdgcn_mbcnt_lo((unsigned)m, 0u)); }
template <int SH, int PSH> __device__ __forceinline__ void sel_level(const unsigned (&v)[64], int nreg, unsigned pval, unsigned need, LAS unsigned* hist, int lane, unsigned& bin_out, unsigned& above_out) {
#pragma unroll
    for (int i = 0; i < 8; ++i) ((LAS v4u*)hist)[lane + 64 * i] = (v4u){0u, 0u, 0u, 0u};
    LDS_WAIT(); __builtin_amdgcn_wave_barrier();
    const unsigned hb = (unsigned)(size_t)hist, sink = hb + 9216u + 4u * (unsigned)lane;
#pragma unroll
    for (int g = 0; g < 8; ++g) if (8 * g < nreg) {
#pragma unroll
        for (int jj = 0; jj < 8; ++jj) { const int j = 8 * g + jj;
#pragma unroll
            for (int e = 0; e < 2; ++e) { const unsigned k = e ? (v[j] >> 16) : (v[j] & 0xffffu);
                const bool pred = (k != 0u) && (PSH >= 16 || (k >> (PSH & 15)) == pval);
                const unsigned tgt = pred ? hb + (((k >> SH) & 2047u) << 2) : sink;
                __hip_atomic_fetch_add((LAS unsigned*)tgt, 1u, __ATOMIC_RELAXED, __HIP_MEMORY_SCOPE_WAVEFRONT); }
            if ((jj & 1) == 1) __builtin_amdgcn_sched_barrier(0); }
    }
    LDS_WAIT(); __builtin_amdgcn_wave_barrier();
    unsigned S = 0u;
#pragma unroll
    for (int i = 0; i < 8; ++i) { const v4u q = ((LAS v4u*)hist)[lane * 8 + i]; S += (q.x + q.y) + (q.z + q.w); }
    unsigned T = S;
#pragma unroll
    for (int o = 1; o < 64; o <<= 1) { const unsigned t = __shfl_down(T, o); if (lane + o < 64) T += t; }
    const unsigned above_lane = T - S;
    const bool cross = (T >= need) && (above_lane < need);
    unsigned run = above_lane, bin = 0u, ab = 0u; bool found = false;
#pragma unroll
    for (int i = 7; i >= 0; --i) { const v4u q = ((LAS v4u*)hist)[lane * 8 + i]; const unsigned c4[4] = {q.x, q.y, q.z, q.w};
#pragma unroll
        for (int e = 3; e >= 0; --e) { const bool hit = !found && (run + c4[e] >= need); if (hit) { bin = 32u * lane + 4 * i + e; ab = run; found = true; } run += c4[e]; } }
    const unsigned long long cm = __ballot(cross);
    const int src = cm ? (int)__builtin_ctzll(cm) : 0;
    bin_out = __builtin_amdgcn_readlane(bin, src); above_out = __builtin_amdgcn_readlane(ab, src);
    LDS_WAIT(); __builtin_amdgcn_wave_barrier();
}
__device__ __forceinline__ void select_row(const Frame& F, int m, LAS unsigned* hist, LAS int* out) {
    int lane = F.lane; asm volatile("" : "+v"(lane));
    const int t = m % SEQ, n = t + 1;
    if (n <= TOPK) { for (int j = lane; j < TOPK; j += 64) out[j] = (j < n) ? j : 0; return; }
    const int nreg = (n + 127) >> 7;
    unsigned v[64];
    const GAS unsigned* pr = (const GAS unsigned*)(F.SC + (size_t)m * SEQ) + lane;
#pragma unroll
    for (int g = 0; g < 8; ++g) {
        if (8 * g < nreg) {
#pragma unroll
            for (int jj = 0; jj < 8; ++jj) v[8 * g + jj] = pr[jj * 64];
        } else {
#pragma unroll
            for (int jj = 0; jj < 8; ++jj) v[8 * g + jj] = 0u;
        }
        pr += 512; asm volatile("" : "+v"(pr));
    }
    const int nfull = n >> 7;
#pragma unroll
    for (int g = 0; g < 8; ++g) if (8 * g < nreg && 8 * g + 8 > nfull) {
#pragma unroll
        for (int jj = 0; jj < 8; ++jj) { const int j = 8 * g + jj; const int e0 = 128 * j + 2 * lane; const unsigned w = v[j];
            v[j] = ((e0 < n) ? (w & 0xffffu) : 0u) | ((e0 + 1 < n) ? (w & 0xffff0000u) : 0u); asm volatile("" : "+v"(v[j])); }
    }
    unsigned b1, a1, b2, a2;
    sel_level<5, 16>(v, nreg, 0u, (unsigned)TOPK, hist, lane, b1, a1);
    sel_level<0, 5>(v, nreg, b1, (unsigned)TOPK - a1, hist, lane, b2, a2);
    const unsigned tau = (b1 << 5) | (b2 & 31u);
    const unsigned quota = (unsigned)TOPK - a1 - a2;
    unsigned mg[4] = {0u, 0u, 0u, 0u}, me[4] = {0u, 0u, 0u, 0u};
#pragma unroll
    for (int g = 0; g < 8; ++g) {
        if (8 * g < nreg) {
#pragma unroll
            for (int jj = 0; jj < 8; ++jj) { const int j = 8 * g + jj;
#pragma unroll
                for (int e = 0; e < 2; ++e) { const unsigned k = e ? (v[j] >> 16) : (v[j] & 0xffffu);
                    mg[g >> 1] = mg[g >> 1] + mg[g >> 1] + ((k > tau) ? 1u : 0u); me[g >> 1] = me[g >> 1] + me[g >> 1] + ((k == tau) ? 1u : 0u); }
                if ((jj & 3) == 3) __builtin_amdgcn_sched_barrier(0); }
        } else { mg[g >> 1] <<= 16; me[g >> 1] <<= 16; }
    }
    const unsigned cg = (unsigned)(__builtin_popcount(mg[0]) + __builtin_popcount(mg[1]) + __builtin_popcount(mg[2]) + __builtin_popcount(mg[3]));
    unsigned ce = (unsigned)(__builtin_popcount(me[0]) + __builtin_popcount(me[1]) + __builtin_popcount(me[2]) + __builtin_popcount(me[3]));
    unsigned incl = cg | (ce << 16);
#pragma unroll
    for (int o = 1; o < 64; o <<= 1) { const unsigned t = (unsigned)__shfl_up((int)incl, o); if (lane >= o) incl += t; }
    const unsigned excl = incl - (cg | (ce << 16));
    const unsigned pre_g = excl & 0xffffu, pre_e = excl >> 16;
    const unsigned keep = pre_e >= quota ? 0u : ((quota - pre_e) < ce ? (quota - pre_e) : ce);
#pragma unroll
    for (int q = 3; q >= 0; --q) { while (ce > keep && me[q] != 0u) { me[q] &= me[q] - 1u; --ce; } }
    unsigned pos = pre_g + (pre_e < quota ? pre_e : quota);
    const int ilane = 2 * lane;
#pragma unroll
    for (int q = 0; q < 4; ++q) { unsigned mm = mg[q] | me[q];
        while (mm != 0u) { const int bpos = 31 - (int)__builtin_clz(mm); const int sl = 31 - bpos; mm &= ~(1u << bpos);
            const int i = 128 * (16 * q + (sl >> 1)) + ilane + (sl & 1);
            if (pos < (unsigned)TOPK) out[pos] = i;
            ++pos; } }
}


constexpr int AT_K = 0, AT_V = 16384, AT_KB = 32768, AT_WSF = 33280, AT_BT = 35328, AT_DEAD = 35840, AT_SV = 36864;
typedef short v4i16_t __attribute__((ext_vector_type(4)));
__device__ __forceinline__ s16x4 vtr(const LAS unsigned char* p) { return __builtin_bit_cast(s16x4, __builtin_amdgcn_ds_read_tr16_b64_v4i16((LAS v4i16_t*)p)); }
typedef __bf16 bfpair_t __attribute__((ext_vector_type(2))); typedef float f32pair_t __attribute__((ext_vector_type(2)));
__device__ __forceinline__ unsigned cvtpk(float lo, float hi) { const f32pair_t v = {lo, hi}; return __builtin_bit_cast(unsigned, __builtin_convertvector(v, bfpair_t)); }
#define NEG_INF (-__builtin_inff())

template <int TYPE>
__device__ __forceinline__ void dense_attn_unit(const Frame& F, int l, int b, int h, int qb) {
    constexpr int QOFF = TYPE == 1 ? PB_Q : TYPE == 2 ? PC_Q : PD_Q, KOFF = TYPE == 1 ? PB_K : TYPE == 2 ? PC_K : PD_K, VOFF = TYPE == 1 ? PB_V : TYPE == 2 ? PC_V : PD_V;
    constexpr bool MQA = TYPE == 1; constexpr int YOFF = TYPE * GWID;
    const int tid = F.tid, lane = F.lane, wid = F.wave, r32 = lane & 31, hi = lane >> 5;
    LAS unsigned char* L = F.lds + RING_OFF;
    LAS float* wsf = (LAS float*)(L + AT_WSF + wid * 256);
    LAS float* BT = (LAS float*)(L + AT_BT);
    const int hq = (TYPE == 1) ? wid : h, qoff = (TYPE == 1) ? (qb & 7) * 32 : wid * 32, qb256 = (TYPE == 1) ? (qb >> 3) : qb;
    const size_t rowb = (size_t)b * SEQ; const int q0 = qb256 * 256;
    const bf16* Pk = F.P + rowb * NIN + KOFF + (MQA ? 0 : h * 64);
    const bf16* Pv = F.P + rowb * NIN + VOFF + (MQA ? 0 : h * 64);
    const bf16* Pq = F.P + (rowb + q0 + qoff + r32) * NIN + QOFF + hq * 64 + hi * 8;
    bf16x8 qr[4];
#pragma unroll
    for (int d0 = 0; d0 < 4; ++d0) qr[d0] = *(const GAS bf16x8*)(Pq + 16 * d0);
    const int jt_hi = (TYPE == 1) ? ((q0 + qoff + 31) >> 6) : 4 * qb256 + 3, jt_lo = (TYPE == 1) ? (((q0 + qoff - (WINDOW - 1)) > 0 ? (q0 + qoff - (WINDOW - 1)) : 0) >> 6) : 0, nt = jt_hi - jt_lo + 1;
    if (TYPE == 1) { LAS float* BTall = (LAS float*)(L + AT_SV);
        for (int i = tid; i < 8 * 128; i += NTHREADS) BTall[i] = F.rel_table[(int)kBucketLut[i & 127] * 16 + 8 + (i >> 7)] * LOG2E;
        BT = BTall + 128 * wid; }
    const bf16* kgp = Pk + (size_t)lane * NIN + wid * 8;
    const int vkey = tid >> 3, vch = tid & 7;
    const bf16* vgp = Pv + (size_t)vkey * NIN + vch * 8;
    const int kl = wid * 1024 + lane * 16;
    const int vl = (vch >> 2) * 4096 + (vkey >> 3) * 512 + (vkey & 7) * 64 + (vch & 3) * 16;
    const float* kb2 = F.KB2 + ((size_t)b * NH + h) * SEQ;
    v4u kreg = *(const GAS v4u*)(kgp + (size_t)jt_hi * 64 * NIN), vreg = *(const GAS v4u*)(vgp + (size_t)jt_hi * 64 * NIN);
    float kbreg = 0.f; if (TYPE == 2 && tid < 64) kbreg = kb2[jt_hi * 64 + tid];
    *(LAS v4u*)(L + AT_K + kl) = kreg; *(LAS v4u*)(L + AT_V + vl) = vreg; if (TYPE == 2 && tid < 64) ((LAS float*)(L + AT_KB))[tid] = kbreg;
    __syncthreads();
    f32x16 o[2]; o[0] = f32x16{}; o[1] = f32x16{};
    float mrun = NEG_INF, lsum = 0.f, carry = 1.f;
    float qbound = 0.f;
    if (TYPE == 2) {
        float ss = 0.f;
#pragma unroll
        for (int d0 = 0; d0 < 4; ++d0)
#pragma unroll
            for (int j = 0; j < 8; ++j) { const float x = bf2f((bf16)qr[d0][j]); ss += x * x; }
        ss += __shfl_xor(ss, 32);
        float gm = fabsf(F.qk_g[((size_t)l * 6 + 5) * HD + lane]);
#pragma unroll
        for (int o = 1; o < 64; o <<= 1) gm = fmaxf(gm, __shfl_xor(gm, o));
        qbound = sqrtf(ss) * 8.08f * gm;
    }
    const int qrel = qoff + r32;
    const int vb = ((lane >> 4) & 1) * 32 + (lane & 3) * 8 + (4 * hi + ((lane & 15) >> 2)) * 64;
    LAS unsigned* deadf = (LAS unsigned*)(L + AT_DEAD);
    for (int i = 0; i < nt; ++i) {
        const int jt = jt_hi - i, cur = i & 1, jb = jt - 4 * qb256; const bool more = (i + 1 < nt);
        float kbnext = 0.f;
        if (more) { kreg = *(const GAS v4u*)(kgp + (size_t)(jt - 1) * 64 * NIN); vreg = *(const GAS v4u*)(vgp + (size_t)(jt - 1) * 64 * NIN); if (TYPE == 2 && tid < 64) kbreg = kb2[(jt - 1) * 64 + tid]; if (TYPE == 2) kbnext = kb2[jt * 64 - 1]; }
        const bool active = (64 * jb <= qoff + 31) && (TYPE != 1 || (64 * jb + 63 >= qoff - (WINDOW - 1)));
        if (active) {
            const LAS unsigned char* Kb = L + AT_K + cur * 8192; const LAS unsigned char* Vb = L + AT_V + cur * 8192;
            f32x16 p0 = f32x16{}, p1 = f32x16{};
            bf16x8 ka[4], kc[4];
#pragma unroll
            for (int d0 = 0; d0 < 4; ++d0) { ka[d0] = *(const LAS bf16x8*)(Kb + (2 * d0 + hi) * 1024 + r32 * 16); kc[d0] = *(const LAS bf16x8*)(Kb + (2 * d0 + hi) * 1024 + 512 + r32 * 16); }
            __builtin_amdgcn_sched_barrier(0);
#pragma unroll
            for (int d0 = 0; d0 < 4; ++d0) { p0 = __builtin_amdgcn_mfma_f32_32x32x16_bf16(ka[d0], qr[d0], p0, 0, 0, 0); p1 = __builtin_amdgcn_mfma_f32_32x32x16_bf16(kc[d0], qr[d0], p1, 0, 0, 0); }
            bf16x8 vfr[2][4];
#pragma unroll
            for (int d0 = 0; d0 < 2; ++d0)
#pragma unroll
                for (int ks = 0; ks < 4; ++ks) { const s16x4 lo = vtr(Vb + vb + d0 * 4096 + ks * 1024), hh = vtr(Vb + vb + d0 * 4096 + ks * 1024 + 512);
                    vfr[d0][ks] = (bf16x8){lo[0], lo[1], lo[2], lo[3], hh[0], hh[1], hh[2], hh[3]}; }
            __builtin_amdgcn_sched_barrier(0);
            const int kv0 = 64 * jb + 4 * hi;
            if (TYPE == 3) {
                float b0[16], b1[16];
#pragma unroll
                for (int r = 0; r < 16; ++r) { const int kv = kv0 + (r & 3) + 8 * (r >> 2);
                    const float e0 = fexp2(fminf(p0[r], 80.f)), e1 = fexp2(fminf(p1[r], 80.f));
                    const float m0 = frcp(1.0f + e0), m1 = frcp(1.0f + e1);
                    const bool ok0 = kv < qrel, ok1 = (kv + 32) < qrel;
                    b0[r] = ok0 ? e0 * m0 : 0.f; b1[r] = ok1 ? e1 * m1 : 0.f; p0[r] = ok0 ? m0 : 1.0f; p1[r] = ok1 ? m1 : 1.0f; }
                float gp[8], go[8], pp[8];
#pragma unroll
                for (int g = 0; g < 4; ++g) { gp[g] = (p0[4 * g] * p0[4 * g + 1]) * (p0[4 * g + 2] * p0[4 * g + 3]); gp[4 + g] = (p1[4 * g] * p1[4 * g + 1]) * (p1[4 * g + 2] * p1[4 * g + 3]); }
#pragma unroll
                for (int g = 0; g < 8; ++g) { const float oth = __shfl_xor(gp[g], 32); pp[g] = gp[g] * oth; go[g] = hi ? 1.0f : oth; }
                float sp = 1.0f;
#pragma unroll
                for (int g = 7; g >= 0; --g) { const float sg = sp * go[g] * carry;
                    if (g < 4) { const float c3 = p0[4 * g + 3], c2 = p0[4 * g + 2], c1 = p0[4 * g + 1];
                        p0[4 * g + 3] = b0[4 * g + 3] * sg; const float s2 = sg * c3; p0[4 * g + 2] = b0[4 * g + 2] * s2; const float s1 = s2 * c2; p0[4 * g + 1] = b0[4 * g + 1] * s1; p0[4 * g] = b0[4 * g] * (s1 * c1); }
                    else { const int q = g - 4; const float c3 = p1[4 * q + 3], c2 = p1[4 * q + 2], c1 = p1[4 * q + 1];
                        p1[4 * q + 3] = b1[4 * q + 3] * sg; const float s2 = sg * c3; p1[4 * q + 2] = b1[4 * q + 2] * s2; const float s1 = s2 * c2; p1[4 * q + 1] = b1[4 * q + 1] * s1; p1[4 * q] = b1[4 * q] * (s1 * c1); }
                    sp *= pp[g]; }
                carry *= sp;
            } else {
                if (TYPE == 2) {
                    const LAS f32x4* kbp = (const LAS f32x4*)(L + AT_KB + cur * 256);
#pragma unroll
                    for (int g = 0; g < 4; ++g) { const f32x4 a = kbp[2 * g + hi], c = kbp[8 + 2 * g + hi];
#pragma unroll
                        for (int e = 0; e < 4; ++e) { p0[4 * g + e] += a[e]; p1[4 * g + e] += c[e]; } }
                    if (jb >= 0) {
#pragma unroll
                        for (int r = 0; r < 16; ++r) { const int kv = kv0 + (r & 3) + 8 * (r >> 2); if (kv > qrel) p0[r] = NEG_INF; if (kv + 32 > qrel) p1[r] = NEG_INF; }
                    }
                } else {
#pragma unroll
                    for (int r = 0; r < 16; ++r) { const int d0_ = qrel - (kv0 + (r & 3) + 8 * (r >> 2)), d1_ = d0_ - 32;
                        const bool ok0 = (d0_ >= 0) && (d0_ < WINDOW), ok1 = (d1_ >= 0) && (d1_ < WINDOW);
                        const float t0 = BT[ok0 ? d0_ : 0], t1 = BT[ok1 ? d1_ : 0];
                        p0[r] = ok0 ? p0[r] + t0 : NEG_INF; p1[r] = ok1 ? p1[r] + t1 : NEG_INF; }
                }
                float rm = fmaxf(p0[0], p1[0]);
#pragma unroll
                for (int r = 1; r < 16; ++r) rm = fmaxf(rm, fmaxf(p0[r], p1[r]));
                { auto rr = __builtin_amdgcn_permlane32_swap(__float_as_uint(rm), __float_as_uint(rm), false, false); rm = fmaxf(__uint_as_float(rr[0]), __uint_as_float(rr[1])); }
                const float mn = fmaxf(mrun, rm);
                if (__any(mn > mrun)) {
                    const float f = (mn > mrun) ? fexp2(mrun - mn) : 1.0f;
                    lsum *= f; mrun = mn;
                    if (hi == 0) wsf[r32] = f;
                    LDS_WAIT(); __builtin_amdgcn_wave_barrier();
#pragma unroll
                    for (int g = 0; g < 4; ++g) { const f32x4 fv = ((const LAS f32x4*)wsf)[2 * g + hi];
#pragma unroll
                        for (int e = 0; e < 4; ++e) { o[0][4 * g + e] *= fv[e]; o[1][4 * g + e] *= fv[e]; } }
                    LDS_WAIT(); __builtin_amdgcn_wave_barrier();
                }
                const float ms = (mrun == NEG_INF) ? 0.f : mrun;
                float ps = 0.f;
#pragma unroll
                for (int r = 0; r < 16; ++r) { p0[r] = fexp2(p0[r] - ms); p1[r] = fexp2(p1[r] - ms); ps += p0[r] + p1[r]; }
                lsum += ps;
            }
            bf16x8 pa[4];
#pragma unroll
            for (int ks = 0; ks < 4; ++ks) { v4u w;
                if (ks < 2) { w.x = cvtpk(p0[8 * ks], p0[8 * ks + 1]); w.y = cvtpk(p0[8 * ks + 2], p0[8 * ks + 3]); w.z = cvtpk(p0[8 * ks + 4], p0[8 * ks + 5]); w.w = cvtpk(p0[8 * ks + 6], p0[8 * ks + 7]); }
                else { const int k2 = ks - 2; w.x = cvtpk(p1[8 * k2], p1[8 * k2 + 1]); w.y = cvtpk(p1[8 * k2 + 2], p1[8 * k2 + 3]); w.z = cvtpk(p1[8 * k2 + 4], p1[8 * k2 + 5]); w.w = cvtpk(p1[8 * k2 + 6], p1[8 * k2 + 7]); }
                pa[ks] = __builtin_bit_cast(bf16x8, w); }
#pragma unroll
            for (int d0 = 0; d0 < 2; ++d0)
#pragma unroll
                for (int ks = 0; ks < 4; ++ks) o[d0] = __builtin_amdgcn_mfma_f32_32x32x16_bf16(pa[ks], vfr[d0][ks], o[d0], 0, 0, 0);
        }
        if (TYPE == 2) {
            bool wdead = false;
            if (active && more) wdead = __all(qbound + kbnext - mrun < -40.f);
            if (lane == 0) deadf[cur * 8 + wid] = wdead ? 1u : 0u; }
        if (TYPE == 3) { const bool wdead = active && __all(carry < 2.3e-10f);
            if (lane == 0) deadf[cur * 8 + wid] = wdead ? 1u : 0u; }
        if (more) { *(LAS v4u*)(L + AT_K + (cur ^ 1) * 8192 + kl) = kreg; *(LAS v4u*)(L + AT_V + (cur ^ 1) * 8192 + vl) = vreg; if (TYPE == 2 && tid < 64) ((LAS float*)(L + AT_KB + (cur ^ 1) * 256))[tid] = kbreg; }
        __syncthreads();
        if (TYPE >= 2) { const v4u d0 = *(const LAS v4u*)(deadf + cur * 8), d1 = *(const LAS v4u*)(deadf + cur * 8 + 4);
            if ((d0.x & d0.y & d0.z & d0.w & d1.x & d1.y & d1.z & d1.w) != 0u) break; }
    }
    float inv[16];
    if (TYPE != 3) {
        { auto rr = __builtin_amdgcn_permlane32_swap(__float_as_uint(lsum), __float_as_uint(lsum), false, false); lsum = __uint_as_float(rr[0]) + __uint_as_float(rr[1]); }
        if (TYPE == 1) lsum += fexp2(F.sinks[l * NH + hq] * LOG2E - mrun);
        const float il = 1.0f / lsum;
        if (hi == 0) wsf[r32] = il;
        LDS_WAIT(); __builtin_amdgcn_wave_barrier();
#pragma unroll
        for (int g = 0; g < 4; ++g) { const f32x4 fv = ((const LAS f32x4*)wsf)[2 * g + hi]; inv[4 * g] = fv[0]; inv[4 * g + 1] = fv[1]; inv[4 * g + 2] = fv[2]; inv[4 * g + 3] = fv[3]; }
        LDS_WAIT(); __builtin_amdgcn_wave_barrier();
    } else {
#pragma unroll
        for (int r = 0; r < 16; ++r) inv[r] = 1.0f;
    }
    unsigned short gte[2][16];
    if (TYPE == 2) {
#pragma unroll
        for (int d0 = 0; d0 < 2; ++d0)
#pragma unroll
            for (int r = 0; r < 16; ++r) { const int q = (r & 3) + 8 * (r >> 2) + 4 * hi; const size_t mrow = rowb + q0 + qoff + q; gte[d0][r] = ((const GAS unsigned short*)F.P)[mrow * NIN + PC_G + hq * 64 + 32 * d0 + r32]; }
    }
#pragma unroll
    for (int d0 = 0; d0 < 2; ++d0)
#pragma unroll
        for (int r = 0; r < 16; ++r) { const int q = (r & 3) + 8 * (r >> 2) + 4 * hi; const size_t mrow = rowb + q0 + qoff + q; const int col = hq * 64 + 32 * d0 + r32;
            float val = o[d0][r] * inv[r];
            if (TYPE == 2) val *= frcp(1.0f + fexp2(-LOG2E * __builtin_bit_cast(float, (unsigned)gte[d0][r] << 16)));
            F.Y[mrow * DM + YOFF + col] = (bf16)f2bf(val); }
}

__device__ __forceinline__ void sparse_attn_query(const Frame& F, int m, LAS unsigned char* vch, const LAS float* TBA, const LAS int* idx) {
    int lane = F.lane; asm volatile("" : "+v"(lane));
    const int hh = lane & 15, kg = lane >> 4, t = m % SEQ, b = m / SEQ;
    const size_t rowb = (size_t)b * SEQ;
    const int nsel = (t + 1) < TOPK ? (t + 1) : TOPK, nch = (nsel + 63) >> 6;
    const bf16* qp = F.P + (size_t)m * NIN + PA_Q + (hh & 7) * 64 + 8 * kg;
    const bf16x8 qf0 = *(const GAS bf16x8*)qp, qf1 = *(const GAS bf16x8*)(qp + 32);
    float s[4][4][4];
#pragma unroll
    for (int cp = 0; cp < 2; ++cp) {
        if (2 * cp < nch) {
            bf16x8 kf[8][2];
#pragma unroll
            for (int bb = 0; bb < 8; ++bb) { const int keyA = idx[128 * cp + 16 * bb + hh];
                const bf16* kp = F.P + (rowb + keyA) * NIN + PA_K + 8 * kg;
                kf[bb][0] = *(const GAS bf16x8*)kp; kf[bb][1] = *(const GAS bf16x8*)(kp + 32); }
            __builtin_amdgcn_sched_barrier(0);
#pragma unroll
            for (int bb = 0; bb < 8; ++bb) { const int c = 2 * cp + (bb >> 2), blk = bb & 3, j0 = 64 * c + 16 * blk;
                f32x4 acc = {0.f, 0.f, 0.f, 0.f};
                acc = __builtin_amdgcn_mfma_f32_16x16x32_bf16(kf[bb][0], qf0, acc, 0, 0, 0); acc = __builtin_amdgcn_mfma_f32_16x16x32_bf16(kf[bb][1], qf1, acc, 0, 0, 0);
                const v4i id4 = *(const LAS v4i*)(idx + j0 + 4 * kg);
#pragma unroll
                for (int r = 0; r < 4; ++r) { const int j = j0 + 4 * kg + r; int dist = t - id4[r]; dist = dist < 0 ? 0 : (dist > 128 ? 128 : dist);
                    const float bias = TBA[dist * 8 + (hh & 7)];
                    s[c][blk][r] = (j < nsel) ? acc[r] + bias : NEG_INF; }
            }
        } else {
#pragma unroll
            for (int c = 2 * cp; c < 2 * cp + 2; ++c)
#pragma unroll
                for (int blk = 0; blk < 4; ++blk)
#pragma unroll
                    for (int r = 0; r < 4; ++r) s[c][blk][r] = NEG_INF;
        }
    }
    v4u xv[2][8];
#define SP_VLOAD(c_, X) do { const int keyV_ = idx[64 * (c_) + lane]; const bf16* vp_ = F.P + (rowb + keyV_) * NIN + PA_V; \
        _Pragma("unroll") for (int i_ = 0; i_ < 8; ++i_) X[i_] = *(const GAS v4u*)(vp_ + 8 * i_); } while (0)
    SP_VLOAD(0, xv[0]);
    if (1 < nch) SP_VLOAD(1, xv[1]);
    __builtin_amdgcn_sched_barrier(0);
    float mx = NEG_INF;
#pragma unroll
    for (int c = 0; c < 4; ++c)
#pragma unroll
        for (int blk = 0; blk < 4; ++blk)
#pragma unroll
            for (int r = 0; r < 4; ++r) mx = fmaxf(mx, s[c][blk][r]);
    mx = fmaxf(mx, __shfl_xor(mx, 16)); mx = fmaxf(mx, __shfl_xor(mx, 32));
    float sum = 0.f;
#pragma unroll
    for (int c = 0; c < 4; ++c)
#pragma unroll
        for (int blk = 0; blk < 4; ++blk)
#pragma unroll
            for (int r = 0; r < 4; ++r) { const float p = fexp2(s[c][blk][r] - mx); s[c][blk][r] = p; sum += p; }
    sum += __shfl_xor(sum, 16); sum += __shfl_xor(sum, 32);
    const float inv = 1.0f / sum;
    f32x4 oacc[4];
#pragma unroll
    for (int d = 0; d < 4; ++d) oacc[d] = (f32x4){0.f, 0.f, 0.f, 0.f};
    const int q4 = (lane & 15) >> 2, p4 = lane & 3;
#pragma unroll
    for (int c = 0; c < 4; ++c) {
        if (c < nch) {
#pragma unroll
            for (int i = 0; i < 8; ++i) *(LAS v4u*)(vch + (i >> 2) * 4096 + lane * 64 + (i & 3) * 16) = xv[c & 1][i];
            LDS_WAIT(); __builtin_amdgcn_wave_barrier();
            if (c + 2 < nch) SP_VLOAD(c + 2, xv[c & 1]);
            __builtin_amdgcn_sched_barrier(0);
#pragma unroll
            for (int kp = 0; kp < 2; ++kp) { v4u w; w.x = cvtpk(s[c][2 * kp][0], s[c][2 * kp][1]); w.y = cvtpk(s[c][2 * kp][2], s[c][2 * kp][3]); w.z = cvtpk(s[c][2 * kp + 1][0], s[c][2 * kp + 1][1]); w.w = cvtpk(s[c][2 * kp + 1][2], s[c][2 * kp + 1][3]);
                const bf16x8 pf = __builtin_bit_cast(bf16x8, w);
#pragma unroll
                for (int d = 0; d < 4; ++d) { const LAS unsigned char* a = vch + (d >> 1) * 4096 + (32 * kp + 4 * kg + q4) * 64 + ((d & 1) * 16 + 4 * p4) * 2;
                    const s16x4 lo = vtr(a), hv = vtr(a + 16 * 64);
                    const bf16x8 vf = {lo[0], lo[1], lo[2], lo[3], hv[0], hv[1], hv[2], hv[3]};
                    oacc[d] = __builtin_amdgcn_mfma_f32_16x16x32_bf16(vf, pf, oacc[d], 0, 0, 0); } }
            LDS_WAIT(); __builtin_amdgcn_wave_barrier();
        }
    }
#undef SP_VLOAD
    if (hh < 8) {
#pragma unroll
        for (int d = 0; d < 4; ++d) { v2u w; w.x = pk2(oacc[d][0] * inv, oacc[d][1] * inv); w.y = pk2(oacc[d][2] * inv, oacc[d][3] * inv);
            *(GAS v2u*)(F.Y + (size_t)m * DM + hh * 64 + 16 * d + 4 * kg) = w; }
    }
}

constexpr int CW_QUEUE = 8192;
constexpr int MIX_ITEMS = 2560;
template <unsigned EN> __device__ __forceinline__ void ph_attention(const Frame& F, int l, int qsel = 0) {
    LAS float* TBA = (LAS float*)(F.lds + AUX_OFF);
    for (int i = F.tid; i < 129 * 8; i += NTHREADS) { const int d = i >> 3, hq = i & 7; const int bk = d < 128 ? (int)kBucketLut[d] : 31; TBA[i] = F.rel_table[bk * 16 + hq] * LOG2E; }
    LAS unsigned* qslot = (LAS unsigned*)(F.lds + LDSCTL_OFF + 64);
    LAS unsigned char* wbuf = F.lds + RING_OFF + AT_SV + F.wave * 9472;
    LAS int* idxl = (LAS int*)(wbuf + 8192);
    __syncthreads();
#define MIX_FETCH(it) do { if (F.tid == 0) *qslot = __hip_atomic_fetch_add((unsigned*)(F.ctl + CW_QUEUE + 64 * l + 32 * qsel), 1u, __ATOMIC_RELAXED, __HIP_MEMORY_SCOPE_AGENT); \
        __syncthreads(); it = (int)*qslot; __syncthreads(); } while (0)
    for (int r = (int)blockIdx.x; r < 1024; r += F.G) {
        if (EN & 0x800) {
            const int b = r >> 9, blk = r & 511;
#pragma unroll 1
            for (int k = 0; k < 2; ++k) { const int u = 8 * blk + F.wave; const int t = k ? (SEQ - 1 - u) : u; const int m = b * SEQ + t;
                select_row(F, m, (LAS unsigned*)wbuf, idxl);
                LDS_WAIT(); __builtin_amdgcn_wave_barrier();
#ifdef PROBE_SEL2
                select_row(F, m, (LAS unsigned*)wbuf, idxl); LDS_WAIT(); __builtin_amdgcn_wave_barrier();
#endif
#ifdef PROBE_ATT2
                sparse_attn_query(F, m, wbuf, TBA, idxl); LDS_WAIT(); __builtin_amdgcn_wave_barrier();
#endif
                sparse_attn_query(F, m, wbuf, TBA, idxl);
                LDS_WAIT(); __builtin_amdgcn_wave_barrier(); }
        }
    }
    __syncthreads();
    int it; MIX_FETCH(it); it += 1024;
    while (it < 1536) { const int r = it & 511; if (EN & 0x100) dense_attn_unit<2>(F, l, (r & 15) >> 3, r & 7, 31 - (r >> 4)); MIX_FETCH(it); it += 1024; }
    while (it < 2048) { const int r = it & 511; if (EN & 0x200) dense_attn_unit<3>(F, l, (r & 15) >> 3, r & 7, 31 - (r >> 4)); MIX_FETCH(it); it += 1024; }
    while (it < MIX_ITEMS) { const int r = it & 511; if (EN & 0x400) dense_attn_unit<1>(F, l, r >> 8, 0, 255 - (r & 255)); MIX_FETCH(it); it += 1024; }
#undef MIX_FETCH
}


__device__ __forceinline__ const float* gp_(const float* p) {
#if defined(__HIP_DEVICE_COMPILE__)
    __builtin_assume(!__builtin_amdgcn_is_shared((const __attribute__((address_space(0))) void*)p)); __builtin_assume(!__builtin_amdgcn_is_private((const __attribute__((address_space(0))) void*)p));
#endif
    return p; }
#ifndef PROBE_KINDS
#define PROBE_KINDS 0u
#endif
#ifndef PROBE_ATT
#define PROBE_ATT 0xF00u
#endif
#ifndef PROBE_REPS
#define PROBE_REPS 1
#endif
#ifndef MK_ONE_LAUNCH
#define MK_ONE_LAUNCH 1
#endif
constexpr int PH_PER_LAYER = 14, N_PHASES = 1 + DEPTH * PH_PER_LAYER;
struct Args { const float* in[15]; float* out; unsigned char* ws; int ph_lo, ph_hi; };
struct ArgsG { const GAS float* in[15]; GAS float* out; GAS unsigned char* ws; int ph_lo, ph_hi; };
template <unsigned EN> __global__ void __launch_bounds__(NTHREADS, 2) trunk_fwd(Args args) {
    extern __shared__ __attribute__((aligned(16))) unsigned char lds[];
    LAS unsigned char* const ldsb = (LAS unsigned char*)lds;
    const int wave0 = __builtin_amdgcn_readfirstlane((int)threadIdx.x >> 6);
    for (int u = threadIdx.x; u < (LDS_BYTES - LDSCTL_OFF) / 4; u += NTHREADS) ((LAS unsigned*)(ldsb + LDSCTL_OFF))[u] = 0u;
    __syncthreads();
#if MK_ONE_LAUNCH
    constexpr int lo = 0, hi = N_PHASES;
#else
    const int lo = args.ph_lo, hi = args.ph_hi;
#endif
    XcdBarrier bar; bar.bar = (unsigned*)(args.ws + WS_CTL) + CW_BAR; bar.x = 0; bar.st = nullptr;
    if (hi - lo > 1) bar = xcd_barrier_post((unsigned*)(args.ws + WS_CTL) + CW_BAR, (volatile LAS unsigned*)(ldsb + LDSCTL_OFF));
#define GP(p) ((const float*)(p))
#define PH_BEGIN(k, kind) if (lo <= (k) && (k) < hi) { _Pragma("unroll 1") for (int rep_ = 0; rep_ < (((PROBE_KINDS >> (kind)) & 1u) ? PROBE_REPS : 1); ++rep_) { Frame F; { \
        const ArgsG* ka = (const ArgsG*)__builtin_amdgcn_kernarg_segment_ptr(); asm volatile("" : "+s"(ka)); \
        unsigned o_ = ~0u; asm volatile("" : "+s"(o_)); int t_ = wave0 * 64 + (int)__builtin_amdgcn_mbcnt_hi(o_, __builtin_amdgcn_mbcnt_lo(o_, 0u)); asm volatile("" : "+v"(t_)); \
        F.lds = ldsb; F.tid = t_; F.lane = t_ & 63; F.wave = wave0; int gw_ = blockIdx.x * NWAVES + wave0; asm volatile("" : "+s"(gw_)); F.G = gridDim.x; F.gw = gw_; F.NGW = F.G * NWAVES; \
        unsigned char* ws = (unsigned char*)ka->ws; F.ctl = (gu32*)(ws + WS_CTL);     \
        F.x = GP(ka->in[0]); F.c = GP(ka->in[1]); F.w_ada = GP(ka->in[2]); F.b_ada = GP(ka->in[3]); F.norm_g = GP(ka->in[4]); F.w_in = GP(ka->in[5]); F.qk_g = GP(ka->in[6]); F.forget_b = GP(ka->in[7]); \
        F.sinks = GP(ka->in[8]); F.rel_table = GP(ka->in[9]); F.group_g = GP(ka->in[10]); F.w_out = GP(ka->in[11]); F.w_gate = GP(ka->in[12]); F.w_up = GP(ka->in[13]); F.w_down = GP(ka->in[14]); F.out = (float*)ka->out; \
        F.MOD = (float*)(ws + WS_MOD); F.LF = (float*)(ws + WS_LF); F.KB2 = (float*)(ws + WS_KB2); F.SC = (unsigned short*)(ws + WS_SC); F.IDX = (int*)(ws + WS_IDX); \
        F.WGU = (bf16*)(ws + WS_WGU); F.WD = (bf16*)(ws + WS_WD); F.WIN = (bf16*)(ws + WS_WIN); F.WOUT = (bf16*)(ws + WS_WOUT); \
        F.H = (bf16*)(ws + WS_H); F.P = (bf16*)(ws + WS_P); F.Y = (bf16*)(ws + WS_Y); F.XB = (bf16*)(ws + WS_XB); }
#define PH_END(k) if ((k) + 1 < hi) xcd_barrier(bar); } }

    PH_BEGIN(0, 31) if (EN & 1) p0_prologue(F); PH_END(0)

    for (int l = 0; l < DEPTH; ++l) {
        const int base = 1 + l * PH_PER_LAYER;
        for (int sub = 0; sub < 3; ++sub) {
            if (sub != 1) {
                const int f = sub >> 1, pb = base + (f ? 11 : 0), ni = f ? 2 : 0, lf = l * 2 + f;
                PH_BEGIN(pb, (f ? 11 : 0)) if (EN & 2) { const float* modl = F.MOD + (size_t)l * BATCH * NMOD;
                    if (l == 0 && f == 0) ph_modulate<FFN_FP8, false>(F, F.x, F.norm_g + ((size_t)l * 3 + ni) * DM, modl + (3 * ni + 0) * DM, modl + (3 * ni + 1) * DM);
                    else ph_modulate<FFN_FP8, true>(F, F.XB, F.norm_g + ((size_t)l * 3 + ni) * DM, modl + (3 * ni + 0) * DM, modl + (3 * ni + 1) * DM); } PH_END(pb)
                PH_BEGIN(pb + 1, (f ? 12 : 1)) if (EN & 4) {
                    pg8::StaticOrder S; S.init(M, NGU, F.G, (int)blockIdx.x);
                    if constexpr (FFN_FP8) { pg8::Gemm g{F.H, (const bf16*)((const unsigned char*)F.WGU + (size_t)lf * NGU * DM), M, NGU, DM, 127, W8_E8M0};
                        pg8::EpiSwiGLU8 E{(unsigned char*)F.P, DFFP};
                        pg8::gemm_phase<pg8::EpiSwiGLU8, pg8::StaticOrder, true, true, true>(F.lds + RING_OFF, g, S, E, F.tid); }
                    else { pg8::Gemm g{F.H, F.WGU + (size_t)lf * NGU * DM, M, NGU, DM};
                        pg8::EpiSwiGLU E{F.P, DFF};
                        pg8::gemm_phase<pg8::EpiSwiGLU, pg8::StaticOrder, true, true>(F.lds + RING_OFF, g, S, E, F.tid); } } PH_END(pb + 1)
                PH_BEGIN(pb + 2, (f ? 13 : 2)) if (EN & 8) {
                    pg8::Gemm g{F.P, FFN_FP8 ? (const bf16*)((const unsigned char*)F.WD + (size_t)lf * DM * DFFP) : F.WD + (size_t)lf * DM * DFF, M, DM, DFF, 127, FFN_FP8 ? W8_E8M0 : 127, FFN_FP8 ? DFFP : 0, FFN_FP8 ? DFFP : 0}; pg8::StaticOrder S; S.init(M, DM, F.G, (int)blockIdx.x);
                    const float* modl = F.MOD + (size_t)l * BATCH * NMOD;
                    if (l == DEPTH - 1 && f == 1) { pg8::EpiResid<false> E{F.XB, rep_ ? (void*)F.SC : (void*)F.out, DM, modl + (3 * ni + 2) * DM, NMOD, SEQ, 0.5f};
                        pg8::gemm_phase<pg8::EpiResid<false>, pg8::StaticOrder, true, true, FFN_FP8>(F.lds + RING_OFF, g, S, E, F.tid); }
                    else { pg8::EpiResid<true> E{F.XB, rep_ ? (void*)F.SC : (void*)F.XB, DM, modl + (3 * ni + 2) * DM, NMOD, SEQ, 0.5f};
                        pg8::gemm_phase<pg8::EpiResid<true>, pg8::StaticOrder, true, true, FFN_FP8>(F.lds + RING_OFF, g, S, E, F.tid); } } PH_END(pb + 2)
            } else {
                PH_BEGIN(base + 3, 3) if (EN & 2) { const float* modl = F.MOD + (size_t)l * BATCH * NMOD; ph_modulate<false, true>(F, F.XB, F.norm_g + ((size_t)l * 3 + 1) * DM, modl + 3 * DM, modl + 4 * DM); } PH_END(base + 3)
                PH_BEGIN(base + 4, 4) if (EN & 16) {
                    pg8::Gemm g{F.H, F.WIN + (size_t)l * NIN * DM, M, NIN, DM}; pg8::StaticOrder S; S.init(M, NIN, F.G, (int)blockIdx.x);
                    pg8::EpiBf16 E{F.P, NIN};
                    pg8::gemm_phase<pg8::EpiBf16, pg8::StaticOrder, true, true>(F.lds + RING_OFF, g, S, E, F.tid); } PH_END(base + 4)
                PH_BEGIN(base + 6, 6) if (EN & 64) { ph_scan(F, l);
                    int par_ = (int)(blockIdx.x & 1u); asm volatile("" : "+s"(par_));
                    _Pragma("unroll 1") for (int st_ = 0; st_ < 2; ++st_) { if ((st_ ^ par_) == 0) { if (EN & 32) ph_post(F, l); } else ph_idx_scores(F); } } PH_END(base + 6)
                PH_BEGIN(base + 8, 8) if (EN & 0xF00) { if (rep_ == 0) ph_attention<EN>(F, l, 0); else ph_attention<(PROBE_ATT)>(F, l, 1); } PH_END(base + 8)
                PH_BEGIN(base + 9, 9) if (EN & 0x1000) ph_gnorm(F, l); PH_END(base + 9)
                PH_BEGIN(base + 10, 10) if (EN & 0x2000) {
                    pg8::Gemm g{F.Y, F.WOUT + (size_t)l * DM * DM, M, DM, DM}; pg8::StaticOrder S; S.init(M, DM, F.G, (int)blockIdx.x);
                    const float* modl = F.MOD + (size_t)l * BATCH * NMOD;
                    pg8::EpiResid<true> E{F.XB, rep_ ? (void*)F.SC : (void*)F.XB, DM, modl + 5 * DM, NMOD, SEQ, 1.0f};
                    pg8::gemm_phase<pg8::EpiResid<true>, pg8::StaticOrder, true, true>(F.lds + RING_OFF, g, S, E, F.tid); } PH_END(base + 10)
            }
        }
    }
#undef PH_BEGIN
#undef PH_END
}

#ifndef EN_MASK
#define EN_MASK 0xFFFFu
#endif
template <unsigned EN> static int setup_kernel() {
    if (hipFuncSetAttribute((const void*)trunk_fwd<EN>, hipFuncAttributeMaxDynamicSharedMemorySize, LDS_BYTES) != hipSuccess) { fprintf(stderr, "kernel_launch: hipFuncSetAttribute failed\n"); return -1; }
    int per_cu = 0;
    if (hipOccupancyMaxActiveBlocksPerMultiprocessor(&per_cu, (const void*)trunk_fwd<EN>, NTHREADS, LDS_BYTES) != hipSuccess || per_cu < 1) { fprintf(stderr, "kernel_launch: occupancy query says %d\n", per_cu); }
    (void)hipGetLastError();
    return 0;
}
template <unsigned EN> static void launch_range(const Args& a0, int lo, int hi, int grid, hipStream_t stream) {
    Args a = a0; a.ph_lo = lo; a.ph_hi = hi;
    hipLaunchKernelGGL(trunk_fwd<EN>, dim3(grid), dim3(NTHREADS), LDS_BYTES, stream, a);
}
extern "C" void kernel_launch(void* const* d_in, const int* in_sizes, int n_in, void* d_out, int out_size, void* d_ws, size_t ws_size, hipStream_t stream) {
    static int grid = 0;
    if (grid == 0) {
        if (n_in != 15 || in_sizes[0] != M * DM || out_size != M * DM || ws_size < WS_END) {
            fprintf(stderr, "kernel_launch: shape/workspace mismatch: n_in %d in0 %d out %d ws %zu (need %zu); nothing launched\n", n_in, n_in > 0 ? in_sizes[0] : -1, out_size, ws_size, (size_t)WS_END); grid = -1; return; }
        int dev = 0, cus = 0;
        if (hipGetDevice(&dev) != hipSuccess || hipDeviceGetAttribute(&cus, hipDeviceAttributeMultiprocessorCount, dev) != hipSuccess) { grid = -1; return; }
#if MK_ONE_LAUNCH
        if (setup_kernel<EN_MASK>()) { grid = -1; return; }
#else
        if (setup_kernel<0x1u>() || setup_kernel<0x2u>() || setup_kernel<0x4u>() || setup_kernel<0x8u>() || setup_kernel<0x10u>() || setup_kernel<0x20u>() || setup_kernel<0x40u>() || setup_kernel<0x80u>() ||
            setup_kernel<0x100u>() || setup_kernel<0x200u>() || setup_kernel<0x400u>() || setup_kernel<0x800u>() || setup_kernel<0x1000u>() || setup_kernel<0x2000u>()) { grid = -1; return; }
#endif
        grid = cus;
    }
    if (grid < 0) return;
    if (hipMemsetAsync((char*)d_ws + WS_CTL, 0, CTL_ZERO_BYTES, stream) != hipSuccess) return;
    Args a{};
    for (int i = 0; i < 15; ++i) a.in[i] = (const float*)d_in[i];
    a.out = (float*)d_out; a.ws = (unsigned char*)d_ws;
#if MK_ONE_LAUNCH
    launch_range<EN_MASK>(a, 0, N_PHASES, grid, stream);
#else
    launch_range<0x1u>(a, 0, 1, grid, stream);
    for (int l = 0; l < DEPTH; ++l) { const int base = 1 + l * PH_PER_LAYER;
        for (int f = 0; f < 2; ++f) { const int pb = base + (f ? 11 : 0);
            if (f == 1) {
                launch_range<0x2u>(a, base + 3, base + 4, grid, stream); launch_range<0x10u>(a, base + 4, base + 5, grid, stream); launch_range<0x20u>(a, base + 5, base + 6, grid, stream);
                launch_range<0x40u>(a, base + 6, base + 7, grid, stream); launch_range<0x80u>(a, base + 7, base + 8, grid, stream);
                launch_range<0x100u>(a, base + 8, base + 9, grid, stream); launch_range<0x200u>(a, base + 8, base + 9, grid, stream); launch_range<0x400u>(a, base + 8, base + 9, grid, stream); launch_range<0x800u>(a, base + 8, base + 9, grid, stream);
                launch_range<0x1000u>(a, base + 9, base + 10, grid, stream); launch_range<0x2000u>(a, base + 10, base + 11, grid, stream);
            }
            launch_range<0x2u>(a, pb, pb + 1, grid, stream); launch_range<0x4u>(a, pb + 1, pb + 2, grid, stream); launch_range<0x8u>(a, pb + 2, pb + 3, grid, stream);
        }
    }
#endif
}
```

```cpp
#include <hip/hip_runtime.h>
#include <cstdio>
#include <cstdint>

namespace pg8 {
#define PG8_LAS __attribute__((address_space(3)))
typedef unsigned short bf16_t;
typedef short bf16x8 __attribute__((ext_vector_type(8)));
typedef float f32x4 __attribute__((ext_vector_type(4)));
typedef unsigned u32x4 __attribute__((ext_vector_type(4)));
constexpr int BM = 256, BK = 64, HALF = 128, HTB = HALF * BK * 2  , STAGE_BYTES = 8 * HTB, NXCD = 8, WGM = 8;

__host__ __device__ __forceinline__ int lds_byte(int r, int c) { const int st = (r >> 4) * 2 + (c >> 5), rr = r & 15, cc = c & 31, ob = rr * 64 + cc * 2; return st * 1024 + (ob ^ (((ob >> 9) & 1) << 5)); }
__host__ __device__ __forceinline__ void stage_rc(int b, int& R, int& C) { const int st = b / 1024, sb = b % 1024, swz = sb ^ (((sb >> 9) & 1) << 5); R = (st >> 1) * 16 + swz / 64; C = (st & 1) * 32 + (swz % 64) / 2; }
__host__ __device__ __forceinline__ int perm32(int rho) { const int n = rho >> 4, i = rho & 15; return 8 * (i >> 2) + 4 * n + (i & 3); }

struct Unit { int pm, pn; };
struct Gemm { const bf16_t* A; const bf16_t* Bt; int M, N, K; int scaleA = 127, scaleB = 127; int lda = 0, ldb = 0; int blk = 0; };
typedef int i32x8 __attribute__((ext_vector_type(8))); typedef int i32x4v __attribute__((ext_vector_type(4)));
__device__ __forceinline__ i32x8 pg8_cat(bf16x8 lo, bf16x8 hi) { return __builtin_shufflevector(__builtin_bit_cast(i32x4v, lo), __builtin_bit_cast(i32x4v, hi), 0, 1, 2, 3, 4, 5, 6, 7); }

struct StaticOrder {
    int nM, nN, nwg, G, c;
    __host__ __device__ void init(int M, int N, int G_, int c_) { nM = M / BM; nN = N / BM; nwg = nM * nN; G = G_; c = c_; }
    __host__ __device__ bool next(int i, Unit& u) const {
        const long L = (long)i * G + c; if (L >= nwg) return false;
        int wgid = (int)L; { const int q = nwg / NXCD, r = nwg % NXCD, xcd = wgid % NXCD, off = wgid / NXCD; wgid = (xcd < r ? xcd * (q + 1) : r * (q + 1) + (xcd - r) * q) + off; }
        const int nig = WGM * nN, gid = wgid / nig, fm = gid * WGM, gsz = (nM - fm) < WGM ? (nM - fm) : WGM;
        u.pm = fm + ((wgid % nig) % gsz); u.pn = (wgid % nig) / gsz; return true;
    }
    __device__ __forceinline__ void a_ready(const Unit&) const {}
    __device__ __forceinline__ void done(const Unit&) const {}
};
typedef __bf16 pg8_bfpair __attribute__((ext_vector_type(2))); typedef float pg8_f32pair __attribute__((ext_vector_type(2)));
__device__ __forceinline__ unsigned cvt_pk_bf16(float lo, float hi) { const pg8_f32pair v = {lo, hi}; return __builtin_bit_cast(unsigned, __builtin_convertvector(v, pg8_bfpair)); }
__device__ __forceinline__ unsigned cvt_pk_bf16_nv(float lo, float hi) { return cvt_pk_bf16(lo, hi); }
__device__ __forceinline__ const char* uptr(const char* p) { const unsigned long long v = (unsigned long long)p; const unsigned lo = __builtin_amdgcn_readfirstlane((unsigned)v), hi = __builtin_amdgcn_readfirstlane((unsigned)(v >> 32)); return (const char*)(((unsigned long long)hi << 32) | lo); }
struct EpiBf16 {
    static constexpr bool PERM = true, AFTER_DRAIN = false;
    bf16_t* O; int ldc;
    __device__ __forceinline__ void operator()(const f32x4 (&acc)[2][2][4][2], const Unit& u, int wr, int wc, int fr, int fq) const {
        asm volatile("" : "+v"(fr), "+v"(fq));
        const int row0 = u.pm * BM + wr * 64 + fr; const int col0 = u.pn * BM + wc * 32 + 8 * fq;
#pragma unroll
        for (int ai = 0; ai < 2; ++ai)
#pragma unroll
            for (int m = 0; m < 4; ++m) { bf16_t* rowp = O + (size_t)(row0 + ai * HALF + m * 16) * ldc + col0;
#pragma unroll
                for (int bj = 0; bj < 2; ++bj) { const f32x4 v0 = acc[ai][bj][m][0], v1 = acc[ai][bj][m][1];
                    u32x4 w; w.x = cvt_pk_bf16(v0[0], v0[1]); w.y = cvt_pk_bf16(v0[2], v0[3]); w.z = cvt_pk_bf16(v1[0], v1[1]); w.w = cvt_pk_bf16(v1[2], v1[3]);
                    *(u32x4*)(rowp + bj * HALF) = w; } }
    }
};
__device__ __forceinline__ float silu_mul(float g, float u) { return g * u * __builtin_amdgcn_rcpf(1.0f + __builtin_amdgcn_exp2f(-1.4426950408889634f * g)); }
struct EpiSwiGLU {
    static constexpr bool PERM = true, AFTER_DRAIN = false;
    bf16_t* O; int ldc;
    __device__ __forceinline__ void operator()(const f32x4 (&acc)[2][2][4][2], const Unit& u, int wr, int wc, int fr, int fq) const {
        asm volatile("" : "+v"(fr), "+v"(fq));
        const int row0 = u.pm * BM + wr * 64 + fr; const int col0 = u.pn * HALF + wc * 32 + 8 * fq;
#pragma unroll
        for (int ai = 0; ai < 2; ++ai)
#pragma unroll
            for (int m = 0; m < 4; ++m) { bf16_t* rowp = O + (size_t)(row0 + ai * HALF + m * 16) * ldc + col0;
                const f32x4 g0 = acc[ai][0][m][0], g1 = acc[ai][0][m][1], u0 = acc[ai][1][m][0], u1 = acc[ai][1][m][1];
                u32x4 w; w.x = cvt_pk_bf16(silu_mul(g0[0], u0[0]), silu_mul(g0[1], u0[1])); w.y = cvt_pk_bf16(silu_mul(g0[2], u0[2]), silu_mul(g0[3], u0[3]));
                w.z = cvt_pk_bf16(silu_mul(g1[0], u1[0]), silu_mul(g1[1], u1[1])); w.w = cvt_pk_bf16(silu_mul(g1[2], u1[2]), silu_mul(g1[3], u1[3]));
                *(u32x4*)rowp = w; }
    }
};
template <bool OUT16> struct EpiResid {
    static constexpr bool PERM = false, AFTER_DRAIN = false;
    const bf16_t* base; void* out; int ldc; const float* gv; int gstride; int rows_per_batch; float coef;
    __device__ __forceinline__ void operator()(const f32x4 (&acc)[2][2][4][2], const Unit& u, int wr, int wc, int fr, int fq) const {
        typedef unsigned v2u_ __attribute__((ext_vector_type(2)));
        asm volatile("" : "+v"(fr), "+v"(fq));
        const int row0 = u.pm * BM + wr * 64 + fr; const int col0 = u.pn * BM + wc * 32 + 4 * fq;
        const float* gvec = gv + (size_t)((u.pm * BM) / rows_per_batch) * gstride + col0;
        f32x4 gg[2][2];
#pragma unroll
        for (int bj = 0; bj < 2; ++bj)
#pragma unroll
            for (int n = 0; n < 2; ++n) gg[bj][n] = *(const f32x4*)(gvec + bj * HALF + n * 16) * coef;
#pragma unroll
        for (int ai = 0; ai < 2; ++ai) {
            v2u_ bwv[4][2][2];
#pragma unroll
            for (int m = 0; m < 4; ++m) { const size_t off = (size_t)(row0 + ai * HALF + m * 16) * ldc + col0;
#pragma unroll
                for (int bj = 0; bj < 2; ++bj)
#pragma unroll
                    for (int n = 0; n < 2; ++n) bwv[m][bj][n] = *(const v2u_*)(base + off + bj * HALF + n * 16); }
#pragma unroll
            for (int m = 0; m < 4; ++m) { const size_t off = (size_t)(row0 + ai * HALF + m * 16) * ldc + col0;
#pragma unroll
                for (int bj = 0; bj < 2; ++bj)
#pragma unroll
                    for (int n = 0; n < 2; ++n) { const v2u_ bw = bwv[m][bj][n];
                        f32x4 bs; bs[0] = __builtin_bit_cast(float, bw.x << 16); bs[1] = __builtin_bit_cast(float, bw.x & 0xffff0000u); bs[2] = __builtin_bit_cast(float, bw.y << 16); bs[3] = __builtin_bit_cast(float, bw.y & 0xffff0000u);
                        const f32x4 r = bs + gg[bj][n] * acc[ai][bj][m][n];
                        if constexpr (OUT16) { v2u_ w; w.x = cvt_pk_bf16_nv(r[0], r[1]); w.y = cvt_pk_bf16_nv(r[2], r[3]); *(v2u_*)((bf16_t*)out + off + bj * HALF + n * 16) = w; }
                        else *(f32x4*)((float*)out + off + bj * HALF + n * 16) = r; } }
        }
    }
};
__device__ __forceinline__ unsigned pack_fp8x4(float a, float b, float c, float d) {
    a = fminf(fmaxf(a, -448.f), 448.f); b = fminf(fmaxf(b, -448.f), 448.f); c = fminf(fmaxf(c, -448.f), 448.f); d = fminf(fmaxf(d, -448.f), 448.f);
    int w = 0; w = __builtin_amdgcn_cvt_pk_fp8_f32(a, b, w, false); w = __builtin_amdgcn_cvt_pk_fp8_f32(c, d, w, true); return (unsigned)w; }
struct EpiSwiGLU8 {
    static constexpr bool PERM = true, AFTER_DRAIN = false;
    unsigned char* O; int ldc;
    __device__ __forceinline__ void operator()(const f32x4 (&acc)[2][2][4][2], const Unit& u, int wr, int wc, int fr, int fq) const {
        asm volatile("" : "+v"(fr), "+v"(fq));
        const int row0 = u.pm * BM + wr * 64 + fr; const int col0 = u.pn * HALF + wc * 32 + 8 * fq;
#pragma unroll
        for (int ai = 0; ai < 2; ++ai)
#pragma unroll
            for (int m = 0; m < 4; ++m) { unsigned char* rowp = O + (size_t)(row0 + ai * HALF + m * 16) * ldc + col0;
                const f32x4 g0 = acc[ai][0][m][0], g1 = acc[ai][0][m][1], u0 = acc[ai][1][m][0], u1 = acc[ai][1][m][1];
                typedef unsigned u32x2v __attribute__((ext_vector_type(2))); u32x2v w;
                w.x = pack_fp8x4(silu_mul(g0[0], u0[0]), silu_mul(g0[1], u0[1]), silu_mul(g0[2], u0[2]), silu_mul(g0[3], u0[3]));
                w.y = pack_fp8x4(silu_mul(g1[0], u1[0]), silu_mul(g1[1], u1[1]), silu_mul(g1[2], u1[2]), silu_mul(g1[3], u1[3]));
                *(u32x2v*)rowp = w; }
    }
};
template <class Epi, class Sched, bool ALIGN_EPI = false, bool SP2 = false, bool FP8 = false>
__device__ __forceinline__ void gemm_phase(PG8_LAS unsigned char* lds, const Gemm g, const Sched& S, const Epi& E, int tid_in) {
    int tid_ = tid_in; asm volatile("" : "+v"(tid_));
    const int tid = tid_, wid = __builtin_amdgcn_readfirstlane(tid >> 6), lane = tid & 63, wr = wid >> 2, wc = wid & 3, fr = lane & 15, fq = lane >> 4;
    const int K = g.K, nt = FP8 ? K / (2 * BK) : K / BK;
    const int pitchA = g.blk ? 2 * BK : g.lda ? g.lda : (FP8 ? K : 2 * K), pitchB = g.blk ? 2 * BK : g.ldb ? g.ldb : (FP8 ? K : 2 * K);
    unsigned voffA[2], voffB[2];
#pragma unroll
    for (int i = 0; i < 2; ++i) { int R, C; stage_rc(tid * 16 + i * 8192, R, C); const int Rb = Epi::PERM ? ((R & ~31) + perm32(R & 31)) : R;
        voffA[i] = (unsigned)(R * pitchA + C * 2); voffB[i] = (unsigned)(Rb * pitchB + C * 2); }
    const size_t kstep = g.blk ? (size_t)(512 * BK) : (size_t)(BK * 2);
    const size_t hstepA = (size_t)HALF * pitchA, hstepB = (size_t)HALF * pitchB;
    const size_t tstepA = g.blk ? (size_t)(FP8 ? K / (2 * BK) : K / BK) * kstep : 2 * hstepA, tstepB = g.blk ? tstepA : 2 * hstepB;
    const unsigned ldsw = (unsigned)wid * 1024u;
    const int aoff = lds_byte(wr * 64 + fr, fq * 8), boff = lds_byte(wc * 32 + fr, fq * 8);
    PG8_LAS unsigned char* abase = lds + aoff; PG8_LAS unsigned char* bbase = lds + boff + 4 * HTB;
#define PG8_SA(b, h) (((b) * 2 + (h)) * HTB)
#define PG8_SB(b, h) ((4 + (b) * 2 + (h)) * HTB)
#define PG8_STAGE(bufoff, gbase, voff) do { _Pragma("unroll") for (int _i = 0; _i < 2; ++_i) \
        __builtin_amdgcn_global_load_lds((const unsigned*)((const char*)(gbase) + (voff)[_i]), (PG8_LAS unsigned*)(lds + (bufoff) + ldsw + _i * 8192), 16, 0, 0); } while (0)
#define PG8_RDA(off) (*(const PG8_LAS bf16x8*)(abase + (off)))
#define PG8_RDB(off) (*(const PG8_LAS bf16x8*)(bbase + ((off) - 4 * HTB)))
#define PG8_LDA(dst, b, h) do { if constexpr (FP8) { _Pragma("unroll") for (int m = 0; m < 4; ++m) dst##8[m] = pg8_cat(PG8_RDA(PG8_SA(b, h) + m * 2048), PG8_RDA(PG8_SA(b, h) + m * 2048 + 1024)); } \
    else { _Pragma("unroll") for (int m = 0; m < 4; ++m) _Pragma("unroll") for (int k = 0; k < 2; ++k) dst[m][k] = PG8_RDA(PG8_SA(b, h) + m * 2048 + k * 1024); } } while (0)
#define PG8_LDB(dst, b, h) do { if constexpr (FP8) { _Pragma("unroll") for (int n = 0; n < 2; ++n) dst##8[n] = pg8_cat(PG8_RDB(PG8_SB(b, h) + n * 2048), PG8_RDB(PG8_SB(b, h) + n * 2048 + 1024)); } \
    else { _Pragma("unroll") for (int n = 0; n < 2; ++n) _Pragma("unroll") for (int k = 0; k < 2; ++k) dst[n][k] = PG8_RDB(PG8_SB(b, h) + n * 2048 + k * 1024); } } while (0)
#define PG8_MMA(ai, bj, At, Bt) do { __builtin_amdgcn_s_setprio(1); if constexpr (FP8) { \
        _Pragma("unroll") for (int m = 0; m < 4; ++m) _Pragma("unroll") for (int n = 0; n < 2; ++n) \
            asm volatile("v_mfma_scale_f32_16x16x128_f8f6f4 %0, %1, %2, %0, %3, %4 op_sel_hi:[0,0,0]" : "+v"(acc[ai][bj][m][n]) : "v"(Bt##8[n]), "v"(At##8[m]), "v"(sclB), "v"(sclA)); \
        } else { _Pragma("unroll") for (int m = 0; m < 4; ++m) _Pragma("unroll") for (int n = 0; n < 2; ++n) _Pragma("unroll") for (int k = 0; k < 2; ++k) \
        acc[ai][bj][m][n] = __builtin_amdgcn_mfma_f32_16x16x32_bf16(Bt[n][k], At[m][k], acc[ai][bj][m][n], 0, 0, 0); } __builtin_amdgcn_s_setprio(0); } while (0)
#define PG8_WAIT_V(n) asm volatile("s_waitcnt vmcnt(" #n ")" ::: "memory")
#define PG8_WAIT_L(n) asm volatile("s_waitcnt lgkmcnt(" #n ")" ::: "memory")
#define PG8_BAR __builtin_amdgcn_s_barrier()
#define PG8_SCHED __builtin_amdgcn_sched_barrier(0)
    Unit cur, nxt; int ui = 0;
    if (!S.next(0, cur)) return;
    f32x4 acc[2][2][4][2];
#pragma unroll
    for (int a = 0; a < 2; ++a)
#pragma unroll
        for (int b = 0; b < 2; ++b)
#pragma unroll
            for (int m = 0; m < 4; ++m)
#pragma unroll
                for (int n = 0; n < 2; ++n) acc[a][b][m][n] = (f32x4){0.f, 0.f, 0.f, 0.f};
    const int sclA = g.scaleA, sclB = g.scaleB;
    bf16x8 At[4][2], B0[2][2], B1[2][2]; i32x8 At8[4], B08[2], B18[2];
    const char* cA = uptr((const char*)g.A + (size_t)cur.pm * tstepA); const char* cB = uptr((const char*)g.Bt + (size_t)cur.pn * tstepB);
    S.a_ready(cur);
    if constexpr (SP2) {
        PG8_STAGE(PG8_SB(0, 0), cB, voffB); PG8_STAGE(PG8_SB(0, 1), cB + hstepB, voffB); PG8_STAGE(PG8_SA(0, 0), cA, voffA); PG8_STAGE(PG8_SA(0, 1), cA + hstepA, voffA);
        if (wr == 1) PG8_BAR;
        PG8_WAIT_V(2); PG8_BAR;
        PG8_STAGE(PG8_SB(1, 0), cB + kstep, voffB); PG8_STAGE(PG8_SA(1, 0), cA + kstep, voffA); PG8_STAGE(PG8_SB(1, 1), cB + hstepB + kstep, voffB);
        PG8_WAIT_V(6); PG8_BAR;
    } else {
        PG8_STAGE(PG8_SB(0, 0), cB, voffB); PG8_STAGE(PG8_SA(0, 0), cA, voffA); PG8_STAGE(PG8_SB(0, 1), cB + hstepB, voffB); PG8_STAGE(PG8_SA(0, 1), cA + hstepA, voffA);
        if (wr == 1) PG8_BAR;
        PG8_WAIT_V(4); PG8_BAR;
        PG8_STAGE(PG8_SB(1, 0), cB + kstep, voffB); PG8_STAGE(PG8_SA(1, 0), cA + kstep, voffA); PG8_STAGE(PG8_SB(1, 1), cB + hstepB + kstep, voffB);
        PG8_WAIT_V(6); PG8_BAR;
    }
    for (;;) {
        const bool has_next = S.next(ui + 1, nxt);
        const char* nA = uptr(has_next ? (const char*)g.A + (size_t)nxt.pm * tstepA : cA); const char* nB = uptr(has_next ? (const char*)g.Bt + (size_t)nxt.pn * tstepB : cB);
        for (int t = 0; t < nt; t += 2) {
            asm volatile("" : "+v"(abase), "+v"(bbase));
            const bool last = (t == nt - 2);
            const char* a1 = cA + (size_t)(t + 1) * kstep;
            const char* a2 = uptr(last ? nA : cA + (size_t)(t + 2) * kstep); const char* b2 = uptr(last ? nB : cB + (size_t)(t + 2) * kstep);
            const char* a3 = a2 + kstep; const char* b3 = b2 + kstep;
            if (last && has_next) S.a_ready(nxt);
            if constexpr (SP2) {
            PG8_LDB(B0, 0, 0); PG8_LDB(B1, 0, 1); PG8_SCHED; PG8_LDA(At, 0, 0); PG8_STAGE(PG8_SA(1, 1), a1 + hstepA, voffA);
            PG8_WAIT_V(8); PG8_WAIT_L(0); PG8_BAR; PG8_MMA(0, 0, At, B0); PG8_MMA(0, 1, At, B1); PG8_BAR; PG8_SCHED;
            PG8_LDA(At, 0, 1); PG8_STAGE(PG8_SB(0, 0), b2, voffB); PG8_STAGE(PG8_SB(0, 1), b2 + hstepB, voffB); PG8_STAGE(PG8_SA(0, 0), a2, voffA);
            PG8_WAIT_V(8); PG8_WAIT_L(0); PG8_BAR; PG8_MMA(1, 0, At, B0); PG8_MMA(1, 1, At, B1); PG8_BAR; PG8_SCHED;
            PG8_LDB(B0, 1, 0); PG8_LDB(B1, 1, 1); PG8_SCHED; PG8_LDA(At, 1, 0); PG8_STAGE(PG8_SA(0, 1), a2 + hstepA, voffA);
            PG8_WAIT_V(8); PG8_WAIT_L(0); PG8_BAR; PG8_MMA(0, 0, At, B0); PG8_MMA(0, 1, At, B1); PG8_BAR; PG8_SCHED;
            PG8_LDA(At, 1, 1); PG8_STAGE(PG8_SB(1, 0), b3, voffB); PG8_STAGE(PG8_SB(1, 1), b3 + hstepB, voffB); PG8_STAGE(PG8_SA(1, 0), a3, voffA);
            PG8_WAIT_V(8); PG8_WAIT_L(0); PG8_BAR; PG8_MMA(1, 0, At, B0); PG8_MMA(1, 1, At, B1); PG8_BAR; PG8_SCHED;
            } else {
            PG8_LDB(B0, 0, 0); PG8_SCHED; PG8_LDA(At, 0, 0); PG8_STAGE(PG8_SA(1, 1), a1 + hstepA, voffA);
            PG8_WAIT_L(8); PG8_BAR; PG8_WAIT_L(0); PG8_MMA(0, 0, At, B0); PG8_BAR; PG8_SCHED;
            PG8_LDB(B1, 0, 1); PG8_STAGE(PG8_SB(0, 0), b2, voffB);
            PG8_BAR; PG8_WAIT_L(0); PG8_MMA(0, 1, At, B1); PG8_BAR;
            PG8_LDA(At, 0, 1); PG8_STAGE(PG8_SA(0, 0), a2, voffA);
            PG8_BAR; PG8_WAIT_L(0); PG8_MMA(1, 0, At, B0); PG8_BAR; PG8_SCHED;
            PG8_STAGE(PG8_SB(0, 1), b2 + hstepB, voffB);
            PG8_WAIT_V(6); PG8_BAR; PG8_MMA(1, 1, At, B1); PG8_BAR;
            PG8_LDB(B0, 1, 0); PG8_SCHED; PG8_LDA(At, 1, 0); PG8_STAGE(PG8_SA(0, 1), a2 + hstepA, voffA);
            PG8_WAIT_L(8); PG8_BAR; PG8_WAIT_L(0); PG8_MMA(0, 0, At, B0); PG8_BAR; PG8_SCHED;
            PG8_LDB(B1, 1, 1); PG8_STAGE(PG8_SB(1, 0), b3, voffB);
            PG8_BAR; PG8_WAIT_L(0); PG8_MMA(0, 1, At, B1); PG8_BAR;
            PG8_LDA(At, 1, 1); PG8_STAGE(PG8_SA(1, 0), a3, voffA);
            PG8_BAR; PG8_WAIT_L(0); PG8_MMA(1, 0, At, B0); PG8_BAR; PG8_SCHED;
            PG8_STAGE(PG8_SB(1, 1), b3 + hstepB, voffB);
            PG8_WAIT_V(6); PG8_BAR; PG8_MMA(1, 1, At, B1); PG8_BAR;
            }
        }
        if constexpr (FP8) asm volatile("s_nop 15\n\ts_nop 7" ::: "memory");
        if constexpr (ALIGN_EPI) { if (wr == 0) PG8_BAR; }
        if constexpr (!Epi::AFTER_DRAIN) { E(acc, cur, wr, wc, fr, fq); S.done(cur); }
        if (!has_next) break;
#pragma unroll
        for (int a = 0; a < 2; ++a)
#pragma unroll
            for (int b = 0; b < 2; ++b)
#pragma unroll
                for (int m = 0; m < 4; ++m)
#pragma unroll
                    for (int n = 0; n < 2; ++n) acc[a][b][m][n] = (f32x4){0.f, 0.f, 0.f, 0.f};
        cur = nxt; cA = nA; cB = nB; ++ui;
        if constexpr (ALIGN_EPI) { if (wr == 1) PG8_BAR; }
    }
    PG8_WAIT_V(0);
    if constexpr (!ALIGN_EPI) { if (wr == 0) PG8_BAR; }
    PG8_BAR;
    if constexpr (Epi::AFTER_DRAIN) { E.fused(acc, cur, wr, wc, fr, fq, lds, wid, lane); S.done(cur); }
#undef PG8_SA
#undef PG8_SB
#undef PG8_STAGE
#undef PG8_RDA
#undef PG8_RDB
#undef PG8_LDA
#undef PG8_LDB
#undef PG8_MMA
#undef PG8_WAIT_V
#undef PG8_WAIT_L
#undef PG8_BAR
#undef PG8_SCHED
}
}

#ifndef MK_FFN_FP8
#define MK_FFN_FP8 1
#endif
constexpr bool FFN_FP8 = MK_FFN_FP8;
constexpr int NWAVES = 8, NTHREADS = NWAVES * 64;
constexpr int BATCH = 2, SEQ = 8192, M = BATCH * SEQ, DM = 2048, DEPTH = 4, DFF = 5632, NGU = 2 * DFF, INC = 5976, NIN = 6144, NMOD = 9 * DM;
constexpr int DFFP = DFF + 128;
constexpr int NH = 8, HD = 64, GWID = 512, TOPK = 256, WINDOW = 128;
constexpr int PA_Q = 0, PA_K = 512, PA_V = 576, PA_IQ = 640, PA_IK = 1664, PB_Q = 1728, PB_K = 2240, PB_V = 2304, PC_Q = 2368, PC_K = 2880, PC_V = 3392, PC_G = 3904,
              PD_Q = 4416, PD_K = 4928, PD_V = 5440, PA_IW = 5952, PC_F = 5968;
constexpr float RMS_EPS = 1e-6f, LOG2E = 1.4426950408889634f, QSCALE = 0.125f * LOG2E;

constexpr size_t MiB = 1u << 20;
constexpr size_t WS_CTL = 0, CTL_ZERO_BYTES = 1 * MiB;
constexpr size_t WS_MOD = 1 * MiB;
constexpr size_t WS_LF = 2 * MiB;
constexpr size_t WS_KB2 = 3 * MiB;
constexpr size_t WS_WGU = 4 * MiB;
constexpr size_t SZ_WGU = (size_t)NGU * DM * 2;
constexpr size_t WS_WD = WS_WGU + 8 * SZ_WGU;
constexpr size_t SZ_WD = (size_t)DM * DFF * 2;
constexpr size_t WS_WIN = WS_WD + 8 * SZ_WD;
constexpr size_t SZ_WIN = (size_t)NIN * DM * 2;
constexpr size_t WS_WOUT = WS_WIN + 4 * SZ_WIN;
constexpr size_t SZ_WOUT = (size_t)DM * DM * 2;
constexpr size_t WS_H = WS_WOUT + 4 * SZ_WOUT;
constexpr size_t WS_P = WS_H + (size_t)M * DM * 2;
constexpr size_t WS_Y = WS_P + (size_t)M * NIN * 2;
constexpr size_t WS_IDX = WS_Y + (size_t)M * DM * 2;
constexpr size_t WS_SC = WS_IDX + (size_t)M * TOPK * 4;
constexpr size_t WS_XB = WS_SC + (size_t)BATCH * SEQ * SEQ * 2;
constexpr size_t WS_END = WS_XB + (size_t)M * DM * 2;
static_assert(WS_WGU % MiB == 0 && WS_WD % MiB == 0 && WS_WIN % MiB == 0 && WS_WOUT % MiB == 0 && WS_H % MiB == 0 && WS_P % MiB == 0 && WS_Y % MiB == 0 && WS_IDX % MiB == 0 && WS_SC % MiB == 0, "d_ws map alignment");
constexpr int CW_BAR = 4096;

constexpr int RING_OFF = 0, RING_BYTES = 131072;
constexpr int AUX_OFF = RING_BYTES, AUX_BYTES = 16384;
constexpr int LDSCTL_OFF = AUX_OFF + AUX_BYTES;
constexpr int LDS_BYTES = LDSCTL_OFF + 256;

#define GAS __attribute__((address_space(1)))
#define LAS __attribute__((address_space(3)))
typedef unsigned short bf16;
typedef unsigned v4u __attribute__((ext_vector_type(4)));
typedef unsigned v2u __attribute__((ext_vector_type(2)));
typedef int v4i __attribute__((ext_vector_type(4)));
typedef float f32x4 __attribute__((ext_vector_type(4)));
typedef float f32x16 __attribute__((ext_vector_type(16)));
typedef short bf16x8 __attribute__((ext_vector_type(8)));
typedef short s16x4 __attribute__((ext_vector_type(4)));
typedef GAS unsigned gu32;
#define RLX_AGENT __ATOMIC_RELAXED, __HIP_MEMORY_SCOPE_AGENT
#define LDS_WAIT() asm volatile("s_waitcnt lgkmcnt(0)" ::: "memory")
#define VM_WAIT() asm volatile("s_waitcnt vmcnt(0)" ::: "memory")
__device__ __forceinline__ unsigned f2bf(float f) { unsigned u = __builtin_bit_cast(unsigned, f); return (u + 0x7fffu + ((u >> 16) & 1u)) >> 16; }
__device__ __forceinline__ unsigned pk2(float lo, float hi) { return f2bf(lo) | (f2bf(hi) << 16); }
__device__ __forceinline__ float bf_lo(unsigned w) { return __builtin_bit_cast(float, w << 16); }
__device__ __forceinline__ float bf_hi(unsigned w) { return __builtin_bit_cast(float, w & 0xffff0000u); }
__device__ __forceinline__ float bf2f(bf16 h) { return __builtin_bit_cast(float, (unsigned)h << 16); }
__device__ __forceinline__ float wave_sum(float v) {
#pragma unroll
    for (int o = 1; o < 64; o <<= 1) v += __shfl_xor(v, o);
    return v;
}
__device__ __forceinline__ float fexp2(float x) { return __builtin_amdgcn_exp2f(x); }
__device__ __forceinline__ float frcp(float x) { return __builtin_amdgcn_rcpf(x); }
__device__ const unsigned char kBucketLut[128] = {0, 1, 2, 3, 4, 5, 6, 7, 8, 9, 10, 11, 12, 13, 14, 15, 16, 16, 16, 17, 17, 18, 18, 18, 19, 19, 19, 20, 20, 20, 20, 21, 21, 21, 21, 22, 22, 22, 22, 22,
    23, 23, 23, 23, 23, 23, 24, 24, 24, 24, 24, 24, 25, 25, 25, 25, 25, 25, 25, 26, 26, 26, 26, 26, 26, 26, 26, 27, 27, 27, 27, 27, 27, 27, 27, 27, 27, 28, 28, 28, 28, 28, 28, 28, 28, 28, 28,
    29, 29, 29, 29, 29, 29, 29, 29, 29, 29, 29, 29, 30, 30, 30, 30, 30, 30, 30, 30, 30, 30, 30, 30, 30, 30, 31, 31, 31, 31, 31, 31, 31, 31, 31, 31, 31, 31, 31, 31, 31};

#define XB_TMO      128
#define XB_XCNT(j)  (256  + 64 * (j))
#define XB_XSUB(j)  (1280 + 64 * (j))
#define XB_XGEN(j)  (2304 + 64 * (j))
#define XB_TOP      3328
#define XB_TOPGEN   3392
#define XCD_BAR_WORDS 3456
#define XB_SPIN_CAP (1u << 18)

__device__ __forceinline__ unsigned xb_ld(unsigned* p)              { return __hip_atomic_load((GAS unsigned*)p, __ATOMIC_RELAXED, __HIP_MEMORY_SCOPE_AGENT); }
__device__ __forceinline__ unsigned xb_add(unsigned* p, unsigned v) { return __hip_atomic_fetch_add((GAS unsigned*)p, v, __ATOMIC_RELAXED, __HIP_MEMORY_SCOPE_AGENT); }
__device__ __forceinline__ unsigned xb_xcc_id() { return (unsigned)__builtin_amdgcn_s_getreg((3 << 11) | 20) & 0xFu; }
#define XB_SPIN(cond, bar) do { unsigned _sp = 0; while (cond) { __builtin_amdgcn_s_sleep(1); \
    if ((++_sp & 255u) == 0u) { if (xb_ld(&(bar)[XB_TMO])) break; if (_sp > XB_SPIN_CAP) { xb_add(&(bar)[XB_TMO], 1u); break; } } } } while (0)

struct XcdBarrier {
    unsigned* bar; unsigned x;
    volatile LAS unsigned* st;
};

__device__ __forceinline__ XcdBarrier xcd_barrier_post(unsigned* bar, volatile LAS unsigned* st) {
    XcdBarrier b; b.bar = bar; b.x = xb_xcc_id(); b.st = st;
    if (threadIdx.x == 0) (void)xb_add(&bar[XB_XCNT(b.x)], 1u);
    return b;
}
__device__ __forceinline__ void xcd_barrier_complete(unsigned* bar, unsigned x, unsigned& nloc, unsigned& nx) {
    const unsigned G = gridDim.x * gridDim.y * gridDim.z;
    unsigned sum, cnt, mine, sp = 0u;
    for (;;) {
        sum = 0u; cnt = 0u; mine = 0u;
#pragma unroll
        for (unsigned j = 0; j < 16; ++j) { const unsigned c = xb_ld(&bar[XB_XCNT(j)]); sum += c; cnt += (c > 0u) ? 1u : 0u; mine = (j == x) ? c : mine; }
        if (sum == G) break;
        __builtin_amdgcn_s_sleep(1);
        if ((++sp & 255u) == 0u) { if (xb_ld(&bar[XB_TMO])) break; if (sp > XB_SPIN_CAP) { xb_add(&bar[XB_TMO], 1u); break; } }
    }
    nloc = mine > 0u ? mine : 1u; nx = cnt > 0u ? cnt : 1u;
}

__device__ __forceinline__ void xcd_barrier(const XcdBarrier& b) {
    asm volatile("s_waitcnt vmcnt(0)" ::: "memory");
    __syncthreads();
    if (threadIdx.x == 0) {
        unsigned* bar = b.bar; asm volatile("" : "+s"(bar));
        __builtin_amdgcn_s_waitcnt(0);
        unsigned nloc = b.st[0], nx = b.st[1];
        if (nloc == 0u) { xcd_barrier_complete(bar, b.x, nloc, nx); b.st[0] = nloc; b.st[1] = nx; }
        const unsigned old = xb_add(&bar[XB_XSUB(b.x)], 1u);
        const unsigned gen = old / nloc;
        if (old + 1u == (gen + 1u) * nloc) {
            __builtin_amdgcn_fence(__ATOMIC_RELEASE, "agent");
            asm volatile("s_waitcnt vmcnt(0)" ::: "memory");
            const unsigned og = xb_add(&bar[XB_TOP], 1u);
            const unsigned tg = og / nx;
            if (og + 1u == (tg + 1u) * nx) xb_add(&bar[XB_TOPGEN], 1u);
            else XB_SPIN(xb_ld(&bar[XB_TOPGEN]) == tg, bar);
            __builtin_amdgcn_fence(__ATOMIC_ACQUIRE, "agent");
            xb_add(&bar[XB_XGEN(b.x)], 1u);
            asm volatile("s_waitcnt vmcnt(0)" ::: "memory");
        } else {
            XB_SPIN(xb_ld(&bar[XB_XGEN(b.x)]) == gen, bar);
            __builtin_amdgcn_fence(__ATOMIC_ACQUIRE, "agent");
            asm volatile("s_waitcnt vmcnt(0)" ::: "memory");
        }
    }
    __syncthreads();
}

struct Frame {
    LAS unsigned char* lds;
    gu32* ctl;
    int tid, lane, wave, G, gw, NGW;
    const float *x, *c, *w_ada, *b_ada, *norm_g, *w_in, *qk_g, *forget_b, *sinks, *rel_table, *group_g, *w_out, *w_gate, *w_up, *w_down;
    float* out;
    float *MOD, *LF, *KB2; unsigned short* SC; int* IDX;
    bf16 *WGU, *WD, *WIN, *WOUT, *H, *P, *Y, *XB;
};

template <int MAP> __device__ __forceinline__ int w_rowmap(int n) {
    if (MAP == 1) return 256 * (n >> 7) + (n & 127);
    if (MAP == 2) return 256 * (n >> 7) + 128 + (n & 127);
    if (MAP == 3) { if (n < 1728) return n; if (n < 1744) return PA_IW + (n - 1728); if (n < 3920) return n - 16; if (n < 3928) return PC_F + (n - 3920); return n - 24; }
    return n;
}
template <int MAP> __device__ __forceinline__ void p0_transpose_item(const float* W, int K, int N, bf16* WT, LAS unsigned* T, int item, int lane) {
    const int nblk = (N + 63) / 64, kb = item / nblk, nb = item % nblk, k0 = 64 * kb, n0 = 64 * nb;
    const int r = lane >> 4, c = lane & 15;
    const bool nok = (n0 + 4 * c) < N;
    const float* src = W + (size_t)(k0 + 2 * r) * N + n0 + 4 * c;
    f32x4 a[8], b[8];
#pragma unroll
    for (int i = 0; i < 8; ++i) { a[i] = nok ? *(const GAS f32x4*)(src + (size_t)(8 * i) * N) : (f32x4){0.f, 0.f, 0.f, 0.f}; b[i] = nok ? *(const GAS f32x4*)(src + (size_t)(8 * i + 1) * N) : (f32x4){0.f, 0.f, 0.f, 0.f}; }
#pragma unroll
    for (int i = 0; i < 8; ++i)
#pragma unroll
        for (int e = 0; e < 4; ++e) T[(4 * c + e) * 36 + 4 * i + r] = pk2(a[i][e], b[i][e]);
    LDS_WAIT(); asm volatile("" ::: "memory");
    const int rr = lane >> 3, ch = lane & 7;
#pragma unroll
    for (int j = 0; j < 8; ++j) { const int n = 8 * j + rr; const v4u o = *(const LAS v4u*)(T + n * 36 + 4 * ch);
        if (n0 + n < N) *(GAS v4u*)(WT + (size_t)w_rowmap<MAP>(n0 + n) * K + k0 + 8 * ch) = o; }
    LDS_WAIT(); asm volatile("" ::: "memory");
}
constexpr float W8_SCALE = 64.0f; constexpr int W8_E8M0 = 127 - 6;
__device__ __forceinline__ unsigned pk_fp8x4(float a, float b, float c, float d) {
    a = fminf(fmaxf(a, -448.f), 448.f); b = fminf(fmaxf(b, -448.f), 448.f); c = fminf(fmaxf(c, -448.f), 448.f); d = fminf(fmaxf(d, -448.f), 448.f);
    int w = 0; w = __builtin_amdgcn_cvt_pk_fp8_f32(a, b, w, false); w = __builtin_amdgcn_cvt_pk_fp8_f32(c, d, w, true); return (unsigned)w; }
template <int MAP> __device__ __forceinline__ void p0_transpose8_item(const float* W, int K, int N, unsigned char* WT, int ldw, LAS unsigned* T, int item, int lane) {
    const int nblk = (N + 63) / 64, kb = item / nblk, nb = item % nblk, k0 = 64 * kb, n0 = 64 * nb;
    const int r = lane >> 4, c = lane & 15;
    const bool nok = (n0 + 4 * c) < N;
    const float* src = W + (size_t)(k0 + 4 * r) * N + n0 + 4 * c;
    f32x4 q[4][4];
#pragma unroll
    for (int i = 0; i < 4; ++i)
#pragma unroll
        for (int d = 0; d < 4; ++d) q[i][d] = nok ? *(const GAS f32x4*)(src + (size_t)(16 * i + d) * N) : (f32x4){0.f, 0.f, 0.f, 0.f};
#pragma unroll
    for (int i = 0; i < 4; ++i)
#pragma unroll
        for (int e = 0; e < 4; ++e) T[(4 * c + e) * 20 + 4 * i + r] = pk_fp8x4(q[i][0][e] * W8_SCALE, q[i][1][e] * W8_SCALE, q[i][2][e] * W8_SCALE, q[i][3][e] * W8_SCALE);
    LDS_WAIT(); asm volatile("" ::: "memory");
    const int rr = lane >> 2, ch = lane & 3;
#pragma unroll
    for (int j = 0; j < 4; ++j) { const int n = 16 * j + rr; const v4u o = *(const LAS v4u*)(T + n * 20 + 4 * ch);
        if (n0 + n < N) *(GAS v4u*)(WT + (size_t)w_rowmap<MAP>(n0 + n) * ldw + k0 + 16 * ch) = o; }
    LDS_WAIT(); asm volatile("" ::: "memory");
}
template <int MAP> __device__ __forceinline__ void p0_transpose8(const Frame& F, const float* W, int K, int N, unsigned char* WT, int ldw, LAS unsigned* scr) {
    const int nitems = (K / 64) * ((N + 63) / 64);
    for (int it = F.gw; it < nitems; it += F.NGW) p0_transpose8_item<MAP>(W, K, N, WT, ldw, scr, it, F.lane);
}
template <int MAP> __device__ __forceinline__ void p0_transpose(const Frame& F, const float* W, int K, int N, bf16* WT, LAS unsigned* scr) {
    const int nitems = (K / 64) * ((N + 63) / 64);
    for (int it = F.gw; it < nitems; it += F.NGW) p0_transpose_item<MAP>(W, K, N, WT, scr, it, F.lane);
}
__device__ __forceinline__ void p0_prologue(const Frame& F) {
    LAS unsigned* scr = (LAS unsigned*)(F.lds + RING_OFF + F.wave * 16384);
    LAS float* cond = (LAS float*)(F.lds + AUX_OFF);
    LAS float* red = (LAS float*)(F.lds + RING_OFF);
    for (int i = F.tid; i < BATCH * DM; i += NTHREADS) { const float v = F.c[i]; cond[i] = v / (1.0f + __expf(-v)); }
    __syncthreads();
    for (int it = blockIdx.x; it < DEPTH * (NMOD / 64); it += F.G) {
        const int l = it / (NMOD / 64), n = (it % (NMOD / 64)) * 64 + F.lane;
        const float* w = F.w_ada + (size_t)l * DM * NMOD + (size_t)(256 * F.wave) * NMOD + n;
        const LAS float* c0 = cond + 256 * F.wave; const LAS float* c1 = cond + DM + 256 * F.wave;
        float a0 = 0.f, a1 = 0.f;
#pragma unroll 32
        for (int k = 0; k < 256; ++k) { const float wv = w[(size_t)k * NMOD]; a0 += c0[k] * wv; a1 += c1[k] * wv; }
        red[F.wave * 128 + F.lane] = a0; red[F.wave * 128 + 64 + F.lane] = a1;
        __syncthreads();
        if (F.tid < 128) { float sacc = 0.f;
#pragma unroll
            for (int wv = 0; wv < 8; ++wv) sacc += red[wv * 128 + F.tid];
            const int bsel = F.tid >> 6, nn = (it % (NMOD / 64)) * 64 + (F.tid & 63);
            F.MOD[((size_t)l * BATCH + bsel) * NMOD + nn] = sacc + F.b_ada[(size_t)l * NMOD + nn]; }
        __syncthreads();
    }
    for (int lf = 0; lf < DEPTH * 2; ++lf) {
        if (FFN_FP8) {
            p0_transpose8<1>(F, F.w_gate + (size_t)lf * DM * DFF, DM, DFF, (unsigned char*)F.WGU + (size_t)lf * NGU * DM, DM, scr);
            p0_transpose8<2>(F, F.w_up + (size_t)lf * DM * DFF, DM, DFF, (unsigned char*)F.WGU + (size_t)lf * NGU * DM, DM, scr);
            p0_transpose8<0>(F, F.w_down + (size_t)lf * DFF * DM, DFF, DM, (unsigned char*)F.WD + (size_t)lf * DM * DFFP, DFFP, scr);
        } else {
            p0_transpose<1>(F, F.w_gate + (size_t)lf * DM * DFF, DM, DFF, F.WGU + (size_t)lf * NGU * DM, scr);
            p0_transpose<2>(F, F.w_up + (size_t)lf * DM * DFF, DM, DFF, F.WGU + (size_t)lf * NGU * DM, scr);
            p0_transpose<0>(F, F.w_down + (size_t)lf * DFF * DM, DFF, DM, F.WD + (size_t)lf * DM * DFF, scr);
        }
    }
    for (int l = 0; l < DEPTH; ++l) {
        p0_transpose<3>(F, F.w_in + (size_t)l * DM * INC, DM, INC, F.WIN + (size_t)l * NIN * DM, scr);
        p0_transpose<0>(F, F.w_out + (size_t)l * DM * DM, DM, DM, F.WOUT + (size_t)l * DM * DM, scr);
        GAS v4u* z = (GAS v4u*)(F.WIN + (size_t)l * NIN * DM + (size_t)INC * DM);
        for (int i = F.gw * 64 + F.lane; i < (NIN - INC) * DM / 8; i += F.NGW * 64) z[i] = (v4u){0u, 0u, 0u, 0u};
    }
}

template <bool OUT8, bool IN16> __device__ __forceinline__ void ph_modulate(const Frame& F, const void* xin, const float* g, const float* shift, const float* scale) {
    for (int m = F.gw; m < M; m += F.NGW) {
        const int b = m / SEQ;
        float x[4][8]; float s = 0.f;
        if constexpr (IN16) {
            const GAS v4u* xr = (const GAS v4u*)((const bf16*)xin + (size_t)m * DM) + F.lane;
            v4u w[4];
#pragma unroll
            for (int j = 0; j < 4; ++j) w[j] = xr[64 * j];
#pragma unroll
            for (int j = 0; j < 4; ++j) { x[j][0] = bf_lo(w[j].x); x[j][1] = bf_hi(w[j].x); x[j][2] = bf_lo(w[j].y); x[j][3] = bf_hi(w[j].y); x[j][4] = bf_lo(w[j].z); x[j][5] = bf_hi(w[j].z); x[j][6] = bf_lo(w[j].w); x[j][7] = bf_hi(w[j].w); }
        } else {
            const GAS f32x4* xr = (const GAS f32x4*)((const float*)xin + (size_t)m * DM) + 2 * F.lane;
            f32x4 a[4][2];
#pragma unroll
            for (int j = 0; j < 4; ++j) { a[j][0] = xr[128 * j]; a[j][1] = xr[128 * j + 1]; }
            GAS v4u* xo = (GAS v4u*)(F.XB + (size_t)m * DM) + F.lane;
#pragma unroll
            for (int j = 0; j < 4; ++j) { x[j][0] = a[j][0].x; x[j][1] = a[j][0].y; x[j][2] = a[j][0].z; x[j][3] = a[j][0].w; x[j][4] = a[j][1].x; x[j][5] = a[j][1].y; x[j][6] = a[j][1].z; x[j][7] = a[j][1].w;
                v4u w; w.x = pk2(x[j][0], x[j][1]); w.y = pk2(x[j][2], x[j][3]); w.z = pk2(x[j][4], x[j][5]); w.w = pk2(x[j][6], x[j][7]); xo[64 * j] = w; }
        }
#pragma unroll
        for (int j = 0; j < 4; ++j) s += ((x[j][0] * x[j][0] + x[j][1] * x[j][1]) + (x[j][2] * x[j][2] + x[j][3] * x[j][3])) + ((x[j][4] * x[j][4] + x[j][5] * x[j][5]) + (x[j][6] * x[j][6] + x[j][7] * x[j][7]));
        const float rstd = 1.0f / sqrtf(wave_sum(s) * (1.f / DM) + RMS_EPS);
        const GAS f32x4* gp = (const GAS f32x4*)g + 2 * F.lane; const GAS f32x4* sh = (const GAS f32x4*)(shift + (size_t)b * NMOD) + 2 * F.lane; const GAS f32x4* sc = (const GAS f32x4*)(scale + (size_t)b * NMOD) + 2 * F.lane;
        GAS v4u* o16 = (GAS v4u*)(F.H + (size_t)m * DM) + F.lane;
        GAS v2u* o8 = (GAS v2u*)((unsigned char*)F.H + (size_t)m * DM) + F.lane;
#pragma unroll
        for (int j = 0; j < 4; ++j) { float y[8];
#pragma unroll
            for (int h = 0; h < 2; ++h) { const f32x4 gg = gp[128 * j + h], ss = sc[128 * j + h], hh = sh[128 * j + h];
                y[4 * h + 0] = x[j][4 * h + 0] * rstd * gg.x * (ss.x + 1.0f) + hh.x; y[4 * h + 1] = x[j][4 * h + 1] * rstd * gg.y * (ss.y + 1.0f) + hh.y;
                y[4 * h + 2] = x[j][4 * h + 2] * rstd * gg.z * (ss.z + 1.0f) + hh.z; y[4 * h + 3] = x[j][4 * h + 3] * rstd * gg.w * (ss.w + 1.0f) + hh.w; }
            if (OUT8) { v2u w; w.x = pk_fp8x4(y[0], y[1], y[2], y[3]); w.y = pk_fp8x4(y[4], y[5], y[6], y[7]); o8[64 * j] = w; }
            else { v4u w; w.x = pk2(y[0], y[1]); w.y = pk2(y[2], y[3]); w.z = pk2(y[4], y[5]); w.w = pk2(y[6], y[7]); o16[64 * j] = w; } }
    }
}
__device__ __forceinline__ v4u headnorm8(v4u w, const float* g, float mul, int lane, bool normalize) {
    float x[8] = {bf_lo(w.x), bf_hi(w.x), bf_lo(w.y), bf_hi(w.y), bf_lo(w.z), bf_hi(w.z), bf_lo(w.w), bf_hi(w.w)};
    float r = mul;
    if (normalize) {
        float s = 0.f;
#pragma unroll
        for (int i = 0; i < 8; ++i) s += x[i] * x[i];
        s += __shfl_xor(s, 1); s += __shfl_xor(s, 2); s += __shfl_xor(s, 4);
        r = mul / sqrtf(s * (1.f / 64.f) + RMS_EPS);
        const f32x4 g0 = *(const GAS f32x4*)(g + 8 * (lane & 7)), g1 = *(const GAS f32x4*)(g + 8 * (lane & 7) + 4);
        x[0] *= g0.x; x[1] *= g0.y; x[2] *= g0.z; x[3] *= g0.w; x[4] *= g1.x; x[5] *= g1.y; x[6] *= g1.z; x[7] *= g1.w;
    }
    w.x = pk2(x[0] * r, x[1] * r); w.y = pk2(x[2] * r, x[3] * r); w.z = pk2(x[4] * r, x[5] * r); w.w = pk2(x[6] * r, x[7] * r);
    return w;
}
__device__ __forceinline__ void ph_post(const Frame& F, int l) {
    const float* qg = F.qk_g + (size_t)l * 6 * HD;
    for (int m = F.gw; m < M; m += F.NGW) {
        bf16* row = F.P + (size_t)m * NIN; const int lane = F.lane;
        GAS v4u* paq = (GAS v4u*)(row + PA_Q + 8 * lane); GAS v4u* pbq = (GAS v4u*)(row + PB_Q + 8 * lane); GAS v4u* pcq = (GAS v4u*)(row + PC_Q + 8 * lane);
        GAS v4u* pck = (GAS v4u*)(row + PC_K + 8 * lane); GAS v4u* pdq = (GAS v4u*)(row + PD_Q + 8 * lane);
        GAS v4u* pkk = (GAS v4u*)(row + (lane < 8 ? PA_K : PB_K) + 8 * (lane & 7));
        const v4u waq = *paq, wbq = *pbq, wcq = *pcq, wck = *pck, wdq = *pdq;
        v4u wkk = {0u, 0u, 0u, 0u}; if (lane < 16) wkk = *pkk;
        *paq = headnorm8(waq, qg + 0 * HD, QSCALE, lane, true);
        *pbq = headnorm8(wbq, qg + 2 * HD, QSCALE, lane, true);
        *pcq = headnorm8(wcq, qg + 4 * HD, QSCALE, lane, true);
        *pck = headnorm8(wck, qg + 5 * HD, 1.0f, lane, true);
        *pdq = headnorm8(wdq, qg, QSCALE, lane, false);
        if (lane < 16) *pkk = headnorm8(wkk, qg + (lane < 8 ? 1 : 3) * HD, 1.0f, lane, true);
    }
}
__device__ __forceinline__ void ph_scan(const Frame& F, int l) {
    LAS float* wtot = (LAS float*)(F.lds + RING_OFF);
    for (int sq = blockIdx.x; sq < BATCH * NH; sq += F.G) {
        const int b = sq / NH, h = sq % NH; const float fb = F.forget_b[(size_t)l * NH + h];
        const GAS unsigned short* src = (const GAS unsigned short*)(F.P + ((size_t)b * SEQ + 16 * F.tid) * NIN + PC_F + h); float* dst = F.KB2 + (size_t)sq * SEQ + 16 * F.tid;
        float v[16]; unsigned short raw[16];
#pragma unroll
        for (int i = 0; i < 16; ++i) raw[i] = src[(size_t)i * NIN];
#pragma unroll
        for (int i = 0; i < 16; ++i) { const float y = __builtin_bit_cast(float, (unsigned)raw[i] << 16) + fb; v[i] = (y >= 0.f) ? -log1pf(__expf(-y)) : (y - log1pf(__expf(y))); }
#pragma unroll
        for (int i = 1; i < 16; ++i) v[i] += v[i - 1];
        float incl = v[15];
#pragma unroll
        for (int o = 1; o < 64; o <<= 1) { const float t = __shfl_up(incl, o); if (F.lane >= o) incl += t; }
        if (F.lane == 63) wtot[F.wave] = incl;
        __syncthreads();
        float base = incl - v[15];
        for (int w = 0; w < F.wave; ++w) base += wtot[w];
#pragma unroll
        for (int i = 0; i < 4; ++i) *(GAS f32x4*)(dst + 4 * i) = (f32x4){-(v[4 * i] + base) * LOG2E, -(v[4 * i + 1] + base) * LOG2E, -(v[4 * i + 2] + base) * LOG2E, -(v[4 * i + 3] + base) * LOG2E};
        __syncthreads();
    }
}
__device__ __forceinline__ void ph_gnorm(const Frame& F, int l) {
    const float* gg = F.group_g + (size_t)l * DM;
    for (int m = F.gw; m < M; m += F.NGW) {
        v4u w[4];
#pragma unroll
        for (int g = 0; g < 4; ++g) w[g] = *(GAS v4u*)(F.Y + (size_t)m * DM + g * GWID + 8 * F.lane);
#pragma unroll
        for (int g = 0; g < 4; ++g) {
            bf16* p = F.Y + (size_t)m * DM + g * GWID + 8 * F.lane;
            float x[8] = {bf_lo(w[g].x), bf_hi(w[g].x), bf_lo(w[g].y), bf_hi(w[g].y), bf_lo(w[g].z), bf_hi(w[g].z), bf_lo(w[g].w), bf_hi(w[g].w)};
            float s = 0.f;
#pragma unroll
            for (int i = 0; i < 8; ++i) s += x[i] * x[i];
            const float r = 1.0f / sqrtf(wave_sum(s) * (1.f / GWID) + RMS_EPS);
            const f32x4 g0 = *(const GAS f32x4*)(gg + g * GWID + 8 * F.lane), g1 = *(const GAS f32x4*)(gg + g * GWID + 8 * F.lane + 4);
            v4u o; o.x = pk2(x[0] * r * g0.x, x[1] * r * g0.y); o.y = pk2(x[2] * r * g0.z, x[3] * r * g0.w); o.z = pk2(x[4] * r * g1.x, x[5] * r * g1.y); o.w = pk2(x[6] * r * g1.z, x[7] * r * g1.w);
            *(GAS v4u*)p = o;
        }
    }
}


__device__ __forceinline__ unsigned short score_key(float sc) {
    const _Float16 hf = (_Float16)fminf(fmaxf(sc, -60000.f), 60000.f);
    const unsigned h = (unsigned)__builtin_bit_cast(unsigned short, hf);
    return (unsigned short)((h & 0x8000u) ? (~h & 0xffffu) : (h | 0x8000u));
}
__device__ __forceinline__ void glds16x(const void* gsrc, unsigned lds_dst) { unsigned keep;
    asm volatile("s_mov_b32 %0, m0\n\ts_mov_b32 m0, %2\n\ts_nop 0\n\tglobal_load_lds_dwordx4 %1, off\n\ts_mov_b32 m0, %0" : "=&s"(keep) : "v"(gsrc), "s"(lds_dst) : "memory"); }
__device__ __forceinline__ void ph_idx_scores(const Frame& F) {
    constexpr int UPB = 8 * (16 * 17 / 2), NU = BATCH * UPB;
    const int lane = F.lane, r32 = lane & 31, hi = lane >> 5;
    const int u_lo = (int)(((long)blockIdx.x * NU) / F.G), u_hi = (int)(((long)(blockIdx.x + 1) * NU) / F.G);
    if (u_lo >= u_hi) return;
    int b = u_lo / UPB, qb = 127, kc = 0; { int r = u_lo % UPB; for (;;) { const int n = (qb >> 3) + 1; if (r < n) { kc = r; break; } r -= n; --qb; } }
    LAS unsigned char* KL = F.lds + RING_OFF;
    const unsigned kl_lds = (unsigned)(size_t)KL;
#define X1_STAGE(bb, kk, buf) do { const bf16* ksrc_ = F.P + ((size_t)(bb) * SEQ + 512 * (kk) + 64 * F.wave + lane) * NIN + PA_IK; \
        _Pragma("unroll") for (int c_ = 0; c_ < 8; ++c_) glds16x(ksrc_ + 8 * c_, (unsigned)__builtin_amdgcn_readfirstlane(kl_lds + (buf) * 65536 + c_ * 8192 + F.wave * 1024)); } while (0)
    X1_STAGE(b, kc, 0);
    asm volatile("s_waitcnt vmcnt(0)" ::: "memory"); __syncthreads();
    bf16x8 af[4][4]; float wq[4][16]; int cb = -1, cqb = -1;
    for (int u = u_lo; u < u_hi; ++u) {
        const int cur = (u - u_lo) & 1;
        int nb = b, nqb = qb, nkc = kc + 1; if (nkc > (qb >> 3)) { nkc = 0; --nqb; if (nqb < 0) { nqb = 127; ++nb; } }
        if (u + 1 < u_hi) X1_STAGE(nb, nkc, cur ^ 1);
        const size_t rowb = (size_t)b * SEQ; const int t0 = 64 * qb + 8 * F.wave;
        if (b != cb || qb != cqb) { cb = b; cqb = qb;
#pragma unroll
            for (int pr = 0; pr < 4; ++pr) {
                const bf16* qrow = F.P + (rowb + t0 + 2 * pr + ((r32 >> 2) & 1)) * NIN + PA_IQ + ((r32 & 3) + 4 * (r32 >> 3)) * 64 + 8 * hi;
#pragma unroll
                for (int s = 0; s < 4; ++s) af[pr][s] = *(const GAS bf16x8*)(qrow + 16 * s);
                const bf16* wrow = F.P + (rowb + t0 + 2 * pr + hi) * NIN + PA_IW;
                const v4u w0 = *(const GAS v4u*)wrow, w1 = *(const GAS v4u*)(wrow + 8);
                const unsigned ww[8] = {w0.x, w0.y, w0.z, w0.w, w1.x, w1.y, w1.z, w1.w};
#pragma unroll
                for (int i = 0; i < 8; ++i) { wq[pr][2 * i] = bf_lo(ww[i]) * 0.015625f; wq[pr][2 * i + 1] = bf_hi(ww[i]) * 0.015625f; }
            }
        }
        const int kend = 64 * (qb + 1) - 512 * kc;
        const int nkt = kend >= 512 ? 16 : (kend + 31) / 32;
        const LAS unsigned char* kl = KL + cur * 65536 + hi * 8192 + r32 * 16;
        for (int kt = 0; kt < nkt; ++kt) {
            bf16x8 bfr[4];
#pragma unroll
            for (int s = 0; s < 4; ++s) bfr[s] = *(const LAS bf16x8*)(kl + s * 16384 + kt * 512);
            const int s0 = 512 * kc + 32 * kt;
#pragma unroll
            for (int pr = 0; pr < 4; ++pr) {
                f32x16 acc = {};
#pragma unroll
                for (int s = 0; s < 4; ++s) acc = __builtin_amdgcn_mfma_f32_32x32x16_bf16(af[pr][s], bfr[s], acc, 0, 0, 0);
                float sc0 = 0.f, sc1 = 0.f;
#pragma unroll
                for (int r = 0; r < 16; ++r) { sc0 = __builtin_fmaf(wq[pr][r], acc[r], sc0); sc1 = __builtin_fmaf(wq[pr][r], __builtin_fabsf(acc[r]), sc1); if ((r & 3) == 3) asm("" : "+v"(sc1)); }
                ((GAS unsigned short*)F.SC)[(rowb + t0 + 2 * pr + hi) * SEQ + s0 + r32] = score_key(sc0 + sc1);
                __builtin_amdgcn_sched_barrier(0);
            }
        }
        asm volatile("s_waitcnt vmcnt(0)" ::: "memory");
        __syncthreads();
        b = nb; qb = nqb; kc = nkc;
    }
#undef X1_STAGE
}

__device__ __forceinline__ unsigned mbcnt64(unsigned long long m) { return __builtin_amdgcn_mbcnt_hi((unsigned)(m >> 32), __builtin_amdgcn_mbcnt_lo((unsigned)m, 0u)); }
template <int SH, int PSH> __device__ __forceinline__ void sel_level(const unsigned (&v)[64], int nreg, unsigned pval, unsigned need, LAS unsigned* hist, int lane, unsigned& bin_out, unsigned& above_out) {
#pragma unroll
    for (int i = 0; i < 8; ++i) ((LAS v4u*)hist)[lane + 64 * i] = (v4u){0u, 0u, 0u, 0u};
    LDS_WAIT(); __builtin_amdgcn_wave_barrier();
    const unsigned hb = (unsigned)(size_t)hist, sink = hb + 9216u + 4u * (unsigned)lane;
#pragma unroll
    for (int g = 0; g < 8; ++g) if (8 * g < nreg) {
#pragma unroll
        for (int jj = 0; jj < 8; ++jj) { const int j = 8 * g + jj;
#pragma unroll
            for (int e = 0; e < 2; ++e) { const unsigned k = e ? (v[j] >> 16) : (v[j] & 0xffffu);
                const bool pred = (k != 0u) && (PSH >= 16 || (k >> (PSH & 15)) == pval);
                const unsigned tgt = pred ? hb + (((k >> SH) & 2047u) << 2) : sink;
                __hip_atomic_fetch_add((LAS unsigned*)tgt, 1u, __ATOMIC_RELAXED, __HIP_MEMORY_SCOPE_WAVEFRONT); }
            if ((jj & 1) == 1) __builtin_amdgcn_sched_barrier(0); }
    }
    LDS_WAIT(); __builtin_amdgcn_wave_barrier();
    unsigned S = 0u;
#pragma unroll
    for (int i = 0; i < 8; ++i) { const v4u q = ((LAS v4u*)hist)[lane * 8 + i]; S += (q.x + q.y) + (q.z + q.w); }
    unsigned T = S;
#pragma unroll
    for (int o = 1; o < 64; o <<= 1) { const unsigned t = __shfl_down(T, o); if (lane + o < 64) T += t; }
    const unsigned above_lane = T - S;
    const bool cross = (T >= need) && (above_lane < need);
    unsigned run = above_lane, bin = 0u, ab = 0u; bool found = false;
#pragma unroll
    for (int i = 7; i >= 0; --i) { const v4u q = ((LAS v4u*)hist)[lane * 8 + i]; const unsigned c4[4] = {q.x, q.y, q.z, q.w};
#pragma unroll
        for (int e = 3; e >= 0; --e) { const bool hit = !found && (run + c4[e] >= need); if (hit) { bin = 32u * lane + 4 * i + e; ab = run; found = true; } run += c4[e]; } }
    const unsigned long long cm = __ballot(cross);
    const int src = cm ? (int)__builtin_ctzll(cm) : 0;
    bin_out = __builtin_amdgcn_readlane(bin, src); above_out = __builtin_amdgcn_readlane(ab, src);
    LDS_WAIT(); __builtin_amdgcn_wave_barrier();
}
__device__ __forceinline__ void select_row(const Frame& F, int m, LAS unsigned* hist, LAS int* out) {
    int lane = F.lane; asm volatile("" : "+v"(lane));
    const int t = m % SEQ, n = t + 1;
    if (n <= TOPK) { for (int j = lane; j < TOPK; j += 64) out[j] = (j < n) ? j : 0; return; }
    const int nreg = (n + 127) >> 7;
    unsigned v[64];
    const GAS unsigned* pr = (const GAS unsigned*)(F.SC + (size_t)m * SEQ) + lane;
#pragma unroll
    for (int g = 0; g < 8; ++g) {
        if (8 * g < nreg) {
#pragma unroll
            for (int jj = 0; jj < 8; ++jj) v[8 * g + jj] = pr[jj * 64];
        } else {
#pragma unroll
            for (int jj = 0; jj < 8; ++jj) v[8 * g + jj] = 0u;
        }
        pr += 512; asm volatile("" : "+v"(pr));
    }
    const int nfull = n >> 7;
#pragma unroll
    for (int g = 0; g < 8; ++g) if (8 * g < nreg && 8 * g + 8 > nfull) {
#pragma unroll
        for (int jj = 0; jj < 8; ++jj) { const int j = 8 * g + jj; const int e0 = 128 * j + 2 * lane; const unsigned w = v[j];
            v[j] = ((e0 < n) ? (w & 0xffffu) : 0u) | ((e0 + 1 < n) ? (w & 0xffff0000u) : 0u); asm volatile("" : "+v"(v[j])); }
    }
    unsigned b1, a1, b2, a2;
    sel_level<5, 16>(v, nreg, 0u, (unsigned)TOPK, hist, lane, b1, a1);
    sel_level<0, 5>(v, nreg, b1, (unsigned)TOPK - a1, hist, lane, b2, a2);
    const unsigned tau = (b1 << 5) | (b2 & 31u);
    const unsigned quota = (unsigned)TOPK - a1 - a2;
    unsigned mg[4] = {0u, 0u, 0u, 0u}, me[4] = {0u, 0u, 0u, 0u};
#pragma unroll
    for (int g = 0; g < 8; ++g) {
        if (8 * g < nreg) {
#pragma unroll
            for (int jj = 0; jj < 8; ++jj) { const int j = 8 * g + jj;
#pragma unroll
                for (int e = 0; e < 2; ++e) { const unsigned k = e ? (v[j] >> 16) : (v[j] & 0xffffu);
                    mg[g >> 1] = mg[g >> 1] + mg[g >> 1] + ((k > tau) ? 1u : 0u); me[g >> 1] = me[g >> 1] + me[g >> 1] + ((k == tau) ? 1u : 0u); }
                if ((jj & 3) == 3) __builtin_amdgcn_sched_barrier(0); }
        } else { mg[g >> 1] <<= 16; me[g >> 1] <<= 16; }
    }
    const unsigned cg = (unsigned)(__builtin_popcount(mg[0]) + __builtin_popcount(mg[1]) + __builtin_popcount(mg[2]) + __builtin_popcount(mg[3]));
    unsigned ce = (unsigned)(__builtin_popcount(me[0]) + __builtin_popcount(me[1]) + __builtin_popcount(me[2]) + __builtin_popcount(me[3]));
    unsigned incl = cg | (ce << 16);
#pragma unroll
    for (int o = 1; o < 64; o <<= 1) { const unsigned t = (unsigned)__shfl_up((int)incl, o); if (lane >= o) incl += t; }
    const unsigned excl = incl - (cg | (ce << 16));
    const unsigned pre_g = excl & 0xffffu, pre_e = excl >> 16;
    const unsigned keep = pre_e >= quota ? 0u : ((quota - pre_e) < ce ? (quota - pre_e) : ce);
#pragma unroll
    for (int q = 3; q >= 0; --q) { while (ce > keep && me[q] != 0u) { me[q] &= me[q] - 1u; --ce; } }
    unsigned pos = pre_g + (pre_e < quota ? pre_e : quota);
    const int ilane = 2 * lane;
#pragma unroll
    for (int q = 0; q < 4; ++q) { unsigned mm = mg[q] | me[q];
        while (mm != 0u) { const int bpos = 31 - (int)__builtin_clz(mm); const int sl = 31 - bpos; mm &= ~(1u << bpos);
            const int i = 128 * (16 * q + (sl >> 1)) + ilane + (sl & 1);
            if (pos < (unsigned)TOPK) out[pos] = i;
            ++pos; } }
}


constexpr int AT_K = 0, AT_V = 16384, AT_KB = 32768, AT_WSF = 33280, AT_BT = 35328, AT_DEAD = 35840, AT_SV = 36864;
typedef short v4i16_t __attribute__((ext_vector_type(4)));
__device__ __forceinline__ s16x4 vtr(const LAS unsigned char* p) { return __builtin_bit_cast(s16x4, __builtin_amdgcn_ds_read_tr16_b64_v4i16((LAS v4i16_t*)p)); }
typedef __bf16 bfpair_t __attribute__((ext_vector_type(2))); typedef float f32pair_t __attribute__((ext_vector_type(2)));
__device__ __forceinline__ unsigned cvtpk(float lo, float hi) { const f32pair_t v = {lo, hi}; return __builtin_bit_cast(unsigned, __builtin_convertvector(v, bfpair_t)); }
#define NEG_INF (-__builtin_inff())

template <int TYPE>
__device__ __forceinline__ void dense_attn_unit(const Frame& F, int l, int b, int h, int qb) {
    constexpr int QOFF = TYPE == 1 ? PB_Q : TYPE == 2 ? PC_Q : PD_Q, KOFF = TYPE == 1 ? PB_K : TYPE == 2 ? PC_K : PD_K, VOFF = TYPE == 1 ? PB_V : TYPE == 2 ? PC_V : PD_V;
    constexpr bool MQA = TYPE == 1; constexpr int YOFF = TYPE * GWID;
    const int tid = F.tid, lane = F.lane, wid = F.wave, r32 = lane & 31, hi = lane >> 5;
    LAS unsigned char* L = F.lds + RING_OFF;
    LAS float* wsf = (LAS float*)(L + AT_WSF + wid * 256);
    LAS float* BT = (LAS float*)(L + AT_BT);
    const int hq = (TYPE == 1) ? wid : h, qoff = (TYPE == 1) ? (qb & 7) * 32 : wid * 32, qb256 = (TYPE == 1) ? (qb >> 3) : qb;
    const size_t rowb = (size_t)b * SEQ; const int q0 = qb256 * 256;
    const bf16* Pk = F.P + rowb * NIN + KOFF + (MQA ? 0 : h * 64);
    const bf16* Pv = F.P + rowb * NIN + VOFF + (MQA ? 0 : h * 64);
    const bf16* Pq = F.P + (rowb + q0 + qoff + r32) * NIN + QOFF + hq * 64 + hi * 8;
    bf16x8 qr[4];
#pragma unroll
    for (int d0 = 0; d0 < 4; ++d0) qr[d0] = *(const GAS bf16x8*)(Pq + 16 * d0);
    const int jt_hi = (TYPE == 1) ? ((q0 + qoff + 31) >> 6) : 4 * qb256 + 3, jt_lo = (TYPE == 1) ? (((q0 + qoff - (WINDOW - 1)) > 0 ? (q0 + qoff - (WINDOW - 1)) : 0) >> 6) : 0, nt = jt_hi - jt_lo + 1;
    if (TYPE == 1) { LAS float* BTall = (LAS float*)(L + AT_SV);
        for (int i = tid; i < 8 * 128; i += NTHREADS) BTall[i] = F.rel_table[(int)kBucketLut[i & 127] * 16 + 8 + (i >> 7)] * LOG2E;
        BT = BTall + 128 * wid; }
    const bf16* kgp = Pk + (size_t)lane * NIN + wid * 8;
    const int vkey = tid >> 3, vch = tid & 7;
    const bf16* vgp = Pv + (size_t)vkey * NIN + vch * 8;
    const int kl = wid * 1024 + lane * 16;
    const int vl = (vch >> 2) * 4096 + (vkey >> 3) * 512 + (vkey & 7) * 64 + (vch & 3) * 16;
    const float* kb2 = F.KB2 + ((size_t)b * NH + h) * SEQ;
    v4u kreg = *(const GAS v4u*)(kgp + (size_t)jt_hi * 64 * NIN), vreg = *(const GAS v4u*)(vgp + (size_t)jt_hi * 64 * NIN);
    float kbreg = 0.f; if (TYPE == 2 && tid < 64) kbreg = kb2[jt_hi * 64 + tid];
    *(LAS v4u*)(L + AT_K + kl) = kreg; *(LAS v4u*)(L + AT_V + vl) = vreg; if (TYPE == 2 && tid < 64) ((LAS float*)(L + AT_KB))[tid] = kbreg;
    __syncthreads();
    f32x16 o[2]; o[0] = f32x16{}; o[1] = f32x16{};
    float mrun = NEG_INF, lsum = 0.f, carry = 1.f;
    float qbound = 0.f;
    if (TYPE == 2) {
        float ss = 0.f;
#pragma unroll
        for (int d0 = 0; d0 < 4; ++d0)
#pragma unroll
            for (int j = 0; j < 8; ++j) { const float x = bf2f((bf16)qr[d0][j]); ss += x * x; }
        ss += __shfl_xor(ss, 32);
        float gm = fabsf(F.qk_g[((size_t)l * 6 + 5) * HD + lane]);
#pragma unroll
        for (int o = 1; o < 64; o <<= 1) gm = fmaxf(gm, __shfl_xor(gm, o));
        qbound = sqrtf(ss) * 8.08f * gm;
    }
    const int qrel = qoff + r32;
    const int vb = ((lane >> 4) & 1) * 32 + (lane & 3) * 8 + (4 * hi + ((lane & 15) >> 2)) * 64;
    LAS unsigned* deadf = (LAS unsigned*)(L + AT_DEAD);
    for (int i = 0; i < nt; ++i) {
        const int jt = jt_hi - i, cur = i & 1, jb = jt - 4 * qb256; const bool more = (i + 1 < nt);
        float kbnext = 0.f;
        if (more) { kreg = *(const GAS v4u*)(kgp + (size_t)(jt - 1) * 64 * NIN); vreg = *(const GAS v4u*)(vgp + (size_t)(jt - 1) * 64 * NIN); if (TYPE == 2 && tid < 64) kbreg = kb2[(jt - 1) * 64 + tid]; if (TYPE == 2) kbnext = kb2[jt * 64 - 1]; }
        const bool active = (64 * jb <= qoff + 31) && (TYPE != 1 || (64 * jb + 63 >= qoff - (WINDOW - 1)));
        if (active) {
            const LAS unsigned char* Kb = L + AT_K + cur * 8192; const LAS unsigned char* Vb = L + AT_V + cur * 8192;
            f32x16 p0 = f32x16{}, p1 = f32x16{};
            bf16x8 ka[4], kc[4];
#pragma unroll
            for (int d0 = 0; d0 < 4; ++d0) { ka[d0] = *(const LAS bf16x8*)(Kb + (2 * d0 + hi) * 1024 + r32 * 16); kc[d0] = *(const LAS bf16x8*)(Kb + (2 * d0 + hi) * 1024 + 512 + r32 * 16); }
            __builtin_amdgcn_sched_barrier(0);
#pragma unroll
            for (int d0 = 0; d0 < 4; ++d0) { p0 = __builtin_amdgcn_mfma_f32_32x32x16_bf16(ka[d0], qr[d0], p0, 0, 0, 0); p1 = __builtin_amdgcn_mfma_f32_32x32x16_bf16(kc[d0], qr[d0], p1, 0, 0, 0); }
            bf16x8 vfr[2][4];
#pragma unroll
            for (int d0 = 0; d0 < 2; ++d0)
#pragma unroll
                for (int ks = 0; ks < 4; ++ks) { const s16x4 lo = vtr(Vb + vb + d0 * 4096 + ks * 1024), hh = vtr(Vb + vb + d0 * 4096 + ks * 1024 + 512);
                    vfr[d0][ks] = (bf16x8){lo[0], lo[1], lo[2], lo[3], hh[0], hh[1], hh[2], hh[3]}; }
            __builtin_amdgcn_sched_barrier(0);
            bool live = true;
            const int kv0 = 64 * jb + 4 * hi;
            if (TYPE == 3) {
                float b0[16], b1[16];
#pragma unroll
                for (int r = 0; r < 16; ++r) { const int kv = kv0 + (r & 3) + 8 * (r >> 2);
                    const float e0 = fexp2(fminf(p0[r], 80.f)), e1 = fexp2(fminf(p1[r], 80.f));
                    const float m0 = frcp(1.0f + e0), m1 = frcp(1.0f + e1);
                    const bool ok0 = kv < qrel, ok1 = (kv + 32) < qrel;
                    b0[r] = ok0 ? e0 * m0 : 0.f; b1[r] = ok1 ? e1 * m1 : 0.f; p0[r] = ok0 ? m0 : 1.0f; p1[r] = ok1 ? m1 : 1.0f; }
                float gp[8], go[8], pp[8];
#pragma unroll
                for (int g = 0; g < 4; ++g) { gp[g] = (p0[4 * g] * p0[4 * g + 1]) * (p0[4 * g + 2] * p0[4 * g + 3]); gp[4 + g] = (p1[4 * g] * p1[4 * g + 1]) * (p1[4 * g + 2] * p1[4 * g + 3]); }
#pragma unroll
                for (int g = 0; g < 8; ++g) { const float oth = __shfl_xor(gp[g], 32); pp[g] = gp[g] * oth; go[g] = hi ? 1.0f : oth; }
                float sp = 1.0f;
#pragma unroll
                for (int g = 7; g >= 0; --g) { const float sg = sp * go[g] * carry;
                    if (g < 4) { const float c3 = p0[4 * g + 3], c2 = p0[4 * g + 2], c1 = p0[4 * g + 1];
                        p0[4 * g + 3] = b0[4 * g + 3] * sg; const float s2 = sg * c3; p0[4 * g + 2] = b0[4 * g + 2] * s2; const float s1 = s2 * c2; p0[4 * g + 1] = b0[4 * g + 1] * s1; p0[4 * g] = b0[4 * g] * (s1 * c1); }
                    else { const int q = g - 4; const float c3 = p1[4 * q + 3], c2 = p1[4 * q + 2], c1 = p1[4 * q + 1];
                        p1[4 * q + 3] = b1[4 * q + 3] * sg; const float s2 = sg * c3; p1[4 * q + 2] = b1[4 * q + 2] * s2; const float s1 = s2 * c2; p1[4 * q + 1] = b1[4 * q + 1] * s1; p1[4 * q] = b1[4 * q] * (s1 * c1); }
                    sp *= pp[g]; }
                carry *= sp;
            } else {
                if (TYPE == 2) {
                    const LAS f32x4* kbp = (const LAS f32x4*)(L + AT_KB + cur * 256);
#pragma unroll
                    for (int g = 0; g < 4; ++g) { const f32x4 a = kbp[2 * g + hi], c = kbp[8 + 2 * g + hi];
#pragma unroll
                        for (int e = 0; e < 4; ++e) { p0[4 * g + e] += a[e]; p1[4 * g + e] += c[e]; } }
                    if (jb >= 0) {
#pragma unroll
                        for (int r = 0; r < 16; ++r) { const int kv = kv0 + (r & 3) + 8 * (r >> 2); if (kv > qrel) p0[r] = NEG_INF; if (kv + 32 > qrel) p1[r] = NEG_INF; }
                    }
                } else {
#pragma unroll
                    for (int r = 0; r < 16; ++r) { const int d0_ = qrel - (kv0 + (r & 3) + 8 * (r >> 2)), d1_ = d0_ - 32;
                        const bool ok0 = (d0_ >= 0) && (d0_ < WINDOW), ok1 = (d1_ >= 0) && (d1_ < WINDOW);
                        const float t0 = BT[ok0 ? d0_ : 0], t1 = BT[ok1 ? d1_ : 0];
                        p0[r] = ok0 ? p0[r] + t0 : NEG_INF; p1[r] = ok1 ? p1[r] + t1 : NEG_INF; }
                }
                float rm = fmaxf(p0[0], p1[0]);
#pragma unroll
                for (int r = 1; r < 16; ++r) rm = fmaxf(rm, fmaxf(p0[r], p1[r]));
                { auto rr = __builtin_amdgcn_permlane32_swap(__float_as_uint(rm), __float_as_uint(rm), false, false); rm = fmaxf(__uint_as_float(rr[0]), __uint_as_float(rr[1])); }
                const float mn = fmaxf(mrun, rm);
                if (TYPE == 2) live = !__all(rm - mrun < -40.f);
                if (live) {
                if (__any(mn > mrun)) {
                    const float f = (mn > mrun) ? fexp2(mrun - mn) : 1.0f;
                    lsum *= f; mrun = mn;
                    if (hi == 0) wsf[r32] = f;
                    LDS_WAIT(); __builtin_amdgcn_wave_barrier();
#pragma unroll
                    for (int g = 0; g < 4; ++g) { const f32x4 fv = ((const LAS f32x4*)wsf)[2 * g + hi];
#pragma unroll
                        for (int e = 0; e < 4; ++e) { o[0][4 * g + e] *= fv[e]; o[1][4 * g + e] *= fv[e]; } }
                    LDS_WAIT(); __builtin_amdgcn_wave_barrier();
                }
                const float ms = (mrun == NEG_INF) ? 0.f : mrun;
                float ps = 0.f;
#pragma unroll
                for (int r = 0; r < 16; ++r) { p0[r] = fexp2(p0[r] - ms); p1[r] = fexp2(p1[r] - ms); ps += p0[r] + p1[r]; }
                lsum += ps;
                }
            }
            if (live) {
            bf16x8 pa[4];
#pragma unroll
            for (int ks = 0; ks < 4; ++ks) { v4u w;
                if (ks < 2) { w.x = cvtpk(p0[8 * ks], p0[8 * ks + 1]); w.y = cvtpk(p0[8 * ks + 2], p0[8 * ks + 3]); w.z = cvtpk(p0[8 * ks + 4], p0[8 * ks + 5]); w.w = cvtpk(p0[8 * ks + 6], p0[8 * ks + 7]); }
                else { const int k2 = ks - 2; w.x = cvtpk(p1[8 * k2], p1[8 * k2 + 1]); w.y = cvtpk(p1[8 * k2 + 2], p1[8 * k2 + 3]); w.z = cvtpk(p1[8 * k2 + 4], p1[8 * k2 + 5]); w.w = cvtpk(p1[8 * k2 + 6], p1[8 * k2 + 7]); }
                pa[ks] = __builtin_bit_cast(bf16x8, w); }
#pragma unroll
            for (int d0 = 0; d0 < 2; ++d0)
#pragma unroll
                for (int ks = 0; ks < 4; ++ks) o[d0] = __builtin_amdgcn_mfma_f32_32x32x16_bf16(pa[ks], vfr[d0][ks], o[d0], 0, 0, 0);
            }
        }
        if (TYPE == 2) {
            bool wdead = false;
            if (active && more) wdead = __all(qbound + kbnext - mrun < -40.f);
            if (lane == 0) deadf[cur * 8 + wid] = wdead ? 1u : 0u; }
        if (TYPE == 3) { const bool wdead = active && __all(carry < 2.3e-10f);
            if (lane == 0) deadf[cur * 8 + wid] = wdead ? 1u : 0u; }
        if (more) { *(LAS v4u*)(L + AT_K + (cur ^ 1) * 8192 + kl) = kreg; *(LAS v4u*)(L + AT_V + (cur ^ 1) * 8192 + vl) = vreg; if (TYPE == 2 && tid < 64) ((LAS float*)(L + AT_KB + (cur ^ 1) * 256))[tid] = kbreg; }
        __syncthreads();
        if (TYPE >= 2) { const v4u d0 = *(const LAS v4u*)(deadf + cur * 8), d1 = *(const LAS v4u*)(deadf + cur * 8 + 4);
            if ((d0.x & d0.y & d0.z & d0.w & d1.x & d1.y & d1.z & d1.w) != 0u) break; }
    }
    float inv[16];
    if (TYPE != 3) {
        { auto rr = __builtin_amdgcn_permlane32_swap(__float_as_uint(lsum), __float_as_uint(lsum), false, false); lsum = __uint_as_float(rr[0]) + __uint_as_float(rr[1]); }
        if (TYPE == 1) lsum += fexp2(F.sinks[l * NH + hq] * LOG2E - mrun);
        const float il = 1.0f / lsum;
        if (hi == 0) wsf[r32] = il;
        LDS_WAIT(); __builtin_amdgcn_wave_barrier();
#pragma unroll
        for (int g = 0; g < 4; ++g) { const f32x4 fv = ((const LAS f32x4*)wsf)[2 * g + hi]; inv[4 * g] = fv[0]; inv[4 * g + 1] = fv[1]; inv[4 * g + 2] = fv[2]; inv[4 * g + 3] = fv[3]; }
        LDS_WAIT(); __builtin_amdgcn_wave_barrier();
    } else {
#pragma unroll
        for (int r = 0; r < 16; ++r) inv[r] = 1.0f;
    }
    unsigned short gte[2][16];
    if (TYPE == 2) {
#pragma unroll
        for (int d0 = 0; d0 < 2; ++d0)
#pragma unroll
            for (int r = 0; r < 16; ++r) { const int q = (r & 3) + 8 * (r >> 2) + 4 * hi; const size_t mrow = rowb + q0 + qoff + q; gte[d0][r] = ((const GAS unsigned short*)F.P)[mrow * NIN + PC_G + hq * 64 + 32 * d0 + r32]; }
    }
#pragma unroll
    for (int d0 = 0; d0 < 2; ++d0)
#pragma unroll
        for (int r = 0; r < 16; ++r) { const int q = (r & 3) + 8 * (r >> 2) + 4 * hi; const size_t mrow = rowb + q0 + qoff + q; const int col = hq * 64 + 32 * d0 + r32;
            float val = o[d0][r] * inv[r];
            if (TYPE == 2) val *= frcp(1.0f + fexp2(-LOG2E * __builtin_bit_cast(float, (unsigned)gte[d0][r] << 16)));
            F.Y[mrow * DM + YOFF + col] = (bf16)f2bf(val); }
}

__device__ __forceinline__ void sparse_attn_query(const Frame& F, int m, LAS unsigned char* vch, const LAS float* TBA, const LAS int* idx) {
    int lane = F.lane; asm volatile("" : "+v"(lane));
    const int hh = lane & 15, kg = lane >> 4, t = m % SEQ, b = m / SEQ;
    const size_t rowb = (size_t)b * SEQ;
    const int nsel = (t + 1) < TOPK ? (t + 1) : TOPK, nch = (nsel + 63) >> 6;
    const bf16* qp = F.P + (size_t)m * NIN + PA_Q + (hh & 7) * 64 + 8 * kg;
    const bf16x8 qf0 = *(const GAS bf16x8*)qp, qf1 = *(const GAS bf16x8*)(qp + 32);
    float s[4][4][4];
#pragma unroll
    for (int cp = 0; cp < 2; ++cp) {
        if (2 * cp < nch) {
            bf16x8 kf[8][2];
#pragma unroll
            for (int bb = 0; bb < 8; ++bb) { const int keyA = idx[128 * cp + 16 * bb + hh];
                const bf16* kp = F.P + (rowb + keyA) * NIN + PA_K + 8 * kg;
                kf[bb][0] = *(const GAS bf16x8*)kp; kf[bb][1] = *(const GAS bf16x8*)(kp + 32); }
            __builtin_amdgcn_sched_barrier(0);
#pragma unroll
            for (int bb = 0; bb < 8; ++bb) { const int c = 2 * cp + (bb >> 2), blk = bb & 3, j0 = 64 * c + 16 * blk;
                f32x4 acc = {0.f, 0.f, 0.f, 0.f};
                acc = __builtin_amdgcn_mfma_f32_16x16x32_bf16(kf[bb][0], qf0, acc, 0, 0, 0); acc = __builtin_amdgcn_mfma_f32_16x16x32_bf16(kf[bb][1], qf1, acc, 0, 0, 0);
                const v4i id4 = *(const LAS v4i*)(idx + j0 + 4 * kg);
#pragma unroll
                for (int r = 0; r < 4; ++r) { const int j = j0 + 4 * kg + r; int dist = t - id4[r]; dist = dist < 0 ? 0 : (dist > 128 ? 128 : dist);
                    const float bias = TBA[dist * 8 + (hh & 7)];
                    s[c][blk][r] = (j < nsel) ? acc[r] + bias : NEG_INF; }
            }
        } else {
#pragma unroll
            for (int c = 2 * cp; c < 2 * cp + 2; ++c)
#pragma unroll
                for (int blk = 0; blk < 4; ++blk)
#pragma unroll
                    for (int r = 0; r < 4; ++r) s[c][blk][r] = NEG_INF;
        }
    }
    v4u xv[2][8];
#define SP_VLOAD(c_, X) do { const int keyV_ = idx[64 * (c_) + lane]; const bf16* vp_ = F.P + (rowb + keyV_) * NIN + PA_V; \
        _Pragma("unroll") for (int i_ = 0; i_ < 8; ++i_) X[i_] = *(const GAS v4u*)(vp_ + 8 * i_); } while (0)
    SP_VLOAD(0, xv[0]);
    if (1 < nch) SP_VLOAD(1, xv[1]);
    __builtin_amdgcn_sched_barrier(0);
    float mx = NEG_INF;
#pragma unroll
    for (int c = 0; c < 4; ++c)
#pragma unroll
        for (int blk = 0; blk < 4; ++blk)
#pragma unroll
            for (int r = 0; r < 4; ++r) mx = fmaxf(mx, s[c][blk][r]);
    mx = fmaxf(mx, __shfl_xor(mx, 16)); mx = fmaxf(mx, __shfl_xor(mx, 32));
    float sum = 0.f;
#pragma unroll
    for (int c = 0; c < 4; ++c)
#pragma unroll
        for (int blk = 0; blk < 4; ++blk)
#pragma unroll
            for (int r = 0; r < 4; ++r) { const float p = fexp2(s[c][blk][r] - mx); s[c][blk][r] = p; sum += p; }
    sum += __shfl_xor(sum, 16); sum += __shfl_xor(sum, 32);
    const float inv = 1.0f / sum;
    f32x4 oacc[4];
#pragma unroll
    for (int d = 0; d < 4; ++d) oacc[d] = (f32x4){0.f, 0.f, 0.f, 0.f};
    const int q4 = (lane & 15) >> 2, p4 = lane & 3;
#pragma unroll
    for (int c = 0; c < 4; ++c) {
        if (c < nch) {
#pragma unroll
            for (int i = 0; i < 8; ++i) *(LAS v4u*)(vch + (i >> 2) * 4096 + lane * 64 + (i & 3) * 16) = xv[c & 1][i];
            LDS_WAIT(); __builtin_amdgcn_wave_barrier();
            if (c + 2 < nch) SP_VLOAD(c + 2, xv[c & 1]);
            __builtin_amdgcn_sched_barrier(0);
#pragma unroll
            for (int kp = 0; kp < 2; ++kp) { v4u w; w.x = cvtpk(s[c][2 * kp][0], s[c][2 * kp][1]); w.y = cvtpk(s[c][2 * kp][2], s[c][2 * kp][3]); w.z = cvtpk(s[c][2 * kp + 1][0], s[c][2 * kp + 1][1]); w.w = cvtpk(s[c][2 * kp + 1][2], s[c][2 * kp + 1][3]);
                const bf16x8 pf = __builtin_bit_cast(bf16x8, w);
#pragma unroll
                for (int d = 0; d < 4; ++d) { const LAS unsigned char* a = vch + (d >> 1) * 4096 + (32 * kp + 4 * kg + q4) * 64 + ((d & 1) * 16 + 4 * p4) * 2;
                    const s16x4 lo = vtr(a), hv = vtr(a + 16 * 64);
                    const bf16x8 vf = {lo[0], lo[1], lo[2], lo[3], hv[0], hv[1], hv[2], hv[3]};
                    oacc[d] = __builtin_amdgcn_mfma_f32_16x16x32_bf16(vf, pf, oacc[d], 0, 0, 0); } }
            LDS_WAIT(); __builtin_amdgcn_wave_barrier();
        }
    }
#undef SP_VLOAD
    if (hh < 8) {
#pragma unroll
        for (int d = 0; d < 4; ++d) { v2u w; w.x = pk2(oacc[d][0] * inv, oacc[d][1] * inv); w.y = pk2(oacc[d][2] * inv, oacc[d][3] * inv);
            *(GAS v2u*)(F.Y + (size_t)m * DM + hh * 64 + 16 * d + 4 * kg) = w; }
    }
}

constexpr int CW_QUEUE = 8192;
constexpr int MIX_ITEMS = 2560;
template <unsigned EN> __device__ __forceinline__ void ph_attention(const Frame& F, int l, int qsel = 0) {
    LAS float* TBA = (LAS float*)(F.lds + AUX_OFF);
    for (int i = F.tid; i < 129 * 8; i += NTHREADS) { const int d = i >> 3, hq = i & 7; const int bk = d < 128 ? (int)kBucketLut[d] : 31; TBA[i] = F.rel_table[bk * 16 + hq] * LOG2E; }
    LAS unsigned* qslot = (LAS unsigned*)(F.lds + LDSCTL_OFF + 64);
    LAS unsigned char* wbuf = F.lds + RING_OFF + AT_SV + F.wave * 9472;
    LAS int* idxl = (LAS int*)(wbuf + 8192);
    __syncthreads();
#define MIX_FETCH(it) do { if (F.tid == 0) *qslot = __hip_atomic_fetch_add((unsigned*)(F.ctl + CW_QUEUE + 64 * l + 32 * qsel), 1u, __ATOMIC_RELAXED, __HIP_MEMORY_SCOPE_AGENT); \
        __syncthreads(); it = (int)*qslot; __syncthreads(); } while (0)
    for (int r = (int)blockIdx.x; r < 1024; r += F.G) {
        if (EN & 0x800) {
            const int b = r >> 9, blk = r & 511;
#pragma unroll 1
            for (int k = 0; k < 2; ++k) { const int u = 8 * blk + F.wave; const int t = k ? (SEQ - 1 - u) : u; const int m = b * SEQ + t;
                select_row(F, m, (LAS unsigned*)wbuf, idxl);
                LDS_WAIT(); __builtin_amdgcn_wave_barrier();
#ifdef PROBE_SEL2
                select_row(F, m, (LAS unsigned*)wbuf, idxl); LDS_WAIT(); __builtin_amdgcn_wave_barrier();
#endif
#ifdef PROBE_ATT2
                sparse_attn_query(F, m, wbuf, TBA, idxl); LDS_WAIT(); __builtin_amdgcn_wave_barrier();
#endif
                sparse_attn_query(F, m, wbuf, TBA, idxl);
                LDS_WAIT(); __builtin_amdgcn_wave_barrier(); }
        }
    }
    __syncthreads();
    int it; MIX_FETCH(it); it += 1024;
    while (it < 1536) { const int r = it & 511; if (EN & 0x100) dense_attn_unit<2>(F, l, (r & 15) >> 3, r & 7, 31 - (r >> 4)); MIX_FETCH(it); it += 1024; }
    while (it < 2048) { const int r = it & 511; if (EN & 0x200) dense_attn_unit<3>(F, l, (r & 15) >> 3, r & 7, 31 - (r >> 4)); MIX_FETCH(it); it += 1024; }
    while (it < MIX_ITEMS) { const int r = it & 511; if (EN & 0x400) dense_attn_unit<1>(F, l, r >> 8, 0, 255 - (r & 255)); MIX_FETCH(it); it += 1024; }
#undef MIX_FETCH
}


__device__ __forceinline__ const float* gp_(const float* p) {
#if defined(__HIP_DEVICE_COMPILE__)
    __builtin_assume(!__builtin_amdgcn_is_shared((const __attribute__((address_space(0))) void*)p)); __builtin_assume(!__builtin_amdgcn_is_private((const __attribute__((address_space(0))) void*)p));
#endif
    return p; }
#ifndef PROBE_KINDS
#define PROBE_KINDS 0u
#endif
#ifndef PROBE_ATT
#define PROBE_ATT 0xF00u
#endif
#ifndef PROBE_REPS
#define PROBE_REPS 1
#endif
#ifndef MK_ONE_LAUNCH
#define MK_ONE_LAUNCH 1
#endif
constexpr int PH_PER_LAYER = 14, N_PHASES = 1 + DEPTH * PH_PER_LAYER;
struct Args { const float* in[15]; float* out; unsigned char* ws; int ph_lo, ph_hi; };
struct ArgsG { const GAS float* in[15]; GAS float* out; GAS unsigned char* ws; int ph_lo, ph_hi; };
template <unsigned EN> __global__ void __launch_bounds__(NTHREADS, 2) trunk_fwd(Args args) {
    extern __shared__ __attribute__((aligned(16))) unsigned char lds[];
    LAS unsigned char* const ldsb = (LAS unsigned char*)lds;
    const int wave0 = __builtin_amdgcn_readfirstlane((int)threadIdx.x >> 6);
    for (int u = threadIdx.x; u < (LDS_BYTES - LDSCTL_OFF) / 4; u += NTHREADS) ((LAS unsigned*)(ldsb + LDSCTL_OFF))[u] = 0u;
    __syncthreads();
#if MK_ONE_LAUNCH
    constexpr int lo = 0, hi = N_PHASES;
#else
    const int lo = args.ph_lo, hi = args.ph_hi;
#endif
    XcdBarrier bar; bar.bar = (unsigned*)(args.ws + WS_CTL) + CW_BAR; bar.x = 0; bar.st = nullptr;
    if (hi - lo > 1) bar = xcd_barrier_post((unsigned*)(args.ws + WS_CTL) + CW_BAR, (volatile LAS unsigned*)(ldsb + LDSCTL_OFF));
#define GP(p) ((const float*)(p))
#define PH_BEGIN(k, kind) if (lo <= (k) && (k) < hi) { _Pragma("unroll 1") for (int rep_ = 0; rep_ < (((PROBE_KINDS >> (kind)) & 1u) ? PROBE_REPS : 1); ++rep_) { Frame F; { \
        const ArgsG* ka = (const ArgsG*)__builtin_amdgcn_kernarg_segment_ptr(); asm volatile("" : "+s"(ka)); \
        unsigned o_ = ~0u; asm volatile("" : "+s"(o_)); int t_ = wave0 * 64 + (int)__builtin_amdgcn_mbcnt_hi(o_, __builtin_amdgcn_mbcnt_lo(o_, 0u)); asm volatile("" : "+v"(t_)); \
        F.lds = ldsb; F.tid = t_; F.lane = t_ & 63; F.wave = wave0; int gw_ = blockIdx.x * NWAVES + wave0; asm volatile("" : "+s"(gw_)); F.G = gridDim.x; F.gw = gw_; F.NGW = F.G * NWAVES; \
        unsigned char* ws = (unsigned char*)ka->ws; F.ctl = (gu32*)(ws + WS_CTL);     \
        F.x = GP(ka->in[0]); F.c = GP(ka->in[1]); F.w_ada = GP(ka->in[2]); F.b_ada = GP(ka->in[3]); F.norm_g = GP(ka->in[4]); F.w_in = GP(ka->in[5]); F.qk_g = GP(ka->in[6]); F.forget_b = GP(ka->in[7]); \
        F.sinks = GP(ka->in[8]); F.rel_table = GP(ka->in[9]); F.group_g = GP(ka->in[10]); F.w_out = GP(ka->in[11]); F.w_gate = GP(ka->in[12]); F.w_up = GP(ka->in[13]); F.w_down = GP(ka->in[14]); F.out = (float*)ka->out; \
        F.MOD = (float*)(ws + WS_MOD); F.LF = (float*)(ws + WS_LF); F.KB2 = (float*)(ws + WS_KB2); F.SC = (unsigned short*)(ws + WS_SC); F.IDX = (int*)(ws + WS_IDX); \
        F.WGU = (bf16*)(ws + WS_WGU); F.WD = (bf16*)(ws + WS_WD); F.WIN = (bf16*)(ws + WS_WIN); F.WOUT = (bf16*)(ws + WS_WOUT); \
        F.H = (bf16*)(ws + WS_H); F.P = (bf16*)(ws + WS_P); F.Y = (bf16*)(ws + WS_Y); F.XB = (bf16*)(ws + WS_XB); }
#define PH_END(k) if ((k) + 1 < hi) xcd_barrier(bar); } }

    PH_BEGIN(0, 31) if (EN & 1) p0_prologue(F); PH_END(0)

    for (int l = 0; l < DEPTH; ++l) {
        const int base = 1 + l * PH_PER_LAYER;
        for (int sub = 0; sub < 3; ++sub) {
            if (sub != 1) {
                const int f = sub >> 1, pb = base + (f ? 11 : 0), ni = f ? 2 : 0, lf = l * 2 + f;
                PH_BEGIN(pb, (f ? 11 : 0)) if (EN & 2) { const float* modl = F.MOD + (size_t)l * BATCH * NMOD;
                    if (l == 0 && f == 0) ph_modulate<FFN_FP8, false>(F, F.x, F.norm_g + ((size_t)l * 3 + ni) * DM, modl + (3 * ni + 0) * DM, modl + (3 * ni + 1) * DM);
                    else ph_modulate<FFN_FP8, true>(F, F.XB, F.norm_g + ((size_t)l * 3 + ni) * DM, modl + (3 * ni + 0) * DM, modl + (3 * ni + 1) * DM); } PH_END(pb)
                PH_BEGIN(pb + 1, (f ? 12 : 1)) if (EN & 4) {
                    pg8::StaticOrder S; S.init(M, NGU, F.G, (int)blockIdx.x);
                    if constexpr (FFN_FP8) { pg8::Gemm g{F.H, (const bf16*)((const unsigned char*)F.WGU + (size_t)lf * NGU * DM), M, NGU, DM, 127, W8_E8M0};
                        pg8::EpiSwiGLU8 E{(unsigned char*)F.P, DFFP};
                        pg8::gemm_phase<pg8::EpiSwiGLU8, pg8::StaticOrder, true, true, true>(F.lds + RING_OFF, g, S, E, F.tid); }
                    else { pg8::Gemm g{F.H, F.WGU + (size_t)lf * NGU * DM, M, NGU, DM};
                        pg8::EpiSwiGLU E{F.P, DFF};
                        pg8::gemm_phase<pg8::EpiSwiGLU, pg8::StaticOrder, true, true>(F.lds + RING_OFF, g, S, E, F.tid); } } PH_END(pb + 1)
                PH_BEGIN(pb + 2, (f ? 13 : 2)) if (EN & 8) {
                    pg8::Gemm g{F.P, FFN_FP8 ? (const bf16*)((const unsigned char*)F.WD + (size_t)lf * DM * DFFP) : F.WD + (size_t)lf * DM * DFF, M, DM, DFF, 127, FFN_FP8 ? W8_E8M0 : 127, FFN_FP8 ? DFFP : 0, FFN_FP8 ? DFFP : 0}; pg8::StaticOrder S; S.init(M, DM, F.G, (int)blockIdx.x);
                    const float* modl = F.MOD + (size_t)l * BATCH * NMOD;
                    if (l == DEPTH - 1 && f == 1) { pg8::EpiResid<false> E{F.XB, rep_ ? (void*)F.SC : (void*)F.out, DM, modl + (3 * ni + 2) * DM, NMOD, SEQ, 0.5f};
                        pg8::gemm_phase<pg8::EpiResid<false>, pg8::StaticOrder, true, true, FFN_FP8>(F.lds + RING_OFF, g, S, E, F.tid); }
                    else { pg8::EpiResid<true> E{F.XB, rep_ ? (void*)F.SC : (void*)F.XB, DM, modl + (3 * ni + 2) * DM, NMOD, SEQ, 0.5f};
                        pg8::gemm_phase<pg8::EpiResid<true>, pg8::StaticOrder, true, true, FFN_FP8>(F.lds + RING_OFF, g, S, E, F.tid); } } PH_END(pb + 2)
            } else {
                PH_BEGIN(base + 3, 3) if (EN & 2) { const float* modl = F.MOD + (size_t)l * BATCH * NMOD; ph_modulate<false, true>(F, F.XB, F.norm_g + ((size_t)l * 3 + 1) * DM, modl + 3 * DM, modl + 4 * DM); } PH_END(base + 3)
                PH_BEGIN(base + 4, 4) if (EN & 16) {
                    pg8::Gemm g{F.H, F.WIN + (size_t)l * NIN * DM, M, NIN, DM}; pg8::StaticOrder S; S.init(M, NIN, F.G, (int)blockIdx.x);
                    pg8::EpiBf16 E{F.P, NIN};
                    pg8::gemm_phase<pg8::EpiBf16, pg8::StaticOrder, true, true>(F.lds + RING_OFF, g, S, E, F.tid); } PH_END(base + 4)
                PH_BEGIN(base + 6, 6) if (EN & 64) { ph_scan(F, l);
                    int par_ = (int)(blockIdx.x & 1u); asm volatile("" : "+s"(par_));
                    _Pragma("unroll 1") for (int st_ = 0; st_ < 2; ++st_) { if ((st_ ^ par_) == 0) { if (EN & 32) ph_post(F, l); } else ph_idx_scores(F); } } PH_END(base + 6)
                PH_BEGIN(base + 8, 8) if (EN & 0xF00) { if (rep_ == 0) ph_attention<EN>(F, l, 0); else ph_attention<(PROBE_ATT)>(F, l, 1); } PH_END(base + 8)
                PH_BEGIN(base + 9, 9) if (EN & 0x1000) ph_gnorm(F, l); PH_END(base + 9)
                PH_BEGIN(base + 10, 10) if (EN & 0x2000) {
                    pg8::Gemm g{F.Y, F.WOUT + (size_t)l * DM * DM, M, DM, DM}; pg8::StaticOrder S; S.init(M, DM, F.G, (int)blockIdx.x);
                    const float* modl = F.MOD + (size_t)l * BATCH * NMOD;
                    pg8::EpiResid<true> E{F.XB, rep_ ? (void*)F.SC : (void*)F.XB, DM, modl + 5 * DM, NMOD, SEQ, 1.0f};
                    pg8::gemm_phase<pg8::EpiResid<true>, pg8::StaticOrder, true, true>(F.lds + RING_OFF, g, S, E, F.tid); } PH_END(base + 10)
            }
        }
    }
#undef PH_BEGIN
#undef PH_END
}

#ifndef EN_MASK
#define EN_MASK 0xFFFFu
#endif
template <unsigned EN> static int setup_kernel() {
    if (hipFuncSetAttribute((const void*)trunk_fwd<EN>, hipFuncAttributeMaxDynamicSharedMemorySize, LDS_BYTES) != hipSuccess) { fprintf(stderr, "kernel_launch: hipFuncSetAttribute failed\n"); return -1; }
    int per_cu = 0;
    if (hipOccupancyMaxActiveBlocksPerMultiprocessor(&per_cu, (const void*)trunk_fwd<EN>, NTHREADS, LDS_BYTES) != hipSuccess || per_cu < 1) { fprintf(stderr, "kernel_launch: occupancy query says %d\n", per_cu); }
    (void)hipGetLastError();
    return 0;
}
template <unsigned EN> static void launch_range(const Args& a0, int lo, int hi, int grid, hipStream_t stream) {
    Args a = a0; a.ph_lo = lo; a.ph_hi = hi;
    hipLaunchKernelGGL(trunk_fwd<EN>, dim3(grid), dim3(NTHREADS), LDS_BYTES, stream, a);
}
extern "C" void kernel_launch(void* const* d_in, const int* in_sizes, int n_in, void* d_out, int out_size, void* d_ws, size_t ws_size, hipStream_t stream) {
    static int grid = 0;
    if (grid == 0) {
        if (n_in != 15 || in_sizes[0] != M * DM || out_size != M * DM || ws_size < WS_END) {
            fprintf(stderr, "kernel_launch: shape/workspace mismatch: n_in %d in0 %d out %d ws %zu (need %zu); nothing launched\n", n_in, n_in > 0 ? in_sizes[0] : -1, out_size, ws_size, (size_t)WS_END); grid = -1; return; }
        int dev = 0, cus = 0;
        if (hipGetDevice(&dev) != hipSuccess || hipDeviceGetAttribute(&cus, hipDeviceAttributeMultiprocessorCount, dev) != hipSuccess) { grid = -1; return; }
#if MK_ONE_LAUNCH
        if (setup_kernel<EN_MASK>()) { grid = -1; return; }
#else
        if (setup_kernel<0x1u>() || setup_kernel<0x2u>() || setup_kernel<0x4u>() || setup_kernel<0x8u>() || setup_kernel<0x10u>() || setup_kernel<0x20u>() || setup_kernel<0x40u>() || setup_kernel<0x80u>() ||
            setup_kernel<0x100u>() || setup_kernel<0x200u>() || setup_kernel<0x400u>() || setup_kernel<0x800u>() || setup_kernel<0x1000u>() || setup_kernel<0x2000u>()) { grid = -1; return; }
#endif
        grid = cus;
    }
    if (grid < 0) return;
    if (hipMemsetAsync((char*)d_ws + WS_CTL, 0, CTL_ZERO_BYTES, stream) != hipSuccess) return;
    Args a{};
    for (int i = 0; i < 15; ++i) a.in[i] = (const float*)d_in[i];
    a.out = (float*)d_out; a.ws = (unsigned char*)d_ws;
#if MK_ONE_LAUNCH
    launch_range<EN_MASK>(a, 0, N_PHASES, grid, stream);
#else
    launch_range<0x1u>(a, 0, 1, grid, stream);
    for (int l = 0; l < DEPTH; ++l) { const int base = 1 + l * PH_PER_LAYER;
        for (int f = 0; f < 2; ++f) { const int pb = base + (f ? 11 : 0);
            if (f == 1) {
                launch_range<0x2u>(a, base + 3, base + 4, grid, stream); launch_range<0x10u>(a, base + 4, base + 5, grid, stream); launch_range<0x20u>(a, base + 5, base + 6, grid, stream);
                launch_range<0x40u>(a, base + 6, base + 7, grid, stream); launch_range<0x80u>(a, base + 7, base + 8, grid, stream);
                launch_range<0x100u>(a, base + 8, base + 9, grid, stream); launch_range<0x200u>(a, base + 8, base + 9, grid, stream); launch_range<0x400u>(a, base + 8, base + 9, grid, stream); launch_range<0x800u>(a, base + 8, base + 9, grid, stream);
                launch_range<0x1000u>(a, base + 9, base + 10, grid, stream); launch_range<0x2000u>(a, base + 10, base + 11, grid, stream);
            }
            launch_range<0x2u>(a, pb, pb + 1, grid, stream); launch_range<0x4u>(a, pb + 1, pb + 2, grid, stream); launch_range<0x8u>(a, pb + 2, pb + 3, grid, stream);
        }
    }
#endif
}
```

```cpp
#include <hip/hip_runtime.h>
#include <cstdio>
#include <cstdint>

namespace pg8 {
#define PG8_LAS __attribute__((address_space(3)))
typedef unsigned short bf16_t;
typedef short bf16x8 __attribute__((ext_vector_type(8)));
typedef float f32x4 __attribute__((ext_vector_type(4)));
typedef unsigned u32x4 __attribute__((ext_vector_type(4)));
constexpr int BM = 256, BK = 64, HALF = 128, HTB = HALF * BK * 2  , STAGE_BYTES = 8 * HTB, NXCD = 8, WGM = 8;

__host__ __device__ __forceinline__ int lds_byte(int r, int c) { const int st = (r >> 4) * 2 + (c >> 5), rr = r & 15, cc = c & 31, ob = rr * 64 + cc * 2; return st * 1024 + (ob ^ (((ob >> 9) & 1) << 5)); }
__host__ __device__ __forceinline__ void stage_rc(int b, int& R, int& C) { const int st = b / 1024, sb = b % 1024, swz = sb ^ (((sb >> 9) & 1) << 5); R = (st >> 1) * 16 + swz / 64; C = (st & 1) * 32 + (swz % 64) / 2; }
__host__ __device__ __forceinline__ int perm32(int rho) { const int n = rho >> 4, i = rho & 15; return 8 * (i >> 2) + 4 * n + (i & 3); }

struct Unit { int pm, pn; };
struct Gemm { const bf16_t* A; const bf16_t* Bt; int M, N, K; int scaleA = 127, scaleB = 127; int lda = 0, ldb = 0; int blk = 0; };
typedef int i32x8 __attribute__((ext_vector_type(8))); typedef int i32x4v __attribute__((ext_vector_type(4)));
__device__ __forceinline__ i32x8 pg8_cat(bf16x8 lo, bf16x8 hi) { return __builtin_shufflevector(__builtin_bit_cast(i32x4v, lo), __builtin_bit_cast(i32x4v, hi), 0, 1, 2, 3, 4, 5, 6, 7); }

struct StaticOrder {
    int nM, nN, nwg, G, c;
    __host__ __device__ void init(int M, int N, int G_, int c_) { nM = M / BM; nN = N / BM; nwg = nM * nN; G = G_; c = c_; }
    __host__ __device__ bool next(int i, Unit& u) const {
        const long L = (long)i * G + c; if (L >= nwg) return false;
        int wgid = (int)L; { const int q = nwg / NXCD, r = nwg % NXCD, xcd = wgid % NXCD, off = wgid / NXCD; wgid = (xcd < r ? xcd * (q + 1) : r * (q + 1) + (xcd - r) * q) + off; }
        const int nig = WGM * nN, gid = wgid / nig, fm = gid * WGM, gsz = (nM - fm) < WGM ? (nM - fm) : WGM;
        u.pm = fm + ((wgid % nig) % gsz); u.pn = (wgid % nig) / gsz; return true;
    }
    __device__ __forceinline__ void a_ready(const Unit&) const {}
    __device__ __forceinline__ void done(const Unit&) const {}
};
typedef __bf16 pg8_bfpair __attribute__((ext_vector_type(2))); typedef float pg8_f32pair __attribute__((ext_vector_type(2)));
__device__ __forceinline__ unsigned cvt_pk_bf16(float lo, float hi) { const pg8_f32pair v = {lo, hi}; return __builtin_bit_cast(unsigned, __builtin_convertvector(v, pg8_bfpair)); }
__device__ __forceinline__ unsigned cvt_pk_bf16_nv(float lo, float hi) { return cvt_pk_bf16(lo, hi); }
__device__ __forceinline__ const char* uptr(const char* p) { const unsigned long long v = (unsigned long long)p; const unsigned lo = __builtin_amdgcn_readfirstlane((unsigned)v), hi = __builtin_amdgcn_readfirstlane((unsigned)(v >> 32)); return (const char*)(((unsigned long long)hi << 32) | lo); }
struct EpiBf16 {
    static constexpr bool PERM = true, AFTER_DRAIN = false;
    bf16_t* O; int ldc;
    __device__ __forceinline__ void operator()(const f32x4 (&acc)[2][2][4][2], const Unit& u, int wr, int wc, int fr, int fq) const {
        asm volatile("" : "+v"(fr), "+v"(fq));
        const int row0 = u.pm * BM + wr * 64 + fr; const int col0 = u.pn * BM + wc * 32 + 8 * fq;
#pragma unroll
        for (int ai = 0; ai < 2; ++ai)
#pragma unroll
            for (int m = 0; m < 4; ++m) { bf16_t* rowp = O + (size_t)(row0 + ai * HALF + m * 16) * ldc + col0;
#pragma unroll
                for (int bj = 0; bj < 2; ++bj) { const f32x4 v0 = acc[ai][bj][m][0], v1 = acc[ai][bj][m][1];
                    u32x4 w; w.x = cvt_pk_bf16(v0[0], v0[1]); w.y = cvt_pk_bf16(v0[2], v0[3]); w.z = cvt_pk_bf16(v1[0], v1[1]); w.w = cvt_pk_bf16(v1[2], v1[3]);
                    *(u32x4*)(rowp + bj * HALF) = w; } }
    }
};
__device__ __forceinline__ float silu_mul(float g, float u) { return g * u * __builtin_amdgcn_rcpf(1.0f + __builtin_amdgcn_exp2f(-1.4426950408889634f * g)); }
struct EpiSwiGLU {
    static constexpr bool PERM = true, AFTER_DRAIN = false;
    bf16_t* O; int ldc;
    __device__ __forceinline__ void operator()(const f32x4 (&acc)[2][2][4][2], const Unit& u, int wr, int wc, int fr, int fq) const {
        asm volatile("" : "+v"(fr), "+v"(fq));
        const int row0 = u.pm * BM + wr * 64 + fr; const int col0 = u.pn * HALF + wc * 32 + 8 * fq;
#pragma unroll
        for (int ai = 0; ai < 2; ++ai)
#pragma unroll
            for (int m = 0; m < 4; ++m) { bf16_t* rowp = O + (size_t)(row0 + ai * HALF + m * 16) * ldc + col0;
                const f32x4 g0 = acc[ai][0][m][0], g1 = acc[ai][0][m][1], u0 = acc[ai][1][m][0], u1 = acc[ai][1][m][1];
                u32x4 w; w.x = cvt_pk_bf16(silu_mul(g0[0], u0[0]), silu_mul(g0[1], u0[1])); w.y = cvt_pk_bf16(silu_mul(g0[2], u0[2]), silu_mul(g0[3], u0[3]));
                w.z = cvt_pk_bf16(silu_mul(g1[0], u1[0]), silu_mul(g1[1], u1[1])); w.w = cvt_pk_bf16(silu_mul(g1[2], u1[2]), silu_mul(g1[3], u1[3]));
                *(u32x4*)rowp = w; }
    }
};
template <bool OUT16> struct EpiResid {
    static constexpr bool PERM = false, AFTER_DRAIN = false;
    const bf16_t* base; void* out; int ldc; const float* gv; int gstride; int rows_per_batch; float coef;
    __device__ __forceinline__ void operator()(const f32x4 (&acc)[2][2][4][2], const Unit& u, int wr, int wc, int fr, int fq) const {
        typedef unsigned v2u_ __attribute__((ext_vector_type(2)));
        asm volatile("" : "+v"(fr), "+v"(fq));
        const int row0 = u.pm * BM + wr * 64 + fr; const int col0 = u.pn * BM + wc * 32 + 4 * fq;
        const float* gvec = gv + (size_t)((u.pm * BM) / rows_per_batch) * gstride + col0;
        f32x4 gg[2][2];
#pragma unroll
        for (int bj = 0; bj < 2; ++bj)
#pragma unroll
            for (int n = 0; n < 2; ++n) gg[bj][n] = *(const f32x4*)(gvec + bj * HALF + n * 16) * coef;
#pragma unroll
        for (int ai = 0; ai < 2; ++ai) {
            v2u_ bwv[4][2][2];
#pragma unroll
            for (int m = 0; m < 4; ++m) { const size_t off = (size_t)(row0 + ai * HALF + m * 16) * ldc + col0;
#pragma unroll
                for (int bj = 0; bj < 2; ++bj)
#pragma unroll
                    for (int n = 0; n < 2; ++n) bwv[m][bj][n] = *(const v2u_*)(base + off + bj * HALF + n * 16); }
#pragma unroll
            for (int m = 0; m < 4; ++m) { const size_t off = (size_t)(row0 + ai * HALF + m * 16) * ldc + col0;
#pragma unroll
                for (int bj = 0; bj < 2; ++bj)
#pragma unroll
                    for (int n = 0; n < 2; ++n) { const v2u_ bw = bwv[m][bj][n];
                        f32x4 bs; bs[0] = __builtin_bit_cast(float, bw.x << 16); bs[1] = __builtin_bit_cast(float, bw.x & 0xffff0000u); bs[2] = __builtin_bit_cast(float, bw.y << 16); bs[3] = __builtin_bit_cast(float, bw.y & 0xffff0000u);
                        const f32x4 r = bs + gg[bj][n] * acc[ai][bj][m][n];
                        if constexpr (OUT16) { v2u_ w; w.x = cvt_pk_bf16_nv(r[0], r[1]); w.y = cvt_pk_bf16_nv(r[2], r[3]); *(v2u_*)((bf16_t*)out + off + bj * HALF + n * 16) = w; }
                        else *(f32x4*)((float*)out + off + bj * HALF + n * 16) = r; } }
        }
    }
};
__device__ __forceinline__ unsigned pack_fp8x4(float a, float b, float c, float d) {
    a = fminf(fmaxf(a, -448.f), 448.f); b = fminf(fmaxf(b, -448.f), 448.f); c = fminf(fmaxf(c, -448.f), 448.f); d = fminf(fmaxf(d, -448.f), 448.f);
    int w = 0; w = __builtin_amdgcn_cvt_pk_fp8_f32(a, b, w, false); w = __builtin_amdgcn_cvt_pk_fp8_f32(c, d, w, true); return (unsigned)w; }
struct EpiSwiGLU8 {
    static constexpr bool PERM = true, AFTER_DRAIN = false;
    unsigned char* O; int ldc;
    __device__ __forceinline__ void operator()(const f32x4 (&acc)[2][2][4][2], const Unit& u, int wr, int wc, int fr, int fq) const {
        asm volatile("" : "+v"(fr), "+v"(fq));
        const int row0 = u.pm * BM + wr * 64 + fr; const int col0 = u.pn * HALF + wc * 32 + 8 * fq;
#pragma unroll
        for (int ai = 0; ai < 2; ++ai)
#pragma unroll
            for (int m = 0; m < 4; ++m) { unsigned char* rowp = O + (size_t)(row0 + ai * HALF + m * 16) * ldc + col0;
                const f32x4 g0 = acc[ai][0][m][0], g1 = acc[ai][0][m][1], u0 = acc[ai][1][m][0], u1 = acc[ai][1][m][1];
                typedef unsigned u32x2v __attribute__((ext_vector_type(2))); u32x2v w;
                w.x = pack_fp8x4(silu_mul(g0[0], u0[0]), silu_mul(g0[1], u0[1]), silu_mul(g0[2], u0[2]), silu_mul(g0[3], u0[3]));
                w.y = pack_fp8x4(silu_mul(g1[0], u1[0]), silu_mul(g1[1], u1[1]), silu_mul(g1[2], u1[2]), silu_mul(g1[3], u1[3]));
                *(u32x2v*)rowp = w; }
    }
};
template <class Epi, class Sched, bool ALIGN_EPI = false, bool SP2 = false, bool FP8 = false>
__device__ __forceinline__ void gemm_phase(PG8_LAS unsigned char* lds, const Gemm g, const Sched& S, const Epi& E, int tid_in) {
    int tid_ = tid_in; asm volatile("" : "+v"(tid_));
    const int tid = tid_, wid = __builtin_amdgcn_readfirstlane(tid >> 6), lane = tid & 63, wr = wid >> 2, wc = wid & 3, fr = lane & 15, fq = lane >> 4;
    const int K = g.K, nt = FP8 ? K / (2 * BK) : K / BK;
    const int pitchA = g.blk ? 2 * BK : g.lda ? g.lda : (FP8 ? K : 2 * K), pitchB = g.blk ? 2 * BK : g.ldb ? g.ldb : (FP8 ? K : 2 * K);
    unsigned voffA[2], voffB[2];
#pragma unroll
    for (int i = 0; i < 2; ++i) { int R, C; stage_rc(tid * 16 + i * 8192, R, C); const int Rb = Epi::PERM ? ((R & ~31) + perm32(R & 31)) : R;
        voffA[i] = (unsigned)(R * pitchA + C * 2); voffB[i] = (unsigned)(Rb * pitchB + C * 2); }
    const size_t kstep = g.blk ? (size_t)(512 * BK) : (size_t)(BK * 2);
    const size_t hstepA = (size_t)HALF * pitchA, hstepB = (size_t)HALF * pitchB;
    const size_t tstepA = g.blk ? (size_t)(FP8 ? K / (2 * BK) : K / BK) * kstep : 2 * hstepA, tstepB = g.blk ? tstepA : 2 * hstepB;
    const unsigned ldsw = (unsigned)wid * 1024u;
    const int aoff = lds_byte(wr * 64 + fr, fq * 8), boff = lds_byte(wc * 32 + fr, fq * 8);
    PG8_LAS unsigned char* abase = lds + aoff; PG8_LAS unsigned char* bbase = lds + boff + 4 * HTB;
#define PG8_SA(b, h) (((b) * 2 + (h)) * HTB)
#define PG8_SB(b, h) ((4 + (b) * 2 + (h)) * HTB)
#define PG8_STAGE(bufoff, gbase, voff) do { _Pragma("unroll") for (int _i = 0; _i < 2; ++_i) \
        __builtin_amdgcn_global_load_lds((const unsigned*)((const char*)(gbase) + (voff)[_i]), (PG8_LAS unsigned*)(lds + (bufoff) + ldsw + _i * 8192), 16, 0, 0); } while (0)
#define PG8_RDA(off) (*(const PG8_LAS bf16x8*)(abase + (off)))
#define PG8_RDB(off) (*(const PG8_LAS bf16x8*)(bbase + ((off) - 4 * HTB)))
#define PG8_LDA(dst, b, h) do { if constexpr (FP8) { _Pragma("unroll") for (int m = 0; m < 4; ++m) dst##8[m] = pg8_cat(PG8_RDA(PG8_SA(b, h) + m * 2048), PG8_RDA(PG8_SA(b, h) + m * 2048 + 1024)); } \
    else { _Pragma("unroll") for (int m = 0; m < 4; ++m) _Pragma("unroll") for (int k = 0; k < 2; ++k) dst[m][k] = PG8_RDA(PG8_SA(b, h) + m * 2048 + k * 1024); } } while (0)
#define PG8_LDB(dst, b, h) do { if constexpr (FP8) { _Pragma("unroll") for (int n = 0; n < 2; ++n) dst##8[n] = pg8_cat(PG8_RDB(PG8_SB(b, h) + n * 2048), PG8_RDB(PG8_SB(b, h) + n * 2048 + 1024)); } \
    else { _Pragma("unroll") for (int n = 0; n < 2; ++n) _Pragma("unroll") for (int k = 0; k < 2; ++k) dst[n][k] = PG8_RDB(PG8_SB(b, h) + n * 2048 + k * 1024); } } while (0)
#define PG8_MMA(ai, bj, At, Bt) do { __builtin_amdgcn_s_setprio(1); if constexpr (FP8) { \
        _Pragma("unroll") for (int m = 0; m < 4; ++m) _Pragma("unroll") for (int n = 0; n < 2; ++n) \
            asm volatile("v_mfma_scale_f32_16x16x128_f8f6f4 %0, %1, %2, %0, %3, %4 op_sel_hi:[0,0,0]" : "+v"(acc[ai][bj][m][n]) : "v"(Bt##8[n]), "v"(At##8[m]), "v"(sclB), "v"(sclA)); \
        } else { _Pragma("unroll") for (int m = 0; m < 4; ++m) _Pragma("unroll") for (int n = 0; n < 2; ++n) _Pragma("unroll") for (int k = 0; k < 2; ++k) \
        acc[ai][bj][m][n] = __builtin_amdgcn_mfma_f32_16x16x32_bf16(Bt[n][k], At[m][k], acc[ai][bj][m][n], 0, 0, 0); } __builtin_amdgcn_s_setprio(0); } while (0)
#define PG8_WAIT_V(n) asm volatile("s_waitcnt vmcnt(" #n ")" ::: "memory")
#define PG8_WAIT_L(n) asm volatile("s_waitcnt lgkmcnt(" #n ")" ::: "memory")
#define PG8_BAR __builtin_amdgcn_s_barrier()
#define PG8_SCHED __builtin_amdgcn_sched_barrier(0)
    Unit cur, nxt; int ui = 0;
    if (!S.next(0, cur)) return;
    f32x4 acc[2][2][4][2];
#pragma unroll
    for (int a = 0; a < 2; ++a)
#pragma unroll
        for (int b = 0; b < 2; ++b)
#pragma unroll
            for (int m = 0; m < 4; ++m)
#pragma unroll
                for (int n = 0; n < 2; ++n) acc[a][b][m][n] = (f32x4){0.f, 0.f, 0.f, 0.f};
    const int sclA = g.scaleA, sclB = g.scaleB;
    bf16x8 At[4][2], B0[2][2], B1[2][2]; i32x8 At8[4], B08[2], B18[2];
    const char* cA = uptr((const char*)g.A + (size_t)cur.pm * tstepA); const char* cB = uptr((const char*)g.Bt + (size_t)cur.pn * tstepB);
    S.a_ready(cur);
    if constexpr (SP2) {
        PG8_STAGE(PG8_SB(0, 0), cB, voffB); PG8_STAGE(PG8_SB(0, 1), cB + hstepB, voffB); PG8_STAGE(PG8_SA(0, 0), cA, voffA); PG8_STAGE(PG8_SA(0, 1), cA + hstepA, voffA);
        if (wr == 1) PG8_BAR;
        PG8_WAIT_V(2); PG8_BAR;
        PG8_STAGE(PG8_SB(1, 0), cB + kstep, voffB); PG8_STAGE(PG8_SA(1, 0), cA + kstep, voffA); PG8_STAGE(PG8_SB(1, 1), cB + hstepB + kstep, voffB);
        PG8_WAIT_V(6); PG8_BAR;
    } else {
        PG8_STAGE(PG8_SB(0, 0), cB, voffB); PG8_STAGE(PG8_SA(0, 0), cA, voffA); PG8_STAGE(PG8_SB(0, 1), cB + hstepB, voffB); PG8_STAGE(PG8_SA(0, 1), cA + hstepA, voffA);
        if (wr == 1) PG8_BAR;
        PG8_WAIT_V(4); PG8_BAR;
        PG8_STAGE(PG8_SB(1, 0), cB + kstep, voffB); PG8_STAGE(PG8_SA(1, 0), cA + kstep, voffA); PG8_STAGE(PG8_SB(1, 1), cB + hstepB + kstep, voffB);
        PG8_WAIT_V(6); PG8_BAR;
    }
    for (;;) {
        const bool has_next = S.next(ui + 1, nxt);
        const char* nA = uptr(has_next ? (const char*)g.A + (size_t)nxt.pm * tstepA : cA); const char* nB = uptr(has_next ? (const char*)g.Bt + (size_t)nxt.pn * tstepB : cB);
        for (int t = 0; t < nt; t += 2) {
            asm volatile("" : "+v"(abase), "+v"(bbase));
            const bool last = (t == nt - 2);
            const char* a1 = cA + (size_t)(t + 1) * kstep;
            const char* a2 = uptr(last ? nA : cA + (size_t)(t + 2) * kstep); const char* b2 = uptr(last ? nB : cB + (size_t)(t + 2) * kstep);
            const char* a3 = a2 + kstep; const char* b3 = b2 + kstep;
            if (last && has_next) S.a_ready(nxt);
            if constexpr (SP2) {
            PG8_LDB(B0, 0, 0); PG8_LDB(B1, 0, 1); PG8_SCHED; PG8_LDA(At, 0, 0); PG8_STAGE(PG8_SA(1, 1), a1 + hstepA, voffA);
            PG8_WAIT_V(8); PG8_WAIT_L(0); PG8_BAR; PG8_MMA(0, 0, At, B0); PG8_MMA(0, 1, At, B1); PG8_BAR; PG8_SCHED;
            PG8_LDA(At, 0, 1); PG8_STAGE(PG8_SB(0, 0), b2, voffB); PG8_STAGE(PG8_SB(0, 1), b2 + hstepB, voffB); PG8_STAGE(PG8_SA(0, 0), a2, voffA);
            PG8_WAIT_V(8); PG8_WAIT_L(0); PG8_BAR; PG8_MMA(1, 0, At, B0); PG8_MMA(1, 1, At, B1); PG8_BAR; PG8_SCHED;
            PG8_LDB(B0, 1, 0); PG8_LDB(B1, 1, 1); PG8_SCHED; PG8_LDA(At, 1, 0); PG8_STAGE(PG8_SA(0, 1), a2 + hstepA, voffA);
            PG8_WAIT_V(8); PG8_WAIT_L(0); PG8_BAR; PG8_MMA(0, 0, At, B0); PG8_MMA(0, 1, At, B1); PG8_BAR; PG8_SCHED;
            PG8_LDA(At, 1, 1); PG8_STAGE(PG8_SB(1, 0), b3, voffB); PG8_STAGE(PG8_SB(1, 1), b3 + hstepB, voffB); PG8_STAGE(PG8_SA(1, 0), a3, voffA);
            PG8_WAIT_V(8); PG8_WAIT_L(0); PG8_BAR; PG8_MMA(1, 0, At, B0); PG8_MMA(1, 1, At, B1); PG8_BAR; PG8_SCHED;
            } else {
            PG8_LDB(B0, 0, 0); PG8_SCHED; PG8_LDA(At, 0, 0); PG8_STAGE(PG8_SA(1, 1), a1 + hstepA, voffA);
            PG8_WAIT_L(8); PG8_BAR; PG8_WAIT_L(0); PG8_MMA(0, 0, At, B0); PG8_BAR; PG8_SCHED;
            PG8_LDB(B1, 0, 1); PG8_STAGE(PG8_SB(0, 0), b2, voffB);
            PG8_BAR; PG8_WAIT_L(0); PG8_MMA(0, 1, At, B1); PG8_BAR;
            PG8_LDA(At, 0, 1); PG8_STAGE(PG8_SA(0, 0), a2, voffA);
            PG8_BAR; PG8_WAIT_L(0); PG8_MMA(1, 0, At, B0); PG8_BAR; PG8_SCHED;
            PG8_STAGE(PG8_SB(0, 1), b2 + hstepB, voffB);
            PG8_WAIT_V(6); PG8_BAR; PG8_MMA(1, 1, At, B1); PG8_BAR;
            PG8_LDB(B0, 1, 0); PG8_SCHED; PG8_LDA(At, 1, 0); PG8_STAGE(PG8_SA(0, 1), a2 + hstepA, voffA);
            PG8_WAIT_L(8); PG8_BAR; PG8_WAIT_L(0); PG8_MMA(0, 0, At, B0); PG8_BAR; PG8_SCHED;
            PG8_LDB(B1, 1, 1); PG8_STAGE(PG8_SB(1, 0), b3, voffB);
            PG8_BAR; PG8_WAIT_L(0); PG8_MMA(0, 1, At, B1); PG8_BAR;
            PG8_LDA(At, 1, 1); PG8_STAGE(PG8_SA(1, 0), a3, voffA);
            PG8_BAR; PG8_WAIT_L(0); PG8_MMA(1, 0, At, B0); PG8_BAR; PG8_SCHED;
            PG8_STAGE(PG8_SB(1, 1), b3 + hstepB, voffB);
            PG8_WAIT_V(6); PG8_BAR; PG8_MMA(1, 1, At, B1); PG8_BAR;
            }
        }
        if constexpr (FP8) asm volatile("s_nop 15\n\ts_nop 7" ::: "memory");
        if constexpr (ALIGN_EPI) { if (wr == 0) PG8_BAR; }
        if constexpr (!Epi::AFTER_DRAIN) { E(acc, cur, wr, wc, fr, fq); S.done(cur); }
        if (!has_next) break;
#pragma unroll
        for (int a = 0; a < 2; ++a)
#pragma unroll
            for (int b = 0; b < 2; ++b)
#pragma unroll
                for (int m = 0; m < 4; ++m)
#pragma unroll
                    for (int n = 0; n < 2; ++n) acc[a][b][m][n] = (f32x4){0.f, 0.f, 0.f, 0.f};
        cur = nxt; cA = nA; cB = nB; ++ui;
        if constexpr (ALIGN_EPI) { if (wr == 1) PG8_BAR; }
    }
    PG8_WAIT_V(0);
    if constexpr (!ALIGN_EPI) { if (wr == 0) PG8_BAR; }
    PG8_BAR;
    if constexpr (Epi::AFTER_DRAIN) { E.fused(acc, cur, wr, wc, fr, fq, lds, wid, lane); S.done(cur); }
#undef PG8_SA
#undef PG8_SB
#undef PG8_STAGE
#undef PG8_RDA
#undef PG8_RDB
#undef PG8_LDA
#undef PG8_LDB
#undef PG8_MMA
#undef PG8_WAIT_V
#undef PG8_WAIT_L
#undef PG8_BAR
#undef PG8_SCHED
}
}

#ifndef MK_FFN_FP8
#define MK_FFN_FP8 1
#endif
constexpr bool FFN_FP8 = MK_FFN_FP8;
constexpr int NWAVES = 8, NTHREADS = NWAVES * 64;
constexpr int BATCH = 2, SEQ = 8192, M = BATCH * SEQ, DM = 2048, DEPTH = 4, DFF = 5632, NGU = 2 * DFF, INC = 5976, NIN = 6144, NMOD = 9 * DM;
constexpr int DFFP = DFF + 128;
constexpr int NH = 8, HD = 64, GWID = 512, TOPK = 256, WINDOW = 128;
constexpr int PA_Q = 0, PA_K = 512, PA_V = 576, PA_IQ = 640, PA_IK = 1664, PB_Q = 1728, PB_K = 2240, PB_V = 2304, PC_Q = 2368, PC_K = 2880, PC_V = 3392, PC_G = 3904,
              PD_Q = 4416, PD_K = 4928, PD_V = 5440, PA_IW = 5952, PC_F = 5968;
constexpr float RMS_EPS = 1e-6f, LOG2E = 1.4426950408889634f, QSCALE = 0.125f * LOG2E;

constexpr size_t MiB = 1u << 20;
constexpr size_t WS_CTL = 0, CTL_ZERO_BYTES = 1 * MiB;
constexpr size_t WS_MOD = 1 * MiB;
constexpr size_t WS_LF = 2 * MiB;
constexpr size_t WS_KB2 = 3 * MiB;
constexpr size_t WS_WGU = 4 * MiB;
constexpr size_t SZ_WGU = (size_t)NGU * DM * 2;
constexpr size_t WS_WD = WS_WGU + 8 * SZ_WGU;
constexpr size_t SZ_WD = (size_t)DM * DFF * 2;
constexpr size_t WS_WIN = WS_WD + 8 * SZ_WD;
constexpr size_t SZ_WIN = (size_t)NIN * DM * 2;
constexpr size_t WS_WOUT = WS_WIN + 4 * SZ_WIN;
constexpr size_t SZ_WOUT = (size_t)DM * DM * 2;
constexpr size_t WS_H = WS_WOUT + 4 * SZ_WOUT;
constexpr size_t WS_P = WS_H + (size_t)M * DM * 2;
constexpr size_t WS_Y = WS_P + (size_t)M * NIN * 2;
constexpr size_t WS_IDX = WS_Y + (size_t)M * DM * 2;
constexpr size_t WS_SC = WS_IDX + (size_t)M * TOPK * 4;
constexpr size_t WS_XB = WS_SC + (size_t)BATCH * SEQ * SEQ * 2;
constexpr size_t WS_END = WS_XB + (size_t)M * DM * 2;
static_assert(WS_WGU % MiB == 0 && WS_WD % MiB == 0 && WS_WIN % MiB == 0 && WS_WOUT % MiB == 0 && WS_H % MiB == 0 && WS_P % MiB == 0 && WS_Y % MiB == 0 && WS_IDX % MiB == 0 && WS_SC % MiB == 0, "d_ws map alignment");
constexpr int CW_BAR = 4096;

constexpr int RING_OFF = 0, RING_BYTES = 131072;
constexpr int AUX_OFF = RING_BYTES, AUX_BYTES = 16384;
constexpr int LDSCTL_OFF = AUX_OFF + AUX_BYTES;
constexpr int LDS_BYTES = LDSCTL_OFF + 256;

#define GAS __attribute__((address_space(1)))
#define LAS __attribute__((address_space(3)))
typedef unsigned short bf16;
typedef unsigned v4u __attribute__((ext_vector_type(4)));
typedef unsigned v2u __attribute__((ext_vector_type(2)));
typedef int v4i __attribute__((ext_vector_type(4)));
typedef float f32x4 __attribute__((ext_vector_type(4)));
typedef float f32x16 __attribute__((ext_vector_type(16)));
typedef short bf16x8 __attribute__((ext_vector_type(8)));
typedef short s16x4 __attribute__((ext_vector_type(4)));
typedef GAS unsigned gu32;
#define RLX_AGENT __ATOMIC_RELAXED, __HIP_MEMORY_SCOPE_AGENT
#define LDS_WAIT() asm volatile("s_waitcnt lgkmcnt(0)" ::: "memory")
#define VM_WAIT() asm volatile("s_waitcnt vmcnt(0)" ::: "memory")
__device__ __forceinline__ unsigned f2bf(float f) { unsigned u = __builtin_bit_cast(unsigned, f); return (u + 0x7fffu + ((u >> 16) & 1u)) >> 16; }
__device__ __forceinline__ unsigned pk2(float lo, float hi) { return f2bf(lo) | (f2bf(hi) << 16); }
__device__ __forceinline__ float bf_lo(unsigned w) { return __builtin_bit_cast(float, w << 16); }
__device__ __forceinline__ float bf_hi(unsigned w) { return __builtin_bit_cast(float, w & 0xffff0000u); }
__device__ __forceinline__ float bf2f(bf16 h) { return __builtin_bit_cast(float, (unsigned)h << 16); }
__device__ __forceinline__ float wave_sum(float v) {
#pragma unroll
    for (int o = 1; o < 64; o <<= 1) v += __shfl_xor(v, o);
    return v;
}
__device__ __forceinline__ float fexp2(float x) { return __builtin_amdgcn_exp2f(x); }
__device__ __forceinline__ float frcp(float x) { return __builtin_amdgcn_rcpf(x); }
__device__ const unsigned char kBucketLut[128] = {0, 1, 2, 3, 4, 5, 6, 7, 8, 9, 10, 11, 12, 13, 14, 15, 16, 16, 16, 17, 17, 18, 18, 18, 19, 19, 19, 20, 20, 20, 20, 21, 21, 21, 21, 22, 22, 22, 22, 22,
    23, 23, 23, 23, 23, 23, 24, 24, 24, 24, 24, 24, 25, 25, 25, 25, 25, 25, 25, 26, 26, 26, 26, 26, 26, 26, 26, 27, 27, 27, 27, 27, 27, 27, 27, 27, 27, 28, 28, 28, 28, 28, 28, 28, 28, 28, 28,
    29, 29, 29, 29, 29, 29, 29, 29, 29, 29, 29, 29, 30, 30, 30, 30, 30, 30, 30, 30, 30, 30, 30, 30, 30, 30, 31, 31, 31, 31, 31, 31, 31, 31, 31, 31, 31, 31, 31, 31, 31};

#define XB_TMO      128
#define XB_XCNT(j)  (256  + 64 * (j))
#define XB_XSUB(j)  (1280 + 64 * (j))
#define XB_XGEN(j)  (2304 + 64 * (j))
#define XB_TOP      3328
#define XB_TOPGEN   3392
#define XCD_BAR_WORDS 3456
#define XB_SPIN_CAP (1u << 18)

__device__ __forceinline__ unsigned xb_ld(unsigned* p)              { return __hip_atomic_load((GAS unsigned*)p, __ATOMIC_RELAXED, __HIP_MEMORY_SCOPE_AGENT); }
__device__ __forceinline__ unsigned xb_add(unsigned* p, unsigned v) { return __hip_atomic_fetch_add((GAS unsigned*)p, v, __ATOMIC_RELAXED, __HIP_MEMORY_SCOPE_AGENT); }
__device__ __forceinline__ unsigned xb_xcc_id() { return (unsigned)__builtin_amdgcn_s_getreg((3 << 11) | 20) & 0xFu; }
#define XB_SPIN(cond, bar) do { unsigned _sp = 0; while (cond) { __builtin_amdgcn_s_sleep(1); \
    if ((++_sp & 255u) == 0u) { if (xb_ld(&(bar)[XB_TMO])) break; if (_sp > XB_SPIN_CAP) { xb_add(&(bar)[XB_TMO], 1u); break; } } } } while (0)

struct XcdBarrier {
    unsigned* bar; unsigned x;
    volatile LAS unsigned* st;
};

__device__ __forceinline__ XcdBarrier xcd_barrier_post(unsigned* bar, volatile LAS unsigned* st) {
    XcdBarrier b; b.bar = bar; b.x = xb_xcc_id(); b.st = st;
    if (threadIdx.x == 0) (void)xb_add(&bar[XB_XCNT(b.x)], 1u);
    return b;
}
__device__ __forceinline__ void xcd_barrier_complete(unsigned* bar, unsigned x, unsigned& nloc, unsigned& nx) {
    const unsigned G = gridDim.x * gridDim.y * gridDim.z;
    unsigned sum, cnt, mine, sp = 0u;
    for (;;) {
        sum = 0u; cnt = 0u; mine = 0u;
#pragma unroll
        for (unsigned j = 0; j < 16; ++j) { const unsigned c = xb_ld(&bar[XB_XCNT(j)]); sum += c; cnt += (c > 0u) ? 1u : 0u; mine = (j == x) ? c : mine; }
        if (sum == G) break;
        __builtin_amdgcn_s_sleep(1);
        if ((++sp & 255u) == 0u) { if (xb_ld(&bar[XB_TMO])) break; if (sp > XB_SPIN_CAP) { xb_add(&bar[XB_TMO], 1u); break; } }
    }
    nloc = mine > 0u ? mine : 1u; nx = cnt > 0u ? cnt : 1u;
}

__device__ __forceinline__ void xcd_barrier(const XcdBarrier& b) {
    asm volatile("s_waitcnt vmcnt(0)" ::: "memory");
    __syncthreads();
    if (threadIdx.x == 0) {
        unsigned* bar = b.bar; asm volatile("" : "+s"(bar));
        __builtin_amdgcn_s_waitcnt(0);
        unsigned nloc = b.st[0], nx = b.st[1];
        if (nloc == 0u) { xcd_barrier_complete(bar, b.x, nloc, nx); b.st[0] = nloc; b.st[1] = nx; }
        const unsigned old = xb_add(&bar[XB_XSUB(b.x)], 1u);
        const unsigned gen = old / nloc;
        if (old + 1u == (gen + 1u) * nloc) {
            __builtin_amdgcn_fence(__ATOMIC_RELEASE, "agent");
            asm volatile("s_waitcnt vmcnt(0)" ::: "memory");
            const unsigned og = xb_add(&bar[XB_TOP], 1u);
            const unsigned tg = og / nx;
            if (og + 1u == (tg + 1u) * nx) xb_add(&bar[XB_TOPGEN], 1u);
            else XB_SPIN(xb_ld(&bar[XB_TOPGEN]) == tg, bar);
            __builtin_amdgcn_fence(__ATOMIC_ACQUIRE, "agent");
            xb_add(&bar[XB_XGEN(b.x)], 1u);
            asm volatile("s_waitcnt vmcnt(0)" ::: "memory");
        } else {
            XB_SPIN(xb_ld(&bar[XB_XGEN(b.x)]) == gen, bar);
            __builtin_amdgcn_fence(__ATOMIC_ACQUIRE, "agent");
            asm volatile("s_waitcnt vmcnt(0)" ::: "memory");
        }
    }
    __syncthreads();
}

struct Frame {
    LAS unsigned char* lds;
    gu32* ctl;
    int tid, lane, wave, G, gw, NGW;
    const float *x, *c, *w_ada, *b_ada, *norm_g, *w_in, *qk_g, *forget_b, *sinks, *rel_table, *group_g, *w_out, *w_gate, *w_up, *w_down;
    float* out;
    float *MOD, *LF, *KB2; unsigned short* SC; int* IDX;
    bf16 *WGU, *WD, *WIN, *WOUT, *H, *P, *Y, *XB;
};

template <int MAP> __device__ __forceinline__ int w_rowmap(int n) {
    if (MAP == 1) return 256 * (n >> 7) + (n & 127);
    if (MAP == 2) return 256 * (n >> 7) + 128 + (n & 127);
    if (MAP == 3) { if (n < 1728) return n; if (n < 1744) return PA_IW + (n - 1728); if (n < 3920) return n - 16; if (n < 3928) return PC_F + (n - 3920); return n - 24; }
    return n;
}
template <int MAP> __device__ __forceinline__ void p0_transpose_item(const float* W, int K, int N, bf16* WT, LAS unsigned* T, int item, int lane) {
    const int nblk = (N + 63) / 64, kb = item / nblk, nb = item % nblk, k0 = 64 * kb, n0 = 64 * nb;
    const int r = lane >> 4, c = lane & 15;
    const bool nok = (n0 + 4 * c) < N;
    const float* src = W + (size_t)(k0 + 2 * r) * N + n0 + 4 * c;
    f32x4 a[8], b[8];
#pragma unroll
    for (int i = 0; i < 8; ++i) { a[i] = nok ? *(const GAS f32x4*)(src + (size_t)(8 * i) * N) : (f32x4){0.f, 0.f, 0.f, 0.f}; b[i] = nok ? *(const GAS f32x4*)(src + (size_t)(8 * i + 1) * N) : (f32x4){0.f, 0.f, 0.f, 0.f}; }
#pragma unroll
    for (int i = 0; i < 8; ++i)
#pragma unroll
        for (int e = 0; e < 4; ++e) T[(4 * c + e) * 36 + 4 * i + r] = pk2(a[i][e], b[i][e]);
    LDS_WAIT(); asm volatile("" ::: "memory");
    const int rr = lane >> 3, ch = lane & 7;
#pragma unroll
    for (int j = 0; j < 8; ++j) { const int n = 8 * j + rr; const v4u o = *(const LAS v4u*)(T + n * 36 + 4 * ch);
        if (n0 + n < N) *(GAS v4u*)(WT + (size_t)w_rowmap<MAP>(n0 + n) * K + k0 + 8 * ch) = o; }
    LDS_WAIT(); asm volatile("" ::: "memory");
}
constexpr float W8_SCALE = 64.0f; constexpr int W8_E8M0 = 127 - 6;
__device__ __forceinline__ unsigned pk_fp8x4(float a, float b, float c, float d) {
    a = fminf(fmaxf(a, -448.f), 448.f); b = fminf(fmaxf(b, -448.f), 448.f); c = fminf(fmaxf(c, -448.f), 448.f); d = fminf(fmaxf(d, -448.f), 448.f);
    int w = 0; w = __builtin_amdgcn_cvt_pk_fp8_f32(a, b, w, false); w = __builtin_amdgcn_cvt_pk_fp8_f32(c, d, w, true); return (unsigned)w; }
template <int MAP> __device__ __forceinline__ void p0_transpose8_item(const float* W, int K, int N, unsigned char* WT, int ldw, LAS unsigned* T, int item, int lane) {
    const int nblk = (N + 63) / 64, kb = item / nblk, nb = item % nblk, k0 = 64 * kb, n0 = 64 * nb;
    const int r = lane >> 4, c = lane & 15;
    const bool nok = (n0 + 4 * c) < N;
    const float* src = W + (size_t)(k0 + 4 * r) * N + n0 + 4 * c;
    f32x4 q[4][4];
#pragma unroll
    for (int i = 0; i < 4; ++i)
#pragma unroll
        for (int d = 0; d < 4; ++d) q[i][d] = nok ? *(const GAS f32x4*)(src + (size_t)(16 * i + d) * N) : (f32x4){0.f, 0.f, 0.f, 0.f};
#pragma unroll
    for (int i = 0; i < 4; ++i)
#pragma unroll
        for (int e = 0; e < 4; ++e) T[(4 * c + e) * 20 + 4 * i + r] = pk_fp8x4(q[i][0][e] * W8_SCALE, q[i][1][e] * W8_SCALE, q[i][2][e] * W8_SCALE, q[i][3][e] * W8_SCALE);
    LDS_WAIT(); asm volatile("" ::: "memory");
    const int rr = lane >> 2, ch = lane & 3;
#pragma unroll
    for (int j = 0; j < 4; ++j) { const int n = 16 * j + rr; const v4u o = *(const LAS v4u*)(T + n * 20 + 4 * ch);
        if (n0 + n < N) *(GAS v4u*)(WT + (size_t)w_rowmap<MAP>(n0 + n) * ldw + k0 + 16 * ch) = o; }
    LDS_WAIT(); asm volatile("" ::: "memory");
}
template <int MAP> __device__ __forceinline__ void p0_transpose8(const Frame& F, const float* W, int K, int N, unsigned char* WT, int ldw, LAS unsigned* scr) {
    const int nitems = (K / 64) * ((N + 63) / 64);
    for (int it = F.gw; it < nitems; it += F.NGW) p0_transpose8_item<MAP>(W, K, N, WT, ldw, scr, it, F.lane);
}
template <int MAP> __device__ __forceinline__ void p0_transpose(const Frame& F, const float* W, int K, int N, bf16* WT, LAS unsigned* scr) {
    const int nitems = (K / 64) * ((N + 63) / 64);
    for (int it = F.gw; it < nitems; it += F.NGW) p0_transpose_item<MAP>(W, K, N, WT, scr, it, F.lane);
}
__device__ __forceinline__ void p0_prologue(const Frame& F) {
    LAS unsigned* scr = (LAS unsigned*)(F.lds + RING_OFF + F.wave * 16384);
    LAS float* cond = (LAS float*)(F.lds + AUX_OFF);
    LAS float* red = (LAS float*)(F.lds + RING_OFF);
    for (int i = F.tid; i < BATCH * DM; i += NTHREADS) { const float v = F.c[i]; cond[i] = v / (1.0f + __expf(-v)); }
    __syncthreads();
    for (int it = blockIdx.x; it < DEPTH * (NMOD / 64); it += F.G) {
        const int l = it / (NMOD / 64), n = (it % (NMOD / 64)) * 64 + F.lane;
        const float* w = F.w_ada + (size_t)l * DM * NMOD + (size_t)(256 * F.wave) * NMOD + n;
        const LAS float* c0 = cond + 256 * F.wave; const LAS float* c1 = cond + DM + 256 * F.wave;
        float a0 = 0.f, a1 = 0.f;
#pragma unroll 32
        for (int k = 0; k < 256; ++k) { const float wv = w[(size_t)k * NMOD]; a0 += c0[k] * wv; a1 += c1[k] * wv; }
        red[F.wave * 128 + F.lane] = a0; red[F.wave * 128 + 64 + F.lane] = a1;
        __syncthreads();
        if (F.tid < 128) { float sacc = 0.f;
#pragma unroll
            for (int wv = 0; wv < 8; ++wv) sacc += red[wv * 128 + F.tid];
            const int bsel = F.tid >> 6, nn = (it % (NMOD / 64)) * 64 + (F.tid & 63);
            F.MOD[((size_t)l * BATCH + bsel) * NMOD + nn] = sacc + F.b_ada[(size_t)l * NMOD + nn]; }
        __syncthreads();
    }
    for (int lf = 0; lf < DEPTH * 2; ++lf) {
        if (FFN_FP8) {
            p0_transpose8<1>(F, F.w_gate + (size_t)lf * DM * DFF, DM, DFF, (unsigned char*)F.WGU + (size_t)lf * NGU * DM, DM, scr);
            p0_transpose8<2>(F, F.w_up + (size_t)lf * DM * DFF, DM, DFF, (unsigned char*)F.WGU + (size_t)lf * NGU * DM, DM, scr);
            p0_transpose8<0>(F, F.w_down + (size_t)lf * DFF * DM, DFF, DM, (unsigned char*)F.WD + (size_t)lf * DM * DFFP, DFFP, scr);
        } else {
            p0_transpose<1>(F, F.w_gate + (size_t)lf * DM * DFF, DM, DFF, F.WGU + (size_t)lf * NGU * DM, scr);
            p0_transpose<2>(F, F.w_up + (size_t)lf * DM * DFF, DM, DFF, F.WGU + (size_t)lf * NGU * DM, scr);
            p0_transpose<0>(F, F.w_down + (size_t)lf * DFF * DM, DFF, DM, F.WD + (size_t)lf * DM * DFF, scr);
        }
    }
    for (int l = 0; l < DEPTH; ++l) {
        p0_transpose<3>(F, F.w_in + (size_t)l * DM * INC, DM, INC, F.WIN + (size_t)l * NIN * DM, scr);
        p0_transpose<0>(F, F.w_out + (size_t)l * DM * DM, DM, DM, F.WOUT + (size_t)l * DM * DM, scr);
        GAS v4u* z = (GAS v4u*)(F.WIN + (size_t)l * NIN * DM + (size_t)INC * DM);
        for (int i = F.gw * 64 + F.lane; i < (NIN - INC) * DM / 8; i += F.NGW * 64) z[i] = (v4u){0u, 0u, 0u, 0u};
    }
}

template <bool OUT8, bool IN16> __device__ __forceinline__ void ph_modulate(const Frame& F, const void* xin, const float* g, const float* shift, const float* scale) {
    for (int m = F.gw; m < M; m += F.NGW) {
        const int b = m / SEQ;
        float x[4][8]; float s = 0.f;
        if constexpr (IN16) {
            const GAS v4u* xr = (const GAS v4u*)((const bf16*)xin + (size_t)m * DM) + F.lane;
            v4u w[4];
#pragma unroll
            for (int j = 0; j < 4; ++j) w[j] = xr[64 * j];
#pragma unroll
            for (int j = 0; j < 4; ++j) { x[j][0] = bf_lo(w[j].x); x[j][1] = bf_hi(w[j].x); x[j][2] = bf_lo(w[j].y); x[j][3] = bf_hi(w[j].y); x[j][4] = bf_lo(w[j].z); x[j][5] = bf_hi(w[j].z); x[j][6] = bf_lo(w[j].w); x[j][7] = bf_hi(w[j].w); }
        } else {
            const GAS f32x4* xr = (const GAS f32x4*)((const float*)xin + (size_t)m * DM) + 2 * F.lane;
            f32x4 a[4][2];
#pragma unroll
            for (int j = 0; j < 4; ++j) { a[j][0] = xr[128 * j]; a[j][1] = xr[128 * j + 1]; }
            GAS v4u* xo = (GAS v4u*)(F.XB + (size_t)m * DM) + F.lane;
#pragma unroll
            for (int j = 0; j < 4; ++j) { x[j][0] = a[j][0].x; x[j][1] = a[j][0].y; x[j][2] = a[j][0].z; x[j][3] = a[j][0].w; x[j][4] = a[j][1].x; x[j][5] = a[j][1].y; x[j][6] = a[j][1].z; x[j][7] = a[j][1].w;
                v4u w; w.x = pk2(x[j][0], x[j][1]); w.y = pk2(x[j][2], x[j][3]); w.z = pk2(x[j][4], x[j][5]); w.w = pk2(x[j][6], x[j][7]); xo[64 * j] = w; }
        }
#pragma unroll
        for (int j = 0; j < 4; ++j) s += ((x[j][0] * x[j][0] + x[j][1] * x[j][1]) + (x[j][2] * x[j][2] + x[j][3] * x[j][3])) + ((x[j][4] * x[j][4] + x[j][5] * x[j][5]) + (x[j][6] * x[j][6] + x[j][7] * x[j][7]));
        const float rstd = 1.0f / sqrtf(wave_sum(s) * (1.f / DM) + RMS_EPS);
        const GAS f32x4* gp = (const GAS f32x4*)g + 2 * F.lane; const GAS f32x4* sh = (const GAS f32x4*)(shift + (size_t)b * NMOD) + 2 * F.lane; const GAS f32x4* sc = (const GAS f32x4*)(scale + (size_t)b * NMOD) + 2 * F.lane;
        GAS v4u* o16 = (GAS v4u*)(F.H + (size_t)m * DM) + F.lane;
        GAS v2u* o8 = (GAS v2u*)((unsigned char*)F.H + (size_t)m * DM) + F.lane;
#pragma unroll
        for (int j = 0; j < 4; ++j) { float y[8];
#pragma unroll
            for (int h = 0; h < 2; ++h) { const f32x4 gg = gp[128 * j + h], ss = sc[128 * j + h], hh = sh[128 * j + h];
                y[4 * h + 0] = x[j][4 * h + 0] * rstd * gg.x * (ss.x + 1.0f) + hh.x; y[4 * h + 1] = x[j][4 * h + 1] * rstd * gg.y * (ss.y + 1.0f) + hh.y;
                y[4 * h + 2] = x[j][4 * h + 2] * rstd * gg.z * (ss.z + 1.0f) + hh.z; y[4 * h + 3] = x[j][4 * h + 3] * rstd * gg.w * (ss.w + 1.0f) + hh.w; }
            if (OUT8) { v2u w; w.x = pk_fp8x4(y[0], y[1], y[2], y[3]); w.y = pk_fp8x4(y[4], y[5], y[6], y[7]); o8[64 * j] = w; }
            else { v4u w; w.x = pk2(y[0], y[1]); w.y = pk2(y[2], y[3]); w.z = pk2(y[4], y[5]); w.w = pk2(y[6], y[7]); o16[64 * j] = w; } }
    }
}
__device__ __forceinline__ v4u headnorm8(v4u w, const float* g, float mul, int lane, bool normalize) {
    float x[8] = {bf_lo(w.x), bf_hi(w.x), bf_lo(w.y), bf_hi(w.y), bf_lo(w.z), bf_hi(w.z), bf_lo(w.w), bf_hi(w.w)};
    float r = mul;
    if (normalize) {
        float s = 0.f;
#pragma unroll
        for (int i = 0; i < 8; ++i) s += x[i] * x[i];
        s += __shfl_xor(s, 1); s += __shfl_xor(s, 2); s += __shfl_xor(s, 4);
        r = mul / sqrtf(s * (1.f / 64.f) + RMS_EPS);
        const f32x4 g0 = *(const GAS f32x4*)(g + 8 * (lane & 7)), g1 = *(const GAS f32x4*)(g + 8 * (lane & 7) + 4);
        x[0] *= g0.x; x[1] *= g0.y; x[2] *= g0.z; x[3] *= g0.w; x[4] *= g1.x; x[5] *= g1.y; x[6] *= g1.z; x[7] *= g1.w;
    }
    w.x = pk2(x[0] * r, x[1] * r); w.y = pk2(x[2] * r, x[3] * r); w.z = pk2(x[4] * r, x[5] * r); w.w = pk2(x[6] * r, x[7] * r);
    return w;
}
__device__ __forceinline__ void ph_post(const Frame& F, int l) {
    const float* qg = F.qk_g + (size_t)l * 6 * HD;
    for (int m = F.gw; m < M; m += F.NGW) {
        bf16* row = F.P + (size_t)m * NIN; const int lane = F.lane;
        GAS v4u* paq = (GAS v4u*)(row + PA_Q + 8 * lane); GAS v4u* pbq = (GAS v4u*)(row + PB_Q + 8 * lane); GAS v4u* pcq = (GAS v4u*)(row + PC_Q + 8 * lane);
        GAS v4u* pck = (GAS v4u*)(row + PC_K + 8 * lane); GAS v4u* pdq = (GAS v4u*)(row + PD_Q + 8 * lane);
        GAS v4u* pkk = (GAS v4u*)(row + (lane < 8 ? PA_K : PB_K) + 8 * (lane & 7));
        const v4u waq = *paq, wbq = *pbq, wcq = *pcq, wck = *pck, wdq = *pdq;
        v4u wkk = {0u, 0u, 0u, 0u}; if (lane < 16) wkk = *pkk;
        *paq = headnorm8(waq, qg + 0 * HD, QSCALE, lane, true);
        *pbq = headnorm8(wbq, qg + 2 * HD, QSCALE, lane, true);
        *pcq = headnorm8(wcq, qg + 4 * HD, QSCALE, lane, true);
        *pck = headnorm8(wck, qg + 5 * HD, 1.0f, lane, true);
        *pdq = headnorm8(wdq, qg, QSCALE, lane, false);
        if (lane < 16) *pkk = headnorm8(wkk, qg + (lane < 8 ? 1 : 3) * HD, 1.0f, lane, true);
    }
}
__device__ __forceinline__ void ph_scan(const Frame& F, int l) {
    LAS float* wtot = (LAS float*)(F.lds + RING_OFF);
    for (int sq = blockIdx.x; sq < BATCH * NH; sq += F.G) {
        const int b = sq / NH, h = sq % NH; const float fb = F.forget_b[(size_t)l * NH + h];
        const GAS unsigned short* src = (const GAS unsigned short*)(F.P + ((size_t)b * SEQ + 16 * F.tid) * NIN + PC_F + h); float* dst = F.KB2 + (size_t)sq * SEQ + 16 * F.tid;
        float v[16]; unsigned short raw[16];
#pragma unroll
        for (int i = 0; i < 16; ++i) raw[i] = src[(size_t)i * NIN];
#pragma unroll
        for (int i = 0; i < 16; ++i) { const float y = __builtin_bit_cast(float, (unsigned)raw[i] << 16) + fb; v[i] = (y >= 0.f) ? -log1pf(__expf(-y)) : (y - log1pf(__expf(y))); }
#pragma unroll
        for (int i = 1; i < 16; ++i) v[i] += v[i - 1];
        float incl = v[15];
#pragma unroll
        for (int o = 1; o < 64; o <<= 1) { const float t = __shfl_up(incl, o); if (F.lane >= o) incl += t; }
        if (F.lane == 63) wtot[F.wave] = incl;
        __syncthreads();
        float base = incl - v[15];
        for (int w = 0; w < F.wave; ++w) base += wtot[w];
#pragma unroll
        for (int i = 0; i < 4; ++i) *(GAS f32x4*)(dst + 4 * i) = (f32x4){-(v[4 * i] + base) * LOG2E, -(v[4 * i + 1] + base) * LOG2E, -(v[4 * i + 2] + base) * LOG2E, -(v[4 * i + 3] + base) * LOG2E};
        __syncthreads();
    }
}
__device__ __forceinline__ void ph_gnorm(const Frame& F, int l) {
    const float* gg = F.group_g + (size_t)l * DM;
    for (int m = F.gw; m < M; m += F.NGW) {
        v4u w[4];
#pragma unroll
        for (int g = 0; g < 4; ++g) w[g] = *(GAS v4u*)(F.Y + (size_t)m * DM + g * GWID + 8 * F.lane);
#pragma unroll
        for (int g = 0; g < 4; ++g) {
            bf16* p = F.Y + (size_t)m * DM + g * GWID + 8 * F.lane;
            float x[8] = {bf_lo(w[g].x), bf_hi(w[g].x), bf_lo(w[g].y), bf_hi(w[g].y), bf_lo(w[g].z), bf_hi(w[g].z), bf_lo(w[g].w), bf_hi(w[g].w)};
            float s = 0.f;
#pragma unroll
            for (int i = 0; i < 8; ++i) s += x[i] * x[i];
            const float r = 1.0f / sqrtf(wave_sum(s) * (1.f / GWID) + RMS_EPS);
            const f32x4 g0 = *(const GAS f32x4*)(gg + g * GWID + 8 * F.lane), g1 = *(const GAS f32x4*)(gg + g * GWID + 8 * F.lane + 4);
            v4u o; o.x = pk2(x[0] * r * g0.x, x[1] * r * g0.y); o.y = pk2(x[2] * r * g0.z, x[3] * r * g0.w); o.z = pk2(x[4] * r * g1.x, x[5] * r * g1.y); o.w = pk2(x[6] * r * g1.z, x[7] * r * g1.w);
            *(GAS v4u*)p = o;
        }
    }
}


__device__ __forceinline__ unsigned short score_key(float sc) {
    const _Float16 hf = (_Float16)fminf(fmaxf(sc, -60000.f), 60000.f);
    const unsigned h = (unsigned)__builtin_bit_cast(unsigned short, hf);
    return (unsigned short)((h & 0x8000u) ? (~h & 0xffffu) : (h | 0x8000u));
}
__device__ __forceinline__ void glds16x(const void* gsrc, unsigned lds_dst) { unsigned keep;
    asm volatile("s_mov_b32 %0, m0\n\ts_mov_b32 m0, %2\n\ts_nop 0\n\tglobal_load_lds_dwordx4 %1, off\n\ts_mov_b32 m0, %0" : "=&s"(keep) : "v"(gsrc), "s"(lds_dst) : "memory"); }
__device__ __forceinline__ void ph_idx_scores(const Frame& F) {
    constexpr int UPB = 8 * (16 * 17 / 2), NU = BATCH * UPB;
    const int lane = F.lane, r32 = lane & 31, hi = lane >> 5;
    const int u_lo = (int)(((long)blockIdx.x * NU) / F.G), u_hi = (int)(((long)(blockIdx.x + 1) * NU) / F.G);
    if (u_lo >= u_hi) return;
    int b = u_lo / UPB, qb = 127, kc = 0; { int r = u_lo % UPB; for (;;) { const int n = (qb >> 3) + 1; if (r < n) { kc = r; break; } r -= n; --qb; } }
    LAS unsigned char* KL = F.lds + RING_OFF;
    const unsigned kl_lds = (unsigned)(size_t)KL;
#define X1_STAGE(bb, kk, buf) do { const bf16* ksrc_ = F.P + ((size_t)(bb) * SEQ + 512 * (kk) + 64 * F.wave + lane) * NIN + PA_IK; \
        _Pragma("unroll") for (int c_ = 0; c_ < 8; ++c_) glds16x(ksrc_ + 8 * c_, (unsigned)__builtin_amdgcn_readfirstlane(kl_lds + (buf) * 65536 + c_ * 8192 + F.wave * 1024)); } while (0)
    X1_STAGE(b, kc, 0);
    asm volatile("s_waitcnt vmcnt(0)" ::: "memory"); __syncthreads();
    bf16x8 af[4][4]; float wq[4][16]; int cb = -1, cqb = -1;
    for (int u = u_lo; u < u_hi; ++u) {
        const int cur = (u - u_lo) & 1;
        int nb = b, nqb = qb, nkc = kc + 1; if (nkc > (qb >> 3)) { nkc = 0; --nqb; if (nqb < 0) { nqb = 127; ++nb; } }
        if (u + 1 < u_hi) X1_STAGE(nb, nkc, cur ^ 1);
        const size_t rowb = (size_t)b * SEQ; const int t0 = 64 * qb + 8 * F.wave;
        if (b != cb || qb != cqb) { cb = b; cqb = qb;
#pragma unroll
            for (int pr = 0; pr < 4; ++pr) {
                const bf16* qrow = F.P + (rowb + t0 + 2 * pr + ((r32 >> 2) & 1)) * NIN + PA_IQ + ((r32 & 3) + 4 * (r32 >> 3)) * 64 + 8 * hi;
#pragma unroll
                for (int s = 0; s < 4; ++s) af[pr][s] = *(const GAS bf16x8*)(qrow + 16 * s);
                const bf16* wrow = F.P + (rowb + t0 + 2 * pr + hi) * NIN + PA_IW;
                const v4u w0 = *(const GAS v4u*)wrow, w1 = *(const GAS v4u*)(wrow + 8);
                const unsigned ww[8] = {w0.x, w0.y, w0.z, w0.w, w1.x, w1.y, w1.z, w1.w};
#pragma unroll
                for (int i = 0; i < 8; ++i) { wq[pr][2 * i] = bf_lo(ww[i]) * 0.015625f; wq[pr][2 * i + 1] = bf_hi(ww[i]) * 0.015625f; }
            }
        }
        const int kend = 64 * (qb + 1) - 512 * kc;
        const int nkt = kend >= 512 ? 16 : (kend + 31) / 32;
        const LAS unsigned char* kl = KL + cur * 65536 + hi * 8192 + r32 * 16;
        for (int kt = 0; kt < nkt; ++kt) {
            bf16x8 bfr[4];
#pragma unroll
            for (int s = 0; s < 4; ++s) bfr[s] = *(const LAS bf16x8*)(kl + s * 16384 + kt * 512);
            const int s0 = 512 * kc + 32 * kt;
#pragma unroll
            for (int pr = 0; pr < 4; ++pr) {
                f32x16 acc = {};
#pragma unroll
                for (int s = 0; s < 4; ++s) acc = __builtin_amdgcn_mfma_f32_32x32x16_bf16(af[pr][s], bfr[s], acc, 0, 0, 0);
                float sc0 = 0.f, sc1 = 0.f;
#pragma unroll
                for (int r = 0; r < 16; ++r) { sc0 = __builtin_fmaf(wq[pr][r], acc[r], sc0); sc1 = __builtin_fmaf(wq[pr][r], __builtin_fabsf(acc[r]), sc1); if ((r & 3) == 3) asm("" : "+v"(sc1)); }
                ((GAS unsigned short*)F.SC)[(rowb + t0 + 2 * pr + hi) * SEQ + s0 + r32] = score_key(sc0 + sc1);
                __builtin_amdgcn_sched_barrier(0);
            }
        }
        asm volatile("s_waitcnt vmcnt(0)" ::: "memory");
        __syncthreads();
        b = nb; qb = nqb; kc = nkc;
    }
#undef X1_STAGE
}

__device__ __forceinline__ unsigned mbcnt64(unsigned long long m) { return __builtin_amdgcn_mbcnt_hi((unsigned)(m >> 32), __builtin_amdgcn_mbcnt_lo((unsigned)m, 0u)); }
template <int SH, int PSH> __device__ __forceinline__ void sel_level(const unsigned (&v)[64], int nreg, unsigned pval, unsigned need, LAS unsigned* hist, int lane, unsigned& bin_out, unsigned& above_out) {
#pragma unroll
    for (int i = 0; i < 8; ++i) ((LAS v4u*)hist)[lane + 64 * i] = (v4u){0u, 0u, 0u, 0u};
    LDS_WAIT(); __builtin_amdgcn_wave_barrier();
    const unsigned hb = (unsigned)(size_t)hist, sink = hb + 9216u + 4u * (unsigned)lane;
#pragma unroll
    for (int g = 0; g < 8; ++g) if (8 * g < nreg) {
#pragma unroll
        for (int jj = 0; jj < 8; ++jj) { const int j = 8 * g + jj;
#pragma unroll
            for (int e = 0; e < 2; ++e) { const unsigned k = e ? (v[j] >> 16) : (v[j] & 0xffffu);
                const bool pred = (k != 0u) && (PSH >= 16 || (k >> (PSH & 15)) == pval);
                const unsigned tgt = pred ? hb + (((k >> SH) & 2047u) << 2) : sink;
                __hip_atomic_fetch_add((LAS unsigned*)tgt, 1u, __ATOMIC_RELAXED, __HIP_MEMORY_SCOPE_WAVEFRONT); }
            if ((jj & 1) == 1) __builtin_amdgcn_sched_barrier(0); }
    }
    LDS_WAIT(); __builtin_amdgcn_wave_barrier();
    unsigned S = 0u;
#pragma unroll
    for (int i = 0; i < 8; ++i) { const v4u q = ((LAS v4u*)hist)[lane * 8 + i]; S += (q.x + q.y) + (q.z + q.w); }
    unsigned T = S;
#pragma unroll
    for (int o = 1; o < 64; o <<= 1) { const unsigned t = __shfl_down(T, o); if (lane + o < 64) T += t; }
    const unsigned above_lane = T - S;
    const bool cross = (T >= need) && (above_lane < need);
    unsigned run = above_lane, bin = 0u, ab = 0u; bool found = false;
#pragma unroll
    for (int i = 7; i >= 0; --i) { const v4u q = ((LAS v4u*)hist)[lane * 8 + i]; const unsigned c4[4] = {q.x, q.y, q.z, q.w};
#pragma unroll
        for (int e = 3; e >= 0; --e) { const bool hit = !found && (run + c4[e] >= need); if (hit) { bin = 32u * lane + 4 * i + e; ab = run; found = true; } run += c4[e]; } }
    const unsigned long long cm = __ballot(cross);
    const int src = cm ? (int)__builtin_ctzll(cm) : 0;
    bin_out = __builtin_amdgcn_readlane(bin, src); above_out = __builtin_amdgcn_readlane(ab, src);
    LDS_WAIT(); __builtin_amdgcn_wave_barrier();
}
__device__ __forceinline__ void select_row(const Frame& F, int m, LAS unsigned* hist, LAS int* out) {
    int lane = F.lane; asm volatile("" : "+v"(lane));
    const int t = m % SEQ, n = t + 1;
    if (n <= TOPK) { for (int j = lane; j < TOPK; j += 64) out[j] = (j < n) ? j : 0; return; }
    const int nreg = (n + 127) >> 7;
    unsigned v[64];
    const GAS unsigned* pr = (const GAS unsigned*)(F.SC + (size_t)m * SEQ) + lane;
#pragma unroll
    for (int g = 0; g < 8; ++g) {
        if (8 * g < nreg) {
#pragma unroll
            for (int jj = 0; jj < 8; ++jj) v[8 * g + jj] = pr[jj * 64];
        } else {
#pragma unroll
            for (int jj = 0; jj < 8; ++jj) v[8 * g + jj] = 0u;
        }
        pr += 512; asm volatile("" : "+v"(pr));
    }
    const int nfull = n >> 7;
#pragma unroll
    for (int g = 0; g < 8; ++g) if (8 * g < nreg && 8 * g + 8 > nfull) {
#pragma unroll
        for (int jj = 0; jj < 8; ++jj) { const int j = 8 * g + jj; const int e0 = 128 * j + 2 * lane; const unsigned w = v[j];
            v[j] = ((e0 < n) ? (w & 0xffffu) : 0u) | ((e0 + 1 < n) ? (w & 0xffff0000u) : 0u); asm volatile("" : "+v"(v[j])); }
    }
    unsigned b1, a1, b2, a2;
    sel_level<5, 16>(v, nreg, 0u, (unsigned)TOPK, hist, lane, b1, a1);
    sel_level<0, 5>(v, nreg, b1, (unsigned)TOPK - a1, hist, lane, b2, a2);
    const unsigned tau = (b1 << 5) | (b2 & 31u);
    const unsigned quota = (unsigned)TOPK - a1 - a2;
    unsigned mg[4] = {0u, 0u, 0u, 0u}, me[4] = {0u, 0u, 0u, 0u};
#pragma unroll
    for (int g = 0; g < 8; ++g) {
        if (8 * g < nreg) {
#pragma unroll
            for (int jj = 0; jj < 8; ++jj) { const int j = 8 * g + jj;
#pragma unroll
                for (int e = 0; e < 2; ++e) { const unsigned k = e ? (v[j] >> 16) : (v[j] & 0xffffu);
                    mg[g >> 1] = mg[g >> 1] + mg[g >> 1] + ((k > tau) ? 1u : 0u); me[g >> 1] = me[g >> 1] + me[g >> 1] + ((k == tau) ? 1u : 0u); }
                if ((jj & 3) == 3) __builtin_amdgcn_sched_barrier(0); }
        } else { mg[g >> 1] <<= 16; me[g >> 1] <<= 16; }
    }
    const unsigned cg = (unsigned)(__builtin_popcount(mg[0]) + __builtin_popcount(mg[1]) + __builtin_popcount(mg[2]) + __builtin_popcount(mg[3]));
    unsigned ce = (unsigned)(__builtin_popcount(me[0]) + __builtin_popcount(me[1]) + __builtin_popcount(me[2]) + __builtin_popcount(me[3]));
    unsigned incl = cg | (ce << 16);
#pragma unroll
    for (int o = 1; o < 64; o <<= 1) { const unsigned t = (unsigned)__shfl_up((int)incl, o); if (lane >= o) incl += t; }
    const unsigned excl = incl - (cg | (ce << 16));
    const unsigned pre_g = excl & 0xffffu, pre_e = excl >> 16;
    const unsigned keep = pre_e >= quota ? 0u : ((quota - pre_e) < ce ? (quota - pre_e) : ce);
#pragma unroll
    for (int q = 3; q >= 0; --q) { while (ce > keep && me[q] != 0u) { me[q] &= me[q] - 1u; --ce; } }
    unsigned pos = pre_g + (pre_e < quota ? pre_e : quota);
    const int ilane = 2 * lane;
#pragma unroll
    for (int q = 0; q < 4; ++q) { unsigned mm = mg[q] | me[q];
        while (mm != 0u) { const int bpos = 31 - (int)__builtin_clz(mm); const int sl = 31 - bpos; mm &= ~(1u << bpos);
            const int i = 128 * (16 * q + (sl >> 1)) + ilane + (sl & 1);
            if (pos < (unsigned)TOPK) out[pos] = i;
            ++pos; } }
}


constexpr int AT_K = 0, AT_V = 16384, AT_KB = 32768, AT_WSF = 33280, AT_BT = 35328, AT_DEAD = 35840, AT_SV = 36864;
typedef short v4i16_t __attribute__((ext_vector_type(4)));
__device__ __forceinline__ s16x4 vtr(const LAS unsigned char* p) { return __builtin_bit_cast(s16x4, __builtin_amdgcn_ds_read_tr16_b64_v4i16((LAS v4i16_t*)p)); }
typedef __bf16 bfpair_t __attribute__((ext_vector_type(2))); typedef float f32pair_t __attribute__((ext_vector_type(2)));
__device__ __forceinline__ unsigned cvtpk(float lo, float hi) { const f32pair_t v = {lo, hi}; return __builtin_bit_cast(unsigned, __builtin_convertvector(v, bfpair_t)); }
#define NEG_INF (-__builtin_inff())

template <int TYPE>
__device__ __forceinline__ void dense_attn_unit(const Frame& F, int l, int b, int h, int qb) {
    constexpr int QOFF = TYPE == 1 ? PB_Q : TYPE == 2 ? PC_Q : PD_Q, KOFF = TYPE == 1 ? PB_K : TYPE == 2 ? PC_K : PD_K, VOFF = TYPE == 1 ? PB_V : TYPE == 2 ? PC_V : PD_V;
    constexpr bool MQA = TYPE == 1; constexpr int YOFF = TYPE * GWID;
    const int tid = F.tid, lane = F.lane, wid = F.wave, r32 = lane & 31, hi = lane >> 5;
    LAS unsigned char* L = F.lds + RING_OFF;
    LAS float* wsf = (LAS float*)(L + AT_WSF + wid * 256);
    LAS float* BT = (LAS float*)(L + AT_BT);
    const int hq = (TYPE == 1) ? wid : h, qoff = (TYPE == 1) ? (qb & 7) * 32 : wid * 32, qb256 = (TYPE == 1) ? (qb >> 3) : qb;
    const size_t rowb = (size_t)b * SEQ; const int q0 = qb256 * 256;
    const bf16* Pk = F.P + rowb * NIN + KOFF + (MQA ? 0 : h * 64);
    const bf16* Pv = F.P + rowb * NIN + VOFF + (MQA ? 0 : h * 64);
    const bf16* Pq = F.P + (rowb + q0 + qoff + r32) * NIN + QOFF + hq * 64 + hi * 8;
    bf16x8 qr[4];
#pragma unroll
    for (int d0 = 0; d0 < 4; ++d0) qr[d0] = *(const GAS bf16x8*)(Pq + 16 * d0);
    const int jt_hi = (TYPE == 1) ? ((q0 + qoff + 31) >> 6) : 4 * qb256 + 3, jt_lo = (TYPE == 1) ? (((q0 + qoff - (WINDOW - 1)) > 0 ? (q0 + qoff - (WINDOW - 1)) : 0) >> 6) : 0, nt = jt_hi - jt_lo + 1;
    if (TYPE == 1) { LAS float* BTall = (LAS float*)(L + AT_SV);
        for (int i = tid; i < 8 * 128; i += NTHREADS) BTall[i] = F.rel_table[(int)kBucketLut[i & 127] * 16 + 8 + (i >> 7)] * LOG2E;
        BT = BTall + 128 * wid; }
    const bf16* kgp = Pk + (size_t)lane * NIN + wid * 8;
    const int vkey = tid >> 3, vch = tid & 7;
    const bf16* vgp = Pv + (size_t)vkey * NIN + vch * 8;
    const int kl = wid * 1024 + lane * 16;
    const int vl = (vch >> 2) * 4096 + (vkey >> 3) * 512 + (vkey & 7) * 64 + (vch & 3) * 16;
    const float* kb2 = F.KB2 + ((size_t)b * NH + h) * SEQ;
    v4u kreg = *(const GAS v4u*)(kgp + (size_t)jt_hi * 64 * NIN), vreg = *(const GAS v4u*)(vgp + (size_t)jt_hi * 64 * NIN);
    float kbreg = 0.f; if (TYPE == 2 && tid < 64) kbreg = kb2[jt_hi * 64 + tid];
    *(LAS v4u*)(L + AT_K + kl) = kreg; *(LAS v4u*)(L + AT_V + vl) = vreg; if (TYPE == 2 && tid < 64) ((LAS float*)(L + AT_KB))[tid] = kbreg;
    __syncthreads();
    f32x16 o[2]; o[0] = f32x16{}; o[1] = f32x16{};
    float mrun = NEG_INF, lsum = 0.f, carry = 1.f;
    float qbound = 0.f;
    if (TYPE == 2) {
        float ss = 0.f;
#pragma unroll
        for (int d0 = 0; d0 < 4; ++d0)
#pragma unroll
            for (int j = 0; j < 8; ++j) { const float x = bf2f((bf16)qr[d0][j]); ss += x * x; }
        ss += __shfl_xor(ss, 32);
        float gm = fabsf(F.qk_g[((size_t)l * 6 + 5) * HD + lane]);
#pragma unroll
        for (int o = 1; o < 64; o <<= 1) gm = fmaxf(gm, __shfl_xor(gm, o));
        qbound = sqrtf(ss) * 8.08f * gm;
    }
    const int qrel = qoff + r32;
    const int vb = ((lane >> 4) & 1) * 32 + (lane & 3) * 8 + (4 * hi + ((lane & 15) >> 2)) * 64;
    LAS unsigned* deadf = (LAS unsigned*)(L + AT_DEAD);
    for (int i = 0; i < nt; ++i) {
        const int jt = jt_hi - i, cur = i & 1, jb = jt - 4 * qb256; const bool more = (i + 1 < nt);
        float kbnext = 0.f;
        if (more) { kreg = *(const GAS v4u*)(kgp + (size_t)(jt - 1) * 64 * NIN); vreg = *(const GAS v4u*)(vgp + (size_t)(jt - 1) * 64 * NIN); if (TYPE == 2 && tid < 64) kbreg = kb2[(jt - 1) * 64 + tid]; if (TYPE == 2) kbnext = kb2[jt * 64 - 1]; }
        const bool active = (64 * jb <= qoff + 31) && (TYPE != 1 || (64 * jb + 63 >= qoff - (WINDOW - 1)));
        if (active) {
            const LAS unsigned char* Kb = L + AT_K + cur * 8192; const LAS unsigned char* Vb = L + AT_V + cur * 8192;
            f32x16 p0 = f32x16{}, p1 = f32x16{};
            bf16x8 ka[4], kc[4];
#pragma unroll
            for (int d0 = 0; d0 < 4; ++d0) { ka[d0] = *(const LAS bf16x8*)(Kb + (2 * d0 + hi) * 1024 + r32 * 16); kc[d0] = *(const LAS bf16x8*)(Kb + (2 * d0 + hi) * 1024 + 512 + r32 * 16); }
            __builtin_amdgcn_sched_barrier(0);
#pragma unroll
            for (int d0 = 0; d0 < 4; ++d0) { p0 = __builtin_amdgcn_mfma_f32_32x32x16_bf16(ka[d0], qr[d0], p0, 0, 0, 0); p1 = __builtin_amdgcn_mfma_f32_32x32x16_bf16(kc[d0], qr[d0], p1, 0, 0, 0); }
            bf16x8 vfr[2][4];
#pragma unroll
            for (int d0 = 0; d0 < 2; ++d0)
#pragma unroll
                for (int ks = 0; ks < 4; ++ks) { const s16x4 lo = vtr(Vb + vb + d0 * 4096 + ks * 1024), hh = vtr(Vb + vb + d0 * 4096 + ks * 1024 + 512);
                    vfr[d0][ks] = (bf16x8){lo[0], lo[1], lo[2], lo[3], hh[0], hh[1], hh[2], hh[3]}; }
            __builtin_amdgcn_sched_barrier(0);
            bool live = true;
            const int kv0 = 64 * jb + 4 * hi;
            if (TYPE == 3) {
                float b0[16], b1[16];
#pragma unroll
                for (int r = 0; r < 16; ++r) { const int kv = kv0 + (r & 3) + 8 * (r >> 2);
                    const float e0 = fexp2(fminf(p0[r], 80.f)), e1 = fexp2(fminf(p1[r], 80.f));
                    const float m0 = frcp(1.0f + e0), m1 = frcp(1.0f + e1);
                    const bool ok0 = kv < qrel, ok1 = (kv + 32) < qrel;
                    b0[r] = ok0 ? e0 * m0 : 0.f; b1[r] = ok1 ? e1 * m1 : 0.f; p0[r] = ok0 ? m0 : 1.0f; p1[r] = ok1 ? m1 : 1.0f; }
                float gp[8], go[8], pp[8];
#pragma unroll
                for (int g = 0; g < 4; ++g) { gp[g] = (p0[4 * g] * p0[4 * g + 1]) * (p0[4 * g + 2] * p0[4 * g + 3]); gp[4 + g] = (p1[4 * g] * p1[4 * g + 1]) * (p1[4 * g + 2] * p1[4 * g + 3]); }
#pragma unroll
                for (int g = 0; g < 8; ++g) { const float oth = __shfl_xor(gp[g], 32); pp[g] = gp[g] * oth; go[g] = hi ? 1.0f : oth; }
                float sp = 1.0f;
#pragma unroll
                for (int g = 7; g >= 0; --g) { const float sg = sp * go[g] * carry;
                    if (g < 4) { const float c3 = p0[4 * g + 3], c2 = p0[4 * g + 2], c1 = p0[4 * g + 1];
                        p0[4 * g + 3] = b0[4 * g + 3] * sg; const float s2 = sg * c3; p0[4 * g + 2] = b0[4 * g + 2] * s2; const float s1 = s2 * c2; p0[4 * g + 1] = b0[4 * g + 1] * s1; p0[4 * g] = b0[4 * g] * (s1 * c1); }
                    else { const int q = g - 4; const float c3 = p1[4 * q + 3], c2 = p1[4 * q + 2], c1 = p1[4 * q + 1];
                        p1[4 * q + 3] = b1[4 * q + 3] * sg; const float s2 = sg * c3; p1[4 * q + 2] = b1[4 * q + 2] * s2; const float s1 = s2 * c2; p1[4 * q + 1] = b1[4 * q + 1] * s1; p1[4 * q] = b1[4 * q] * (s1 * c1); }
                    sp *= pp[g]; }
                carry *= sp;
            } else {
                if (TYPE == 2) {
                    const LAS f32x4* kbp = (const LAS f32x4*)(L + AT_KB + cur * 256);
#pragma unroll
                    for (int g = 0; g < 4; ++g) { const f32x4 a = kbp[2 * g + hi], c = kbp[8 + 2 * g + hi];
#pragma unroll
                        for (int e = 0; e < 4; ++e) { p0[4 * g + e] += a[e]; p1[4 * g + e] += c[e]; } }
                    if (jb >= 0) {
#pragma unroll
                        for (int r = 0; r < 16; ++r) { const int kv = kv0 + (r & 3) + 8 * (r >> 2); if (kv > qrel) p0[r] = NEG_INF; if (kv + 32 > qrel) p1[r] = NEG_INF; }
                    }
                } else {
#pragma unroll
                    for (int r = 0; r < 16; ++r) { const int d0_ = qrel - (kv0 + (r & 3) + 8 * (r >> 2)), d1_ = d0_ - 32;
                        const bool ok0 = (d0_ >= 0) && (d0_ < WINDOW), ok1 = (d1_ >= 0) && (d1_ < WINDOW);
                        const float t0 = BT[ok0 ? d0_ : 0], t1 = BT[ok1 ? d1_ : 0];
                        p0[r] = ok0 ? p0[r] + t0 : NEG_INF; p1[r] = ok1 ? p1[r] + t1 : NEG_INF; }
                }
                float rm = fmaxf(p0[0], p1[0]);
#pragma unroll
                for (int r = 1; r < 16; ++r) rm = fmaxf(rm, fmaxf(p0[r], p1[r]));
                { auto rr = __builtin_amdgcn_permlane32_swap(__float_as_uint(rm), __float_as_uint(rm), false, false); rm = fmaxf(__uint_as_float(rr[0]), __uint_as_float(rr[1])); }
                const float mn = fmaxf(mrun, rm);
                if (TYPE == 2) live = !__all(rm - mrun < -40.f);
                if (live) {
                if (__any(mn > mrun)) {
                    const float f = (mn > mrun) ? fexp2(mrun - mn) : 1.0f;
                    lsum *= f; mrun = mn;
                    if (hi == 0) wsf[r32] = f;
                    LDS_WAIT(); __builtin_amdgcn_wave_barrier();
#pragma unroll
                    for (int g = 0; g < 4; ++g) { const f32x4 fv = ((const LAS f32x4*)wsf)[2 * g + hi];
#pragma unroll
                        for (int e = 0; e < 4; ++e) { o[0][4 * g + e] *= fv[e]; o[1][4 * g + e] *= fv[e]; } }
                    LDS_WAIT(); __builtin_amdgcn_wave_barrier();
                }
                const float ms = (mrun == NEG_INF) ? 0.f : mrun;
                float ps = 0.f;
#pragma unroll
                for (int r = 0; r < 16; ++r) { p0[r] = fexp2(p0[r] - ms); p1[r] = fexp2(p1[r] - ms); ps += p0[r] + p1[r]; }
                lsum += ps;
                }
            }
            if (live) {
            bf16x8 pa[4];
#pragma unroll
            for (int ks = 0; ks < 4; ++ks) { v4u w;
                if (ks < 2) { w.x = cvtpk(p0[8 * ks], p0[8 * ks + 1]); w.y = cvtpk(p0[8 * ks + 2], p0[8 * ks + 3]); w.z = cvtpk(p0[8 * ks + 4], p0[8 * ks + 5]); w.w = cvtpk(p0[8 * ks + 6], p0[8 * ks + 7]); }
                else { const int k2 = ks - 2; w.x = cvtpk(p1[8 * k2], p1[8 * k2 + 1]); w.y = cvtpk(p1[8 * k2 + 2], p1[8 * k2 + 3]); w.z = cvtpk(p1[8 * k2 + 4], p1[8 * k2 + 5]); w.w = cvtpk(p1[8 * k2 + 6], p1[8 * k2 + 7]); }
                pa[ks] = __builtin_bit_cast(bf16x8, w); }
#pragma unroll
            for (int d0 = 0; d0 < 2; ++d0)
#pragma unroll
                for (int ks = 0; ks < 4; ++ks) o[d0] = __builtin_amdgcn_mfma_f32_32x32x16_bf16(pa[ks], vfr[d0][ks], o[d0], 0, 0, 0);
            }
        }
        if (TYPE == 2) {
            bool wdead = false;
            if (active && more) wdead = __all(qbound + kbnext - mrun < -40.f);
            if (lane == 0) deadf[cur * 8 + wid] = wdead ? 1u : 0u; }
        if (TYPE == 3) { const bool wdead = active && __all(carry < 2.3e-10f);
            if (lane == 0) deadf[cur * 8 + wid] = wdead ? 1u : 0u; }
        if (more) { *(LAS v4u*)(L + AT_K + (cur ^ 1) * 8192 + kl) = kreg; *(LAS v4u*)(L + AT_V + (cur ^ 1) * 8192 + vl) = vreg; if (TYPE == 2 && tid < 64) ((LAS float*)(L + AT_KB + (cur ^ 1) * 256))[tid] = kbreg; }
        __syncthreads();
        if (TYPE >= 2) { const v4u d0 = *(const LAS v4u*)(deadf + cur * 8), d1 = *(const LAS v4u*)(deadf + cur * 8 + 4);
            if ((d0.x & d0.y & d0.z & d0.w & d1.x & d1.y & d1.z & d1.w) != 0u) break; }
    }
    float inv[16];
    if (TYPE != 3) {
        { auto rr = __builtin_amdgcn_permlane32_swap(__float_as_uint(lsum), __float_as_uint(lsum), false, false); lsum = __uint_as_float(rr[0]) + __uint_as_float(rr[1]); }
        if (TYPE == 1) lsum += fexp2(F.sinks[l * NH + hq] * LOG2E - mrun);
        const float il = 1.0f / lsum;
        if (hi == 0) wsf[r32] = il;
        LDS_WAIT(); __builtin_amdgcn_wave_barrier();
#pragma unroll
        for (int g = 0; g < 4; ++g) { const f32x4 fv = ((const LAS f32x4*)wsf)[2 * g + hi]; inv[4 * g] = fv[0]; inv[4 * g + 1] = fv[1]; inv[4 * g + 2] = fv[2]; inv[4 * g + 3] = fv[3]; }
        LDS_WAIT(); __builtin_amdgcn_wave_barrier();
    } else {
#pragma unroll
        for (int r = 0; r < 16; ++r) inv[r] = 1.0f;
    }
    unsigned short gte[2][16];
    if (TYPE == 2) {
#pragma unroll
        for (int d0 = 0; d0 < 2; ++d0)
#pragma unroll
            for (int r = 0; r < 16; ++r) { const int q = (r & 3) + 8 * (r >> 2) + 4 * hi; const size_t mrow = rowb + q0 + qoff + q; gte[d0][r] = ((const GAS unsigned short*)F.P)[mrow * NIN + PC_G + hq * 64 + 32 * d0 + r32]; }
    }
#pragma unroll
    for (int d0 = 0; d0 < 2; ++d0)
#pragma unroll
        for (int r = 0; r < 16; ++r) { const int q = (r & 3) + 8 * (r >> 2) + 4 * hi; const size_t mrow = rowb + q0 + qoff + q; const int col = hq * 64 + 32 * d0 + r32;
            float val = o[d0][r] * inv[r];
            if (TYPE == 2) val *= frcp(1.0f + fexp2(-LOG2E * __builtin_bit_cast(float, (unsigned)gte[d0][r] << 16)));
            F.Y[mrow * DM + YOFF + col] = (bf16)f2bf(val); }
}

__device__ __forceinline__ void sparse_attn_query(const Frame& F, int m, LAS unsigned char* vch, const LAS float* TBA, const LAS int* idx) {
    int lane = F.lane; asm volatile("" : "+v"(lane));
    const int hh = lane & 15, kg = lane >> 4, t = m % SEQ, b = m / SEQ;
    const size_t rowb = (size_t)b * SEQ;
    const int nsel = (t + 1) < TOPK ? (t + 1) : TOPK, nch = (nsel + 63) >> 6;
    const bf16* qp = F.P + (size_t)m * NIN + PA_Q + (hh & 7) * 64 + 8 * kg;
    const bf16x8 qf0 = *(const GAS bf16x8*)qp, qf1 = *(const GAS bf16x8*)(qp + 32);
    float s[4][4][4];
#pragma unroll
    for (int cp = 0; cp < 2; ++cp) {
        if (2 * cp < nch) {
            bf16x8 kf[8][2];
#pragma unroll
            for (int bb = 0; bb < 8; ++bb) { const int keyA = idx[128 * cp + 16 * bb + hh];
                const bf16* kp = F.P + (rowb + keyA) * NIN + PA_K + 8 * kg;
                kf[bb][0] = *(const GAS bf16x8*)kp; kf[bb][1] = *(const GAS bf16x8*)(kp + 32); }
            __builtin_amdgcn_sched_barrier(0);
#pragma unroll
            for (int bb = 0; bb < 8; ++bb) { const int c = 2 * cp + (bb >> 2), blk = bb & 3, j0 = 64 * c + 16 * blk;
                f32x4 acc = {0.f, 0.f, 0.f, 0.f};
                acc = __builtin_amdgcn_mfma_f32_16x16x32_bf16(kf[bb][0], qf0, acc, 0, 0, 0); acc = __builtin_amdgcn_mfma_f32_16x16x32_bf16(kf[bb][1], qf1, acc, 0, 0, 0);
                const v4i id4 = *(const LAS v4i*)(idx + j0 + 4 * kg);
#pragma unroll
                for (int r = 0; r < 4; ++r) { const int j = j0 + 4 * kg + r; int dist = t - id4[r]; dist = dist < 0 ? 0 : (dist > 128 ? 128 : dist);
                    const float bias = TBA[dist * 8 + (hh & 7)];
                    s[c][blk][r] = (j < nsel) ? acc[r] + bias : NEG_INF; }
            }
        } else {
#pragma unroll
            for (int c = 2 * cp; c < 2 * cp + 2; ++c)
#pragma unroll
                for (int blk = 0; blk < 4; ++blk)
#pragma unroll
                    for (int r = 0; r < 4; ++r) s[c][blk][r] = NEG_INF;
        }
    }
    v4u xv[2][8];
#define SP_VLOAD(c_, X) do { const int keyV_ = idx[64 * (c_) + lane]; const bf16* vp_ = F.P + (rowb + keyV_) * NIN + PA_V; \
        _Pragma("unroll") for (int i_ = 0; i_ < 8; ++i_) X[i_] = *(const GAS v4u*)(vp_ + 8 * i_); } while (0)
    SP_VLOAD(0, xv[0]);
    if (1 < nch) SP_VLOAD(1, xv[1]);
    __builtin_amdgcn_sched_barrier(0);
    float mx = NEG_INF;
#pragma unroll
    for (int c = 0; c < 4; ++c)
#pragma unroll
        for (int blk = 0; blk < 4; ++blk)
#pragma unroll
            for (int r = 0; r < 4; ++r) mx = fmaxf(mx, s[c][blk][r]);
    mx = fmaxf(mx, __shfl_xor(mx, 16)); mx = fmaxf(mx, __shfl_xor(mx, 32));
    float sum = 0.f;
#pragma unroll
    for (int c = 0; c < 4; ++c)
#pragma unroll
        for (int blk = 0; blk < 4; ++blk)
#pragma unroll
            for (int r = 0; r < 4; ++r) { const float p = fexp2(s[c][blk][r] - mx); s[c][blk][r] = p; sum += p; }
    sum += __shfl_xor(sum, 16); sum += __shfl_xor(sum, 32);
    const float inv = 1.0f / sum;
    f32x4 oacc[4];
#pragma unroll
    for (int d = 0; d < 4; ++d) oacc[d] = (f32x4){0.f, 0.f, 0.f, 0.f};
    const int q4 = (lane & 15) >> 2, p4 = lane & 3;
#pragma unroll
    for (int c = 0; c < 4; ++c) {
        if (c < nch) {
#pragma unroll
            for (int i = 0; i < 8; ++i) *(LAS v4u*)(vch + (i >> 2) * 4096 + lane * 64 + (i & 3) * 16) = xv[c & 1][i];
            LDS_WAIT(); __builtin_amdgcn_wave_barrier();
            if (c + 2 < nch) SP_VLOAD(c + 2, xv[c & 1]);
            __builtin_amdgcn_sched_barrier(0);
#pragma unroll
            for (int kp = 0; kp < 2; ++kp) { v4u w; w.x = cvtpk(s[c][2 * kp][0], s[c][2 * kp][1]); w.y = cvtpk(s[c][2 * kp][2], s[c][2 * kp][3]); w.z = cvtpk(s[c][2 * kp + 1][0], s[c][2 * kp + 1][1]); w.w = cvtpk(s[c][2 * kp + 1][2], s[c][2 * kp + 1][3]);
                const bf16x8 pf = __builtin_bit_cast(bf16x8, w);
#pragma unroll
                for (int d = 0; d < 4; ++d) { const LAS unsigned char* a = vch + (d >> 1) * 4096 + (32 * kp + 4 * kg + q4) * 64 + ((d & 1) * 16 + 4 * p4) * 2;
                    const s16x4 lo = vtr(a), hv = vtr(a + 16 * 64);
                    const bf16x8 vf = {lo[0], lo[1], lo[2], lo[3], hv[0], hv[1], hv[2], hv[3]};
                    oacc[d] = __builtin_amdgcn_mfma_f32_16x16x32_bf16(vf, pf, oacc[d], 0, 0, 0); } }
            LDS_WAIT(); __builtin_amdgcn_wave_barrier();
        }
    }
#undef SP_VLOAD
    if (hh < 8) {
#pragma unroll
        for (int d = 0; d < 4; ++d) { v2u w; w.x = pk2(oacc[d][0] * inv, oacc[d][1] * inv); w.y = pk2(oacc[d][2] * inv, oacc[d][3] * inv);
            *(GAS v2u*)(F.Y + (size_t)m * DM + hh * 64 + 16 * d + 4 * kg) = w; }
    }
}

constexpr int CW_QUEUE = 8192;
constexpr int MIX_ITEMS = 2560;
template <unsigned EN> __device__ __forceinline__ void ph_attention(const Frame& F, int l, int qsel = 0) {
    LAS float* TBA = (LAS float*)(F.lds + AUX_OFF);
    for (int i = F.tid; i < 129 * 8; i += NTHREADS) { const int d = i >> 3, hq = i & 7; const int bk = d < 128 ? (int)kBucketLut[d] : 31; TBA[i] = F.rel_table[bk * 16 + hq] * LOG2E; }
    LAS unsigned* qslot = (LAS unsigned*)(F.lds + LDSCTL_OFF + 64);
    LAS unsigned char* wbuf = F.lds + RING_OFF + AT_SV + F.wave * 9472;
    LAS int* idxl = (LAS int*)(wbuf + 8192);
    __syncthreads();
#define MIX_FETCH(it) do { if (F.tid == 0) *qslot = __hip_atomic_fetch_add((unsigned*)(F.ctl + CW_QUEUE + 64 * l + 32 * qsel), 1u, __ATOMIC_RELAXED, __HIP_MEMORY_SCOPE_AGENT); \
        __syncthreads(); it = (int)*qslot; __syncthreads(); } while (0)
    for (int r = (int)blockIdx.x; r < 1024; r += F.G) {
        if (EN & 0x800) {
            const int b = r >> 9, blk = r & 511;
#pragma unroll 1
            for (int k = 0; k < 2; ++k) { const int u = 8 * blk + F.wave; const int t = k ? (SEQ - 1 - u) : u; const int m = b * SEQ + t;
                select_row(F, m, (LAS unsigned*)wbuf, idxl);
                LDS_WAIT(); __builtin_amdgcn_wave_barrier();
#ifdef PROBE_SEL2
                select_row(F, m, (LAS unsigned*)wbuf, idxl); LDS_WAIT(); __builtin_amdgcn_wave_barrier();
#endif
#ifdef PROBE_ATT2
                sparse_attn_query(F, m, wbuf, TBA, idxl); LDS_WAIT(); __builtin_amdgcn_wave_barrier();
#endif
                sparse_attn_query(F, m, wbuf, TBA, idxl);
                LDS_WAIT(); __builtin_amdgcn_wave_barrier(); }
        }
    }
    __syncthreads();
    int it; MIX_FETCH(it); it += 1024;
    while (it < 1536) { const int r = it & 511; if (EN & 0x100) dense_attn_unit<2>(F, l, (r & 15) >> 3, r & 7, 31 - (r >> 4)); MIX_FETCH(it); it += 1024; }
    while (it < 2048) { const int r = it & 511; if (EN & 0x200) dense_attn_unit<3>(F, l, (r & 15) >> 3, r & 7, 31 - (r >> 4)); MIX_FETCH(it); it += 1024; }
    while (it < MIX_ITEMS) { const int r = it & 511; if (EN & 0x400) dense_attn_unit<1>(F, l, r >> 8, 0, 255 - (r & 255)); MIX_FETCH(it); it += 1024; }
#undef MIX_FETCH
}


__device__ __forceinline__ const float* gp_(const float* p) {
#if defined(__HIP_DEVICE_COMPILE__)
    __builtin_assume(!__builtin_amdgcn_is_shared((const __attribute__((address_space(0))) void*)p)); __builtin_assume(!__builtin_amdgcn_is_private((const __attribute__((address_space(0))) void*)p));
#endif
    return p; }
#ifndef PROBE_KINDS
#define PROBE_KINDS 0u
#endif
#ifndef PROBE_ATT
#define PROBE_ATT 0xF00u
#endif
#ifndef PROBE_REPS
#define PROBE_REPS 1
#endif
#ifndef MK_ONE_LAUNCH
#define MK_ONE_LAUNCH 1
#endif
constexpr int PH_PER_LAYER = 14, N_PHASES = 1 + DEPTH * PH_PER_LAYER;
struct Args { const float* in[15]; float* out; unsigned char* ws; int ph_lo, ph_hi; };
struct ArgsG { const GAS float* in[15]; GAS float* out; GAS unsigned char* ws; int ph_lo, ph_hi; };
template <unsigned EN> __global__ void __launch_bounds__(NTHREADS, 2) trunk_fwd(Args args) {
    extern __shared__ __attribute__((aligned(16))) unsigned char lds[];
    LAS unsigned char* const ldsb = (LAS unsigned char*)lds;
    const int wave0 = __builtin_amdgcn_readfirstlane((int)threadIdx.x >> 6);
    for (int u = threadIdx.x; u < (LDS_BYTES - LDSCTL_OFF) / 4; u += NTHREADS) ((LAS unsigned*)(ldsb + LDSCTL_OFF))[u] = 0u;
    __syncthreads();
#if MK_ONE_LAUNCH
    constexpr int lo = 0, hi = N_PHASES;
#else
    const int lo = args.ph_lo, hi = args.ph_hi;
#endif
    XcdBarrier bar; bar.bar = (unsigned*)(args.ws + WS_CTL) + CW_BAR; bar.x = 0; bar.st = nullptr;
    if (hi - lo > 1) bar = xcd_barrier_post((unsigned*)(args.ws + WS_CTL) + CW_BAR, (volatile LAS unsigned*)(ldsb + LDSCTL_OFF));
#define GP(p) ((const float*)(p))
#define PH_BEGIN(k, kind) if (lo <= (k) && (k) < hi) { _Pragma("unroll 1") for (int rep_ = 0; rep_ < (((PROBE_KINDS >> (kind)) & 1u) ? PROBE_REPS : 1); ++rep_) { Frame F; { \
        const ArgsG* ka = (const ArgsG*)__builtin_amdgcn_kernarg_segment_ptr(); asm volatile("" : "+s"(ka)); \
        unsigned o_ = ~0u; asm volatile("" : "+s"(o_)); int t_ = wave0 * 64 + (int)__builtin_amdgcn_mbcnt_hi(o_, __builtin_amdgcn_mbcnt_lo(o_, 0u)); asm volatile("" : "+v"(t_)); \
        F.lds = ldsb; F.tid = t_; F.lane = t_ & 63; F.wave = wave0; int gw_ = blockIdx.x * NWAVES + wave0; asm volatile("" : "+s"(gw_)); F.G = gridDim.x; F.gw = gw_; F.NGW = F.G * NWAVES; \
        unsigned char* ws = (unsigned char*)ka->ws; F.ctl = (gu32*)(ws + WS_CTL);     \
        F.x = GP(ka->in[0]); F.c = GP(ka->in[1]); F.w_ada = GP(ka->in[2]); F.b_ada = GP(ka->in[3]); F.norm_g = GP(ka->in[4]); F.w_in = GP(ka->in[5]); F.qk_g = GP(ka->in[6]); F.forget_b = GP(ka->in[7]); \
        F.sinks = GP(ka->in[8]); F.rel_table = GP(ka->in[9]); F.group_g = GP(ka->in[10]); F.w_out = GP(ka->in[11]); F.w_gate = GP(ka->in[12]); F.w_up = GP(ka->in[13]); F.w_down = GP(ka->in[14]); F.out = (float*)ka->out; \
        F.MOD = (float*)(ws + WS_MOD); F.LF = (float*)(ws + WS_LF); F.KB2 = (float*)(ws + WS_KB2); F.SC = (unsigned short*)(ws + WS_SC); F.IDX = (int*)(ws + WS_IDX); \
        F.WGU = (bf16*)(ws + WS_WGU); F.WD = (bf16*)(ws + WS_WD); F.WIN = (bf16*)(ws + WS_WIN); F.WOUT = (bf16*)(ws + WS_WOUT); \
        F.H = (bf16*)(ws + WS_H); F.P = (bf16*)(ws + WS_P); F.Y = (bf16*)(ws + WS_Y); F.XB = (bf16*)(ws + WS_XB); }
#define PH_END(k) if ((k) + 1 < hi) xcd_barrier(bar); } }

    PH_BEGIN(0, 31) if (EN & 1) p0_prologue(F); PH_END(0)

    for (int l = 0; l < DEPTH; ++l) {
        const int base = 1 + l * PH_PER_LAYER;
        for (int sub = 0; sub < 3; ++sub) {
            if (sub != 1) {
                const int f = sub >> 1, pb = base + (f ? 11 : 0), ni = f ? 2 : 0, lf = l * 2 + f;
                PH_BEGIN(pb, (f ? 11 : 0)) if (EN & 2) { const float* modl = F.MOD + (size_t)l * BATCH * NMOD;
                    if (l == 0 && f == 0) ph_modulate<FFN_FP8, false>(F, F.x, F.norm_g + ((size_t)l * 3 + ni) * DM, modl + (3 * ni + 0) * DM, modl + (3 * ni + 1) * DM);
                    else ph_modulate<FFN_FP8, true>(F, F.XB, F.norm_g + ((size_t)l * 3 + ni) * DM, modl + (3 * ni + 0) * DM, modl + (3 * ni + 1) * DM); } PH_END(pb)
                PH_BEGIN(pb + 1, (f ? 12 : 1)) if (EN & 4) {
                    pg8::StaticOrder S; S.init(M, NGU, F.G, (int)blockIdx.x);
                    if constexpr (FFN_FP8) { pg8::Gemm g{F.H, (const bf16*)((const unsigned char*)F.WGU + (size_t)lf * NGU * DM), M, NGU, DM, 127, W8_E8M0};
                        pg8::EpiSwiGLU8 E{(unsigned char*)F.P, DFFP};
                        pg8::gemm_phase<pg8::EpiSwiGLU8, pg8::StaticOrder, true, true, true>(F.lds + RING_OFF, g, S, E, F.tid); }
                    else { pg8::Gemm g{F.H, F.WGU + (size_t)lf * NGU * DM, M, NGU, DM};
                        pg8::EpiSwiGLU E{F.P, DFF};
                        pg8::gemm_phase<pg8::EpiSwiGLU, pg8::StaticOrder, true, true>(F.lds + RING_OFF, g, S, E, F.tid); } } PH_END(pb + 1)
                PH_BEGIN(pb + 2, (f ? 13 : 2)) if (EN & 8) {
                    pg8::Gemm g{F.P, FFN_FP8 ? (const bf16*)((const unsigned char*)F.WD + (size_t)lf * DM * DFFP) : F.WD + (size_t)lf * DM * DFF, M, DM, DFF, 127, FFN_FP8 ? W8_E8M0 : 127, FFN_FP8 ? DFFP : 0, FFN_FP8 ? DFFP : 0}; pg8::StaticOrder S; S.init(M, DM, F.G, (int)blockIdx.x);
                    const float* modl = F.MOD + (size_t)l * BATCH * NMOD;
                    if (l == DEPTH - 1 && f == 1) { pg8::EpiResid<false> E{F.XB, rep_ ? (void*)F.SC : (void*)F.out, DM, modl + (3 * ni + 2) * DM, NMOD, SEQ, 0.5f};
                        pg8::gemm_phase<pg8::EpiResid<false>, pg8::StaticOrder, true, true, FFN_FP8>(F.lds + RING_OFF, g, S, E, F.tid); }
                    else { pg8::EpiResid<true> E{F.XB, rep_ ? (void*)F.SC : (void*)F.XB, DM, modl + (3 * ni + 2) * DM, NMOD, SEQ, 0.5f};
                        pg8::gemm_phase<pg8::EpiResid<true>, pg8::StaticOrder, true, true, FFN_FP8>(F.lds + RING_OFF, g, S, E, F.tid); } } PH_END(pb + 2)
            } else {
                PH_BEGIN(base + 3, 3) if (EN & 2) { const float* modl = F.MOD + (size_t)l * BATCH * NMOD; ph_modulate<false, true>(F, F.XB, F.norm_g + ((size_t)l * 3 + 1) * DM, modl + 3 * DM, modl + 4 * DM); } PH_END(base + 3)
                PH_BEGIN(base + 4, 4) if (EN & 16) {
                    pg8::Gemm g{F.H, F.WIN + (size_t)l * NIN * DM, M, NIN, DM}; pg8::StaticOrder S; S.init(M, NIN, F.G, (int)blockIdx.x);
                    pg8::EpiBf16 E{F.P, NIN};
                    pg8::gemm_phase<pg8::EpiBf16, pg8::StaticOrder, true, true>(F.lds + RING_OFF, g, S, E, F.tid); } PH_END(base + 4)
                PH_BEGIN(base + 6, 6) if (EN & 64) { ph_scan(F, l);
                    int par_ = (int)((blockIdx.x & 1u) ^ 1u); asm volatile("" : "+s"(par_));
                    _Pragma("unroll 1") for (int st_ = 0; st_ < 2; ++st_) { if ((st_ ^ par_) == 0) { if (EN & 32) ph_post(F, l); } else ph_idx_scores(F); } } PH_END(base + 6)
                PH_BEGIN(base + 8, 8) if (EN & 0xF00) { if (rep_ == 0) ph_attention<EN>(F, l, 0); else ph_attention<(PROBE_ATT)>(F, l, 1); } PH_END(base + 8)
                PH_BEGIN(base + 9, 9) if (EN & 0x1000) ph_gnorm(F, l); PH_END(base + 9)
                PH_BEGIN(base + 10, 10) if (EN & 0x2000) {
                    pg8::Gemm g{F.Y, F.WOUT + (size_t)l * DM * DM, M, DM, DM}; pg8::StaticOrder S; S.init(M, DM, F.G, (int)blockIdx.x);
                    const float* modl = F.MOD + (size_t)l * BATCH * NMOD;
                    pg8::EpiResid<true> E{F.XB, rep_ ? (void*)F.SC : (void*)F.XB, DM, modl + 5 * DM, NMOD, SEQ, 1.0f};
                    pg8::gemm_phase<pg8::EpiResid<true>, pg8::StaticOrder, true, true>(F.lds + RING_OFF, g, S, E, F.tid); } PH_END(base + 10)
            }
        }
    }
#undef PH_BEGIN
#undef PH_END
}

#ifndef EN_MASK
#define EN_MASK 0xFFFFu
#endif
template <unsigned EN> static int setup_kernel() {
    if (hipFuncSetAttribute((const void*)trunk_fwd<EN>, hipFuncAttributeMaxDynamicSharedMemorySize, LDS_BYTES) != hipSuccess) { fprintf(stderr, "kernel_launch: hipFuncSetAttribute failed\n"); return -1; }
    int per_cu = 0;
    if (hipOccupancyMaxActiveBlocksPerMultiprocessor(&per_cu, (const void*)trunk_fwd<EN>, NTHREADS, LDS_BYTES) != hipSuccess || per_cu < 1) { fprintf(stderr, "kernel_launch: occupancy query says %d\n", per_cu); }
    (void)hipGetLastError();
    return 0;
}
template <unsigned EN> static void launch_range(const Args& a0, int lo, int hi, int grid, hipStream_t stream) {
    Args a = a0; a.ph_lo = lo; a.ph_hi = hi;
    hipLaunchKernelGGL(trunk_fwd<EN>, dim3(grid), dim3(NTHREADS), LDS_BYTES, stream, a);
}
extern "C" void kernel_launch(void* const* d_in, const int* in_sizes, int n_in, void* d_out, int out_size, void* d_ws, size_t ws_size, hipStream_t stream) {
    static int grid = 0;
    if (grid == 0) {
        if (n_in != 15 || in_sizes[0] != M * DM || out_size != M * DM || ws_size < WS_END) {
            fprintf(stderr, "kernel_launch: shape/workspace mismatch: n_in %d in0 %d out %d ws %zu (need %zu); nothing launched\n", n_in, n_in > 0 ? in_sizes[0] : -1, out_size, ws_size, (size_t)WS_END); grid = -1; return; }
        int dev = 0, cus = 0;
        if (hipGetDevice(&dev) != hipSuccess || hipDeviceGetAttribute(&cus, hipDeviceAttributeMultiprocessorCount, dev) != hipSuccess) { grid = -1; return; }
#if MK_ONE_LAUNCH
        if (setup_kernel<EN_MASK>()) { grid = -1; return; }
#else
        if (setup_kernel<0x1u>() || setup_kernel<0x2u>() || setup_kernel<0x4u>() || setup_kernel<0x8u>() || setup_kernel<0x10u>() || setup_kernel<0x20u>() || setup_kernel<0x40u>() || setup_kernel<0x80u>() ||
            setup_kernel<0x100u>() || setup_kernel<0x200u>() || setup_kernel<0x400u>() || setup_kernel<0x800u>() || setup_kernel<0x1000u>() || setup_kernel<0x2000u>()) { grid = -1; return; }
#endif
        grid = cus;
    }
    if (grid < 0) return;
    if (hipMemsetAsync((char*)d_ws + WS_CTL, 0, CTL_ZERO_BYTES, stream) != hipSuccess) return;
    Args a{};
    for (int i = 0; i < 15; ++i) a.in[i] = (const float*)d_in[i];
    a.out = (float*)d_out; a.ws = (unsigned char*)d_ws;
#if MK_ONE_LAUNCH
    launch_range<EN_MASK>(a, 0, N_PHASES, grid, stream);
#else
    launch_range<0x1u>(a, 0, 1, grid, stream);
    for (int l = 0; l < DEPTH; ++l) { const int base = 1 + l * PH_PER_LAYER;
        for (int f = 0; f < 2; ++f) { const int pb = base + (f ? 11 : 0);
            if (f == 1) {
                launch_range<0x2u>(a, base + 3, base + 4, grid, stream); launch_range<0x10u>(a, base + 4, base + 5, grid, stream); launch_range<0x20u>(a, base + 5, base + 6, grid, stream);
                launch_range<0x40u>(a, base + 6, base + 7, grid, stream); launch_range<0x80u>(a, base + 7, base + 8, grid, stream);
                launch_range<0x100u>(a, base + 8, base + 9, grid, stream); launch_range<0x200u>(a, base + 8, base + 9, grid, stream); launch_range<0x400u>(a, base + 8, base + 9, grid, stream); launch_range<0x800u>(a, base + 8, base + 9, grid, stream);
                launch_range<0x1000u>(a, base + 9, base + 10, grid, stream); launch_range<0x2000u>(a, base + 10, base + 11, grid, stream);
            }
            launch_range<0x2u>(a, pb, pb + 1, grid, stream); launch_range<0x4u>(a, pb + 1, pb + 2, grid, stream); launch_range<0x8u>(a, pb + 2, pb + 3, grid, stream);
        }
    }
#endif
}
```

```cpp
#include <hip/hip_runtime.h>
#include <cstdio>
#include <cstdint>

namespace pg8 {
#define PG8_LAS __attribute__((address_space(3)))
typedef unsigned short bf16_t;
typedef short bf16x8 __attribute__((ext_vector_type(8)));
typedef float f32x4 __attribute__((ext_vector_type(4)));
typedef unsigned u32x4 __attribute__((ext_vector_type(4)));
constexpr int BM = 256, BK = 64, HALF = 128, HTB = HALF * BK * 2  , STAGE_BYTES = 8 * HTB, NXCD = 8, WGM = 8;

__host__ __device__ __forceinline__ int lds_byte(int r, int c) { const int st = (r >> 4) * 2 + (c >> 5), rr = r & 15, cc = c & 31, ob = rr * 64 + cc * 2; return st * 1024 + (ob ^ (((ob >> 9) & 1) << 5)); }
__host__ __device__ __forceinline__ void stage_rc(int b, int& R, int& C) { const int st = b / 1024, sb = b % 1024, swz = sb ^ (((sb >> 9) & 1) << 5); R = (st >> 1) * 16 + swz / 64; C = (st & 1) * 32 + (swz % 64) / 2; }
__host__ __device__ __forceinline__ int perm32(int rho) { const int n = rho >> 4, i = rho & 15; return 8 * (i >> 2) + 4 * n + (i & 3); }

struct Unit { int pm, pn; };
struct Gemm { const bf16_t* A; const bf16_t* Bt; int M, N, K; int scaleA = 127, scaleB = 127; int lda = 0, ldb = 0; int blk = 0; };
typedef int i32x8 __attribute__((ext_vector_type(8))); typedef int i32x4v __attribute__((ext_vector_type(4)));
__device__ __forceinline__ i32x8 pg8_cat(bf16x8 lo, bf16x8 hi) { return __builtin_shufflevector(__builtin_bit_cast(i32x4v, lo), __builtin_bit_cast(i32x4v, hi), 0, 1, 2, 3, 4, 5, 6, 7); }

struct StaticOrder {
    int nM, nN, nwg, G, c;
    __host__ __device__ void init(int M, int N, int G_, int c_) { nM = M / BM; nN = N / BM; nwg = nM * nN; G = G_; c = c_; }
    __host__ __device__ bool next(int i, Unit& u) const {
        const long L = (long)i * G + c; if (L >= nwg) return false;
        int wgid = (int)L; { const int q = nwg / NXCD, r = nwg % NXCD, xcd = wgid % NXCD, off = wgid / NXCD; wgid = (xcd < r ? xcd * (q + 1) : r * (q + 1) + (xcd - r) * q) + off; }
        const int nig = WGM * nN, gid = wgid / nig, fm = gid * WGM, gsz = (nM - fm) < WGM ? (nM - fm) : WGM;
        u.pm = fm + ((wgid % nig) % gsz); u.pn = (wgid % nig) / gsz; return true;
    }
    __device__ __forceinline__ void a_ready(const Unit&) const {}
    __device__ __forceinline__ void done(const Unit&) const {}
};
typedef __bf16 pg8_bfpair __attribute__((ext_vector_type(2))); typedef float pg8_f32pair __attribute__((ext_vector_type(2)));
__device__ __forceinline__ unsigned cvt_pk_bf16(float lo, float hi) { const pg8_f32pair v = {lo, hi}; return __builtin_bit_cast(unsigned, __builtin_convertvector(v, pg8_bfpair)); }
__device__ __forceinline__ unsigned cvt_pk_bf16_nv(float lo, float hi) { return cvt_pk_bf16(lo, hi); }
__device__ __forceinline__ const char* uptr(const char* p) { const unsigned long long v = (unsigned long long)p; const unsigned lo = __builtin_amdgcn_readfirstlane((unsigned)v), hi = __builtin_amdgcn_readfirstlane((unsigned)(v >> 32)); return (const char*)(((unsigned long long)hi << 32) | lo); }
struct EpiBf16 {
    static constexpr bool PERM = true, AFTER_DRAIN = false;
    bf16_t* O; int ldc;
    __device__ __forceinline__ void operator()(const f32x4 (&acc)[2][2][4][2], const Unit& u, int wr, int wc, int fr, int fq) const {
        asm volatile("" : "+v"(fr), "+v"(fq));
        const int row0 = u.pm * BM + wr * 64 + fr; const int col0 = u.pn * BM + wc * 32 + 8 * fq;
#pragma unroll
        for (int ai = 0; ai < 2; ++ai)
#pragma unroll
            for (int m = 0; m < 4; ++m) { bf16_t* rowp = O + (size_t)(row0 + ai * HALF + m * 16) * ldc + col0;
#pragma unroll
                for (int bj = 0; bj < 2; ++bj) { const f32x4 v0 = acc[ai][bj][m][0], v1 = acc[ai][bj][m][1];
                    u32x4 w; w.x = cvt_pk_bf16(v0[0], v0[1]); w.y = cvt_pk_bf16(v0[2], v0[3]); w.z = cvt_pk_bf16(v1[0], v1[1]); w.w = cvt_pk_bf16(v1[2], v1[3]);
                    *(u32x4*)(rowp + bj * HALF) = w; } }
    }
};
__device__ __forceinline__ float silu_mul(float g, float u) { return g * u * __builtin_amdgcn_rcpf(1.0f + __builtin_amdgcn_exp2f(-1.4426950408889634f * g)); }
struct EpiSwiGLU {
    static constexpr bool PERM = true, AFTER_DRAIN = false;
    bf16_t* O; int ldc;
    __device__ __forceinline__ void operator()(const f32x4 (&acc)[2][2][4][2], const Unit& u, int wr, int wc, int fr, int fq) const {
        asm volatile("" : "+v"(fr), "+v"(fq));
        const int row0 = u.pm * BM + wr * 64 + fr; const int col0 = u.pn * HALF + wc * 32 + 8 * fq;
#pragma unroll
        for (int ai = 0; ai < 2; ++ai)
#pragma unroll
            for (int m = 0; m < 4; ++m) { bf16_t* rowp = O + (size_t)(row0 + ai * HALF + m * 16) * ldc + col0;
                const f32x4 g0 = acc[ai][0][m][0], g1 = acc[ai][0][m][1], u0 = acc[ai][1][m][0], u1 = acc[ai][1][m][1];
                u32x4 w; w.x = cvt_pk_bf16(silu_mul(g0[0], u0[0]), silu_mul(g0[1], u0[1])); w.y = cvt_pk_bf16(silu_mul(g0[2], u0[2]), silu_mul(g0[3], u0[3]));
                w.z = cvt_pk_bf16(silu_mul(g1[0], u1[0]), silu_mul(g1[1], u1[1])); w.w = cvt_pk_bf16(silu_mul(g1[2], u1[2]), silu_mul(g1[3], u1[3]));
                *(u32x4*)rowp = w; }
    }
};
template <bool OUT16> struct EpiResid {
    static constexpr bool PERM = false, AFTER_DRAIN = false;
    const bf16_t* base; void* out; int ldc; const float* gv; int gstride; int rows_per_batch; float coef;
    __device__ __forceinline__ void operator()(const f32x4 (&acc)[2][2][4][2], const Unit& u, int wr, int wc, int fr, int fq) const {
        typedef unsigned v2u_ __attribute__((ext_vector_type(2)));
        asm volatile("" : "+v"(fr), "+v"(fq));
        const int row0 = u.pm * BM + wr * 64 + fr; const int col0 = u.pn * BM + wc * 32 + 4 * fq;
        const float* gvec = gv + (size_t)((u.pm * BM) / rows_per_batch) * gstride + col0;
        f32x4 gg[2][2];
#pragma unroll
        for (int bj = 0; bj < 2; ++bj)
#pragma unroll
            for (int n = 0; n < 2; ++n) gg[bj][n] = *(const f32x4*)(gvec + bj * HALF + n * 16) * coef;
#pragma unroll
        for (int ai = 0; ai < 2; ++ai) {
            v2u_ bwv[4][2][2];
#pragma unroll
            for (int m = 0; m < 4; ++m) { const size_t off = (size_t)(row0 + ai * HALF + m * 16) * ldc + col0;
#pragma unroll
                for (int bj = 0; bj < 2; ++bj)
#pragma unroll
                    for (int n = 0; n < 2; ++n) bwv[m][bj][n] = *(const v2u_*)(base + off + bj * HALF + n * 16); }
#pragma unroll
            for (int m = 0; m < 4; ++m) { const size_t off = (size_t)(row0 + ai * HALF + m * 16) * ldc + col0;
#pragma unroll
                for (int bj = 0; bj < 2; ++bj)
#pragma unroll
                    for (int n = 0; n < 2; ++n) { const v2u_ bw = bwv[m][bj][n];
                        f32x4 bs; bs[0] = __builtin_bit_cast(float, bw.x << 16); bs[1] = __builtin_bit_cast(float, bw.x & 0xffff0000u); bs[2] = __builtin_bit_cast(float, bw.y << 16); bs[3] = __builtin_bit_cast(float, bw.y & 0xffff0000u);
                        const f32x4 r = bs + gg[bj][n] * acc[ai][bj][m][n];
                        if constexpr (OUT16) { v2u_ w; w.x = cvt_pk_bf16_nv(r[0], r[1]); w.y = cvt_pk_bf16_nv(r[2], r[3]); *(v2u_*)((bf16_t*)out + off + bj * HALF + n * 16) = w; }
                        else *(f32x4*)((float*)out + off + bj * HALF + n * 16) = r; } }
        }
    }
};
__device__ __forceinline__ unsigned pack_fp8x4(float a, float b, float c, float d) {
    a = fminf(fmaxf(a, -448.f), 448.f); b = fminf(fmaxf(b, -448.f), 448.f); c = fminf(fmaxf(c, -448.f), 448.f); d = fminf(fmaxf(d, -448.f), 448.f);
    int w = 0; w = __builtin_amdgcn_cvt_pk_fp8_f32(a, b, w, false); w = __builtin_amdgcn_cvt_pk_fp8_f32(c, d, w, true); return (unsigned)w; }
struct EpiSwiGLU8 {
    static constexpr bool PERM = true, AFTER_DRAIN = false;
    unsigned char* O; int ldc;
    __device__ __forceinline__ void operator()(const f32x4 (&acc)[2][2][4][2], const Unit& u, int wr, int wc, int fr, int fq) const {
        asm volatile("" : "+v"(fr), "+v"(fq));
        const int row0 = u.pm * BM + wr * 64 + fr; const int col0 = u.pn * HALF + wc * 32 + 8 * fq;
#pragma unroll
        for (int ai = 0; ai < 2; ++ai)
#pragma unroll
            for (int m = 0; m < 4; ++m) { unsigned char* rowp = O + (size_t)(row0 + ai * HALF + m * 16) * ldc + col0;
                const f32x4 g0 = acc[ai][0][m][0], g1 = acc[ai][0][m][1], u0 = acc[ai][1][m][0], u1 = acc[ai][1][m][1];
                typedef unsigned u32x2v __attribute__((ext_vector_type(2))); u32x2v w;
                w.x = pack_fp8x4(silu_mul(g0[0], u0[0]), silu_mul(g0[1], u0[1]), silu_mul(g0[2], u0[2]), silu_mul(g0[3], u0[3]));
                w.y = pack_fp8x4(silu_mul(g1[0], u1[0]), silu_mul(g1[1], u1[1]), silu_mul(g1[2], u1[2]), silu_mul(g1[3], u1[3]));
                *(u32x2v*)rowp = w; }
    }
};
template <class Epi, class Sched, bool ALIGN_EPI = false, bool SP2 = false, bool FP8 = false>
__device__ __forceinline__ void gemm_phase(PG8_LAS unsigned char* lds, const Gemm g, const Sched& S, const Epi& E, int tid_in) {
    int tid_ = tid_in; asm volatile("" : "+v"(tid_));
    const int tid = tid_, wid = __builtin_amdgcn_readfirstlane(tid >> 6), lane = tid & 63, wr = wid >> 2, wc = wid & 3, fr = lane & 15, fq = lane >> 4;
    const int K = g.K, nt = FP8 ? K / (2 * BK) : K / BK;
    const int pitchA = g.blk ? 2 * BK : g.lda ? g.lda : (FP8 ? K : 2 * K), pitchB = g.blk ? 2 * BK : g.ldb ? g.ldb : (FP8 ? K : 2 * K);
    unsigned voffA[2], voffB[2];
#pragma unroll
    for (int i = 0; i < 2; ++i) { int R, C; stage_rc(tid * 16 + i * 8192, R, C); const int Rb = Epi::PERM ? ((R & ~31) + perm32(R & 31)) : R;
        voffA[i] = (unsigned)(R * pitchA + C * 2); voffB[i] = (unsigned)(Rb * pitchB + C * 2); }
    const size_t kstep = g.blk ? (size_t)(512 * BK) : (size_t)(BK * 2);
    const size_t hstepA = (size_t)HALF * pitchA, hstepB = (size_t)HALF * pitchB;
    const size_t tstepA = g.blk ? (size_t)(FP8 ? K / (2 * BK) : K / BK) * kstep : 2 * hstepA, tstepB = g.blk ? tstepA : 2 * hstepB;
    const unsigned ldsw = (unsigned)wid * 1024u;
    const int aoff = lds_byte(wr * 64 + fr, fq * 8), boff = lds_byte(wc * 32 + fr, fq * 8);
    PG8_LAS unsigned char* abase = lds + aoff; PG8_LAS unsigned char* bbase = lds + boff + 4 * HTB;
#define PG8_SA(b, h) (((b) * 2 + (h)) * HTB)
#define PG8_SB(b, h) ((4 + (b) * 2 + (h)) * HTB)
#define PG8_STAGE(bufoff, gbase, voff) do { _Pragma("unroll") for (int _i = 0; _i < 2; ++_i) \
        __builtin_amdgcn_global_load_lds((const unsigned*)((const char*)(gbase) + (voff)[_i]), (PG8_LAS unsigned*)(lds + (bufoff) + ldsw + _i * 8192), 16, 0, 0); } while (0)
#define PG8_RDA(off) (*(const PG8_LAS bf16x8*)(abase + (off)))
#define PG8_RDB(off) (*(const PG8_LAS bf16x8*)(bbase + ((off) - 4 * HTB)))
#define PG8_LDA(dst, b, h) do { if constexpr (FP8) { _Pragma("unroll") for (int m = 0; m < 4; ++m) dst##8[m] = pg8_cat(PG8_RDA(PG8_SA(b, h) + m * 2048), PG8_RDA(PG8_SA(b, h) + m * 2048 + 1024)); } \
    else { _Pragma("unroll") for (int m = 0; m < 4; ++m) _Pragma("unroll") for (int k = 0; k < 2; ++k) dst[m][k] = PG8_RDA(PG8_SA(b, h) + m * 2048 + k * 1024); } } while (0)
#define PG8_LDB(dst, b, h) do { if constexpr (FP8) { _Pragma("unroll") for (int n = 0; n < 2; ++n) dst##8[n] = pg8_cat(PG8_RDB(PG8_SB(b, h) + n * 2048), PG8_RDB(PG8_SB(b, h) + n * 2048 + 1024)); } \
    else { _Pragma("unroll") for (int n = 0; n < 2; ++n) _Pragma("unroll") for (int k = 0; k < 2; ++k) dst[n][k] = PG8_RDB(PG8_SB(b, h) + n * 2048 + k * 1024); } } while (0)
#define PG8_MMA(ai, bj, At, Bt) do { __builtin_amdgcn_s_setprio(1); if constexpr (FP8) { \
        _Pragma("unroll") for (int m = 0; m < 4; ++m) _Pragma("unroll") for (int n = 0; n < 2; ++n) \
            asm volatile("v_mfma_scale_f32_16x16x128_f8f6f4 %0, %1, %2, %0, %3, %4 op_sel_hi:[0,0,0]" : "+v"(acc[ai][bj][m][n]) : "v"(Bt##8[n]), "v"(At##8[m]), "v"(sclB), "v"(sclA)); \
        } else { _Pragma("unroll") for (int m = 0; m < 4; ++m) _Pragma("unroll") for (int n = 0; n < 2; ++n) _Pragma("unroll") for (int k = 0; k < 2; ++k) \
        acc[ai][bj][m][n] = __builtin_amdgcn_mfma_f32_16x16x32_bf16(Bt[n][k], At[m][k], acc[ai][bj][m][n], 0, 0, 0); } __builtin_amdgcn_s_setprio(0); } while (0)
#define PG8_WAIT_V(n) asm volatile("s_waitcnt vmcnt(" #n ")" ::: "memory")
#define PG8_WAIT_L(n) asm volatile("s_waitcnt lgkmcnt(" #n ")" ::: "memory")
#define PG8_BAR __builtin_amdgcn_s_barrier()
#define PG8_SCHED __builtin_amdgcn_sched_barrier(0)
    Unit cur, nxt; int ui = 0;
    if (!S.next(0, cur)) return;
    f32x4 acc[2][2][4][2];
#pragma unroll
    for (int a = 0; a < 2; ++a)
#pragma unroll
        for (int b = 0; b < 2; ++b)
#pragma unroll
            for (int m = 0; m < 4; ++m)
#pragma unroll
                for (int n = 0; n < 2; ++n) acc[a][b][m][n] = (f32x4){0.f, 0.f, 0.f, 0.f};
    const int sclA = g.scaleA, sclB = g.scaleB;
    bf16x8 At[4][2], B0[2][2], B1[2][2]; i32x8 At8[4], B08[2], B18[2];
    const char* cA = uptr((const char*)g.A + (size_t)cur.pm * tstepA); const char* cB = uptr((const char*)g.Bt + (size_t)cur.pn * tstepB);
    S.a_ready(cur);
    if constexpr (SP2) {
        PG8_STAGE(PG8_SB(0, 0), cB, voffB); PG8_STAGE(PG8_SB(0, 1), cB + hstepB, voffB); PG8_STAGE(PG8_SA(0, 0), cA, voffA); PG8_STAGE(PG8_SA(0, 1), cA + hstepA, voffA);
        if (wr == 1) PG8_BAR;
        PG8_WAIT_V(2); PG8_BAR;
        PG8_STAGE(PG8_SB(1, 0), cB + kstep, voffB); PG8_STAGE(PG8_SA(1, 0), cA + kstep, voffA); PG8_STAGE(PG8_SB(1, 1), cB + hstepB + kstep, voffB);
        PG8_WAIT_V(6); PG8_BAR;
    } else {
        PG8_STAGE(PG8_SB(0, 0), cB, voffB); PG8_STAGE(PG8_SA(0, 0), cA, voffA); PG8_STAGE(PG8_SB(0, 1), cB + hstepB, voffB); PG8_STAGE(PG8_SA(0, 1), cA + hstepA, voffA);
        if (wr == 1) PG8_BAR;
        PG8_WAIT_V(4); PG8_BAR;
        PG8_STAGE(PG8_SB(1, 0), cB + kstep, voffB); PG8_STAGE(PG8_SA(1, 0), cA + kstep, voffA); PG8_STAGE(PG8_SB(1, 1), cB + hstepB + kstep, voffB);
        PG8_WAIT_V(6); PG8_BAR;
    }
    for (;;) {
        const bool has_next = S.next(ui + 1, nxt);
        const char* nA = uptr(has_next ? (const char*)g.A + (size_t)nxt.pm * tstepA : cA); const char* nB = uptr(has_next ? (const char*)g.Bt + (size_t)nxt.pn * tstepB : cB);
        for (int t = 0; t < nt; t += 2) {
            asm volatile("" : "+v"(abase), "+v"(bbase));
            const bool last = (t == nt - 2);
            const char* a1 = cA + (size_t)(t + 1) * kstep;
            const char* a2 = uptr(last ? nA : cA + (size_t)(t + 2) * kstep); const char* b2 = uptr(last ? nB : cB + (size_t)(t + 2) * kstep);
            const char* a3 = a2 + kstep; const char* b3 = b2 + kstep;
            if (last && has_next) S.a_ready(nxt);
            if constexpr (SP2) {
            PG8_LDB(B0, 0, 0); PG8_LDB(B1, 0, 1); PG8_SCHED; PG8_LDA(At, 0, 0); PG8_STAGE(PG8_SA(1, 1), a1 + hstepA, voffA);
            PG8_WAIT_V(8); PG8_WAIT_L(0); PG8_BAR; PG8_MMA(0, 0, At, B0); PG8_MMA(0, 1, At, B1); PG8_BAR; PG8_SCHED;
            PG8_LDA(At, 0, 1); PG8_STAGE(PG8_SB(0, 0), b2, voffB); PG8_STAGE(PG8_SB(0, 1), b2 + hstepB, voffB); PG8_STAGE(PG8_SA(0, 0), a2, voffA);
            PG8_WAIT_V(8); PG8_WAIT_L(0); PG8_BAR; PG8_MMA(1, 0, At, B0); PG8_MMA(1, 1, At, B1); PG8_BAR; PG8_SCHED;
            PG8_LDB(B0, 1, 0); PG8_LDB(B1, 1, 1); PG8_SCHED; PG8_LDA(At, 1, 0); PG8_STAGE(PG8_SA(0, 1), a2 + hstepA, voffA);
            PG8_WAIT_V(8); PG8_WAIT_L(0); PG8_BAR; PG8_MMA(0, 0, At, B0); PG8_MMA(0, 1, At, B1); PG8_BAR; PG8_SCHED;
            PG8_LDA(At, 1, 1); PG8_STAGE(PG8_SB(1, 0), b3, voffB); PG8_STAGE(PG8_SB(1, 1), b3 + hstepB, voffB); PG8_STAGE(PG8_SA(1, 0), a3, voffA);
            PG8_WAIT_V(8); PG8_WAIT_L(0); PG8_BAR; PG8_MMA(1, 0, At, B0); PG8_MMA(1, 1, At, B1); PG8_BAR; PG8_SCHED;
            } else {
            PG8_LDB(B0, 0, 0); PG8_SCHED; PG8_LDA(At, 0, 0); PG8_STAGE(PG8_SA(1, 1), a1 + hstepA, voffA);
            PG8_WAIT_L(8); PG8_BAR; PG8_WAIT_L(0); PG8_MMA(0, 0, At, B0); PG8_BAR; PG8_SCHED;
            PG8_LDB(B1, 0, 1); PG8_STAGE(PG8_SB(0, 0), b2, voffB);
            PG8_BAR; PG8_WAIT_L(0); PG8_MMA(0, 1, At, B1); PG8_BAR;
            PG8_LDA(At, 0, 1); PG8_STAGE(PG8_SA(0, 0), a2, voffA);
            PG8_BAR; PG8_WAIT_L(0); PG8_MMA(1, 0, At, B0); PG8_BAR; PG8_SCHED;
            PG8_STAGE(PG8_SB(0, 1), b2 + hstepB, voffB);
            PG8_WAIT_V(6); PG8_BAR; PG8_MMA(1, 1, At, B1); PG8_BAR;
            PG8_LDB(B0, 1, 0); PG8_SCHED; PG8_LDA(At, 1, 0); PG8_STAGE(PG8_SA(0, 1), a2 + hstepA, voffA);
            PG8_WAIT_L(8); PG8_BAR; PG8_WAIT_L(0); PG8_MMA(0, 0, At, B0); PG8_BAR; PG8_SCHED;
            PG8_LDB(B1, 1, 1); PG8_STAGE(PG8_SB(1, 0), b3, voffB);
            PG8_BAR; PG8_WAIT_L(0); PG8_MMA(0, 1, At, B1); PG8_BAR;
            PG8_LDA(At, 1, 1); PG8_STAGE(PG8_SA(1, 0), a3, voffA);
            PG8_BAR; PG8_WAIT_L(0); PG8_MMA(1, 0, At, B0); PG8_BAR; PG8_SCHED;
            PG8_STAGE(PG8_SB(1, 1), b3 + hstepB, voffB);
            PG8_WAIT_V(6); PG8_BAR; PG8_MMA(1, 1, At, B1); PG8_BAR;
            }
        }
        if constexpr (FP8) asm volatile("s_nop 15\n\ts_nop 7" ::: "memory");
        if constexpr (ALIGN_EPI) { if (wr == 0) PG8_BAR; }
        if constexpr (!Epi::AFTER_DRAIN) { E(acc, cur, wr, wc, fr, fq); S.done(cur); }
        if (!has_next) break;
#pragma unroll
        for (int a = 0; a < 2; ++a)
#pragma unroll
            for (int b = 0; b < 2; ++b)
#pragma unroll
                for (int m = 0; m < 4; ++m)
#pragma unroll
                    for (int n = 0; n < 2; ++n) acc[a][b][m][n] = (f32x4){0.f, 0.f, 0.f, 0.f};
        cur = nxt; cA = nA; cB = nB; ++ui;
        if constexpr (ALIGN_EPI) { if (wr == 1) PG8_BAR; }
    }
    PG8_WAIT_V(0);
    if constexpr (!ALIGN_EPI) { if (wr == 0) PG8_BAR; }
    PG8_BAR;
    if constexpr (Epi::AFTER_DRAIN) { E.fused(acc, cur, wr, wc, fr, fq, lds, wid, lane); S.done(cur); }
#undef PG8_SA
#undef PG8_SB
#undef PG8_STAGE
#undef PG8_RDA
#undef PG8_RDB
#undef PG8_LDA
#undef PG8_LDB
#undef PG8_MMA
#undef PG8_WAIT_V
#undef PG8_WAIT_L
#undef PG8_BAR
#undef PG8_SCHED
}
}

#ifndef MK_FFN_FP8
#define MK_FFN_FP8 1
#endif
constexpr bool FFN_FP8 = MK_FFN_FP8;
constexpr int NWAVES = 8, NTHREADS = NWAVES * 64;
constexpr int BATCH = 2, SEQ = 8192, M = BATCH * SEQ, DM = 2048, DEPTH = 4, DFF = 5632, NGU = 2 * DFF, INC = 5976, NIN = 6144, NMOD = 9 * DM;
constexpr int DFFP = DFF + 128;
constexpr int NH = 8, HD = 64, GWID = 512, TOPK = 256, WINDOW = 128;
constexpr int PA_Q = 0, PA_K = 512, PA_V = 576, PA_IQ = 640, PA_IK = 1664, PB_Q = 1728, PB_K = 2240, PB_V = 2304, PC_Q = 2368, PC_K = 2880, PC_V = 3392, PC_G = 3904,
              PD_Q = 4416, PD_K = 4928, PD_V = 5440, PA_IW = 5952, PC_F = 5968;
constexpr float RMS_EPS = 1e-6f, LOG2E = 1.4426950408889634f, QSCALE = 0.125f * LOG2E;

constexpr size_t MiB = 1u << 20;
constexpr size_t WS_CTL = 0, CTL_ZERO_BYTES = 64 * 1024;
constexpr size_t WS_MOD = 1 * MiB;
constexpr size_t WS_LF = 2 * MiB;
constexpr size_t WS_KB2 = 3 * MiB;
constexpr size_t WS_WGU = 4 * MiB;
constexpr size_t SZ_WGU = (size_t)NGU * DM * 2;
constexpr size_t WS_WD = WS_WGU + 8 * SZ_WGU;
constexpr size_t SZ_WD = (size_t)DM * DFF * 2;
constexpr size_t WS_WIN = WS_WD + 8 * SZ_WD;
constexpr size_t SZ_WIN = (size_t)NIN * DM * 2;
constexpr size_t WS_WOUT = WS_WIN + 4 * SZ_WIN;
constexpr size_t SZ_WOUT = (size_t)DM * DM * 2;
constexpr size_t WS_H = WS_WOUT + 4 * SZ_WOUT;
constexpr size_t WS_P = WS_H + (size_t)M * DM * 2;
constexpr size_t WS_Y = WS_P + (size_t)M * NIN * 2;
constexpr size_t WS_IDX = WS_Y + (size_t)M * DM * 2;
constexpr size_t WS_SC = WS_IDX + (size_t)M * TOPK * 4;
constexpr size_t WS_XB = WS_SC + (size_t)BATCH * SEQ * SEQ * 2;
constexpr size_t WS_END = WS_XB + (size_t)M * DM * 2;
static_assert(WS_WGU % MiB == 0 && WS_WD % MiB == 0 && WS_WIN % MiB == 0 && WS_WOUT % MiB == 0 && WS_H % MiB == 0 && WS_P % MiB == 0 && WS_Y % MiB == 0 && WS_IDX % MiB == 0 && WS_SC % MiB == 0, "d_ws map alignment");
constexpr int CW_BAR = 4096;

constexpr int RING_OFF = 0, RING_BYTES = 131072;
constexpr int AUX_OFF = RING_BYTES, AUX_BYTES = 16384;
constexpr int LDSCTL_OFF = AUX_OFF + AUX_BYTES;
constexpr int LDS_BYTES = LDSCTL_OFF + 256;

#define GAS __attribute__((address_space(1)))
#define LAS __attribute__((address_space(3)))
typedef unsigned short bf16;
typedef unsigned v4u __attribute__((ext_vector_type(4)));
typedef unsigned v2u __attribute__((ext_vector_type(2)));
typedef int v4i __attribute__((ext_vector_type(4)));
typedef float f32x4 __attribute__((ext_vector_type(4)));
typedef float f32x16 __attribute__((ext_vector_type(16)));
typedef short bf16x8 __attribute__((ext_vector_type(8)));
typedef short s16x4 __attribute__((ext_vector_type(4)));
typedef GAS unsigned gu32;
#define RLX_AGENT __ATOMIC_RELAXED, __HIP_MEMORY_SCOPE_AGENT
#define LDS_WAIT() asm volatile("s_waitcnt lgkmcnt(0)" ::: "memory")
#define VM_WAIT() asm volatile("s_waitcnt vmcnt(0)" ::: "memory")
__device__ __forceinline__ unsigned f2bf(float f) { unsigned u = __builtin_bit_cast(unsigned, f); return (u + 0x7fffu + ((u >> 16) & 1u)) >> 16; }
__device__ __forceinline__ unsigned pk2(float lo, float hi) { return f2bf(lo) | (f2bf(hi) << 16); }
__device__ __forceinline__ float bf_lo(unsigned w) { return __builtin_bit_cast(float, w << 16); }
__device__ __forceinline__ float bf_hi(unsigned w) { return __builtin_bit_cast(float, w & 0xffff0000u); }
__device__ __forceinline__ float bf2f(bf16 h) { return __builtin_bit_cast(float, (unsigned)h << 16); }
__device__ __forceinline__ float wave_sum(float v) {
#pragma unroll
    for (int o = 1; o < 64; o <<= 1) v += __shfl_xor(v, o);
    return v;
}
__device__ __forceinline__ float fexp2(float x) { return __builtin_amdgcn_exp2f(x); }
__device__ __forceinline__ float frcp(float x) { return __builtin_amdgcn_rcpf(x); }
__device__ const unsigned char kBucketLut[128] = {0, 1, 2, 3, 4, 5, 6, 7, 8, 9, 10, 11, 12, 13, 14, 15, 16, 16, 16, 17, 17, 18, 18, 18, 19, 19, 19, 20, 20, 20, 20, 21, 21, 21, 21, 22, 22, 22, 22, 22,
    23, 23, 23, 23, 23, 23, 24, 24, 24, 24, 24, 24, 25, 25, 25, 25, 25, 25, 25, 26, 26, 26, 26, 26, 26, 26, 26, 27, 27, 27, 27, 27, 27, 27, 27, 27, 27, 28, 28, 28, 28, 28, 28, 28, 28, 28, 28,
    29, 29, 29, 29, 29, 29, 29, 29, 29, 29, 29, 29, 30, 30, 30, 30, 30, 30, 30, 30, 30, 30, 30, 30, 30, 30, 31, 31, 31, 31, 31, 31, 31, 31, 31, 31, 31, 31, 31, 31, 31};

#define XB_TMO      128
#define XB_XCNT(j)  (256  + 64 * (j))
#define XB_XSUB(j)  (1280 + 64 * (j))
#define XB_XGEN(j)  (2304 + 64 * (j))
#define XB_TOP      3328
#define XB_TOPGEN   3392
#define XCD_BAR_WORDS 3456
#define XB_SPIN_CAP (1u << 18)

__device__ __forceinline__ unsigned xb_ld(unsigned* p)              { return __hip_atomic_load((GAS unsigned*)p, __ATOMIC_RELAXED, __HIP_MEMORY_SCOPE_AGENT); }
__device__ __forceinline__ unsigned xb_add(unsigned* p, unsigned v) { return __hip_atomic_fetch_add((GAS unsigned*)p, v, __ATOMIC_RELAXED, __HIP_MEMORY_SCOPE_AGENT); }
__device__ __forceinline__ unsigned xb_xcc_id() { return (unsigned)__builtin_amdgcn_s_getreg((3 << 11) | 20) & 0xFu; }
#define XB_SPIN(cond, bar) do { unsigned _sp = 0; while (cond) { __builtin_amdgcn_s_sleep(1); \
    if ((++_sp & 255u) == 0u) { if (xb_ld(&(bar)[XB_TMO])) break; if (_sp > XB_SPIN_CAP) { xb_add(&(bar)[XB_TMO], 1u); break; } } } } while (0)

struct XcdBarrier {
    unsigned* bar; unsigned x;
    volatile LAS unsigned* st;
};

__device__ __forceinline__ XcdBarrier xcd_barrier_post(unsigned* bar, volatile LAS unsigned* st) {
    XcdBarrier b; b.bar = bar; b.x = xb_xcc_id(); b.st = st;
    if (threadIdx.x == 0) (void)xb_add(&bar[XB_XCNT(b.x)], 1u);
    return b;
}
__device__ __forceinline__ void xcd_barrier_complete(unsigned* bar, unsigned x, unsigned& nloc, unsigned& nx) {
    const unsigned G = gridDim.x * gridDim.y * gridDim.z;
    unsigned sum, cnt, mine, sp = 0u;
    for (;;) {
        sum = 0u; cnt = 0u; mine = 0u;
#pragma unroll
        for (unsigned j = 0; j < 16; ++j) { const unsigned c = xb_ld(&bar[XB_XCNT(j)]); sum += c; cnt += (c > 0u) ? 1u : 0u; mine = (j == x) ? c : mine; }
        if (sum == G) break;
        __builtin_amdgcn_s_sleep(1);
        if ((++sp & 255u) == 0u) { if (xb_ld(&bar[XB_TMO])) break; if (sp > XB_SPIN_CAP) { xb_add(&bar[XB_TMO], 1u); break; } }
    }
    nloc = mine > 0u ? mine : 1u; nx = cnt > 0u ? cnt : 1u;
}

__device__ __forceinline__ void xcd_barrier(const XcdBarrier& b) {
    asm volatile("s_waitcnt vmcnt(0)" ::: "memory");
    __syncthreads();
    if (threadIdx.x == 0) {
        unsigned* bar = b.bar; asm volatile("" : "+s"(bar));
        __builtin_amdgcn_s_waitcnt(0);
        unsigned nloc = b.st[0], nx = b.st[1];
        if (nloc == 0u) { xcd_barrier_complete(bar, b.x, nloc, nx); b.st[0] = nloc; b.st[1] = nx; }
        const unsigned old = xb_add(&bar[XB_XSUB(b.x)], 1u);
        const unsigned gen = old / nloc;
        if (old + 1u == (gen + 1u) * nloc) {
            __builtin_amdgcn_fence(__ATOMIC_RELEASE, "agent");
            asm volatile("s_waitcnt vmcnt(0)" ::: "memory");
            const unsigned og = xb_add(&bar[XB_TOP], 1u);
            const unsigned tg = og / nx;
            if (og + 1u == (tg + 1u) * nx) xb_add(&bar[XB_TOPGEN], 1u);
            else XB_SPIN(xb_ld(&bar[XB_TOPGEN]) == tg, bar);
            __builtin_amdgcn_fence(__ATOMIC_ACQUIRE, "agent");
            xb_add(&bar[XB_XGEN(b.x)], 1u);
            asm volatile("s_waitcnt vmcnt(0)" ::: "memory");
        } else {
            XB_SPIN(xb_ld(&bar[XB_XGEN(b.x)]) == gen, bar);
            __builtin_amdgcn_fence(__ATOMIC_ACQUIRE, "agent");
            asm volatile("s_waitcnt vmcnt(0)" ::: "memory");
        }
    }
    __syncthreads();
}

struct Frame {
    LAS unsigned char* lds;
    gu32* ctl;
    int tid, lane, wave, G, gw, NGW;
    const float *x, *c, *w_ada, *b_ada, *norm_g, *w_in, *qk_g, *forget_b, *sinks, *rel_table, *group_g, *w_out, *w_gate, *w_up, *w_down;
    float* out;
    float *MOD, *LF, *KB2; unsigned short* SC; int* IDX;
    bf16 *WGU, *WD, *WIN, *WOUT, *H, *P, *Y, *XB;
};

template <int MAP> __device__ __forceinline__ int w_rowmap(int n) {
    if (MAP == 1) return 256 * (n >> 7) + (n & 127);
    if (MAP == 2) return 256 * (n >> 7) + 128 + (n & 127);
    if (MAP == 3) { if (n < 1728) return n; if (n < 1744) return PA_IW + (n - 1728); if (n < 3920) return n - 16; if (n < 3928) return PC_F + (n - 3920); return n - 24; }
    return n;
}
template <int MAP> __device__ __forceinline__ void p0_transpose_item(const float* W, int K, int N, bf16* WT, LAS unsigned* T, int item, int lane) {
    const int nblk = (N + 63) / 64, kb = item / nblk, nb = item % nblk, k0 = 64 * kb, n0 = 64 * nb;
    const int r = lane >> 4, c = lane & 15;
    const bool nok = (n0 + 4 * c) < N;
    const float* src = W + (size_t)(k0 + 2 * r) * N + n0 + 4 * c;
    f32x4 a[8], b[8];
#pragma unroll
    for (int i = 0; i < 8; ++i) { a[i] = nok ? *(const GAS f32x4*)(src + (size_t)(8 * i) * N) : (f32x4){0.f, 0.f, 0.f, 0.f}; b[i] = nok ? *(const GAS f32x4*)(src + (size_t)(8 * i + 1) * N) : (f32x4){0.f, 0.f, 0.f, 0.f}; }
#pragma unroll
    for (int i = 0; i < 8; ++i)
#pragma unroll
        for (int e = 0; e < 4; ++e) T[(4 * c + e) * 36 + 4 * i + r] = pk2(a[i][e], b[i][e]);
    LDS_WAIT(); asm volatile("" ::: "memory");
    const int rr = lane >> 3, ch = lane & 7;
#pragma unroll
    for (int j = 0; j < 8; ++j) { const int n = 8 * j + rr; const v4u o = *(const LAS v4u*)(T + n * 36 + 4 * ch);
        if (n0 + n < N) *(GAS v4u*)(WT + (size_t)w_rowmap<MAP>(n0 + n) * K + k0 + 8 * ch) = o; }
    LDS_WAIT(); asm volatile("" ::: "memory");
}
constexpr float W8_SCALE = 64.0f; constexpr int W8_E8M0 = 127 - 6;
__device__ __forceinline__ unsigned pk_fp8x4(float a, float b, float c, float d) {
    a = fminf(fmaxf(a, -448.f), 448.f); b = fminf(fmaxf(b, -448.f), 448.f); c = fminf(fmaxf(c, -448.f), 448.f); d = fminf(fmaxf(d, -448.f), 448.f);
    int w = 0; w = __builtin_amdgcn_cvt_pk_fp8_f32(a, b, w, false); w = __builtin_amdgcn_cvt_pk_fp8_f32(c, d, w, true); return (unsigned)w; }
template <int MAP> __device__ __forceinline__ void p0_transpose8_item(const float* W, int K, int N, unsigned char* WT, int ldw, LAS unsigned* T, int item, int lane) {
    const int nblk = (N + 63) / 64, kb = item / nblk, nb = item % nblk, k0 = 64 * kb, n0 = 64 * nb;
    const int r = lane >> 4, c = lane & 15;
    const bool nok = (n0 + 4 * c) < N;
    const float* src = W + (size_t)(k0 + 4 * r) * N + n0 + 4 * c;
    f32x4 q[4][4];
#pragma unroll
    for (int i = 0; i < 4; ++i)
#pragma unroll
        for (int d = 0; d < 4; ++d) q[i][d] = nok ? *(const GAS f32x4*)(src + (size_t)(16 * i + d) * N) : (f32x4){0.f, 0.f, 0.f, 0.f};
#pragma unroll
    for (int i = 0; i < 4; ++i)
#pragma unroll
        for (int e = 0; e < 4; ++e) T[(4 * c + e) * 20 + 4 * i + r] = pk_fp8x4(q[i][0][e] * W8_SCALE, q[i][1][e] * W8_SCALE, q[i][2][e] * W8_SCALE, q[i][3][e] * W8_SCALE);
    LDS_WAIT(); asm volatile("" ::: "memory");
    const int rr = lane >> 2, ch = lane & 3;
#pragma unroll
    for (int j = 0; j < 4; ++j) { const int n = 16 * j + rr; const v4u o = *(const LAS v4u*)(T + n * 20 + 4 * ch);
        if (n0 + n < N) *(GAS v4u*)(WT + (size_t)w_rowmap<MAP>(n0 + n) * ldw + k0 + 16 * ch) = o; }
    LDS_WAIT(); asm volatile("" ::: "memory");
}
template <int MAP> __device__ __forceinline__ void p0_transpose8(const Frame& F, const float* W, int K, int N, unsigned char* WT, int ldw, LAS unsigned* scr) {
    const int nitems = (K / 64) * ((N + 63) / 64);
    for (int it = F.gw; it < nitems; it += F.NGW) p0_transpose8_item<MAP>(W, K, N, WT, ldw, scr, it, F.lane);
}
template <int MAP> __device__ __forceinline__ void p0_transpose(const Frame& F, const float* W, int K, int N, bf16* WT, LAS unsigned* scr) {
    const int nitems = (K / 64) * ((N + 63) / 64);
    for (int it = F.gw; it < nitems; it += F.NGW) p0_transpose_item<MAP>(W, K, N, WT, scr, it, F.lane);
}
__device__ __forceinline__ void p0_prologue(const Frame& F) {
    LAS unsigned* scr = (LAS unsigned*)(F.lds + RING_OFF + F.wave * 16384);
    LAS float* cond = (LAS float*)(F.lds + AUX_OFF);
    LAS float* red = (LAS float*)(F.lds + RING_OFF);
    for (int i = F.tid; i < BATCH * DM; i += NTHREADS) { const float v = F.c[i]; cond[i] = v / (1.0f + __expf(-v)); }
    __syncthreads();
    for (int it = blockIdx.x; it < DEPTH * (NMOD / 64); it += F.G) {
        const int l = it / (NMOD / 64), n = (it % (NMOD / 64)) * 64 + F.lane;
        const float* w = F.w_ada + (size_t)l * DM * NMOD + (size_t)(256 * F.wave) * NMOD + n;
        const LAS float* c0 = cond + 256 * F.wave; const LAS float* c1 = cond + DM + 256 * F.wave;
        float a0 = 0.f, a1 = 0.f;
#pragma unroll 32
        for (int k = 0; k < 256; ++k) { const float wv = w[(size_t)k * NMOD]; a0 += c0[k] * wv; a1 += c1[k] * wv; }
        red[F.wave * 128 + F.lane] = a0; red[F.wave * 128 + 64 + F.lane] = a1;
        __syncthreads();
        if (F.tid < 128) { float sacc = 0.f;
#pragma unroll
            for (int wv = 0; wv < 8; ++wv) sacc += red[wv * 128 + F.tid];
            const int bsel = F.tid >> 6, nn = (it % (NMOD / 64)) * 64 + (F.tid & 63);
            F.MOD[((size_t)l * BATCH + bsel) * NMOD + nn] = sacc + F.b_ada[(size_t)l * NMOD + nn]; }
        __syncthreads();
    }
    for (int lf = 0; lf < DEPTH * 2; ++lf) {
        if (FFN_FP8) {
            p0_transpose8<1>(F, F.w_gate + (size_t)lf * DM * DFF, DM, DFF, (unsigned char*)F.WGU + (size_t)lf * NGU * DM, DM, scr);
            p0_transpose8<2>(F, F.w_up + (size_t)lf * DM * DFF, DM, DFF, (unsigned char*)F.WGU + (size_t)lf * NGU * DM, DM, scr);
            p0_transpose8<0>(F, F.w_down + (size_t)lf * DFF * DM, DFF, DM, (unsigned char*)F.WD + (size_t)lf * DM * DFFP, DFFP, scr);
        } else {
            p0_transpose<1>(F, F.w_gate + (size_t)lf * DM * DFF, DM, DFF, F.WGU + (size_t)lf * NGU * DM, scr);
            p0_transpose<2>(F, F.w_up + (size_t)lf * DM * DFF, DM, DFF, F.WGU + (size_t)lf * NGU * DM, scr);
            p0_transpose<0>(F, F.w_down + (size_t)lf * DFF * DM, DFF, DM, F.WD + (size_t)lf * DM * DFF, scr);
        }
    }
    for (int l = 0; l < DEPTH; ++l) {
        p0_transpose<3>(F, F.w_in + (size_t)l * DM * INC, DM, INC, F.WIN + (size_t)l * NIN * DM, scr);
        p0_transpose<0>(F, F.w_out + (size_t)l * DM * DM, DM, DM, F.WOUT + (size_t)l * DM * DM, scr);
        GAS v4u* z = (GAS v4u*)(F.WIN + (size_t)l * NIN * DM + (size_t)INC * DM);
        for (int i = F.gw * 64 + F.lane; i < (NIN - INC) * DM / 8; i += F.NGW * 64) z[i] = (v4u){0u, 0u, 0u, 0u};
    }
}

template <bool OUT8, bool IN16> __device__ __forceinline__ void ph_modulate(const Frame& F, const void* xin, const float* g, const float* shift, const float* scale) {
    for (int m = F.gw; m < M; m += F.NGW) {
        const int b = m / SEQ;
        float x[4][8]; float s = 0.f;
        if constexpr (IN16) {
            const GAS v4u* xr = (const GAS v4u*)((const bf16*)xin + (size_t)m * DM) + F.lane;
            v4u w[4];
#pragma unroll
            for (int j = 0; j < 4; ++j) w[j] = xr[64 * j];
#pragma unroll
            for (int j = 0; j < 4; ++j) { x[j][0] = bf_lo(w[j].x); x[j][1] = bf_hi(w[j].x); x[j][2] = bf_lo(w[j].y); x[j][3] = bf_hi(w[j].y); x[j][4] = bf_lo(w[j].z); x[j][5] = bf_hi(w[j].z); x[j][6] = bf_lo(w[j].w); x[j][7] = bf_hi(w[j].w); }
        } else {
            const GAS f32x4* xr = (const GAS f32x4*)((const float*)xin + (size_t)m * DM) + 2 * F.lane;
            f32x4 a[4][2];
#pragma unroll
            for (int j = 0; j < 4; ++j) { a[j][0] = xr[128 * j]; a[j][1] = xr[128 * j + 1]; }
            GAS v4u* xo = (GAS v4u*)(F.XB + (size_t)m * DM) + F.lane;
#pragma unroll
            for (int j = 0; j < 4; ++j) { x[j][0] = a[j][0].x; x[j][1] = a[j][0].y; x[j][2] = a[j][0].z; x[j][3] = a[j][0].w; x[j][4] = a[j][1].x; x[j][5] = a[j][1].y; x[j][6] = a[j][1].z; x[j][7] = a[j][1].w;
                v4u w; w.x = pk2(x[j][0], x[j][1]); w.y = pk2(x[j][2], x[j][3]); w.z = pk2(x[j][4], x[j][5]); w.w = pk2(x[j][6], x[j][7]); xo[64 * j] = w; }
        }
#pragma unroll
        for (int j = 0; j < 4; ++j) s += ((x[j][0] * x[j][0] + x[j][1] * x[j][1]) + (x[j][2] * x[j][2] + x[j][3] * x[j][3])) + ((x[j][4] * x[j][4] + x[j][5] * x[j][5]) + (x[j][6] * x[j][6] + x[j][7] * x[j][7]));
        const float rstd = 1.0f / sqrtf(wave_sum(s) * (1.f / DM) + RMS_EPS);
        const GAS f32x4* gp = (const GAS f32x4*)g + 2 * F.lane; const GAS f32x4* sh = (const GAS f32x4*)(shift + (size_t)b * NMOD) + 2 * F.lane; const GAS f32x4* sc = (const GAS f32x4*)(scale + (size_t)b * NMOD) + 2 * F.lane;
        GAS v4u* o16 = (GAS v4u*)(F.H + (size_t)m * DM) + F.lane;
        GAS v2u* o8 = (GAS v2u*)((unsigned char*)F.H + (size_t)m * DM) + F.lane;
#pragma unroll
        for (int j = 0; j < 4; ++j) { float y[8];
#pragma unroll
            for (int h = 0; h < 2; ++h) { const f32x4 gg = gp[128 * j + h], ss = sc[128 * j + h], hh = sh[128 * j + h];
                y[4 * h + 0] = x[j][4 * h + 0] * rstd * gg.x * (ss.x + 1.0f) + hh.x; y[4 * h + 1] = x[j][4 * h + 1] * rstd * gg.y * (ss.y + 1.0f) + hh.y;
                y[4 * h + 2] = x[j][4 * h + 2] * rstd * gg.z * (ss.z + 1.0f) + hh.z; y[4 * h + 3] = x[j][4 * h + 3] * rstd * gg.w * (ss.w + 1.0f) + hh.w; }
            if (OUT8) { v2u w; w.x = pk_fp8x4(y[0], y[1], y[2], y[3]); w.y = pk_fp8x4(y[4], y[5], y[6], y[7]); o8[64 * j] = w; }
            else { v4u w; w.x = pk2(y[0], y[1]); w.y = pk2(y[2], y[3]); w.z = pk2(y[4], y[5]); w.w = pk2(y[6], y[7]); o16[64 * j] = w; } }
    }
}
__device__ __forceinline__ v4u headnorm8(v4u w, const float* g, float mul, int lane, bool normalize) {
    float x[8] = {bf_lo(w.x), bf_hi(w.x), bf_lo(w.y), bf_hi(w.y), bf_lo(w.z), bf_hi(w.z), bf_lo(w.w), bf_hi(w.w)};
    float r = mul;
    if (normalize) {
        float s = 0.f;
#pragma unroll
        for (int i = 0; i < 8; ++i) s += x[i] * x[i];
        s += __shfl_xor(s, 1); s += __shfl_xor(s, 2); s += __shfl_xor(s, 4);
        r = mul / sqrtf(s * (1.f / 64.f) + RMS_EPS);
        const f32x4 g0 = *(const GAS f32x4*)(g + 8 * (lane & 7)), g1 = *(const GAS f32x4*)(g + 8 * (lane & 7) + 4);
        x[0] *= g0.x; x[1] *= g0.y; x[2] *= g0.z; x[3] *= g0.w; x[4] *= g1.x; x[5] *= g1.y; x[6] *= g1.z; x[7] *= g1.w;
    }
    w.x = pk2(x[0] * r, x[1] * r); w.y = pk2(x[2] * r, x[3] * r); w.z = pk2(x[4] * r, x[5] * r); w.w = pk2(x[6] * r, x[7] * r);
    return w;
}
__device__ __forceinline__ void ph_post(const Frame& F, int l) {
    const float* qg = F.qk_g + (size_t)l * 6 * HD;
    for (int m = F.gw; m < M; m += F.NGW) {
        bf16* row = F.P + (size_t)m * NIN; const int lane = F.lane;
        GAS v4u* paq = (GAS v4u*)(row + PA_Q + 8 * lane); GAS v4u* pbq = (GAS v4u*)(row + PB_Q + 8 * lane); GAS v4u* pcq = (GAS v4u*)(row + PC_Q + 8 * lane);
        GAS v4u* pck = (GAS v4u*)(row + PC_K + 8 * lane); GAS v4u* pdq = (GAS v4u*)(row + PD_Q + 8 * lane);
        GAS v4u* pkk = (GAS v4u*)(row + (lane < 8 ? PA_K : PB_K) + 8 * (lane & 7));
        const v4u waq = *paq, wbq = *pbq, wcq = *pcq, wck = *pck, wdq = *pdq;
        v4u wkk = {0u, 0u, 0u, 0u}; if (lane < 16) wkk = *pkk;
        *paq = headnorm8(waq, qg + 0 * HD, QSCALE, lane, true);
        *pbq = headnorm8(wbq, qg + 2 * HD, QSCALE, lane, true);
        *pcq = headnorm8(wcq, qg + 4 * HD, QSCALE, lane, true);
        *pck = headnorm8(wck, qg + 5 * HD, 1.0f, lane, true);
        *pdq = headnorm8(wdq, qg, QSCALE, lane, false);
        if (lane < 16) *pkk = headnorm8(wkk, qg + (lane < 8 ? 1 : 3) * HD, 1.0f, lane, true);
    }
}
__device__ __forceinline__ void ph_scan(const Frame& F, int l) {
    LAS float* wtot = (LAS float*)(F.lds + RING_OFF);
    for (int sq = blockIdx.x; sq < BATCH * NH; sq += F.G) {
        const int b = sq / NH, h = sq % NH; const float fb = F.forget_b[(size_t)l * NH + h];
        const GAS unsigned short* src = (const GAS unsigned short*)(F.P + ((size_t)b * SEQ + 16 * F.tid) * NIN + PC_F + h); float* dst = F.KB2 + (size_t)sq * SEQ + 16 * F.tid;
        float v[16]; unsigned short raw[16];
#pragma unroll
        for (int i = 0; i < 16; ++i) raw[i] = src[(size_t)i * NIN];
#pragma unroll
        for (int i = 0; i < 16; ++i) { const float y = __builtin_bit_cast(float, (unsigned)raw[i] << 16) + fb; v[i] = (y >= 0.f) ? -log1pf(__expf(-y)) : (y - log1pf(__expf(y))); }
#pragma unroll
        for (int i = 1; i < 16; ++i) v[i] += v[i - 1];
        float incl = v[15];
#pragma unroll
        for (int o = 1; o < 64; o <<= 1) { const float t = __shfl_up(incl, o); if (F.lane >= o) incl += t; }
        if (F.lane == 63) wtot[F.wave] = incl;
        __syncthreads();
        float base = incl - v[15];
        for (int w = 0; w < F.wave; ++w) base += wtot[w];
#pragma unroll
        for (int i = 0; i < 4; ++i) *(GAS f32x4*)(dst + 4 * i) = (f32x4){-(v[4 * i] + base) * LOG2E, -(v[4 * i + 1] + base) * LOG2E, -(v[4 * i + 2] + base) * LOG2E, -(v[4 * i + 3] + base) * LOG2E};
        __syncthreads();
    }
}
__device__ __forceinline__ void ph_gnorm(const Frame& F, int l) {
    const float* gg = F.group_g + (size_t)l * DM;
    for (int m = F.gw; m < M; m += F.NGW) {
        v4u w[4];
#pragma unroll
        for (int g = 0; g < 4; ++g) w[g] = *(GAS v4u*)(F.Y + (size_t)m * DM + g * GWID + 8 * F.lane);
#pragma unroll
        for (int g = 0; g < 4; ++g) {
            bf16* p = F.Y + (size_t)m * DM + g * GWID + 8 * F.lane;
            float x[8] = {bf_lo(w[g].x), bf_hi(w[g].x), bf_lo(w[g].y), bf_hi(w[g].y), bf_lo(w[g].z), bf_hi(w[g].z), bf_lo(w[g].w), bf_hi(w[g].w)};
            float s = 0.f;
#pragma unroll
            for (int i = 0; i < 8; ++i) s += x[i] * x[i];
            const float r = 1.0f / sqrtf(wave_sum(s) * (1.f / GWID) + RMS_EPS);
            const f32x4 g0 = *(const GAS f32x4*)(gg + g * GWID + 8 * F.lane), g1 = *(const GAS f32x4*)(gg + g * GWID + 8 * F.lane + 4);
            v4u o; o.x = pk2(x[0] * r * g0.x, x[1] * r * g0.y); o.y = pk2(x[2] * r * g0.z, x[3] * r * g0.w); o.z = pk2(x[4] * r * g1.x, x[5] * r * g1.y); o.w = pk2(x[6] * r * g1.z, x[7] * r * g1.w);
            *(GAS v4u*)p = o;
        }
    }
}


__device__ __forceinline__ unsigned short score_key(float sc) {
    const _Float16 hf = (_Float16)fminf(fmaxf(sc, -60000.f), 60000.f);
    const unsigned h = (unsigned)__builtin_bit_cast(unsigned short, hf);
    return (unsigned short)((h & 0x8000u) ? (~h & 0xffffu) : (h | 0x8000u));
}
__device__ __forceinline__ void glds16x(const void* gsrc, unsigned lds_dst) { unsigned keep;
    asm volatile("s_mov_b32 %0, m0\n\ts_mov_b32 m0, %2\n\ts_nop 0\n\tglobal_load_lds_dwordx4 %1, off\n\ts_mov_b32 m0, %0" : "=&s"(keep) : "v"(gsrc), "s"(lds_dst) : "memory"); }
__device__ __forceinline__ void ph_idx_scores(const Frame& F) {
    constexpr int UPB = 8 * (16 * 17 / 2), NU = BATCH * UPB;
    const int lane = F.lane, r32 = lane & 31, hi = lane >> 5;
    const int u_lo = (int)(((long)blockIdx.x * NU) / F.G), u_hi = (int)(((long)(blockIdx.x + 1) * NU) / F.G);
    if (u_lo >= u_hi) return;
    int b = u_lo / UPB, qb = 127, kc = 0; { int r = u_lo % UPB; for (;;) { const int n = (qb >> 3) + 1; if (r < n) { kc = r; break; } r -= n; --qb; } }
    LAS unsigned char* KL = F.lds + RING_OFF;
    const unsigned kl_lds = (unsigned)(size_t)KL;
#define X1_STAGE(bb, kk, buf) do { const bf16* ksrc_ = F.P + ((size_t)(bb) * SEQ + 512 * (kk) + 64 * F.wave + lane) * NIN + PA_IK; \
        _Pragma("unroll") for (int c_ = 0; c_ < 8; ++c_) glds16x(ksrc_ + 8 * c_, (unsigned)__builtin_amdgcn_readfirstlane(kl_lds + (buf) * 65536 + c_ * 8192 + F.wave * 1024)); } while (0)
    X1_STAGE(b, kc, 0);
    asm volatile("s_waitcnt vmcnt(0)" ::: "memory"); __syncthreads();
    bf16x8 af[4][4]; float wq[4][16]; int cb = -1, cqb = -1;
    for (int u = u_lo; u < u_hi; ++u) {
        const int cur = (u - u_lo) & 1;
        int nb = b, nqb = qb, nkc = kc + 1; if (nkc > (qb >> 3)) { nkc = 0; --nqb; if (nqb < 0) { nqb = 127; ++nb; } }
        if (u + 1 < u_hi) X1_STAGE(nb, nkc, cur ^ 1);
        const size_t rowb = (size_t)b * SEQ; const int t0 = 64 * qb + 8 * F.wave;
        if (b != cb || qb != cqb) { cb = b; cqb = qb;
#pragma unroll
            for (int pr = 0; pr < 4; ++pr) {
                const bf16* qrow = F.P + (rowb + t0 + 2 * pr + ((r32 >> 2) & 1)) * NIN + PA_IQ + ((r32 & 3) + 4 * (r32 >> 3)) * 64 + 8 * hi;
#pragma unroll
                for (int s = 0; s < 4; ++s) af[pr][s] = *(const GAS bf16x8*)(qrow + 16 * s);
                const bf16* wrow = F.P + (rowb + t0 + 2 * pr + hi) * NIN + PA_IW;
                const v4u w0 = *(const GAS v4u*)wrow, w1 = *(const GAS v4u*)(wrow + 8);
                const unsigned ww[8] = {w0.x, w0.y, w0.z, w0.w, w1.x, w1.y, w1.z, w1.w};
#pragma unroll
                for (int i = 0; i < 8; ++i) { wq[pr][2 * i] = bf_lo(ww[i]) * 0.015625f; wq[pr][2 * i + 1] = bf_hi(ww[i]) * 0.015625f; }
            }
        }
        const int kend = 64 * (qb + 1) - 512 * kc;
        const int nkt = kend >= 512 ? 16 : (kend + 31) / 32;
        const LAS unsigned char* kl = KL + cur * 65536 + hi * 8192 + r32 * 16;
        for (int kt = 0; kt < nkt; ++kt) {
            bf16x8 bfr[4];
#pragma unroll
            for (int s = 0; s < 4; ++s) bfr[s] = *(const LAS bf16x8*)(kl + s * 16384 + kt * 512);
            const int s0 = 512 * kc + 32 * kt;
#pragma unroll
            for (int pr = 0; pr < 4; ++pr) {
                f32x16 acc = {};
#pragma unroll
                for (int s = 0; s < 4; ++s) acc = __builtin_amdgcn_mfma_f32_32x32x16_bf16(af[pr][s], bfr[s], acc, 0, 0, 0);
                float sc0 = 0.f, sc1 = 0.f;
#pragma unroll
                for (int r = 0; r < 16; ++r) { sc0 = __builtin_fmaf(wq[pr][r], acc[r], sc0); sc1 = __builtin_fmaf(wq[pr][r], __builtin_fabsf(acc[r]), sc1); if ((r & 3) == 3) asm("" : "+v"(sc1)); }
                ((GAS unsigned short*)F.SC)[(rowb + t0 + 2 * pr + hi) * SEQ + s0 + r32] = score_key(sc0 + sc1);
                __builtin_amdgcn_sched_barrier(0);
            }
        }
        asm volatile("s_waitcnt vmcnt(0)" ::: "memory");
        __syncthreads();
        b = nb; qb = nqb; kc = nkc;
    }
#undef X1_STAGE
}

__device__ __forceinline__ unsigned mbcnt64(unsigned long long m) { return __builtin_amdgcn_mbcnt_hi((unsigned)(m >> 32), __builtin_amdgcn_mbcnt_lo((unsigned)m, 0u)); }
template <int SH, int PSH> __device__ __forceinline__ void sel_level(const unsigned (&v)[64], int nreg, unsigned pval, unsigned need, LAS unsigned* hist, int lane, unsigned& bin_out, unsigned& above_out) {
#pragma unroll
    for (int i = 0; i < 8; ++i) ((LAS v4u*)hist)[lane + 64 * i] = (v4u){0u, 0u, 0u, 0u};
    LDS_WAIT(); __builtin_amdgcn_wave_barrier();
    const unsigned hb = (unsigned)(size_t)hist, sink = hb + 9216u + 4u * (unsigned)lane;
#pragma unroll
    for (int g = 0; g < 8; ++g) if (8 * g < nreg) {
#pragma unroll
        for (int jj = 0; jj < 8; ++jj) { const int j = 8 * g + jj;
#pragma unroll
            for (int e = 0; e < 2; ++e) { const unsigned k = e ? (v[j] >> 16) : (v[j] & 0xffffu);
                const bool pred = (k != 0u) && (PSH >= 16 || (k >> (PSH & 15)) == pval);
                const unsigned tgt = pred ? hb + (((k >> SH) & 2047u) << 2) : sink;
                __hip_atomic_fetch_add((LAS unsigned*)tgt, 1u, __ATOMIC_RELAXED, __HIP_MEMORY_SCOPE_WAVEFRONT); }
            if ((jj & 1) == 1) __builtin_amdgcn_sched_barrier(0); }
    }
    LDS_WAIT(); __builtin_amdgcn_wave_barrier();
    unsigned S = 0u;
#pragma unroll
    for (int i = 0; i < 8; ++i) { const v4u q = ((LAS v4u*)hist)[lane * 8 + i]; S += (q.x + q.y) + (q.z + q.w); }
    unsigned T = S;
#pragma unroll
    for (int o = 1; o < 64; o <<= 1) { const unsigned t = __shfl_down(T, o); if (lane + o < 64) T += t; }
    const unsigned above_lane = T - S;
    const bool cross = (T >= need) && (above_lane < need);
    unsigned run = above_lane, bin = 0u, ab = 0u; bool found = false;
#pragma unroll
    for (int i = 7; i >= 0; --i) { const v4u q = ((LAS v4u*)hist)[lane * 8 + i]; const unsigned c4[4] = {q.x, q.y, q.z, q.w};
#pragma unroll
        for (int e = 3; e >= 0; --e) { const bool hit = !found && (run + c4[e] >= need); if (hit) { bin = 32u * lane + 4 * i + e; ab = run; found = true; } run += c4[e]; } }
    const unsigned long long cm = __ballot(cross);
    const int src = cm ? (int)__builtin_ctzll(cm) : 0;
    bin_out = __builtin_amdgcn_readlane(bin, src); above_out = __builtin_amdgcn_readlane(ab, src);
    LDS_WAIT(); __builtin_amdgcn_wave_barrier();
}
__device__ __forceinline__ void select_row(const Frame& F, int m, LAS unsigned* hist, LAS int* out) {
    int lane = F.lane; asm volatile("" : "+v"(lane));
    const int t = m % SEQ, n = t + 1;
    if (n <= TOPK) { for (int j = lane; j < TOPK; j += 64) out[j] = (j < n) ? j : 0; return; }
    const int nreg = (n + 127) >> 7;
    unsigned v[64];
    const GAS unsigned* pr = (const GAS unsigned*)(F.SC + (size_t)m * SEQ) + lane;
#pragma unroll
    for (int g = 0; g < 8; ++g) {
        if (8 * g < nreg) {
#pragma unroll
            for (int jj = 0; jj < 8; ++jj) v[8 * g + jj] = pr[jj * 64];
        } else {
#pragma unroll
            for (int jj = 0; jj < 8; ++jj) v[8 * g + jj] = 0u;
        }
        pr += 512; asm volatile("" : "+v"(pr));
    }
    const int nfull = n >> 7;
#pragma unroll
    for (int g = 0; g < 8; ++g) if (8 * g < nreg && 8 * g + 8 > nfull) {
#pragma unroll
        for (int jj = 0; jj < 8; ++jj) { const int j = 8 * g + jj; const int e0 = 128 * j + 2 * lane; const unsigned w = v[j];
            v[j] = ((e0 < n) ? (w & 0xffffu) : 0u) | ((e0 + 1 < n) ? (w & 0xffff0000u) : 0u); asm volatile("" : "+v"(v[j])); }
    }
    unsigned b1, a1, b2, a2;
    sel_level<5, 16>(v, nreg, 0u, (unsigned)TOPK, hist, lane, b1, a1);
    sel_level<0, 5>(v, nreg, b1, (unsigned)TOPK - a1, hist, lane, b2, a2);
    const unsigned tau = (b1 << 5) | (b2 & 31u);
    const unsigned quota = (unsigned)TOPK - a1 - a2;
    unsigned mg[4] = {0u, 0u, 0u, 0u}, me[4] = {0u, 0u, 0u, 0u};
#pragma unroll
    for (int g = 0; g < 8; ++g) {
        if (8 * g < nreg) {
#pragma unroll
            for (int jj = 0; jj < 8; ++jj) { const int j = 8 * g + jj;
#pragma unroll
                for (int e = 0; e < 2; ++e) { const unsigned k = e ? (v[j] >> 16) : (v[j] & 0xffffu);
                    mg[g >> 1] = mg[g >> 1] + mg[g >> 1] + ((k > tau) ? 1u : 0u); me[g >> 1] = me[g >> 1] + me[g >> 1] + ((k == tau) ? 1u : 0u); }
                if ((jj & 3) == 3) __builtin_amdgcn_sched_barrier(0); }
        } else { mg[g >> 1] <<= 16; me[g >> 1] <<= 16; }
    }
    const unsigned cg = (unsigned)(__builtin_popcount(mg[0]) + __builtin_popcount(mg[1]) + __builtin_popcount(mg[2]) + __builtin_popcount(mg[3]));
    unsigned ce = (unsigned)(__builtin_popcount(me[0]) + __builtin_popcount(me[1]) + __builtin_popcount(me[2]) + __builtin_popcount(me[3]));
    unsigned incl = cg | (ce << 16);
#pragma unroll
    for (int o = 1; o < 64; o <<= 1) { const unsigned t = (unsigned)__shfl_up((int)incl, o); if (lane >= o) incl += t; }
    const unsigned excl = incl - (cg | (ce << 16));
    const unsigned pre_g = excl & 0xffffu, pre_e = excl >> 16;
    const unsigned keep = pre_e >= quota ? 0u : ((quota - pre_e) < ce ? (quota - pre_e) : ce);
#pragma unroll
    for (int q = 3; q >= 0; --q) { while (ce > keep && me[q] != 0u) { me[q] &= me[q] - 1u; --ce; } }
    unsigned pos = pre_g + (pre_e < quota ? pre_e : quota);
    const int ilane = 2 * lane;
#pragma unroll
    for (int q = 0; q < 4; ++q) { unsigned mm = mg[q] | me[q];
        while (mm != 0u) { const int bpos = 31 - (int)__builtin_clz(mm); const int sl = 31 - bpos; mm &= ~(1u << bpos);
            const int i = 128 * (16 * q + (sl >> 1)) + ilane + (sl & 1);
            if (pos < (unsigned)TOPK) out[pos] = i;
            ++pos; } }
}


constexpr int AT_K = 0, AT_V = 16384, AT_KB = 32768, AT_WSF = 33280, AT_BT = 35328, AT_DEAD = 35840, AT_SV = 36864;
typedef short v4i16_t __attribute__((ext_vector_type(4)));
__device__ __forceinline__ s16x4 vtr(const LAS unsigned char* p) { return __builtin_bit_cast(s16x4, __builtin_amdgcn_ds_read_tr16_b64_v4i16((LAS v4i16_t*)p)); }
typedef __bf16 bfpair_t __attribute__((ext_vector_type(2))); typedef float f32pair_t __attribute__((ext_vector_type(2)));
__device__ __forceinline__ unsigned cvtpk(float lo, float hi) { const f32pair_t v = {lo, hi}; return __builtin_bit_cast(unsigned, __builtin_convertvector(v, bfpair_t)); }
#define NEG_INF (-__builtin_inff())

template <int TYPE>
__device__ __forceinline__ void dense_attn_unit(const Frame& F, int l, int b, int h, int qb) {
    constexpr int QOFF = TYPE == 1 ? PB_Q : TYPE == 2 ? PC_Q : PD_Q, KOFF = TYPE == 1 ? PB_K : TYPE == 2 ? PC_K : PD_K, VOFF = TYPE == 1 ? PB_V : TYPE == 2 ? PC_V : PD_V;
    constexpr bool MQA = TYPE == 1; constexpr int YOFF = TYPE * GWID;
    const int tid = F.tid, lane = F.lane, wid = F.wave, r32 = lane & 31, hi = lane >> 5;
    LAS unsigned char* L = F.lds + RING_OFF;
    LAS float* wsf = (LAS float*)(L + AT_WSF + wid * 256);
    LAS float* BT = (LAS float*)(L + AT_BT);
    const int hq = (TYPE == 1) ? wid : h, qoff = (TYPE == 1) ? (qb & 7) * 32 : wid * 32, qb256 = (TYPE == 1) ? (qb >> 3) : qb;
    const size_t rowb = (size_t)b * SEQ; const int q0 = qb256 * 256;
    const bf16* Pk = F.P + rowb * NIN + KOFF + (MQA ? 0 : h * 64);
    const bf16* Pv = F.P + rowb * NIN + VOFF + (MQA ? 0 : h * 64);
    const bf16* Pq = F.P + (rowb + q0 + qoff + r32) * NIN + QOFF + hq * 64 + hi * 8;
    bf16x8 qr[4];
#pragma unroll
    for (int d0 = 0; d0 < 4; ++d0) qr[d0] = *(const GAS bf16x8*)(Pq + 16 * d0);
    const int jt_hi = (TYPE == 1) ? ((q0 + qoff + 31) >> 6) : 4 * qb256 + 3, jt_lo = (TYPE == 1) ? (((q0 + qoff - (WINDOW - 1)) > 0 ? (q0 + qoff - (WINDOW - 1)) : 0) >> 6) : 0, nt = jt_hi - jt_lo + 1;
    if (TYPE == 1) { LAS float* BTall = (LAS float*)(L + AT_SV);
        for (int i = tid; i < 8 * 128; i += NTHREADS) BTall[i] = F.rel_table[(int)kBucketLut[i & 127] * 16 + 8 + (i >> 7)] * LOG2E;
        BT = BTall + 128 * wid; }
    const bf16* kgp = Pk + (size_t)lane * NIN + wid * 8;
    const int vkey = tid >> 3, vch = tid & 7;
    const bf16* vgp = Pv + (size_t)vkey * NIN + vch * 8;
    const int kl = wid * 1024 + lane * 16;
    const int vl = (vch >> 2) * 4096 + (vkey >> 3) * 512 + (vkey & 7) * 64 + (vch & 3) * 16;
    const float* kb2 = F.KB2 + ((size_t)b * NH + h) * SEQ;
    v4u kreg = *(const GAS v4u*)(kgp + (size_t)jt_hi * 64 * NIN), vreg = *(const GAS v4u*)(vgp + (size_t)jt_hi * 64 * NIN);
    float kbreg = 0.f; if (TYPE == 2 && tid < 64) kbreg = kb2[jt_hi * 64 + tid];
    *(LAS v4u*)(L + AT_K + kl) = kreg; *(LAS v4u*)(L + AT_V + vl) = vreg; if (TYPE == 2 && tid < 64) ((LAS float*)(L + AT_KB))[tid] = kbreg;
    __syncthreads();
    f32x16 o[2]; o[0] = f32x16{}; o[1] = f32x16{};
    float mrun = NEG_INF, lsum = 0.f, carry = 1.f;
    float qbound = 0.f;
    if (TYPE == 2) {
        float ss = 0.f;
#pragma unroll
        for (int d0 = 0; d0 < 4; ++d0)
#pragma unroll
            for (int j = 0; j < 8; ++j) { const float x = bf2f((bf16)qr[d0][j]); ss += x * x; }
        ss += __shfl_xor(ss, 32);
        float gm = fabsf(F.qk_g[((size_t)l * 6 + 5) * HD + lane]);
#pragma unroll
        for (int o = 1; o < 64; o <<= 1) gm = fmaxf(gm, __shfl_xor(gm, o));
        qbound = sqrtf(ss) * 8.08f * gm;
    }
    const int qrel = qoff + r32;
    const int vb = ((lane >> 4) & 1) * 32 + (lane & 3) * 8 + (4 * hi + ((lane & 15) >> 2)) * 64;
    LAS unsigned* deadf = (LAS unsigned*)(L + AT_DEAD);
    for (int i = 0; i < nt; ++i) {
        const int jt = jt_hi - i, cur = i & 1, jb = jt - 4 * qb256; const bool more = (i + 1 < nt);
        float kbnext = 0.f;
        if (more) { kreg = *(const GAS v4u*)(kgp + (size_t)(jt - 1) * 64 * NIN); vreg = *(const GAS v4u*)(vgp + (size_t)(jt - 1) * 64 * NIN); if (TYPE == 2 && tid < 64) kbreg = kb2[(jt - 1) * 64 + tid]; if (TYPE == 2) kbnext = kb2[jt * 64 - 1]; }
        const bool active = (64 * jb <= qoff + 31) && (TYPE != 1 || (64 * jb + 63 >= qoff - (WINDOW - 1)));
        if (active) {
            const LAS unsigned char* Kb = L + AT_K + cur * 8192; const LAS unsigned char* Vb = L + AT_V + cur * 8192;
            f32x16 p0 = f32x16{}, p1 = f32x16{};
            bf16x8 ka[4], kc[4];
#pragma unroll
            for (int d0 = 0; d0 < 4; ++d0) { ka[d0] = *(const LAS bf16x8*)(Kb + (2 * d0 + hi) * 1024 + r32 * 16); kc[d0] = *(const LAS bf16x8*)(Kb + (2 * d0 + hi) * 1024 + 512 + r32 * 16); }
            __builtin_amdgcn_sched_barrier(0);
#pragma unroll
            for (int d0 = 0; d0 < 4; ++d0) { p0 = __builtin_amdgcn_mfma_f32_32x32x16_bf16(ka[d0], qr[d0], p0, 0, 0, 0); p1 = __builtin_amdgcn_mfma_f32_32x32x16_bf16(kc[d0], qr[d0], p1, 0, 0, 0); }
            bf16x8 vfr[2][4];
#pragma unroll
            for (int d0 = 0; d0 < 2; ++d0)
#pragma unroll
                for (int ks = 0; ks < 4; ++ks) { const s16x4 lo = vtr(Vb + vb + d0 * 4096 + ks * 1024), hh = vtr(Vb + vb + d0 * 4096 + ks * 1024 + 512);
                    vfr[d0][ks] = (bf16x8){lo[0], lo[1], lo[2], lo[3], hh[0], hh[1], hh[2], hh[3]}; }
            __builtin_amdgcn_sched_barrier(0);
            bool live = true;
            const int kv0 = 64 * jb + 4 * hi;
            if (TYPE == 3) {
                float b0[16], b1[16];
#pragma unroll
                for (int r = 0; r < 16; ++r) { const int kv = kv0 + (r & 3) + 8 * (r >> 2);
                    const float e0 = fexp2(fminf(p0[r], 80.f)), e1 = fexp2(fminf(p1[r], 80.f));
                    const float m0 = frcp(1.0f + e0), m1 = frcp(1.0f + e1);
                    const bool ok0 = kv < qrel, ok1 = (kv + 32) < qrel;
                    b0[r] = ok0 ? e0 * m0 : 0.f; b1[r] = ok1 ? e1 * m1 : 0.f; p0[r] = ok0 ? m0 : 1.0f; p1[r] = ok1 ? m1 : 1.0f; }
                float gp[8], go[8], pp[8];
#pragma unroll
                for (int g = 0; g < 4; ++g) { gp[g] = (p0[4 * g] * p0[4 * g + 1]) * (p0[4 * g + 2] * p0[4 * g + 3]); gp[4 + g] = (p1[4 * g] * p1[4 * g + 1]) * (p1[4 * g + 2] * p1[4 * g + 3]); }
#pragma unroll
                for (int g = 0; g < 8; ++g) { const float oth = __shfl_xor(gp[g], 32); pp[g] = gp[g] * oth; go[g] = hi ? 1.0f : oth; }
                float sp = 1.0f;
#pragma unroll
                for (int g = 7; g >= 0; --g) { const float sg = sp * go[g] * carry;
                    if (g < 4) { const float c3 = p0[4 * g + 3], c2 = p0[4 * g + 2], c1 = p0[4 * g + 1];
                        p0[4 * g + 3] = b0[4 * g + 3] * sg; const float s2 = sg * c3; p0[4 * g + 2] = b0[4 * g + 2] * s2; const float s1 = s2 * c2; p0[4 * g + 1] = b0[4 * g + 1] * s1; p0[4 * g] = b0[4 * g] * (s1 * c1); }
                    else { const int q = g - 4; const float c3 = p1[4 * q + 3], c2 = p1[4 * q + 2], c1 = p1[4 * q + 1];
                        p1[4 * q + 3] = b1[4 * q + 3] * sg; const float s2 = sg * c3; p1[4 * q + 2] = b1[4 * q + 2] * s2; const float s1 = s2 * c2; p1[4 * q + 1] = b1[4 * q + 1] * s1; p1[4 * q] = b1[4 * q] * (s1 * c1); }
                    sp *= pp[g]; }
                carry *= sp;
            } else {
                if (TYPE == 2) {
                    const LAS f32x4* kbp = (const LAS f32x4*)(L + AT_KB + cur * 256);
#pragma unroll
                    for (int g = 0; g < 4; ++g) { const f32x4 a = kbp[2 * g + hi], c = kbp[8 + 2 * g + hi];
#pragma unroll
                        for (int e = 0; e < 4; ++e) { p0[4 * g + e] += a[e]; p1[4 * g + e] += c[e]; } }
                    if (jb >= 0) {
#pragma unroll
                        for (int r = 0; r < 16; ++r) { const int kv = kv0 + (r & 3) + 8 * (r >> 2); if (kv > qrel) p0[r] = NEG_INF; if (kv + 32 > qrel) p1[r] = NEG_INF; }
                    }
                } else {
#pragma unroll
                    for (int r = 0; r < 16; ++r) { const int d0_ = qrel - (kv0 + (r & 3) + 8 * (r >> 2)), d1_ = d0_ - 32;
                        const bool ok0 = (d0_ >= 0) && (d0_ < WINDOW), ok1 = (d1_ >= 0) && (d1_ < WINDOW);
                        const float t0 = BT[ok0 ? d0_ : 0], t1 = BT[ok1 ? d1_ : 0];
                        p0[r] = ok0 ? p0[r] + t0 : NEG_INF; p1[r] = ok1 ? p1[r] + t1 : NEG_INF; }
                }
                float rm = fmaxf(p0[0], p1[0]);
#pragma unroll
                for (int r = 1; r < 16; ++r) rm = fmaxf(rm, fmaxf(p0[r], p1[r]));
                { auto rr = __builtin_amdgcn_permlane32_swap(__float_as_uint(rm), __float_as_uint(rm), false, false); rm = fmaxf(__uint_as_float(rr[0]), __uint_as_float(rr[1])); }
                const float mn = fmaxf(mrun, rm);
                if (TYPE == 2) live = !__all(rm - mrun < -40.f);
                if (live) {
                if (__any(mn > mrun)) {
                    const float f = (mn > mrun) ? fexp2(mrun - mn) : 1.0f;
                    lsum *= f; mrun = mn;
                    if (hi == 0) wsf[r32] = f;
                    LDS_WAIT(); __builtin_amdgcn_wave_barrier();
#pragma unroll
                    for (int g = 0; g < 4; ++g) { const f32x4 fv = ((const LAS f32x4*)wsf)[2 * g + hi];
#pragma unroll
                        for (int e = 0; e < 4; ++e) { o[0][4 * g + e] *= fv[e]; o[1][4 * g + e] *= fv[e]; } }
                    LDS_WAIT(); __builtin_amdgcn_wave_barrier();
                }
                const float ms = (mrun == NEG_INF) ? 0.f : mrun;
                float ps = 0.f;
#pragma unroll
                for (int r = 0; r < 16; ++r) { p0[r] = fexp2(p0[r] - ms); p1[r] = fexp2(p1[r] - ms); ps += p0[r] + p1[r]; }
                lsum += ps;
                }
            }
            if (live) {
            bf16x8 pa[4];
#pragma unroll
            for (int ks = 0; ks < 4; ++ks) { v4u w;
                if (ks < 2) { w.x = cvtpk(p0[8 * ks], p0[8 * ks + 1]); w.y = cvtpk(p0[8 * ks + 2], p0[8 * ks + 3]); w.z = cvtpk(p0[8 * ks + 4], p0[8 * ks + 5]); w.w = cvtpk(p0[8 * ks + 6], p0[8 * ks + 7]); }
                else { const int k2 = ks - 2; w.x = cvtpk(p1[8 * k2], p1[8 * k2 + 1]); w.y = cvtpk(p1[8 * k2 + 2], p1[8 * k2 + 3]); w.z = cvtpk(p1[8 * k2 + 4], p1[8 * k2 + 5]); w.w = cvtpk(p1[8 * k2 + 6], p1[8 * k2 + 7]); }
                pa[ks] = __builtin_bit_cast(bf16x8, w); }
#pragma unroll
            for (int d0 = 0; d0 < 2; ++d0)
#pragma unroll
                for (int ks = 0; ks < 4; ++ks) o[d0] = __builtin_amdgcn_mfma_f32_32x32x16_bf16(pa[ks], vfr[d0][ks], o[d0], 0, 0, 0);
            }
        }
        if (TYPE == 2) {
            bool wdead = false;
            if (active && more) wdead = __all(qbound + kbnext - mrun < -40.f);
            if (lane == 0) deadf[cur * 8 + wid] = wdead ? 1u : 0u; }
        if (TYPE == 3) { const bool wdead = active && __all(carry < 2.3e-10f);
            if (lane == 0) deadf[cur * 8 + wid] = wdead ? 1u : 0u; }
        if (more) { *(LAS v4u*)(L + AT_K + (cur ^ 1) * 8192 + kl) = kreg; *(LAS v4u*)(L + AT_V + (cur ^ 1) * 8192 + vl) = vreg; if (TYPE == 2 && tid < 64) ((LAS float*)(L + AT_KB + (cur ^ 1) * 256))[tid] = kbreg; }
        __syncthreads();
        if (TYPE >= 2) { const v4u d0 = *(const LAS v4u*)(deadf + cur * 8), d1 = *(const LAS v4u*)(deadf + cur * 8 + 4);
            if ((d0.x & d0.y & d0.z & d0.w & d1.x & d1.y & d1.z & d1.w) != 0u) break; }
    }
    float inv[16];
    if (TYPE != 3) {
        { auto rr = __builtin_amdgcn_permlane32_swap(__float_as_uint(lsum), __float_as_uint(lsum), false, false); lsum = __uint_as_float(rr[0]) + __uint_as_float(rr[1]); }
        if (TYPE == 1) lsum += fexp2(F.sinks[l * NH + hq] * LOG2E - mrun);
        const float il = 1.0f / lsum;
        if (hi == 0) wsf[r32] = il;
        LDS_WAIT(); __builtin_amdgcn_wave_barrier();
#pragma unroll
        for (int g = 0; g < 4; ++g) { const f32x4 fv = ((const LAS f32x4*)wsf)[2 * g + hi]; inv[4 * g] = fv[0]; inv[4 * g + 1] = fv[1]; inv[4 * g + 2] = fv[2]; inv[4 * g + 3] = fv[3]; }
        LDS_WAIT(); __builtin_amdgcn_wave_barrier();
    } else {
#pragma unroll
        for (int r = 0; r < 16; ++r) inv[r] = 1.0f;
    }
    unsigned short gte[2][16];
    if (TYPE == 2) {
#pragma unroll
        for (int d0 = 0; d0 < 2; ++d0)
#pragma unroll
            for (int r = 0; r < 16; ++r) { const int q = (r & 3) + 8 * (r >> 2) + 4 * hi; const size_t mrow = rowb + q0 + qoff + q; gte[d0][r] = ((const GAS unsigned short*)F.P)[mrow * NIN + PC_G + hq * 64 + 32 * d0 + r32]; }
    }
#pragma unroll
    for (int d0 = 0; d0 < 2; ++d0)
#pragma unroll
        for (int r = 0; r < 16; ++r) { const int q = (r & 3) + 8 * (r >> 2) + 4 * hi; const size_t mrow = rowb + q0 + qoff + q; const int col = hq * 64 + 32 * d0 + r32;
            float val = o[d0][r] * inv[r];
            if (TYPE == 2) val *= frcp(1.0f + fexp2(-LOG2E * __builtin_bit_cast(float, (unsigned)gte[d0][r] << 16)));
            F.Y[mrow * DM + YOFF + col] = (bf16)f2bf(val); }
}

__device__ __forceinline__ void sparse_attn_query(const Frame& F, int m, LAS unsigned char* vch, const LAS float* TBA, const LAS int* idx) {
    int lane = F.lane; asm volatile("" : "+v"(lane));
    const int hh = lane & 15, kg = lane >> 4, t = m % SEQ, b = m / SEQ;
    const size_t rowb = (size_t)b * SEQ;
    const int nsel = (t + 1) < TOPK ? (t + 1) : TOPK, nch = (nsel + 63) >> 6;
    const bf16* qp = F.P + (size_t)m * NIN + PA_Q + (hh & 7) * 64 + 8 * kg;
    const bf16x8 qf0 = *(const GAS bf16x8*)qp, qf1 = *(const GAS bf16x8*)(qp + 32);
    float s[4][4][4];
#pragma unroll
    for (int cp = 0; cp < 2; ++cp) {
        if (2 * cp < nch) {
            bf16x8 kf[8][2];
#pragma unroll
            for (int bb = 0; bb < 8; ++bb) { const int keyA = idx[128 * cp + 16 * bb + hh];
                const bf16* kp = F.P + (rowb + keyA) * NIN + PA_K + 8 * kg;
                kf[bb][0] = *(const GAS bf16x8*)kp; kf[bb][1] = *(const GAS bf16x8*)(kp + 32); }
            __builtin_amdgcn_sched_barrier(0);
#pragma unroll
            for (int bb = 0; bb < 8; ++bb) { const int c = 2 * cp + (bb >> 2), blk = bb & 3, j0 = 64 * c + 16 * blk;
                f32x4 acc = {0.f, 0.f, 0.f, 0.f};
                acc = __builtin_amdgcn_mfma_f32_16x16x32_bf16(kf[bb][0], qf0, acc, 0, 0, 0); acc = __builtin_amdgcn_mfma_f32_16x16x32_bf16(kf[bb][1], qf1, acc, 0, 0, 0);
                const v4i id4 = *(const LAS v4i*)(idx + j0 + 4 * kg);
#pragma unroll
                for (int r = 0; r < 4; ++r) { const int j = j0 + 4 * kg + r; int dist = t - id4[r]; dist = dist < 0 ? 0 : (dist > 128 ? 128 : dist);
                    const float bias = TBA[dist * 8 + (hh & 7)];
                    s[c][blk][r] = (j < nsel) ? acc[r] + bias : NEG_INF; }
            }
        } else {
#pragma unroll
            for (int c = 2 * cp; c < 2 * cp + 2; ++c)
#pragma unroll
                for (int blk = 0; blk < 4; ++blk)
#pragma unroll
                    for (int r = 0; r < 4; ++r) s[c][blk][r] = NEG_INF;
        }
    }
    v4u xv[2][8];
#define SP_VLOAD(c_, X) do { const int keyV_ = idx[64 * (c_) + lane]; const bf16* vp_ = F.P + (rowb + keyV_) * NIN + PA_V; \
        _Pragma("unroll") for (int i_ = 0; i_ < 8; ++i_) X[i_] = *(const GAS v4u*)(vp_ + 8 * i_); } while (0)
    SP_VLOAD(0, xv[0]);
    if (1 < nch) SP_VLOAD(1, xv[1]);
    __builtin_amdgcn_sched_barrier(0);
    float mx = NEG_INF;
#pragma unroll
    for (int c = 0; c < 4; ++c)
#pragma unroll
        for (int blk = 0; blk < 4; ++blk)
#pragma unroll
            for (int r = 0; r < 4; ++r) mx = fmaxf(mx, s[c][blk][r]);
    mx = fmaxf(mx, __shfl_xor(mx, 16)); mx = fmaxf(mx, __shfl_xor(mx, 32));
    float sum = 0.f;
#pragma unroll
    for (int c = 0; c < 4; ++c)
#pragma unroll
        for (int blk = 0; blk < 4; ++blk)
#pragma unroll
            for (int r = 0; r < 4; ++r) { const float p = fexp2(s[c][blk][r] - mx); s[c][blk][r] = p; sum += p; }
    sum += __shfl_xor(sum, 16); sum += __shfl_xor(sum, 32);
    const float inv = 1.0f / sum;
    f32x4 oacc[4];
#pragma unroll
    for (int d = 0; d < 4; ++d) oacc[d] = (f32x4){0.f, 0.f, 0.f, 0.f};
    const int q4 = (lane & 15) >> 2, p4 = lane & 3;
#pragma unroll
    for (int c = 0; c < 4; ++c) {
        if (c < nch) {
#pragma unroll
            for (int i = 0; i < 8; ++i) *(LAS v4u*)(vch + (i >> 2) * 4096 + lane * 64 + (i & 3) * 16) = xv[c & 1][i];
            LDS_WAIT(); __builtin_amdgcn_wave_barrier();
            if (c + 2 < nch) SP_VLOAD(c + 2, xv[c & 1]);
            __builtin_amdgcn_sched_barrier(0);
#pragma unroll
            for (int kp = 0; kp < 2; ++kp) { v4u w; w.x = cvtpk(s[c][2 * kp][0], s[c][2 * kp][1]); w.y = cvtpk(s[c][2 * kp][2], s[c][2 * kp][3]); w.z = cvtpk(s[c][2 * kp + 1][0], s[c][2 * kp + 1][1]); w.w = cvtpk(s[c][2 * kp + 1][2], s[c][2 * kp + 1][3]);
                const bf16x8 pf = __builtin_bit_cast(bf16x8, w);
#pragma unroll
                for (int d = 0; d < 4; ++d) { const LAS unsigned char* a = vch + (d >> 1) * 4096 + (32 * kp + 4 * kg + q4) * 64 + ((d & 1) * 16 + 4 * p4) * 2;
                    const s16x4 lo = vtr(a), hv = vtr(a + 16 * 64);
                    const bf16x8 vf = {lo[0], lo[1], lo[2], lo[3], hv[0], hv[1], hv[2], hv[3]};
                    oacc[d] = __builtin_amdgcn_mfma_f32_16x16x32_bf16(vf, pf, oacc[d], 0, 0, 0); } }
            LDS_WAIT(); __builtin_amdgcn_wave_barrier();
        }
    }
#undef SP_VLOAD
    if (hh < 8) {
#pragma unroll
        for (int d = 0; d < 4; ++d) { v2u w; w.x = pk2(oacc[d][0] * inv, oacc[d][1] * inv); w.y = pk2(oacc[d][2] * inv, oacc[d][3] * inv);
            *(GAS v2u*)(F.Y + (size_t)m * DM + hh * 64 + 16 * d + 4 * kg) = w; }
    }
}

constexpr int CW_QUEUE = 8192;
constexpr int MIX_ITEMS = 2560;
template <unsigned EN> __device__ __forceinline__ void ph_attention(const Frame& F, int l, int qsel = 0) {
    LAS float* TBA = (LAS float*)(F.lds + AUX_OFF);
    for (int i = F.tid; i < 129 * 8; i += NTHREADS) { const int d = i >> 3, hq = i & 7; const int bk = d < 128 ? (int)kBucketLut[d] : 31; TBA[i] = F.rel_table[bk * 16 + hq] * LOG2E; }
    LAS unsigned* qslot = (LAS unsigned*)(F.lds + LDSCTL_OFF + 64);
    LAS unsigned char* wbuf = F.lds + RING_OFF + AT_SV + F.wave * 9472;
    LAS int* idxl = (LAS int*)(wbuf + 8192);
    __syncthreads();
#define MIX_FETCH(it) do { if (F.tid == 0) *qslot = __hip_atomic_fetch_add((unsigned*)(F.ctl + CW_QUEUE + 64 * l + 32 * qsel), 1u, __ATOMIC_RELAXED, __HIP_MEMORY_SCOPE_AGENT); \
        __syncthreads(); it = (int)*qslot; __syncthreads(); } while (0)
    for (int r = (int)blockIdx.x; r < 1024; r += F.G) {
        if (EN & 0x800) {
            const int b = r >> 9, blk = r & 511;
#pragma unroll 1
            for (int k = 0; k < 2; ++k) { const int u = 8 * blk + F.wave; const int t = k ? (SEQ - 1 - u) : u; const int m = b * SEQ + t;
                select_row(F, m, (LAS unsigned*)wbuf, idxl);
                LDS_WAIT(); __builtin_amdgcn_wave_barrier();
#ifdef PROBE_SEL2
                select_row(F, m, (LAS unsigned*)wbuf, idxl); LDS_WAIT(); __builtin_amdgcn_wave_barrier();
#endif
#ifdef PROBE_ATT2
                sparse_attn_query(F, m, wbuf, TBA, idxl); LDS_WAIT(); __builtin_amdgcn_wave_barrier();
#endif
                sparse_attn_query(F, m, wbuf, TBA, idxl);
                LDS_WAIT(); __builtin_amdgcn_wave_barrier(); }
        }
    }
    __syncthreads();
    int it; MIX_FETCH(it); it += 1024;
    while (it < 1536) { const int r = it & 511; if (EN & 0x100) dense_attn_unit<2>(F, l, (r & 15) >> 3, r & 7, 31 - (r >> 4)); MIX_FETCH(it); it += 1024; }
    while (it < 2048) { const int r = it & 511; if (EN & 0x200) dense_attn_unit<3>(F, l, (r & 15) >> 3, r & 7, 31 - (r >> 4)); MIX_FETCH(it); it += 1024; }
    while (it < MIX_ITEMS) { const int r = it & 511; if (EN & 0x400) dense_attn_unit<1>(F, l, r >> 8, 0, 255 - (r & 255)); MIX_FETCH(it); it += 1024; }
#undef MIX_FETCH
}


__device__ __forceinline__ const float* gp_(const float* p) {
#if defined(__HIP_DEVICE_COMPILE__)
    __builtin_assume(!__builtin_amdgcn_is_shared((const __attribute__((address_space(0))) void*)p)); __builtin_assume(!__builtin_amdgcn_is_private((const __attribute__((address_space(0))) void*)p));
#endif
    return p; }
#ifndef PROBE_KINDS
#define PROBE_KINDS 0u
#endif
#ifndef PROBE_ATT
#define PROBE_ATT 0xF00u
#endif
#ifndef PROBE_REPS
#define PROBE_REPS 1
#endif
#ifndef MK_ONE_LAUNCH
#define MK_ONE_LAUNCH 1
#endif
constexpr int PH_PER_LAYER = 14, N_PHASES = 1 + DEPTH * PH_PER_LAYER;
struct Args { const float* in[15]; float* out; unsigned char* ws; int ph_lo, ph_hi; };
struct ArgsG { const GAS float* in[15]; GAS float* out; GAS unsigned char* ws; int ph_lo, ph_hi; };
template <unsigned EN> __global__ void __launch_bounds__(NTHREADS, 2) trunk_fwd(Args args) {
    extern __shared__ __attribute__((aligned(16))) unsigned char lds[];
    LAS unsigned char* const ldsb = (LAS unsigned char*)lds;
    const int wave0 = __builtin_amdgcn_readfirstlane((int)threadIdx.x >> 6);
    for (int u = threadIdx.x; u < (LDS_BYTES - LDSCTL_OFF) / 4; u += NTHREADS) ((LAS unsigned*)(ldsb + LDSCTL_OFF))[u] = 0u;
    __syncthreads();
#if MK_ONE_LAUNCH
    constexpr int lo = 0, hi = N_PHASES;
#else
    const int lo = args.ph_lo, hi = args.ph_hi;
#endif
    XcdBarrier bar; bar.bar = (unsigned*)(args.ws + WS_CTL) + CW_BAR; bar.x = 0; bar.st = nullptr;
    if (hi - lo > 1) bar = xcd_barrier_post((unsigned*)(args.ws + WS_CTL) + CW_BAR, (volatile LAS unsigned*)(ldsb + LDSCTL_OFF));
#define GP(p) ((const float*)(p))
#define PH_BEGIN(k, kind) if (lo <= (k) && (k) < hi) { _Pragma("unroll 1") for (int rep_ = 0; rep_ < (((PROBE_KINDS >> (kind)) & 1u) ? PROBE_REPS : 1); ++rep_) { Frame F; { \
        const ArgsG* ka = (const ArgsG*)__builtin_amdgcn_kernarg_segment_ptr(); asm volatile("" : "+s"(ka)); \
        unsigned o_ = ~0u; asm volatile("" : "+s"(o_)); int t_ = wave0 * 64 + (int)__builtin_amdgcn_mbcnt_hi(o_, __builtin_amdgcn_mbcnt_lo(o_, 0u)); asm volatile("" : "+v"(t_)); \
        F.lds = ldsb; F.tid = t_; F.lane = t_ & 63; F.wave = wave0; int gw_ = blockIdx.x * NWAVES + wave0; asm volatile("" : "+s"(gw_)); F.G = gridDim.x; F.gw = gw_; F.NGW = F.G * NWAVES; \
        unsigned char* ws = (unsigned char*)ka->ws; F.ctl = (gu32*)(ws + WS_CTL);     \
        F.x = GP(ka->in[0]); F.c = GP(ka->in[1]); F.w_ada = GP(ka->in[2]); F.b_ada = GP(ka->in[3]); F.norm_g = GP(ka->in[4]); F.w_in = GP(ka->in[5]); F.qk_g = GP(ka->in[6]); F.forget_b = GP(ka->in[7]); \
        F.sinks = GP(ka->in[8]); F.rel_table = GP(ka->in[9]); F.group_g = GP(ka->in[10]); F.w_out = GP(ka->in[11]); F.w_gate = GP(ka->in[12]); F.w_up = GP(ka->in[13]); F.w_down = GP(ka->in[14]); F.out = (float*)ka->out; \
        F.MOD = (float*)(ws + WS_MOD); F.LF = (float*)(ws + WS_LF); F.KB2 = (float*)(ws + WS_KB2); F.SC = (unsigned short*)(ws + WS_SC); F.IDX = (int*)(ws + WS_IDX); \
        F.WGU = (bf16*)(ws + WS_WGU); F.WD = (bf16*)(ws + WS_WD); F.WIN = (bf16*)(ws + WS_WIN); F.WOUT = (bf16*)(ws + WS_WOUT); \
        F.H = (bf16*)(ws + WS_H); F.P = (bf16*)(ws + WS_P); F.Y = (bf16*)(ws + WS_Y); F.XB = (bf16*)(ws + WS_XB); }
#define PH_END(k) if ((k) + 1 < hi) xcd_barrier(bar); } }

    PH_BEGIN(0, 31) if (EN & 1) p0_prologue(F); PH_END(0)

    for (int l = 0; l < DEPTH; ++l) {
        const int base = 1 + l * PH_PER_LAYER;
        for (int sub = 0; sub < 3; ++sub) {
            if (sub != 1) {
                const int f = sub >> 1, pb = base + (f ? 11 : 0), ni = f ? 2 : 0, lf = l * 2 + f;
                PH_BEGIN(pb, (f ? 11 : 0)) if (EN & 2) { const float* modl = F.MOD + (size_t)l * BATCH * NMOD;
                    if (l == 0 && f == 0) ph_modulate<FFN_FP8, false>(F, F.x, F.norm_g + ((size_t)l * 3 + ni) * DM, modl + (3 * ni + 0) * DM, modl + (3 * ni + 1) * DM);
                    else ph_modulate<FFN_FP8, true>(F, F.XB, F.norm_g + ((size_t)l * 3 + ni) * DM, modl + (3 * ni + 0) * DM, modl + (3 * ni + 1) * DM); } PH_END(pb)
                PH_BEGIN(pb + 1, (f ? 12 : 1)) if (EN & 4) {
                    pg8::StaticOrder S; S.init(M, NGU, F.G, (int)blockIdx.x);
                    if constexpr (FFN_FP8) { pg8::Gemm g{F.H, (const bf16*)((const unsigned char*)F.WGU + (size_t)lf * NGU * DM), M, NGU, DM, 127, W8_E8M0};
                        pg8::EpiSwiGLU8 E{(unsigned char*)F.P, DFFP};
                        pg8::gemm_phase<pg8::EpiSwiGLU8, pg8::StaticOrder, true, true, true>(F.lds + RING_OFF, g, S, E, F.tid); }
                    else { pg8::Gemm g{F.H, F.WGU + (size_t)lf * NGU * DM, M, NGU, DM};
                        pg8::EpiSwiGLU E{F.P, DFF};
                        pg8::gemm_phase<pg8::EpiSwiGLU, pg8::StaticOrder, true, true>(F.lds + RING_OFF, g, S, E, F.tid); } } PH_END(pb + 1)
                PH_BEGIN(pb + 2, (f ? 13 : 2)) if (EN & 8) {
                    pg8::Gemm g{F.P, FFN_FP8 ? (const bf16*)((const unsigned char*)F.WD + (size_t)lf * DM * DFFP) : F.WD + (size_t)lf * DM * DFF, M, DM, DFF, 127, FFN_FP8 ? W8_E8M0 : 127, FFN_FP8 ? DFFP : 0, FFN_FP8 ? DFFP : 0}; pg8::StaticOrder S; S.init(M, DM, F.G, (int)blockIdx.x);
                    const float* modl = F.MOD + (size_t)l * BATCH * NMOD;
                    if (l == DEPTH - 1 && f == 1) { pg8::EpiResid<false> E{F.XB, rep_ ? (void*)F.SC : (void*)F.out, DM, modl + (3 * ni + 2) * DM, NMOD, SEQ, 0.5f};
                        pg8::gemm_phase<pg8::EpiResid<false>, pg8::StaticOrder, true, true, FFN_FP8>(F.lds + RING_OFF, g, S, E, F.tid); }
                    else { pg8::EpiResid<true> E{F.XB, rep_ ? (void*)F.SC : (void*)F.XB, DM, modl + (3 * ni + 2) * DM, NMOD, SEQ, 0.5f};
                        pg8::gemm_phase<pg8::EpiResid<true>, pg8::StaticOrder, true, true, FFN_FP8>(F.lds + RING_OFF, g, S, E, F.tid); } } PH_END(pb + 2)
            } else {
                PH_BEGIN(base + 3, 3) if (EN & 2) { const float* modl = F.MOD + (size_t)l * BATCH * NMOD; ph_modulate<false, true>(F, F.XB, F.norm_g + ((size_t)l * 3 + 1) * DM, modl + 3 * DM, modl + 4 * DM); } PH_END(base + 3)
                PH_BEGIN(base + 4, 4) if (EN & 16) {
                    pg8::Gemm g{F.H, F.WIN + (size_t)l * NIN * DM, M, NIN, DM}; pg8::StaticOrder S; S.init(M, NIN, F.G, (int)blockIdx.x);
                    pg8::EpiBf16 E{F.P, NIN};
                    pg8::gemm_phase<pg8::EpiBf16, pg8::StaticOrder, true, true>(F.lds + RING_OFF, g, S, E, F.tid); } PH_END(base + 4)
                PH_BEGIN(base + 6, 6) if (EN & 64) { ph_scan(F, l);
                    int par_ = (int)((blockIdx.x & 1u) ^ 1u); asm volatile("" : "+s"(par_));
                    _Pragma("unroll 1") for (int st_ = 0; st_ < 2; ++st_) { if ((st_ ^ par_) == 0) { if (EN & 32) ph_post(F, l); } else ph_idx_scores(F); } } PH_END(base + 6)
                PH_BEGIN(base + 8, 8) if (EN & 0xF00) { if (rep_ == 0) ph_attention<EN>(F, l, 0); else ph_attention<(PROBE_ATT)>(F, l, 1); } PH_END(base + 8)
                PH_BEGIN(base + 9, 9) if (EN & 0x1000) ph_gnorm(F, l); PH_END(base + 9)
                PH_BEGIN(base + 10, 10) if (EN & 0x2000) {
                    pg8::Gemm g{F.Y, F.WOUT + (size_t)l * DM * DM, M, DM, DM}; pg8::StaticOrder S; S.init(M, DM, F.G, (int)blockIdx.x);
                    const float* modl = F.MOD + (size_t)l * BATCH * NMOD;
                    pg8::EpiResid<true> E{F.XB, rep_ ? (void*)F.SC : (void*)F.XB, DM, modl + 5 * DM, NMOD, SEQ, 1.0f};
                    pg8::gemm_phase<pg8::EpiResid<true>, pg8::StaticOrder, true, true>(F.lds + RING_OFF, g, S, E, F.tid); } PH_END(base + 10)
            }
        }
    }
#undef PH_BEGIN
#undef PH_END
}

#ifndef EN_MASK
#define EN_MASK 0xFFFFu
#endif
template <unsigned EN> static int setup_kernel() {
    if (hipFuncSetAttribute((const void*)trunk_fwd<EN>, hipFuncAttributeMaxDynamicSharedMemorySize, LDS_BYTES) != hipSuccess) { fprintf(stderr, "kernel_launch: hipFuncSetAttribute failed\n"); return -1; }
    int per_cu = 0;
    if (hipOccupancyMaxActiveBlocksPerMultiprocessor(&per_cu, (const void*)trunk_fwd<EN>, NTHREADS, LDS_BYTES) != hipSuccess || per_cu < 1) { fprintf(stderr, "kernel_launch: occupancy query says %d\n", per_cu); }
    (void)hipGetLastError();
    return 0;
}
template <unsigned EN> static void launch_range(const Args& a0, int lo, int hi, int grid, hipStream_t stream) {
    Args a = a0; a.ph_lo = lo; a.ph_hi = hi;
    hipLaunchKernelGGL(trunk_fwd<EN>, dim3(grid), dim3(NTHREADS), LDS_BYTES, stream, a);
}
extern "C" void kernel_launch(void* const* d_in, const int* in_sizes, int n_in, void* d_out, int out_size, void* d_ws, size_t ws_size, hipStream_t stream) {
    static int grid = 0;
    if (grid == 0) {
        if (n_in != 15 || in_sizes[0] != M * DM || out_size != M * DM || ws_size < WS_END) {
            fprintf(stderr, "kernel_launch: shape/workspace mismatch: n_in %d in0 %d out %d ws %zu (need %zu); nothing launched\n", n_in, n_in > 0 ? in_sizes[0] : -1, out_size, ws_size, (size_t)WS_END); grid = -1; return; }
        int dev = 0, cus = 0;
        if (hipGetDevice(&dev) != hipSuccess || hipDeviceGetAttribute(&cus, hipDeviceAttributeMultiprocessorCount, dev) != hipSuccess) { grid = -1; return; }
#if MK_ONE_LAUNCH
        if (setup_kernel<EN_MASK>()) { grid = -1; return; }
#else
        if (setup_kernel<0x1u>() || setup_kernel<0x2u>() || setup_kernel<0x4u>() || setup_kernel<0x8u>() || setup_kernel<0x10u>() || setup_kernel<0x20u>() || setup_kernel<0x40u>() || setup_kernel<0x80u>() ||
            setup_kernel<0x100u>() || setup_kernel<0x200u>() || setup_kernel<0x400u>() || setup_kernel<0x800u>() || setup_kernel<0x1000u>() || setup_kernel<0x2000u>()) { grid = -1; return; }
#endif
        grid = cus;
    }
    if (grid < 0) return;
    if (hipMemsetAsync((char*)d_ws + WS_CTL, 0, CTL_ZERO_BYTES, stream) != hipSuccess) return;
    Args a{};
    for (int i = 0; i < 15; ++i) a.in[i] = (const float*)d_in[i];
    a.out = (float*)d_out; a.ws = (unsigned char*)d_ws;
#if MK_ONE_LAUNCH
    launch_range<EN_MASK>(a, 0, N_PHASES, grid, stream);
#else
    launch_range<0x1u>(a, 0, 1, grid, stream);
    for (int l = 0; l < DEPTH; ++l) { const int base = 1 + l * PH_PER_LAYER;
        for (int f = 0; f < 2; ++f) { const int pb = base + (f ? 11 : 0);
            if (f == 1) {
                launch_range<0x2u>(a, base + 3, base + 4, grid, stream); launch_range<0x10u>(a, base + 4, base + 5, grid, stream); launch_range<0x20u>(a, base + 5, base + 6, grid, stream);
                launch_range<0x40u>(a, base + 6, base + 7, grid, stream); launch_range<0x80u>(a, base + 7, base + 8, grid, stream);
                launch_range<0x100u>(a, base + 8, base + 9, grid, stream); launch_range<0x200u>(a, base + 8, base + 9, grid, stream); launch_range<0x400u>(a, base + 8, base + 9, grid, stream); launch_range<0x800u>(a, base + 8, base + 9, grid, stream);
                launch_range<0x1000u>(a, base + 9, base + 10, grid, stream); launch_range<0x2000u>(a, base + 10, base + 11, grid, stream);
            }
            launch_range<0x2u>(a, pb, pb + 1, grid, stream); launch_range<0x4u>(a, pb + 1, pb + 2, grid, stream); launch_range<0x8u>(a, pb + 2, pb + 3, grid, stream);
        }
    }
#endif
}
```

```cpp
#include <hip/hip_runtime.h>
#include <cstdio>
#include <cstdint>

namespace pg8 {
#define PG8_LAS __attribute__((address_space(3)))
typedef unsigned short bf16_t;
typedef short bf16x8 __attribute__((ext_vector_type(8)));
typedef float f32x4 __attribute__((ext_vector_type(4)));
typedef unsigned u32x4 __attribute__((ext_vector_type(4)));
constexpr int BM = 256, BK = 64, HALF = 128, HTB = HALF * BK * 2  , STAGE_BYTES = 8 * HTB, NXCD = 8, WGM = 8;

__host__ __device__ __forceinline__ int lds_byte(int r, int c) { const int st = (r >> 4) * 2 + (c >> 5), rr = r & 15, cc = c & 31, ob = rr * 64 + cc * 2; return st * 1024 + (ob ^ (((ob >> 9) & 1) << 5)); }
__host__ __device__ __forceinline__ void stage_rc(int b, int& R, int& C) { const int st = b / 1024, sb = b % 1024, swz = sb ^ (((sb >> 9) & 1) << 5); R = (st >> 1) * 16 + swz / 64; C = (st & 1) * 32 + (swz % 64) / 2; }
__host__ __device__ __forceinline__ int perm32(int rho) { const int n = rho >> 4, i = rho & 15; return 8 * (i >> 2) + 4 * n + (i & 3); }

struct Unit { int pm, pn; };
struct Gemm { const bf16_t* A; const bf16_t* Bt; int M, N, K; int scaleA = 127, scaleB = 127; int lda = 0, ldb = 0; int blk = 0; };
typedef int i32x8 __attribute__((ext_vector_type(8))); typedef int i32x4v __attribute__((ext_vector_type(4)));
__device__ __forceinline__ i32x8 pg8_cat(bf16x8 lo, bf16x8 hi) { return __builtin_shufflevector(__builtin_bit_cast(i32x4v, lo), __builtin_bit_cast(i32x4v, hi), 0, 1, 2, 3, 4, 5, 6, 7); }

struct StaticOrder {
    int nM, nN, nwg, G, c;
    __host__ __device__ void init(int M, int N, int G_, int c_) { nM = M / BM; nN = N / BM; nwg = nM * nN; G = G_; c = c_; }
    __host__ __device__ bool next(int i, Unit& u) const {
        const long L = (long)i * G + c; if (L >= nwg) return false;
        int wgid = (int)L; { const int q = nwg / NXCD, r = nwg % NXCD, xcd = wgid % NXCD, off = wgid / NXCD; wgid = (xcd < r ? xcd * (q + 1) : r * (q + 1) + (xcd - r) * q) + off; }
        const int nig = WGM * nN, gid = wgid / nig, fm = gid * WGM, gsz = (nM - fm) < WGM ? (nM - fm) : WGM;
        u.pm = fm + ((wgid % nig) % gsz); u.pn = (wgid % nig) / gsz; return true;
    }
    __device__ __forceinline__ void a_ready(const Unit&) const {}
    __device__ __forceinline__ void done(const Unit&) const {}
};
typedef __bf16 pg8_bfpair __attribute__((ext_vector_type(2))); typedef float pg8_f32pair __attribute__((ext_vector_type(2)));
__device__ __forceinline__ unsigned cvt_pk_bf16(float lo, float hi) { const pg8_f32pair v = {lo, hi}; return __builtin_bit_cast(unsigned, __builtin_convertvector(v, pg8_bfpair)); }
__device__ __forceinline__ unsigned cvt_pk_bf16_nv(float lo, float hi) { return cvt_pk_bf16(lo, hi); }
__device__ __forceinline__ const char* uptr(const char* p) { const unsigned long long v = (unsigned long long)p; const unsigned lo = __builtin_amdgcn_readfirstlane((unsigned)v), hi = __builtin_amdgcn_readfirstlane((unsigned)(v >> 32)); return (const char*)(((unsigned long long)hi << 32) | lo); }
struct EpiBf16 {
    static constexpr bool PERM = true, AFTER_DRAIN = false;
    bf16_t* O; int ldc;
    __device__ __forceinline__ void operator()(const f32x4 (&acc)[2][2][4][2], const Unit& u, int wr, int wc, int fr, int fq) const {
        asm volatile("" : "+v"(fr), "+v"(fq));
        const int row0 = u.pm * BM + wr * 64 + fr; const int col0 = u.pn * BM + wc * 32 + 8 * fq;
#pragma unroll
        for (int ai = 0; ai < 2; ++ai)
#pragma unroll
            for (int m = 0; m < 4; ++m) { bf16_t* rowp = O + (size_t)(row0 + ai * HALF + m * 16) * ldc + col0;
#pragma unroll
                for (int bj = 0; bj < 2; ++bj) { const f32x4 v0 = acc[ai][bj][m][0], v1 = acc[ai][bj][m][1];
                    u32x4 w; w.x = cvt_pk_bf16(v0[0], v0[1]); w.y = cvt_pk_bf16(v0[2], v0[3]); w.z = cvt_pk_bf16(v1[0], v1[1]); w.w = cvt_pk_bf16(v1[2], v1[3]);
                    *(u32x4*)(rowp + bj * HALF) = w; } }
    }
};
__device__ __forceinline__ float silu_mul(float g, float u) { return g * u * __builtin_amdgcn_rcpf(1.0f + __builtin_amdgcn_exp2f(-1.4426950408889634f * g)); }
struct EpiSwiGLU {
    static constexpr bool PERM = true, AFTER_DRAIN = false;
    bf16_t* O; int ldc;
    __device__ __forceinline__ void operator()(const f32x4 (&acc)[2][2][4][2], const Unit& u, int wr, int wc, int fr, int fq) const {
        asm volatile("" : "+v"(fr), "+v"(fq));
        const int row0 = u.pm * BM + wr * 64 + fr; const int col0 = u.pn * HALF + wc * 32 + 8 * fq;
#pragma unroll
        for (int ai = 0; ai < 2; ++ai)
#pragma unroll
            for (int m = 0; m < 4; ++m) { bf16_t* rowp = O + (size_t)(row0 + ai * HALF + m * 16) * ldc + col0;
                const f32x4 g0 = acc[ai][0][m][0], g1 = acc[ai][0][m][1], u0 = acc[ai][1][m][0], u1 = acc[ai][1][m][1];
                u32x4 w; w.x = cvt_pk_bf16(silu_mul(g0[0], u0[0]), silu_mul(g0[1], u0[1])); w.y = cvt_pk_bf16(silu_mul(g0[2], u0[2]), silu_mul(g0[3], u0[3]));
                w.z = cvt_pk_bf16(silu_mul(g1[0], u1[0]), silu_mul(g1[1], u1[1])); w.w = cvt_pk_bf16(silu_mul(g1[2], u1[2]), silu_mul(g1[3], u1[3]));
                *(u32x4*)rowp = w; }
    }
};
template <bool OUT16> struct EpiResid {
    static constexpr bool PERM = false, AFTER_DRAIN = false;
    const bf16_t* base; void* out; int ldc; const float* gv; int gstride; int rows_per_batch; float coef;
    __device__ __forceinline__ void operator()(const f32x4 (&acc)[2][2][4][2], const Unit& u, int wr, int wc, int fr, int fq) const {
        typedef unsigned v2u_ __attribute__((ext_vector_type(2)));
        asm volatile("" : "+v"(fr), "+v"(fq));
        const int row0 = u.pm * BM + wr * 64 + fr; const int col0 = u.pn * BM + wc * 32 + 4 * fq;
        const float* gvec = gv + (size_t)((u.pm * BM) / rows_per_batch) * gstride + col0;
        f32x4 gg[2][2];
#pragma unroll
        for (int bj = 0; bj < 2; ++bj)
#pragma unroll
            for (int n = 0; n < 2; ++n) gg[bj][n] = *(const f32x4*)(gvec + bj * HALF + n * 16) * coef;
#pragma unroll
        for (int ai = 0; ai < 2; ++ai) {
            v2u_ bwv[4][2][2];
#pragma unroll
            for (int m = 0; m < 4; ++m) { const size_t off = (size_t)(row0 + ai * HALF + m * 16) * ldc + col0;
#pragma unroll
                for (int bj = 0; bj < 2; ++bj)
#pragma unroll
                    for (int n = 0; n < 2; ++n) bwv[m][bj][n] = *(const v2u_*)(base + off + bj * HALF + n * 16); }
#pragma unroll
            for (int m = 0; m < 4; ++m) { const size_t off = (size_t)(row0 + ai * HALF + m * 16) * ldc + col0;
#pragma unroll
                for (int bj = 0; bj < 2; ++bj)
#pragma unroll
                    for (int n = 0; n < 2; ++n) { const v2u_ bw = bwv[m][bj][n];
                        f32x4 bs; bs[0] = __builtin_bit_cast(float, bw.x << 16); bs[1] = __builtin_bit_cast(float, bw.x & 0xffff0000u); bs[2] = __builtin_bit_cast(float, bw.y << 16); bs[3] = __builtin_bit_cast(float, bw.y & 0xffff0000u);
                        const f32x4 r = bs + gg[bj][n] * acc[ai][bj][m][n];
                        if constexpr (OUT16) { v2u_ w; w.x = cvt_pk_bf16_nv(r[0], r[1]); w.y = cvt_pk_bf16_nv(r[2], r[3]); *(v2u_*)((bf16_t*)out + off + bj * HALF + n * 16) = w; }
                        else *(f32x4*)((float*)out + off + bj * HALF + n * 16) = r; } }
        }
    }
};
__device__ __forceinline__ unsigned pack_fp8x4(float a, float b, float c, float d) {
    a = fminf(fmaxf(a, -448.f), 448.f); b = fminf(fmaxf(b, -448.f), 448.f); c = fminf(fmaxf(c, -448.f), 448.f); d = fminf(fmaxf(d, -448.f), 448.f);
    int w = 0; w = __builtin_amdgcn_cvt_pk_fp8_f32(a, b, w, false); w = __builtin_amdgcn_cvt_pk_fp8_f32(c, d, w, true); return (unsigned)w; }
struct EpiSwiGLU8 {
    static constexpr bool PERM = true, AFTER_DRAIN = false;
    unsigned char* O; int ldc;
    __device__ __forceinline__ void operator()(const f32x4 (&acc)[2][2][4][2], const Unit& u, int wr, int wc, int fr, int fq) const {
        asm volatile("" : "+v"(fr), "+v"(fq));
        const int row0 = u.pm * BM + wr * 64 + fr; const int col0 = u.pn * HALF + wc * 32 + 8 * fq;
#pragma unroll
        for (int ai = 0; ai < 2; ++ai)
#pragma unroll
            for (int m = 0; m < 4; ++m) { unsigned char* rowp = O + (size_t)(row0 + ai * HALF + m * 16) * ldc + col0;
                const f32x4 g0 = acc[ai][0][m][0], g1 = acc[ai][0][m][1], u0 = acc[ai][1][m][0], u1 = acc[ai][1][m][1];
                typedef unsigned u32x2v __attribute__((ext_vector_type(2))); u32x2v w;
                w.x = pack_fp8x4(silu_mul(g0[0], u0[0]), silu_mul(g0[1], u0[1]), silu_mul(g0[2], u0[2]), silu_mul(g0[3], u0[3]));
                w.y = pack_fp8x4(silu_mul(g1[0], u1[0]), silu_mul(g1[1], u1[1]), silu_mul(g1[2], u1[2]), silu_mul(g1[3], u1[3]));
                *(u32x2v*)rowp = w; }
    }
};
template <class Epi, class Sched, bool ALIGN_EPI = false, bool SP2 = false, bool FP8 = false>
__device__ __forceinline__ void gemm_phase(PG8_LAS unsigned char* lds, const Gemm g, const Sched& S, const Epi& E, int tid_in) {
    int tid_ = tid_in; asm volatile("" : "+v"(tid_));
    const int tid = tid_, wid = __builtin_amdgcn_readfirstlane(tid >> 6), lane = tid & 63, wr = wid >> 2, wc = wid & 3, fr = lane & 15, fq = lane >> 4;
    const int K = g.K, nt = FP8 ? K / (2 * BK) : K / BK;
    const int pitchA = g.blk ? 2 * BK : g.lda ? g.lda : (FP8 ? K : 2 * K), pitchB = g.blk ? 2 * BK : g.ldb ? g.ldb : (FP8 ? K : 2 * K);
    unsigned voffA[2], voffB[2];
#pragma unroll
    for (int i = 0; i < 2; ++i) { int R, C; stage_rc(tid * 16 + i * 8192, R, C); const int Rb = Epi::PERM ? ((R & ~31) + perm32(R & 31)) : R;
        voffA[i] = (unsigned)(R * pitchA + C * 2); voffB[i] = (unsigned)(Rb * pitchB + C * 2); }
    const size_t kstep = g.blk ? (size_t)(512 * BK) : (size_t)(BK * 2);
    const size_t hstepA = (size_t)HALF * pitchA, hstepB = (size_t)HALF * pitchB;
    const size_t tstepA = g.blk ? (size_t)(FP8 ? K / (2 * BK) : K / BK) * kstep : 2 * hstepA, tstepB = g.blk ? tstepA : 2 * hstepB;
    const unsigned ldsw = (unsigned)wid * 1024u;
    const int aoff = lds_byte(wr * 64 + fr, fq * 8), boff = lds_byte(wc * 32 + fr, fq * 8);
    PG8_LAS unsigned char* abase = lds + aoff; PG8_LAS unsigned char* bbase = lds + boff + 4 * HTB;
#define PG8_SA(b, h) (((b) * 2 + (h)) * HTB)
#define PG8_SB(b, h) ((4 + (b) * 2 + (h)) * HTB)
#define PG8_STAGE(bufoff, gbase, voff) do { _Pragma("unroll") for (int _i = 0; _i < 2; ++_i) \
        __builtin_amdgcn_global_load_lds((const unsigned*)((const char*)(gbase) + (voff)[_i]), (PG8_LAS unsigned*)(lds + (bufoff) + ldsw + _i * 8192), 16, 0, 0); } while (0)
#define PG8_RDA(off) (*(const PG8_LAS bf16x8*)(abase + (off)))
#define PG8_RDB(off) (*(const PG8_LAS bf16x8*)(bbase + ((off) - 4 * HTB)))
#define PG8_LDA(dst, b, h) do { if constexpr (FP8) { _Pragma("unroll") for (int m = 0; m < 4; ++m) dst##8[m] = pg8_cat(PG8_RDA(PG8_SA(b, h) + m * 2048), PG8_RDA(PG8_SA(b, h) + m * 2048 + 1024)); } \
    else { _Pragma("unroll") for (int m = 0; m < 4; ++m) _Pragma("unroll") for (int k = 0; k < 2; ++k) dst[m][k] = PG8_RDA(PG8_SA(b, h) + m * 2048 + k * 1024); } } while (0)
#define PG8_LDB(dst, b, h) do { if constexpr (FP8) { _Pragma("unroll") for (int n = 0; n < 2; ++n) dst##8[n] = pg8_cat(PG8_RDB(PG8_SB(b, h) + n * 2048), PG8_RDB(PG8_SB(b, h) + n * 2048 + 1024)); } \
    else { _Pragma("unroll") for (int n = 0; n < 2; ++n) _Pragma("unroll") for (int k = 0; k < 2; ++k) dst[n][k] = PG8_RDB(PG8_SB(b, h) + n * 2048 + k * 1024); } } while (0)
#define PG8_MMA(ai, bj, At, Bt) do { __builtin_amdgcn_s_setprio(1); if constexpr (FP8) { \
        _Pragma("unroll") for (int m = 0; m < 4; ++m) _Pragma("unroll") for (int n = 0; n < 2; ++n) \
            asm volatile("v_mfma_scale_f32_16x16x128_f8f6f4 %0, %1, %2, %0, %3, %4 op_sel_hi:[0,0,0]" : "+v"(acc[ai][bj][m][n]) : "v"(Bt##8[n]), "v"(At##8[m]), "v"(sclB), "v"(sclA)); \
        } else { _Pragma("unroll") for (int m = 0; m < 4; ++m) _Pragma("unroll") for (int n = 0; n < 2; ++n) _Pragma("unroll") for (int k = 0; k < 2; ++k) \
        acc[ai][bj][m][n] = __builtin_amdgcn_mfma_f32_16x16x32_bf16(Bt[n][k], At[m][k], acc[ai][bj][m][n], 0, 0, 0); } __builtin_amdgcn_s_setprio(0); } while (0)
#define PG8_WAIT_V(n) asm volatile("s_waitcnt vmcnt(" #n ")" ::: "memory")
#define PG8_WAIT_L(n) asm volatile("s_waitcnt lgkmcnt(" #n ")" ::: "memory")
#define PG8_BAR __builtin_amdgcn_s_barrier()
#define PG8_SCHED __builtin_amdgcn_sched_barrier(0)
    Unit cur, nxt; int ui = 0;
    if (!S.next(0, cur)) return;
    f32x4 acc[2][2][4][2];
#pragma unroll
    for (int a = 0; a < 2; ++a)
#pragma unroll
        for (int b = 0; b < 2; ++b)
#pragma unroll
            for (int m = 0; m < 4; ++m)
#pragma unroll
                for (int n = 0; n < 2; ++n) acc[a][b][m][n] = (f32x4){0.f, 0.f, 0.f, 0.f};
    const int sclA = g.scaleA, sclB = g.scaleB;
    bf16x8 At[4][2], B0[2][2], B1[2][2]; i32x8 At8[4], B08[2], B18[2];
    const char* cA = uptr((const char*)g.A + (size_t)cur.pm * tstepA); const char* cB = uptr((const char*)g.Bt + (size_t)cur.pn * tstepB);
    S.a_ready(cur);
    if constexpr (SP2) {
        PG8_STAGE(PG8_SB(0, 0), cB, voffB); PG8_STAGE(PG8_SB(0, 1), cB + hstepB, voffB); PG8_STAGE(PG8_SA(0, 0), cA, voffA); PG8_STAGE(PG8_SA(0, 1), cA + hstepA, voffA);
        if (wr == 1) PG8_BAR;
        PG8_WAIT_V(2); PG8_BAR;
        PG8_STAGE(PG8_SB(1, 0), cB + kstep, voffB); PG8_STAGE(PG8_SA(1, 0), cA + kstep, voffA); PG8_STAGE(PG8_SB(1, 1), cB + hstepB + kstep, voffB);
        PG8_WAIT_V(6); PG8_BAR;
    } else {
        PG8_STAGE(PG8_SB(0, 0), cB, voffB); PG8_STAGE(PG8_SA(0, 0), cA, voffA); PG8_STAGE(PG8_SB(0, 1), cB + hstepB, voffB); PG8_STAGE(PG8_SA(0, 1), cA + hstepA, voffA);
        if (wr == 1) PG8_BAR;
        PG8_WAIT_V(4); PG8_BAR;
        PG8_STAGE(PG8_SB(1, 0), cB + kstep, voffB); PG8_STAGE(PG8_SA(1, 0), cA + kstep, voffA); PG8_STAGE(PG8_SB(1, 1), cB + hstepB + kstep, voffB);
        PG8_WAIT_V(6); PG8_BAR;
    }
    for (;;) {
        const bool has_next = S.next(ui + 1, nxt);
        const char* nA = uptr(has_next ? (const char*)g.A + (size_t)nxt.pm * tstepA : cA); const char* nB = uptr(has_next ? (const char*)g.Bt + (size_t)nxt.pn * tstepB : cB);
        for (int t = 0; t < nt; t += 2) {
            asm volatile("" : "+v"(abase), "+v"(bbase));
            const bool last = (t == nt - 2);
            const char* a1 = cA + (size_t)(t + 1) * kstep;
            const char* a2 = uptr(last ? nA : cA + (size_t)(t + 2) * kstep); const char* b2 = uptr(last ? nB : cB + (size_t)(t + 2) * kstep);
            const char* a3 = a2 + kstep; const char* b3 = b2 + kstep;
            if (last && has_next) S.a_ready(nxt);
            if constexpr (SP2) {
            PG8_LDB(B0, 0, 0); PG8_LDB(B1, 0, 1); PG8_SCHED; PG8_LDA(At, 0, 0); PG8_STAGE(PG8_SA(1, 1), a1 + hstepA, voffA);
            PG8_WAIT_V(8); PG8_WAIT_L(0); PG8_BAR; PG8_MMA(0, 0, At, B0); PG8_MMA(0, 1, At, B1); PG8_BAR; PG8_SCHED;
            PG8_LDA(At, 0, 1); PG8_STAGE(PG8_SB(0, 0), b2, voffB); PG8_STAGE(PG8_SB(0, 1), b2 + hstepB, voffB); PG8_STAGE(PG8_SA(0, 0), a2, voffA);
            PG8_WAIT_V(8); PG8_WAIT_L(0); PG8_BAR; PG8_MMA(1, 0, At, B0); PG8_MMA(1, 1, At, B1); PG8_BAR; PG8_SCHED;
            PG8_LDB(B0, 1, 0); PG8_LDB(B1, 1, 1); PG8_SCHED; PG8_LDA(At, 1, 0); PG8_STAGE(PG8_SA(0, 1), a2 + hstepA, voffA);
            PG8_WAIT_V(8); PG8_WAIT_L(0); PG8_BAR; PG8_MMA(0, 0, At, B0); PG8_MMA(0, 1, At, B1); PG8_BAR; PG8_SCHED;
            PG8_LDA(At, 1, 1); PG8_STAGE(PG8_SB(1, 0), b3, voffB); PG8_STAGE(PG8_SB(1, 1), b3 + hstepB, voffB); PG8_STAGE(PG8_SA(1, 0), a3, voffA);
            PG8_WAIT_V(8); PG8_WAIT_L(0); PG8_BAR; PG8_MMA(1, 0, At, B0); PG8_MMA(1, 1, At, B1); PG8_BAR; PG8_SCHED;
            } else {
            PG8_LDB(B0, 0, 0); PG8_SCHED; PG8_LDA(At, 0, 0); PG8_STAGE(PG8_SA(1, 1), a1 + hstepA, voffA);
            PG8_WAIT_L(8); PG8_BAR; PG8_WAIT_L(0); PG8_MMA(0, 0, At, B0); PG8_BAR; PG8_SCHED;
            PG8_LDB(B1, 0, 1); PG8_STAGE(PG8_SB(0, 0), b2, voffB);
            PG8_BAR; PG8_WAIT_L(0); PG8_MMA(0, 1, At, B1); PG8_BAR;
            PG8_LDA(At, 0, 1); PG8_STAGE(PG8_SA(0, 0), a2, voffA);
            PG8_BAR; PG8_WAIT_L(0); PG8_MMA(1, 0, At, B0); PG8_BAR; PG8_SCHED;
            PG8_STAGE(PG8_SB(0, 1), b2 + hstepB, voffB);
            PG8_WAIT_V(6); PG8_BAR; PG8_MMA(1, 1, At, B1); PG8_BAR;
            PG8_LDB(B0, 1, 0); PG8_SCHED; PG8_LDA(At, 1, 0); PG8_STAGE(PG8_SA(0, 1), a2 + hstepA, voffA);
            PG8_WAIT_L(8); PG8_BAR; PG8_WAIT_L(0); PG8_MMA(0, 0, At, B0); PG8_BAR; PG8_SCHED;
            PG8_LDB(B1, 1, 1); PG8_STAGE(PG8_SB(1, 0), b3, voffB);
            PG8_BAR; PG8_WAIT_L(0); PG8_MMA(0, 1, At, B1); PG8_BAR;
            PG8_LDA(At, 1, 1); PG8_STAGE(PG8_SA(1, 0), a3, voffA);
            PG8_BAR; PG8_WAIT_L(0); PG8_MMA(1, 0, At, B0); PG8_BAR; PG8_SCHED;
            PG8_STAGE(PG8_SB(1, 1), b3 + hstepB, voffB);
            PG8_WAIT_V(6); PG8_BAR; PG8_MMA(1, 1, At, B1); PG8_BAR;
            }
        }
        if constexpr (FP8) asm volatile("s_nop 15\n\ts_nop 7" ::: "memory");
        if constexpr (ALIGN_EPI) { if (wr == 0) PG8_BAR; }
        if constexpr (!Epi::AFTER_DRAIN) { E(acc, cur, wr, wc, fr, fq); S.done(cur); }
        if (!has_next) break;
#pragma unroll
        for (int a = 0; a < 2; ++a)
#pragma unroll
            for (int b = 0; b < 2; ++b)
#pragma unroll
                for (int m = 0; m < 4; ++m)
#pragma unroll
                    for (int n = 0; n < 2; ++n) acc[a][b][m][n] = (f32x4){0.f, 0.f, 0.f, 0.f};
        cur = nxt; cA = nA; cB = nB; ++ui;
        if constexpr (ALIGN_EPI) { if (wr == 1) PG8_BAR; }
    }
    PG8_WAIT_V(0);
    if constexpr (!ALIGN_EPI) { if (wr == 0) PG8_BAR; }
    PG8_BAR;
    if constexpr (Epi::AFTER_DRAIN) { E.fused(acc, cur, wr, wc, fr, fq, lds, wid, lane); S.done(cur); }
#undef PG8_SA
#undef PG8_SB
#undef PG8_STAGE
#undef PG8_RDA
#undef PG8_RDB
#undef PG8_LDA
#undef PG8_LDB
#undef PG8_MMA
#undef PG8_WAIT_V
#undef PG8_WAIT_L
#undef PG8_BAR
#undef PG8_SCHED
}
}

#ifndef MK_FFN_FP8
#define MK_FFN_FP8 1
#endif
constexpr bool FFN_FP8 = MK_FFN_FP8;
constexpr int NWAVES = 8, NTHREADS = NWAVES * 64;
constexpr int BATCH = 2, SEQ = 8192, M = BATCH * SEQ, DM = 2048, DEPTH = 4, DFF = 5632, NGU = 2 * DFF, INC = 5976, NIN = 6144, NMOD = 9 * DM;
constexpr int DFFP = DFF + 128;
constexpr int NH = 8, HD = 64, GWID = 512, TOPK = 256, WINDOW = 128;
constexpr int PA_Q = 0, PA_K = 512, PA_V = 576, PA_IQ = 640, PA_IK = 1664, PB_Q = 1728, PB_K = 2240, PB_V = 2304, PC_Q = 2368, PC_K = 2880, PC_V = 3392, PC_G = 3904,
              PD_Q = 4416, PD_K = 4928, PD_V = 5440, PA_IW = 5952, PC_F = 5968;
constexpr float RMS_EPS = 1e-6f, LOG2E = 1.4426950408889634f, QSCALE = 0.125f * LOG2E;

constexpr size_t MiB = 1u << 20;
constexpr size_t WS_CTL = 0, CTL_ZERO_BYTES = 64 * 1024;
constexpr size_t WS_MOD = 1 * MiB;
constexpr size_t WS_LF = 2 * MiB;
constexpr size_t WS_KB2 = 3 * MiB;
constexpr size_t WS_WGU = 4 * MiB;
constexpr size_t SZ_WGU = (size_t)NGU * DM * 2;
constexpr size_t WS_WD = WS_WGU + 8 * SZ_WGU;
constexpr size_t SZ_WD = (size_t)DM * DFF * 2;
constexpr size_t WS_WIN = WS_WD + 8 * SZ_WD;
constexpr size_t SZ_WIN = (size_t)NIN * DM * 2;
constexpr size_t WS_WOUT = WS_WIN + 4 * SZ_WIN;
constexpr size_t SZ_WOUT = (size_t)DM * DM * 2;
constexpr size_t WS_H = WS_WOUT + 4 * SZ_WOUT;
constexpr size_t WS_P = WS_H + (size_t)M * DM * 2;
constexpr size_t WS_Y = WS_P + (size_t)M * NIN * 2;
constexpr size_t WS_IDX = WS_Y + (size_t)M * DM * 2;
constexpr size_t WS_SC = WS_IDX + (size_t)M * TOPK * 4;
constexpr size_t WS_XB = WS_SC + (size_t)BATCH * SEQ * SEQ * 2;
constexpr size_t WS_END = WS_XB + (size_t)M * DM * 2;
static_assert(WS_WGU % MiB == 0 && WS_WD % MiB == 0 && WS_WIN % MiB == 0 && WS_WOUT % MiB == 0 && WS_H % MiB == 0 && WS_P % MiB == 0 && WS_Y % MiB == 0 && WS_IDX % MiB == 0 && WS_SC % MiB == 0, "d_ws map alignment");
constexpr int CW_BAR = 4096;

constexpr int RING_OFF = 0, RING_BYTES = 131072;
constexpr int AUX_OFF = RING_BYTES, AUX_BYTES = 16384;
constexpr int LDSCTL_OFF = AUX_OFF + AUX_BYTES;
constexpr int LDS_BYTES = LDSCTL_OFF + 256;

#define GAS __attribute__((address_space(1)))
#define LAS __attribute__((address_space(3)))
typedef unsigned short bf16;
typedef unsigned v4u __attribute__((ext_vector_type(4)));
typedef unsigned v2u __attribute__((ext_vector_type(2)));
typedef int v4i __attribute__((ext_vector_type(4)));
typedef float f32x4 __attribute__((ext_vector_type(4)));
typedef float f32x16 __attribute__((ext_vector_type(16)));
typedef short bf16x8 __attribute__((ext_vector_type(8)));
typedef short s16x4 __attribute__((ext_vector_type(4)));
typedef GAS unsigned gu32;
#define RLX_AGENT __ATOMIC_RELAXED, __HIP_MEMORY_SCOPE_AGENT
#define LDS_WAIT() asm volatile("s_waitcnt lgkmcnt(0)" ::: "memory")
#define VM_WAIT() asm volatile("s_waitcnt vmcnt(0)" ::: "memory")
__device__ __forceinline__ unsigned f2bf(float f) { unsigned u = __builtin_bit_cast(unsigned, f); return (u + 0x7fffu + ((u >> 16) & 1u)) >> 16; }
__device__ __forceinline__ unsigned pk2(float lo, float hi) { return f2bf(lo) | (f2bf(hi) << 16); }
__device__ __forceinline__ float bf_lo(unsigned w) { return __builtin_bit_cast(float, w << 16); }
__device__ __forceinline__ float bf_hi(unsigned w) { return __builtin_bit_cast(float, w & 0xffff0000u); }
__device__ __forceinline__ float bf2f(bf16 h) { return __builtin_bit_cast(float, (unsigned)h << 16); }
__device__ __forceinline__ float wave_sum(float v) {
#pragma unroll
    for (int o = 1; o < 64; o <<= 1) v += __shfl_xor(v, o);
    return v;
}
__device__ __forceinline__ float fexp2(float x) { return __builtin_amdgcn_exp2f(x); }
__device__ __forceinline__ float frcp(float x) { return __builtin_amdgcn_rcpf(x); }
__device__ const unsigned char kBucketLut[128] = {0, 1, 2, 3, 4, 5, 6, 7, 8, 9, 10, 11, 12, 13, 14, 15, 16, 16, 16, 17, 17, 18, 18, 18, 19, 19, 19, 20, 20, 20, 20, 21, 21, 21, 21, 22, 22, 22, 22, 22,
    23, 23, 23, 23, 23, 23, 24, 24, 24, 24, 24, 24, 25, 25, 25, 25, 25, 25, 25, 26, 26, 26, 26, 26, 26, 26, 26, 27, 27, 27, 27, 27, 27, 27, 27, 27, 27, 28, 28, 28, 28, 28, 28, 28, 28, 28, 28,
    29, 29, 29, 29, 29, 29, 29, 29, 29, 29, 29, 29, 30, 30, 30, 30, 30, 30, 30, 30, 30, 30, 30, 30, 30, 30, 31, 31, 31, 31, 31, 31, 31, 31, 31, 31, 31, 31, 31, 31, 31};

#define XB_TMO      128
#define XB_XCNT(j)  (256  + 64 * (j))
#define XB_XSUB(j)  (1280 + 64 * (j))
#define XB_XGEN(j)  (2304 + 64 * (j))
#define XB_TOP      3328
#define XB_TOPGEN   3392
#define XCD_BAR_WORDS 3456
#define XB_SPIN_CAP (1u << 18)

__device__ __forceinline__ unsigned xb_ld(unsigned* p)              { return __hip_atomic_load((GAS unsigned*)p, __ATOMIC_RELAXED, __HIP_MEMORY_SCOPE_AGENT); }
__device__ __forceinline__ unsigned xb_add(unsigned* p, unsigned v) { return __hip_atomic_fetch_add((GAS unsigned*)p, v, __ATOMIC_RELAXED, __HIP_MEMORY_SCOPE_AGENT); }
__device__ __forceinline__ unsigned xb_xcc_id() { return (unsigned)__builtin_amdgcn_s_getreg((3 << 11) | 20) & 0xFu; }
#define XB_SPIN(cond, bar) do { unsigned _sp = 0; while (cond) { __builtin_amdgcn_s_sleep(1); \
    if ((++_sp & 255u) == 0u) { if (xb_ld(&(bar)[XB_TMO])) break; if (_sp > XB_SPIN_CAP) { xb_add(&(bar)[XB_TMO], 1u); break; } } } } while (0)

struct XcdBarrier {
    unsigned* bar; unsigned x;
    volatile LAS unsigned* st;
};

__device__ __forceinline__ XcdBarrier xcd_barrier_post(unsigned* bar, volatile LAS unsigned* st) {
    XcdBarrier b; b.bar = bar; b.x = xb_xcc_id(); b.st = st;
    if (threadIdx.x == 0) (void)xb_add(&bar[XB_XCNT(b.x)], 1u);
    return b;
}
__device__ __forceinline__ void xcd_barrier_complete(unsigned* bar, unsigned x, unsigned& nloc, unsigned& nx) {
    const unsigned G = gridDim.x * gridDim.y * gridDim.z;
    unsigned sum, cnt, mine, sp = 0u;
    for (;;) {
        sum = 0u; cnt = 0u; mine = 0u;
#pragma unroll
        for (unsigned j = 0; j < 16; ++j) { const unsigned c = xb_ld(&bar[XB_XCNT(j)]); sum += c; cnt += (c > 0u) ? 1u : 0u; mine = (j == x) ? c : mine; }
        if (sum == G) break;
        __builtin_amdgcn_s_sleep(1);
        if ((++sp & 255u) == 0u) { if (xb_ld(&bar[XB_TMO])) break; if (sp > XB_SPIN_CAP) { xb_add(&bar[XB_TMO], 1u); break; } }
    }
    nloc = mine > 0u ? mine : 1u; nx = cnt > 0u ? cnt : 1u;
}

__device__ __forceinline__ void xcd_barrier(const XcdBarrier& b) {
    asm volatile("s_waitcnt vmcnt(0)" ::: "memory");
    __syncthreads();
    if (threadIdx.x == 0) {
        unsigned* bar = b.bar; asm volatile("" : "+s"(bar));
        __builtin_amdgcn_s_waitcnt(0);
        unsigned nloc = b.st[0], nx = b.st[1];
        if (nloc == 0u) { xcd_barrier_complete(bar, b.x, nloc, nx); b.st[0] = nloc; b.st[1] = nx; }
        const unsigned old = xb_add(&bar[XB_XSUB(b.x)], 1u);
        const unsigned gen = old / nloc;
        if (old + 1u == (gen + 1u) * nloc) {
            __builtin_amdgcn_fence(__ATOMIC_RELEASE, "agent");
            asm volatile("s_waitcnt vmcnt(0)" ::: "memory");
            const unsigned og = xb_add(&bar[XB_TOP], 1u);
            const unsigned tg = og / nx;
            if (og + 1u == (tg + 1u) * nx) xb_add(&bar[XB_TOPGEN], 1u);
            else XB_SPIN(xb_ld(&bar[XB_TOPGEN]) == tg, bar);
            __builtin_amdgcn_fence(__ATOMIC_ACQUIRE, "agent");
            xb_add(&bar[XB_XGEN(b.x)], 1u);
            asm volatile("s_waitcnt vmcnt(0)" ::: "memory");
        } else {
            XB_SPIN(xb_ld(&bar[XB_XGEN(b.x)]) == gen, bar);
            __builtin_amdgcn_fence(__ATOMIC_ACQUIRE, "agent");
            asm volatile("s_waitcnt vmcnt(0)" ::: "memory");
        }
    }
    __syncthreads();
}

struct Frame {
    LAS unsigned char* lds;
    gu32* ctl;
    int tid, lane, wave, G, gw, NGW;
    const float *x, *c, *w_ada, *b_ada, *norm_g, *w_in, *qk_g, *forget_b, *sinks, *rel_table, *group_g, *w_out, *w_gate, *w_up, *w_down;
    float* out;
    float *MOD, *LF, *KB2; unsigned short* SC; int* IDX;
    bf16 *WGU, *WD, *WIN, *WOUT, *H, *P, *Y, *XB;
};

template <int MAP> __device__ __forceinline__ int w_rowmap(int n) {
    if (MAP == 1) return 256 * (n >> 7) + (n & 127);
    if (MAP == 2) return 256 * (n >> 7) + 128 + (n & 127);
    if (MAP == 3) { if (n < 1728) return n; if (n < 1744) return PA_IW + (n - 1728); if (n < 3920) return n - 16; if (n < 3928) return PC_F + (n - 3920); return n - 24; }
    return n;
}
template <int MAP> __device__ __forceinline__ void p0_transpose_item(const float* W, int K, int N, bf16* WT, LAS unsigned* T, int item, int lane) {
    const int nblk = (N + 63) / 64, kb = item / nblk, nb = item % nblk, k0 = 64 * kb, n0 = 64 * nb;
    const int r = lane >> 4, c = lane & 15;
    const bool nok = (n0 + 4 * c) < N;
    const float* src = W + (size_t)(k0 + 2 * r) * N + n0 + 4 * c;
    f32x4 a[8], b[8];
#pragma unroll
    for (int i = 0; i < 8; ++i) { a[i] = nok ? *(const GAS f32x4*)(src + (size_t)(8 * i) * N) : (f32x4){0.f, 0.f, 0.f, 0.f}; b[i] = nok ? *(const GAS f32x4*)(src + (size_t)(8 * i + 1) * N) : (f32x4){0.f, 0.f, 0.f, 0.f}; }
#pragma unroll
    for (int i = 0; i < 8; ++i)
#pragma unroll
        for (int e = 0; e < 4; ++e) T[(4 * c + e) * 36 + 4 * i + r] = pk2(a[i][e], b[i][e]);
    LDS_WAIT(); asm volatile("" ::: "memory");
    const int rr = lane >> 3, ch = lane & 7;
#pragma unroll
    for (int j = 0; j < 8; ++j) { const int n = 8 * j + rr; const v4u o = *(const LAS v4u*)(T + n * 36 + 4 * ch);
        if (n0 + n < N) *(GAS v4u*)(WT + (size_t)w_rowmap<MAP>(n0 + n) * K + k0 + 8 * ch) = o; }
    LDS_WAIT(); asm volatile("" ::: "memory");
}
constexpr float W8_SCALE = 64.0f; constexpr int W8_E8M0 = 127 - 6;
__device__ __forceinline__ unsigned pk_fp8x4(float a, float b, float c, float d) {
    a = fminf(fmaxf(a, -448.f), 448.f); b = fminf(fmaxf(b, -448.f), 448.f); c = fminf(fmaxf(c, -448.f), 448.f); d = fminf(fmaxf(d, -448.f), 448.f);
    int w = 0; w = __builtin_amdgcn_cvt_pk_fp8_f32(a, b, w, false); w = __builtin_amdgcn_cvt_pk_fp8_f32(c, d, w, true); return (unsigned)w; }
template <int MAP> __device__ __forceinline__ void p0_transpose8_item(const float* W, int K, int N, unsigned char* WT, int ldw, LAS unsigned* T, int item, int lane) {
    const int nblk = (N + 63) / 64, kb = item / nblk, nb = item % nblk, k0 = 64 * kb, n0 = 64 * nb;
    const int r = lane >> 4, c = lane & 15;
    const bool nok = (n0 + 4 * c) < N;
    const float* src = W + (size_t)(k0 + 4 * r) * N + n0 + 4 * c;
    f32x4 q[4][4];
#pragma unroll
    for (int i = 0; i < 4; ++i)
#pragma unroll
        for (int d = 0; d < 4; ++d) q[i][d] = nok ? *(const GAS f32x4*)(src + (size_t)(16 * i + d) * N) : (f32x4){0.f, 0.f, 0.f, 0.f};
#pragma unroll
    for (int i = 0; i < 4; ++i)
#pragma unroll
        for (int e = 0; e < 4; ++e) T[(4 * c + e) * 20 + 4 * i + r] = pk_fp8x4(q[i][0][e] * W8_SCALE, q[i][1][e] * W8_SCALE, q[i][2][e] * W8_SCALE, q[i][3][e] * W8_SCALE);
    LDS_WAIT(); asm volatile("" ::: "memory");
    const int rr = lane >> 2, ch = lane & 3;
#pragma unroll
    for (int j = 0; j < 4; ++j) { const int n = 16 * j + rr; const v4u o = *(const LAS v4u*)(T + n * 20 + 4 * ch);
        if (n0 + n < N) *(GAS v4u*)(WT + (size_t)w_rowmap<MAP>(n0 + n) * ldw + k0 + 16 * ch) = o; }
    LDS_WAIT(); asm volatile("" ::: "memory");
}
template <int MAP> __device__ __forceinline__ void p0_transpose8(const Frame& F, const float* W, int K, int N, unsigned char* WT, int ldw, LAS unsigned* scr) {
    const int nitems = (K / 64) * ((N + 63) / 64);
    for (int it = F.gw; it < nitems; it += F.NGW) p0_transpose8_item<MAP>(W, K, N, WT, ldw, scr, it, F.lane);
}
template <int MAP> __device__ __forceinline__ void p0_transpose(const Frame& F, const float* W, int K, int N, bf16* WT, LAS unsigned* scr) {
    const int nitems = (K / 64) * ((N + 63) / 64);
    for (int it = F.gw; it < nitems; it += F.NGW) p0_transpose_item<MAP>(W, K, N, WT, scr, it, F.lane);
}
__device__ __forceinline__ void p0_prologue(const Frame& F) {
    LAS unsigned* scr = (LAS unsigned*)(F.lds + RING_OFF + F.wave * 16384);
    LAS float* cond = (LAS float*)(F.lds + AUX_OFF);
    LAS float* red = (LAS float*)(F.lds + RING_OFF);
    for (int i = F.tid; i < BATCH * DM; i += NTHREADS) { const float v = F.c[i]; cond[i] = v / (1.0f + __expf(-v)); }
    __syncthreads();
    for (int it = blockIdx.x; it < DEPTH * (NMOD / 64); it += F.G) {
        const int l = it / (NMOD / 64), n = (it % (NMOD / 64)) * 64 + F.lane;
        const float* w = F.w_ada + (size_t)l * DM * NMOD + (size_t)(256 * F.wave) * NMOD + n;
        const LAS float* c0 = cond + 256 * F.wave; const LAS float* c1 = cond + DM + 256 * F.wave;
        float a0 = 0.f, a1 = 0.f;
#pragma unroll 32
        for (int k = 0; k < 256; ++k) { const float wv = w[(size_t)k * NMOD]; a0 += c0[k] * wv; a1 += c1[k] * wv; }
        red[F.wave * 128 + F.lane] = a0; red[F.wave * 128 + 64 + F.lane] = a1;
        __syncthreads();
        if (F.tid < 128) { float sacc = 0.f;
#pragma unroll
            for (int wv = 0; wv < 8; ++wv) sacc += red[wv * 128 + F.tid];
            const int bsel = F.tid >> 6, nn = (it % (NMOD / 64)) * 64 + (F.tid & 63);
            F.MOD[((size_t)l * BATCH + bsel) * NMOD + nn] = sacc + F.b_ada[(size_t)l * NMOD + nn]; }
        __syncthreads();
    }
    for (int lf = 0; lf < DEPTH * 2; ++lf) {
        if (FFN_FP8) {
            p0_transpose8<1>(F, F.w_gate + (size_t)lf * DM * DFF, DM, DFF, (unsigned char*)F.WGU + (size_t)lf * NGU * DM, DM, scr);
            p0_transpose8<2>(F, F.w_up + (size_t)lf * DM * DFF, DM, DFF, (unsigned char*)F.WGU + (size_t)lf * NGU * DM, DM, scr);
            p0_transpose8<0>(F, F.w_down + (size_t)lf * DFF * DM, DFF, DM, (unsigned char*)F.WD + (size_t)lf * DM * DFFP, DFFP, scr);
        } else {
            p0_transpose<1>(F, F.w_gate + (size_t)lf * DM * DFF, DM, DFF, F.WGU + (size_t)lf * NGU * DM, scr);
            p0_transpose<2>(F, F.w_up + (size_t)lf * DM * DFF, DM, DFF, F.WGU + (size_t)lf * NGU * DM, scr);
            p0_transpose<0>(F, F.w_down + (size_t)lf * DFF * DM, DFF, DM, F.WD + (size_t)lf * DM * DFF, scr);
        }
    }
    for (int l = 0; l < DEPTH; ++l) {
        p0_transpose<3>(F, F.w_in + (size_t)l * DM * INC, DM, INC, F.WIN + (size_t)l * NIN * DM, scr);
        p0_transpose<0>(F, F.w_out + (size_t)l * DM * DM, DM, DM, F.WOUT + (size_t)l * DM * DM, scr);
        GAS v4u* z = (GAS v4u*)(F.WIN + (size_t)l * NIN * DM + (size_t)INC * DM);
        for (int i = F.gw * 64 + F.lane; i < (NIN - INC) * DM / 8; i += F.NGW * 64) z[i] = (v4u){0u, 0u, 0u, 0u};
    }
}

template <bool OUT8, bool IN16> __device__ __forceinline__ void ph_modulate(const Frame& F, const void* xin, const float* g, const float* shift, const float* scale) {
    if constexpr (IN16) {
        f32x4 av[4][2], hv[4][2]; int cb = -1;
        int m = F.gw;
        v4u wc[4];
        if (m < M) { const GAS v4u* xr = (const GAS v4u*)((const bf16*)xin + (size_t)m * DM) + F.lane;
#pragma unroll
            for (int j = 0; j < 4; ++j) wc[j] = xr[64 * j]; }
        while (m < M) {
            const int mn = m + F.NGW; const int b = m / SEQ;
            v4u wn[4];
            if (mn < M) { const GAS v4u* xr = (const GAS v4u*)((const bf16*)xin + (size_t)mn * DM) + F.lane;
#pragma unroll
                for (int j = 0; j < 4; ++j) wn[j] = xr[64 * j]; }
            else {
#pragma unroll
                for (int j = 0; j < 4; ++j) wn[j] = (v4u){0u, 0u, 0u, 0u}; }
            if (b != cb) { cb = b;
                const GAS f32x4* gp = (const GAS f32x4*)g + 2 * F.lane; const GAS f32x4* sh = (const GAS f32x4*)(shift + (size_t)b * NMOD) + 2 * F.lane; const GAS f32x4* sc = (const GAS f32x4*)(scale + (size_t)b * NMOD) + 2 * F.lane;
#pragma unroll
                for (int j = 0; j < 4; ++j)
#pragma unroll
                    for (int h = 0; h < 2; ++h) { const f32x4 gg = gp[128 * j + h], ss = sc[128 * j + h]; hv[j][h] = sh[128 * j + h]; av[j][h] = gg * (ss + 1.0f); } }
            float x[4][8]; float s = 0.f;
#pragma unroll
            for (int j = 0; j < 4; ++j) { x[j][0] = bf_lo(wc[j].x); x[j][1] = bf_hi(wc[j].x); x[j][2] = bf_lo(wc[j].y); x[j][3] = bf_hi(wc[j].y); x[j][4] = bf_lo(wc[j].z); x[j][5] = bf_hi(wc[j].z); x[j][6] = bf_lo(wc[j].w); x[j][7] = bf_hi(wc[j].w); }
#pragma unroll
            for (int j = 0; j < 4; ++j) s += ((x[j][0] * x[j][0] + x[j][1] * x[j][1]) + (x[j][2] * x[j][2] + x[j][3] * x[j][3])) + ((x[j][4] * x[j][4] + x[j][5] * x[j][5]) + (x[j][6] * x[j][6] + x[j][7] * x[j][7]));
            const float rstd = 1.0f / sqrtf(wave_sum(s) * (1.f / DM) + RMS_EPS);
            GAS v4u* o16 = (GAS v4u*)(F.H + (size_t)m * DM) + F.lane;
            GAS v2u* o8 = (GAS v2u*)((unsigned char*)F.H + (size_t)m * DM) + F.lane;
#pragma unroll
            for (int j = 0; j < 4; ++j) { float y[8];
#pragma unroll
                for (int h = 0; h < 2; ++h) { const f32x4 aa = av[j][h], hh = hv[j][h];
                    y[4 * h + 0] = x[j][4 * h + 0] * rstd * aa.x + hh.x; y[4 * h + 1] = x[j][4 * h + 1] * rstd * aa.y + hh.y;
                    y[4 * h + 2] = x[j][4 * h + 2] * rstd * aa.z + hh.z; y[4 * h + 3] = x[j][4 * h + 3] * rstd * aa.w + hh.w; }
                if (OUT8) { v2u w; w.x = pk_fp8x4(y[0], y[1], y[2], y[3]); w.y = pk_fp8x4(y[4], y[5], y[6], y[7]); o8[64 * j] = w; }
                else { v4u w; w.x = pk2(y[0], y[1]); w.y = pk2(y[2], y[3]); w.z = pk2(y[4], y[5]); w.w = pk2(y[6], y[7]); o16[64 * j] = w; } }
#pragma unroll
            for (int j = 0; j < 4; ++j) wc[j] = wn[j];
            m = mn;
        }
        return;
    }
    for (int m = F.gw; m < M; m += F.NGW) {
        const int b = m / SEQ;
        float x[4][8]; float s = 0.f;
        if constexpr (IN16) {
            const GAS v4u* xr = (const GAS v4u*)((const bf16*)xin + (size_t)m * DM) + F.lane;
            v4u w[4];
#pragma unroll
            for (int j = 0; j < 4; ++j) w[j] = xr[64 * j];
#pragma unroll
            for (int j = 0; j < 4; ++j) { x[j][0] = bf_lo(w[j].x); x[j][1] = bf_hi(w[j].x); x[j][2] = bf_lo(w[j].y); x[j][3] = bf_hi(w[j].y); x[j][4] = bf_lo(w[j].z); x[j][5] = bf_hi(w[j].z); x[j][6] = bf_lo(w[j].w); x[j][7] = bf_hi(w[j].w); }
        } else {
            const GAS f32x4* xr = (const GAS f32x4*)((const float*)xin + (size_t)m * DM) + 2 * F.lane;
            f32x4 a[4][2];
#pragma unroll
            for (int j = 0; j < 4; ++j) { a[j][0] = xr[128 * j]; a[j][1] = xr[128 * j + 1]; }
            GAS v4u* xo = (GAS v4u*)(F.XB + (size_t)m * DM) + F.lane;
#pragma unroll
            for (int j = 0; j < 4; ++j) { x[j][0] = a[j][0].x; x[j][1] = a[j][0].y; x[j][2] = a[j][0].z; x[j][3] = a[j][0].w; x[j][4] = a[j][1].x; x[j][5] = a[j][1].y; x[j][6] = a[j][1].z; x[j][7] = a[j][1].w;
                v4u w; w.x = pk2(x[j][0], x[j][1]); w.y = pk2(x[j][2], x[j][3]); w.z = pk2(x[j][4], x[j][5]); w.w = pk2(x[j][6], x[j][7]); xo[64 * j] = w; }
        }
#pragma unroll
        for (int j = 0; j < 4; ++j) s += ((x[j][0] * x[j][0] + x[j][1] * x[j][1]) + (x[j][2] * x[j][2] + x[j][3] * x[j][3])) + ((x[j][4] * x[j][4] + x[j][5] * x[j][5]) + (x[j][6] * x[j][6] + x[j][7] * x[j][7]));
        const float rstd = 1.0f / sqrtf(wave_sum(s) * (1.f / DM) + RMS_EPS);
        const GAS f32x4* gp = (const GAS f32x4*)g + 2 * F.lane; const GAS f32x4* sh = (const GAS f32x4*)(shift + (size_t)b * NMOD) + 2 * F.lane; const GAS f32x4* sc = (const GAS f32x4*)(scale + (size_t)b * NMOD) + 2 * F.lane;
        GAS v4u* o16 = (GAS v4u*)(F.H + (size_t)m * DM) + F.lane;
        GAS v2u* o8 = (GAS v2u*)((unsigned char*)F.H + (size_t)m * DM) + F.lane;
#pragma unroll
        for (int j = 0; j < 4; ++j) { float y[8];
#pragma unroll
            for (int h = 0; h < 2; ++h) { const f32x4 gg = gp[128 * j + h], ss = sc[128 * j + h], hh = sh[128 * j + h];
                y[4 * h + 0] = x[j][4 * h + 0] * rstd * gg.x * (ss.x + 1.0f) + hh.x; y[4 * h + 1] = x[j][4 * h + 1] * rstd * gg.y * (ss.y + 1.0f) + hh.y;
                y[4 * h + 2] = x[j][4 * h + 2] * rstd * gg.z * (ss.z + 1.0f) + hh.z; y[4 * h + 3] = x[j][4 * h + 3] * rstd * gg.w * (ss.w + 1.0f) + hh.w; }
            if (OUT8) { v2u w; w.x = pk_fp8x4(y[0], y[1], y[2], y[3]); w.y = pk_fp8x4(y[4], y[5], y[6], y[7]); o8[64 * j] = w; }
            else { v4u w; w.x = pk2(y[0], y[1]); w.y = pk2(y[2], y[3]); w.z = pk2(y[4], y[5]); w.w = pk2(y[6], y[7]); o16[64 * j] = w; } }
    }
}
__device__ __forceinline__ v4u headnorm8(v4u w, const float* g, float mul, int lane, bool normalize) {
    float x[8] = {bf_lo(w.x), bf_hi(w.x), bf_lo(w.y), bf_hi(w.y), bf_lo(w.z), bf_hi(w.z), bf_lo(w.w), bf_hi(w.w)};
    float r = mul;
    if (normalize) {
        float s = 0.f;
#pragma unroll
        for (int i = 0; i < 8; ++i) s += x[i] * x[i];
        s += __shfl_xor(s, 1); s += __shfl_xor(s, 2); s += __shfl_xor(s, 4);
        r = mul / sqrtf(s * (1.f / 64.f) + RMS_EPS);
        const f32x4 g0 = *(const GAS f32x4*)(g + 8 * (lane & 7)), g1 = *(const GAS f32x4*)(g + 8 * (lane & 7) + 4);
        x[0] *= g0.x; x[1] *= g0.y; x[2] *= g0.z; x[3] *= g0.w; x[4] *= g1.x; x[5] *= g1.y; x[6] *= g1.z; x[7] *= g1.w;
    }
    w.x = pk2(x[0] * r, x[1] * r); w.y = pk2(x[2] * r, x[3] * r); w.z = pk2(x[4] * r, x[5] * r); w.w = pk2(x[6] * r, x[7] * r);
    return w;
}
__device__ __forceinline__ void ph_post(const Frame& F, int l) {
    const float* qg = F.qk_g + (size_t)l * 6 * HD;
    for (int m = F.gw; m < M; m += F.NGW) {
        bf16* row = F.P + (size_t)m * NIN; const int lane = F.lane;
        GAS v4u* paq = (GAS v4u*)(row + PA_Q + 8 * lane); GAS v4u* pbq = (GAS v4u*)(row + PB_Q + 8 * lane); GAS v4u* pcq = (GAS v4u*)(row + PC_Q + 8 * lane);
        GAS v4u* pck = (GAS v4u*)(row + PC_K + 8 * lane); GAS v4u* pdq = (GAS v4u*)(row + PD_Q + 8 * lane);
        GAS v4u* pkk = (GAS v4u*)(row + (lane < 8 ? PA_K : PB_K) + 8 * (lane & 7));
        const v4u waq = *paq, wbq = *pbq, wcq = *pcq, wck = *pck, wdq = *pdq;
        v4u wkk = {0u, 0u, 0u, 0u}; if (lane < 16) wkk = *pkk;
        *paq = headnorm8(waq, qg + 0 * HD, QSCALE, lane, true);
        *pbq = headnorm8(wbq, qg + 2 * HD, QSCALE, lane, true);
        *pcq = headnorm8(wcq, qg + 4 * HD, QSCALE, lane, true);
        *pck = headnorm8(wck, qg + 5 * HD, 1.0f, lane, true);
        *pdq = headnorm8(wdq, qg, QSCALE, lane, false);
        if (lane < 16) *pkk = headnorm8(wkk, qg + (lane < 8 ? 1 : 3) * HD, 1.0f, lane, true);
    }
}
__device__ __forceinline__ void ph_scan(const Frame& F, int l) {
    LAS float* wtot = (LAS float*)(F.lds + RING_OFF);
    for (int sq = blockIdx.x; sq < BATCH * NH; sq += F.G) {
        const int b = sq / NH, h = sq % NH; const float fb = F.forget_b[(size_t)l * NH + h];
        const GAS unsigned short* src = (const GAS unsigned short*)(F.P + ((size_t)b * SEQ + 16 * F.tid) * NIN + PC_F + h); float* dst = F.KB2 + (size_t)sq * SEQ + 16 * F.tid;
        float v[16]; unsigned short raw[16];
#pragma unroll
        for (int i = 0; i < 16; ++i) raw[i] = src[(size_t)i * NIN];
#pragma unroll
        for (int i = 0; i < 16; ++i) { const float y = __builtin_bit_cast(float, (unsigned)raw[i] << 16) + fb; v[i] = (y >= 0.f) ? -log1pf(__expf(-y)) : (y - log1pf(__expf(y))); }
#pragma unroll
        for (int i = 1; i < 16; ++i) v[i] += v[i - 1];
        float incl = v[15];
#pragma unroll
        for (int o = 1; o < 64; o <<= 1) { const float t = __shfl_up(incl, o); if (F.lane >= o) incl += t; }
        if (F.lane == 63) wtot[F.wave] = incl;
        __syncthreads();
        float base = incl - v[15];
        for (int w = 0; w < F.wave; ++w) base += wtot[w];
#pragma unroll
        for (int i = 0; i < 4; ++i) *(GAS f32x4*)(dst + 4 * i) = (f32x4){-(v[4 * i] + base) * LOG2E, -(v[4 * i + 1] + base) * LOG2E, -(v[4 * i + 2] + base) * LOG2E, -(v[4 * i + 3] + base) * LOG2E};
        __syncthreads();
    }
}
__device__ __forceinline__ void ph_gnorm(const Frame& F, int l) {
    const float* gg = F.group_g + (size_t)l * DM;
    for (int m = F.gw; m < M; m += F.NGW) {
        v4u w[4];
#pragma unroll
        for (int g = 0; g < 4; ++g) w[g] = *(GAS v4u*)(F.Y + (size_t)m * DM + g * GWID + 8 * F.lane);
#pragma unroll
        for (int g = 0; g < 4; ++g) {
            bf16* p = F.Y + (size_t)m * DM + g * GWID + 8 * F.lane;
            float x[8] = {bf_lo(w[g].x), bf_hi(w[g].x), bf_lo(w[g].y), bf_hi(w[g].y), bf_lo(w[g].z), bf_hi(w[g].z), bf_lo(w[g].w), bf_hi(w[g].w)};
            float s = 0.f;
#pragma unroll
            for (int i = 0; i < 8; ++i) s += x[i] * x[i];
            const float r = 1.0f / sqrtf(wave_sum(s) * (1.f / GWID) + RMS_EPS);
            const f32x4 g0 = *(const GAS f32x4*)(gg + g * GWID + 8 * F.lane), g1 = *(const GAS f32x4*)(gg + g * GWID + 8 * F.lane + 4);
            v4u o; o.x = pk2(x[0] * r * g0.x, x[1] * r * g0.y); o.y = pk2(x[2] * r * g0.z, x[3] * r * g0.w); o.z = pk2(x[4] * r * g1.x, x[5] * r * g1.y); o.w = pk2(x[6] * r * g1.z, x[7] * r * g1.w);
            *(GAS v4u*)p = o;
        }
    }
}


__device__ __forceinline__ unsigned short score_key(float sc) {
    const _Float16 hf = (_Float16)fminf(fmaxf(sc, -60000.f), 60000.f);
    const unsigned h = (unsigned)__builtin_bit_cast(unsigned short, hf);
    return (unsigned short)((h & 0x8000u) ? (~h & 0xffffu) : (h | 0x8000u));
}
__device__ __forceinline__ void glds16x(const void* gsrc, unsigned lds_dst) { unsigned keep;
    asm volatile("s_mov_b32 %0, m0\n\ts_mov_b32 m0, %2\n\ts_nop 0\n\tglobal_load_lds_dwordx4 %1, off\n\ts_mov_b32 m0, %0" : "=&s"(keep) : "v"(gsrc), "s"(lds_dst) : "memory"); }
__device__ __forceinline__ void ph_idx_scores(const Frame& F) {
    constexpr int UPB = 8 * (16 * 17 / 2), NU = BATCH * UPB;
    const int lane = F.lane, r32 = lane & 31, hi = lane >> 5;
    const int u_lo = (int)(((long)blockIdx.x * NU) / F.G), u_hi = (int)(((long)(blockIdx.x + 1) * NU) / F.G);
    if (u_lo >= u_hi) return;
    int b = u_lo / UPB, qb = 127, kc = 0; { int r = u_lo % UPB; for (;;) { const int n = (qb >> 3) + 1; if (r < n) { kc = r; break; } r -= n; --qb; } }
    LAS unsigned char* KL = F.lds + RING_OFF;
    const unsigned kl_lds = (unsigned)(size_t)KL;
#define X1_STAGE(bb, kk, buf) do { const bf16* ksrc_ = F.P + ((size_t)(bb) * SEQ + 512 * (kk) + 64 * F.wave + lane) * NIN + PA_IK; \
        _Pragma("unroll") for (int c_ = 0; c_ < 8; ++c_) glds16x(ksrc_ + 8 * c_, (unsigned)__builtin_amdgcn_readfirstlane(kl_lds + (buf) * 65536 + c_ * 8192 + F.wave * 1024)); } while (0)
    X1_STAGE(b, kc, 0);
    asm volatile("s_waitcnt vmcnt(0)" ::: "memory"); __syncthreads();
    bf16x8 af[4][4]; float wq[4][16]; int cb = -1, cqb = -1;
    for (int u = u_lo; u < u_hi; ++u) {
        const int cur = (u - u_lo) & 1;
        int nb = b, nqb = qb, nkc = kc + 1; if (nkc > (qb >> 3)) { nkc = 0; --nqb; if (nqb < 0) { nqb = 127; ++nb; } }
        if (u + 1 < u_hi) X1_STAGE(nb, nkc, cur ^ 1);
        const size_t rowb = (size_t)b * SEQ; const int t0 = 64 * qb + 8 * F.wave;
        if (b != cb || qb != cqb) { cb = b; cqb = qb;
#pragma unroll
            for (int pr = 0; pr < 4; ++pr) {
                const bf16* qrow = F.P + (rowb + t0 + 2 * pr + ((r32 >> 2) & 1)) * NIN + PA_IQ + ((r32 & 3) + 4 * (r32 >> 3)) * 64 + 8 * hi;
#pragma unroll
                for (int s = 0; s < 4; ++s) af[pr][s] = *(const GAS bf16x8*)(qrow + 16 * s);
                const bf16* wrow = F.P + (rowb + t0 + 2 * pr + hi) * NIN + PA_IW;
                const v4u w0 = *(const GAS v4u*)wrow, w1 = *(const GAS v4u*)(wrow + 8);
                const unsigned ww[8] = {w0.x, w0.y, w0.z, w0.w, w1.x, w1.y, w1.z, w1.w};
#pragma unroll
                for (int i = 0; i < 8; ++i) { wq[pr][2 * i] = bf_lo(ww[i]) * 0.015625f; wq[pr][2 * i + 1] = bf_hi(ww[i]) * 0.015625f; }
            }
        }
        const int kend = 64 * (qb + 1) - 512 * kc;
        const int nkt = kend >= 512 ? 16 : (kend + 31) / 32;
        const LAS unsigned char* kl = KL + cur * 65536 + hi * 8192 + r32 * 16;
        for (int kt = 0; kt < nkt; ++kt) {
            bf16x8 bfr[4];
#pragma unroll
            for (int s = 0; s < 4; ++s) bfr[s] = *(const LAS bf16x8*)(kl + s * 16384 + kt * 512);
            const int s0 = 512 * kc + 32 * kt;
#pragma unroll
            for (int pr = 0; pr < 4; ++pr) {
                f32x16 acc = {};
#pragma unroll
                for (int s = 0; s < 4; ++s) acc = __builtin_amdgcn_mfma_f32_32x32x16_bf16(af[pr][s], bfr[s], acc, 0, 0, 0);
                float sc0 = 0.f, sc1 = 0.f;
#pragma unroll
                for (int r = 0; r < 16; ++r) { sc0 = __builtin_fmaf(wq[pr][r], acc[r], sc0); sc1 = __builtin_fmaf(wq[pr][r], __builtin_fabsf(acc[r]), sc1); if ((r & 3) == 3) asm("" : "+v"(sc1)); }
                ((GAS unsigned short*)F.SC)[(rowb + t0 + 2 * pr + hi) * SEQ + s0 + r32] = score_key(sc0 + sc1);
                __builtin_amdgcn_sched_barrier(0);
            }
        }
        asm volatile("s_waitcnt vmcnt(0)" ::: "memory");
        __syncthreads();
        b = nb; qb = nqb; kc = nkc;
    }
#undef X1_STAGE
}

__device__ __forceinline__ unsigned mbcnt64(unsigned long long m) { return __builtin_amdgcn_mbcnt_hi((unsigned)(m >> 32), __builtin_amdgcn_mbcnt_lo((unsigned)m, 0u)); }
template <int SH, int PSH> __device__ __forceinline__ void sel_level(const unsigned (&v)[64], int nreg, unsigned pval, unsigned need, LAS unsigned* hist, int lane, unsigned& bin_out, unsigned& above_out) {
#pragma unroll
    for (int i = 0; i < 8; ++i) ((LAS v4u*)hist)[lane + 64 * i] = (v4u){0u, 0u, 0u, 0u};
    LDS_WAIT(); __builtin_amdgcn_wave_barrier();
    const unsigned hb = (unsigned)(size_t)hist, sink = hb + 9216u + 4u * (unsigned)lane;
#pragma unroll
    for (int g = 0; g < 8; ++g) if (8 * g < nreg) {
#pragma unroll
        for (int jj = 0; jj < 8; ++jj) { const int j = 8 * g + jj;
#pragma unroll
            for (int e = 0; e < 2; ++e) { const unsigned k = e ? (v[j] >> 16) : (v[j] & 0xffffu);
                const bool pred = (k != 0u) && (PSH >= 16 || (k >> (PSH & 15)) == pval);
                const unsigned tgt = pred ? hb + (((k >> SH) & 2047u) << 2) : sink;
                __hip_atomic_fetch_add((LAS unsigned*)tgt, 1u, __ATOMIC_RELAXED, __HIP_MEMORY_SCOPE_WAVEFRONT); }
            if ((jj & 1) == 1) __builtin_amdgcn_sched_barrier(0); }
    }
    LDS_WAIT(); __builtin_amdgcn_wave_barrier();
    unsigned S = 0u;
#pragma unroll
    for (int i = 0; i < 8; ++i) { const v4u q = ((LAS v4u*)hist)[lane * 8 + i]; S += (q.x + q.y) + (q.z + q.w); }
    unsigned T = S;
#pragma unroll
    for (int o = 1; o < 64; o <<= 1) { const unsigned t = __shfl_down(T, o); if (lane + o < 64) T += t; }
    const unsigned above_lane = T - S;
    const bool cross = (T >= need) && (above_lane < need);
    unsigned run = above_lane, bin = 0u, ab = 0u; bool found = false;
#pragma unroll
    for (int i = 7; i >= 0; --i) { const v4u q = ((LAS v4u*)hist)[lane * 8 + i]; const unsigned c4[4] = {q.x, q.y, q.z, q.w};
#pragma unroll
        for (int e = 3; e >= 0; --e) { const bool hit = !found && (run + c4[e] >= need); if (hit) { bin = 32u * lane + 4 * i + e; ab = run; found = true; } run += c4[e]; } }
    const unsigned long long cm = __ballot(cross);
    const int src = cm ? (int)__builtin_ctzll(cm) : 0;
    bin_out = __builtin_amdgcn_readlane(bin, src); above_out = __builtin_amdgcn_readlane(ab, src);
    LDS_WAIT(); __builtin_amdgcn_wave_barrier();
}
__device__ __forceinline__ void select_row(const Frame& F, int m, LAS unsigned* hist, LAS int* out) {
    int lane = F.lane; asm volatile("" : "+v"(lane));
    const int t = m % SEQ, n = t + 1;
    if (n <= TOPK) { for (int j = lane; j < TOPK; j += 64) out[j] = (j < n) ? j : 0; return; }
    const int nreg = (n + 127) >> 7;
    unsigned v[64];
    const GAS unsigned* pr = (const GAS unsigned*)(F.SC + (size_t)m * SEQ) + lane;
#pragma unroll
    for (int g = 0; g < 8; ++g) {
        if (8 * g < nreg) {
#pragma unroll
            for (int jj = 0; jj < 8; ++jj) v[8 * g + jj] = pr[jj * 64];
        } else {
#pragma unroll
            for (int jj = 0; jj < 8; ++jj) v[8 * g + jj] = 0u;
        }
        pr += 512; asm volatile("" : "+v"(pr));
    }
    const int nfull = n >> 7;
#pragma unroll
    for (int g = 0; g < 8; ++g) if (8 * g < nreg && 8 * g + 8 > nfull) {
#pragma unroll
        for (int jj = 0; jj < 8; ++jj) { const int j = 8 * g + jj; const int e0 = 128 * j + 2 * lane; const unsigned w = v[j];
            v[j] = ((e0 < n) ? (w & 0xffffu) : 0u) | ((e0 + 1 < n) ? (w & 0xffff0000u) : 0u); asm volatile("" : "+v"(v[j])); }
    }
    unsigned b1, a1, b2, a2;
    sel_level<5, 16>(v, nreg, 0u, (unsigned)TOPK, hist, lane, b1, a1);
    sel_level<0, 5>(v, nreg, b1, (unsigned)TOPK - a1, hist, lane, b2, a2);
    const unsigned tau = (b1 << 5) | (b2 & 31u);
    const unsigned quota = (unsigned)TOPK - a1 - a2;
    unsigned mg[4] = {0u, 0u, 0u, 0u}, me[4] = {0u, 0u, 0u, 0u};
#pragma unroll
    for (int g = 0; g < 8; ++g) {
        if (8 * g < nreg) {
#pragma unroll
            for (int jj = 0; jj < 8; ++jj) { const int j = 8 * g + jj;
#pragma unroll
                for (int e = 0; e < 2; ++e) { const unsigned k = e ? (v[j] >> 16) : (v[j] & 0xffffu);
                    mg[g >> 1] = mg[g >> 1] + mg[g >> 1] + ((k > tau) ? 1u : 0u); me[g >> 1] = me[g >> 1] + me[g >> 1] + ((k == tau) ? 1u : 0u); }
                if ((jj & 3) == 3) __builtin_amdgcn_sched_barrier(0); }
        } else { mg[g >> 1] <<= 16; me[g >> 1] <<= 16; }
    }
    const unsigned cg = (unsigned)(__builtin_popcount(mg[0]) + __builtin_popcount(mg[1]) + __builtin_popcount(mg[2]) + __builtin_popcount(mg[3]));
    unsigned ce = (unsigned)(__builtin_popcount(me[0]) + __builtin_popcount(me[1]) + __builtin_popcount(me[2]) + __builtin_popcount(me[3]));
    unsigned incl = cg | (ce << 16);
#pragma unroll
    for (int o = 1; o < 64; o <<= 1) { const unsigned t = (unsigned)__shfl_up((int)incl, o); if (lane >= o) incl += t; }
    const unsigned excl = incl - (cg | (ce << 16));
    const unsigned pre_g = excl & 0xffffu, pre_e = excl >> 16;
    const unsigned keep = pre_e >= quota ? 0u : ((quota - pre_e) < ce ? (quota - pre_e) : ce);
#pragma unroll
    for (int q = 3; q >= 0; --q) { while (ce > keep && me[q] != 0u) { me[q] &= me[q] - 1u; --ce; } }
    unsigned pos = pre_g + (pre_e < quota ? pre_e : quota);
    const int ilane = 2 * lane;
#pragma unroll
    for (int q = 0; q < 4; ++q) { unsigned mm = mg[q] | me[q];
        while (mm != 0u) { const int bpos = 31 - (int)__builtin_clz(mm); const int sl = 31 - bpos; mm &= ~(1u << bpos);
            const int i = 128 * (16 * q + (sl >> 1)) + ilane + (sl & 1);
            if (pos < (unsigned)TOPK) out[pos] = i;
            ++pos; } }
}


constexpr int AT_K = 0, AT_V = 16384, AT_KB = 32768, AT_WSF = 33280, AT_BT = 35328, AT_DEAD = 35840, AT_SV = 36864;
typedef short v4i16_t __attribute__((ext_vector_type(4)));
__device__ __forceinline__ s16x4 vtr(const LAS unsigned char* p) { return __builtin_bit_cast(s16x4, __builtin_amdgcn_ds_read_tr16_b64_v4i16((LAS v4i16_t*)p)); }
typedef __bf16 bfpair_t __attribute__((ext_vector_type(2))); typedef float f32pair_t __attribute__((ext_vector_type(2)));
__device__ __forceinline__ unsigned cvtpk(float lo, float hi) { const f32pair_t v = {lo, hi}; return __builtin_bit_cast(unsigned, __builtin_convertvector(v, bfpair_t)); }
#define NEG_INF (-__builtin_inff())

template <int TYPE>
__device__ __forceinline__ void dense_attn_unit(const Frame& F, int l, int b, int h, int qb) {
    constexpr int QOFF = TYPE == 1 ? PB_Q : TYPE == 2 ? PC_Q : PD_Q, KOFF = TYPE == 1 ? PB_K : TYPE == 2 ? PC_K : PD_K, VOFF = TYPE == 1 ? PB_V : TYPE == 2 ? PC_V : PD_V;
    constexpr bool MQA = TYPE == 1; constexpr int YOFF = TYPE * GWID;
    const int tid = F.tid, lane = F.lane, wid = F.wave, r32 = lane & 31, hi = lane >> 5;
    LAS unsigned char* L = F.lds + RING_OFF;
    LAS float* wsf = (LAS float*)(L + AT_WSF + wid * 256);
    LAS float* BT = (LAS float*)(L + AT_BT);
    const int hq = (TYPE == 1) ? wid : h, qoff = (TYPE == 1) ? (qb & 7) * 32 : wid * 32, qb256 = (TYPE == 1) ? (qb >> 3) : qb;
    const size_t rowb = (size_t)b * SEQ; const int q0 = qb256 * 256;
    const bf16* Pk = F.P + rowb * NIN + KOFF + (MQA ? 0 : h * 64);
    const bf16* Pv = F.P + rowb * NIN + VOFF + (MQA ? 0 : h * 64);
    const bf16* Pq = F.P + (rowb + q0 + qoff + r32) * NIN + QOFF + hq * 64 + hi * 8;
    bf16x8 qr[4];
#pragma unroll
    for (int d0 = 0; d0 < 4; ++d0) qr[d0] = *(const GAS bf16x8*)(Pq + 16 * d0);
    const int jt_hi = (TYPE == 1) ? ((q0 + qoff + 31) >> 6) : 4 * qb256 + 3, jt_lo = (TYPE == 1) ? (((q0 + qoff - (WINDOW - 1)) > 0 ? (q0 + qoff - (WINDOW - 1)) : 0) >> 6) : 0, nt = jt_hi - jt_lo + 1;
    if (TYPE == 1) { LAS float* BTall = (LAS float*)(L + AT_SV);
        for (int i = tid; i < 8 * 128; i += NTHREADS) BTall[i] = F.rel_table[(int)kBucketLut[i & 127] * 16 + 8 + (i >> 7)] * LOG2E;
        BT = BTall + 128 * wid; }
    const bf16* kgp = Pk + (size_t)lane * NIN + wid * 8;
    const int vkey = tid >> 3, vch = tid & 7;
    const bf16* vgp = Pv + (size_t)vkey * NIN + vch * 8;
    const int kl = wid * 1024 + lane * 16;
    const int vl = (vch >> 2) * 4096 + (vkey >> 3) * 512 + (vkey & 7) * 64 + (vch & 3) * 16;
    const float* kb2 = F.KB2 + ((size_t)b * NH + h) * SEQ;
    v4u kreg = *(const GAS v4u*)(kgp + (size_t)jt_hi * 64 * NIN), vreg = *(const GAS v4u*)(vgp + (size_t)jt_hi * 64 * NIN);
    float kbreg = 0.f; if (TYPE == 2 && tid < 64) kbreg = kb2[jt_hi * 64 + tid];
    *(LAS v4u*)(L + AT_K + kl) = kreg; *(LAS v4u*)(L + AT_V + vl) = vreg; if (TYPE == 2 && tid < 64) ((LAS float*)(L + AT_KB))[tid] = kbreg;
    __syncthreads();
    f32x16 o[2]; o[0] = f32x16{}; o[1] = f32x16{};
    float mrun = NEG_INF, lsum = 0.f, carry = 1.f;
    float qbound = 0.f;
    if (TYPE == 2) {
        float ss = 0.f;
#pragma unroll
        for (int d0 = 0; d0 < 4; ++d0)
#pragma unroll
            for (int j = 0; j < 8; ++j) { const float x = bf2f((bf16)qr[d0][j]); ss += x * x; }
        ss += __shfl_xor(ss, 32);
        float gm = fabsf(F.qk_g[((size_t)l * 6 + 5) * HD + lane]);
#pragma unroll
        for (int o = 1; o < 64; o <<= 1) gm = fmaxf(gm, __shfl_xor(gm, o));
        qbound = sqrtf(ss) * 8.08f * gm;
    }
    const int qrel = qoff + r32;
    const int vb = ((lane >> 4) & 1) * 32 + (lane & 3) * 8 + (4 * hi + ((lane & 15) >> 2)) * 64;
    LAS unsigned* deadf = (LAS unsigned*)(L + AT_DEAD);
    for (int i = 0; i < nt; ++i) {
        const int jt = jt_hi - i, cur = i & 1, jb = jt - 4 * qb256; const bool more = (i + 1 < nt);
        float kbnext = 0.f;
        if (more) { kreg = *(const GAS v4u*)(kgp + (size_t)(jt - 1) * 64 * NIN); vreg = *(const GAS v4u*)(vgp + (size_t)(jt - 1) * 64 * NIN); if (TYPE == 2 && tid < 64) kbreg = kb2[(jt - 1) * 64 + tid]; if (TYPE == 2) kbnext = kb2[jt * 64 - 1]; }
        const bool active = (64 * jb <= qoff + 31) && (TYPE != 1 || (64 * jb + 63 >= qoff - (WINDOW - 1)));
        if (active) {
            const LAS unsigned char* Kb = L + AT_K + cur * 8192; const LAS unsigned char* Vb = L + AT_V + cur * 8192;
            f32x16 p0 = f32x16{}, p1 = f32x16{};
            bf16x8 ka[4], kc[4];
#pragma unroll
            for (int d0 = 0; d0 < 4; ++d0) { ka[d0] = *(const LAS bf16x8*)(Kb + (2 * d0 + hi) * 1024 + r32 * 16); kc[d0] = *(const LAS bf16x8*)(Kb + (2 * d0 + hi) * 1024 + 512 + r32 * 16); }
            __builtin_amdgcn_sched_barrier(0);
#pragma unroll
            for (int d0 = 0; d0 < 4; ++d0) { p0 = __builtin_amdgcn_mfma_f32_32x32x16_bf16(ka[d0], qr[d0], p0, 0, 0, 0); p1 = __builtin_amdgcn_mfma_f32_32x32x16_bf16(kc[d0], qr[d0], p1, 0, 0, 0); }
            bf16x8 vfr[2][4];
#pragma unroll
            for (int d0 = 0; d0 < 2; ++d0)
#pragma unroll
                for (int ks = 0; ks < 4; ++ks) { const s16x4 lo = vtr(Vb + vb + d0 * 4096 + ks * 1024), hh = vtr(Vb + vb + d0 * 4096 + ks * 1024 + 512);
                    vfr[d0][ks] = (bf16x8){lo[0], lo[1], lo[2], lo[3], hh[0], hh[1], hh[2], hh[3]}; }
            __builtin_amdgcn_sched_barrier(0);
            bool live = true;
            const int kv0 = 64 * jb + 4 * hi;
            if (TYPE == 3) {
                float b0[16], b1[16];
#pragma unroll
                for (int r = 0; r < 16; ++r) { const int kv = kv0 + (r & 3) + 8 * (r >> 2);
                    const float e0 = fexp2(fminf(p0[r], 80.f)), e1 = fexp2(fminf(p1[r], 80.f));
                    const float m0 = frcp(1.0f + e0), m1 = frcp(1.0f + e1);
                    const bool ok0 = kv < qrel, ok1 = (kv + 32) < qrel;
                    b0[r] = ok0 ? e0 * m0 : 0.f; b1[r] = ok1 ? e1 * m1 : 0.f; p0[r] = ok0 ? m0 : 1.0f; p1[r] = ok1 ? m1 : 1.0f; }
                float gp[8], go[8], pp[8];
#pragma unroll
                for (int g = 0; g < 4; ++g) { gp[g] = (p0[4 * g] * p0[4 * g + 1]) * (p0[4 * g + 2] * p0[4 * g + 3]); gp[4 + g] = (p1[4 * g] * p1[4 * g + 1]) * (p1[4 * g + 2] * p1[4 * g + 3]); }
#pragma unroll
                for (int g = 0; g < 8; ++g) { const float oth = __shfl_xor(gp[g], 32); pp[g] = gp[g] * oth; go[g] = hi ? 1.0f : oth; }
                float sp = 1.0f;
#pragma unroll
                for (int g = 7; g >= 0; --g) { const float sg = sp * go[g] * carry;
                    if (g < 4) { const float c3 = p0[4 * g + 3], c2 = p0[4 * g + 2], c1 = p0[4 * g + 1];
                        p0[4 * g + 3] = b0[4 * g + 3] * sg; const float s2 = sg * c3; p0[4 * g + 2] = b0[4 * g + 2] * s2; const float s1 = s2 * c2; p0[4 * g + 1] = b0[4 * g + 1] * s1; p0[4 * g] = b0[4 * g] * (s1 * c1); }
                    else { const int q = g - 4; const float c3 = p1[4 * q + 3], c2 = p1[4 * q + 2], c1 = p1[4 * q + 1];
                        p1[4 * q + 3] = b1[4 * q + 3] * sg; const float s2 = sg * c3; p1[4 * q + 2] = b1[4 * q + 2] * s2; const float s1 = s2 * c2; p1[4 * q + 1] = b1[4 * q + 1] * s1; p1[4 * q] = b1[4 * q] * (s1 * c1); }
                    sp *= pp[g]; }
                carry *= sp;
            } else {
                if (TYPE == 2) {
                    const LAS f32x4* kbp = (const LAS f32x4*)(L + AT_KB + cur * 256);
#pragma unroll
                    for (int g = 0; g < 4; ++g) { const f32x4 a = kbp[2 * g + hi], c = kbp[8 + 2 * g + hi];
#pragma unroll
                        for (int e = 0; e < 4; ++e) { p0[4 * g + e] += a[e]; p1[4 * g + e] += c[e]; } }
                    if (jb >= 0) {
#pragma unroll
                        for (int r = 0; r < 16; ++r) { const int kv = kv0 + (r & 3) + 8 * (r >> 2); if (kv > qrel) p0[r] = NEG_INF; if (kv + 32 > qrel) p1[r] = NEG_INF; }
                    }
                } else {
#pragma unroll
                    for (int r = 0; r < 16; ++r) { const int d0_ = qrel - (kv0 + (r & 3) + 8 * (r >> 2)), d1_ = d0_ - 32;
                        const bool ok0 = (d0_ >= 0) && (d0_ < WINDOW), ok1 = (d1_ >= 0) && (d1_ < WINDOW);
                        const float t0 = BT[ok0 ? d0_ : 0], t1 = BT[ok1 ? d1_ : 0];
                        p0[r] = ok0 ? p0[r] + t0 : NEG_INF; p1[r] = ok1 ? p1[r] + t1 : NEG_INF; }
                }
                float rm = fmaxf(p0[0], p1[0]);
#pragma unroll
                for (int r = 1; r < 16; ++r) rm = fmaxf(rm, fmaxf(p0[r], p1[r]));
                { auto rr = __builtin_amdgcn_permlane32_swap(__float_as_uint(rm), __float_as_uint(rm), false, false); rm = fmaxf(__uint_as_float(rr[0]), __uint_as_float(rr[1])); }
                const float mn = fmaxf(mrun, rm);
                if (TYPE == 2) live = !__all(rm - mrun < -40.f);
                if (live) {
                if (__any(mn > mrun)) {
                    const float f = (mn > mrun) ? fexp2(mrun - mn) : 1.0f;
                    lsum *= f; mrun = mn;
                    if (hi == 0) wsf[r32] = f;
                    LDS_WAIT(); __builtin_amdgcn_wave_barrier();
#pragma unroll
                    for (int g = 0; g < 4; ++g) { const f32x4 fv = ((const LAS f32x4*)wsf)[2 * g + hi];
#pragma unroll
                        for (int e = 0; e < 4; ++e) { o[0][4 * g + e] *= fv[e]; o[1][4 * g + e] *= fv[e]; } }
                    LDS_WAIT(); __builtin_amdgcn_wave_barrier();
                }
                const float ms = (mrun == NEG_INF) ? 0.f : mrun;
                float ps = 0.f;
#pragma unroll
                for (int r = 0; r < 16; ++r) { p0[r] = fexp2(p0[r] - ms); p1[r] = fexp2(p1[r] - ms); ps += p0[r] + p1[r]; }
                lsum += ps;
                }
            }
            if (live) {
            bf16x8 pa[4];
#pragma unroll
            for (int ks = 0; ks < 4; ++ks) { v4u w;
                if (ks < 2) { w.x = cvtpk(p0[8 * ks], p0[8 * ks + 1]); w.y = cvtpk(p0[8 * ks + 2], p0[8 * ks + 3]); w.z = cvtpk(p0[8 * ks + 4], p0[8 * ks + 5]); w.w = cvtpk(p0[8 * ks + 6], p0[8 * ks + 7]); }
                else { const int k2 = ks - 2; w.x = cvtpk(p1[8 * k2], p1[8 * k2 + 1]); w.y = cvtpk(p1[8 * k2 + 2], p1[8 * k2 + 3]); w.z = cvtpk(p1[8 * k2 + 4], p1[8 * k2 + 5]); w.w = cvtpk(p1[8 * k2 + 6], p1[8 * k2 + 7]); }
                pa[ks] = __builtin_bit_cast(bf16x8, w); }
#pragma unroll
            for (int d0 = 0; d0 < 2; ++d0)
#pragma unroll
                for (int ks = 0; ks < 4; ++ks) o[d0] = __builtin_amdgcn_mfma_f32_32x32x16_bf16(pa[ks], vfr[d0][ks], o[d0], 0, 0, 0);
            }
        }
        if (TYPE == 2) {
            bool wdead = false;
            if (active && more) wdead = __all(qbound + kbnext - mrun < -40.f);
            if (lane == 0) deadf[cur * 8 + wid] = wdead ? 1u : 0u; }
        if (TYPE == 3) { const bool wdead = active && __all(carry < 2.3e-10f);
            if (lane == 0) deadf[cur * 8 + wid] = wdead ? 1u : 0u; }
        if (more) { *(LAS v4u*)(L + AT_K + (cur ^ 1) * 8192 + kl) = kreg; *(LAS v4u*)(L + AT_V + (cur ^ 1) * 8192 + vl) = vreg; if (TYPE == 2 && tid < 64) ((LAS float*)(L + AT_KB + (cur ^ 1) * 256))[tid] = kbreg; }
        __syncthreads();
        if (TYPE >= 2) { const v4u d0 = *(const LAS v4u*)(deadf + cur * 8), d1 = *(const LAS v4u*)(deadf + cur * 8 + 4);
            if ((d0.x & d0.y & d0.z & d0.w & d1.x & d1.y & d1.z & d1.w) != 0u) break; }
    }
    float inv[16];
    if (TYPE != 3) {
        { auto rr = __builtin_amdgcn_permlane32_swap(__float_as_uint(lsum), __float_as_uint(lsum), false, false); lsum = __uint_as_float(rr[0]) + __uint_as_float(rr[1]); }
        if (TYPE == 1) lsum += fexp2(F.sinks[l * NH + hq] * LOG2E - mrun);
        const float il = 1.0f / lsum;
        if (hi == 0) wsf[r32] = il;
        LDS_WAIT(); __builtin_amdgcn_wave_barrier();
#pragma unroll
        for (int g = 0; g < 4; ++g) { const f32x4 fv = ((const LAS f32x4*)wsf)[2 * g + hi]; inv[4 * g] = fv[0]; inv[4 * g + 1] = fv[1]; inv[4 * g + 2] = fv[2]; inv[4 * g + 3] = fv[3]; }
        LDS_WAIT(); __builtin_amdgcn_wave_barrier();
    } else {
#pragma unroll
        for (int r = 0; r < 16; ++r) inv[r] = 1.0f;
    }
    unsigned short gte[2][16];
    if (TYPE == 2) {
#pragma unroll
        for (int d0 = 0; d0 < 2; ++d0)
#pragma unroll
            for (int r = 0; r < 16; ++r) { const int q = (r & 3) + 8 * (r >> 2) + 4 * hi; const size_t mrow = rowb + q0 + qoff + q; gte[d0][r] = ((const GAS unsigned short*)F.P)[mrow * NIN + PC_G + hq * 64 + 32 * d0 + r32]; }
    }
#pragma unroll
    for (int d0 = 0; d0 < 2; ++d0)
#pragma unroll
        for (int r = 0; r < 16; ++r) { const int q = (r & 3) + 8 * (r >> 2) + 4 * hi; const size_t mrow = rowb + q0 + qoff + q; const int col = hq * 64 + 32 * d0 + r32;
            float val = o[d0][r] * inv[r];
            if (TYPE == 2) val *= frcp(1.0f + fexp2(-LOG2E * __builtin_bit_cast(float, (unsigned)gte[d0][r] << 16)));
            F.Y[mrow * DM + YOFF + col] = (bf16)f2bf(val); }
}

__device__ __forceinline__ void sparse_attn_query(const Frame& F, int m, LAS unsigned char* vch, const LAS float* TBA, const LAS int* idx) {
    int lane = F.lane; asm volatile("" : "+v"(lane));
    const int hh = lane & 15, kg = lane >> 4, t = m % SEQ, b = m / SEQ;
    const size_t rowb = (size_t)b * SEQ;
    const int nsel = (t + 1) < TOPK ? (t + 1) : TOPK, nch = (nsel + 63) >> 6;
    const bf16* qp = F.P + (size_t)m * NIN + PA_Q + (hh & 7) * 64 + 8 * kg;
    const bf16x8 qf0 = *(const GAS bf16x8*)qp, qf1 = *(const GAS bf16x8*)(qp + 32);
    float s[4][4][4];
#pragma unroll
    for (int cp = 0; cp < 2; ++cp) {
        if (2 * cp < nch) {
            bf16x8 kf[8][2];
#pragma unroll
            for (int bb = 0; bb < 8; ++bb) { const int keyA = idx[128 * cp + 16 * bb + hh];
                const bf16* kp = F.P + (rowb + keyA) * NIN + PA_K + 8 * kg;
                kf[bb][0] = *(const GAS bf16x8*)kp; kf[bb][1] = *(const GAS bf16x8*)(kp + 32); }
            __builtin_amdgcn_sched_barrier(0);
#pragma unroll
            for (int bb = 0; bb < 8; ++bb) { const int c = 2 * cp + (bb >> 2), blk = bb & 3, j0 = 64 * c + 16 * blk;
                f32x4 acc = {0.f, 0.f, 0.f, 0.f};
                acc = __builtin_amdgcn_mfma_f32_16x16x32_bf16(kf[bb][0], qf0, acc, 0, 0, 0); acc = __builtin_amdgcn_mfma_f32_16x16x32_bf16(kf[bb][1], qf1, acc, 0, 0, 0);
                const v4i id4 = *(const LAS v4i*)(idx + j0 + 4 * kg);
#pragma unroll
                for (int r = 0; r < 4; ++r) { const int j = j0 + 4 * kg + r; int dist = t - id4[r]; dist = dist < 0 ? 0 : (dist > 128 ? 128 : dist);
                    const float bias = TBA[dist * 8 + (hh & 7)];
                    s[c][blk][r] = (j < nsel) ? acc[r] + bias : NEG_INF; }
            }
        } else {
#pragma unroll
            for (int c = 2 * cp; c < 2 * cp + 2; ++c)
#pragma unroll
                for (int blk = 0; blk < 4; ++blk)
#pragma unroll
                    for (int r = 0; r < 4; ++r) s[c][blk][r] = NEG_INF;
        }
    }
    v4u xv[2][8];
#define SP_VLOAD(c_, X) do { const int keyV_ = idx[64 * (c_) + lane]; const bf16* vp_ = F.P + (rowb + keyV_) * NIN + PA_V; \
        _Pragma("unroll") for (int i_ = 0; i_ < 8; ++i_) X[i_] = *(const GAS v4u*)(vp_ + 8 * i_); } while (0)
    SP_VLOAD(0, xv[0]);
    if (1 < nch) SP_VLOAD(1, xv[1]);
    __builtin_amdgcn_sched_barrier(0);
    float mx = NEG_INF;
#pragma unroll
    for (int c = 0; c < 4; ++c)
#pragma unroll
        for (int blk = 0; blk < 4; ++blk)
#pragma unroll
            for (int r = 0; r < 4; ++r) mx = fmaxf(mx, s[c][blk][r]);
    mx = fmaxf(mx, __shfl_xor(mx, 16)); mx = fmaxf(mx, __shfl_xor(mx, 32));
    float sum = 0.f;
#pragma unroll
    for (int c = 0; c < 4; ++c)
#pragma unroll
        for (int blk = 0; blk < 4; ++blk)
#pragma unroll
            for (int r = 0; r < 4; ++r) { const float p = fexp2(s[c][blk][r] - mx); s[c][blk][r] = p; sum += p; }
    sum += __shfl_xor(sum, 16); sum += __shfl_xor(sum, 32);
    const float inv = 1.0f / sum;
    f32x4 oacc[4];
#pragma unroll
    for (int d = 0; d < 4; ++d) oacc[d] = (f32x4){0.f, 0.f, 0.f, 0.f};
    const int q4 = (lane & 15) >> 2, p4 = lane & 3;
#pragma unroll
    for (int c = 0; c < 4; ++c) {
        if (c < nch) {
#pragma unroll
            for (int i = 0; i < 8; ++i) *(LAS v4u*)(vch + (i >> 2) * 4096 + lane * 64 + (i & 3) * 16) = xv[c & 1][i];
            LDS_WAIT(); __builtin_amdgcn_wave_barrier();
            if (c + 2 < nch) SP_VLOAD(c + 2, xv[c & 1]);
            __builtin_amdgcn_sched_barrier(0);
#pragma unroll
            for (int kp = 0; kp < 2; ++kp) { v4u w; w.x = cvtpk(s[c][2 * kp][0], s[c][2 * kp][1]); w.y = cvtpk(s[c][2 * kp][2], s[c][2 * kp][3]); w.z = cvtpk(s[c][2 * kp + 1][0], s[c][2 * kp + 1][1]); w.w = cvtpk(s[c][2 * kp + 1][2], s[c][2 * kp + 1][3]);
                const bf16x8 pf = __builtin_bit_cast(bf16x8, w);
#pragma unroll
                for (int d = 0; d < 4; ++d) { const LAS unsigned char* a = vch + (d >> 1) * 4096 + (32 * kp + 4 * kg + q4) * 64 + ((d & 1) * 16 + 4 * p4) * 2;
                    const s16x4 lo = vtr(a), hv = vtr(a + 16 * 64);
                    const bf16x8 vf = {lo[0], lo[1], lo[2], lo[3], hv[0], hv[1], hv[2], hv[3]};
                    oacc[d] = __builtin_amdgcn_mfma_f32_16x16x32_bf16(vf, pf, oacc[d], 0, 0, 0); } }
            LDS_WAIT(); __builtin_amdgcn_wave_barrier();
        }
    }
#undef SP_VLOAD
    if (hh < 8) {
#pragma unroll
        for (int d = 0; d < 4; ++d) { v2u w; w.x = pk2(oacc[d][0] * inv, oacc[d][1] * inv); w.y = pk2(oacc[d][2] * inv, oacc[d][3] * inv);
            *(GAS v2u*)(F.Y + (size_t)m * DM + hh * 64 + 16 * d + 4 * kg) = w; }
    }
}

constexpr int CW_QUEUE = 8192;
constexpr int MIX_ITEMS = 2560;
template <unsigned EN> __device__ __forceinline__ void ph_attention(const Frame& F, int l, int qsel = 0) {
    LAS float* TBA = (LAS float*)(F.lds + AUX_OFF);
    for (int i = F.tid; i < 129 * 8; i += NTHREADS) { const int d = i >> 3, hq = i & 7; const int bk = d < 128 ? (int)kBucketLut[d] : 31; TBA[i] = F.rel_table[bk * 16 + hq] * LOG2E; }
    LAS unsigned* qslot = (LAS unsigned*)(F.lds + LDSCTL_OFF + 64);
    LAS unsigned char* wbuf = F.lds + RING_OFF + AT_SV + F.wave * 9472;
    LAS int* idxl = (LAS int*)(wbuf + 8192);
    __syncthreads();
#define MIX_FETCH(it) do { if (F.tid == 0) *qslot = __hip_atomic_fetch_add((unsigned*)(F.ctl + CW_QUEUE + 64 * l + 32 * qsel), 1u, __ATOMIC_RELAXED, __HIP_MEMORY_SCOPE_AGENT); \
        __syncthreads(); it = (int)*qslot; __syncthreads(); } while (0)
    for (int r = (int)blockIdx.x; r < 1024; r += F.G) {
        if (EN & 0x800) {
            const int b = r >> 9, blk = r & 511;
#pragma unroll 1
            for (int k = 0; k < 2; ++k) { const int u = 8 * blk + F.wave; const int t = k ? (SEQ - 1 - u) : u; const int m = b * SEQ + t;
                select_row(F, m, (LAS unsigned*)wbuf, idxl);
                LDS_WAIT(); __builtin_amdgcn_wave_barrier();
#ifdef PROBE_SEL2
                select_row(F, m, (LAS unsigned*)wbuf, idxl); LDS_WAIT(); __builtin_amdgcn_wave_barrier();
#endif
#ifdef PROBE_ATT2
                sparse_attn_query(F, m, wbuf, TBA, idxl); LDS_WAIT(); __builtin_amdgcn_wave_barrier();
#endif
                sparse_attn_query(F, m, wbuf, TBA, idxl);
                LDS_WAIT(); __builtin_amdgcn_wave_barrier(); }
        }
    }
    __syncthreads();
    int it; MIX_FETCH(it); it += 1024;
    while (it < 1536) { const int r = it & 511; if (EN & 0x100) dense_attn_unit<2>(F, l, (r & 15) >> 3, r & 7, 31 - (r >> 4)); MIX_FETCH(it); it += 1024; }
    while (it < 2048) { const int r = it & 511; if (EN & 0x200) dense_attn_unit<3>(F, l, (r & 15) >> 3, r & 7, 31 - (r >> 4)); MIX_FETCH(it); it += 1024; }
    while (it < MIX_ITEMS) { const int r = it & 511; if (EN & 0x400) dense_attn_unit<1>(F, l, r >> 8, 0, 255 - (r & 255)); MIX_FETCH(it); it += 1024; }
#undef MIX_FETCH
}


__device__ __forceinline__ const float* gp_(const float* p) {
#if defined(__HIP_DEVICE_COMPILE__)
    __builtin_assume(!__builtin_amdgcn_is_shared((const __attribute__((address_space(0))) void*)p)); __builtin_assume(!__builtin_amdgcn_is_private((const __attribute__((address_space(0))) void*)p));
#endif
    return p; }
#ifndef PROBE_KINDS
#define PROBE_KINDS 0u
#endif
#ifndef PROBE_ATT
#define PROBE_ATT 0xF00u
#endif
#ifndef PROBE_REPS
#define PROBE_REPS 1
#endif
#ifndef MK_ONE_LAUNCH
#define MK_ONE_LAUNCH 1
#endif
constexpr int PH_PER_LAYER = 14, N_PHASES = 1 + DEPTH * PH_PER_LAYER;
struct Args { const float* in[15]; float* out; unsigned char* ws; int ph_lo, ph_hi; };
struct ArgsG { const GAS float* in[15]; GAS float* out; GAS unsigned char* ws; int ph_lo, ph_hi; };
template <unsigned EN> __global__ void __launch_bounds__(NTHREADS, 2) trunk_fwd(Args args) {
    extern __shared__ __attribute__((aligned(16))) unsigned char lds[];
    LAS unsigned char* const ldsb = (LAS unsigned char*)lds;
    const int wave0 = __builtin_amdgcn_readfirstlane((int)threadIdx.x >> 6);
    for (int u = threadIdx.x; u < (LDS_BYTES - LDSCTL_OFF) / 4; u += NTHREADS) ((LAS unsigned*)(ldsb + LDSCTL_OFF))[u] = 0u;
    __syncthreads();
#if MK_ONE_LAUNCH
    constexpr int lo = 0, hi = N_PHASES;
#else
    const int lo = args.ph_lo, hi = args.ph_hi;
#endif
    XcdBarrier bar; bar.bar = (unsigned*)(args.ws + WS_CTL) + CW_BAR; bar.x = 0; bar.st = nullptr;
    if (hi - lo > 1) bar = xcd_barrier_post((unsigned*)(args.ws + WS_CTL) + CW_BAR, (volatile LAS unsigned*)(ldsb + LDSCTL_OFF));
#define GP(p) ((const float*)(p))
#define PH_BEGIN(k, kind) if (lo <= (k) && (k) < hi) { _Pragma("unroll 1") for (int rep_ = 0; rep_ < (((PROBE_KINDS >> (kind)) & 1u) ? PROBE_REPS : 1); ++rep_) { Frame F; { \
        const ArgsG* ka = (const ArgsG*)__builtin_amdgcn_kernarg_segment_ptr(); asm volatile("" : "+s"(ka)); \
        unsigned o_ = ~0u; asm volatile("" : "+s"(o_)); int t_ = wave0 * 64 + (int)__builtin_amdgcn_mbcnt_hi(o_, __builtin_amdgcn_mbcnt_lo(o_, 0u)); asm volatile("" : "+v"(t_)); \
        F.lds = ldsb; F.tid = t_; F.lane = t_ & 63; F.wave = wave0; int gw_ = blockIdx.x * NWAVES + wave0; asm volatile("" : "+s"(gw_)); F.G = gridDim.x; F.gw = gw_; F.NGW = F.G * NWAVES; \
        unsigned char* ws = (unsigned char*)ka->ws; F.ctl = (gu32*)(ws + WS_CTL);     \
        F.x = GP(ka->in[0]); F.c = GP(ka->in[1]); F.w_ada = GP(ka->in[2]); F.b_ada = GP(ka->in[3]); F.norm_g = GP(ka->in[4]); F.w_in = GP(ka->in[5]); F.qk_g = GP(ka->in[6]); F.forget_b = GP(ka->in[7]); \
        F.sinks = GP(ka->in[8]); F.rel_table = GP(ka->in[9]); F.group_g = GP(ka->in[10]); F.w_out = GP(ka->in[11]); F.w_gate = GP(ka->in[12]); F.w_up = GP(ka->in[13]); F.w_down = GP(ka->in[14]); F.out = (float*)ka->out; \
        F.MOD = (float*)(ws + WS_MOD); F.LF = (float*)(ws + WS_LF); F.KB2 = (float*)(ws + WS_KB2); F.SC = (unsigned short*)(ws + WS_SC); F.IDX = (int*)(ws + WS_IDX); \
        F.WGU = (bf16*)(ws + WS_WGU); F.WD = (bf16*)(ws + WS_WD); F.WIN = (bf16*)(ws + WS_WIN); F.WOUT = (bf16*)(ws + WS_WOUT); \
        F.H = (bf16*)(ws + WS_H); F.P = (bf16*)(ws + WS_P); F.Y = (bf16*)(ws + WS_Y); F.XB = (bf16*)(ws + WS_XB); }
#define PH_END(k) if ((k) + 1 < hi) xcd_barrier(bar); } }

    PH_BEGIN(0, 31) if (EN & 1) p0_prologue(F); PH_END(0)

    for (int l = 0; l < DEPTH; ++l) {
        const int base = 1 + l * PH_PER_LAYER;
        for (int sub = 0; sub < 3; ++sub) {
            if (sub != 1) {
                const int f = sub >> 1, pb = base + (f ? 11 : 0), ni = f ? 2 : 0, lf = l * 2 + f;
                PH_BEGIN(pb, (f ? 11 : 0)) if (EN & 2) { const float* modl = F.MOD + (size_t)l * BATCH * NMOD;
                    if (l == 0 && f == 0) ph_modulate<FFN_FP8, false>(F, F.x, F.norm_g + ((size_t)l * 3 + ni) * DM, modl + (3 * ni + 0) * DM, modl + (3 * ni + 1) * DM);
                    else ph_modulate<FFN_FP8, true>(F, F.XB, F.norm_g + ((size_t)l * 3 + ni) * DM, modl + (3 * ni + 0) * DM, modl + (3 * ni + 1) * DM); } PH_END(pb)
                PH_BEGIN(pb + 1, (f ? 12 : 1)) if (EN & 4) {
                    pg8::StaticOrder S; S.init(M, NGU, F.G, (int)blockIdx.x);
                    if constexpr (FFN_FP8) { pg8::Gemm g{F.H, (const bf16*)((const unsigned char*)F.WGU + (size_t)lf * NGU * DM), M, NGU, DM, 127, W8_E8M0};
                        pg8::EpiSwiGLU8 E{(unsigned char*)F.P, DFFP};
                        pg8::gemm_phase<pg8::EpiSwiGLU8, pg8::StaticOrder, true, true, true>(F.lds + RING_OFF, g, S, E, F.tid); }
                    else { pg8::Gemm g{F.H, F.WGU + (size_t)lf * NGU * DM, M, NGU, DM};
                        pg8::EpiSwiGLU E{F.P, DFF};
                        pg8::gemm_phase<pg8::EpiSwiGLU, pg8::StaticOrder, true, true>(F.lds + RING_OFF, g, S, E, F.tid); } } PH_END(pb + 1)
                PH_BEGIN(pb + 2, (f ? 13 : 2)) if (EN & 8) {
                    pg8::Gemm g{F.P, FFN_FP8 ? (const bf16*)((const unsigned char*)F.WD + (size_t)lf * DM * DFFP) : F.WD + (size_t)lf * DM * DFF, M, DM, DFF, 127, FFN_FP8 ? W8_E8M0 : 127, FFN_FP8 ? DFFP : 0, FFN_FP8 ? DFFP : 0}; pg8::StaticOrder S; S.init(M, DM, F.G, (int)blockIdx.x);
                    const float* modl = F.MOD + (size_t)l * BATCH * NMOD;
                    if (l == DEPTH - 1 && f == 1) { pg8::EpiResid<false> E{F.XB, rep_ ? (void*)F.SC : (void*)F.out, DM, modl + (3 * ni + 2) * DM, NMOD, SEQ, 0.5f};
                        pg8::gemm_phase<pg8::EpiResid<false>, pg8::StaticOrder, true, true, FFN_FP8>(F.lds + RING_OFF, g, S, E, F.tid); }
                    else { pg8::EpiResid<true> E{F.XB, rep_ ? (void*)F.SC : (void*)F.XB, DM, modl + (3 * ni + 2) * DM, NMOD, SEQ, 0.5f};
                        pg8::gemm_phase<pg8::EpiResid<true>, pg8::StaticOrder, true, true, FFN_FP8>(F.lds + RING_OFF, g, S, E, F.tid); } } PH_END(pb + 2)
            } else {
                PH_BEGIN(base + 3, 3) if (EN & 2) { const float* modl = F.MOD + (size_t)l * BATCH * NMOD; ph_modulate<false, true>(F, F.XB, F.norm_g + ((size_t)l * 3 + 1) * DM, modl + 3 * DM, modl + 4 * DM); } PH_END(base + 3)
                PH_BEGIN(base + 4, 4) if (EN & 16) {
                    pg8::Gemm g{F.H, F.WIN + (size_t)l * NIN * DM, M, NIN, DM}; pg8::StaticOrder S; S.init(M, NIN, F.G, (int)blockIdx.x);
                    pg8::EpiBf16 E{F.P, NIN};
                    pg8::gemm_phase<pg8::EpiBf16, pg8::StaticOrder, true, true>(F.lds + RING_OFF, g, S, E, F.tid); } PH_END(base + 4)
                PH_BEGIN(base + 6, 6) if (EN & 64) { ph_scan(F, l);
                    int par_ = (int)((blockIdx.x & 1u) ^ 1u); asm volatile("" : "+s"(par_));
                    _Pragma("unroll 1") for (int st_ = 0; st_ < 2; ++st_) { if ((st_ ^ par_) == 0) { if (EN & 32) ph_post(F, l); } else ph_idx_scores(F); } } PH_END(base + 6)
                PH_BEGIN(base + 8, 8) if (EN & 0xF00) { if (rep_ == 0) ph_attention<EN>(F, l, 0); else ph_attention<(PROBE_ATT)>(F, l, 1); } PH_END(base + 8)
                PH_BEGIN(base + 9, 9) if (EN & 0x1000) ph_gnorm(F, l); PH_END(base + 9)
                PH_BEGIN(base + 10, 10) if (EN & 0x2000) {
                    pg8::Gemm g{F.Y, F.WOUT + (size_t)l * DM * DM, M, DM, DM}; pg8::StaticOrder S; S.init(M, DM, F.G, (int)blockIdx.x);
                    const float* modl = F.MOD + (size_t)l * BATCH * NMOD;
                    pg8::EpiResid<true> E{F.XB, rep_ ? (void*)F.SC : (void*)F.XB, DM, modl + 5 * DM, NMOD, SEQ, 1.0f};
                    pg8::gemm_phase<pg8::EpiResid<true>, pg8::StaticOrder, true, true>(F.lds + RING_OFF, g, S, E, F.tid); } PH_END(base + 10)
            }
        }
    }
#undef PH_BEGIN
#undef PH_END
}

#ifndef EN_MASK
#define EN_MASK 0xFFFFu
#endif
template <unsigned EN> static int setup_kernel() {
    if (hipFuncSetAttribute((const void*)trunk_fwd<EN>, hipFuncAttributeMaxDynamicSharedMemorySize, LDS_BYTES) != hipSuccess) { fprintf(stderr, "kernel_launch: hipFuncSetAttribute failed\n"); return -1; }
    int per_cu = 0;
    if (hipOccupancyMaxActiveBlocksPerMultiprocessor(&per_cu, (const void*)trunk_fwd<EN>, NTHREADS, LDS_BYTES) != hipSuccess || per_cu < 1) { fprintf(stderr, "kernel_launch: occupancy query says %d\n", per_cu); }
    (void)hipGetLastError();
    return 0;
}
template <unsigned EN> static void launch_range(const Args& a0, int lo, int hi, int grid, hipStream_t stream) {
    Args a = a0; a.ph_lo = lo; a.ph_hi = hi;
    hipLaunchKernelGGL(trunk_fwd<EN>, dim3(grid), dim3(NTHREADS), LDS_BYTES, stream, a);
}
extern "C" void kernel_launch(void* const* d_in, const int* in_sizes, int n_in, void* d_out, int out_size, void* d_ws, size_t ws_size, hipStream_t stream) {
    static int grid = 0;
    if (grid == 0) {
        if (n_in != 15 || in_sizes[0] != M * DM || out_size != M * DM || ws_size < WS_END) {
            fprintf(stderr, "kernel_launch: shape/workspace mismatch: n_in %d in0 %d out %d ws %zu (need %zu); nothing launched\n", n_in, n_in > 0 ? in_sizes[0] : -1, out_size, ws_size, (size_t)WS_END); grid = -1; return; }
        int dev = 0, cus = 0;
        if (hipGetDevice(&dev) != hipSuccess || hipDeviceGetAttribute(&cus, hipDeviceAttributeMultiprocessorCount, dev) != hipSuccess) { grid = -1; return; }
#if MK_ONE_LAUNCH
        if (setup_kernel<EN_MASK>()) { grid = -1; return; }
#else
        if (setup_kernel<0x1u>() || setup_kernel<0x2u>() || setup_kernel<0x4u>() || setup_kernel<0x8u>() || setup_kernel<0x10u>() || setup_kernel<0x20u>() || setup_kernel<0x40u>() || setup_kernel<0x80u>() ||
            setup_kernel<0x100u>() || setup_kernel<0x200u>() || setup_kernel<0x400u>() || setup_kernel<0x800u>() || setup_kernel<0x1000u>() || setup_kernel<0x2000u>()) { grid = -1; return; }
#endif
        grid = cus;
    }
    if (grid < 0) return;
    if (hipMemsetAsync((char*)d_ws + WS_CTL, 0, CTL_ZERO_BYTES, stream) != hipSuccess) return;
    Args a{};
    for (int i = 0; i < 15; ++i) a.in[i] = (const float*)d_in[i];
    a.out = (float*)d_out; a.ws = (unsigned char*)d_ws;
#if MK_ONE_LAUNCH
    launch_range<EN_MASK>(a, 0, N_PHASES, grid, stream);
#else
    launch_range<0x1u>(a, 0, 1, grid, stream);
    for (int l = 0; l < DEPTH; ++l) { const int base = 1 + l * PH_PER_LAYER;
        for (int f = 0; f < 2; ++f) { const int pb = base + (f ? 11 : 0);
            if (f == 1) {
                launch_range<0x2u>(a, base + 3, base + 4, grid, stream); launch_range<0x10u>(a, base + 4, base + 5, grid, stream); launch_range<0x20u>(a, base + 5, base + 6, grid, stream);
                launch_range<0x40u>(a, base + 6, base + 7, grid, stream); launch_range<0x80u>(a, base + 7, base + 8, grid, stream);
                launch_range<0x100u>(a, base + 8, base + 9, grid, stream); launch_range<0x200u>(a, base + 8, base + 9, grid, stream); launch_range<0x400u>(a, base + 8, base + 9, grid, stream); launch_range<0x800u>(a, base + 8, base + 9, grid, stream);
                launch_range<0x1000u>(a, base + 9, base + 10, grid, stream); launch_range<0x2000u>(a, base + 10, base + 11, grid, stream);
            }
            launch_range<0x2u>(a, pb, pb + 1, grid, stream); launch_range<0x4u>(a, pb + 1, pb + 2, grid, stream); launch_range<0x8u>(a, pb + 2, pb + 3, grid, stream);
        }
    }
#endif
}
```

```cpp
#include <hip/hip_runtime.h>
#include <cstdio>
#include <cstdint>

namespace pg8 {
#define PG8_LAS __attribute__((address_space(3)))
typedef unsigned short bf16_t;
typedef short bf16x8 __attribute__((ext_vector_type(8)));
typedef float f32x4 __attribute__((ext_vector_type(4)));
typedef unsigned u32x4 __attribute__((ext_vector_type(4)));
constexpr int BM = 256, BK = 64, HALF = 128, HTB = HALF * BK * 2  , STAGE_BYTES = 8 * HTB, NXCD = 8, WGM = 8;

__host__ __device__ __forceinline__ int lds_byte(int r, int c) { const int st = (r >> 4) * 2 + (c >> 5), rr = r & 15, cc = c & 31, ob = rr * 64 + cc * 2; return st * 1024 + (ob ^ (((ob >> 9) & 1) << 5)); }
__host__ __device__ __forceinline__ void stage_rc(int b, int& R, int& C) { const int st = b / 1024, sb = b % 1024, swz = sb ^ (((sb >> 9) & 1) << 5); R = (st >> 1) * 16 + swz / 64; C = (st & 1) * 32 + (swz % 64) / 2; }
__host__ __device__ __forceinline__ int perm32(int rho) { const int n = rho >> 4, i = rho & 15; return 8 * (i >> 2) + 4 * n + (i & 3); }

struct Unit { int pm, pn; };
struct Gemm { const bf16_t* A; const bf16_t* Bt; int M, N, K; int scaleA = 127, scaleB = 127; int lda = 0, ldb = 0; int blk = 0; };
typedef int i32x8 __attribute__((ext_vector_type(8))); typedef int i32x4v __attribute__((ext_vector_type(4)));
__device__ __forceinline__ i32x8 pg8_cat(bf16x8 lo, bf16x8 hi) { return __builtin_shufflevector(__builtin_bit_cast(i32x4v, lo), __builtin_bit_cast(i32x4v, hi), 0, 1, 2, 3, 4, 5, 6, 7); }

struct StaticOrder {
    int nM, nN, nwg, G, c;
    __host__ __device__ void init(int M, int N, int G_, int c_) { nM = M / BM; nN = N / BM; nwg = nM * nN; G = G_; c = c_; }
    __host__ __device__ bool next(int i, Unit& u) const {
        const long L = (long)i * G + c; if (L >= nwg) return false;
        int wgid = (int)L; { const int q = nwg / NXCD, r = nwg % NXCD, xcd = wgid % NXCD, off = wgid / NXCD; wgid = (xcd < r ? xcd * (q + 1) : r * (q + 1) + (xcd - r) * q) + off; }
        const int nig = WGM * nN, gid = wgid / nig, fm = gid * WGM, gsz = (nM - fm) < WGM ? (nM - fm) : WGM;
        u.pm = fm + ((wgid % nig) % gsz); u.pn = (wgid % nig) / gsz; return true;
    }
    __device__ __forceinline__ void a_ready(const Unit&) const {}
    __device__ __forceinline__ void done(const Unit&) const {}
};
typedef __bf16 pg8_bfpair __attribute__((ext_vector_type(2))); typedef float pg8_f32pair __attribute__((ext_vector_type(2)));
__device__ __forceinline__ unsigned cvt_pk_bf16(float lo, float hi) { const pg8_f32pair v = {lo, hi}; return __builtin_bit_cast(unsigned, __builtin_convertvector(v, pg8_bfpair)); }
__device__ __forceinline__ unsigned cvt_pk_bf16_nv(float lo, float hi) { return cvt_pk_bf16(lo, hi); }
__device__ __forceinline__ const char* uptr(const char* p) { const unsigned long long v = (unsigned long long)p; const unsigned lo = __builtin_amdgcn_readfirstlane((unsigned)v), hi = __builtin_amdgcn_readfirstlane((unsigned)(v >> 32)); return (const char*)(((unsigned long long)hi << 32) | lo); }
struct EpiBf16 {
    static constexpr bool PERM = true, AFTER_DRAIN = false;
    bf16_t* O; int ldc;
    __device__ __forceinline__ void operator()(const f32x4 (&acc)[2][2][4][2], const Unit& u, int wr, int wc, int fr, int fq) const {
        asm volatile("" : "+v"(fr), "+v"(fq));
        const int row0 = u.pm * BM + wr * 64 + fr; const int col0 = u.pn * BM + wc * 32 + 8 * fq;
#pragma unroll
        for (int ai = 0; ai < 2; ++ai)
#pragma unroll
            for (int m = 0; m < 4; ++m) { bf16_t* rowp = O + (size_t)(row0 + ai * HALF + m * 16) * ldc + col0;
#pragma unroll
                for (int bj = 0; bj < 2; ++bj) { const f32x4 v0 = acc[ai][bj][m][0], v1 = acc[ai][bj][m][1];
                    u32x4 w; w.x = cvt_pk_bf16(v0[0], v0[1]); w.y = cvt_pk_bf16(v0[2], v0[3]); w.z = cvt_pk_bf16(v1[0], v1[1]); w.w = cvt_pk_bf16(v1[2], v1[3]);
                    *(u32x4*)(rowp + bj * HALF) = w; } }
    }
};
__device__ __forceinline__ float silu_mul(float g, float u) { return g * u * __builtin_amdgcn_rcpf(1.0f + __builtin_amdgcn_exp2f(-1.4426950408889634f * g)); }
struct EpiSwiGLU {
    static constexpr bool PERM = true, AFTER_DRAIN = false;
    bf16_t* O; int ldc;
    __device__ __forceinline__ void operator()(const f32x4 (&acc)[2][2][4][2], const Unit& u, int wr, int wc, int fr, int fq) const {
        asm volatile("" : "+v"(fr), "+v"(fq));
        const int row0 = u.pm * BM + wr * 64 + fr; const int col0 = u.pn * HALF + wc * 32 + 8 * fq;
#pragma unroll
        for (int ai = 0; ai < 2; ++ai)
#pragma unroll
            for (int m = 0; m < 4; ++m) { bf16_t* rowp = O + (size_t)(row0 + ai * HALF + m * 16) * ldc + col0;
                const f32x4 g0 = acc[ai][0][m][0], g1 = acc[ai][0][m][1], u0 = acc[ai][1][m][0], u1 = acc[ai][1][m][1];
                u32x4 w; w.x = cvt_pk_bf16(silu_mul(g0[0], u0[0]), silu_mul(g0[1], u0[1])); w.y = cvt_pk_bf16(silu_mul(g0[2], u0[2]), silu_mul(g0[3], u0[3]));
                w.z = cvt_pk_bf16(silu_mul(g1[0], u1[0]), silu_mul(g1[1], u1[1])); w.w = cvt_pk_bf16(silu_mul(g1[2], u1[2]), silu_mul(g1[3], u1[3]));
                *(u32x4*)rowp = w; }
    }
};
template <bool OUT16> struct EpiResid {
    static constexpr bool PERM = false, AFTER_DRAIN = false;
    const bf16_t* base; void* out; int ldc; const float* gv; int gstride; int rows_per_batch; float coef;
    __device__ __forceinline__ void operator()(const f32x4 (&acc)[2][2][4][2], const Unit& u, int wr, int wc, int fr, int fq) const {
        typedef unsigned v2u_ __attribute__((ext_vector_type(2)));
        asm volatile("" : "+v"(fr), "+v"(fq));
        const int row0 = u.pm * BM + wr * 64 + fr; const int col0 = u.pn * BM + wc * 32 + 4 * fq;
        const float* gvec = gv + (size_t)((u.pm * BM) / rows_per_batch) * gstride + col0;
        f32x4 gg[2][2];
#pragma unroll
        for (int bj = 0; bj < 2; ++bj)
#pragma unroll
            for (int n = 0; n < 2; ++n) gg[bj][n] = *(const f32x4*)(gvec + bj * HALF + n * 16) * coef;
#pragma unroll
        for (int ai = 0; ai < 2; ++ai) {
            v2u_ bwv[4][2][2];
#pragma unroll
            for (int m = 0; m < 4; ++m) { const size_t off = (size_t)(row0 + ai * HALF + m * 16) * ldc + col0;
#pragma unroll
                for (int bj = 0; bj < 2; ++bj)
#pragma unroll
                    for (int n = 0; n < 2; ++n) bwv[m][bj][n] = *(const v2u_*)(base + off + bj * HALF + n * 16); }
#pragma unroll
            for (int m = 0; m < 4; ++m) { const size_t off = (size_t)(row0 + ai * HALF + m * 16) * ldc + col0;
#pragma unroll
                for (int bj = 0; bj < 2; ++bj)
#pragma unroll
                    for (int n = 0; n < 2; ++n) { const v2u_ bw = bwv[m][bj][n];
                        f32x4 bs; bs[0] = __builtin_bit_cast(float, bw.x << 16); bs[1] = __builtin_bit_cast(float, bw.x & 0xffff0000u); bs[2] = __builtin_bit_cast(float, bw.y << 16); bs[3] = __builtin_bit_cast(float, bw.y & 0xffff0000u);
                        const f32x4 r = bs + gg[bj][n] * acc[ai][bj][m][n];
                        if constexpr (OUT16) { v2u_ w; w.x = cvt_pk_bf16_nv(r[0], r[1]); w.y = cvt_pk_bf16_nv(r[2], r[3]); *(v2u_*)((bf16_t*)out + off + bj * HALF + n * 16) = w; }
                        else *(f32x4*)((float*)out + off + bj * HALF + n * 16) = r; } }
        }
    }
};
__device__ __forceinline__ unsigned pack_fp8x4(float a, float b, float c, float d) {
    a = fminf(fmaxf(a, -448.f), 448.f); b = fminf(fmaxf(b, -448.f), 448.f); c = fminf(fmaxf(c, -448.f), 448.f); d = fminf(fmaxf(d, -448.f), 448.f);
    int w = 0; w = __builtin_amdgcn_cvt_pk_fp8_f32(a, b, w, false); w = __builtin_amdgcn_cvt_pk_fp8_f32(c, d, w, true); return (unsigned)w; }
struct EpiSwiGLU8 {
    static constexpr bool PERM = true, AFTER_DRAIN = false;
    unsigned char* O; int ldc;
    __device__ __forceinline__ void operator()(const f32x4 (&acc)[2][2][4][2], const Unit& u, int wr, int wc, int fr, int fq) const {
        asm volatile("" : "+v"(fr), "+v"(fq));
        const int row0 = u.pm * BM + wr * 64 + fr; const int col0 = u.pn * HALF + wc * 32 + 8 * fq;
#pragma unroll
        for (int ai = 0; ai < 2; ++ai)
#pragma unroll
            for (int m = 0; m < 4; ++m) { unsigned char* rowp = O + (size_t)(row0 + ai * HALF + m * 16) * ldc + col0;
                const f32x4 g0 = acc[ai][0][m][0], g1 = acc[ai][0][m][1], u0 = acc[ai][1][m][0], u1 = acc[ai][1][m][1];
                typedef unsigned u32x2v __attribute__((ext_vector_type(2))); u32x2v w;
                w.x = pack_fp8x4(silu_mul(g0[0], u0[0]), silu_mul(g0[1], u0[1]), silu_mul(g0[2], u0[2]), silu_mul(g0[3], u0[3]));
                w.y = pack_fp8x4(silu_mul(g1[0], u1[0]), silu_mul(g1[1], u1[1]), silu_mul(g1[2], u1[2]), silu_mul(g1[3], u1[3]));
                *(u32x2v*)rowp = w; }
    }
};
template <class Epi, class Sched, bool ALIGN_EPI = false, bool SP2 = false, bool FP8 = false>
__device__ __forceinline__ void gemm_phase(PG8_LAS unsigned char* lds, const Gemm g, const Sched& S, const Epi& E, int tid_in) {
    int tid_ = tid_in; asm volatile("" : "+v"(tid_));
    const int tid = tid_, wid = __builtin_amdgcn_readfirstlane(tid >> 6), lane = tid & 63, wr = wid >> 2, wc = wid & 3, fr = lane & 15, fq = lane >> 4;
    const int K = g.K, nt = FP8 ? K / (2 * BK) : K / BK;
    const int pitchA = g.blk ? 2 * BK : g.lda ? g.lda : (FP8 ? K : 2 * K), pitchB = g.blk ? 2 * BK : g.ldb ? g.ldb : (FP8 ? K : 2 * K);
    unsigned voffA[2], voffB[2];
#pragma unroll
    for (int i = 0; i < 2; ++i) { int R, C; stage_rc(tid * 16 + i * 8192, R, C); const int Rb = Epi::PERM ? ((R & ~31) + perm32(R & 31)) : R;
        voffA[i] = (unsigned)(R * pitchA + C * 2); voffB[i] = (unsigned)(Rb * pitchB + C * 2); }
    const size_t kstep = g.blk ? (size_t)(512 * BK) : (size_t)(BK * 2);
    const size_t hstepA = (size_t)HALF * pitchA, hstepB = (size_t)HALF * pitchB;
    const size_t tstepA = g.blk ? (size_t)(FP8 ? K / (2 * BK) : K / BK) * kstep : 2 * hstepA, tstepB = g.blk ? tstepA : 2 * hstepB;
    const unsigned ldsw = (unsigned)wid * 1024u;
    const int aoff = lds_byte(wr * 64 + fr, fq * 8), boff = lds_byte(wc * 32 + fr, fq * 8);
    PG8_LAS unsigned char* abase = lds + aoff; PG8_LAS unsigned char* bbase = lds + boff + 4 * HTB;
#define PG8_SA(b, h) (((b) * 2 + (h)) * HTB)
#define PG8_SB(b, h) ((4 + (b) * 2 + (h)) * HTB)
#define PG8_STAGE(bufoff, gbase, voff) do { _Pragma("unroll") for (int _i = 0; _i < 2; ++_i) \
        __builtin_amdgcn_global_load_lds((const unsigned*)((const char*)(gbase) + (voff)[_i]), (PG8_LAS unsigned*)(lds + (bufoff) + ldsw + _i * 8192), 16, 0, 0); } while (0)
#define PG8_RDA(off) (*(const PG8_LAS bf16x8*)(abase + (off)))
#define PG8_RDB(off) (*(const PG8_LAS bf16x8*)(bbase + ((off) - 4 * HTB)))
#define PG8_LDA(dst, b, h) do { if constexpr (FP8) { _Pragma("unroll") for (int m = 0; m < 4; ++m) dst##8[m] = pg8_cat(PG8_RDA(PG8_SA(b, h) + m * 2048), PG8_RDA(PG8_SA(b, h) + m * 2048 + 1024)); } \
    else { _Pragma("unroll") for (int m = 0; m < 4; ++m) _Pragma("unroll") for (int k = 0; k < 2; ++k) dst[m][k] = PG8_RDA(PG8_SA(b, h) + m * 2048 + k * 1024); } } while (0)
#define PG8_LDB(dst, b, h) do { if constexpr (FP8) { _Pragma("unroll") for (int n = 0; n < 2; ++n) dst##8[n] = pg8_cat(PG8_RDB(PG8_SB(b, h) + n * 2048), PG8_RDB(PG8_SB(b, h) + n * 2048 + 1024)); } \
    else { _Pragma("unroll") for (int n = 0; n < 2; ++n) _Pragma("unroll") for (int k = 0; k < 2; ++k) dst[n][k] = PG8_RDB(PG8_SB(b, h) + n * 2048 + k * 1024); } } while (0)
#define PG8_MMA(ai, bj, At, Bt) do { __builtin_amdgcn_s_setprio(1); if constexpr (FP8) { \
        _Pragma("unroll") for (int m = 0; m < 4; ++m) _Pragma("unroll") for (int n = 0; n < 2; ++n) \
            asm volatile("v_mfma_scale_f32_16x16x128_f8f6f4 %0, %1, %2, %0, %3, %4 op_sel_hi:[0,0,0]" : "+v"(acc[ai][bj][m][n]) : "v"(Bt##8[n]), "v"(At##8[m]), "v"(sclB), "v"(sclA)); \
        } else { _Pragma("unroll") for (int m = 0; m < 4; ++m) _Pragma("unroll") for (int n = 0; n < 2; ++n) _Pragma("unroll") for (int k = 0; k < 2; ++k) \
        acc[ai][bj][m][n] = __builtin_amdgcn_mfma_f32_16x16x32_bf16(Bt[n][k], At[m][k], acc[ai][bj][m][n], 0, 0, 0); } __builtin_amdgcn_s_setprio(0); } while (0)
#define PG8_WAIT_V(n) asm volatile("s_waitcnt vmcnt(" #n ")" ::: "memory")
#define PG8_WAIT_L(n) asm volatile("s_waitcnt lgkmcnt(" #n ")" ::: "memory")
#define PG8_BAR __builtin_amdgcn_s_barrier()
#define PG8_SCHED __builtin_amdgcn_sched_barrier(0)
    Unit cur, nxt; int ui = 0;
    if (!S.next(0, cur)) return;
    f32x4 acc[2][2][4][2];
#pragma unroll
    for (int a = 0; a < 2; ++a)
#pragma unroll
        for (int b = 0; b < 2; ++b)
#pragma unroll
            for (int m = 0; m < 4; ++m)
#pragma unroll
                for (int n = 0; n < 2; ++n) acc[a][b][m][n] = (f32x4){0.f, 0.f, 0.f, 0.f};
    const int sclA = g.scaleA, sclB = g.scaleB;
    bf16x8 At[4][2], B0[2][2], B1[2][2]; i32x8 At8[4], B08[2], B18[2];
    const char* cA = uptr((const char*)g.A + (size_t)cur.pm * tstepA); const char* cB = uptr((const char*)g.Bt + (size_t)cur.pn * tstepB);
    S.a_ready(cur);
    if constexpr (SP2) {
        PG8_STAGE(PG8_SB(0, 0), cB, voffB); PG8_STAGE(PG8_SB(0, 1), cB + hstepB, voffB); PG8_STAGE(PG8_SA(0, 0), cA, voffA); PG8_STAGE(PG8_SA(0, 1), cA + hstepA, voffA);
        if (wr == 1) PG8_BAR;
        PG8_WAIT_V(2); PG8_BAR;
        PG8_STAGE(PG8_SB(1, 0), cB + kstep, voffB); PG8_STAGE(PG8_SA(1, 0), cA + kstep, voffA); PG8_STAGE(PG8_SB(1, 1), cB + hstepB + kstep, voffB);
        PG8_WAIT_V(6); PG8_BAR;
    } else {
        PG8_STAGE(PG8_SB(0, 0), cB, voffB); PG8_STAGE(PG8_SA(0, 0), cA, voffA); PG8_STAGE(PG8_SB(0, 1), cB + hstepB, voffB); PG8_STAGE(PG8_SA(0, 1), cA + hstepA, voffA);
        if (wr == 1) PG8_BAR;
        PG8_WAIT_V(4); PG8_BAR;
        PG8_STAGE(PG8_SB(1, 0), cB + kstep, voffB); PG8_STAGE(PG8_SA(1, 0), cA + kstep, voffA); PG8_STAGE(PG8_SB(1, 1), cB + hstepB + kstep, voffB);
        PG8_WAIT_V(6); PG8_BAR;
    }
    for (;;) {
        const bool has_next = S.next(ui + 1, nxt);
        const char* nA = uptr(has_next ? (const char*)g.A + (size_t)nxt.pm * tstepA : cA); const char* nB = uptr(has_next ? (const char*)g.Bt + (size_t)nxt.pn * tstepB : cB);
        for (int t = 0; t < nt; t += 2) {
            asm volatile("" : "+v"(abase), "+v"(bbase));
            const bool last = (t == nt - 2);
            const char* a1 = cA + (size_t)(t + 1) * kstep;
            const char* a2 = uptr(last ? nA : cA + (size_t)(t + 2) * kstep); const char* b2 = uptr(last ? nB : cB + (size_t)(t + 2) * kstep);
            const char* a3 = a2 + kstep; const char* b3 = b2 + kstep;
            if (last && has_next) S.a_ready(nxt);
            if constexpr (SP2) {
            PG8_LDB(B0, 0, 0); PG8_LDB(B1, 0, 1); PG8_SCHED; PG8_LDA(At, 0, 0); PG8_STAGE(PG8_SA(1, 1), a1 + hstepA, voffA);
            PG8_WAIT_V(8); PG8_WAIT_L(0); PG8_BAR; PG8_MMA(0, 0, At, B0); PG8_MMA(0, 1, At, B1); PG8_BAR; PG8_SCHED;
            PG8_LDA(At, 0, 1); PG8_STAGE(PG8_SB(0, 0), b2, voffB); PG8_STAGE(PG8_SB(0, 1), b2 + hstepB, voffB); PG8_STAGE(PG8_SA(0, 0), a2, voffA);
            PG8_WAIT_V(8); PG8_WAIT_L(0); PG8_BAR; PG8_MMA(1, 0, At, B0); PG8_MMA(1, 1, At, B1); PG8_BAR; PG8_SCHED;
            PG8_LDB(B0, 1, 0); PG8_LDB(B1, 1, 1); PG8_SCHED; PG8_LDA(At, 1, 0); PG8_STAGE(PG8_SA(0, 1), a2 + hstepA, voffA);
            PG8_WAIT_V(8); PG8_WAIT_L(0); PG8_BAR; PG8_MMA(0, 0, At, B0); PG8_MMA(0, 1, At, B1); PG8_BAR; PG8_SCHED;
            PG8_LDA(At, 1, 1); PG8_STAGE(PG8_SB(1, 0), b3, voffB); PG8_STAGE(PG8_SB(1, 1), b3 + hstepB, voffB); PG8_STAGE(PG8_SA(1, 0), a3, voffA);
            PG8_WAIT_V(8); PG8_WAIT_L(0); PG8_BAR; PG8_MMA(1, 0, At, B0); PG8_MMA(1, 1, At, B1); PG8_BAR; PG8_SCHED;
            } else {
            PG8_LDB(B0, 0, 0); PG8_SCHED; PG8_LDA(At, 0, 0); PG8_STAGE(PG8_SA(1, 1), a1 + hstepA, voffA);
            PG8_WAIT_L(8); PG8_BAR; PG8_WAIT_L(0); PG8_MMA(0, 0, At, B0); PG8_BAR; PG8_SCHED;
            PG8_LDB(B1, 0, 1); PG8_STAGE(PG8_SB(0, 0), b2, voffB);
            PG8_BAR; PG8_WAIT_L(0); PG8_MMA(0, 1, At, B1); PG8_BAR;
            PG8_LDA(At, 0, 1); PG8_STAGE(PG8_SA(0, 0), a2, voffA);
            PG8_BAR; PG8_WAIT_L(0); PG8_MMA(1, 0, At, B0); PG8_BAR; PG8_SCHED;
            PG8_STAGE(PG8_SB(0, 1), b2 + hstepB, voffB);
            PG8_WAIT_V(6); PG8_BAR; PG8_MMA(1, 1, At, B1); PG8_BAR;
            PG8_LDB(B0, 1, 0); PG8_SCHED; PG8_LDA(At, 1, 0); PG8_STAGE(PG8_SA(0, 1), a2 + hstepA, voffA);
            PG8_WAIT_L(8); PG8_BAR; PG8_WAIT_L(0); PG8_MMA(0, 0, At, B0); PG8_BAR; PG8_SCHED;
            PG8_LDB(B1, 1, 1); PG8_STAGE(PG8_SB(1, 0), b3, voffB);
            PG8_BAR; PG8_WAIT_L(0); PG8_MMA(0, 1, At, B1); PG8_BAR;
            PG8_LDA(At, 1, 1); PG8_STAGE(PG8_SA(1, 0), a3, voffA);
            PG8_BAR; PG8_WAIT_L(0); PG8_MMA(1, 0, At, B0); PG8_BAR; PG8_SCHED;
            PG8_STAGE(PG8_SB(1, 1), b3 + hstepB, voffB);
            PG8_WAIT_V(6); PG8_BAR; PG8_MMA(1, 1, At, B1); PG8_BAR;
            }
        }
        if constexpr (FP8) asm volatile("s_nop 15\n\ts_nop 7" ::: "memory");
        if constexpr (ALIGN_EPI) { if (wr == 0) PG8_BAR; }
        if constexpr (!Epi::AFTER_DRAIN) { E(acc, cur, wr, wc, fr, fq); S.done(cur); }
        if (!has_next) break;
#pragma unroll
        for (int a = 0; a < 2; ++a)
#pragma unroll
            for (int b = 0; b < 2; ++b)
#pragma unroll
                for (int m = 0; m < 4; ++m)
#pragma unroll
                    for (int n = 0; n < 2; ++n) acc[a][b][m][n] = (f32x4){0.f, 0.f, 0.f, 0.f};
        cur = nxt; cA = nA; cB = nB; ++ui;
        if constexpr (ALIGN_EPI) { if (wr == 1) PG8_BAR; }
    }
    PG8_WAIT_V(0);
    if constexpr (!ALIGN_EPI) { if (wr == 0) PG8_BAR; }
    PG8_BAR;
    if constexpr (Epi::AFTER_DRAIN) { E.fused(acc, cur, wr, wc, fr, fq, lds, wid, lane); S.done(cur); }
#undef PG8_SA
#undef PG8_SB
#undef PG8_STAGE
#undef PG8_RDA
#undef PG8_RDB
#undef PG8_LDA
#undef PG8_LDB
#undef PG8_MMA
#undef PG8_WAIT_V
#undef PG8_WAIT_L
#undef PG8_BAR
#undef PG8_SCHED
}
}

#ifndef MK_FFN_FP8
#define MK_FFN_FP8 1
#endif
constexpr bool FFN_FP8 = MK_FFN_FP8;
constexpr int NWAVES = 8, NTHREADS = NWAVES * 64;
constexpr int BATCH = 2, SEQ = 8192, M = BATCH * SEQ, DM = 2048, DEPTH = 4, DFF = 5632, NGU = 2 * DFF, INC = 5976, NIN = 6144, NMOD = 9 * DM;
constexpr int DFFP = DFF + 128;
constexpr int NH = 8, HD = 64, GWID = 512, TOPK = 256, WINDOW = 128;
constexpr int PA_Q = 0, PA_K = 512, PA_V = 576, PA_IQ = 640, PA_IK = 1664, PB_Q = 1728, PB_K = 2240, PB_V = 2304, PC_Q = 2368, PC_K = 2880, PC_V = 3392, PC_G = 3904,
              PD_Q = 4416, PD_K = 4928, PD_V = 5440, PA_IW = 5952, PC_F = 5968;
constexpr float RMS_EPS = 1e-6f, LOG2E = 1.4426950408889634f, QSCALE = 0.125f * LOG2E;

constexpr size_t MiB = 1u << 20;
constexpr size_t WS_CTL = 0, CTL_ZERO_BYTES = 64 * 1024;
constexpr size_t WS_MOD = 1 * MiB;
constexpr size_t WS_LF = 2 * MiB;
constexpr size_t WS_KB2 = 3 * MiB;
constexpr size_t WS_WGU = 4 * MiB;
constexpr size_t SZ_WGU = (size_t)NGU * DM * 2;
constexpr size_t WS_WD = WS_WGU + 8 * SZ_WGU;
constexpr size_t SZ_WD = (size_t)DM * DFF * 2;
constexpr size_t WS_WIN = WS_WD + 8 * SZ_WD;
constexpr size_t SZ_WIN = (size_t)NIN * DM * 2;
constexpr size_t WS_WOUT = WS_WIN + 4 * SZ_WIN;
constexpr size_t SZ_WOUT = (size_t)DM * DM * 2;
constexpr size_t WS_H = WS_WOUT + 4 * SZ_WOUT;
constexpr size_t WS_P = WS_H + (size_t)M * DM * 2;
constexpr size_t WS_Y = WS_P + (size_t)M * NIN * 2;
constexpr size_t WS_IDX = WS_Y + (size_t)M * DM * 2;
constexpr size_t WS_SC = WS_IDX + (size_t)M * TOPK * 4;
constexpr size_t WS_XB = WS_SC + (size_t)BATCH * SEQ * SEQ * 2;
constexpr size_t WS_END = WS_XB + (size_t)M * DM * 2;
static_assert(WS_WGU % MiB == 0 && WS_WD % MiB == 0 && WS_WIN % MiB == 0 && WS_WOUT % MiB == 0 && WS_H % MiB == 0 && WS_P % MiB == 0 && WS_Y % MiB == 0 && WS_IDX % MiB == 0 && WS_SC % MiB == 0, "d_ws map alignment");
constexpr int CW_BAR = 4096;

constexpr int RING_OFF = 0, RING_BYTES = 131072;
constexpr int AUX_OFF = RING_BYTES, AUX_BYTES = 16384;
constexpr int LDSCTL_OFF = AUX_OFF + AUX_BYTES;
constexpr int LDS_BYTES = LDSCTL_OFF + 256;

#define GAS __attribute__((address_space(1)))
#define LAS __attribute__((address_space(3)))
typedef unsigned short bf16;
typedef unsigned v4u __attribute__((ext_vector_type(4)));
typedef unsigned v2u __attribute__((ext_vector_type(2)));
typedef int v4i __attribute__((ext_vector_type(4)));
typedef float f32x4 __attribute__((ext_vector_type(4)));
typedef float f32x16 __attribute__((ext_vector_type(16)));
typedef short bf16x8 __attribute__((ext_vector_type(8)));
typedef short s16x4 __attribute__((ext_vector_type(4)));
typedef GAS unsigned gu32;
#define RLX_AGENT __ATOMIC_RELAXED, __HIP_MEMORY_SCOPE_AGENT
#define LDS_WAIT() asm volatile("s_waitcnt lgkmcnt(0)" ::: "memory")
#define VM_WAIT() asm volatile("s_waitcnt vmcnt(0)" ::: "memory")
__device__ __forceinline__ unsigned f2bf(float f) { unsigned u = __builtin_bit_cast(unsigned, f); return (u + 0x7fffu + ((u >> 16) & 1u)) >> 16; }
__device__ __forceinline__ unsigned pk2(float lo, float hi) { return f2bf(lo) | (f2bf(hi) << 16); }
__device__ __forceinline__ float bf_lo(unsigned w) { return __builtin_bit_cast(float, w << 16); }
__device__ __forceinline__ float bf_hi(unsigned w) { return __builtin_bit_cast(float, w & 0xffff0000u); }
__device__ __forceinline__ float bf2f(bf16 h) { return __builtin_bit_cast(float, (unsigned)h << 16); }
__device__ __forceinline__ float wave_sum(float v) {
#pragma unroll
    for (int o = 1; o < 64; o <<= 1) v += __shfl_xor(v, o);
    return v;
}
__device__ __forceinline__ float fexp2(float x) { return __builtin_amdgcn_exp2f(x); }
__device__ __forceinline__ float frcp(float x) { return __builtin_amdgcn_rcpf(x); }
__device__ const unsigned char kBucketLut[128] = {0, 1, 2, 3, 4, 5, 6, 7, 8, 9, 10, 11, 12, 13, 14, 15, 16, 16, 16, 17, 17, 18, 18, 18, 19, 19, 19, 20, 20, 20, 20, 21, 21, 21, 21, 22, 22, 22, 22, 22,
    23, 23, 23, 23, 23, 23, 24, 24, 24, 24, 24, 24, 25, 25, 25, 25, 25, 25, 25, 26, 26, 26, 26, 26, 26, 26, 26, 27, 27, 27, 27, 27, 27, 27, 27, 27, 27, 28, 28, 28, 28, 28, 28, 28, 28, 28, 28,
    29, 29, 29, 29, 29, 29, 29, 29, 29, 29, 29, 29, 30, 30, 30, 30, 30, 30, 30, 30, 30, 30, 30, 30, 30, 30, 31, 31, 31, 31, 31, 31, 31, 31, 31, 31, 31, 31, 31, 31, 31};

#define XB_TMO      128
#define XB_XCNT(j)  (256  + 64 * (j))
#define XB_XSUB(j)  (1280 + 64 * (j))
#define XB_XGEN(j)  (2304 + 64 * (j))
#define XB_TOP      3328
#define XB_TOPGEN   3392
#define XCD_BAR_WORDS 3456
#define XB_SPIN_CAP (1u << 18)

__device__ __forceinline__ unsigned xb_ld(unsigned* p)              { return __hip_atomic_load((GAS unsigned*)p, __ATOMIC_RELAXED, __HIP_MEMORY_SCOPE_AGENT); }
__device__ __forceinline__ unsigned xb_add(unsigned* p, unsigned v) { return __hip_atomic_fetch_add((GAS unsigned*)p, v, __ATOMIC_RELAXED, __HIP_MEMORY_SCOPE_AGENT); }
__device__ __forceinline__ unsigned xb_xcc_id() { return (unsigned)__builtin_amdgcn_s_getreg((3 << 11) | 20) & 0xFu; }
#define XB_SPIN(cond, bar) do { unsigned _sp = 0; while (cond) { __builtin_amdgcn_s_sleep(1); \
    if ((++_sp & 255u) == 0u) { if (xb_ld(&(bar)[XB_TMO])) break; if (_sp > XB_SPIN_CAP) { xb_add(&(bar)[XB_TMO], 1u); break; } } } } while (0)

struct XcdBarrier {
    unsigned* bar; unsigned x;
    volatile LAS unsigned* st;
};

__device__ __forceinline__ XcdBarrier xcd_barrier_post(unsigned* bar, volatile LAS unsigned* st) {
    XcdBarrier b; b.bar = bar; b.x = xb_xcc_id(); b.st = st;
    if (threadIdx.x == 0) (void)xb_add(&bar[XB_XCNT(b.x)], 1u);
    return b;
}
__device__ __forceinline__ void xcd_barrier_complete(unsigned* bar, unsigned x, unsigned& nloc, unsigned& nx) {
    const unsigned G = gridDim.x * gridDim.y * gridDim.z;
    unsigned sum, cnt, mine, sp = 0u;
    for (;;) {
        sum = 0u; cnt = 0u; mine = 0u;
#pragma unroll
        for (unsigned j = 0; j < 16; ++j) { const unsigned c = xb_ld(&bar[XB_XCNT(j)]); sum += c; cnt += (c > 0u) ? 1u : 0u; mine = (j == x) ? c : mine; }
        if (sum == G) break;
        __builtin_amdgcn_s_sleep(1);
        if ((++sp & 255u) == 0u) { if (xb_ld(&bar[XB_TMO])) break; if (sp > XB_SPIN_CAP) { xb_add(&bar[XB_TMO], 1u); break; } }
    }
    nloc = mine > 0u ? mine : 1u; nx = cnt > 0u ? cnt : 1u;
}

__device__ __forceinline__ void xcd_barrier(const XcdBarrier& b) {
    asm volatile("s_waitcnt vmcnt(0)" ::: "memory");
    __syncthreads();
    if (threadIdx.x == 0) {
        unsigned* bar = b.bar; asm volatile("" : "+s"(bar));
        __builtin_amdgcn_s_waitcnt(0);
        unsigned nloc = b.st[0], nx = b.st[1];
        if (nloc == 0u) { xcd_barrier_complete(bar, b.x, nloc, nx); b.st[0] = nloc; b.st[1] = nx; }
        const unsigned old = xb_add(&bar[XB_XSUB(b.x)], 1u);
        const unsigned gen = old / nloc;
        if (old + 1u == (gen + 1u) * nloc) {
            __builtin_amdgcn_fence(__ATOMIC_RELEASE, "agent");
            asm volatile("s_waitcnt vmcnt(0)" ::: "memory");
            const unsigned og = xb_add(&bar[XB_TOP], 1u);
            const unsigned tg = og / nx;
            if (og + 1u == (tg + 1u) * nx) xb_add(&bar[XB_TOPGEN], 1u);
            else XB_SPIN(xb_ld(&bar[XB_TOPGEN]) == tg, bar);
            __builtin_amdgcn_fence(__ATOMIC_ACQUIRE, "agent");
            xb_add(&bar[XB_XGEN(b.x)], 1u);
            asm volatile("s_waitcnt vmcnt(0)" ::: "memory");
        } else {
            XB_SPIN(xb_ld(&bar[XB_XGEN(b.x)]) == gen, bar);
            __builtin_amdgcn_fence(__ATOMIC_ACQUIRE, "agent");
            asm volatile("s_waitcnt vmcnt(0)" ::: "memory");
        }
    }
    __syncthreads();
}

struct Frame {
    LAS unsigned char* lds;
    gu32* ctl;
    int tid, lane, wave, G, gw, NGW;
    const float *x, *c, *w_ada, *b_ada, *norm_g, *w_in, *qk_g, *forget_b, *sinks, *rel_table, *group_g, *w_out, *w_gate, *w_up, *w_down;
    float* out;
    float *MOD, *LF, *KB2; unsigned short* SC; int* IDX;
    bf16 *WGU, *WD, *WIN, *WOUT, *H, *P, *Y, *XB;
};

template <int MAP> __device__ __forceinline__ int w_rowmap(int n) {
    if (MAP == 1) return 256 * (n >> 7) + (n & 127);
    if (MAP == 2) return 256 * (n >> 7) + 128 + (n & 127);
    if (MAP == 3) { if (n < 1728) return n; if (n < 1744) return PA_IW + (n - 1728); if (n < 3920) return n - 16; if (n < 3928) return PC_F + (n - 3920); return n - 24; }
    return n;
}
template <int MAP> __device__ __forceinline__ void p0_transpose_item(const float* W, int K, int N, bf16* WT, LAS unsigned* T, int item, int lane) {
    const int nblk = (N + 63) / 64, kb = item / nblk, nb = item % nblk, k0 = 64 * kb, n0 = 64 * nb;
    const int r = lane >> 4, c = lane & 15;
    const bool nok = (n0 + 4 * c) < N;
    const float* src = W + (size_t)(k0 + 2 * r) * N + n0 + 4 * c;
    f32x4 a[8], b[8];
#pragma unroll
    for (int i = 0; i < 8; ++i) { a[i] = nok ? *(const GAS f32x4*)(src + (size_t)(8 * i) * N) : (f32x4){0.f, 0.f, 0.f, 0.f}; b[i] = nok ? *(const GAS f32x4*)(src + (size_t)(8 * i + 1) * N) : (f32x4){0.f, 0.f, 0.f, 0.f}; }
#pragma unroll
    for (int i = 0; i < 8; ++i)
#pragma unroll
        for (int e = 0; e < 4; ++e) T[(4 * c + e) * 36 + 4 * i + r] = pk2(a[i][e], b[i][e]);
    LDS_WAIT(); asm volatile("" ::: "memory");
    const int rr = lane >> 3, ch = lane & 7;
#pragma unroll
    for (int j = 0; j < 8; ++j) { const int n = 8 * j + rr; const v4u o = *(const LAS v4u*)(T + n * 36 + 4 * ch);
        if (n0 + n < N) *(GAS v4u*)(WT + (size_t)w_rowmap<MAP>(n0 + n) * K + k0 + 8 * ch) = o; }
    LDS_WAIT(); asm volatile("" ::: "memory");
}
constexpr float W8_SCALE = 64.0f; constexpr int W8_E8M0 = 127 - 6;
__device__ __forceinline__ unsigned pk_fp8x4(float a, float b, float c, float d) {
    a = fminf(fmaxf(a, -448.f), 448.f); b = fminf(fmaxf(b, -448.f), 448.f); c = fminf(fmaxf(c, -448.f), 448.f); d = fminf(fmaxf(d, -448.f), 448.f);
    int w = 0; w = __builtin_amdgcn_cvt_pk_fp8_f32(a, b, w, false); w = __builtin_amdgcn_cvt_pk_fp8_f32(c, d, w, true); return (unsigned)w; }
template <int MAP> __device__ __forceinline__ void p0_transpose8_item(const float* W, int K, int N, unsigned char* WT, int ldw, LAS unsigned* T, int item, int lane) {
    const int nblk = (N + 63) / 64, kb = item / nblk, nb = item % nblk, k0 = 64 * kb, n0 = 64 * nb;
    const int r = lane >> 4, c = lane & 15;
    const bool nok = (n0 + 4 * c) < N;
    const float* src = W + (size_t)(k0 + 4 * r) * N + n0 + 4 * c;
    f32x4 q[4][4];
#pragma unroll
    for (int i = 0; i < 4; ++i)
#pragma unroll
        for (int d = 0; d < 4; ++d) q[i][d] = nok ? *(const GAS f32x4*)(src + (size_t)(16 * i + d) * N) : (f32x4){0.f, 0.f, 0.f, 0.f};
#pragma unroll
    for (int i = 0; i < 4; ++i)
#pragma unroll
        for (int e = 0; e < 4; ++e) T[(4 * c + e) * 20 + 4 * i + r] = pk_fp8x4(q[i][0][e] * W8_SCALE, q[i][1][e] * W8_SCALE, q[i][2][e] * W8_SCALE, q[i][3][e] * W8_SCALE);
    LDS_WAIT(); asm volatile("" ::: "memory");
    const int rr = lane >> 2, ch = lane & 3;
#pragma unroll
    for (int j = 0; j < 4; ++j) { const int n = 16 * j + rr; const v4u o = *(const LAS v4u*)(T + n * 20 + 4 * ch);
        if (n0 + n < N) *(GAS v4u*)(WT + (size_t)w_rowmap<MAP>(n0 + n) * ldw + k0 + 16 * ch) = o; }
    LDS_WAIT(); asm volatile("" ::: "memory");
}
template <int MAP> __device__ __forceinline__ void p0_transpose8(const Frame& F, const float* W, int K, int N, unsigned char* WT, int ldw, LAS unsigned* scr) {
    const int nitems = (K / 64) * ((N + 63) / 64);
    for (int it = F.gw; it < nitems; it += F.NGW) p0_transpose8_item<MAP>(W, K, N, WT, ldw, scr, it, F.lane);
}
template <int MAP> __device__ __forceinline__ void p0_transpose(const Frame& F, const float* W, int K, int N, bf16* WT, LAS unsigned* scr) {
    const int nitems = (K / 64) * ((N + 63) / 64);
    for (int it = F.gw; it < nitems; it += F.NGW) p0_transpose_item<MAP>(W, K, N, WT, scr, it, F.lane);
}
__device__ __forceinline__ void p0_prologue(const Frame& F) {
    LAS unsigned* scr = (LAS unsigned*)(F.lds + RING_OFF + F.wave * 16384);
    LAS float* cond = (LAS float*)(F.lds + AUX_OFF);
    LAS float* red = (LAS float*)(F.lds + RING_OFF);
    for (int i = F.tid; i < BATCH * DM; i += NTHREADS) { const float v = F.c[i]; cond[i] = v / (1.0f + __expf(-v)); }
    __syncthreads();
    for (int it = blockIdx.x; it < DEPTH * (NMOD / 64); it += F.G) {
        const int l = it / (NMOD / 64), n = (it % (NMOD / 64)) * 64 + F.lane;
        const float* w = F.w_ada + (size_t)l * DM * NMOD + (size_t)(256 * F.wave) * NMOD + n;
        const LAS float* c0 = cond + 256 * F.wave; const LAS float* c1 = cond + DM + 256 * F.wave;
        float a0 = 0.f, a1 = 0.f;
#pragma unroll 32
        for (int k = 0; k < 256; ++k) { const float wv = w[(size_t)k * NMOD]; a0 += c0[k] * wv; a1 += c1[k] * wv; }
        red[F.wave * 128 + F.lane] = a0; red[F.wave * 128 + 64 + F.lane] = a1;
        __syncthreads();
        if (F.tid < 128) { float sacc = 0.f;
#pragma unroll
            for (int wv = 0; wv < 8; ++wv) sacc += red[wv * 128 + F.tid];
            const int bsel = F.tid >> 6, nn = (it % (NMOD / 64)) * 64 + (F.tid & 63);
            F.MOD[((size_t)l * BATCH + bsel) * NMOD + nn] = sacc + F.b_ada[(size_t)l * NMOD + nn]; }
        __syncthreads();
    }
    for (int lf = 0; lf < DEPTH * 2; ++lf) {
        if (FFN_FP8) {
            p0_transpose8<1>(F, F.w_gate + (size_t)lf * DM * DFF, DM, DFF, (unsigned char*)F.WGU + (size_t)lf * NGU * DM, DM, scr);
            p0_transpose8<2>(F, F.w_up + (size_t)lf * DM * DFF, DM, DFF, (unsigned char*)F.WGU + (size_t)lf * NGU * DM, DM, scr);
            p0_transpose8<0>(F, F.w_down + (size_t)lf * DFF * DM, DFF, DM, (unsigned char*)F.WD + (size_t)lf * DM * DFFP, DFFP, scr);
        } else {
            p0_transpose<1>(F, F.w_gate + (size_t)lf * DM * DFF, DM, DFF, F.WGU + (size_t)lf * NGU * DM, scr);
            p0_transpose<2>(F, F.w_up + (size_t)lf * DM * DFF, DM, DFF, F.WGU + (size_t)lf * NGU * DM, scr);
            p0_transpose<0>(F, F.w_down + (size_t)lf * DFF * DM, DFF, DM, F.WD + (size_t)lf * DM * DFF, scr);
        }
    }
    for (int l = 0; l < DEPTH; ++l) {
        p0_transpose<3>(F, F.w_in + (size_t)l * DM * INC, DM, INC, F.WIN + (size_t)l * NIN * DM, scr);
        p0_transpose<0>(F, F.w_out + (size_t)l * DM * DM, DM, DM, F.WOUT + (size_t)l * DM * DM, scr);
        GAS v4u* z = (GAS v4u*)(F.WIN + (size_t)l * NIN * DM + (size_t)INC * DM);
        for (int i = F.gw * 64 + F.lane; i < (NIN - INC) * DM / 8; i += F.NGW * 64) z[i] = (v4u){0u, 0u, 0u, 0u};
    }
}

template <bool OUT8, bool IN16> __device__ __forceinline__ void ph_modulate(const Frame& F, const void* xin, const float* g, const float* shift, const float* scale) {
    if constexpr (IN16) {
        f32x4 av[4][2], hv[4][2]; int cb = -1;
        int m = F.gw;
        v4u wc[4];
        if (m < M) { const GAS v4u* xr = (const GAS v4u*)((const bf16*)xin + (size_t)m * DM) + F.lane;
#pragma unroll
            for (int j = 0; j < 4; ++j) wc[j] = xr[64 * j]; }
        while (m < M) {
            const int mn = m + F.NGW; const int b = m / SEQ;
            v4u wn[4];
            if (mn < M) { const GAS v4u* xr = (const GAS v4u*)((const bf16*)xin + (size_t)mn * DM) + F.lane;
#pragma unroll
                for (int j = 0; j < 4; ++j) wn[j] = xr[64 * j]; }
            else {
#pragma unroll
                for (int j = 0; j < 4; ++j) wn[j] = (v4u){0u, 0u, 0u, 0u}; }
            if (b != cb) { cb = b;
                const GAS f32x4* gp = (const GAS f32x4*)g + 2 * F.lane; const GAS f32x4* sh = (const GAS f32x4*)(shift + (size_t)b * NMOD) + 2 * F.lane; const GAS f32x4* sc = (const GAS f32x4*)(scale + (size_t)b * NMOD) + 2 * F.lane;
#pragma unroll
                for (int j = 0; j < 4; ++j)
#pragma unroll
                    for (int h = 0; h < 2; ++h) { const f32x4 gg = gp[128 * j + h], ss = sc[128 * j + h]; hv[j][h] = sh[128 * j + h]; av[j][h] = gg * (ss + 1.0f); } }
            float x[4][8]; float s = 0.f;
#pragma unroll
            for (int j = 0; j < 4; ++j) { x[j][0] = bf_lo(wc[j].x); x[j][1] = bf_hi(wc[j].x); x[j][2] = bf_lo(wc[j].y); x[j][3] = bf_hi(wc[j].y); x[j][4] = bf_lo(wc[j].z); x[j][5] = bf_hi(wc[j].z); x[j][6] = bf_lo(wc[j].w); x[j][7] = bf_hi(wc[j].w); }
#pragma unroll
            for (int j = 0; j < 4; ++j) s += ((x[j][0] * x[j][0] + x[j][1] * x[j][1]) + (x[j][2] * x[j][2] + x[j][3] * x[j][3])) + ((x[j][4] * x[j][4] + x[j][5] * x[j][5]) + (x[j][6] * x[j][6] + x[j][7] * x[j][7]));
            const float rstd = 1.0f / sqrtf(wave_sum(s) * (1.f / DM) + RMS_EPS);
            GAS v4u* o16 = (GAS v4u*)(F.H + (size_t)m * DM) + F.lane;
            GAS v2u* o8 = (GAS v2u*)((unsigned char*)F.H + (size_t)m * DM) + F.lane;
#pragma unroll
            for (int j = 0; j < 4; ++j) { float y[8];
#pragma unroll
                for (int h = 0; h < 2; ++h) { const f32x4 aa = av[j][h], hh = hv[j][h];
                    y[4 * h + 0] = x[j][4 * h + 0] * rstd * aa.x + hh.x; y[4 * h + 1] = x[j][4 * h + 1] * rstd * aa.y + hh.y;
                    y[4 * h + 2] = x[j][4 * h + 2] * rstd * aa.z + hh.z; y[4 * h + 3] = x[j][4 * h + 3] * rstd * aa.w + hh.w; }
                if (OUT8) { v2u w; w.x = pk_fp8x4(y[0], y[1], y[2], y[3]); w.y = pk_fp8x4(y[4], y[5], y[6], y[7]); o8[64 * j] = w; }
                else { v4u w; w.x = pk2(y[0], y[1]); w.y = pk2(y[2], y[3]); w.z = pk2(y[4], y[5]); w.w = pk2(y[6], y[7]); o16[64 * j] = w; } }
#pragma unroll
            for (int j = 0; j < 4; ++j) wc[j] = wn[j];
            m = mn;
        }
        return;
    }
    for (int m = F.gw; m < M; m += F.NGW) {
        const int b = m / SEQ;
        float x[4][8]; float s = 0.f;
        if constexpr (IN16) {
            const GAS v4u* xr = (const GAS v4u*)((const bf16*)xin + (size_t)m * DM) + F.lane;
            v4u w[4];
#pragma unroll
            for (int j = 0; j < 4; ++j) w[j] = xr[64 * j];
#pragma unroll
            for (int j = 0; j < 4; ++j) { x[j][0] = bf_lo(w[j].x); x[j][1] = bf_hi(w[j].x); x[j][2] = bf_lo(w[j].y); x[j][3] = bf_hi(w[j].y); x[j][4] = bf_lo(w[j].z); x[j][5] = bf_hi(w[j].z); x[j][6] = bf_lo(w[j].w); x[j][7] = bf_hi(w[j].w); }
        } else {
            const GAS f32x4* xr = (const GAS f32x4*)((const float*)xin + (size_t)m * DM) + 2 * F.lane;
            f32x4 a[4][2];
#pragma unroll
            for (int j = 0; j < 4; ++j) { a[j][0] = xr[128 * j]; a[j][1] = xr[128 * j + 1]; }
            GAS v4u* xo = (GAS v4u*)(F.XB + (size_t)m * DM) + F.lane;
#pragma unroll
            for (int j = 0; j < 4; ++j) { x[j][0] = a[j][0].x; x[j][1] = a[j][0].y; x[j][2] = a[j][0].z; x[j][3] = a[j][0].w; x[j][4] = a[j][1].x; x[j][5] = a[j][1].y; x[j][6] = a[j][1].z; x[j][7] = a[j][1].w;
                v4u w; w.x = pk2(x[j][0], x[j][1]); w.y = pk2(x[j][2], x[j][3]); w.z = pk2(x[j][4], x[j][5]); w.w = pk2(x[j][6], x[j][7]); xo[64 * j] = w; }
        }
#pragma unroll
        for (int j = 0; j < 4; ++j) s += ((x[j][0] * x[j][0] + x[j][1] * x[j][1]) + (x[j][2] * x[j][2] + x[j][3] * x[j][3])) + ((x[j][4] * x[j][4] + x[j][5] * x[j][5]) + (x[j][6] * x[j][6] + x[j][7] * x[j][7]));
        const float rstd = 1.0f / sqrtf(wave_sum(s) * (1.f / DM) + RMS_EPS);
        const GAS f32x4* gp = (const GAS f32x4*)g + 2 * F.lane; const GAS f32x4* sh = (const GAS f32x4*)(shift + (size_t)b * NMOD) + 2 * F.lane; const GAS f32x4* sc = (const GAS f32x4*)(scale + (size_t)b * NMOD) + 2 * F.lane;
        GAS v4u* o16 = (GAS v4u*)(F.H + (size_t)m * DM) + F.lane;
        GAS v2u* o8 = (GAS v2u*)((unsigned char*)F.H + (size_t)m * DM) + F.lane;
#pragma unroll
        for (int j = 0; j < 4; ++j) { float y[8];
#pragma unroll
            for (int h = 0; h < 2; ++h) { const f32x4 gg = gp[128 * j + h], ss = sc[128 * j + h], hh = sh[128 * j + h];
                y[4 * h + 0] = x[j][4 * h + 0] * rstd * gg.x * (ss.x + 1.0f) + hh.x; y[4 * h + 1] = x[j][4 * h + 1] * rstd * gg.y * (ss.y + 1.0f) + hh.y;
                y[4 * h + 2] = x[j][4 * h + 2] * rstd * gg.z * (ss.z + 1.0f) + hh.z; y[4 * h + 3] = x[j][4 * h + 3] * rstd * gg.w * (ss.w + 1.0f) + hh.w; }
            if (OUT8) { v2u w; w.x = pk_fp8x4(y[0], y[1], y[2], y[3]); w.y = pk_fp8x4(y[4], y[5], y[6], y[7]); o8[64 * j] = w; }
            else { v4u w; w.x = pk2(y[0], y[1]); w.y = pk2(y[2], y[3]); w.z = pk2(y[4], y[5]); w.w = pk2(y[6], y[7]); o16[64 * j] = w; } }
    }
}
__device__ __forceinline__ v4u headnorm8(v4u w, const float* g, float mul, int lane, bool normalize) {
    float x[8] = {bf_lo(w.x), bf_hi(w.x), bf_lo(w.y), bf_hi(w.y), bf_lo(w.z), bf_hi(w.z), bf_lo(w.w), bf_hi(w.w)};
    float r = mul;
    if (normalize) {
        float s = 0.f;
#pragma unroll
        for (int i = 0; i < 8; ++i) s += x[i] * x[i];
        s += __shfl_xor(s, 1); s += __shfl_xor(s, 2); s += __shfl_xor(s, 4);
        r = mul / sqrtf(s * (1.f / 64.f) + RMS_EPS);
        const f32x4 g0 = *(const GAS f32x4*)(g + 8 * (lane & 7)), g1 = *(const GAS f32x4*)(g + 8 * (lane & 7) + 4);
        x[0] *= g0.x; x[1] *= g0.y; x[2] *= g0.z; x[3] *= g0.w; x[4] *= g1.x; x[5] *= g1.y; x[6] *= g1.z; x[7] *= g1.w;
    }
    w.x = pk2(x[0] * r, x[1] * r); w.y = pk2(x[2] * r, x[3] * r); w.z = pk2(x[4] * r, x[5] * r); w.w = pk2(x[6] * r, x[7] * r);
    return w;
}
__device__ __forceinline__ v4u headnorm8g(v4u w, f32x4 g0, f32x4 g1, float mul, bool normalize) {
    float x[8] = {bf_lo(w.x), bf_hi(w.x), bf_lo(w.y), bf_hi(w.y), bf_lo(w.z), bf_hi(w.z), bf_lo(w.w), bf_hi(w.w)};
    float r = mul;
    if (normalize) {
        float s = 0.f;
#pragma unroll
        for (int i = 0; i < 8; ++i) s += x[i] * x[i];
        s += __shfl_xor(s, 1); s += __shfl_xor(s, 2); s += __shfl_xor(s, 4);
        r = mul / sqrtf(s * (1.f / 64.f) + RMS_EPS);
        x[0] *= g0.x; x[1] *= g0.y; x[2] *= g0.z; x[3] *= g0.w; x[4] *= g1.x; x[5] *= g1.y; x[6] *= g1.z; x[7] *= g1.w;
    }
    w.x = pk2(x[0] * r, x[1] * r); w.y = pk2(x[2] * r, x[3] * r); w.z = pk2(x[4] * r, x[5] * r); w.w = pk2(x[6] * r, x[7] * r);
    return w;
}
__device__ __forceinline__ void ph_post(const Frame& F, int l) {
    const float* qg = F.qk_g + (size_t)l * 6 * HD; const int lane = F.lane;
    f32x4 gq[6][2];
    { const int gi[5] = {0, 2, 4, 5, (lane < 8 ? 1 : 3)};
#pragma unroll
      for (int i = 0; i < 5; ++i) { const float* gp = qg + gi[i] * HD + 8 * (lane & 7); gq[i][0] = *(const GAS f32x4*)gp; gq[i][1] = *(const GAS f32x4*)(gp + 4); } }
    const int koff = (lane < 8 ? PA_K : PB_K) + 8 * (lane & 7);
    int m = F.gw;
    v4u wc[6];
#define POST_LOAD(mm_, W) do { const bf16* row_ = F.P + (size_t)(mm_) * NIN; W[0] = *(const GAS v4u*)(row_ + PA_Q + 8 * lane); W[1] = *(const GAS v4u*)(row_ + PB_Q + 8 * lane); W[2] = *(const GAS v4u*)(row_ + PC_Q + 8 * lane); \
        W[3] = *(const GAS v4u*)(row_ + PC_K + 8 * lane); W[4] = *(const GAS v4u*)(row_ + PD_Q + 8 * lane); W[5] = (v4u){0u, 0u, 0u, 0u}; if (lane < 16) W[5] = *(const GAS v4u*)(row_ + koff); } while (0)
    if (m < M) POST_LOAD(m, wc);
    while (m < M) {
        const int mn = m + F.NGW;
        v4u wn[6];
        if (mn < M) POST_LOAD(mn, wn);
        else {
#pragma unroll
            for (int i = 0; i < 6; ++i) wn[i] = (v4u){0u, 0u, 0u, 0u}; }
        bf16* row = F.P + (size_t)m * NIN;
        *(GAS v4u*)(row + PA_Q + 8 * lane) = headnorm8g(wc[0], gq[0][0], gq[0][1], QSCALE, true);
        *(GAS v4u*)(row + PB_Q + 8 * lane) = headnorm8g(wc[1], gq[1][0], gq[1][1], QSCALE, true);
        *(GAS v4u*)(row + PC_Q + 8 * lane) = headnorm8g(wc[2], gq[2][0], gq[2][1], QSCALE, true);
        *(GAS v4u*)(row + PC_K + 8 * lane) = headnorm8g(wc[3], gq[3][0], gq[3][1], 1.0f, true);
        *(GAS v4u*)(row + PD_Q + 8 * lane) = headnorm8g(wc[4], gq[0][0], gq[0][1], QSCALE, false);
        if (lane < 16) *(GAS v4u*)(row + koff) = headnorm8g(wc[5], gq[4][0], gq[4][1], 1.0f, true);
#pragma unroll
        for (int i = 0; i < 6; ++i) wc[i] = wn[i];
        m = mn;
    }
#undef POST_LOAD
}
__device__ __forceinline__ void ph_scan(const Frame& F, int l) {
    LAS float* wtot = (LAS float*)(F.lds + RING_OFF);
    for (int sq = blockIdx.x; sq < BATCH * NH; sq += F.G) {
        const int b = sq / NH, h = sq % NH; const float fb = F.forget_b[(size_t)l * NH + h];
        const GAS unsigned short* src = (const GAS unsigned short*)(F.P + ((size_t)b * SEQ + 16 * F.tid) * NIN + PC_F + h); float* dst = F.KB2 + (size_t)sq * SEQ + 16 * F.tid;
        float v[16]; unsigned short raw[16];
#pragma unroll
        for (int i = 0; i < 16; ++i) raw[i] = src[(size_t)i * NIN];
#pragma unroll
        for (int i = 0; i < 16; ++i) { const float y = __builtin_bit_cast(float, (unsigned)raw[i] << 16) + fb; v[i] = (y >= 0.f) ? -log1pf(__expf(-y)) : (y - log1pf(__expf(y))); }
#pragma unroll
        for (int i = 1; i < 16; ++i) v[i] += v[i - 1];
        float incl = v[15];
#pragma unroll
        for (int o = 1; o < 64; o <<= 1) { const float t = __shfl_up(incl, o); if (F.lane >= o) incl += t; }
        if (F.lane == 63) wtot[F.wave] = incl;
        __syncthreads();
        float base = incl - v[15];
        for (int w = 0; w < F.wave; ++w) base += wtot[w];
#pragma unroll
        for (int i = 0; i < 4; ++i) *(GAS f32x4*)(dst + 4 * i) = (f32x4){-(v[4 * i] + base) * LOG2E, -(v[4 * i + 1] + base) * LOG2E, -(v[4 * i + 2] + base) * LOG2E, -(v[4 * i + 3] + base) * LOG2E};
        __syncthreads();
    }
}
__device__ __forceinline__ void ph_gnorm(const Frame& F, int l) {
    const float* gg = F.group_g + (size_t)l * DM;
    f32x4 gv[4][2];
#pragma unroll
    for (int g = 0; g < 4; ++g) { gv[g][0] = *(const GAS f32x4*)(gg + g * GWID + 8 * F.lane); gv[g][1] = *(const GAS f32x4*)(gg + g * GWID + 8 * F.lane + 4); }
    int m = F.gw;
    v4u wc[4];
    if (m < M) {
#pragma unroll
        for (int g = 0; g < 4; ++g) wc[g] = *(GAS v4u*)(F.Y + (size_t)m * DM + g * GWID + 8 * F.lane); }
    while (m < M) {
        const int mn = m + F.NGW;
        v4u wn[4];
        if (mn < M) {
#pragma unroll
            for (int g = 0; g < 4; ++g) wn[g] = *(GAS v4u*)(F.Y + (size_t)mn * DM + g * GWID + 8 * F.lane); }
        else {
#pragma unroll
            for (int g = 0; g < 4; ++g) wn[g] = (v4u){0u, 0u, 0u, 0u}; }
#pragma unroll
        for (int g = 0; g < 4; ++g) {
            bf16* p = F.Y + (size_t)m * DM + g * GWID + 8 * F.lane;
            float x[8] = {bf_lo(wc[g].x), bf_hi(wc[g].x), bf_lo(wc[g].y), bf_hi(wc[g].y), bf_lo(wc[g].z), bf_hi(wc[g].z), bf_lo(wc[g].w), bf_hi(wc[g].w)};
            float s = 0.f;
#pragma unroll
            for (int i = 0; i < 8; ++i) s += x[i] * x[i];
            const float r = 1.0f / sqrtf(wave_sum(s) * (1.f / GWID) + RMS_EPS);
            const f32x4 g0 = gv[g][0], g1 = gv[g][1];
            v4u o; o.x = pk2(x[0] * r * g0.x, x[1] * r * g0.y); o.y = pk2(x[2] * r * g0.z, x[3] * r * g0.w); o.z = pk2(x[4] * r * g1.x, x[5] * r * g1.y); o.w = pk2(x[6] * r * g1.z, x[7] * r * g1.w);
            *(GAS v4u*)p = o;
        }
#pragma unroll
        for (int g = 0; g < 4; ++g) wc[g] = wn[g];
        m = mn;
    }
}


__device__ __forceinline__ unsigned short score_key(float sc) {
    const _Float16 hf = (_Float16)fminf(fmaxf(sc, -60000.f), 60000.f);
    const unsigned h = (unsigned)__builtin_bit_cast(unsigned short, hf);
    return (unsigned short)((h & 0x8000u) ? (~h & 0xffffu) : (h | 0x8000u));
}
__device__ __forceinline__ void glds16x(const void* gsrc, unsigned lds_dst) { unsigned keep;
    asm volatile("s_mov_b32 %0, m0\n\ts_mov_b32 m0, %2\n\ts_nop 0\n\tglobal_load_lds_dwordx4 %1, off\n\ts_mov_b32 m0, %0" : "=&s"(keep) : "v"(gsrc), "s"(lds_dst) : "memory"); }
__device__ __forceinline__ void ph_idx_scores(const Frame& F) {
    constexpr int UPB = 8 * (16 * 17 / 2), NU = BATCH * UPB;
    const int lane = F.lane, r32 = lane & 31, hi = lane >> 5;
    const int u_lo = (int)(((long)blockIdx.x * NU) / F.G), u_hi = (int)(((long)(blockIdx.x + 1) * NU) / F.G);
    if (u_lo >= u_hi) return;
    int b = u_lo / UPB, qb = 127, kc = 0; { int r = u_lo % UPB; for (;;) { const int n = (qb >> 3) + 1; if (r < n) { kc = r; break; } r -= n; --qb; } }
    LAS unsigned char* KL = F.lds + RING_OFF;
    const unsigned kl_lds = (unsigned)(size_t)KL;
#define X1_STAGE(bb, kk, buf) do { const bf16* ksrc_ = F.P + ((size_t)(bb) * SEQ + 512 * (kk) + 64 * F.wave + lane) * NIN + PA_IK; \
        _Pragma("unroll") for (int c_ = 0; c_ < 8; ++c_) glds16x(ksrc_ + 8 * c_, (unsigned)__builtin_amdgcn_readfirstlane(kl_lds + (buf) * 65536 + c_ * 8192 + F.wave * 1024)); } while (0)
    X1_STAGE(b, kc, 0);
    asm volatile("s_waitcnt vmcnt(0)" ::: "memory"); __syncthreads();
    bf16x8 af[4][4]; float wq[4][16]; int cb = -1, cqb = -1;
    for (int u = u_lo; u < u_hi; ++u) {
        const int cur = (u - u_lo) & 1;
        int nb = b, nqb = qb, nkc = kc + 1; if (nkc > (qb >> 3)) { nkc = 0; --nqb; if (nqb < 0) { nqb = 127; ++nb; } }
        if (u + 1 < u_hi) X1_STAGE(nb, nkc, cur ^ 1);
        const size_t rowb = (size_t)b * SEQ; const int t0 = 64 * qb + 8 * F.wave;
        if (b != cb || qb != cqb) { cb = b; cqb = qb;
#pragma unroll
            for (int pr = 0; pr < 4; ++pr) {
                const bf16* qrow = F.P + (rowb + t0 + 2 * pr + ((r32 >> 2) & 1)) * NIN + PA_IQ + ((r32 & 3) + 4 * (r32 >> 3)) * 64 + 8 * hi;
#pragma unroll
                for (int s = 0; s < 4; ++s) af[pr][s] = *(const GAS bf16x8*)(qrow + 16 * s);
                const bf16* wrow = F.P + (rowb + t0 + 2 * pr + hi) * NIN + PA_IW;
                const v4u w0 = *(const GAS v4u*)wrow, w1 = *(const GAS v4u*)(wrow + 8);
                const unsigned ww[8] = {w0.x, w0.y, w0.z, w0.w, w1.x, w1.y, w1.z, w1.w};
#pragma unroll
                for (int i = 0; i < 8; ++i) { wq[pr][2 * i] = bf_lo(ww[i]) * 0.015625f; wq[pr][2 * i + 1] = bf_hi(ww[i]) * 0.015625f; }
            }
        }
        const int kend = 64 * (qb + 1) - 512 * kc;
        const int nkt = kend >= 512 ? 16 : (kend + 31) / 32;
        const LAS unsigned char* kl = KL + cur * 65536 + hi * 8192 + r32 * 16;
        for (int kt = 0; kt < nkt; ++kt) {
            bf16x8 bfr[4];
#pragma unroll
            for (int s = 0; s < 4; ++s) bfr[s] = *(const LAS bf16x8*)(kl + s * 16384 + kt * 512);
            const int s0 = 512 * kc + 32 * kt;
#pragma unroll
            for (int pr = 0; pr < 4; ++pr) {
                f32x16 acc = {};
#pragma unroll
                for (int s = 0; s < 4; ++s) acc = __builtin_amdgcn_mfma_f32_32x32x16_bf16(af[pr][s], bfr[s], acc, 0, 0, 0);
                float sc0 = 0.f, sc1 = 0.f;
#pragma unroll
                for (int r = 0; r < 16; ++r) { sc0 = __builtin_fmaf(wq[pr][r], acc[r], sc0); sc1 = __builtin_fmaf(wq[pr][r], __builtin_fabsf(acc[r]), sc1); if ((r & 3) == 3) asm("" : "+v"(sc1)); }
                ((GAS unsigned short*)F.SC)[(rowb + t0 + 2 * pr + hi) * SEQ + s0 + r32] = score_key(sc0 + sc1);
                __builtin_amdgcn_sched_barrier(0);
            }
        }
        asm volatile("s_waitcnt vmcnt(0)" ::: "memory");
        __syncthreads();
        b = nb; qb = nqb; kc = nkc;
    }
#undef X1_STAGE
}

__device__ __forceinline__ unsigned mbcnt64(unsigned long long m) { return __builtin_amdgcn_mbcnt_hi((unsigned)(m >> 32), __builtin_amdgcn_mbcnt_lo((unsigned)m, 0u)); }
template <int SH, int PSH> __device__ __forceinline__ void sel_level(const unsigned (&v)[64], int nreg, unsigned pval, unsigned need, LAS unsigned* hist, int lane, unsigned& bin_out, unsigned& above_out) {
#pragma unroll
    for (int i = 0; i < 8; ++i) ((LAS v4u*)hist)[lane + 64 * i] = (v4u){0u, 0u, 0u, 0u};
    LDS_WAIT(); __builtin_amdgcn_wave_barrier();
    const unsigned hb = (unsigned)(size_t)hist, sink = hb + 9216u + 4u * (unsigned)lane;
#pragma unroll
    for (int g = 0; g < 8; ++g) if (8 * g < nreg) {
#pragma unroll
        for (int jj = 0; jj < 8; ++jj) { const int j = 8 * g + jj;
#pragma unroll
            for (int e = 0; e < 2; ++e) { const unsigned k = e ? (v[j] >> 16) : (v[j] & 0xffffu);
                const bool pred = (k != 0u) && (PSH >= 16 || (k >> (PSH & 15)) == pval);
                const unsigned tgt = pred ? hb + (((k >> SH) & 2047u) << 2) : sink;
                __hip_atomic_fetch_add((LAS unsigned*)tgt, 1u, __ATOMIC_RELAXED, __HIP_MEMORY_SCOPE_WAVEFRONT); }
            if ((jj & 1) == 1) __builtin_amdgcn_sched_barrier(0); }
    }
    LDS_WAIT(); __builtin_amdgcn_wave_barrier();
    unsigned S = 0u;
#pragma unroll
    for (int i = 0; i < 8; ++i) { const v4u q = ((LAS v4u*)hist)[lane * 8 + i]; S += (q.x + q.y) + (q.z + q.w); }
    unsigned T = S;
#pragma unroll
    for (int o = 1; o < 64; o <<= 1) { const unsigned t = __shfl_down(T, o); if (lane + o < 64) T += t; }
    const unsigned above_lane = T - S;
    const bool cross = (T >= need) && (above_lane < need);
    unsigned run = above_lane, bin = 0u, ab = 0u; bool found = false;
#pragma unroll
    for (int i = 7; i >= 0; --i) { const v4u q = ((LAS v4u*)hist)[lane * 8 + i]; const unsigned c4[4] = {q.x, q.y, q.z, q.w};
#pragma unroll
        for (int e = 3; e >= 0; --e) { const bool hit = !found && (run + c4[e] >= need); if (hit) { bin = 32u * lane + 4 * i + e; ab = run; found = true; } run += c4[e]; } }
    const unsigned long long cm = __ballot(cross);
    const int src = cm ? (int)__builtin_ctzll(cm) : 0;
    bin_out = __builtin_amdgcn_readlane(bin, src); above_out = __builtin_amdgcn_readlane(ab, src);
    LDS_WAIT(); __builtin_amdgcn_wave_barrier();
}
__device__ __forceinline__ void select_row(const Frame& F, int m, LAS unsigned* hist, LAS int* out) {
    int lane = F.lane; asm volatile("" : "+v"(lane));
    const int t = m % SEQ, n = t + 1;
    if (n <= TOPK) { for (int j = lane; j < TOPK; j += 64) out[j] = (j < n) ? j : 0; return; }
    const int nreg = (n + 127) >> 7;
    unsigned v[64];
    const GAS unsigned* pr = (const GAS unsigned*)(F.SC + (size_t)m * SEQ) + lane;
#pragma unroll
    for (int g = 0; g < 8; ++g) {
        if (8 * g < nreg) {
#pragma unroll
            for (int jj = 0; jj < 8; ++jj) v[8 * g + jj] = pr[jj * 64];
        } else {
#pragma unroll
            for (int jj = 0; jj < 8; ++jj) v[8 * g + jj] = 0u;
        }
        pr += 512; asm volatile("" : "+v"(pr));
    }
    const int nfull = n >> 7;
#pragma unroll
    for (int g = 0; g < 8; ++g) if (8 * g < nreg && 8 * g + 8 > nfull) {
#pragma unroll
        for (int jj = 0; jj < 8; ++jj) { const int j = 8 * g + jj; const int e0 = 128 * j + 2 * lane; const unsigned w = v[j];
            v[j] = ((e0 < n) ? (w & 0xffffu) : 0u) | ((e0 + 1 < n) ? (w & 0xffff0000u) : 0u); asm volatile("" : "+v"(v[j])); }
    }
    unsigned b1, a1, b2, a2;
    sel_level<5, 16>(v, nreg, 0u, (unsigned)TOPK, hist, lane, b1, a1);
    sel_level<0, 5>(v, nreg, b1, (unsigned)TOPK - a1, hist, lane, b2, a2);
    const unsigned tau = (b1 << 5) | (b2 & 31u);
    const unsigned quota = (unsigned)TOPK - a1 - a2;
    unsigned mg[4] = {0u, 0u, 0u, 0u}, me[4] = {0u, 0u, 0u, 0u};
#pragma unroll
    for (int g = 0; g < 8; ++g) {
        if (8 * g < nreg) {
#pragma unroll
            for (int jj = 0; jj < 8; ++jj) { const int j = 8 * g + jj;
#pragma unroll
                for (int e = 0; e < 2; ++e) { const unsigned k = e ? (v[j] >> 16) : (v[j] & 0xffffu);
                    mg[g >> 1] = mg[g >> 1] + mg[g >> 1] + ((k > tau) ? 1u : 0u); me[g >> 1] = me[g >> 1] + me[g >> 1] + ((k == tau) ? 1u : 0u); }
                if ((jj & 3) == 3) __builtin_amdgcn_sched_barrier(0); }
        } else { mg[g >> 1] <<= 16; me[g >> 1] <<= 16; }
    }
    const unsigned cg = (unsigned)(__builtin_popcount(mg[0]) + __builtin_popcount(mg[1]) + __builtin_popcount(mg[2]) + __builtin_popcount(mg[3]));
    unsigned ce = (unsigned)(__builtin_popcount(me[0]) + __builtin_popcount(me[1]) + __builtin_popcount(me[2]) + __builtin_popcount(me[3]));
    unsigned incl = cg | (ce << 16);
#pragma unroll
    for (int o = 1; o < 64; o <<= 1) { const unsigned t = (unsigned)__shfl_up((int)incl, o); if (lane >= o) incl += t; }
    const unsigned excl = incl - (cg | (ce << 16));
    const unsigned pre_g = excl & 0xffffu, pre_e = excl >> 16;
    const unsigned keep = pre_e >= quota ? 0u : ((quota - pre_e) < ce ? (quota - pre_e) : ce);
#pragma unroll
    for (int q = 3; q >= 0; --q) { while (ce > keep && me[q] != 0u) { me[q] &= me[q] - 1u; --ce; } }
    unsigned pos = pre_g + (pre_e < quota ? pre_e : quota);
    const int ilane = 2 * lane;
#pragma unroll
    for (int q = 0; q < 4; ++q) { unsigned mm = mg[q] | me[q];
        while (mm != 0u) { const int bpos = 31 - (int)__builtin_clz(mm); const int sl = 31 - bpos; mm &= ~(1u << bpos);
            const int i = 128 * (16 * q + (sl >> 1)) + ilane + (sl & 1);
            if (pos < (unsigned)TOPK) out[pos] = i;
            ++pos; } }
}


constexpr int AT_K = 0, AT_V = 16384, AT_KB = 32768, AT_WSF = 33280, AT_BT = 35328, AT_DEAD = 35840, AT_SV = 36864;
typedef short v4i16_t __attribute__((ext_vector_type(4)));
__device__ __forceinline__ s16x4 vtr(const LAS unsigned char* p) { return __builtin_bit_cast(s16x4, __builtin_amdgcn_ds_read_tr16_b64_v4i16((LAS v4i16_t*)p)); }
typedef __bf16 bfpair_t __attribute__((ext_vector_type(2))); typedef float f32pair_t __attribute__((ext_vector_type(2)));
__device__ __forceinline__ unsigned cvtpk(float lo, float hi) { const f32pair_t v = {lo, hi}; return __builtin_bit_cast(unsigned, __builtin_convertvector(v, bfpair_t)); }
#define NEG_INF (-__builtin_inff())

template <int TYPE>
__device__ __forceinline__ void dense_attn_unit(const Frame& F, int l, int b, int h, int qb) {
    constexpr int QOFF = TYPE == 1 ? PB_Q : TYPE == 2 ? PC_Q : PD_Q, KOFF = TYPE == 1 ? PB_K : TYPE == 2 ? PC_K : PD_K, VOFF = TYPE == 1 ? PB_V : TYPE == 2 ? PC_V : PD_V;
    constexpr bool MQA = TYPE == 1; constexpr int YOFF = TYPE * GWID;
    const int tid = F.tid, lane = F.lane, wid = F.wave, r32 = lane & 31, hi = lane >> 5;
    LAS unsigned char* L = F.lds + RING_OFF;
    LAS float* wsf = (LAS float*)(L + AT_WSF + wid * 256);
    LAS float* BT = (LAS float*)(L + AT_BT);
    const int hq = (TYPE == 1) ? wid : h, qoff = (TYPE == 1) ? (qb & 7) * 32 : wid * 32, qb256 = (TYPE == 1) ? (qb >> 3) : qb;
    const size_t rowb = (size_t)b * SEQ; const int q0 = qb256 * 256;
    const bf16* Pk = F.P + rowb * NIN + KOFF + (MQA ? 0 : h * 64);
    const bf16* Pv = F.P + rowb * NIN + VOFF + (MQA ? 0 : h * 64);
    const bf16* Pq = F.P + (rowb + q0 + qoff + r32) * NIN + QOFF + hq * 64 + hi * 8;
    bf16x8 qr[4];
#pragma unroll
    for (int d0 = 0; d0 < 4; ++d0) qr[d0] = *(const GAS bf16x8*)(Pq + 16 * d0);
    const int jt_hi = (TYPE == 1) ? ((q0 + qoff + 31) >> 6) : 4 * qb256 + 3, jt_lo = (TYPE == 1) ? (((q0 + qoff - (WINDOW - 1)) > 0 ? (q0 + qoff - (WINDOW - 1)) : 0) >> 6) : 0, nt = jt_hi - jt_lo + 1;
    if (TYPE == 1) { LAS float* BTall = (LAS float*)(L + AT_SV);
        for (int i = tid; i < 8 * 128; i += NTHREADS) BTall[i] = F.rel_table[(int)kBucketLut[i & 127] * 16 + 8 + (i >> 7)] * LOG2E;
        BT = BTall + 128 * wid; }
    const bf16* kgp = Pk + (size_t)lane * NIN + wid * 8;
    const int vkey = tid >> 3, vch = tid & 7;
    const bf16* vgp = Pv + (size_t)vkey * NIN + vch * 8;
    const int kl = wid * 1024 + lane * 16;
    const int vl = (vch >> 2) * 4096 + (vkey >> 3) * 512 + (vkey & 7) * 64 + (vch & 3) * 16;
    const float* kb2 = F.KB2 + ((size_t)b * NH + h) * SEQ;
    v4u kreg = *(const GAS v4u*)(kgp + (size_t)jt_hi * 64 * NIN), vreg = *(const GAS v4u*)(vgp + (size_t)jt_hi * 64 * NIN);
    float kbreg = 0.f; if (TYPE == 2 && tid < 64) kbreg = kb2[jt_hi * 64 + tid];
    *(LAS v4u*)(L + AT_K + kl) = kreg; *(LAS v4u*)(L + AT_V + vl) = vreg; if (TYPE == 2 && tid < 64) ((LAS float*)(L + AT_KB))[tid] = kbreg;
    __syncthreads();
    f32x16 o[2]; o[0] = f32x16{}; o[1] = f32x16{};
    float mrun = NEG_INF, lsum = 0.f, carry = 1.f;
    float qbound = 0.f;
    if (TYPE == 2) {
        float ss = 0.f;
#pragma unroll
        for (int d0 = 0; d0 < 4; ++d0)
#pragma unroll
            for (int j = 0; j < 8; ++j) { const float x = bf2f((bf16)qr[d0][j]); ss += x * x; }
        ss += __shfl_xor(ss, 32);
        float gm = fabsf(F.qk_g[((size_t)l * 6 + 5) * HD + lane]);
#pragma unroll
        for (int o = 1; o < 64; o <<= 1) gm = fmaxf(gm, __shfl_xor(gm, o));
        qbound = sqrtf(ss) * 8.08f * gm;
    }
    const int qrel = qoff + r32;
    const int vb = ((lane >> 4) & 1) * 32 + (lane & 3) * 8 + (4 * hi + ((lane & 15) >> 2)) * 64;
    LAS unsigned* deadf = (LAS unsigned*)(L + AT_DEAD);
    for (int i = 0; i < nt; ++i) {
        const int jt = jt_hi - i, cur = i & 1, jb = jt - 4 * qb256; const bool more = (i + 1 < nt);
        float kbnext = 0.f;
        if (more) { kreg = *(const GAS v4u*)(kgp + (size_t)(jt - 1) * 64 * NIN); vreg = *(const GAS v4u*)(vgp + (size_t)(jt - 1) * 64 * NIN); if (TYPE == 2 && tid < 64) kbreg = kb2[(jt - 1) * 64 + tid]; if (TYPE == 2) kbnext = kb2[jt * 64 - 1]; }
        const bool active = (64 * jb <= qoff + 31) && (TYPE != 1 || (64 * jb + 63 >= qoff - (WINDOW - 1)));
        if (active) {
            const LAS unsigned char* Kb = L + AT_K + cur * 8192; const LAS unsigned char* Vb = L + AT_V + cur * 8192;
            f32x16 p0 = f32x16{}, p1 = f32x16{};
            bf16x8 ka[4], kc[4];
#pragma unroll
            for (int d0 = 0; d0 < 4; ++d0) { ka[d0] = *(const LAS bf16x8*)(Kb + (2 * d0 + hi) * 1024 + r32 * 16); kc[d0] = *(const LAS bf16x8*)(Kb + (2 * d0 + hi) * 1024 + 512 + r32 * 16); }
            __builtin_amdgcn_sched_barrier(0);
#pragma unroll
            for (int d0 = 0; d0 < 4; ++d0) { p0 = __builtin_amdgcn_mfma_f32_32x32x16_bf16(ka[d0], qr[d0], p0, 0, 0, 0); p1 = __builtin_amdgcn_mfma_f32_32x32x16_bf16(kc[d0], qr[d0], p1, 0, 0, 0); }
            bf16x8 vfr[2][4];
#pragma unroll
            for (int d0 = 0; d0 < 2; ++d0)
#pragma unroll
                for (int ks = 0; ks < 4; ++ks) { const s16x4 lo = vtr(Vb + vb + d0 * 4096 + ks * 1024), hh = vtr(Vb + vb + d0 * 4096 + ks * 1024 + 512);
                    vfr[d0][ks] = (bf16x8){lo[0], lo[1], lo[2], lo[3], hh[0], hh[1], hh[2], hh[3]}; }
            __builtin_amdgcn_sched_barrier(0);
            bool live = true;
            const int kv0 = 64 * jb + 4 * hi;
            if (TYPE == 3) {
                float b0[16], b1[16];
#pragma unroll
                for (int r = 0; r < 16; ++r) { const int kv = kv0 + (r & 3) + 8 * (r >> 2);
                    const float e0 = fexp2(fminf(p0[r], 80.f)), e1 = fexp2(fminf(p1[r], 80.f));
                    const float m0 = frcp(1.0f + e0), m1 = frcp(1.0f + e1);
                    const bool ok0 = kv < qrel, ok1 = (kv + 32) < qrel;
                    b0[r] = ok0 ? e0 * m0 : 0.f; b1[r] = ok1 ? e1 * m1 : 0.f; p0[r] = ok0 ? m0 : 1.0f; p1[r] = ok1 ? m1 : 1.0f; }
                float gp[8], go[8], pp[8];
#pragma unroll
                for (int g = 0; g < 4; ++g) { gp[g] = (p0[4 * g] * p0[4 * g + 1]) * (p0[4 * g + 2] * p0[4 * g + 3]); gp[4 + g] = (p1[4 * g] * p1[4 * g + 1]) * (p1[4 * g + 2] * p1[4 * g + 3]); }
#pragma unroll
                for (int g = 0; g < 8; ++g) { const float oth = __shfl_xor(gp[g], 32); pp[g] = gp[g] * oth; go[g] = hi ? 1.0f : oth; }
                float sp = 1.0f;
#pragma unroll
                for (int g = 7; g >= 0; --g) { const float sg = sp * go[g] * carry;
                    if (g < 4) { const float c3 = p0[4 * g + 3], c2 = p0[4 * g + 2], c1 = p0[4 * g + 1];
                        p0[4 * g + 3] = b0[4 * g + 3] * sg; const float s2 = sg * c3; p0[4 * g + 2] = b0[4 * g + 2] * s2; const float s1 = s2 * c2; p0[4 * g + 1] = b0[4 * g + 1] * s1; p0[4 * g] = b0[4 * g] * (s1 * c1); }
                    else { const int q = g - 4; const float c3 = p1[4 * q + 3], c2 = p1[4 * q + 2], c1 = p1[4 * q + 1];
                        p1[4 * q + 3] = b1[4 * q + 3] * sg; const float s2 = sg * c3; p1[4 * q + 2] = b1[4 * q + 2] * s2; const float s1 = s2 * c2; p1[4 * q + 1] = b1[4 * q + 1] * s1; p1[4 * q] = b1[4 * q] * (s1 * c1); }
                    sp *= pp[g]; }
                carry *= sp;
            } else {
                if (TYPE == 2) {
                    const LAS f32x4* kbp = (const LAS f32x4*)(L + AT_KB + cur * 256);
#pragma unroll
                    for (int g = 0; g < 4; ++g) { const f32x4 a = kbp[2 * g + hi], c = kbp[8 + 2 * g + hi];
#pragma unroll
                        for (int e = 0; e < 4; ++e) { p0[4 * g + e] += a[e]; p1[4 * g + e] += c[e]; } }
                    if (jb >= 0) {
#pragma unroll
                        for (int r = 0; r < 16; ++r) { const int kv = kv0 + (r & 3) + 8 * (r >> 2); if (kv > qrel) p0[r] = NEG_INF; if (kv + 32 > qrel) p1[r] = NEG_INF; }
                    }
                } else {
#pragma unroll
                    for (int r = 0; r < 16; ++r) { const int d0_ = qrel - (kv0 + (r & 3) + 8 * (r >> 2)), d1_ = d0_ - 32;
                        const bool ok0 = (d0_ >= 0) && (d0_ < WINDOW), ok1 = (d1_ >= 0) && (d1_ < WINDOW);
                        const float t0 = BT[ok0 ? d0_ : 0], t1 = BT[ok1 ? d1_ : 0];
                        p0[r] = ok0 ? p0[r] + t0 : NEG_INF; p1[r] = ok1 ? p1[r] + t1 : NEG_INF; }
                }
                float rm = fmaxf(p0[0], p1[0]);
#pragma unroll
                for (int r = 1; r < 16; ++r) rm = fmaxf(rm, fmaxf(p0[r], p1[r]));
                { auto rr = __builtin_amdgcn_permlane32_swap(__float_as_uint(rm), __float_as_uint(rm), false, false); rm = fmaxf(__uint_as_float(rr[0]), __uint_as_float(rr[1])); }
                const float mn = fmaxf(mrun, rm);
                if (TYPE == 2) live = !__all(rm - mrun < -40.f);
                if (live) {
                if (__any(mn > mrun)) {
                    const float f = (mn > mrun) ? fexp2(mrun - mn) : 1.0f;
                    lsum *= f; mrun = mn;
                    if (hi == 0) wsf[r32] = f;
                    LDS_WAIT(); __builtin_amdgcn_wave_barrier();
#pragma unroll
                    for (int g = 0; g < 4; ++g) { const f32x4 fv = ((const LAS f32x4*)wsf)[2 * g + hi];
#pragma unroll
                        for (int e = 0; e < 4; ++e) { o[0][4 * g + e] *= fv[e]; o[1][4 * g + e] *= fv[e]; } }
                    LDS_WAIT(); __builtin_amdgcn_wave_barrier();
                }
                const float ms = (mrun == NEG_INF) ? 0.f : mrun;
                float ps = 0.f;
#pragma unroll
                for (int r = 0; r < 16; ++r) { p0[r] = fexp2(p0[r] - ms); p1[r] = fexp2(p1[r] - ms); ps += p0[r] + p1[r]; }
                lsum += ps;
                }
            }
            if (live) {
            bf16x8 pa[4];
#pragma unroll
            for (int ks = 0; ks < 4; ++ks) { v4u w;
                if (ks < 2) { w.x = cvtpk(p0[8 * ks], p0[8 * ks + 1]); w.y = cvtpk(p0[8 * ks + 2], p0[8 * ks + 3]); w.z = cvtpk(p0[8 * ks + 4], p0[8 * ks + 5]); w.w = cvtpk(p0[8 * ks + 6], p0[8 * ks + 7]); }
                else { const int k2 = ks - 2; w.x = cvtpk(p1[8 * k2], p1[8 * k2 + 1]); w.y = cvtpk(p1[8 * k2 + 2], p1[8 * k2 + 3]); w.z = cvtpk(p1[8 * k2 + 4], p1[8 * k2 + 5]); w.w = cvtpk(p1[8 * k2 + 6], p1[8 * k2 + 7]); }
                pa[ks] = __builtin_bit_cast(bf16x8, w); }
#pragma unroll
            for (int d0 = 0; d0 < 2; ++d0)
#pragma unroll
                for (int ks = 0; ks < 4; ++ks) o[d0] = __builtin_amdgcn_mfma_f32_32x32x16_bf16(pa[ks], vfr[d0][ks], o[d0], 0, 0, 0);
            }
        }
        if (TYPE == 2) {
            bool wdead = false;
            if (active && more) wdead = __all(qbound + kbnext - mrun < -40.f);
            if (lane == 0) deadf[cur * 8 + wid] = wdead ? 1u : 0u; }
        if (TYPE == 3) { const bool wdead = active && __all(carry < 2.3e-10f);
            if (lane == 0) deadf[cur * 8 + wid] = wdead ? 1u : 0u; }
        if (more) { *(LAS v4u*)(L + AT_K + (cur ^ 1) * 8192 + kl) = kreg; *(LAS v4u*)(L + AT_V + (cur ^ 1) * 8192 + vl) = vreg; if (TYPE == 2 && tid < 64) ((LAS float*)(L + AT_KB + (cur ^ 1) * 256))[tid] = kbreg; }
        __syncthreads();
        if (TYPE >= 2) { const v4u d0 = *(const LAS v4u*)(deadf + cur * 8), d1 = *(const LAS v4u*)(deadf + cur * 8 + 4);
            if ((d0.x & d0.y & d0.z & d0.w & d1.x & d1.y & d1.z & d1.w) != 0u) break; }
    }
    float inv[16];
    if (TYPE != 3) {
        { auto rr = __builtin_amdgcn_permlane32_swap(__float_as_uint(lsum), __float_as_uint(lsum), false, false); lsum = __uint_as_float(rr[0]) + __uint_as_float(rr[1]); }
        if (TYPE == 1) lsum += fexp2(F.sinks[l * NH + hq] * LOG2E - mrun);
        const float il = 1.0f / lsum;
        if (hi == 0) wsf[r32] = il;
        LDS_WAIT(); __builtin_amdgcn_wave_barrier();
#pragma unroll
        for (int g = 0; g < 4; ++g) { const f32x4 fv = ((const LAS f32x4*)wsf)[2 * g + hi]; inv[4 * g] = fv[0]; inv[4 * g + 1] = fv[1]; inv[4 * g + 2] = fv[2]; inv[4 * g + 3] = fv[3]; }
        LDS_WAIT(); __builtin_amdgcn_wave_barrier();
    } else {
#pragma unroll
        for (int r = 0; r < 16; ++r) inv[r] = 1.0f;
    }
    unsigned short gte[2][16];
    if (TYPE == 2) {
#pragma unroll
        for (int d0 = 0; d0 < 2; ++d0)
#pragma unroll
            for (int r = 0; r < 16; ++r) { const int q = (r & 3) + 8 * (r >> 2) + 4 * hi; const size_t mrow = rowb + q0 + qoff + q; gte[d0][r] = ((const GAS unsigned short*)F.P)[mrow * NIN + PC_G + hq * 64 + 32 * d0 + r32]; }
    }
#pragma unroll
    for (int d0 = 0; d0 < 2; ++d0)
#pragma unroll
        for (int r = 0; r < 16; ++r) { const int q = (r & 3) + 8 * (r >> 2) + 4 * hi; const size_t mrow = rowb + q0 + qoff + q; const int col = hq * 64 + 32 * d0 + r32;
            float val = o[d0][r] * inv[r];
            if (TYPE == 2) val *= frcp(1.0f + fexp2(-LOG2E * __builtin_bit_cast(float, (unsigned)gte[d0][r] << 16)));
            F.Y[mrow * DM + YOFF + col] = (bf16)f2bf(val); }
}

__device__ __forceinline__ void sparse_attn_query(const Frame& F, int m, LAS unsigned char* vch, const LAS float* TBA, const LAS int* idx) {
    int lane = F.lane; asm volatile("" : "+v"(lane));
    const int hh = lane & 15, kg = lane >> 4, t = m % SEQ, b = m / SEQ;
    const size_t rowb = (size_t)b * SEQ;
    const int nsel = (t + 1) < TOPK ? (t + 1) : TOPK, nch = (nsel + 63) >> 6;
    const bf16* qp = F.P + (size_t)m * NIN + PA_Q + (hh & 7) * 64 + 8 * kg;
    const bf16x8 qf0 = *(const GAS bf16x8*)qp, qf1 = *(const GAS bf16x8*)(qp + 32);
    float s[4][4][4];
#pragma unroll
    for (int cp = 0; cp < 2; ++cp) {
        if (2 * cp < nch) {
            bf16x8 kf[8][2];
#pragma unroll
            for (int bb = 0; bb < 8; ++bb) { const int keyA = idx[128 * cp + 16 * bb + hh];
                const bf16* kp = F.P + (rowb + keyA) * NIN + PA_K + 8 * kg;
                kf[bb][0] = *(const GAS bf16x8*)kp; kf[bb][1] = *(const GAS bf16x8*)(kp + 32); }
            __builtin_amdgcn_sched_barrier(0);
#pragma unroll
            for (int bb = 0; bb < 8; ++bb) { const int c = 2 * cp + (bb >> 2), blk = bb & 3, j0 = 64 * c + 16 * blk;
                f32x4 acc = {0.f, 0.f, 0.f, 0.f};
                acc = __builtin_amdgcn_mfma_f32_16x16x32_bf16(kf[bb][0], qf0, acc, 0, 0, 0); acc = __builtin_amdgcn_mfma_f32_16x16x32_bf16(kf[bb][1], qf1, acc, 0, 0, 0);
                const v4i id4 = *(const LAS v4i*)(idx + j0 + 4 * kg);
#pragma unroll
                for (int r = 0; r < 4; ++r) { const int j = j0 + 4 * kg + r; int dist = t - id4[r]; dist = dist < 0 ? 0 : (dist > 128 ? 128 : dist);
                    const float bias = TBA[dist * 8 + (hh & 7)];
                    s[c][blk][r] = (j < nsel) ? acc[r] + bias : NEG_INF; }
            }
        } else {
#pragma unroll
            for (int c = 2 * cp; c < 2 * cp + 2; ++c)
#pragma unroll
                for (int blk = 0; blk < 4; ++blk)
#pragma unroll
                    for (int r = 0; r < 4; ++r) s[c][blk][r] = NEG_INF;
        }
    }
    v4u xv[2][8];
#define SP_VLOAD(c_, X) do { const int keyV_ = idx[64 * (c_) + lane]; const bf16* vp_ = F.P + (rowb + keyV_) * NIN + PA_V; \
        _Pragma("unroll") for (int i_ = 0; i_ < 8; ++i_) X[i_] = *(const GAS v4u*)(vp_ + 8 * i_); } while (0)
    SP_VLOAD(0, xv[0]);
    if (1 < nch) SP_VLOAD(1, xv[1]);
    __builtin_amdgcn_sched_barrier(0);
    float mx = NEG_INF;
#pragma unroll
    for (int c = 0; c < 4; ++c)
#pragma unroll
        for (int blk = 0; blk < 4; ++blk)
#pragma unroll
            for (int r = 0; r < 4; ++r) mx = fmaxf(mx, s[c][blk][r]);
    mx = fmaxf(mx, __shfl_xor(mx, 16)); mx = fmaxf(mx, __shfl_xor(mx, 32));
    float sum = 0.f;
#pragma unroll
    for (int c = 0; c < 4; ++c)
#pragma unroll
        for (int blk = 0; blk < 4; ++blk)
#pragma unroll
            for (int r = 0; r < 4; ++r) { const float p = fexp2(s[c][blk][r] - mx); s[c][blk][r] = p; sum += p; }
    sum += __shfl_xor(sum, 16); sum += __shfl_xor(sum, 32);
    const float inv = 1.0f / sum;
    f32x4 oacc[4];
#pragma unroll
    for (int d = 0; d < 4; ++d) oacc[d] = (f32x4){0.f, 0.f, 0.f, 0.f};
    const int q4 = (lane & 15) >> 2, p4 = lane & 3;
#pragma unroll
    for (int c = 0; c < 4; ++c) {
        if (c < nch) {
#pragma unroll
            for (int i = 0; i < 8; ++i) *(LAS v4u*)(vch + (i >> 2) * 4096 + lane * 64 + (i & 3) * 16) = xv[c & 1][i];
            LDS_WAIT(); __builtin_amdgcn_wave_barrier();
            if (c + 2 < nch) SP_VLOAD(c + 2, xv[c & 1]);
            __builtin_amdgcn_sched_barrier(0);
#pragma unroll
            for (int kp = 0; kp < 2; ++kp) { v4u w; w.x = cvtpk(s[c][2 * kp][0], s[c][2 * kp][1]); w.y = cvtpk(s[c][2 * kp][2], s[c][2 * kp][3]); w.z = cvtpk(s[c][2 * kp + 1][0], s[c][2 * kp + 1][1]); w.w = cvtpk(s[c][2 * kp + 1][2], s[c][2 * kp + 1][3]);
                const bf16x8 pf = __builtin_bit_cast(bf16x8, w);
#pragma unroll
                for (int d = 0; d < 4; ++d) { const LAS unsigned char* a = vch + (d >> 1) * 4096 + (32 * kp + 4 * kg + q4) * 64 + ((d & 1) * 16 + 4 * p4) * 2;
                    const s16x4 lo = vtr(a), hv = vtr(a + 16 * 64);
                    const bf16x8 vf = {lo[0], lo[1], lo[2], lo[3], hv[0], hv[1], hv[2], hv[3]};
                    oacc[d] = __builtin_amdgcn_mfma_f32_16x16x32_bf16(vf, pf, oacc[d], 0, 0, 0); } }
            LDS_WAIT(); __builtin_amdgcn_wave_barrier();
        }
    }
#undef SP_VLOAD
    if (hh < 8) {
#pragma unroll
        for (int d = 0; d < 4; ++d) { v2u w; w.x = pk2(oacc[d][0] * inv, oacc[d][1] * inv); w.y = pk2(oacc[d][2] * inv, oacc[d][3] * inv);
            *(GAS v2u*)(F.Y + (size_t)m * DM + hh * 64 + 16 * d + 4 * kg) = w; }
    }
}

constexpr int CW_QUEUE = 8192;
constexpr int MIX_ITEMS = 2560;
template <unsigned EN> __device__ __forceinline__ void ph_attention(const Frame& F, int l, int qsel = 0) {
    LAS float* TBA = (LAS float*)(F.lds + AUX_OFF);
    for (int i = F.tid; i < 129 * 8; i += NTHREADS) { const int d = i >> 3, hq = i & 7; const int bk = d < 128 ? (int)kBucketLut[d] : 31; TBA[i] = F.rel_table[bk * 16 + hq] * LOG2E; }
    LAS unsigned* qslot = (LAS unsigned*)(F.lds + LDSCTL_OFF + 64);
    LAS unsigned char* wbuf = F.lds + RING_OFF + AT_SV + F.wave * 9472;
    LAS int* idxl = (LAS int*)(wbuf + 8192);
    __syncthreads();
#define MIX_FETCH(it) do { if (F.tid == 0) *qslot = __hip_atomic_fetch_add((unsigned*)(F.ctl + CW_QUEUE + 64 * l + 32 * qsel), 1u, __ATOMIC_RELAXED, __HIP_MEMORY_SCOPE_AGENT); \
        __syncthreads(); it = (int)*qslot; __syncthreads(); } while (0)
    for (int r = (int)blockIdx.x; r < 1024; r += F.G) {
        if (EN & 0x800) {
            const int b = r >> 9, blk = r & 511;
#pragma unroll 1
            for (int k = 0; k < 2; ++k) { const int u = 8 * blk + F.wave; const int t = k ? (SEQ - 1 - u) : u; const int m = b * SEQ + t;
                select_row(F, m, (LAS unsigned*)wbuf, idxl);
                LDS_WAIT(); __builtin_amdgcn_wave_barrier();
#ifdef PROBE_SEL2
                select_row(F, m, (LAS unsigned*)wbuf, idxl); LDS_WAIT(); __builtin_amdgcn_wave_barrier();
#endif
#ifdef PROBE_ATT2
                sparse_attn_query(F, m, wbuf, TBA, idxl); LDS_WAIT(); __builtin_amdgcn_wave_barrier();
#endif
                sparse_attn_query(F, m, wbuf, TBA, idxl);
                LDS_WAIT(); __builtin_amdgcn_wave_barrier(); }
        }
    }
    __syncthreads();
    int it; MIX_FETCH(it); it += 1024;
    while (it < 1536) { const int r = it & 511; if (EN & 0x100) dense_attn_unit<2>(F, l, (r & 15) >> 3, r & 7, 31 - (r >> 4)); MIX_FETCH(it); it += 1024; }
    while (it < 2048) { const int r = it & 511; if (EN & 0x200) dense_attn_unit<3>(F, l, (r & 15) >> 3, r & 7, 31 - (r >> 4)); MIX_FETCH(it); it += 1024; }
    while (it < MIX_ITEMS) { const int r = it & 511; if (EN & 0x400) dense_attn_unit<1>(F, l, r >> 8, 0, 255 - (r & 255)); MIX_FETCH(it); it += 1024; }
#undef MIX_FETCH
}


__device__ __forceinline__ const float* gp_(const float* p) {
#if defined(__HIP_DEVICE_COMPILE__)
    __builtin_assume(!__builtin_amdgcn_is_shared((const __attribute__((address_space(0))) void*)p)); __builtin_assume(!__builtin_amdgcn_is_private((const __attribute__((address_space(0))) void*)p));
#endif
    return p; }
#ifndef PROBE_KINDS
#define PROBE_KINDS 0u
#endif
#ifndef PROBE_ATT
#define PROBE_ATT 0xF00u
#endif
#ifndef PROBE_REPS
#define PROBE_REPS 1
#endif
#ifndef MK_ONE_LAUNCH
#define MK_ONE_LAUNCH 1
#endif
constexpr int PH_PER_LAYER = 14, N_PHASES = 1 + DEPTH * PH_PER_LAYER;
struct Args { const float* in[15]; float* out; unsigned char* ws; int ph_lo, ph_hi; };
struct ArgsG { const GAS float* in[15]; GAS float* out; GAS unsigned char* ws; int ph_lo, ph_hi; };
template <unsigned EN> __global__ void __launch_bounds__(NTHREADS, 2) trunk_fwd(Args args) {
    extern __shared__ __attribute__((aligned(16))) unsigned char lds[];
    LAS unsigned char* const ldsb = (LAS unsigned char*)lds;
    const int wave0 = __builtin_amdgcn_readfirstlane((int)threadIdx.x >> 6);
    for (int u = threadIdx.x; u < (LDS_BYTES - LDSCTL_OFF) / 4; u += NTHREADS) ((LAS unsigned*)(ldsb + LDSCTL_OFF))[u] = 0u;
    __syncthreads();
#if MK_ONE_LAUNCH
    constexpr int lo = 0, hi = N_PHASES;
#else
    const int lo = args.ph_lo, hi = args.ph_hi;
#endif
    XcdBarrier bar; bar.bar = (unsigned*)(args.ws + WS_CTL) + CW_BAR; bar.x = 0; bar.st = nullptr;
    if (hi - lo > 1) bar = xcd_barrier_post((unsigned*)(args.ws + WS_CTL) + CW_BAR, (volatile LAS unsigned*)(ldsb + LDSCTL_OFF));
#define GP(p) ((const float*)(p))
#define PH_BEGIN(k, kind) if (lo <= (k) && (k) < hi) { _Pragma("unroll 1") for (int rep_ = 0; rep_ < (((PROBE_KINDS >> (kind)) & 1u) ? PROBE_REPS : 1); ++rep_) { Frame F; { \
        const ArgsG* ka = (const ArgsG*)__builtin_amdgcn_kernarg_segment_ptr(); asm volatile("" : "+s"(ka)); \
        unsigned o_ = ~0u; asm volatile("" : "+s"(o_)); int t_ = wave0 * 64 + (int)__builtin_amdgcn_mbcnt_hi(o_, __builtin_amdgcn_mbcnt_lo(o_, 0u)); asm volatile("" : "+v"(t_)); \
        F.lds = ldsb; F.tid = t_; F.lane = t_ & 63; F.wave = wave0; int gw_ = blockIdx.x * NWAVES + wave0; asm volatile("" : "+s"(gw_)); F.G = gridDim.x; F.gw = gw_; F.NGW = F.G * NWAVES; \
        unsigned char* ws = (unsigned char*)ka->ws; F.ctl = (gu32*)(ws + WS_CTL);     \
        F.x = GP(ka->in[0]); F.c = GP(ka->in[1]); F.w_ada = GP(ka->in[2]); F.b_ada = GP(ka->in[3]); F.norm_g = GP(ka->in[4]); F.w_in = GP(ka->in[5]); F.qk_g = GP(ka->in[6]); F.forget_b = GP(ka->in[7]); \
        F.sinks = GP(ka->in[8]); F.rel_table = GP(ka->in[9]); F.group_g = GP(ka->in[10]); F.w_out = GP(ka->in[11]); F.w_gate = GP(ka->in[12]); F.w_up = GP(ka->in[13]); F.w_down = GP(ka->in[14]); F.out = (float*)ka->out; \
        F.MOD = (float*)(ws + WS_MOD); F.LF = (float*)(ws + WS_LF); F.KB2 = (float*)(ws + WS_KB2); F.SC = (unsigned short*)(ws + WS_SC); F.IDX = (int*)(ws + WS_IDX); \
        F.WGU = (bf16*)(ws + WS_WGU); F.WD = (bf16*)(ws + WS_WD); F.WIN = (bf16*)(ws + WS_WIN); F.WOUT = (bf16*)(ws + WS_WOUT); \
        F.H = (bf16*)(ws + WS_H); F.P = (bf16*)(ws + WS_P); F.Y = (bf16*)(ws + WS_Y); F.XB = (bf16*)(ws + WS_XB); }
#define PH_END(k) if ((k) + 1 < hi) xcd_barrier(bar); } }

    PH_BEGIN(0, 31) if (EN & 1) p0_prologue(F); PH_END(0)

    for (int l = 0; l < DEPTH; ++l) {
        const int base = 1 + l * PH_PER_LAYER;
        for (int sub = 0; sub < 3; ++sub) {
            if (sub != 1) {
                const int f = sub >> 1, pb = base + (f ? 11 : 0), ni = f ? 2 : 0, lf = l * 2 + f;
                PH_BEGIN(pb, (f ? 11 : 0)) if (EN & 2) { const float* modl = F.MOD + (size_t)l * BATCH * NMOD;
                    if (l == 0 && f == 0) ph_modulate<FFN_FP8, false>(F, F.x, F.norm_g + ((size_t)l * 3 + ni) * DM, modl + (3 * ni + 0) * DM, modl + (3 * ni + 1) * DM);
                    else ph_modulate<FFN_FP8, true>(F, F.XB, F.norm_g + ((size_t)l * 3 + ni) * DM, modl + (3 * ni + 0) * DM, modl + (3 * ni + 1) * DM); } PH_END(pb)
                PH_BEGIN(pb + 1, (f ? 12 : 1)) if (EN & 4) {
                    pg8::StaticOrder S; S.init(M, NGU, F.G, (int)blockIdx.x);
                    if constexpr (FFN_FP8) { pg8::Gemm g{F.H, (const bf16*)((const unsigned char*)F.WGU + (size_t)lf * NGU * DM), M, NGU, DM, 127, W8_E8M0};
                        pg8::EpiSwiGLU8 E{(unsigned char*)F.P, DFFP};
                        pg8::gemm_phase<pg8::EpiSwiGLU8, pg8::StaticOrder, true, true, true>(F.lds + RING_OFF, g, S, E, F.tid); }
                    else { pg8::Gemm g{F.H, F.WGU + (size_t)lf * NGU * DM, M, NGU, DM};
                        pg8::EpiSwiGLU E{F.P, DFF};
                        pg8::gemm_phase<pg8::EpiSwiGLU, pg8::StaticOrder, true, true>(F.lds + RING_OFF, g, S, E, F.tid); } } PH_END(pb + 1)
                PH_BEGIN(pb + 2, (f ? 13 : 2)) if (EN & 8) {
                    pg8::Gemm g{F.P, FFN_FP8 ? (const bf16*)((const unsigned char*)F.WD + (size_t)lf * DM * DFFP) : F.WD + (size_t)lf * DM * DFF, M, DM, DFF, 127, FFN_FP8 ? W8_E8M0 : 127, FFN_FP8 ? DFFP : 0, FFN_FP8 ? DFFP : 0}; pg8::StaticOrder S; S.init(M, DM, F.G, (int)blockIdx.x);
                    const float* modl = F.MOD + (size_t)l * BATCH * NMOD;
                    if (l == DEPTH - 1 && f == 1) { pg8::EpiResid<false> E{F.XB, rep_ ? (void*)F.SC : (void*)F.out, DM, modl + (3 * ni + 2) * DM, NMOD, SEQ, 0.5f};
                        pg8::gemm_phase<pg8::EpiResid<false>, pg8::StaticOrder, true, true, FFN_FP8>(F.lds + RING_OFF, g, S, E, F.tid); }
                    else { pg8::EpiResid<true> E{F.XB, rep_ ? (void*)F.SC : (void*)F.XB, DM, modl + (3 * ni + 2) * DM, NMOD, SEQ, 0.5f};
                        pg8::gemm_phase<pg8::EpiResid<true>, pg8::StaticOrder, true, true, FFN_FP8>(F.lds + RING_OFF, g, S, E, F.tid); } } PH_END(pb + 2)
            } else {
                PH_BEGIN(base + 3, 3) if (EN & 2) { const float* modl = F.MOD + (size_t)l * BATCH * NMOD; ph_modulate<false, true>(F, F.XB, F.norm_g + ((size_t)l * 3 + 1) * DM, modl + 3 * DM, modl + 4 * DM); } PH_END(base + 3)
                PH_BEGIN(base + 4, 4) if (EN & 16) {
                    pg8::Gemm g{F.H, F.WIN + (size_t)l * NIN * DM, M, NIN, DM}; pg8::StaticOrder S; S.init(M, NIN, F.G, (int)blockIdx.x);
                    pg8::EpiBf16 E{F.P, NIN};
                    pg8::gemm_phase<pg8::EpiBf16, pg8::StaticOrder, true, true>(F.lds + RING_OFF, g, S, E, F.tid); } PH_END(base + 4)
                PH_BEGIN(base + 6, 6) if (EN & 64) { ph_scan(F, l);
                    int par_ = (int)((blockIdx.x & 1u) ^ 1u); asm volatile("" : "+s"(par_));
                    _Pragma("unroll 1") for (int st_ = 0; st_ < 2; ++st_) { if ((st_ ^ par_) == 0) { if (EN & 32) ph_post(F, l); } else ph_idx_scores(F); } } PH_END(base + 6)
                PH_BEGIN(base + 8, 8) if (EN & 0xF00) { if (rep_ == 0) ph_attention<EN>(F, l, 0); else ph_attention<(PROBE_ATT)>(F, l, 1); } PH_END(base + 8)
                PH_BEGIN(base + 9, 9) if (EN & 0x1000) ph_gnorm(F, l); PH_END(base + 9)
                PH_BEGIN(base + 10, 10) if (EN & 0x2000) {
                    pg8::Gemm g{F.Y, F.WOUT + (size_t)l * DM * DM, M, DM, DM}; pg8::StaticOrder S; S.init(M, DM, F.G, (int)blockIdx.x);
                    const float* modl = F.MOD + (size_t)l * BATCH * NMOD;
                    pg8::EpiResid<true> E{F.XB, rep_ ? (void*)F.SC : (void*)F.XB, DM, modl + 5 * DM, NMOD, SEQ, 1.0f};
                    pg8::gemm_phase<pg8::EpiResid<true>, pg8::StaticOrder, true, true>(F.lds + RING_OFF, g, S, E, F.tid); } PH_END(base + 10)
            }
        }
    }
#undef PH_BEGIN
#undef PH_END
}

#ifndef EN_MASK
#define EN_MASK 0xFFFFu
#endif
template <unsigned EN> static int setup_kernel() {
    if (hipFuncSetAttribute((const void*)trunk_fwd<EN>, hipFuncAttributeMaxDynamicSharedMemorySize, LDS_BYTES) != hipSuccess) { fprintf(stderr, "kernel_launch: hipFuncSetAttribute failed\n"); return -1; }
    int per_cu = 0;
    if (hipOccupancyMaxActiveBlocksPerMultiprocessor(&per_cu, (const void*)trunk_fwd<EN>, NTHREADS, LDS_BYTES) != hipSuccess || per_cu < 1) { fprintf(stderr, "kernel_launch: occupancy query says %d\n", per_cu); }
    (void)hipGetLastError();
    return 0;
}
template <unsigned EN> static void launch_range(const Args& a0, int lo, int hi, int grid, hipStream_t stream) {
    Args a = a0; a.ph_lo = lo; a.ph_hi = hi;
    hipLaunchKernelGGL(trunk_fwd<EN>, dim3(grid), dim3(NTHREADS), LDS_BYTES, stream, a);
}
extern "C" void kernel_launch(void* const* d_in, const int* in_sizes, int n_in, void* d_out, int out_size, void* d_ws, size_t ws_size, hipStream_t stream) {
    static int grid = 0;
    if (grid == 0) {
        if (n_in != 15 || in_sizes[0] != M * DM || out_size != M * DM || ws_size < WS_END) {
            fprintf(stderr, "kernel_launch: shape/workspace mismatch: n_in %d in0 %d out %d ws %zu (need %zu); nothing launched\n", n_in, n_in > 0 ? in_sizes[0] : -1, out_size, ws_size, (size_t)WS_END); grid = -1; return; }
        int dev = 0, cus = 0;
        if (hipGetDevice(&dev) != hipSuccess || hipDeviceGetAttribute(&cus, hipDeviceAttributeMultiprocessorCount, dev) != hipSuccess) { grid = -1; return; }
#if MK_ONE_LAUNCH
        if (setup_kernel<EN_MASK>()) { grid = -1; return; }
#else
        if (setup_kernel<0x1u>() || setup_kernel<0x2u>() || setup_kernel<0x4u>() || setup_kernel<0x8u>() || setup_kernel<0x10u>() || setup_kernel<0x20u>() || setup_kernel<0x40u>() || setup_kernel<0x80u>() ||
            setup_kernel<0x100u>() || setup_kernel<0x200u>() || setup_kernel<0x400u>() || setup_kernel<0x800u>() || setup_kernel<0x1000u>() || setup_kernel<0x2000u>()) { grid = -1; return; }
#endif
        grid = cus;
    }
    if (grid < 0) return;
    if (hipMemsetAsync((char*)d_ws + WS_CTL, 0, CTL_ZERO_BYTES, stream) != hipSuccess) return;
    Args a{};
    for (int i = 0; i < 15; ++i) a.in[i] = (const float*)d_in[i];
    a.out = (float*)d_out; a.ws = (unsigned char*)d_ws;
#if MK_ONE_LAUNCH
    launch_range<EN_MASK>(a, 0, N_PHASES, grid, stream);
#else
    launch_range<0x1u>(a, 0, 1, grid, stream);
    for (int l = 0; l < DEPTH; ++l) { const int base = 1 + l * PH_PER_LAYER;
        for (int f = 0; f < 2; ++f) { const int pb = base + (f ? 11 : 0);
            if (f == 1) {
                launch_range<0x2u>(a, base + 3, base + 4, grid, stream); launch_range<0x10u>(a, base + 4, base + 5, grid, stream); launch_range<0x20u>(a, base + 5, base + 6, grid, stream);
                launch_range<0x40u>(a, base + 6, base + 7, grid, stream); launch_range<0x80u>(a, base + 7, base + 8, grid, stream);
                launch_range<0x100u>(a, base + 8, base + 9, grid, stream); launch_range<0x200u>(a, base + 8, base + 9, grid, stream); launch_range<0x400u>(a, base + 8, base + 9, grid, stream); launch_range<0x800u>(a, base + 8, base + 9, grid, stream);
                launch_range<0x1000u>(a, base + 9, base + 10, grid, stream); launch_range<0x2000u>(a, base + 10, base + 11, grid, stream);
            }
            launch_range<0x2u>(a, pb, pb + 1, grid, stream); launch_range<0x4u>(a, pb + 1, pb + 2, grid, stream); launch_range<0x8u>(a, pb + 2, pb + 3, grid, stream);
        }
    }
#endif
}
```

```cpp
#include <hip/hip_runtime.h>
#include <cstdio>
#include <cstdint>

namespace pg8 {
#define PG8_LAS __attribute__((address_space(3)))
typedef unsigned short bf16_t;
typedef short bf16x8 __attribute__((ext_vector_type(8)));
typedef float f32x4 __attribute__((ext_vector_type(4)));
typedef unsigned u32x4 __attribute__((ext_vector_type(4)));
constexpr int BM = 256, BK = 64, HALF = 128, HTB = HALF * BK * 2  , STAGE_BYTES = 8 * HTB, NXCD = 8, WGM = 8;

__host__ __device__ __forceinline__ int lds_byte(int r, int c) { const int st = (r >> 4) * 2 + (c >> 5), rr = r & 15, cc = c & 31, ob = rr * 64 + cc * 2; return st * 1024 + (ob ^ (((ob >> 9) & 1) << 5)); }
__host__ __device__ __forceinline__ void stage_rc(int b, int& R, int& C) { const int st = b / 1024, sb = b % 1024, swz = sb ^ (((sb >> 9) & 1) << 5); R = (st >> 1) * 16 + swz / 64; C = (st & 1) * 32 + (swz % 64) / 2; }
__host__ __device__ __forceinline__ int perm32(int rho) { const int n = rho >> 4, i = rho & 15; return 8 * (i >> 2) + 4 * n + (i & 3); }

struct Unit { int pm, pn; };
struct Gemm { const bf16_t* A; const bf16_t* Bt; int M, N, K; int scaleA = 127, scaleB = 127; int lda = 0, ldb = 0; int blk = 0; };
typedef int i32x8 __attribute__((ext_vector_type(8))); typedef int i32x4v __attribute__((ext_vector_type(4)));
__device__ __forceinline__ i32x8 pg8_cat(bf16x8 lo, bf16x8 hi) { return __builtin_shufflevector(__builtin_bit_cast(i32x4v, lo), __builtin_bit_cast(i32x4v, hi), 0, 1, 2, 3, 4, 5, 6, 7); }

struct StaticOrder {
    int nM, nN, nwg, G, c;
    __host__ __device__ void init(int M, int N, int G_, int c_) { nM = M / BM; nN = N / BM; nwg = nM * nN; G = G_; c = c_; }
    __host__ __device__ bool next(int i, Unit& u) const {
        const long L = (long)i * G + c; if (L >= nwg) return false;
        int wgid = (int)L; { const int q = nwg / NXCD, r = nwg % NXCD, xcd = wgid % NXCD, off = wgid / NXCD; wgid = (xcd < r ? xcd * (q + 1) : r * (q + 1) + (xcd - r) * q) + off; }
        const int nig = WGM * nN, gid = wgid / nig, fm = gid * WGM, gsz = (nM - fm) < WGM ? (nM - fm) : WGM;
        u.pm = fm + ((wgid % nig) % gsz); u.pn = (wgid % nig) / gsz; return true;
    }
    __device__ __forceinline__ void a_ready(const Unit&) const {}
    __device__ __forceinline__ void done(const Unit&) const {}
};
typedef __bf16 pg8_bfpair __attribute__((ext_vector_type(2))); typedef float pg8_f32pair __attribute__((ext_vector_type(2)));
__device__ __forceinline__ unsigned cvt_pk_bf16(float lo, float hi) { const pg8_f32pair v = {lo, hi}; return __builtin_bit_cast(unsigned, __builtin_convertvector(v, pg8_bfpair)); }
__device__ __forceinline__ unsigned cvt_pk_bf16_nv(float lo, float hi) { return cvt_pk_bf16(lo, hi); }
__device__ __forceinline__ const char* uptr(const char* p) { const unsigned long long v = (unsigned long long)p; const unsigned lo = __builtin_amdgcn_readfirstlane((unsigned)v), hi = __builtin_amdgcn_readfirstlane((unsigned)(v >> 32)); return (const char*)(((unsigned long long)hi << 32) | lo); }
struct EpiBf16 {
    static constexpr bool PERM = true, AFTER_DRAIN = false;
    bf16_t* O; int ldc;
    __device__ __forceinline__ void operator()(const f32x4 (&acc)[2][2][4][2], const Unit& u, int wr, int wc, int fr, int fq) const {
        asm volatile("" : "+v"(fr), "+v"(fq));
        const int row0 = u.pm * BM + wr * 64 + fr; const int col0 = u.pn * BM + wc * 32 + 8 * fq;
#pragma unroll
        for (int ai = 0; ai < 2; ++ai)
#pragma unroll
            for (int m = 0; m < 4; ++m) { bf16_t* rowp = O + (size_t)(row0 + ai * HALF + m * 16) * ldc + col0;
#pragma unroll
                for (int bj = 0; bj < 2; ++bj) { const f32x4 v0 = acc[ai][bj][m][0], v1 = acc[ai][bj][m][1];
                    u32x4 w; w.x = cvt_pk_bf16(v0[0], v0[1]); w.y = cvt_pk_bf16(v0[2], v0[3]); w.z = cvt_pk_bf16(v1[0], v1[1]); w.w = cvt_pk_bf16(v1[2], v1[3]);
                    *(u32x4*)(rowp + bj * HALF) = w; } }
    }
};
__device__ __forceinline__ float silu_mul(float g, float u) { return g * u * __builtin_amdgcn_rcpf(1.0f + __builtin_amdgcn_exp2f(-1.4426950408889634f * g)); }
struct EpiSwiGLU {
    static constexpr bool PERM = true, AFTER_DRAIN = false;
    bf16_t* O; int ldc;
    __device__ __forceinline__ void operator()(const f32x4 (&acc)[2][2][4][2], const Unit& u, int wr, int wc, int fr, int fq) const {
        asm volatile("" : "+v"(fr), "+v"(fq));
        const int row0 = u.pm * BM + wr * 64 + fr; const int col0 = u.pn * HALF + wc * 32 + 8 * fq;
#pragma unroll
        for (int ai = 0; ai < 2; ++ai)
#pragma unroll
            for (int m = 0; m < 4; ++m) { bf16_t* rowp = O + (size_t)(row0 + ai * HALF + m * 16) * ldc + col0;
                const f32x4 g0 = acc[ai][0][m][0], g1 = acc[ai][0][m][1], u0 = acc[ai][1][m][0], u1 = acc[ai][1][m][1];
                u32x4 w; w.x = cvt_pk_bf16(silu_mul(g0[0], u0[0]), silu_mul(g0[1], u0[1])); w.y = cvt_pk_bf16(silu_mul(g0[2], u0[2]), silu_mul(g0[3], u0[3]));
                w.z = cvt_pk_bf16(silu_mul(g1[0], u1[0]), silu_mul(g1[1], u1[1])); w.w = cvt_pk_bf16(silu_mul(g1[2], u1[2]), silu_mul(g1[3], u1[3]));
                *(u32x4*)rowp = w; }
    }
};
template <bool OUT16> struct EpiResid {
    static constexpr bool PERM = true, AFTER_DRAIN = false;
    const bf16_t* base; void* out; int ldc; const float* gv; int gstride; int rows_per_batch; float coef;
    __device__ __forceinline__ void operator()(const f32x4 (&acc)[2][2][4][2], const Unit& u, int wr, int wc, int fr, int fq) const {
        asm volatile("" : "+v"(fr), "+v"(fq));
        const int row0 = u.pm * BM + wr * 64 + fr; const int col0 = u.pn * BM + wc * 32 + 8 * fq;
        const float* gvec = gv + (size_t)((u.pm * BM) / rows_per_batch) * gstride + col0;
        f32x4 gg[2][2];
#pragma unroll
        for (int bj = 0; bj < 2; ++bj)
#pragma unroll
            for (int n = 0; n < 2; ++n) gg[bj][n] = *(const f32x4*)(gvec + bj * HALF + 4 * n) * coef;
#pragma unroll
        for (int ai = 0; ai < 2; ++ai) {
            u32x4 bwv[4][2];
#pragma unroll
            for (int m = 0; m < 4; ++m) { const size_t off = (size_t)(row0 + ai * HALF + m * 16) * ldc + col0;
#pragma unroll
                for (int bj = 0; bj < 2; ++bj) bwv[m][bj] = *(const u32x4*)(base + off + bj * HALF); }
            __builtin_amdgcn_sched_barrier(0);
#pragma unroll
            for (int m = 0; m < 4; ++m) { const size_t off = (size_t)(row0 + ai * HALF + m * 16) * ldc + col0;
#pragma unroll
                for (int bj = 0; bj < 2; ++bj) { const u32x4 bw = bwv[m][bj];
                    f32x4 b0, b1; b0[0] = __builtin_bit_cast(float, bw.x << 16); b0[1] = __builtin_bit_cast(float, bw.x & 0xffff0000u); b0[2] = __builtin_bit_cast(float, bw.y << 16); b0[3] = __builtin_bit_cast(float, bw.y & 0xffff0000u);
                    b1[0] = __builtin_bit_cast(float, bw.z << 16); b1[1] = __builtin_bit_cast(float, bw.z & 0xffff0000u); b1[2] = __builtin_bit_cast(float, bw.w << 16); b1[3] = __builtin_bit_cast(float, bw.w & 0xffff0000u);
                    const f32x4 r0 = b0 + gg[bj][0] * acc[ai][bj][m][0], r1 = b1 + gg[bj][1] * acc[ai][bj][m][1];
                    if constexpr (OUT16) { u32x4 w; w.x = cvt_pk_bf16_nv(r0[0], r0[1]); w.y = cvt_pk_bf16_nv(r0[2], r0[3]); w.z = cvt_pk_bf16_nv(r1[0], r1[1]); w.w = cvt_pk_bf16_nv(r1[2], r1[3]); *(u32x4*)((bf16_t*)out + off + bj * HALF) = w; }
                    else { *(f32x4*)((float*)out + off + bj * HALF) = r0; *(f32x4*)((float*)out + off + bj * HALF + 4) = r1; } } }
        }
    }
};
__device__ __forceinline__ unsigned pack_fp8x4(float a, float b, float c, float d) {
    a = fminf(fmaxf(a, -448.f), 448.f); b = fminf(fmaxf(b, -448.f), 448.f); c = fminf(fmaxf(c, -448.f), 448.f); d = fminf(fmaxf(d, -448.f), 448.f);
    int w = 0; w = __builtin_amdgcn_cvt_pk_fp8_f32(a, b, w, false); w = __builtin_amdgcn_cvt_pk_fp8_f32(c, d, w, true); return (unsigned)w; }
struct EpiSwiGLU8 {
    static constexpr bool PERM = true, AFTER_DRAIN = false;
    unsigned char* O; int ldc;
    __device__ __forceinline__ void operator()(const f32x4 (&acc)[2][2][4][2], const Unit& u, int wr, int wc, int fr, int fq) const {
        asm volatile("" : "+v"(fr), "+v"(fq));
        const int row0 = u.pm * BM + wr * 64 + fr; const int col0 = u.pn * HALF + wc * 32 + 8 * fq;
#pragma unroll
        for (int ai = 0; ai < 2; ++ai)
#pragma unroll
            for (int m = 0; m < 4; ++m) { unsigned char* rowp = O + (size_t)(row0 + ai * HALF + m * 16) * ldc + col0;
                const f32x4 g0 = acc[ai][0][m][0], g1 = acc[ai][0][m][1], u0 = acc[ai][1][m][0], u1 = acc[ai][1][m][1];
                typedef unsigned u32x2v __attribute__((ext_vector_type(2))); u32x2v w;
                w.x = pack_fp8x4(silu_mul(g0[0], u0[0]), silu_mul(g0[1], u0[1]), silu_mul(g0[2], u0[2]), silu_mul(g0[3], u0[3]));
                w.y = pack_fp8x4(silu_mul(g1[0], u1[0]), silu_mul(g1[1], u1[1]), silu_mul(g1[2], u1[2]), silu_mul(g1[3], u1[3]));
                *(u32x2v*)rowp = w; }
    }
};
template <class Epi, class Sched, bool ALIGN_EPI = false, bool SP2 = false, bool FP8 = false>
__device__ __forceinline__ void gemm_phase(PG8_LAS unsigned char* lds, const Gemm g, const Sched& S, const Epi& E, int tid_in) {
    int tid_ = tid_in; asm volatile("" : "+v"(tid_));
    const int tid = tid_, wid = __builtin_amdgcn_readfirstlane(tid >> 6), lane = tid & 63, wr = wid >> 2, wc = wid & 3, fr = lane & 15, fq = lane >> 4;
    const int K = g.K, nt = FP8 ? K / (2 * BK) : K / BK;
    const int pitchA = g.blk ? 2 * BK : g.lda ? g.lda : (FP8 ? K : 2 * K), pitchB = g.blk ? 2 * BK : g.ldb ? g.ldb : (FP8 ? K : 2 * K);
    unsigned voffA[2], voffB[2];
#pragma unroll
    for (int i = 0; i < 2; ++i) { int R, C; stage_rc(tid * 16 + i * 8192, R, C); const int Rb = Epi::PERM ? ((R & ~31) + perm32(R & 31)) : R;
        voffA[i] = (unsigned)(R * pitchA + C * 2); voffB[i] = (unsigned)(Rb * pitchB + C * 2); }
    const size_t kstep = g.blk ? (size_t)(512 * BK) : (size_t)(BK * 2);
    const size_t hstepA = (size_t)HALF * pitchA, hstepB = (size_t)HALF * pitchB;
    const size_t tstepA = g.blk ? (size_t)(FP8 ? K / (2 * BK) : K / BK) * kstep : 2 * hstepA, tstepB = g.blk ? tstepA : 2 * hstepB;
    const unsigned ldsw = (unsigned)wid * 1024u;
    const int aoff = lds_byte(wr * 64 + fr, fq * 8), boff = lds_byte(wc * 32 + fr, fq * 8);
    PG8_LAS unsigned char* abase = lds + aoff; PG8_LAS unsigned char* bbase = lds + boff + 4 * HTB;
#define PG8_SA(b, h) (((b) * 2 + (h)) * HTB)
#define PG8_SB(b, h) ((4 + (b) * 2 + (h)) * HTB)
#define PG8_STAGE(bufoff, gbase, voff) do { _Pragma("unroll") for (int _i = 0; _i < 2; ++_i) \
        __builtin_amdgcn_global_load_lds((const unsigned*)((const char*)(gbase) + (voff)[_i]), (PG8_LAS unsigned*)(lds + (bufoff) + ldsw + _i * 8192), 16, 0, 0); } while (0)
#define PG8_RDA(off) (*(const PG8_LAS bf16x8*)(abase + (off)))
#define PG8_RDB(off) (*(const PG8_LAS bf16x8*)(bbase + ((off) - 4 * HTB)))
#define PG8_LDA(dst, b, h) do { if constexpr (FP8) { _Pragma("unroll") for (int m = 0; m < 4; ++m) dst##8[m] = pg8_cat(PG8_RDA(PG8_SA(b, h) + m * 2048), PG8_RDA(PG8_SA(b, h) + m * 2048 + 1024)); } \
    else { _Pragma("unroll") for (int m = 0; m < 4; ++m) _Pragma("unroll") for (int k = 0; k < 2; ++k) dst[m][k] = PG8_RDA(PG8_SA(b, h) + m * 2048 + k * 1024); } } while (0)
#define PG8_LDB(dst, b, h) do { if constexpr (FP8) { _Pragma("unroll") for (int n = 0; n < 2; ++n) dst##8[n] = pg8_cat(PG8_RDB(PG8_SB(b, h) + n * 2048), PG8_RDB(PG8_SB(b, h) + n * 2048 + 1024)); } \
    else { _Pragma("unroll") for (int n = 0; n < 2; ++n) _Pragma("unroll") for (int k = 0; k < 2; ++k) dst[n][k] = PG8_RDB(PG8_SB(b, h) + n * 2048 + k * 1024); } } while (0)
#define PG8_MMA(ai, bj, At, Bt) do { __builtin_amdgcn_s_setprio(1); if constexpr (FP8) { \
        _Pragma("unroll") for (int m = 0; m < 4; ++m) _Pragma("unroll") for (int n = 0; n < 2; ++n) \
            asm volatile("v_mfma_scale_f32_16x16x128_f8f6f4 %0, %1, %2, %0, %3, %4 op_sel_hi:[0,0,0]" : "+v"(acc[ai][bj][m][n]) : "v"(Bt##8[n]), "v"(At##8[m]), "v"(sclB), "v"(sclA)); \
        } else { _Pragma("unroll") for (int m = 0; m < 4; ++m) _Pragma("unroll") for (int n = 0; n < 2; ++n) _Pragma("unroll") for (int k = 0; k < 2; ++k) \
        acc[ai][bj][m][n] = __builtin_amdgcn_mfma_f32_16x16x32_bf16(Bt[n][k], At[m][k], acc[ai][bj][m][n], 0, 0, 0); } __builtin_amdgcn_s_setprio(0); } while (0)
#define PG8_WAIT_V(n) asm volatile("s_waitcnt vmcnt(" #n ")" ::: "memory")
#define PG8_WAIT_L(n) asm volatile("s_waitcnt lgkmcnt(" #n ")" ::: "memory")
#define PG8_BAR __builtin_amdgcn_s_barrier()
#define PG8_SCHED __builtin_amdgcn_sched_barrier(0)
    Unit cur, nxt; int ui = 0;
    if (!S.next(0, cur)) return;
    f32x4 acc[2][2][4][2];
#pragma unroll
    for (int a = 0; a < 2; ++a)
#pragma unroll
        for (int b = 0; b < 2; ++b)
#pragma unroll
            for (int m = 0; m < 4; ++m)
#pragma unroll
                for (int n = 0; n < 2; ++n) acc[a][b][m][n] = (f32x4){0.f, 0.f, 0.f, 0.f};
    const int sclA = g.scaleA, sclB = g.scaleB;
    bf16x8 At[4][2], B0[2][2], B1[2][2]; i32x8 At8[4], B08[2], B18[2];
    const char* cA = uptr((const char*)g.A + (size_t)cur.pm * tstepA); const char* cB = uptr((const char*)g.Bt + (size_t)cur.pn * tstepB);
    S.a_ready(cur);
    if constexpr (SP2) {
        PG8_STAGE(PG8_SB(0, 0), cB, voffB); PG8_STAGE(PG8_SB(0, 1), cB + hstepB, voffB); PG8_STAGE(PG8_SA(0, 0), cA, voffA); PG8_STAGE(PG8_SA(0, 1), cA + hstepA, voffA);
        if (wr == 1) PG8_BAR;
        PG8_WAIT_V(2); PG8_BAR;
        PG8_STAGE(PG8_SB(1, 0), cB + kstep, voffB); PG8_STAGE(PG8_SA(1, 0), cA + kstep, voffA); PG8_STAGE(PG8_SB(1, 1), cB + hstepB + kstep, voffB);
        PG8_WAIT_V(6); PG8_BAR;
    } else {
        PG8_STAGE(PG8_SB(0, 0), cB, voffB); PG8_STAGE(PG8_SA(0, 0), cA, voffA); PG8_STAGE(PG8_SB(0, 1), cB + hstepB, voffB); PG8_STAGE(PG8_SA(0, 1), cA + hstepA, voffA);
        if (wr == 1) PG8_BAR;
        PG8_WAIT_V(4); PG8_BAR;
        PG8_STAGE(PG8_SB(1, 0), cB + kstep, voffB); PG8_STAGE(PG8_SA(1, 0), cA + kstep, voffA); PG8_STAGE(PG8_SB(1, 1), cB + hstepB + kstep, voffB);
        PG8_WAIT_V(6); PG8_BAR;
    }
    for (;;) {
        const bool has_next = S.next(ui + 1, nxt);
        const char* nA = uptr(has_next ? (const char*)g.A + (size_t)nxt.pm * tstepA : cA); const char* nB = uptr(has_next ? (const char*)g.Bt + (size_t)nxt.pn * tstepB : cB);
        for (int t = 0; t < nt; t += 2) {
            asm volatile("" : "+v"(abase), "+v"(bbase));
            const bool last = (t == nt - 2);
            const char* a1 = cA + (size_t)(t + 1) * kstep;
            const char* a2 = uptr(last ? nA : cA + (size_t)(t + 2) * kstep); const char* b2 = uptr(last ? nB : cB + (size_t)(t + 2) * kstep);
            const char* a3 = a2 + kstep; const char* b3 = b2 + kstep;
            if (last && has_next) S.a_ready(nxt);
            if constexpr (SP2) {
            PG8_LDB(B0, 0, 0); PG8_LDB(B1, 0, 1); PG8_SCHED; PG8_LDA(At, 0, 0); PG8_STAGE(PG8_SA(1, 1), a1 + hstepA, voffA);
            PG8_WAIT_V(8); PG8_WAIT_L(0); PG8_BAR; PG8_MMA(0, 0, At, B0); PG8_MMA(0, 1, At, B1); PG8_BAR; PG8_SCHED;
            PG8_LDA(At, 0, 1); PG8_STAGE(PG8_SB(0, 0), b2, voffB); PG8_STAGE(PG8_SB(0, 1), b2 + hstepB, voffB); PG8_STAGE(PG8_SA(0, 0), a2, voffA);
            PG8_WAIT_V(8); PG8_WAIT_L(0); PG8_BAR; PG8_MMA(1, 0, At, B0); PG8_MMA(1, 1, At, B1); PG8_BAR; PG8_SCHED;
            PG8_LDB(B0, 1, 0); PG8_LDB(B1, 1, 1); PG8_SCHED; PG8_LDA(At, 1, 0); PG8_STAGE(PG8_SA(0, 1), a2 + hstepA, voffA);
            PG8_WAIT_V(8); PG8_WAIT_L(0); PG8_BAR; PG8_MMA(0, 0, At, B0); PG8_MMA(0, 1, At, B1); PG8_BAR; PG8_SCHED;
            PG8_LDA(At, 1, 1); PG8_STAGE(PG8_SB(1, 0), b3, voffB); PG8_STAGE(PG8_SB(1, 1), b3 + hstepB, voffB); PG8_STAGE(PG8_SA(1, 0), a3, voffA);
            PG8_WAIT_V(8); PG8_WAIT_L(0); PG8_BAR; PG8_MMA(1, 0, At, B0); PG8_MMA(1, 1, At, B1); PG8_BAR; PG8_SCHED;
            } else {
            PG8_LDB(B0, 0, 0); PG8_SCHED; PG8_LDA(At, 0, 0); PG8_STAGE(PG8_SA(1, 1), a1 + hstepA, voffA);
            PG8_WAIT_L(8); PG8_BAR; PG8_WAIT_L(0); PG8_MMA(0, 0, At, B0); PG8_BAR; PG8_SCHED;
            PG8_LDB(B1, 0, 1); PG8_STAGE(PG8_SB(0, 0), b2, voffB);
            PG8_BAR; PG8_WAIT_L(0); PG8_MMA(0, 1, At, B1); PG8_BAR;
            PG8_LDA(At, 0, 1); PG8_STAGE(PG8_SA(0, 0), a2, voffA);
            PG8_BAR; PG8_WAIT_L(0); PG8_MMA(1, 0, At, B0); PG8_BAR; PG8_SCHED;
            PG8_STAGE(PG8_SB(0, 1), b2 + hstepB, voffB);
            PG8_WAIT_V(6); PG8_BAR; PG8_MMA(1, 1, At, B1); PG8_BAR;
            PG8_LDB(B0, 1, 0); PG8_SCHED; PG8_LDA(At, 1, 0); PG8_STAGE(PG8_SA(0, 1), a2 + hstepA, voffA);
            PG8_WAIT_L(8); PG8_BAR; PG8_WAIT_L(0); PG8_MMA(0, 0, At, B0); PG8_BAR; PG8_SCHED;
            PG8_LDB(B1, 1, 1); PG8_STAGE(PG8_SB(1, 0), b3, voffB);
            PG8_BAR; PG8_WAIT_L(0); PG8_MMA(0, 1, At, B1); PG8_BAR;
            PG8_LDA(At, 1, 1); PG8_STAGE(PG8_SA(1, 0), a3, voffA);
            PG8_BAR; PG8_WAIT_L(0); PG8_MMA(1, 0, At, B0); PG8_BAR; PG8_SCHED;
            PG8_STAGE(PG8_SB(1, 1), b3 + hstepB, voffB);
            PG8_WAIT_V(6); PG8_BAR; PG8_MMA(1, 1, At, B1); PG8_BAR;
            }
        }
        if constexpr (FP8) asm volatile("s_nop 15\n\ts_nop 7" ::: "memory");
        if constexpr (ALIGN_EPI) { if (wr == 0) PG8_BAR; }
        if constexpr (!Epi::AFTER_DRAIN) { E(acc, cur, wr, wc, fr, fq); S.done(cur); }
        if (!has_next) break;
#pragma unroll
        for (int a = 0; a < 2; ++a)
#pragma unroll
            for (int b = 0; b < 2; ++b)
#pragma unroll
                for (int m = 0; m < 4; ++m)
#pragma unroll
                    for (int n = 0; n < 2; ++n) acc[a][b][m][n] = (f32x4){0.f, 0.f, 0.f, 0.f};
        cur = nxt; cA = nA; cB = nB; ++ui;
        if constexpr (ALIGN_EPI) { if (wr == 1) PG8_BAR; }
    }
    PG8_WAIT_V(0);
    if constexpr (!ALIGN_EPI) { if (wr == 0) PG8_BAR; }
    PG8_BAR;
    if constexpr (Epi::AFTER_DRAIN) { E.fused(acc, cur, wr, wc, fr, fq, lds, wid, lane); S.done(cur); }
#undef PG8_SA
#undef PG8_SB
#undef PG8_STAGE
#undef PG8_RDA
#undef PG8_RDB
#undef PG8_LDA
#undef PG8_LDB
#undef PG8_MMA
#undef PG8_WAIT_V
#undef PG8_WAIT_L
#undef PG8_BAR
#undef PG8_SCHED
}
}

#ifndef MK_FFN_FP8
#define MK_FFN_FP8 1
#endif
constexpr bool FFN_FP8 = MK_FFN_FP8;
constexpr int NWAVES = 8, NTHREADS = NWAVES * 64;
constexpr int BATCH = 2, SEQ = 8192, M = BATCH * SEQ, DM = 2048, DEPTH = 4, DFF = 5632, NGU = 2 * DFF, INC = 5976, NIN = 6144, NMOD = 9 * DM;
constexpr int DFFP = DFF + 128;
constexpr int NH = 8, HD = 64, GWID = 512, TOPK = 256, WINDOW = 128;
constexpr int PA_Q = 0, PA_K = 512, PA_V = 576, PA_IQ = 640, PA_IK = 1664, PB_Q = 1728, PB_K = 2240, PB_V = 2304, PC_Q = 2368, PC_K = 2880, PC_V = 3392, PC_G = 3904,
              PD_Q = 4416, PD_K = 4928, PD_V = 5440, PA_IW = 5952, PC_F = 5968;
constexpr float RMS_EPS = 1e-6f, LOG2E = 1.4426950408889634f, QSCALE = 0.125f * LOG2E;

constexpr size_t MiB = 1u << 20;
constexpr size_t WS_CTL = 0, CTL_ZERO_BYTES = 64 * 1024;
constexpr size_t WS_MOD = 1 * MiB;
constexpr size_t WS_LF = 2 * MiB;
constexpr size_t WS_KB2 = 3 * MiB;
constexpr size_t WS_WGU = 4 * MiB;
constexpr size_t SZ_WGU = (size_t)NGU * DM * 2;
constexpr size_t WS_WD = WS_WGU + 8 * SZ_WGU;
constexpr size_t SZ_WD = (size_t)DM * DFF * 2;
constexpr size_t WS_WIN = WS_WD + 8 * SZ_WD;
constexpr size_t SZ_WIN = (size_t)NIN * DM * 2;
constexpr size_t WS_WOUT = WS_WIN + 4 * SZ_WIN;
constexpr size_t SZ_WOUT = (size_t)DM * DM * 2;
constexpr size_t WS_H = WS_WOUT + 4 * SZ_WOUT;
constexpr size_t WS_P = WS_H + (size_t)M * DM * 2;
constexpr size_t WS_Y = WS_P + (size_t)M * NIN * 2;
constexpr size_t WS_IDX = WS_Y + (size_t)M * DM * 2;
constexpr size_t WS_SC = WS_IDX + (size_t)M * TOPK * 4;
constexpr size_t WS_XB = WS_SC + (size_t)BATCH * SEQ * SEQ * 2;
constexpr size_t WS_END = WS_XB + (size_t)M * DM * 2;
static_assert(WS_WGU % MiB == 0 && WS_WD % MiB == 0 && WS_WIN % MiB == 0 && WS_WOUT % MiB == 0 && WS_H % MiB == 0 && WS_P % MiB == 0 && WS_Y % MiB == 0 && WS_IDX % MiB == 0 && WS_SC % MiB == 0, "d_ws map alignment");
constexpr int CW_BAR = 4096;

constexpr int RING_OFF = 0, RING_BYTES = 131072;
constexpr int AUX_OFF = RING_BYTES, AUX_BYTES = 16384;
constexpr int LDSCTL_OFF = AUX_OFF + AUX_BYTES;
constexpr int LDS_BYTES = LDSCTL_OFF + 256;

#define GAS __attribute__((address_space(1)))
#define LAS __attribute__((address_space(3)))
typedef unsigned short bf16;
typedef unsigned v4u __attribute__((ext_vector_type(4)));
typedef unsigned v2u __attribute__((ext_vector_type(2)));
typedef int v4i __attribute__((ext_vector_type(4)));
typedef float f32x4 __attribute__((ext_vector_type(4)));
typedef float f32x16 __attribute__((ext_vector_type(16)));
typedef short bf16x8 __attribute__((ext_vector_type(8)));
typedef short s16x4 __attribute__((ext_vector_type(4)));
typedef GAS unsigned gu32;
#define RLX_AGENT __ATOMIC_RELAXED, __HIP_MEMORY_SCOPE_AGENT
#define LDS_WAIT() asm volatile("s_waitcnt lgkmcnt(0)" ::: "memory")
#define VM_WAIT() asm volatile("s_waitcnt vmcnt(0)" ::: "memory")
__device__ __forceinline__ unsigned f2bf(float f) { unsigned u = __builtin_bit_cast(unsigned, f); return (u + 0x7fffu + ((u >> 16) & 1u)) >> 16; }
__device__ __forceinline__ unsigned pk2(float lo, float hi) { return f2bf(lo) | (f2bf(hi) << 16); }
__device__ __forceinline__ float bf_lo(unsigned w) { return __builtin_bit_cast(float, w << 16); }
__device__ __forceinline__ float bf_hi(unsigned w) { return __builtin_bit_cast(float, w & 0xffff0000u); }
__device__ __forceinline__ float bf2f(bf16 h) { return __builtin_bit_cast(float, (unsigned)h << 16); }
__device__ __forceinline__ float wave_sum(float v) {
#pragma unroll
    for (int o = 1; o < 64; o <<= 1) v += __shfl_xor(v, o);
    return v;
}
__device__ __forceinline__ float fexp2(float x) { return __builtin_amdgcn_exp2f(x); }
__device__ __forceinline__ float frcp(float x) { return __builtin_amdgcn_rcpf(x); }
__device__ const unsigned char kBucketLut[128] = {0, 1, 2, 3, 4, 5, 6, 7, 8, 9, 10, 11, 12, 13, 14, 15, 16, 16, 16, 17, 17, 18, 18, 18, 19, 19, 19, 20, 20, 20, 20, 21, 21, 21, 21, 22, 22, 22, 22, 22,
    23, 23, 23, 23, 23, 23, 24, 24, 24, 24, 24, 24, 25, 25, 25, 25, 25, 25, 25, 26, 26, 26, 26, 26, 26, 26, 26, 27, 27, 27, 27, 27, 27, 27, 27, 27, 27, 28, 28, 28, 28, 28, 28, 28, 28, 28, 28,
    29, 29, 29, 29, 29, 29, 29, 29, 29, 29, 29, 29, 30, 30, 30, 30, 30, 30, 30, 30, 30, 30, 30, 30, 30, 30, 31, 31, 31, 31, 31, 31, 31, 31, 31, 31, 31, 31, 31, 31, 31};

#define XB_TMO      128
#define XB_XCNT(j)  (256  + 64 * (j))
#define XB_XSUB(j)  (1280 + 64 * (j))
#define XB_XGEN(j)  (2304 + 64 * (j))
#define XB_TOP      3328
#define XB_TOPGEN   3392
#define XCD_BAR_WORDS 3456
#define XB_SPIN_CAP (1u << 18)

__device__ __forceinline__ unsigned xb_ld(unsigned* p)              { return __hip_atomic_load((GAS unsigned*)p, __ATOMIC_RELAXED, __HIP_MEMORY_SCOPE_AGENT); }
__device__ __forceinline__ unsigned xb_add(unsigned* p, unsigned v) { return __hip_atomic_fetch_add((GAS unsigned*)p, v, __ATOMIC_RELAXED, __HIP_MEMORY_SCOPE_AGENT); }
__device__ __forceinline__ unsigned xb_xcc_id() { return (unsigned)__builtin_amdgcn_s_getreg((3 << 11) | 20) & 0xFu; }
#define XB_SPIN(cond, bar) do { unsigned _sp = 0; while (cond) { __builtin_amdgcn_s_sleep(1); \
    if ((++_sp & 255u) == 0u) { if (xb_ld(&(bar)[XB_TMO])) break; if (_sp > XB_SPIN_CAP) { xb_add(&(bar)[XB_TMO], 1u); break; } } } } while (0)

struct XcdBarrier {
    unsigned* bar; unsigned x;
    volatile LAS unsigned* st;
};

__device__ __forceinline__ XcdBarrier xcd_barrier_post(unsigned* bar, volatile LAS unsigned* st) {
    XcdBarrier b; b.bar = bar; b.x = xb_xcc_id(); b.st = st;
    if (threadIdx.x == 0) (void)xb_add(&bar[XB_XCNT(b.x)], 1u);
    return b;
}
__device__ __forceinline__ void xcd_barrier_complete(unsigned* bar, unsigned x, unsigned& nloc, unsigned& nx) {
    const unsigned G = gridDim.x * gridDim.y * gridDim.z;
    unsigned sum, cnt, mine, sp = 0u;
    for (;;) {
        sum = 0u; cnt = 0u; mine = 0u;
#pragma unroll
        for (unsigned j = 0; j < 16; ++j) { const unsigned c = xb_ld(&bar[XB_XCNT(j)]); sum += c; cnt += (c > 0u) ? 1u : 0u; mine = (j == x) ? c : mine; }
        if (sum == G) break;
        __builtin_amdgcn_s_sleep(1);
        if ((++sp & 255u) == 0u) { if (xb_ld(&bar[XB_TMO])) break; if (sp > XB_SPIN_CAP) { xb_add(&bar[XB_TMO], 1u); break; } }
    }
    nloc = mine > 0u ? mine : 1u; nx = cnt > 0u ? cnt : 1u;
}

__device__ __forceinline__ void xcd_barrier(const XcdBarrier& b) {
    asm volatile("s_waitcnt vmcnt(0)" ::: "memory");
    __syncthreads();
    if (threadIdx.x == 0) {
        unsigned* bar = b.bar; asm volatile("" : "+s"(bar));
        __builtin_amdgcn_s_waitcnt(0);
        unsigned nloc = b.st[0], nx = b.st[1];
        if (nloc == 0u) { xcd_barrier_complete(bar, b.x, nloc, nx); b.st[0] = nloc; b.st[1] = nx; }
        const unsigned old = xb_add(&bar[XB_XSUB(b.x)], 1u);
        const unsigned gen = old / nloc;
        if (old + 1u == (gen + 1u) * nloc) {
            __builtin_amdgcn_fence(__ATOMIC_RELEASE, "agent");
            asm volatile("s_waitcnt vmcnt(0)" ::: "memory");
            const unsigned og = xb_add(&bar[XB_TOP], 1u);
            const unsigned tg = og / nx;
            if (og + 1u == (tg + 1u) * nx) xb_add(&bar[XB_TOPGEN], 1u);
            else XB_SPIN(xb_ld(&bar[XB_TOPGEN]) == tg, bar);
            __builtin_amdgcn_fence(__ATOMIC_ACQUIRE, "agent");
            xb_add(&bar[XB_XGEN(b.x)], 1u);
            asm volatile("s_waitcnt vmcnt(0)" ::: "memory");
        } else {
            XB_SPIN(xb_ld(&bar[XB_XGEN(b.x)]) == gen, bar);
            __builtin_amdgcn_fence(__ATOMIC_ACQUIRE, "agent");
            asm volatile("s_waitcnt vmcnt(0)" ::: "memory");
        }
    }
    __syncthreads();
}

struct Frame {
    LAS unsigned char* lds;
    gu32* ctl;
    int tid, lane, wave, G, gw, NGW;
    const float *x, *c, *w_ada, *b_ada, *norm_g, *w_in, *qk_g, *forget_b, *sinks, *rel_table, *group_g, *w_out, *w_gate, *w_up, *w_down;
    float* out;
    float *MOD, *LF, *KB2; unsigned short* SC; int* IDX;
    bf16 *WGU, *WD, *WIN, *WOUT, *H, *P, *Y, *XB;
};

template <int MAP> __device__ __forceinline__ int w_rowmap(int n) {
    if (MAP == 1) return 256 * (n >> 7) + (n & 127);
    if (MAP == 2) return 256 * (n >> 7) + 128 + (n & 127);
    if (MAP == 3) { if (n < 1728) return n; if (n < 1744) return PA_IW + (n - 1728); if (n < 3920) return n - 16; if (n < 3928) return PC_F + (n - 3920); return n - 24; }
    return n;
}
template <int MAP> __device__ __forceinline__ void p0_transpose_item(const float* W, int K, int N, bf16* WT, LAS unsigned* T, int item, int lane) {
    const int nblk = (N + 63) / 64, kb = item / nblk, nb = item % nblk, k0 = 64 * kb, n0 = 64 * nb;
    const int r = lane >> 4, c = lane & 15;
    const bool nok = (n0 + 4 * c) < N;
    const float* src = W + (size_t)(k0 + 2 * r) * N + n0 + 4 * c;
    f32x4 a[8], b[8];
#pragma unroll
    for (int i = 0; i < 8; ++i) { a[i] = nok ? *(const GAS f32x4*)(src + (size_t)(8 * i) * N) : (f32x4){0.f, 0.f, 0.f, 0.f}; b[i] = nok ? *(const GAS f32x4*)(src + (size_t)(8 * i + 1) * N) : (f32x4){0.f, 0.f, 0.f, 0.f}; }
#pragma unroll
    for (int i = 0; i < 8; ++i)
#pragma unroll
        for (int e = 0; e < 4; ++e) T[(4 * c + e) * 36 + 4 * i + r] = pk2(a[i][e], b[i][e]);
    LDS_WAIT(); asm volatile("" ::: "memory");
    const int rr = lane >> 3, ch = lane & 7;
#pragma unroll
    for (int j = 0; j < 8; ++j) { const int n = 8 * j + rr; const v4u o = *(const LAS v4u*)(T + n * 36 + 4 * ch);
        if (n0 + n < N) *(GAS v4u*)(WT + (size_t)w_rowmap<MAP>(n0 + n) * K + k0 + 8 * ch) = o; }
    LDS_WAIT(); asm volatile("" ::: "memory");
}
constexpr float W8_SCALE = 64.0f; constexpr int W8_E8M0 = 127 - 6;
__device__ __forceinline__ unsigned pk_fp8x4(float a, float b, float c, float d) {
    a = fminf(fmaxf(a, -448.f), 448.f); b = fminf(fmaxf(b, -448.f), 448.f); c = fminf(fmaxf(c, -448.f), 448.f); d = fminf(fmaxf(d, -448.f), 448.f);
    int w = 0; w = __builtin_amdgcn_cvt_pk_fp8_f32(a, b, w, false); w = __builtin_amdgcn_cvt_pk_fp8_f32(c, d, w, true); return (unsigned)w; }
template <int MAP> __device__ __forceinline__ void p0_transpose8_item(const float* W, int K, int N, unsigned char* WT, int ldw, LAS unsigned* T, int item, int lane) {
    const int nblk = (N + 63) / 64, kb = item / nblk, nb = item % nblk, k0 = 64 * kb, n0 = 64 * nb;
    const int r = lane >> 4, c = lane & 15;
    const bool nok = (n0 + 4 * c) < N;
    const float* src = W + (size_t)(k0 + 4 * r) * N + n0 + 4 * c;
    f32x4 q[4][4];
#pragma unroll
    for (int i = 0; i < 4; ++i)
#pragma unroll
        for (int d = 0; d < 4; ++d) q[i][d] = nok ? *(const GAS f32x4*)(src + (size_t)(16 * i + d) * N) : (f32x4){0.f, 0.f, 0.f, 0.f};
#pragma unroll
    for (int i = 0; i < 4; ++i)
#pragma unroll
        for (int e = 0; e < 4; ++e) T[(4 * c + e) * 20 + 4 * i + r] = pk_fp8x4(q[i][0][e] * W8_SCALE, q[i][1][e] * W8_SCALE, q[i][2][e] * W8_SCALE, q[i][3][e] * W8_SCALE);
    LDS_WAIT(); asm volatile("" ::: "memory");
    const int rr = lane >> 2, ch = lane & 3;
#pragma unroll
    for (int j = 0; j < 4; ++j) { const int n = 16 * j + rr; const v4u o = *(const LAS v4u*)(T + n * 20 + 4 * ch);
        if (n0 + n < N) *(GAS v4u*)(WT + (size_t)w_rowmap<MAP>(n0 + n) * ldw + k0 + 16 * ch) = o; }
    LDS_WAIT(); asm volatile("" ::: "memory");
}
template <int MAP> __device__ __forceinline__ void p0_transpose8(const Frame& F, const float* W, int K, int N, unsigned char* WT, int ldw, LAS unsigned* scr) {
    const int nitems = (K / 64) * ((N + 63) / 64);
    for (int it = F.gw; it < nitems; it += F.NGW) p0_transpose8_item<MAP>(W, K, N, WT, ldw, scr, it, F.lane);
}
template <int MAP> __device__ __forceinline__ void p0_transpose(const Frame& F, const float* W, int K, int N, bf16* WT, LAS unsigned* scr) {
    const int nitems = (K / 64) * ((N + 63) / 64);
    for (int it = F.gw; it < nitems; it += F.NGW) p0_transpose_item<MAP>(W, K, N, WT, scr, it, F.lane);
}
__device__ __forceinline__ void p0_prologue(const Frame& F) {
    LAS unsigned* scr = (LAS unsigned*)(F.lds + RING_OFF + F.wave * 16384);
    LAS float* cond = (LAS float*)(F.lds + AUX_OFF);
    LAS float* red = (LAS float*)(F.lds + RING_OFF);
    for (int i = F.tid; i < BATCH * DM; i += NTHREADS) { const float v = F.c[i]; cond[i] = v / (1.0f + __expf(-v)); }
    __syncthreads();
    for (int it = blockIdx.x; it < DEPTH * (NMOD / 64); it += F.G) {
        const int l = it / (NMOD / 64), n = (it % (NMOD / 64)) * 64 + F.lane;
        const float* w = F.w_ada + (size_t)l * DM * NMOD + (size_t)(256 * F.wave) * NMOD + n;
        const LAS float* c0 = cond + 256 * F.wave; const LAS float* c1 = cond + DM + 256 * F.wave;
        float a0 = 0.f, a1 = 0.f;
#pragma unroll 32
        for (int k = 0; k < 256; ++k) { const float wv = w[(size_t)k * NMOD]; a0 += c0[k] * wv; a1 += c1[k] * wv; }
        red[F.wave * 128 + F.lane] = a0; red[F.wave * 128 + 64 + F.lane] = a1;
        __syncthreads();
        if (F.tid < 128) { float sacc = 0.f;
#pragma unroll
            for (int wv = 0; wv < 8; ++wv) sacc += red[wv * 128 + F.tid];
            const int bsel = F.tid >> 6, nn = (it % (NMOD / 64)) * 64 + (F.tid & 63);
            F.MOD[((size_t)l * BATCH + bsel) * NMOD + nn] = sacc + F.b_ada[(size_t)l * NMOD + nn]; }
        __syncthreads();
    }
    for (int lf = 0; lf < DEPTH * 2; ++lf) {
        if (FFN_FP8) {
            p0_transpose8<1>(F, F.w_gate + (size_t)lf * DM * DFF, DM, DFF, (unsigned char*)F.WGU + (size_t)lf * NGU * DM, DM, scr);
            p0_transpose8<2>(F, F.w_up + (size_t)lf * DM * DFF, DM, DFF, (unsigned char*)F.WGU + (size_t)lf * NGU * DM, DM, scr);
            p0_transpose8<0>(F, F.w_down + (size_t)lf * DFF * DM, DFF, DM, (unsigned char*)F.WD + (size_t)lf * DM * DFFP, DFFP, scr);
        } else {
            p0_transpose<1>(F, F.w_gate + (size_t)lf * DM * DFF, DM, DFF, F.WGU + (size_t)lf * NGU * DM, scr);
            p0_transpose<2>(F, F.w_up + (size_t)lf * DM * DFF, DM, DFF, F.WGU + (size_t)lf * NGU * DM, scr);
            p0_transpose<0>(F, F.w_down + (size_t)lf * DFF * DM, DFF, DM, F.WD + (size_t)lf * DM * DFF, scr);
        }
    }
    for (int l = 0; l < DEPTH; ++l) {
        p0_transpose<3>(F, F.w_in + (size_t)l * DM * INC, DM, INC, F.WIN + (size_t)l * NIN * DM, scr);
        p0_transpose<0>(F, F.w_out + (size_t)l * DM * DM, DM, DM, F.WOUT + (size_t)l * DM * DM, scr);
        GAS v4u* z = (GAS v4u*)(F.WIN + (size_t)l * NIN * DM + (size_t)INC * DM);
        for (int i = F.gw * 64 + F.lane; i < (NIN - INC) * DM / 8; i += F.NGW * 64) z[i] = (v4u){0u, 0u, 0u, 0u};
    }
}

template <bool OUT8, bool IN16> __device__ __forceinline__ void ph_modulate(const Frame& F, const void* xin, const float* g, const float* shift, const float* scale) {
    if constexpr (IN16) {
        f32x4 av[4][2], hv[4][2]; int cb = -1;
        int m = F.gw;
        v4u wc[4];
        if (m < M) { const GAS v4u* xr = (const GAS v4u*)((const bf16*)xin + (size_t)m * DM) + F.lane;
#pragma unroll
            for (int j = 0; j < 4; ++j) wc[j] = xr[64 * j]; }
        while (m < M) {
            const int mn = m + F.NGW; const int b = m / SEQ;
            v4u wn[4];
            if (mn < M) { const GAS v4u* xr = (const GAS v4u*)((const bf16*)xin + (size_t)mn * DM) + F.lane;
#pragma unroll
                for (int j = 0; j < 4; ++j) wn[j] = xr[64 * j]; }
            else {
#pragma unroll
                for (int j = 0; j < 4; ++j) wn[j] = (v4u){0u, 0u, 0u, 0u}; }
            if (b != cb) { cb = b;
                const GAS f32x4* gp = (const GAS f32x4*)g + 2 * F.lane; const GAS f32x4* sh = (const GAS f32x4*)(shift + (size_t)b * NMOD) + 2 * F.lane; const GAS f32x4* sc = (const GAS f32x4*)(scale + (size_t)b * NMOD) + 2 * F.lane;
#pragma unroll
                for (int j = 0; j < 4; ++j)
#pragma unroll
                    for (int h = 0; h < 2; ++h) { const f32x4 gg = gp[128 * j + h], ss = sc[128 * j + h]; hv[j][h] = sh[128 * j + h]; av[j][h] = gg * (ss + 1.0f); } }
            float x[4][8]; float s = 0.f;
#pragma unroll
            for (int j = 0; j < 4; ++j) { x[j][0] = bf_lo(wc[j].x); x[j][1] = bf_hi(wc[j].x); x[j][2] = bf_lo(wc[j].y); x[j][3] = bf_hi(wc[j].y); x[j][4] = bf_lo(wc[j].z); x[j][5] = bf_hi(wc[j].z); x[j][6] = bf_lo(wc[j].w); x[j][7] = bf_hi(wc[j].w); }
#pragma unroll
            for (int j = 0; j < 4; ++j) s += ((x[j][0] * x[j][0] + x[j][1] * x[j][1]) + (x[j][2] * x[j][2] + x[j][3] * x[j][3])) + ((x[j][4] * x[j][4] + x[j][5] * x[j][5]) + (x[j][6] * x[j][6] + x[j][7] * x[j][7]));
            const float rstd = 1.0f / sqrtf(wave_sum(s) * (1.f / DM) + RMS_EPS);
            GAS v4u* o16 = (GAS v4u*)(F.H + (size_t)m * DM) + F.lane;
            GAS v2u* o8 = (GAS v2u*)((unsigned char*)F.H + (size_t)m * DM) + F.lane;
#pragma unroll
            for (int j = 0; j < 4; ++j) { float y[8];
#pragma unroll
                for (int h = 0; h < 2; ++h) { const f32x4 aa = av[j][h], hh = hv[j][h];
                    y[4 * h + 0] = x[j][4 * h + 0] * rstd * aa.x + hh.x; y[4 * h + 1] = x[j][4 * h + 1] * rstd * aa.y + hh.y;
                    y[4 * h + 2] = x[j][4 * h + 2] * rstd * aa.z + hh.z; y[4 * h + 3] = x[j][4 * h + 3] * rstd * aa.w + hh.w; }
                if (OUT8) { v2u w; w.x = pk_fp8x4(y[0], y[1], y[2], y[3]); w.y = pk_fp8x4(y[4], y[5], y[6], y[7]); o8[64 * j] = w; }
                else { v4u w; w.x = pk2(y[0], y[1]); w.y = pk2(y[2], y[3]); w.z = pk2(y[4], y[5]); w.w = pk2(y[6], y[7]); o16[64 * j] = w; } }
#pragma unroll
            for (int j = 0; j < 4; ++j) wc[j] = wn[j];
            m = mn;
        }
        return;
    }
    for (int m = F.gw; m < M; m += F.NGW) {
        const int b = m / SEQ;
        float x[4][8]; float s = 0.f;
        if constexpr (IN16) {
            const GAS v4u* xr = (const GAS v4u*)((const bf16*)xin + (size_t)m * DM) + F.lane;
            v4u w[4];
#pragma unroll
            for (int j = 0; j < 4; ++j) w[j] = xr[64 * j];
#pragma unroll
            for (int j = 0; j < 4; ++j) { x[j][0] = bf_lo(w[j].x); x[j][1] = bf_hi(w[j].x); x[j][2] = bf_lo(w[j].y); x[j][3] = bf_hi(w[j].y); x[j][4] = bf_lo(w[j].z); x[j][5] = bf_hi(w[j].z); x[j][6] = bf_lo(w[j].w); x[j][7] = bf_hi(w[j].w); }
        } else {
            const GAS f32x4* xr = (const GAS f32x4*)((const float*)xin + (size_t)m * DM) + 2 * F.lane;
            f32x4 a[4][2];
#pragma unroll
            for (int j = 0; j < 4; ++j) { a[j][0] = xr[128 * j]; a[j][1] = xr[128 * j + 1]; }
            GAS v4u* xo = (GAS v4u*)(F.XB + (size_t)m * DM) + F.lane;
#pragma unroll
            for (int j = 0; j < 4; ++j) { x[j][0] = a[j][0].x; x[j][1] = a[j][0].y; x[j][2] = a[j][0].z; x[j][3] = a[j][0].w; x[j][4] = a[j][1].x; x[j][5] = a[j][1].y; x[j][6] = a[j][1].z; x[j][7] = a[j][1].w;
                v4u w; w.x = pk2(x[j][0], x[j][1]); w.y = pk2(x[j][2], x[j][3]); w.z = pk2(x[j][4], x[j][5]); w.w = pk2(x[j][6], x[j][7]); xo[64 * j] = w; }
        }
#pragma unroll
        for (int j = 0; j < 4; ++j) s += ((x[j][0] * x[j][0] + x[j][1] * x[j][1]) + (x[j][2] * x[j][2] + x[j][3] * x[j][3])) + ((x[j][4] * x[j][4] + x[j][5] * x[j][5]) + (x[j][6] * x[j][6] + x[j][7] * x[j][7]));
        const float rstd = 1.0f / sqrtf(wave_sum(s) * (1.f / DM) + RMS_EPS);
        const GAS f32x4* gp = (const GAS f32x4*)g + 2 * F.lane; const GAS f32x4* sh = (const GAS f32x4*)(shift + (size_t)b * NMOD) + 2 * F.lane; const GAS f32x4* sc = (const GAS f32x4*)(scale + (size_t)b * NMOD) + 2 * F.lane;
        GAS v4u* o16 = (GAS v4u*)(F.H + (size_t)m * DM) + F.lane;
        GAS v2u* o8 = (GAS v2u*)((unsigned char*)F.H + (size_t)m * DM) + F.lane;
#pragma unroll
        for (int j = 0; j < 4; ++j) { float y[8];
#pragma unroll
            for (int h = 0; h < 2; ++h) { const f32x4 gg = gp[128 * j + h], ss = sc[128 * j + h], hh = sh[128 * j + h];
                y[4 * h + 0] = x[j][4 * h + 0] * rstd * gg.x * (ss.x + 1.0f) + hh.x; y[4 * h + 1] = x[j][4 * h + 1] * rstd * gg.y * (ss.y + 1.0f) + hh.y;
                y[4 * h + 2] = x[j][4 * h + 2] * rstd * gg.z * (ss.z + 1.0f) + hh.z; y[4 * h + 3] = x[j][4 * h + 3] * rstd * gg.w * (ss.w + 1.0f) + hh.w; }
            if (OUT8) { v2u w; w.x = pk_fp8x4(y[0], y[1], y[2], y[3]); w.y = pk_fp8x4(y[4], y[5], y[6], y[7]); o8[64 * j] = w; }
            else { v4u w; w.x = pk2(y[0], y[1]); w.y = pk2(y[2], y[3]); w.z = pk2(y[4], y[5]); w.w = pk2(y[6], y[7]); o16[64 * j] = w; } }
    }
}
__device__ __forceinline__ v4u headnorm8(v4u w, const float* g, float mul, int lane, bool normalize) {
    float x[8] = {bf_lo(w.x), bf_hi(w.x), bf_lo(w.y), bf_hi(w.y), bf_lo(w.z), bf_hi(w.z), bf_lo(w.w), bf_hi(w.w)};
    float r = mul;
    if (normalize) {
        float s = 0.f;
#pragma unroll
        for (int i = 0; i < 8; ++i) s += x[i] * x[i];
        s += __shfl_xor(s, 1); s += __shfl_xor(s, 2); s += __shfl_xor(s, 4);
        r = mul / sqrtf(s * (1.f / 64.f) + RMS_EPS);
        const f32x4 g0 = *(const GAS f32x4*)(g + 8 * (lane & 7)), g1 = *(const GAS f32x4*)(g + 8 * (lane & 7) + 4);
        x[0] *= g0.x; x[1] *= g0.y; x[2] *= g0.z; x[3] *= g0.w; x[4] *= g1.x; x[5] *= g1.y; x[6] *= g1.z; x[7] *= g1.w;
    }
    w.x = pk2(x[0] * r, x[1] * r); w.y = pk2(x[2] * r, x[3] * r); w.z = pk2(x[4] * r, x[5] * r); w.w = pk2(x[6] * r, x[7] * r);
    return w;
}
__device__ __forceinline__ v4u headnorm8g(v4u w, f32x4 g0, f32x4 g1, float mul, bool normalize) {
    float x[8] = {bf_lo(w.x), bf_hi(w.x), bf_lo(w.y), bf_hi(w.y), bf_lo(w.z), bf_hi(w.z), bf_lo(w.w), bf_hi(w.w)};
    float r = mul;
    if (normalize) {
        float s = 0.f;
#pragma unroll
        for (int i = 0; i < 8; ++i) s += x[i] * x[i];
        s += __shfl_xor(s, 1); s += __shfl_xor(s, 2); s += __shfl_xor(s, 4);
        r = mul / sqrtf(s * (1.f / 64.f) + RMS_EPS);
        x[0] *= g0.x; x[1] *= g0.y; x[2] *= g0.z; x[3] *= g0.w; x[4] *= g1.x; x[5] *= g1.y; x[6] *= g1.z; x[7] *= g1.w;
    }
    w.x = pk2(x[0] * r, x[1] * r); w.y = pk2(x[2] * r, x[3] * r); w.z = pk2(x[4] * r, x[5] * r); w.w = pk2(x[6] * r, x[7] * r);
    return w;
}
__device__ __forceinline__ void ph_post(const Frame& F, int l) {
    const float* qg = F.qk_g + (size_t)l * 6 * HD; const int lane = F.lane;
    f32x4 gq[6][2];
    { const int gi[5] = {0, 2, 4, 5, (lane < 8 ? 1 : 3)};
#pragma unroll
      for (int i = 0; i < 5; ++i) { const float* gp = qg + gi[i] * HD + 8 * (lane & 7); gq[i][0] = *(const GAS f32x4*)gp; gq[i][1] = *(const GAS f32x4*)(gp + 4); } }
    const int koff = (lane < 8 ? PA_K : PB_K) + 8 * (lane & 7);
    int m = F.gw;
    v4u wc[6];
#define POST_LOAD(mm_, W) do { const bf16* row_ = F.P + (size_t)(mm_) * NIN; W[0] = *(const GAS v4u*)(row_ + PA_Q + 8 * lane); W[1] = *(const GAS v4u*)(row_ + PB_Q + 8 * lane); W[2] = *(const GAS v4u*)(row_ + PC_Q + 8 * lane); \
        W[3] = *(const GAS v4u*)(row_ + PC_K + 8 * lane); W[4] = *(const GAS v4u*)(row_ + PD_Q + 8 * lane); W[5] = (v4u){0u, 0u, 0u, 0u}; if (lane < 16) W[5] = *(const GAS v4u*)(row_ + koff); } while (0)
    if (m < M) POST_LOAD(m, wc);
    while (m < M) {
        const int mn = m + F.NGW;
        v4u wn[6];
        if (mn < M) POST_LOAD(mn, wn);
        else {
#pragma unroll
            for (int i = 0; i < 6; ++i) wn[i] = (v4u){0u, 0u, 0u, 0u}; }
        bf16* row = F.P + (size_t)m * NIN;
        *(GAS v4u*)(row + PA_Q + 8 * lane) = headnorm8g(wc[0], gq[0][0], gq[0][1], QSCALE, true);
        *(GAS v4u*)(row + PB_Q + 8 * lane) = headnorm8g(wc[1], gq[1][0], gq[1][1], QSCALE, true);
        *(GAS v4u*)(row + PC_Q + 8 * lane) = headnorm8g(wc[2], gq[2][0], gq[2][1], QSCALE, true);
        *(GAS v4u*)(row + PC_K + 8 * lane) = headnorm8g(wc[3], gq[3][0], gq[3][1], 1.0f, true);
        *(GAS v4u*)(row + PD_Q + 8 * lane) = headnorm8g(wc[4], gq[0][0], gq[0][1], QSCALE, false);
        if (lane < 16) *(GAS v4u*)(row + koff) = headnorm8g(wc[5], gq[4][0], gq[4][1], 1.0f, true);
#pragma unroll
        for (int i = 0; i < 6; ++i) wc[i] = wn[i];
        m = mn;
    }
#undef POST_LOAD
}
__device__ __forceinline__ void ph_scan(const Frame& F, int l) {
    LAS float* wtot = (LAS float*)(F.lds + RING_OFF);
    for (int sq = blockIdx.x; sq < BATCH * NH; sq += F.G) {
        const int b = sq / NH, h = sq % NH; const float fb = F.forget_b[(size_t)l * NH + h];
        const GAS unsigned short* src = (const GAS unsigned short*)(F.P + ((size_t)b * SEQ + 16 * F.tid) * NIN + PC_F + h); float* dst = F.KB2 + (size_t)sq * SEQ + 16 * F.tid;
        float v[16]; unsigned short raw[16];
#pragma unroll
        for (int i = 0; i < 16; ++i) raw[i] = src[(size_t)i * NIN];
#pragma unroll
        for (int i = 0; i < 16; ++i) { const float y = __builtin_bit_cast(float, (unsigned)raw[i] << 16) + fb; v[i] = (y >= 0.f) ? -log1pf(__expf(-y)) : (y - log1pf(__expf(y))); }
#pragma unroll
        for (int i = 1; i < 16; ++i) v[i] += v[i - 1];
        float incl = v[15];
#pragma unroll
        for (int o = 1; o < 64; o <<= 1) { const float t = __shfl_up(incl, o); if (F.lane >= o) incl += t; }
        if (F.lane == 63) wtot[F.wave] = incl;
        __syncthreads();
        float base = incl - v[15];
        for (int w = 0; w < F.wave; ++w) base += wtot[w];
#pragma unroll
        for (int i = 0; i < 4; ++i) *(GAS f32x4*)(dst + 4 * i) = (f32x4){-(v[4 * i] + base) * LOG2E, -(v[4 * i + 1] + base) * LOG2E, -(v[4 * i + 2] + base) * LOG2E, -(v[4 * i + 3] + base) * LOG2E};
        __syncthreads();
    }
}
__device__ __forceinline__ void ph_gnorm(const Frame& F, int l) {
    const float* gg = F.group_g + (size_t)l * DM;
    f32x4 gv[4][2];
#pragma unroll
    for (int g = 0; g < 4; ++g) { gv[g][0] = *(const GAS f32x4*)(gg + g * GWID + 8 * F.lane); gv[g][1] = *(const GAS f32x4*)(gg + g * GWID + 8 * F.lane + 4); }
    int m = F.gw;
    v4u wc[4];
    if (m < M) {
#pragma unroll
        for (int g = 0; g < 4; ++g) wc[g] = *(GAS v4u*)(F.Y + (size_t)m * DM + g * GWID + 8 * F.lane); }
    while (m < M) {
        const int mn = m + F.NGW;
        v4u wn[4];
        if (mn < M) {
#pragma unroll
            for (int g = 0; g < 4; ++g) wn[g] = *(GAS v4u*)(F.Y + (size_t)mn * DM + g * GWID + 8 * F.lane); }
        else {
#pragma unroll
            for (int g = 0; g < 4; ++g) wn[g] = (v4u){0u, 0u, 0u, 0u}; }
#pragma unroll
        for (int g = 0; g < 4; ++g) {
            bf16* p = F.Y + (size_t)m * DM + g * GWID + 8 * F.lane;
            float x[8] = {bf_lo(wc[g].x), bf_hi(wc[g].x), bf_lo(wc[g].y), bf_hi(wc[g].y), bf_lo(wc[g].z), bf_hi(wc[g].z), bf_lo(wc[g].w), bf_hi(wc[g].w)};
            float s = 0.f;
#pragma unroll
            for (int i = 0; i < 8; ++i) s += x[i] * x[i];
            const float r = 1.0f / sqrtf(wave_sum(s) * (1.f / GWID) + RMS_EPS);
            const f32x4 g0 = gv[g][0], g1 = gv[g][1];
            v4u o; o.x = pk2(x[0] * r * g0.x, x[1] * r * g0.y); o.y = pk2(x[2] * r * g0.z, x[3] * r * g0.w); o.z = pk2(x[4] * r * g1.x, x[5] * r * g1.y); o.w = pk2(x[6] * r * g1.z, x[7] * r * g1.w);
            *(GAS v4u*)p = o;
        }
#pragma unroll
        for (int g = 0; g < 4; ++g) wc[g] = wn[g];
        m = mn;
    }
}


__device__ __forceinline__ unsigned short score_key(float sc) {
    const _Float16 hf = (_Float16)fminf(fmaxf(sc, -60000.f), 60000.f);
    const unsigned h = (unsigned)__builtin_bit_cast(unsigned short, hf);
    return (unsigned short)((h & 0x8000u) ? (~h & 0xffffu) : (h | 0x8000u));
}
__device__ __forceinline__ void glds16x(const void* gsrc, unsigned lds_dst) { unsigned keep;
    asm volatile("s_mov_b32 %0, m0\n\ts_mov_b32 m0, %2\n\ts_nop 0\n\tglobal_load_lds_dwordx4 %1, off\n\ts_mov_b32 m0, %0" : "=&s"(keep) : "v"(gsrc), "s"(lds_dst) : "memory"); }
__device__ __forceinline__ void ph_idx_scores(const Frame& F) {
    constexpr int UPB = 8 * (16 * 17 / 2), NU = BATCH * UPB;
    const int lane = F.lane, r32 = lane & 31, hi = lane >> 5;
    const int u_lo = (int)(((long)blockIdx.x * NU) / F.G), u_hi = (int)(((long)(blockIdx.x + 1) * NU) / F.G);
    if (u_lo >= u_hi) return;
    int b = u_lo / UPB, qb = 127, kc = 0; { int r = u_lo % UPB; for (;;) { const int n = (qb >> 3) + 1; if (r < n) { kc = r; break; } r -= n; --qb; } }
    LAS unsigned char* KL = F.lds + RING_OFF;
    const unsigned kl_lds = (unsigned)(size_t)KL;
#define X1_STAGE(bb, kk, buf) do { const bf16* ksrc_ = F.P + ((size_t)(bb) * SEQ + 512 * (kk) + 64 * F.wave + lane) * NIN + PA_IK; \
        _Pragma("unroll") for (int c_ = 0; c_ < 8; ++c_) glds16x(ksrc_ + 8 * c_, (unsigned)__builtin_amdgcn_readfirstlane(kl_lds + (buf) * 65536 + c_ * 8192 + F.wave * 1024)); } while (0)
    X1_STAGE(b, kc, 0);
    asm volatile("s_waitcnt vmcnt(0)" ::: "memory"); __syncthreads();
    bf16x8 af[4][4]; float wq[4][16]; int cb = -1, cqb = -1;
    for (int u = u_lo; u < u_hi; ++u) {
        const int cur = (u - u_lo) & 1;
        int nb = b, nqb = qb, nkc = kc + 1; if (nkc > (qb >> 3)) { nkc = 0; --nqb; if (nqb < 0) { nqb = 127; ++nb; } }
        if (u + 1 < u_hi) X1_STAGE(nb, nkc, cur ^ 1);
        const size_t rowb = (size_t)b * SEQ; const int t0 = 64 * qb + 8 * F.wave;
        if (b != cb || qb != cqb) { cb = b; cqb = qb;
#pragma unroll
            for (int pr = 0; pr < 4; ++pr) {
                const bf16* qrow = F.P + (rowb + t0 + 2 * pr + ((r32 >> 2) & 1)) * NIN + PA_IQ + ((r32 & 3) + 4 * (r32 >> 3)) * 64 + 8 * hi;
#pragma unroll
                for (int s = 0; s < 4; ++s) af[pr][s] = *(const GAS bf16x8*)(qrow + 16 * s);
                const bf16* wrow = F.P + (rowb + t0 + 2 * pr + hi) * NIN + PA_IW;
                const v4u w0 = *(const GAS v4u*)wrow, w1 = *(const GAS v4u*)(wrow + 8);
                const unsigned ww[8] = {w0.x, w0.y, w0.z, w0.w, w1.x, w1.y, w1.z, w1.w};
#pragma unroll
                for (int i = 0; i < 8; ++i) { wq[pr][2 * i] = bf_lo(ww[i]) * 0.015625f; wq[pr][2 * i + 1] = bf_hi(ww[i]) * 0.015625f; }
            }
        }
        const int kend = 64 * (qb + 1) - 512 * kc;
        const int nkt = kend >= 512 ? 16 : (kend + 31) / 32;
        const LAS unsigned char* kl = KL + cur * 65536 + hi * 8192 + r32 * 16;
        for (int kt = 0; kt < nkt; ++kt) {
            bf16x8 bfr[4];
#pragma unroll
            for (int s = 0; s < 4; ++s) bfr[s] = *(const LAS bf16x8*)(kl + s * 16384 + kt * 512);
            const int s0 = 512 * kc + 32 * kt;
#pragma unroll
            for (int pr = 0; pr < 4; ++pr) {
                f32x16 acc = {};
#pragma unroll
                for (int s = 0; s < 4; ++s) acc = __builtin_amdgcn_mfma_f32_32x32x16_bf16(af[pr][s], bfr[s], acc, 0, 0, 0);
                float sc0 = 0.f, sc1 = 0.f;
#pragma unroll
                for (int r = 0; r < 16; ++r) { sc0 = __builtin_fmaf(wq[pr][r], acc[r], sc0); sc1 = __builtin_fmaf(wq[pr][r], __builtin_fabsf(acc[r]), sc1); if ((r & 3) == 3) asm("" : "+v"(sc1)); }
                ((GAS unsigned short*)F.SC)[(rowb + t0 + 2 * pr + hi) * SEQ + s0 + r32] = score_key(sc0 + sc1);
                __builtin_amdgcn_sched_barrier(0);
            }
        }
        asm volatile("s_waitcnt vmcnt(0)" ::: "memory");
        __syncthreads();
        b = nb; qb = nqb; kc = nkc;
    }
#undef X1_STAGE
}

__device__ __forceinline__ unsigned mbcnt64(unsigned long long m) { return __builtin_amdgcn_mbcnt_hi((unsigned)(m >> 32), __builtin_amdgcn_mbcnt_lo((unsigned)m, 0u)); }
template <int SH, int PSH> __device__ __forceinline__ void sel_level(const unsigned (&v)[64], int nreg, unsigned pval, unsigned need, LAS unsigned* hist, int lane, unsigned& bin_out, unsigned& above_out) {
#pragma unroll
    for (int i = 0; i < 8; ++i) ((LAS v4u*)hist)[lane + 64 * i] = (v4u){0u, 0u, 0u, 0u};
    LDS_WAIT(); __builtin_amdgcn_wave_barrier();
    const unsigned hb = (unsigned)(size_t)hist, sink = hb + 9216u + 4u * (unsigned)lane;
#pragma unroll
    for (int g = 0; g < 8; ++g) if (8 * g < nreg) {
#pragma unroll
        for (int jj = 0; jj < 8; ++jj) { const int j = 8 * g + jj;
#pragma unroll
            for (int e = 0; e < 2; ++e) { const unsigned k = e ? (v[j] >> 16) : (v[j] & 0xffffu);
                const bool pred = (k != 0u) && (PSH >= 16 || (k >> (PSH & 15)) == pval);
                const unsigned tgt = pred ? hb + (((k >> SH) & 2047u) << 2) : sink;
                __hip_atomic_fetch_add((LAS unsigned*)tgt, 1u, __ATOMIC_RELAXED, __HIP_MEMORY_SCOPE_WAVEFRONT); }
            if ((jj & 1) == 1) __builtin_amdgcn_sched_barrier(0); }
    }
    LDS_WAIT(); __builtin_amdgcn_wave_barrier();
    unsigned S = 0u;
#pragma unroll
    for (int i = 0; i < 8; ++i) { const v4u q = ((LAS v4u*)hist)[lane * 8 + i]; S += (q.x + q.y) + (q.z + q.w); }
    unsigned T = S;
#pragma unroll
    for (int o = 1; o < 64; o <<= 1) { const unsigned t = __shfl_down(T, o); if (lane + o < 64) T += t; }
    const unsigned above_lane = T - S;
    const bool cross = (T >= need) && (above_lane < need);
    unsigned run = above_lane, bin = 0u, ab = 0u; bool found = false;
#pragma unroll
    for (int i = 7; i >= 0; --i) { const v4u q = ((LAS v4u*)hist)[lane * 8 + i]; const unsigned c4[4] = {q.x, q.y, q.z, q.w};
#pragma unroll
        for (int e = 3; e >= 0; --e) { const bool hit = !found && (run + c4[e] >= need); if (hit) { bin = 32u * lane + 4 * i + e; ab = run; found = true; } run += c4[e]; } }
    const unsigned long long cm = __ballot(cross);
    const int src = cm ? (int)__builtin_ctzll(cm) : 0;
    bin_out = __builtin_amdgcn_readlane(bin, src); above_out = __builtin_amdgcn_readlane(ab, src);
    LDS_WAIT(); __builtin_amdgcn_wave_barrier();
}
__device__ __forceinline__ void select_row(const Frame& F, int m, LAS unsigned* hist, LAS int* out) {
    int lane = F.lane; asm volatile("" : "+v"(lane));
    const int t = m % SEQ, n = t + 1;
    if (n <= TOPK) { for (int j = lane; j < TOPK; j += 64) out[j] = (j < n) ? j : 0; return; }
    const int nreg = (n + 127) >> 7;
    unsigned v[64];
    const GAS unsigned* pr = (const GAS unsigned*)(F.SC + (size_t)m * SEQ) + lane;
#pragma unroll
    for (int g = 0; g < 8; ++g) {
        if (8 * g < nreg) {
#pragma unroll
            for (int jj = 0; jj < 8; ++jj) v[8 * g + jj] = pr[jj * 64];
        } else {
#pragma unroll
            for (int jj = 0; jj < 8; ++jj) v[8 * g + jj] = 0u;
        }
        pr += 512; asm volatile("" : "+v"(pr));
    }
    const int nfull = n >> 7;
#pragma unroll
    for (int g = 0; g < 8; ++g) if (8 * g < nreg && 8 * g + 8 > nfull) {
#pragma unroll
        for (int jj = 0; jj < 8; ++jj) { const int j = 8 * g + jj; const int e0 = 128 * j + 2 * lane; const unsigned w = v[j];
            v[j] = ((e0 < n) ? (w & 0xffffu) : 0u) | ((e0 + 1 < n) ? (w & 0xffff0000u) : 0u); asm volatile("" : "+v"(v[j])); }
    }
    unsigned b1, a1, b2, a2;
    sel_level<5, 16>(v, nreg, 0u, (unsigned)TOPK, hist, lane, b1, a1);
    sel_level<0, 5>(v, nreg, b1, (unsigned)TOPK - a1, hist, lane, b2, a2);
    const unsigned tau = (b1 << 5) | (b2 & 31u);
    const unsigned quota = (unsigned)TOPK - a1 - a2;
    unsigned mg[4] = {0u, 0u, 0u, 0u}, me[4] = {0u, 0u, 0u, 0u};
#pragma unroll
    for (int g = 0; g < 8; ++g) {
        if (8 * g < nreg) {
#pragma unroll
            for (int jj = 0; jj < 8; ++jj) { const int j = 8 * g + jj;
#pragma unroll
                for (int e = 0; e < 2; ++e) { const unsigned k = e ? (v[j] >> 16) : (v[j] & 0xffffu);
                    mg[g >> 1] = mg[g >> 1] + mg[g >> 1] + ((k > tau) ? 1u : 0u); me[g >> 1] = me[g >> 1] + me[g >> 1] + ((k == tau) ? 1u : 0u); }
                if ((jj & 3) == 3) __builtin_amdgcn_sched_barrier(0); }
        } else { mg[g >> 1] <<= 16; me[g >> 1] <<= 16; }
    }
    const unsigned cg = (unsigned)(__builtin_popcount(mg[0]) + __builtin_popcount(mg[1]) + __builtin_popcount(mg[2]) + __builtin_popcount(mg[3]));
    unsigned ce = (unsigned)(__builtin_popcount(me[0]) + __builtin_popcount(me[1]) + __builtin_popcount(me[2]) + __builtin_popcount(me[3]));
    unsigned incl = cg | (ce << 16);
#pragma unroll
    for (int o = 1; o < 64; o <<= 1) { const unsigned t = (unsigned)__shfl_up((int)incl, o); if (lane >= o) incl += t; }
    const unsigned excl = incl - (cg | (ce << 16));
    const unsigned pre_g = excl & 0xffffu, pre_e = excl >> 16;
    const unsigned keep = pre_e >= quota ? 0u : ((quota - pre_e) < ce ? (quota - pre_e) : ce);
#pragma unroll
    for (int q = 3; q >= 0; --q) { while (ce > keep && me[q] != 0u) { me[q] &= me[q] - 1u; --ce; } }
    unsigned pos = pre_g + (pre_e < quota ? pre_e : quota);
    const int ilane = 2 * lane;
#pragma unroll
    for (int q = 0; q < 4; ++q) { unsigned mm = mg[q] | me[q];
        while (mm != 0u) { const int bpos = 31 - (int)__builtin_clz(mm); const int sl = 31 - bpos; mm &= ~(1u << bpos);
            const int i = 128 * (16 * q + (sl >> 1)) + ilane + (sl & 1);
            if (pos < (unsigned)TOPK) out[pos] = i;
            ++pos; } }
}


constexpr int AT_K = 0, AT_V = 16384, AT_KB = 32768, AT_WSF = 33280, AT_BT = 35328, AT_DEAD = 35840, AT_SV = 36864;
typedef short v4i16_t __attribute__((ext_vector_type(4)));
__device__ __forceinline__ s16x4 vtr(const LAS unsigned char* p) { return __builtin_bit_cast(s16x4, __builtin_amdgcn_ds_read_tr16_b64_v4i16((LAS v4i16_t*)p)); }
typedef __bf16 bfpair_t __attribute__((ext_vector_type(2))); typedef float f32pair_t __attribute__((ext_vector_type(2)));
__device__ __forceinline__ unsigned cvtpk(float lo, float hi) { const f32pair_t v = {lo, hi}; return __builtin_bit_cast(unsigned, __builtin_convertvector(v, bfpair_t)); }
#define NEG_INF (-__builtin_inff())

template <int TYPE>
__device__ __forceinline__ void dense_attn_unit(const Frame& F, int l, int b, int h, int qb) {
    constexpr int QOFF = TYPE == 1 ? PB_Q : TYPE == 2 ? PC_Q : PD_Q, KOFF = TYPE == 1 ? PB_K : TYPE == 2 ? PC_K : PD_K, VOFF = TYPE == 1 ? PB_V : TYPE == 2 ? PC_V : PD_V;
    constexpr bool MQA = TYPE == 1; constexpr int YOFF = TYPE * GWID;
    const int tid = F.tid, lane = F.lane, wid = F.wave, r32 = lane & 31, hi = lane >> 5;
    LAS unsigned char* L = F.lds + RING_OFF;
    LAS float* wsf = (LAS float*)(L + AT_WSF + wid * 256);
    LAS float* BT = (LAS float*)(L + AT_BT);
    const int hq = (TYPE == 1) ? wid : h, qoff = (TYPE == 1) ? (qb & 7) * 32 : wid * 32, qb256 = (TYPE == 1) ? (qb >> 3) : qb;
    const size_t rowb = (size_t)b * SEQ; const int q0 = qb256 * 256;
    const bf16* Pk = F.P + rowb * NIN + KOFF + (MQA ? 0 : h * 64);
    const bf16* Pv = F.P + rowb * NIN + VOFF + (MQA ? 0 : h * 64);
    const bf16* Pq = F.P + (rowb + q0 + qoff + r32) * NIN + QOFF + hq * 64 + hi * 8;
    bf16x8 qr[4];
#pragma unroll
    for (int d0 = 0; d0 < 4; ++d0) qr[d0] = *(const GAS bf16x8*)(Pq + 16 * d0);
    const int jt_hi = (TYPE == 1) ? ((q0 + qoff + 31) >> 6) : 4 * qb256 + 3, jt_lo = (TYPE == 1) ? (((q0 + qoff - (WINDOW - 1)) > 0 ? (q0 + qoff - (WINDOW - 1)) : 0) >> 6) : 0, nt = jt_hi - jt_lo + 1;
    if (TYPE == 1) { LAS float* BTall = (LAS float*)(L + AT_SV);
        for (int i = tid; i < 8 * 128; i += NTHREADS) BTall[i] = F.rel_table[(int)kBucketLut[i & 127] * 16 + 8 + (i >> 7)] * LOG2E;
        BT = BTall + 128 * wid; }
    const bf16* kgp = Pk + (size_t)lane * NIN + wid * 8;
    const int vkey = tid >> 3, vch = tid & 7;
    const bf16* vgp = Pv + (size_t)vkey * NIN + vch * 8;
    const int kl = wid * 1024 + lane * 16;
    const int vl = (vch >> 2) * 4096 + (vkey >> 3) * 512 + (vkey & 7) * 64 + (vch & 3) * 16;
    const float* kb2 = F.KB2 + ((size_t)b * NH + h) * SEQ;
    v4u kreg = *(const GAS v4u*)(kgp + (size_t)jt_hi * 64 * NIN), vreg = *(const GAS v4u*)(vgp + (size_t)jt_hi * 64 * NIN);
    float kbreg = 0.f; if (TYPE == 2 && tid < 64) kbreg = kb2[jt_hi * 64 + tid];
    *(LAS v4u*)(L + AT_K + kl) = kreg; *(LAS v4u*)(L + AT_V + vl) = vreg; if (TYPE == 2 && tid < 64) ((LAS float*)(L + AT_KB))[tid] = kbreg;
    __syncthreads();
    f32x16 o[2]; o[0] = f32x16{}; o[1] = f32x16{};
    float mrun = NEG_INF, lsum = 0.f, carry = 1.f;
    float qbound = 0.f;
    if (TYPE == 2) {
        float ss = 0.f;
#pragma unroll
        for (int d0 = 0; d0 < 4; ++d0)
#pragma unroll
            for (int j = 0; j < 8; ++j) { const float x = bf2f((bf16)qr[d0][j]); ss += x * x; }
        ss += __shfl_xor(ss, 32);
        float gm = fabsf(F.qk_g[((size_t)l * 6 + 5) * HD + lane]);
#pragma unroll
        for (int o = 1; o < 64; o <<= 1) gm = fmaxf(gm, __shfl_xor(gm, o));
        qbound = sqrtf(ss) * 8.08f * gm;
    }
    const int qrel = qoff + r32;
    const int vb = ((lane >> 4) & 1) * 32 + (lane & 3) * 8 + (4 * hi + ((lane & 15) >> 2)) * 64;
    LAS unsigned* deadf = (LAS unsigned*)(L + AT_DEAD);
    for (int i = 0; i < nt; ++i) {
        const int jt = jt_hi - i, cur = i & 1, jb = jt - 4 * qb256; const bool more = (i + 1 < nt);
        float kbnext = 0.f;
        if (more) { kreg = *(const GAS v4u*)(kgp + (size_t)(jt - 1) * 64 * NIN); vreg = *(const GAS v4u*)(vgp + (size_t)(jt - 1) * 64 * NIN); if (TYPE == 2 && tid < 64) kbreg = kb2[(jt - 1) * 64 + tid]; if (TYPE == 2) kbnext = kb2[jt * 64 - 1]; }
        const bool active = (64 * jb <= qoff + 31) && (TYPE != 1 || (64 * jb + 63 >= qoff - (WINDOW - 1)));
        if (active) {
            const LAS unsigned char* Kb = L + AT_K + cur * 8192; const LAS unsigned char* Vb = L + AT_V + cur * 8192;
            f32x16 p0 = f32x16{}, p1 = f32x16{};
            bf16x8 ka[4], kc[4];
#pragma unroll
            for (int d0 = 0; d0 < 4; ++d0) { ka[d0] = *(const LAS bf16x8*)(Kb + (2 * d0 + hi) * 1024 + r32 * 16); kc[d0] = *(const LAS bf16x8*)(Kb + (2 * d0 + hi) * 1024 + 512 + r32 * 16); }
            __builtin_amdgcn_sched_barrier(0);
#pragma unroll
            for (int d0 = 0; d0 < 4; ++d0) { p0 = __builtin_amdgcn_mfma_f32_32x32x16_bf16(ka[d0], qr[d0], p0, 0, 0, 0); p1 = __builtin_amdgcn_mfma_f32_32x32x16_bf16(kc[d0], qr[d0], p1, 0, 0, 0); }
            bf16x8 vfr[2][4];
#pragma unroll
            for (int d0 = 0; d0 < 2; ++d0)
#pragma unroll
                for (int ks = 0; ks < 4; ++ks) { const s16x4 lo = vtr(Vb + vb + d0 * 4096 + ks * 1024), hh = vtr(Vb + vb + d0 * 4096 + ks * 1024 + 512);
                    vfr[d0][ks] = (bf16x8){lo[0], lo[1], lo[2], lo[3], hh[0], hh[1], hh[2], hh[3]}; }
            __builtin_amdgcn_sched_barrier(0);
            bool live = true;
            const int kv0 = 64 * jb + 4 * hi;
            if (TYPE == 3) {
                float b0[16], b1[16];
#pragma unroll
                for (int r = 0; r < 16; ++r) { const int kv = kv0 + (r & 3) + 8 * (r >> 2);
                    const float e0 = fexp2(fminf(p0[r], 80.f)), e1 = fexp2(fminf(p1[r], 80.f));
                    const float m0 = frcp(1.0f + e0), m1 = frcp(1.0f + e1);
                    const bool ok0 = kv < qrel, ok1 = (kv + 32) < qrel;
                    b0[r] = ok0 ? e0 * m0 : 0.f; b1[r] = ok1 ? e1 * m1 : 0.f; p0[r] = ok0 ? m0 : 1.0f; p1[r] = ok1 ? m1 : 1.0f; }
                float gp[8], go[8], pp[8];
#pragma unroll
                for (int g = 0; g < 4; ++g) { gp[g] = (p0[4 * g] * p0[4 * g + 1]) * (p0[4 * g + 2] * p0[4 * g + 3]); gp[4 + g] = (p1[4 * g] * p1[4 * g + 1]) * (p1[4 * g + 2] * p1[4 * g + 3]); }
#pragma unroll
                for (int g = 0; g < 8; ++g) { const float oth = __shfl_xor(gp[g], 32); pp[g] = gp[g] * oth; go[g] = hi ? 1.0f : oth; }
                float sp = 1.0f;
#pragma unroll
                for (int g = 7; g >= 0; --g) { const float sg = sp * go[g] * carry;
                    if (g < 4) { const float c3 = p0[4 * g + 3], c2 = p0[4 * g + 2], c1 = p0[4 * g + 1];
                        p0[4 * g + 3] = b0[4 * g + 3] * sg; const float s2 = sg * c3; p0[4 * g + 2] = b0[4 * g + 2] * s2; const float s1 = s2 * c2; p0[4 * g + 1] = b0[4 * g + 1] * s1; p0[4 * g] = b0[4 * g] * (s1 * c1); }
                    else { const int q = g - 4; const float c3 = p1[4 * q + 3], c2 = p1[4 * q + 2], c1 = p1[4 * q + 1];
                        p1[4 * q + 3] = b1[4 * q + 3] * sg; const float s2 = sg * c3; p1[4 * q + 2] = b1[4 * q + 2] * s2; const float s1 = s2 * c2; p1[4 * q + 1] = b1[4 * q + 1] * s1; p1[4 * q] = b1[4 * q] * (s1 * c1); }
                    sp *= pp[g]; }
                carry *= sp;
            } else {
                if (TYPE == 2) {
                    const LAS f32x4* kbp = (const LAS f32x4*)(L + AT_KB + cur * 256);
#pragma unroll
                    for (int g = 0; g < 4; ++g) { const f32x4 a = kbp[2 * g + hi], c = kbp[8 + 2 * g + hi];
#pragma unroll
                        for (int e = 0; e < 4; ++e) { p0[4 * g + e] += a[e]; p1[4 * g + e] += c[e]; } }
                    if (jb >= 0) {
#pragma unroll
                        for (int r = 0; r < 16; ++r) { const int kv = kv0 + (r & 3) + 8 * (r >> 2); if (kv > qrel) p0[r] = NEG_INF; if (kv + 32 > qrel) p1[r] = NEG_INF; }
                    }
                } else {
#pragma unroll
                    for (int r = 0; r < 16; ++r) { const int d0_ = qrel - (kv0 + (r & 3) + 8 * (r >> 2)), d1_ = d0_ - 32;
                        const bool ok0 = (d0_ >= 0) && (d0_ < WINDOW), ok1 = (d1_ >= 0) && (d1_ < WINDOW);
                        const float t0 = BT[ok0 ? d0_ : 0], t1 = BT[ok1 ? d1_ : 0];
                        p0[r] = ok0 ? p0[r] + t0 : NEG_INF; p1[r] = ok1 ? p1[r] + t1 : NEG_INF; }
                }
                float rm = fmaxf(p0[0], p1[0]);
#pragma unroll
                for (int r = 1; r < 16; ++r) rm = fmaxf(rm, fmaxf(p0[r], p1[r]));
                { auto rr = __builtin_amdgcn_permlane32_swap(__float_as_uint(rm), __float_as_uint(rm), false, false); rm = fmaxf(__uint_as_float(rr[0]), __uint_as_float(rr[1])); }
                const float mn = fmaxf(mrun, rm);
                if (TYPE == 2) live = !__all(rm - mrun < -40.f);
                if (live) {
                if (__any(mn > mrun)) {
                    const float f = (mn > mrun) ? fexp2(mrun - mn) : 1.0f;
                    lsum *= f; mrun = mn;
                    if (hi == 0) wsf[r32] = f;
                    LDS_WAIT(); __builtin_amdgcn_wave_barrier();
#pragma unroll
                    for (int g = 0; g < 4; ++g) { const f32x4 fv = ((const LAS f32x4*)wsf)[2 * g + hi];
#pragma unroll
                        for (int e = 0; e < 4; ++e) { o[0][4 * g + e] *= fv[e]; o[1][4 * g + e] *= fv[e]; } }
                    LDS_WAIT(); __builtin_amdgcn_wave_barrier();
                }
                const float ms = (mrun == NEG_INF) ? 0.f : mrun;
                float ps = 0.f;
#pragma unroll
                for (int r = 0; r < 16; ++r) { p0[r] = fexp2(p0[r] - ms); p1[r] = fexp2(p1[r] - ms); ps += p0[r] + p1[r]; }
                lsum += ps;
                }
            }
            if (live) {
            bf16x8 pa[4];
#pragma unroll
            for (int ks = 0; ks < 4; ++ks) { v4u w;
                if (ks < 2) { w.x = cvtpk(p0[8 * ks], p0[8 * ks + 1]); w.y = cvtpk(p0[8 * ks + 2], p0[8 * ks + 3]); w.z = cvtpk(p0[8 * ks + 4], p0[8 * ks + 5]); w.w = cvtpk(p0[8 * ks + 6], p0[8 * ks + 7]); }
                else { const int k2 = ks - 2; w.x = cvtpk(p1[8 * k2], p1[8 * k2 + 1]); w.y = cvtpk(p1[8 * k2 + 2], p1[8 * k2 + 3]); w.z = cvtpk(p1[8 * k2 + 4], p1[8 * k2 + 5]); w.w = cvtpk(p1[8 * k2 + 6], p1[8 * k2 + 7]); }
                pa[ks] = __builtin_bit_cast(bf16x8, w); }
#pragma unroll
            for (int d0 = 0; d0 < 2; ++d0)
#pragma unroll
                for (int ks = 0; ks < 4; ++ks) o[d0] = __builtin_amdgcn_mfma_f32_32x32x16_bf16(pa[ks], vfr[d0][ks], o[d0], 0, 0, 0);
            }
        }
        if (TYPE == 2) {
            bool wdead = false;
            if (active && more) wdead = __all(qbound + kbnext - mrun < -40.f);
            if (lane == 0) deadf[cur * 8 + wid] = wdead ? 1u : 0u; }
        if (TYPE == 3) { const bool wdead = active && __all(carry < 2.3e-10f);
            if (lane == 0) deadf[cur * 8 + wid] = wdead ? 1u : 0u; }
        if (more) { *(LAS v4u*)(L + AT_K + (cur ^ 1) * 8192 + kl) = kreg; *(LAS v4u*)(L + AT_V + (cur ^ 1) * 8192 + vl) = vreg; if (TYPE == 2 && tid < 64) ((LAS float*)(L + AT_KB + (cur ^ 1) * 256))[tid] = kbreg; }
        __syncthreads();
        if (TYPE >= 2) { const v4u d0 = *(const LAS v4u*)(deadf + cur * 8), d1 = *(const LAS v4u*)(deadf + cur * 8 + 4);
            if ((d0.x & d0.y & d0.z & d0.w & d1.x & d1.y & d1.z & d1.w) != 0u) break; }
    }
    float inv[16];
    if (TYPE != 3) {
        { auto rr = __builtin_amdgcn_permlane32_swap(__float_as_uint(lsum), __float_as_uint(lsum), false, false); lsum = __uint_as_float(rr[0]) + __uint_as_float(rr[1]); }
        if (TYPE == 1) lsum += fexp2(F.sinks[l * NH + hq] * LOG2E - mrun);
        const float il = 1.0f / lsum;
        if (hi == 0) wsf[r32] = il;
        LDS_WAIT(); __builtin_amdgcn_wave_barrier();
#pragma unroll
        for (int g = 0; g < 4; ++g) { const f32x4 fv = ((const LAS f32x4*)wsf)[2 * g + hi]; inv[4 * g] = fv[0]; inv[4 * g + 1] = fv[1]; inv[4 * g + 2] = fv[2]; inv[4 * g + 3] = fv[3]; }
        LDS_WAIT(); __builtin_amdgcn_wave_barrier();
    } else {
#pragma unroll
        for (int r = 0; r < 16; ++r) inv[r] = 1.0f;
    }
    unsigned short gte[2][16];
    if (TYPE == 2) {
#pragma unroll
        for (int d0 = 0; d0 < 2; ++d0)
#pragma unroll
            for (int r = 0; r < 16; ++r) { const int q = (r & 3) + 8 * (r >> 2) + 4 * hi; const size_t mrow = rowb + q0 + qoff + q; gte[d0][r] = ((const GAS unsigned short*)F.P)[mrow * NIN + PC_G + hq * 64 + 32 * d0 + r32]; }
    }
#pragma unroll
    for (int d0 = 0; d0 < 2; ++d0)
#pragma unroll
        for (int r = 0; r < 16; ++r) { const int q = (r & 3) + 8 * (r >> 2) + 4 * hi; const size_t mrow = rowb + q0 + qoff + q; const int col = hq * 64 + 32 * d0 + r32;
            float val = o[d0][r] * inv[r];
            if (TYPE == 2) val *= frcp(1.0f + fexp2(-LOG2E * __builtin_bit_cast(float, (unsigned)gte[d0][r] << 16)));
            F.Y[mrow * DM + YOFF + col] = (bf16)f2bf(val); }
}

__device__ __forceinline__ void sparse_attn_query(const Frame& F, int m, LAS unsigned char* vch, const LAS float* TBA, const LAS int* idx) {
    int lane = F.lane; asm volatile("" : "+v"(lane));
    const int hh = lane & 15, kg = lane >> 4, t = m % SEQ, b = m / SEQ;
    const size_t rowb = (size_t)b * SEQ;
    const int nsel = (t + 1) < TOPK ? (t + 1) : TOPK, nch = (nsel + 63) >> 6;
    const bf16* qp = F.P + (size_t)m * NIN + PA_Q + (hh & 7) * 64 + 8 * kg;
    const bf16x8 qf0 = *(const GAS bf16x8*)qp, qf1 = *(const GAS bf16x8*)(qp + 32);
    float s[4][4][4];
#pragma unroll
    for (int cp = 0; cp < 2; ++cp) {
        if (2 * cp < nch) {
            bf16x8 kf[8][2];
#pragma unroll
            for (int bb = 0; bb < 8; ++bb) { const int keyA = idx[128 * cp + 16 * bb + hh];
                const bf16* kp = F.P + (rowb + keyA) * NIN + PA_K + 8 * kg;
                kf[bb][0] = *(const GAS bf16x8*)kp; kf[bb][1] = *(const GAS bf16x8*)(kp + 32); }
            __builtin_amdgcn_sched_barrier(0);
#pragma unroll
            for (int bb = 0; bb < 8; ++bb) { const int c = 2 * cp + (bb >> 2), blk = bb & 3, j0 = 64 * c + 16 * blk;
                f32x4 acc = {0.f, 0.f, 0.f, 0.f};
                acc = __builtin_amdgcn_mfma_f32_16x16x32_bf16(kf[bb][0], qf0, acc, 0, 0, 0); acc = __builtin_amdgcn_mfma_f32_16x16x32_bf16(kf[bb][1], qf1, acc, 0, 0, 0);
                const v4i id4 = *(const LAS v4i*)(idx + j0 + 4 * kg);
#pragma unroll
                for (int r = 0; r < 4; ++r) { const int j = j0 + 4 * kg + r; int dist = t - id4[r]; dist = dist < 0 ? 0 : (dist > 128 ? 128 : dist);
                    const float bias = TBA[dist * 8 + (hh & 7)];
                    s[c][blk][r] = (j < nsel) ? acc[r] + bias : NEG_INF; }
            }
        } else {
#pragma unroll
            for (int c = 2 * cp; c < 2 * cp + 2; ++c)
#pragma unroll
                for (int blk = 0; blk < 4; ++blk)
#pragma unroll
                    for (int r = 0; r < 4; ++r) s[c][blk][r] = NEG_INF;
        }
    }
    v4u xv[2][8];
#define SP_VLOAD(c_, X) do { const int keyV_ = idx[64 * (c_) + lane]; const bf16* vp_ = F.P + (rowb + keyV_) * NIN + PA_V; \
        _Pragma("unroll") for (int i_ = 0; i_ < 8; ++i_) X[i_] = *(const GAS v4u*)(vp_ + 8 * i_); } while (0)
    SP_VLOAD(0, xv[0]);
    if (1 < nch) SP_VLOAD(1, xv[1]);
    __builtin_amdgcn_sched_barrier(0);
    float mx = NEG_INF;
#pragma unroll
    for (int c = 0; c < 4; ++c)
#pragma unroll
        for (int blk = 0; blk < 4; ++blk)
#pragma unroll
            for (int r = 0; r < 4; ++r) mx = fmaxf(mx, s[c][blk][r]);
    mx = fmaxf(mx, __shfl_xor(mx, 16)); mx = fmaxf(mx, __shfl_xor(mx, 32));
    float sum = 0.f;
#pragma unroll
    for (int c = 0; c < 4; ++c)
#pragma unroll
        for (int blk = 0; blk < 4; ++blk)
#pragma unroll
            for (int r = 0; r < 4; ++r) { const float p = fexp2(s[c][blk][r] - mx); s[c][blk][r] = p; sum += p; }
    sum += __shfl_xor(sum, 16); sum += __shfl_xor(sum, 32);
    const float inv = 1.0f / sum;
    f32x4 oacc[4];
#pragma unroll
    for (int d = 0; d < 4; ++d) oacc[d] = (f32x4){0.f, 0.f, 0.f, 0.f};
    const int q4 = (lane & 15) >> 2, p4 = lane & 3;
#pragma unroll
    for (int c = 0; c < 4; ++c) {
        if (c < nch) {
#pragma unroll
            for (int i = 0; i < 8; ++i) *(LAS v4u*)(vch + (i >> 2) * 4096 + lane * 64 + (i & 3) * 16) = xv[c & 1][i];
            LDS_WAIT(); __builtin_amdgcn_wave_barrier();
            if (c + 2 < nch) SP_VLOAD(c + 2, xv[c & 1]);
            __builtin_amdgcn_sched_barrier(0);
#pragma unroll
            for (int kp = 0; kp < 2; ++kp) { v4u w; w.x = cvtpk(s[c][2 * kp][0], s[c][2 * kp][1]); w.y = cvtpk(s[c][2 * kp][2], s[c][2 * kp][3]); w.z = cvtpk(s[c][2 * kp + 1][0], s[c][2 * kp + 1][1]); w.w = cvtpk(s[c][2 * kp + 1][2], s[c][2 * kp + 1][3]);
                const bf16x8 pf = __builtin_bit_cast(bf16x8, w);
#pragma unroll
                for (int d = 0; d < 4; ++d) { const LAS unsigned char* a = vch + (d >> 1) * 4096 + (32 * kp + 4 * kg + q4) * 64 + ((d & 1) * 16 + 4 * p4) * 2;
                    const s16x4 lo = vtr(a), hv = vtr(a + 16 * 64);
                    const bf16x8 vf = {lo[0], lo[1], lo[2], lo[3], hv[0], hv[1], hv[2], hv[3]};
                    oacc[d] = __builtin_amdgcn_mfma_f32_16x16x32_bf16(vf, pf, oacc[d], 0, 0, 0); } }
            LDS_WAIT(); __builtin_amdgcn_wave_barrier();
        }
    }
#undef SP_VLOAD
    if (hh < 8) {
#pragma unroll
        for (int d = 0; d < 4; ++d) { v2u w; w.x = pk2(oacc[d][0] * inv, oacc[d][1] * inv); w.y = pk2(oacc[d][2] * inv, oacc[d][3] * inv);
            *(GAS v2u*)(F.Y + (size_t)m * DM + hh * 64 + 16 * d + 4 * kg) = w; }
    }
}

constexpr int CW_QUEUE = 8192;
constexpr int MIX_ITEMS = 2560;
template <unsigned EN> __device__ __forceinline__ void ph_attention(const Frame& F, int l, int qsel = 0) {
    LAS float* TBA = (LAS float*)(F.lds + AUX_OFF);
    for (int i = F.tid; i < 129 * 8; i += NTHREADS) { const int d = i >> 3, hq = i & 7; const int bk = d < 128 ? (int)kBucketLut[d] : 31; TBA[i] = F.rel_table[bk * 16 + hq] * LOG2E; }
    LAS unsigned* qslot = (LAS unsigned*)(F.lds + LDSCTL_OFF + 64);
    LAS unsigned char* wbuf = F.lds + RING_OFF + AT_SV + F.wave * 9472;
    LAS int* idxl = (LAS int*)(wbuf + 8192);
    __syncthreads();
#define MIX_FETCH(it) do { if (F.tid == 0) *qslot = __hip_atomic_fetch_add((unsigned*)(F.ctl + CW_QUEUE + 64 * l + 32 * qsel), 1u, __ATOMIC_RELAXED, __HIP_MEMORY_SCOPE_AGENT); \
        __syncthreads(); it = (int)*qslot; __syncthreads(); } while (0)
    for (int r = (int)blockIdx.x; r < 1024; r += F.G) {
        if (EN & 0x800) {
            const int b = r >> 9, blk = r & 511;
#pragma unroll 1
            for (int k = 0; k < 2; ++k) { const int u = 8 * blk + F.wave; const int t = k ? (SEQ - 1 - u) : u; const int m = b * SEQ + t;
                select_row(F, m, (LAS unsigned*)wbuf, idxl);
                LDS_WAIT(); __builtin_amdgcn_wave_barrier();
#ifdef PROBE_SEL2
                select_row(F, m, (LAS unsigned*)wbuf, idxl); LDS_WAIT(); __builtin_amdgcn_wave_barrier();
#endif
#ifdef PROBE_ATT2
                sparse_attn_query(F, m, wbuf, TBA, idxl); LDS_WAIT(); __builtin_amdgcn_wave_barrier();
#endif
                sparse_attn_query(F, m, wbuf, TBA, idxl);
                LDS_WAIT(); __builtin_amdgcn_wave_barrier(); }
        }
    }
    __syncthreads();
    int it; MIX_FETCH(it); it += 1024;
    while (it < 1536) { const int r = it & 511; if (EN & 0x100) dense_attn_unit<2>(F, l, (r & 15) >> 3, r & 7, 31 - (r >> 4)); MIX_FETCH(it); it += 1024; }
    while (it < 2048) { const int r = it & 511; if (EN & 0x200) dense_attn_unit<3>(F, l, (r & 15) >> 3, r & 7, 31 - (r >> 4)); MIX_FETCH(it); it += 1024; }
    while (it < MIX_ITEMS) { const int r = it & 511; if (EN & 0x400) dense_attn_unit<1>(F, l, r >> 8, 0, 255 - (r & 255)); MIX_FETCH(it); it += 1024; }
#undef MIX_FETCH
}


__device__ __forceinline__ const float* gp_(const float* p) {
#if defined(__HIP_DEVICE_COMPILE__)
    __builtin_assume(!__builtin_amdgcn_is_shared((const __attribute__((address_space(0))) void*)p)); __builtin_assume(!__builtin_amdgcn_is_private((const __attribute__((address_space(0))) void*)p));
#endif
    return p; }
#ifndef PROBE_KINDS
#define PROBE_KINDS 0u
#endif
#ifndef PROBE_ATT
#define PROBE_ATT 0xF00u
#endif
#ifndef PROBE_REPS
#define PROBE_REPS 1
#endif
#ifndef MK_ONE_LAUNCH
#define MK_ONE_LAUNCH 1
#endif
constexpr int PH_PER_LAYER = 14, N_PHASES = 1 + DEPTH * PH_PER_LAYER;
struct Args { const float* in[15]; float* out; unsigned char* ws; int ph_lo, ph_hi; };
struct ArgsG { const GAS float* in[15]; GAS float* out; GAS unsigned char* ws; int ph_lo, ph_hi; };
template <unsigned EN> __global__ void __launch_bounds__(NTHREADS, 2) trunk_fwd(Args args) {
    extern __shared__ __attribute__((aligned(16))) unsigned char lds[];
    LAS unsigned char* const ldsb = (LAS unsigned char*)lds;
    const int wave0 = __builtin_amdgcn_readfirstlane((int)threadIdx.x >> 6);
    for (int u = threadIdx.x; u < (LDS_BYTES - LDSCTL_OFF) / 4; u += NTHREADS) ((LAS unsigned*)(ldsb + LDSCTL_OFF))[u] = 0u;
    __syncthreads();
#if MK_ONE_LAUNCH
    constexpr int lo = 0, hi = N_PHASES;
#else
    const int lo = args.ph_lo, hi = args.ph_hi;
#endif
    XcdBarrier bar; bar.bar = (unsigned*)(args.ws + WS_CTL) + CW_BAR; bar.x = 0; bar.st = nullptr;
    if (hi - lo > 1) bar = xcd_barrier_post((unsigned*)(args.ws + WS_CTL) + CW_BAR, (volatile LAS unsigned*)(ldsb + LDSCTL_OFF));
#define GP(p) ((const float*)(p))
#define PH_BEGIN(k, kind) if (lo <= (k) && (k) < hi) { _Pragma("unroll 1") for (int rep_ = 0; rep_ < (((PROBE_KINDS >> (kind)) & 1u) ? PROBE_REPS : 1); ++rep_) { Frame F; { \
        const ArgsG* ka = (const ArgsG*)__builtin_amdgcn_kernarg_segment_ptr(); asm volatile("" : "+s"(ka)); \
        unsigned o_ = ~0u; asm volatile("" : "+s"(o_)); int t_ = wave0 * 64 + (int)__builtin_amdgcn_mbcnt_hi(o_, __builtin_amdgcn_mbcnt_lo(o_, 0u)); asm volatile("" : "+v"(t_)); \
        F.lds = ldsb; F.tid = t_; F.lane = t_ & 63; F.wave = wave0; int gw_ = blockIdx.x * NWAVES + wave0; asm volatile("" : "+s"(gw_)); F.G = gridDim.x; F.gw = gw_; F.NGW = F.G * NWAVES; \
        unsigned char* ws = (unsigned char*)ka->ws; F.ctl = (gu32*)(ws + WS_CTL);     \
        F.x = GP(ka->in[0]); F.c = GP(ka->in[1]); F.w_ada = GP(ka->in[2]); F.b_ada = GP(ka->in[3]); F.norm_g = GP(ka->in[4]); F.w_in = GP(ka->in[5]); F.qk_g = GP(ka->in[6]); F.forget_b = GP(ka->in[7]); \
        F.sinks = GP(ka->in[8]); F.rel_table = GP(ka->in[9]); F.group_g = GP(ka->in[10]); F.w_out = GP(ka->in[11]); F.w_gate = GP(ka->in[12]); F.w_up = GP(ka->in[13]); F.w_down = GP(ka->in[14]); F.out = (float*)ka->out; \
        F.MOD = (float*)(ws + WS_MOD); F.LF = (float*)(ws + WS_LF); F.KB2 = (float*)(ws + WS_KB2); F.SC = (unsigned short*)(ws + WS_SC); F.IDX = (int*)(ws + WS_IDX); \
        F.WGU = (bf16*)(ws + WS_WGU); F.WD = (bf16*)(ws + WS_WD); F.WIN = (bf16*)(ws + WS_WIN); F.WOUT = (bf16*)(ws + WS_WOUT); \
        F.H = (bf16*)(ws + WS_H); F.P = (bf16*)(ws + WS_P); F.Y = (bf16*)(ws + WS_Y); F.XB = (bf16*)(ws + WS_XB); }
#define PH_END(k) if ((k) + 1 < hi) xcd_barrier(bar); } }

    PH_BEGIN(0, 31) if (EN & 1) p0_prologue(F); PH_END(0)

    for (int l = 0; l < DEPTH; ++l) {
        const int base = 1 + l * PH_PER_LAYER;
        for (int sub = 0; sub < 3; ++sub) {
            if (sub != 1) {
                const int f = sub >> 1, pb = base + (f ? 11 : 0), ni = f ? 2 : 0, lf = l * 2 + f;
                PH_BEGIN(pb, (f ? 11 : 0)) if (EN & 2) { const float* modl = F.MOD + (size_t)l * BATCH * NMOD;
                    if (l == 0 && f == 0) ph_modulate<FFN_FP8, false>(F, F.x, F.norm_g + ((size_t)l * 3 + ni) * DM, modl + (3 * ni + 0) * DM, modl + (3 * ni + 1) * DM);
                    else ph_modulate<FFN_FP8, true>(F, F.XB, F.norm_g + ((size_t)l * 3 + ni) * DM, modl + (3 * ni + 0) * DM, modl + (3 * ni + 1) * DM); } PH_END(pb)
                PH_BEGIN(pb + 1, (f ? 12 : 1)) if (EN & 4) {
                    pg8::StaticOrder S; S.init(M, NGU, F.G, (int)blockIdx.x);
                    if constexpr (FFN_FP8) { pg8::Gemm g{F.H, (const bf16*)((const unsigned char*)F.WGU + (size_t)lf * NGU * DM), M, NGU, DM, 127, W8_E8M0};
                        pg8::EpiSwiGLU8 E{(unsigned char*)F.P, DFFP};
                        pg8::gemm_phase<pg8::EpiSwiGLU8, pg8::StaticOrder, true, true, true>(F.lds + RING_OFF, g, S, E, F.tid); }
                    else { pg8::Gemm g{F.H, F.WGU + (size_t)lf * NGU * DM, M, NGU, DM};
                        pg8::EpiSwiGLU E{F.P, DFF};
                        pg8::gemm_phase<pg8::EpiSwiGLU, pg8::StaticOrder, true, true>(F.lds + RING_OFF, g, S, E, F.tid); } } PH_END(pb + 1)
                PH_BEGIN(pb + 2, (f ? 13 : 2)) if (EN & 8) {
                    pg8::Gemm g{F.P, FFN_FP8 ? (const bf16*)((const unsigned char*)F.WD + (size_t)lf * DM * DFFP) : F.WD + (size_t)lf * DM * DFF, M, DM, DFF, 127, FFN_FP8 ? W8_E8M0 : 127, FFN_FP8 ? DFFP : 0, FFN_FP8 ? DFFP : 0}; pg8::StaticOrder S; S.init(M, DM, F.G, (int)blockIdx.x);
                    const float* modl = F.MOD + (size_t)l * BATCH * NMOD;
                    if (l == DEPTH - 1 && f == 1) { pg8::EpiResid<false> E{F.XB, rep_ ? (void*)F.SC : (void*)F.out, DM, modl + (3 * ni + 2) * DM, NMOD, SEQ, 0.5f};
                        pg8::gemm_phase<pg8::EpiResid<false>, pg8::StaticOrder, true, true, FFN_FP8>(F.lds + RING_OFF, g, S, E, F.tid); }
                    else { pg8::EpiResid<true> E{F.XB, rep_ ? (void*)F.SC : (void*)F.XB, DM, modl + (3 * ni + 2) * DM, NMOD, SEQ, 0.5f};
                        pg8::gemm_phase<pg8::EpiResid<true>, pg8::StaticOrder, true, true, FFN_FP8>(F.lds + RING_OFF, g, S, E, F.tid); } } PH_END(pb + 2)
            } else {
                PH_BEGIN(base + 3, 3) if (EN & 2) { const float* modl = F.MOD + (size_t)l * BATCH * NMOD; ph_modulate<false, true>(F, F.XB, F.norm_g + ((size_t)l * 3 + 1) * DM, modl + 3 * DM, modl + 4 * DM); } PH_END(base + 3)
                PH_BEGIN(base + 4, 4) if (EN & 16) {
                    pg8::Gemm g{F.H, F.WIN + (size_t)l * NIN * DM, M, NIN, DM}; pg8::StaticOrder S; S.init(M, NIN, F.G, (int)blockIdx.x);
                    pg8::EpiBf16 E{F.P, NIN};
                    pg8::gemm_phase<pg8::EpiBf16, pg8::StaticOrder, true, true>(F.lds + RING_OFF, g, S, E, F.tid); } PH_END(base + 4)
                PH_BEGIN(base + 6, 6) if (EN & 64) { ph_scan(F, l);
                    int par_ = (int)((blockIdx.x & 1u) ^ 1u); asm volatile("" : "+s"(par_));
                    _Pragma("unroll 1") for (int st_ = 0; st_ < 2; ++st_) { if ((st_ ^ par_) == 0) { if (EN & 32) ph_post(F, l); } else ph_idx_scores(F); } } PH_END(base + 6)
                PH_BEGIN(base + 8, 8) if (EN & 0xF00) { if (rep_ == 0) ph_attention<EN>(F, l, 0); else ph_attention<(PROBE_ATT)>(F, l, 1); } PH_END(base + 8)
                PH_BEGIN(base + 9, 9) if (EN & 0x1000) ph_gnorm(F, l); PH_END(base + 9)
                PH_BEGIN(base + 10, 10) if (EN & 0x2000) {
                    pg8::Gemm g{F.Y, F.WOUT + (size_t)l * DM * DM, M, DM, DM}; pg8::StaticOrder S; S.init(M, DM, F.G, (int)blockIdx.x);
                    const float* modl = F.MOD + (size_t)l * BATCH * NMOD;
                    pg8::EpiResid<true> E{F.XB, rep_ ? (void*)F.SC : (void*)F.XB, DM, modl + 5 * DM, NMOD, SEQ, 1.0f};
                    pg8::gemm_phase<pg8::EpiResid<true>, pg8::StaticOrder, true, true>(F.lds + RING_OFF, g, S, E, F.tid); } PH_END(base + 10)
            }
        }
    }
#undef PH_BEGIN
#undef PH_END
}

#ifndef EN_MASK
#define EN_MASK 0xFFFFu
#endif
template <unsigned EN> static int setup_kernel() {
    if (hipFuncSetAttribute((const void*)trunk_fwd<EN>, hipFuncAttributeMaxDynamicSharedMemorySize, LDS_BYTES) != hipSuccess) { fprintf(stderr, "kernel_launch: hipFuncSetAttribute failed\n"); return -1; }
    int per_cu = 0;
    if (hipOccupancyMaxActiveBlocksPerMultiprocessor(&per_cu, (const void*)trunk_fwd<EN>, NTHREADS, LDS_BYTES) != hipSuccess || per_cu < 1) { fprintf(stderr, "kernel_launch: occupancy query says %d\n", per_cu); }
    (void)hipGetLastError();
    return 0;
}
template <unsigned EN> static void launch_range(const Args& a0, int lo, int hi, int grid, hipStream_t stream) {
    Args a = a0; a.ph_lo = lo; a.ph_hi = hi;
    hipLaunchKernelGGL(trunk_fwd<EN>, dim3(grid), dim3(NTHREADS), LDS_BYTES, stream, a);
}
extern "C" void kernel_launch(void* const* d_in, const int* in_sizes, int n_in, void* d_out, int out_size, void* d_ws, size_t ws_size, hipStream_t stream) {
    static int grid = 0;
    if (grid == 0) {
        if (n_in != 15 || in_sizes[0] != M * DM || out_size != M * DM || ws_size < WS_END) {
            fprintf(stderr, "kernel_launch: shape/workspace mismatch: n_in %d in0 %d out %d ws %zu (need %zu); nothing launched\n", n_in, n_in > 0 ? in_sizes[0] : -1, out_size, ws_size, (size_t)WS_END); grid = -1; return; }
        int dev = 0, cus = 0;
        if (hipGetDevice(&dev) != hipSuccess || hipDeviceGetAttribute(&cus, hipDeviceAttributeMultiprocessorCount, dev) != hipSuccess) { grid = -1; return; }
#if MK_ONE_LAUNCH
        if (setup_kernel<EN_MASK>()) { grid = -1; return; }
#else
        if (setup_kernel<0x1u>() || setup_kernel<0x2u>() || setup_kernel<0x4u>() || setup_kernel<0x8u>() || setup_kernel<0x10u>() || setup_kernel<0x20u>() || setup_kernel<0x40u>() || setup_kernel<0x80u>() ||
            setup_kernel<0x100u>() || setup_kernel<0x200u>() || setup_kernel<0x400u>() || setup_kernel<0x800u>() || setup_kernel<0x1000u>() || setup_kernel<0x2000u>()) { grid = -1; return; }
#endif
        grid = cus;
    }
    if (grid < 0) return;
    if (hipMemsetAsync((char*)d_ws + WS_CTL, 0, CTL_ZERO_BYTES, stream) != hipSuccess) return;
    Args a{};
    for (int i = 0; i < 15; ++i) a.in[i] = (const float*)d_in[i];
    a.out = (float*)d_out; a.ws = (unsigned char*)d_ws;
#if MK_ONE_LAUNCH
    launch_range<EN_MASK>(a, 0, N_PHASES, grid, stream);
#else
    launch_range<0x1u>(a, 0, 1, grid, stream);
    for (int l = 0; l < DEPTH; ++l) { const int base = 1 + l * PH_PER_LAYER;
        for (int f = 0; f < 2; ++f) { const int pb = base + (f ? 11 : 0);
            if (f == 1) {
                launch_range<0x2u>(a, base + 3, base + 4, grid, stream); launch_range<0x10u>(a, base + 4, base + 5, grid, stream); launch_range<0x20u>(a, base + 5, base + 6, grid, stream);
                launch_range<0x40u>(a, base + 6, base + 7, grid, stream); launch_range<0x80u>(a, base + 7, base + 8, grid, stream);
                launch_range<0x100u>(a, base + 8, base + 9, grid, stream); launch_range<0x200u>(a, base + 8, base + 9, grid, stream); launch_range<0x400u>(a, base + 8, base + 9, grid, stream); launch_range<0x800u>(a, base + 8, base + 9, grid, stream);
                launch_range<0x1000u>(a, base + 9, base + 10, grid, stream); launch_range<0x2000u>(a, base + 10, base + 11, grid, stream);
            }
            launch_range<0x2u>(a, pb, pb + 1, grid, stream); launch_range<0x4u>(a, pb + 1, pb + 2, grid, stream); launch_range<0x8u>(a, pb + 2, pb + 3, grid, stream);
        }
    }
#endif
}
```

```cpp
#include <hip/hip_runtime.h>
#include <cstdio>
#include <cstdint>

namespace pg8 {
#define PG8_LAS __attribute__((address_space(3)))
typedef unsigned short bf16_t;
typedef short bf16x8 __attribute__((ext_vector_type(8)));
typedef float f32x4 __attribute__((ext_vector_type(4)));
typedef unsigned u32x4 __attribute__((ext_vector_type(4)));
constexpr int BM = 256, BK = 64, HALF = 128, HTB = HALF * BK * 2  , STAGE_BYTES = 8 * HTB, NXCD = 8, WGM = 8;

__host__ __device__ __forceinline__ int lds_byte(int r, int c) { const int st = (r >> 4) * 2 + (c >> 5), rr = r & 15, cc = c & 31, ob = rr * 64 + cc * 2; return st * 1024 + (ob ^ (((ob >> 9) & 1) << 5)); }
__host__ __device__ __forceinline__ void stage_rc(int b, int& R, int& C) { const int st = b / 1024, sb = b % 1024, swz = sb ^ (((sb >> 9) & 1) << 5); R = (st >> 1) * 16 + swz / 64; C = (st & 1) * 32 + (swz % 64) / 2; }
__host__ __device__ __forceinline__ int perm32(int rho) { const int n = rho >> 4, i = rho & 15; return 8 * (i >> 2) + 4 * n + (i & 3); }

struct Unit { int pm, pn; };
struct Gemm { const bf16_t* A; const bf16_t* Bt; int M, N, K; int scaleA = 127, scaleB = 127; int lda = 0, ldb = 0; int blk = 0; };
typedef int i32x8 __attribute__((ext_vector_type(8))); typedef int i32x4v __attribute__((ext_vector_type(4)));
__device__ __forceinline__ i32x8 pg8_cat(bf16x8 lo, bf16x8 hi) { return __builtin_shufflevector(__builtin_bit_cast(i32x4v, lo), __builtin_bit_cast(i32x4v, hi), 0, 1, 2, 3, 4, 5, 6, 7); }

struct StaticOrder {
    int nM, nN, nwg, G, c;
    __host__ __device__ void init(int M, int N, int G_, int c_) { nM = M / BM; nN = N / BM; nwg = nM * nN; G = G_; c = c_; }
    __host__ __device__ bool next(int i, Unit& u) const {
        const long L = (long)i * G + c; if (L >= nwg) return false;
        int wgid = (int)L; { const int q = nwg / NXCD, r = nwg % NXCD, xcd = wgid % NXCD, off = wgid / NXCD; wgid = (xcd < r ? xcd * (q + 1) : r * (q + 1) + (xcd - r) * q) + off; }
        const int nig = WGM * nN, gid = wgid / nig, fm = gid * WGM, gsz = (nM - fm) < WGM ? (nM - fm) : WGM;
        u.pm = fm + ((wgid % nig) % gsz); u.pn = (wgid % nig) / gsz; return true;
    }
    __device__ __forceinline__ void a_ready(const Unit&) const {}
    __device__ __forceinline__ void done(const Unit&) const {}
};
typedef __bf16 pg8_bfpair __attribute__((ext_vector_type(2))); typedef float pg8_f32pair __attribute__((ext_vector_type(2)));
__device__ __forceinline__ unsigned cvt_pk_bf16(float lo, float hi) { const pg8_f32pair v = {lo, hi}; return __builtin_bit_cast(unsigned, __builtin_convertvector(v, pg8_bfpair)); }
__device__ __forceinline__ unsigned cvt_pk_bf16_nv(float lo, float hi) { return cvt_pk_bf16(lo, hi); }
__device__ __forceinline__ const char* uptr(const char* p) { const unsigned long long v = (unsigned long long)p; const unsigned lo = __builtin_amdgcn_readfirstlane((unsigned)v), hi = __builtin_amdgcn_readfirstlane((unsigned)(v >> 32)); return (const char*)(((unsigned long long)hi << 32) | lo); }
struct EpiBf16 {
    static constexpr bool PERM = true, AFTER_DRAIN = false;
    bf16_t* O; int ldc;
    __device__ __forceinline__ void operator()(const f32x4 (&acc)[2][2][4][2], const Unit& u, int wr, int wc, int fr, int fq) const {
        asm volatile("" : "+v"(fr), "+v"(fq));
        const int row0 = u.pm * BM + wr * 64 + fr; const int col0 = u.pn * BM + wc * 32 + 8 * fq;
#pragma unroll
        for (int ai = 0; ai < 2; ++ai)
#pragma unroll
            for (int m = 0; m < 4; ++m) { bf16_t* rowp = O + (size_t)(row0 + ai * HALF + m * 16) * ldc + col0;
#pragma unroll
                for (int bj = 0; bj < 2; ++bj) { const f32x4 v0 = acc[ai][bj][m][0], v1 = acc[ai][bj][m][1];
                    u32x4 w; w.x = cvt_pk_bf16(v0[0], v0[1]); w.y = cvt_pk_bf16(v0[2], v0[3]); w.z = cvt_pk_bf16(v1[0], v1[1]); w.w = cvt_pk_bf16(v1[2], v1[3]);
                    *(u32x4*)(rowp + bj * HALF) = w; } }
    }
};
__device__ __forceinline__ float silu_mul(float g, float u) { return g * u * __builtin_amdgcn_rcpf(1.0f + __builtin_amdgcn_exp2f(-1.4426950408889634f * g)); }
struct EpiSwiGLU {
    static constexpr bool PERM = true, AFTER_DRAIN = false;
    bf16_t* O; int ldc;
    __device__ __forceinline__ void operator()(const f32x4 (&acc)[2][2][4][2], const Unit& u, int wr, int wc, int fr, int fq) const {
        asm volatile("" : "+v"(fr), "+v"(fq));
        const int row0 = u.pm * BM + wr * 64 + fr; const int col0 = u.pn * HALF + wc * 32 + 8 * fq;
#pragma unroll
        for (int ai = 0; ai < 2; ++ai)
#pragma unroll
            for (int m = 0; m < 4; ++m) { bf16_t* rowp = O + (size_t)(row0 + ai * HALF + m * 16) * ldc + col0;
                const f32x4 g0 = acc[ai][0][m][0], g1 = acc[ai][0][m][1], u0 = acc[ai][1][m][0], u1 = acc[ai][1][m][1];
                u32x4 w; w.x = cvt_pk_bf16(silu_mul(g0[0], u0[0]), silu_mul(g0[1], u0[1])); w.y = cvt_pk_bf16(silu_mul(g0[2], u0[2]), silu_mul(g0[3], u0[3]));
                w.z = cvt_pk_bf16(silu_mul(g1[0], u1[0]), silu_mul(g1[1], u1[1])); w.w = cvt_pk_bf16(silu_mul(g1[2], u1[2]), silu_mul(g1[3], u1[3]));
                *(u32x4*)rowp = w; }
    }
};
template <bool OUT16> struct EpiResid {
    static constexpr bool PERM = true, AFTER_DRAIN = false;
    const bf16_t* base; void* out; int ldc; const float* gv; int gstride; int rows_per_batch; float coef;
    __device__ __forceinline__ void operator()(const f32x4 (&acc)[2][2][4][2], const Unit& u, int wr, int wc, int fr, int fq) const {
        asm volatile("" : "+v"(fr), "+v"(fq));
        const int row0 = u.pm * BM + wr * 64 + fr; const int col0 = u.pn * BM + wc * 32 + 8 * fq;
        const float* gvec = gv + (size_t)((u.pm * BM) / rows_per_batch) * gstride + col0;
        f32x4 gg[2][2];
#pragma unroll
        for (int bj = 0; bj < 2; ++bj)
#pragma unroll
            for (int n = 0; n < 2; ++n) gg[bj][n] = *(const f32x4*)(gvec + bj * HALF + 4 * n) * coef;
#pragma unroll
        for (int ai = 0; ai < 2; ++ai) {
            u32x4 bwv[4][2];
#pragma unroll
            for (int m = 0; m < 4; ++m) { const size_t off = (size_t)(row0 + ai * HALF + m * 16) * ldc + col0;
#pragma unroll
                for (int bj = 0; bj < 2; ++bj) bwv[m][bj] = *(const u32x4*)(base + off + bj * HALF); }
            __builtin_amdgcn_sched_barrier(0);
#pragma unroll
            for (int m = 0; m < 4; ++m) { const size_t off = (size_t)(row0 + ai * HALF + m * 16) * ldc + col0;
#pragma unroll
                for (int bj = 0; bj < 2; ++bj) { const u32x4 bw = bwv[m][bj];
                    f32x4 b0, b1; b0[0] = __builtin_bit_cast(float, bw.x << 16); b0[1] = __builtin_bit_cast(float, bw.x & 0xffff0000u); b0[2] = __builtin_bit_cast(float, bw.y << 16); b0[3] = __builtin_bit_cast(float, bw.y & 0xffff0000u);
                    b1[0] = __builtin_bit_cast(float, bw.z << 16); b1[1] = __builtin_bit_cast(float, bw.z & 0xffff0000u); b1[2] = __builtin_bit_cast(float, bw.w << 16); b1[3] = __builtin_bit_cast(float, bw.w & 0xffff0000u);
                    const f32x4 r0 = b0 + gg[bj][0] * acc[ai][bj][m][0], r1 = b1 + gg[bj][1] * acc[ai][bj][m][1];
                    if constexpr (OUT16) { u32x4 w; w.x = cvt_pk_bf16_nv(r0[0], r0[1]); w.y = cvt_pk_bf16_nv(r0[2], r0[3]); w.z = cvt_pk_bf16_nv(r1[0], r1[1]); w.w = cvt_pk_bf16_nv(r1[2], r1[3]); *(u32x4*)((bf16_t*)out + off + bj * HALF) = w; }
                    else { *(f32x4*)((float*)out + off + bj * HALF) = r0; *(f32x4*)((float*)out + off + bj * HALF + 4) = r1; } } }
        }
    }
};
__device__ __forceinline__ unsigned pack_fp8x4(float a, float b, float c, float d) {
    a = fminf(fmaxf(a, -448.f), 448.f); b = fminf(fmaxf(b, -448.f), 448.f); c = fminf(fmaxf(c, -448.f), 448.f); d = fminf(fmaxf(d, -448.f), 448.f);
    int w = 0; w = __builtin_amdgcn_cvt_pk_fp8_f32(a, b, w, false); w = __builtin_amdgcn_cvt_pk_fp8_f32(c, d, w, true); return (unsigned)w; }
struct EpiSwiGLU8 {
    static constexpr bool PERM = true, AFTER_DRAIN = false;
    unsigned char* O; int ldc;
    __device__ __forceinline__ void operator()(const f32x4 (&acc)[2][2][4][2], const Unit& u, int wr, int wc, int fr, int fq) const {
        asm volatile("" : "+v"(fr), "+v"(fq));
        const int row0 = u.pm * BM + wr * 64 + fr; const int col0 = u.pn * HALF + wc * 32 + 8 * fq;
#pragma unroll
        for (int ai = 0; ai < 2; ++ai)
#pragma unroll
            for (int m = 0; m < 4; ++m) { unsigned char* rowp = O + (size_t)(row0 + ai * HALF + m * 16) * ldc + col0;
                const f32x4 g0 = acc[ai][0][m][0], g1 = acc[ai][0][m][1], u0 = acc[ai][1][m][0], u1 = acc[ai][1][m][1];
                typedef unsigned u32x2v __attribute__((ext_vector_type(2))); u32x2v w;
                w.x = pack_fp8x4(silu_mul(g0[0], u0[0]), silu_mul(g0[1], u0[1]), silu_mul(g0[2], u0[2]), silu_mul(g0[3], u0[3]));
                w.y = pack_fp8x4(silu_mul(g1[0], u1[0]), silu_mul(g1[1], u1[1]), silu_mul(g1[2], u1[2]), silu_mul(g1[3], u1[3]));
                *(u32x2v*)rowp = w; }
    }
};
template <class Epi, class Sched, bool ALIGN_EPI = false, bool SP2 = false, bool FP8 = false>
__device__ __forceinline__ void gemm_phase(PG8_LAS unsigned char* lds, const Gemm g, const Sched& S, const Epi& E, int tid_in) {
    int tid_ = tid_in; asm volatile("" : "+v"(tid_));
    const int tid = tid_, wid = __builtin_amdgcn_readfirstlane(tid >> 6), lane = tid & 63, wr = wid >> 2, wc = wid & 3, fr = lane & 15, fq = lane >> 4;
    const int K = g.K, nt = FP8 ? K / (2 * BK) : K / BK;
    const int pitchA = g.blk ? 2 * BK : g.lda ? g.lda : (FP8 ? K : 2 * K), pitchB = g.blk ? 2 * BK : g.ldb ? g.ldb : (FP8 ? K : 2 * K);
    unsigned voffA[2], voffB[2];
#pragma unroll
    for (int i = 0; i < 2; ++i) { int R, C; stage_rc(tid * 16 + i * 8192, R, C); const int Rb = Epi::PERM ? ((R & ~31) + perm32(R & 31)) : R;
        voffA[i] = (unsigned)(R * pitchA + C * 2); voffB[i] = (unsigned)(Rb * pitchB + C * 2); }
    const size_t kstep = g.blk ? (size_t)(512 * BK) : (size_t)(BK * 2);
    const size_t hstepA = (size_t)HALF * pitchA, hstepB = (size_t)HALF * pitchB;
    const size_t tstepA = g.blk ? (size_t)(FP8 ? K / (2 * BK) : K / BK) * kstep : 2 * hstepA, tstepB = g.blk ? tstepA : 2 * hstepB;
    const unsigned ldsw = (unsigned)wid * 1024u;
    const int aoff = lds_byte(wr * 64 + fr, fq * 8), boff = lds_byte(wc * 32 + fr, fq * 8);
    PG8_LAS unsigned char* abase = lds + aoff; PG8_LAS unsigned char* bbase = lds + boff + 4 * HTB;
#define PG8_SA(b, h) (((b) * 2 + (h)) * HTB)
#define PG8_SB(b, h) ((4 + (b) * 2 + (h)) * HTB)
#define PG8_STAGE(bufoff, gbase, voff) do { _Pragma("unroll") for (int _i = 0; _i < 2; ++_i) \
        __builtin_amdgcn_global_load_lds((const unsigned*)((const char*)(gbase) + (voff)[_i]), (PG8_LAS unsigned*)(lds + (bufoff) + ldsw + _i * 8192), 16, 0, 0); } while (0)
#define PG8_RDA(off) (*(const PG8_LAS bf16x8*)(abase + (off)))
#define PG8_RDB(off) (*(const PG8_LAS bf16x8*)(bbase + ((off) - 4 * HTB)))
#define PG8_LDA(dst, b, h) do { if constexpr (FP8) { _Pragma("unroll") for (int m = 0; m < 4; ++m) dst##8[m] = pg8_cat(PG8_RDA(PG8_SA(b, h) + m * 2048), PG8_RDA(PG8_SA(b, h) + m * 2048 + 1024)); } \
    else { _Pragma("unroll") for (int m = 0; m < 4; ++m) _Pragma("unroll") for (int k = 0; k < 2; ++k) dst[m][k] = PG8_RDA(PG8_SA(b, h) + m * 2048 + k * 1024); } } while (0)
#define PG8_LDB(dst, b, h) do { if constexpr (FP8) { _Pragma("unroll") for (int n = 0; n < 2; ++n) dst##8[n] = pg8_cat(PG8_RDB(PG8_SB(b, h) + n * 2048), PG8_RDB(PG8_SB(b, h) + n * 2048 + 1024)); } \
    else { _Pragma("unroll") for (int n = 0; n < 2; ++n) _Pragma("unroll") for (int k = 0; k < 2; ++k) dst[n][k] = PG8_RDB(PG8_SB(b, h) + n * 2048 + k * 1024); } } while (0)
#define PG8_MMA(ai, bj, At, Bt) do { __builtin_amdgcn_s_setprio(1); if constexpr (FP8) { \
        _Pragma("unroll") for (int m = 0; m < 4; ++m) _Pragma("unroll") for (int n = 0; n < 2; ++n) \
            asm volatile("v_mfma_scale_f32_16x16x128_f8f6f4 %0, %1, %2, %0, %3, %4 op_sel_hi:[0,0,0]" : "+v"(acc[ai][bj][m][n]) : "v"(Bt##8[n]), "v"(At##8[m]), "v"(sclB), "v"(sclA)); \
        } else { _Pragma("unroll") for (int m = 0; m < 4; ++m) _Pragma("unroll") for (int n = 0; n < 2; ++n) _Pragma("unroll") for (int k = 0; k < 2; ++k) \
        acc[ai][bj][m][n] = __builtin_amdgcn_mfma_f32_16x16x32_bf16(Bt[n][k], At[m][k], acc[ai][bj][m][n], 0, 0, 0); } __builtin_amdgcn_s_setprio(0); } while (0)
#define PG8_WAIT_V(n) asm volatile("s_waitcnt vmcnt(" #n ")" ::: "memory")
#define PG8_WAIT_L(n) asm volatile("s_waitcnt lgkmcnt(" #n ")" ::: "memory")
#define PG8_BAR __builtin_amdgcn_s_barrier()
#define PG8_SCHED __builtin_amdgcn_sched_barrier(0)
    Unit cur, nxt; int ui = 0;
    if (!S.next(0, cur)) return;
    f32x4 acc[2][2][4][2];
#pragma unroll
    for (int a = 0; a < 2; ++a)
#pragma unroll
        for (int b = 0; b < 2; ++b)
#pragma unroll
            for (int m = 0; m < 4; ++m)
#pragma unroll
                for (int n = 0; n < 2; ++n) acc[a][b][m][n] = (f32x4){0.f, 0.f, 0.f, 0.f};
    const int sclA = g.scaleA, sclB = g.scaleB;
    bf16x8 At[4][2], B0[2][2], B1[2][2]; i32x8 At8[4], B08[2], B18[2];
    const char* cA = uptr((const char*)g.A + (size_t)cur.pm * tstepA); const char* cB = uptr((const char*)g.Bt + (size_t)cur.pn * tstepB);
    S.a_ready(cur);
    if constexpr (SP2) {
        PG8_STAGE(PG8_SB(0, 0), cB, voffB); PG8_STAGE(PG8_SB(0, 1), cB + hstepB, voffB); PG8_STAGE(PG8_SA(0, 0), cA, voffA); PG8_STAGE(PG8_SA(0, 1), cA + hstepA, voffA);
        if (wr == 1) PG8_BAR;
        PG8_WAIT_V(2); PG8_BAR;
        PG8_STAGE(PG8_SB(1, 0), cB + kstep, voffB); PG8_STAGE(PG8_SA(1, 0), cA + kstep, voffA); PG8_STAGE(PG8_SB(1, 1), cB + hstepB + kstep, voffB);
        PG8_WAIT_V(6); PG8_BAR;
    } else {
        PG8_STAGE(PG8_SB(0, 0), cB, voffB); PG8_STAGE(PG8_SA(0, 0), cA, voffA); PG8_STAGE(PG8_SB(0, 1), cB + hstepB, voffB); PG8_STAGE(PG8_SA(0, 1), cA + hstepA, voffA);
        if (wr == 1) PG8_BAR;
        PG8_WAIT_V(4); PG8_BAR;
        PG8_STAGE(PG8_SB(1, 0), cB + kstep, voffB); PG8_STAGE(PG8_SA(1, 0), cA + kstep, voffA); PG8_STAGE(PG8_SB(1, 1), cB + hstepB + kstep, voffB);
        PG8_WAIT_V(6); PG8_BAR;
    }
    for (;;) {
        const bool has_next = S.next(ui + 1, nxt);
        const char* nA = uptr(has_next ? (const char*)g.A + (size_t)nxt.pm * tstepA : cA); const char* nB = uptr(has_next ? (const char*)g.Bt + (size_t)nxt.pn * tstepB : cB);
        for (int t = 0; t < nt; t += 2) {
            asm volatile("" : "+v"(abase), "+v"(bbase));
            const bool last = (t == nt - 2);
            const char* a1 = cA + (size_t)(t + 1) * kstep;
            const char* a2 = uptr(last ? nA : cA + (size_t)(t + 2) * kstep); const char* b2 = uptr(last ? nB : cB + (size_t)(t + 2) * kstep);
            const char* a3 = a2 + kstep; const char* b3 = b2 + kstep;
            if (last && has_next) S.a_ready(nxt);
            if constexpr (SP2) {
            PG8_LDB(B0, 0, 0); PG8_LDB(B1, 0, 1); PG8_SCHED; PG8_LDA(At, 0, 0); PG8_STAGE(PG8_SA(1, 1), a1 + hstepA, voffA);
            PG8_WAIT_V(8); PG8_WAIT_L(0); PG8_BAR; PG8_MMA(0, 0, At, B0); PG8_MMA(0, 1, At, B1); PG8_BAR; PG8_SCHED;
            PG8_LDA(At, 0, 1); PG8_STAGE(PG8_SB(0, 0), b2, voffB); PG8_STAGE(PG8_SB(0, 1), b2 + hstepB, voffB); PG8_STAGE(PG8_SA(0, 0), a2, voffA);
            PG8_WAIT_V(8); PG8_WAIT_L(0); PG8_BAR; PG8_MMA(1, 0, At, B0); PG8_MMA(1, 1, At, B1); PG8_BAR; PG8_SCHED;
            PG8_LDB(B0, 1, 0); PG8_LDB(B1, 1, 1); PG8_SCHED; PG8_LDA(At, 1, 0); PG8_STAGE(PG8_SA(0, 1), a2 + hstepA, voffA);
            PG8_WAIT_V(8); PG8_WAIT_L(0); PG8_BAR; PG8_MMA(0, 0, At, B0); PG8_MMA(0, 1, At, B1); PG8_BAR; PG8_SCHED;
            PG8_LDA(At, 1, 1); PG8_STAGE(PG8_SB(1, 0), b3, voffB); PG8_STAGE(PG8_SB(1, 1), b3 + hstepB, voffB); PG8_STAGE(PG8_SA(1, 0), a3, voffA);
            PG8_WAIT_V(8); PG8_WAIT_L(0); PG8_BAR; PG8_MMA(1, 0, At, B0); PG8_MMA(1, 1, At, B1); PG8_BAR; PG8_SCHED;
            } else {
            PG8_LDB(B0, 0, 0); PG8_SCHED; PG8_LDA(At, 0, 0); PG8_STAGE(PG8_SA(1, 1), a1 + hstepA, voffA);
            PG8_WAIT_L(8); PG8_BAR; PG8_WAIT_L(0); PG8_MMA(0, 0, At, B0); PG8_BAR; PG8_SCHED;
            PG8_LDB(B1, 0, 1); PG8_STAGE(PG8_SB(0, 0), b2, voffB);
            PG8_BAR; PG8_WAIT_L(0); PG8_MMA(0, 1, At, B1); PG8_BAR;
            PG8_LDA(At, 0, 1); PG8_STAGE(PG8_SA(0, 0), a2, voffA);
            PG8_BAR; PG8_WAIT_L(0); PG8_MMA(1, 0, At, B0); PG8_BAR; PG8_SCHED;
            PG8_STAGE(PG8_SB(0, 1), b2 + hstepB, voffB);
            PG8_WAIT_V(6); PG8_BAR; PG8_MMA(1, 1, At, B1); PG8_BAR;
            PG8_LDB(B0, 1, 0); PG8_SCHED; PG8_LDA(At, 1, 0); PG8_STAGE(PG8_SA(0, 1), a2 + hstepA, voffA);
            PG8_WAIT_L(8); PG8_BAR; PG8_WAIT_L(0); PG8_MMA(0, 0, At, B0); PG8_BAR; PG8_SCHED;
            PG8_LDB(B1, 1, 1); PG8_STAGE(PG8_SB(1, 0), b3, voffB);
            PG8_BAR; PG8_WAIT_L(0); PG8_MMA(0, 1, At, B1); PG8_BAR;
            PG8_LDA(At, 1, 1); PG8_STAGE(PG8_SA(1, 0), a3, voffA);
            PG8_BAR; PG8_WAIT_L(0); PG8_MMA(1, 0, At, B0); PG8_BAR; PG8_SCHED;
            PG8_STAGE(PG8_SB(1, 1), b3 + hstepB, voffB);
            PG8_WAIT_V(6); PG8_BAR; PG8_MMA(1, 1, At, B1); PG8_BAR;
            }
        }
        if constexpr (FP8) asm volatile("s_nop 15\n\ts_nop 7" ::: "memory");
        if constexpr (ALIGN_EPI) { if (wr == 0) PG8_BAR; }
        if constexpr (!Epi::AFTER_DRAIN) { E(acc, cur, wr, wc, fr, fq); S.done(cur); }
        if (!has_next) break;
#pragma unroll
        for (int a = 0; a < 2; ++a)
#pragma unroll
            for (int b = 0; b < 2; ++b)
#pragma unroll
                for (int m = 0; m < 4; ++m)
#pragma unroll
                    for (int n = 0; n < 2; ++n) acc[a][b][m][n] = (f32x4){0.f, 0.f, 0.f, 0.f};
        cur = nxt; cA = nA; cB = nB; ++ui;
        if constexpr (ALIGN_EPI) { if (wr == 1) PG8_BAR; }
    }
    PG8_WAIT_V(0);
    if constexpr (!ALIGN_EPI) { if (wr == 0) PG8_BAR; }
    PG8_BAR;
    if constexpr (Epi::AFTER_DRAIN) { E.fused(acc, cur, wr, wc, fr, fq, lds, wid, lane); S.done(cur); }
#undef PG8_SA
#undef PG8_SB
#undef PG8_STAGE
#undef PG8_RDA
#undef PG8_RDB
#undef PG8_LDA
#undef PG8_LDB
#undef PG8_MMA
#undef PG8_WAIT_V
#undef PG8_WAIT_L
#undef PG8_BAR
#undef PG8_SCHED
}
}

#ifndef MK_FFN_FP8
#define MK_FFN_FP8 1
#endif
constexpr bool FFN_FP8 = MK_FFN_FP8;
constexpr int NWAVES = 8, NTHREADS = NWAVES * 64;
constexpr int BATCH = 2, SEQ = 8192, M = BATCH * SEQ, DM = 2048, DEPTH = 4, DFF = 5632, NGU = 2 * DFF, INC = 5976, NIN = 6144, NMOD = 9 * DM;
constexpr int DFFP = DFF + 128;
constexpr int NH = 8, HD = 64, GWID = 512, TOPK = 256, WINDOW = 128;
constexpr int PA_Q = 0, PA_K = 512, PA_V = 576, PA_IQ = 640, PA_IK = 1664, PB_Q = 1728, PB_K = 2240, PB_V = 2304, PC_Q = 2368, PC_K = 2880, PC_V = 3392, PC_G = 3904,
              PD_Q = 4416, PD_K = 4928, PD_V = 5440, PA_IW = 5952, PC_F = 5968;
constexpr float RMS_EPS = 1e-6f, LOG2E = 1.4426950408889634f, QSCALE = 0.125f * LOG2E;

constexpr size_t MiB = 1u << 20;
constexpr size_t WS_CTL = 0, CTL_ZERO_BYTES = 64 * 1024;
constexpr size_t WS_MOD = 1 * MiB;
constexpr size_t WS_LF = 2 * MiB;
constexpr size_t WS_KB2 = 3 * MiB;
constexpr size_t WS_WGU = 4 * MiB;
constexpr size_t SZ_WGU = (size_t)NGU * DM * 2;
constexpr size_t WS_WD = WS_WGU + 8 * SZ_WGU;
constexpr size_t SZ_WD = (size_t)DM * DFF * 2;
constexpr size_t WS_WIN = WS_WD + 8 * SZ_WD;
constexpr size_t SZ_WIN = (size_t)NIN * DM * 2;
constexpr size_t WS_WOUT = WS_WIN + 4 * SZ_WIN;
constexpr size_t SZ_WOUT = (size_t)DM * DM * 2;
constexpr size_t WS_H = WS_WOUT + 4 * SZ_WOUT;
constexpr size_t WS_P = WS_H + (size_t)M * DM * 2;
constexpr size_t WS_Y = WS_P + (size_t)M * NIN * 2;
constexpr size_t WS_IDX = WS_Y + (size_t)M * DM * 2;
constexpr size_t WS_SC = WS_IDX + (size_t)M * TOPK * 4;
constexpr size_t WS_XB = WS_SC + (size_t)BATCH * SEQ * SEQ * 2;
constexpr size_t WS_END = WS_XB + (size_t)M * DM * 2;
static_assert(WS_WGU % MiB == 0 && WS_WD % MiB == 0 && WS_WIN % MiB == 0 && WS_WOUT % MiB == 0 && WS_H % MiB == 0 && WS_P % MiB == 0 && WS_Y % MiB == 0 && WS_IDX % MiB == 0 && WS_SC % MiB == 0, "d_ws map alignment");
constexpr int CW_BAR = 4096;

constexpr int RING_OFF = 0, RING_BYTES = 131072;
constexpr int AUX_OFF = RING_BYTES, AUX_BYTES = 16384;
constexpr int LDSCTL_OFF = AUX_OFF + AUX_BYTES;
constexpr int LDS_BYTES = LDSCTL_OFF + 256;

#define GAS __attribute__((address_space(1)))
#define LAS __attribute__((address_space(3)))
typedef unsigned short bf16;
typedef unsigned v4u __attribute__((ext_vector_type(4)));
typedef unsigned v2u __attribute__((ext_vector_type(2)));
typedef int v4i __attribute__((ext_vector_type(4)));
typedef float f32x4 __attribute__((ext_vector_type(4)));
typedef float f32x16 __attribute__((ext_vector_type(16)));
typedef short bf16x8 __attribute__((ext_vector_type(8)));
typedef short s16x4 __attribute__((ext_vector_type(4)));
typedef GAS unsigned gu32;
#define RLX_AGENT __ATOMIC_RELAXED, __HIP_MEMORY_SCOPE_AGENT
#define LDS_WAIT() asm volatile("s_waitcnt lgkmcnt(0)" ::: "memory")
#define VM_WAIT() asm volatile("s_waitcnt vmcnt(0)" ::: "memory")
__device__ __forceinline__ unsigned f2bf(float f) { unsigned u = __builtin_bit_cast(unsigned, f); return (u + 0x7fffu + ((u >> 16) & 1u)) >> 16; }
__device__ __forceinline__ unsigned pk2(float lo, float hi) { return f2bf(lo) | (f2bf(hi) << 16); }
__device__ __forceinline__ float bf_lo(unsigned w) { return __builtin_bit_cast(float, w << 16); }
__device__ __forceinline__ float bf_hi(unsigned w) { return __builtin_bit_cast(float, w & 0xffff0000u); }
__device__ __forceinline__ float bf2f(bf16 h) { return __builtin_bit_cast(float, (unsigned)h << 16); }
__device__ __forceinline__ float wave_sum(float v) {
#pragma unroll
    for (int o = 1; o < 64; o <<= 1) v += __shfl_xor(v, o);
    return v;
}
__device__ __forceinline__ float fexp2(float x) { return __builtin_amdgcn_exp2f(x); }
__device__ __forceinline__ float frcp(float x) { return __builtin_amdgcn_rcpf(x); }
__device__ const unsigned char kBucketLut[128] = {0, 1, 2, 3, 4, 5, 6, 7, 8, 9, 10, 11, 12, 13, 14, 15, 16, 16, 16, 17, 17, 18, 18, 18, 19, 19, 19, 20, 20, 20, 20, 21, 21, 21, 21, 22, 22, 22, 22, 22,
    23, 23, 23, 23, 23, 23, 24, 24, 24, 24, 24, 24, 25, 25, 25, 25, 25, 25, 25, 26, 26, 26, 26, 26, 26, 26, 26, 27, 27, 27, 27, 27, 27, 27, 27, 27, 27, 28, 28, 28, 28, 28, 28, 28, 28, 28, 28,
    29, 29, 29, 29, 29, 29, 29, 29, 29, 29, 29, 29, 30, 30, 30, 30, 30, 30, 30, 30, 30, 30, 30, 30, 30, 30, 31, 31, 31, 31, 31, 31, 31, 31, 31, 31, 31, 31, 31, 31, 31};

#define XB_TMO      128
#define XB_XCNT(j)  (256  + 64 * (j))
#define XB_XSUB(j)  (1280 + 64 * (j))
#define XB_XGEN(j)  (2304 + 64 * (j))
#define XB_TOP      3328
#define XB_TOPGEN   3392
#define XCD_BAR_WORDS 3456
#define XB_SPIN_CAP (1u << 18)

__device__ __forceinline__ unsigned xb_ld(unsigned* p)              { return __hip_atomic_load((GAS unsigned*)p, __ATOMIC_RELAXED, __HIP_MEMORY_SCOPE_AGENT); }
__device__ __forceinline__ unsigned xb_add(unsigned* p, unsigned v) { return __hip_atomic_fetch_add((GAS unsigned*)p, v, __ATOMIC_RELAXED, __HIP_MEMORY_SCOPE_AGENT); }
__device__ __forceinline__ unsigned xb_xcc_id() { return (unsigned)__builtin_amdgcn_s_getreg((3 << 11) | 20) & 0xFu; }
#define XB_SPIN(cond, bar) do { unsigned _sp = 0; while (cond) { __builtin_amdgcn_s_sleep(1); \
    if ((++_sp & 255u) == 0u) { if (xb_ld(&(bar)[XB_TMO])) break; if (_sp > XB_SPIN_CAP) { xb_add(&(bar)[XB_TMO], 1u); break; } } } } while (0)

struct XcdBarrier {
    unsigned* bar; unsigned x;
    volatile LAS unsigned* st;
};

__device__ __forceinline__ XcdBarrier xcd_barrier_post(unsigned* bar, volatile LAS unsigned* st) {
    XcdBarrier b; b.bar = bar; b.x = xb_xcc_id(); b.st = st;
    if (threadIdx.x == 0) (void)xb_add(&bar[XB_XCNT(b.x)], 1u);
    return b;
}
__device__ __forceinline__ void xcd_barrier_complete(unsigned* bar, unsigned x, unsigned& nloc, unsigned& nx) {
    const unsigned G = gridDim.x * gridDim.y * gridDim.z;
    unsigned sum, cnt, mine, sp = 0u;
    for (;;) {
        sum = 0u; cnt = 0u; mine = 0u;
#pragma unroll
        for (unsigned j = 0; j < 16; ++j) { const unsigned c = xb_ld(&bar[XB_XCNT(j)]); sum += c; cnt += (c > 0u) ? 1u : 0u; mine = (j == x) ? c : mine; }
        if (sum == G) break;
        __builtin_amdgcn_s_sleep(1);
        if ((++sp & 255u) == 0u) { if (xb_ld(&bar[XB_TMO])) break; if (sp > XB_SPIN_CAP) { xb_add(&bar[XB_TMO], 1u); break; } }
    }
    nloc = mine > 0u ? mine : 1u; nx = cnt > 0u ? cnt : 1u;
}

__device__ __forceinline__ void xcd_barrier(const XcdBarrier& b) {
    asm volatile("s_waitcnt vmcnt(0)" ::: "memory");
    __syncthreads();
    if (threadIdx.x == 0) {
        unsigned* bar = b.bar; asm volatile("" : "+s"(bar));
        __builtin_amdgcn_s_waitcnt(0);
        unsigned nloc = b.st[0], nx = b.st[1];
        if (nloc == 0u) { xcd_barrier_complete(bar, b.x, nloc, nx); b.st[0] = nloc; b.st[1] = nx; }
        const unsigned old = xb_add(&bar[XB_XSUB(b.x)], 1u);
        const unsigned gen = old / nloc;
        if (old + 1u == (gen + 1u) * nloc) {
            __builtin_amdgcn_fence(__ATOMIC_RELEASE, "agent");
            asm volatile("s_waitcnt vmcnt(0)" ::: "memory");
            const unsigned og = xb_add(&bar[XB_TOP], 1u);
            const unsigned tg = og / nx;
            if (og + 1u == (tg + 1u) * nx) xb_add(&bar[XB_TOPGEN], 1u);
            else XB_SPIN(xb_ld(&bar[XB_TOPGEN]) == tg, bar);
            __builtin_amdgcn_fence(__ATOMIC_ACQUIRE, "agent");
            xb_add(&bar[XB_XGEN(b.x)], 1u);
            asm volatile("s_waitcnt vmcnt(0)" ::: "memory");
        } else {
            XB_SPIN(xb_ld(&bar[XB_XGEN(b.x)]) == gen, bar);
            __builtin_amdgcn_fence(__ATOMIC_ACQUIRE, "agent");
            asm volatile("s_waitcnt vmcnt(0)" ::: "memory");
        }
    }
    __syncthreads();
}

struct Frame {
    LAS unsigned char* lds;
    gu32* ctl;
    int tid, lane, wave, G, gw, NGW;
    const float *x, *c, *w_ada, *b_ada, *norm_g, *w_in, *qk_g, *forget_b, *sinks, *rel_table, *group_g, *w_out, *w_gate, *w_up, *w_down;
    float* out;
    float *MOD, *LF, *KB2; unsigned short* SC; int* IDX;
    bf16 *WGU, *WD, *WIN, *WOUT, *H, *P, *Y, *XB;
};

template <int MAP> __device__ __forceinline__ int w_rowmap(int n) {
    if (MAP == 1) return 256 * (n >> 7) + (n & 127);
    if (MAP == 2) return 256 * (n >> 7) + 128 + (n & 127);
    if (MAP == 3) { if (n < 1728) return n; if (n < 1744) return PA_IW + (n - 1728); if (n < 3920) return n - 16; if (n < 3928) return PC_F + (n - 3920); return n - 24; }
    return n;
}
template <int MAP> __device__ __forceinline__ void p0_transpose_item(const float* W, int K, int N, bf16* WT, LAS unsigned* T, int item, int lane) {
    const int nblk = (N + 63) / 64, kb = item / nblk, nb = item % nblk, k0 = 64 * kb, n0 = 64 * nb;
    const int r = lane >> 4, c = lane & 15;
    const bool nok = (n0 + 4 * c) < N;
    const float* src = W + (size_t)(k0 + 2 * r) * N + n0 + 4 * c;
    f32x4 a[8], b[8];
#pragma unroll
    for (int i = 0; i < 8; ++i) { a[i] = nok ? *(const GAS f32x4*)(src + (size_t)(8 * i) * N) : (f32x4){0.f, 0.f, 0.f, 0.f}; b[i] = nok ? *(const GAS f32x4*)(src + (size_t)(8 * i + 1) * N) : (f32x4){0.f, 0.f, 0.f, 0.f}; }
#pragma unroll
    for (int i = 0; i < 8; ++i)
#pragma unroll
        for (int e = 0; e < 4; ++e) T[(4 * c + e) * 36 + 4 * i + r] = pk2(a[i][e], b[i][e]);
    LDS_WAIT(); asm volatile("" ::: "memory");
    const int rr = lane >> 3, ch = lane & 7;
#pragma unroll
    for (int j = 0; j < 8; ++j) { const int n = 8 * j + rr; const v4u o = *(const LAS v4u*)(T + n * 36 + 4 * ch);
        if (n0 + n < N) *(GAS v4u*)(WT + (size_t)w_rowmap<MAP>(n0 + n) * K + k0 + 8 * ch) = o; }
    LDS_WAIT(); asm volatile("" ::: "memory");
}
constexpr float W8_SCALE = 64.0f; constexpr int W8_E8M0 = 127 - 6;
__device__ __forceinline__ unsigned pk_fp8x4(float a, float b, float c, float d) {
    a = fminf(fmaxf(a, -448.f), 448.f); b = fminf(fmaxf(b, -448.f), 448.f); c = fminf(fmaxf(c, -448.f), 448.f); d = fminf(fmaxf(d, -448.f), 448.f);
    int w = 0; w = __builtin_amdgcn_cvt_pk_fp8_f32(a, b, w, false); w = __builtin_amdgcn_cvt_pk_fp8_f32(c, d, w, true); return (unsigned)w; }
template <int MAP> __device__ __forceinline__ void p0_transpose8_item(const float* W, int K, int N, unsigned char* WT, int ldw, LAS unsigned* T, int item, int lane) {
    const int nblk = (N + 63) / 64, kb = item / nblk, nb = item % nblk, k0 = 64 * kb, n0 = 64 * nb;
    const int r = lane >> 4, c = lane & 15;
    const bool nok = (n0 + 4 * c) < N;
    const float* src = W + (size_t)(k0 + 4 * r) * N + n0 + 4 * c;
    f32x4 q[4][4];
#pragma unroll
    for (int i = 0; i < 4; ++i)
#pragma unroll
        for (int d = 0; d < 4; ++d) q[i][d] = nok ? *(const GAS f32x4*)(src + (size_t)(16 * i + d) * N) : (f32x4){0.f, 0.f, 0.f, 0.f};
#pragma unroll
    for (int i = 0; i < 4; ++i)
#pragma unroll
        for (int e = 0; e < 4; ++e) T[(4 * c + e) * 20 + 4 * i + r] = pk_fp8x4(q[i][0][e] * W8_SCALE, q[i][1][e] * W8_SCALE, q[i][2][e] * W8_SCALE, q[i][3][e] * W8_SCALE);
    LDS_WAIT(); asm volatile("" ::: "memory");
    const int rr = lane >> 2, ch = lane & 3;
#pragma unroll
    for (int j = 0; j < 4; ++j) { const int n = 16 * j + rr; const v4u o = *(const LAS v4u*)(T + n * 20 + 4 * ch);
        if (n0 + n < N) *(GAS v4u*)(WT + (size_t)w_rowmap<MAP>(n0 + n) * ldw + k0 + 16 * ch) = o; }
    LDS_WAIT(); asm volatile("" ::: "memory");
}
template <int MAP> __device__ __forceinline__ void p0_transpose8(const Frame& F, const float* W, int K, int N, unsigned char* WT, int ldw, LAS unsigned* scr) {
    const int nitems = (K / 64) * ((N + 63) / 64);
    for (int it = F.gw; it < nitems; it += F.NGW) p0_transpose8_item<MAP>(W, K, N, WT, ldw, scr, it, F.lane);
}
template <int MAP> __device__ __forceinline__ void p0_transpose(const Frame& F, const float* W, int K, int N, bf16* WT, LAS unsigned* scr) {
    const int nitems = (K / 64) * ((N + 63) / 64);
    for (int it = F.gw; it < nitems; it += F.NGW) p0_transpose_item<MAP>(W, K, N, WT, scr, it, F.lane);
}
__device__ __forceinline__ void p0_prologue(const Frame& F) {
    LAS unsigned* scr = (LAS unsigned*)(F.lds + RING_OFF + F.wave * 16384);
    LAS float* cond = (LAS float*)(F.lds + AUX_OFF);
    LAS float* red = (LAS float*)(F.lds + RING_OFF);
    for (int i = F.tid; i < BATCH * DM; i += NTHREADS) { const float v = F.c[i]; cond[i] = v / (1.0f + __expf(-v)); }
    __syncthreads();
    for (int it = blockIdx.x; it < DEPTH * (NMOD / 64); it += F.G) {
        const int l = it / (NMOD / 64), n = (it % (NMOD / 64)) * 64 + F.lane;
        const float* w = F.w_ada + (size_t)l * DM * NMOD + (size_t)(256 * F.wave) * NMOD + n;
        const LAS float* c0 = cond + 256 * F.wave; const LAS float* c1 = cond + DM + 256 * F.wave;
        float a0 = 0.f, a1 = 0.f;
#pragma unroll 32
        for (int k = 0; k < 256; ++k) { const float wv = w[(size_t)k * NMOD]; a0 += c0[k] * wv; a1 += c1[k] * wv; }
        red[F.wave * 128 + F.lane] = a0; red[F.wave * 128 + 64 + F.lane] = a1;
        __syncthreads();
        if (F.tid < 128) { float sacc = 0.f;
#pragma unroll
            for (int wv = 0; wv < 8; ++wv) sacc += red[wv * 128 + F.tid];
            const int bsel = F.tid >> 6, nn = (it % (NMOD / 64)) * 64 + (F.tid & 63);
            F.MOD[((size_t)l * BATCH + bsel) * NMOD + nn] = sacc + F.b_ada[(size_t)l * NMOD + nn]; }
        __syncthreads();
    }
    for (int lf = 0; lf < DEPTH * 2; ++lf) {
        if (FFN_FP8) {
            p0_transpose8<1>(F, F.w_gate + (size_t)lf * DM * DFF, DM, DFF, (unsigned char*)F.WGU + (size_t)lf * NGU * DM, DM, scr);
            p0_transpose8<2>(F, F.w_up + (size_t)lf * DM * DFF, DM, DFF, (unsigned char*)F.WGU + (size_t)lf * NGU * DM, DM, scr);
            p0_transpose8<0>(F, F.w_down + (size_t)lf * DFF * DM, DFF, DM, (unsigned char*)F.WD + (size_t)lf * DM * DFFP, DFFP, scr);
        } else {
            p0_transpose<1>(F, F.w_gate + (size_t)lf * DM * DFF, DM, DFF, F.WGU + (size_t)lf * NGU * DM, scr);
            p0_transpose<2>(F, F.w_up + (size_t)lf * DM * DFF, DM, DFF, F.WGU + (size_t)lf * NGU * DM, scr);
            p0_transpose<0>(F, F.w_down + (size_t)lf * DFF * DM, DFF, DM, F.WD + (size_t)lf * DM * DFF, scr);
        }
    }
    for (int l = 0; l < DEPTH; ++l) {
        p0_transpose<3>(F, F.w_in + (size_t)l * DM * INC, DM, INC, F.WIN + (size_t)l * NIN * DM, scr);
        p0_transpose<0>(F, F.w_out + (size_t)l * DM * DM, DM, DM, F.WOUT + (size_t)l * DM * DM, scr);
        GAS v4u* z = (GAS v4u*)(F.WIN + (size_t)l * NIN * DM + (size_t)INC * DM);
        for (int i = F.gw * 64 + F.lane; i < (NIN - INC) * DM / 8; i += F.NGW * 64) z[i] = (v4u){0u, 0u, 0u, 0u};
    }
}

template <bool OUT8, bool IN16> __device__ __forceinline__ void ph_modulate(const Frame& F, const void* xin, const float* g, const float* shift, const float* scale) {
    if constexpr (IN16) {
        f32x4 av[4][2], hv[4][2]; int cb = -1;
        int m = F.gw;
        v4u wc[4];
        if (m < M) { const GAS v4u* xr = (const GAS v4u*)((const bf16*)xin + (size_t)m * DM) + F.lane;
#pragma unroll
            for (int j = 0; j < 4; ++j) wc[j] = xr[64 * j]; }
        while (m < M) {
            const int mn = m + F.NGW; const int b = m / SEQ;
            v4u wn[4];
            if (mn < M) { const GAS v4u* xr = (const GAS v4u*)((const bf16*)xin + (size_t)mn * DM) + F.lane;
#pragma unroll
                for (int j = 0; j < 4; ++j) wn[j] = xr[64 * j]; }
            else {
#pragma unroll
                for (int j = 0; j < 4; ++j) wn[j] = (v4u){0u, 0u, 0u, 0u}; }
            if (b != cb) { cb = b;
                const GAS f32x4* gp = (const GAS f32x4*)g + 2 * F.lane; const GAS f32x4* sh = (const GAS f32x4*)(shift + (size_t)b * NMOD) + 2 * F.lane; const GAS f32x4* sc = (const GAS f32x4*)(scale + (size_t)b * NMOD) + 2 * F.lane;
#pragma unroll
                for (int j = 0; j < 4; ++j)
#pragma unroll
                    for (int h = 0; h < 2; ++h) { const f32x4 gg = gp[128 * j + h], ss = sc[128 * j + h]; hv[j][h] = sh[128 * j + h]; av[j][h] = gg * (ss + 1.0f); } }
            float x[4][8]; float s = 0.f;
#pragma unroll
            for (int j = 0; j < 4; ++j) { x[j][0] = bf_lo(wc[j].x); x[j][1] = bf_hi(wc[j].x); x[j][2] = bf_lo(wc[j].y); x[j][3] = bf_hi(wc[j].y); x[j][4] = bf_lo(wc[j].z); x[j][5] = bf_hi(wc[j].z); x[j][6] = bf_lo(wc[j].w); x[j][7] = bf_hi(wc[j].w); }
#pragma unroll
            for (int j = 0; j < 4; ++j) s += ((x[j][0] * x[j][0] + x[j][1] * x[j][1]) + (x[j][2] * x[j][2] + x[j][3] * x[j][3])) + ((x[j][4] * x[j][4] + x[j][5] * x[j][5]) + (x[j][6] * x[j][6] + x[j][7] * x[j][7]));
            const float rstd = 1.0f / sqrtf(wave_sum(s) * (1.f / DM) + RMS_EPS);
            GAS v4u* o16 = (GAS v4u*)(F.H + (size_t)m * DM) + F.lane;
            GAS v2u* o8 = (GAS v2u*)((unsigned char*)F.H + (size_t)m * DM) + F.lane;
#pragma unroll
            for (int j = 0; j < 4; ++j) { float y[8];
#pragma unroll
                for (int h = 0; h < 2; ++h) { const f32x4 aa = av[j][h], hh = hv[j][h];
                    y[4 * h + 0] = x[j][4 * h + 0] * rstd * aa.x + hh.x; y[4 * h + 1] = x[j][4 * h + 1] * rstd * aa.y + hh.y;
                    y[4 * h + 2] = x[j][4 * h + 2] * rstd * aa.z + hh.z; y[4 * h + 3] = x[j][4 * h + 3] * rstd * aa.w + hh.w; }
                if (OUT8) { v2u w; w.x = pk_fp8x4(y[0], y[1], y[2], y[3]); w.y = pk_fp8x4(y[4], y[5], y[6], y[7]); o8[64 * j] = w; }
                else { v4u w; w.x = pk2(y[0], y[1]); w.y = pk2(y[2], y[3]); w.z = pk2(y[4], y[5]); w.w = pk2(y[6], y[7]); o16[64 * j] = w; } }
#pragma unroll
            for (int j = 0; j < 4; ++j) wc[j] = wn[j];
            m = mn;
        }
        return;
    }
    for (int m = F.gw; m < M; m += F.NGW) {
        const int b = m / SEQ;
        float x[4][8]; float s = 0.f;
        if constexpr (IN16) {
            const GAS v4u* xr = (const GAS v4u*)((const bf16*)xin + (size_t)m * DM) + F.lane;
            v4u w[4];
#pragma unroll
            for (int j = 0; j < 4; ++j) w[j] = xr[64 * j];
#pragma unroll
            for (int j = 0; j < 4; ++j) { x[j][0] = bf_lo(w[j].x); x[j][1] = bf_hi(w[j].x); x[j][2] = bf_lo(w[j].y); x[j][3] = bf_hi(w[j].y); x[j][4] = bf_lo(w[j].z); x[j][5] = bf_hi(w[j].z); x[j][6] = bf_lo(w[j].w); x[j][7] = bf_hi(w[j].w); }
        } else {
            const GAS f32x4* xr = (const GAS f32x4*)((const float*)xin + (size_t)m * DM) + 2 * F.lane;
            f32x4 a[4][2];
#pragma unroll
            for (int j = 0; j < 4; ++j) { a[j][0] = xr[128 * j]; a[j][1] = xr[128 * j + 1]; }
            GAS v4u* xo = (GAS v4u*)(F.XB + (size_t)m * DM) + F.lane;
#pragma unroll
            for (int j = 0; j < 4; ++j) { x[j][0] = a[j][0].x; x[j][1] = a[j][0].y; x[j][2] = a[j][0].z; x[j][3] = a[j][0].w; x[j][4] = a[j][1].x; x[j][5] = a[j][1].y; x[j][6] = a[j][1].z; x[j][7] = a[j][1].w;
                v4u w; w.x = pk2(x[j][0], x[j][1]); w.y = pk2(x[j][2], x[j][3]); w.z = pk2(x[j][4], x[j][5]); w.w = pk2(x[j][6], x[j][7]); xo[64 * j] = w; }
        }
#pragma unroll
        for (int j = 0; j < 4; ++j) s += ((x[j][0] * x[j][0] + x[j][1] * x[j][1]) + (x[j][2] * x[j][2] + x[j][3] * x[j][3])) + ((x[j][4] * x[j][4] + x[j][5] * x[j][5]) + (x[j][6] * x[j][6] + x[j][7] * x[j][7]));
        const float rstd = 1.0f / sqrtf(wave_sum(s) * (1.f / DM) + RMS_EPS);
        const GAS f32x4* gp = (const GAS f32x4*)g + 2 * F.lane; const GAS f32x4* sh = (const GAS f32x4*)(shift + (size_t)b * NMOD) + 2 * F.lane; const GAS f32x4* sc = (const GAS f32x4*)(scale + (size_t)b * NMOD) + 2 * F.lane;
        GAS v4u* o16 = (GAS v4u*)(F.H + (size_t)m * DM) + F.lane;
        GAS v2u* o8 = (GAS v2u*)((unsigned char*)F.H + (size_t)m * DM) + F.lane;
#pragma unroll
        for (int j = 0; j < 4; ++j) { float y[8];
#pragma unroll
            for (int h = 0; h < 2; ++h) { const f32x4 gg = gp[128 * j + h], ss = sc[128 * j + h], hh = sh[128 * j + h];
                y[4 * h + 0] = x[j][4 * h + 0] * rstd * gg.x * (ss.x + 1.0f) + hh.x; y[4 * h + 1] = x[j][4 * h + 1] * rstd * gg.y * (ss.y + 1.0f) + hh.y;
                y[4 * h + 2] = x[j][4 * h + 2] * rstd * gg.z * (ss.z + 1.0f) + hh.z; y[4 * h + 3] = x[j][4 * h + 3] * rstd * gg.w * (ss.w + 1.0f) + hh.w; }
            if (OUT8) { v2u w; w.x = pk_fp8x4(y[0], y[1], y[2], y[3]); w.y = pk_fp8x4(y[4], y[5], y[6], y[7]); o8[64 * j] = w; }
            else { v4u w; w.x = pk2(y[0], y[1]); w.y = pk2(y[2], y[3]); w.z = pk2(y[4], y[5]); w.w = pk2(y[6], y[7]); o16[64 * j] = w; } }
    }
}
__device__ __forceinline__ v4u headnorm8(v4u w, const float* g, float mul, int lane, bool normalize) {
    float x[8] = {bf_lo(w.x), bf_hi(w.x), bf_lo(w.y), bf_hi(w.y), bf_lo(w.z), bf_hi(w.z), bf_lo(w.w), bf_hi(w.w)};
    float r = mul;
    if (normalize) {
        float s = 0.f;
#pragma unroll
        for (int i = 0; i < 8; ++i) s += x[i] * x[i];
        s += __shfl_xor(s, 1); s += __shfl_xor(s, 2); s += __shfl_xor(s, 4);
        r = mul / sqrtf(s * (1.f / 64.f) + RMS_EPS);
        const f32x4 g0 = *(const GAS f32x4*)(g + 8 * (lane & 7)), g1 = *(const GAS f32x4*)(g + 8 * (lane & 7) + 4);
        x[0] *= g0.x; x[1] *= g0.y; x[2] *= g0.z; x[3] *= g0.w; x[4] *= g1.x; x[5] *= g1.y; x[6] *= g1.z; x[7] *= g1.w;
    }
    w.x = pk2(x[0] * r, x[1] * r); w.y = pk2(x[2] * r, x[3] * r); w.z = pk2(x[4] * r, x[5] * r); w.w = pk2(x[6] * r, x[7] * r);
    return w;
}
__device__ __forceinline__ v4u headnorm8g(v4u w, f32x4 g0, f32x4 g1, float mul, bool normalize) {
    float x[8] = {bf_lo(w.x), bf_hi(w.x), bf_lo(w.y), bf_hi(w.y), bf_lo(w.z), bf_hi(w.z), bf_lo(w.w), bf_hi(w.w)};
    float r = mul;
    if (normalize) {
        float s = 0.f;
#pragma unroll
        for (int i = 0; i < 8; ++i) s += x[i] * x[i];
        s += __shfl_xor(s, 1); s += __shfl_xor(s, 2); s += __shfl_xor(s, 4);
        r = mul / sqrtf(s * (1.f / 64.f) + RMS_EPS);
        x[0] *= g0.x; x[1] *= g0.y; x[2] *= g0.z; x[3] *= g0.w; x[4] *= g1.x; x[5] *= g1.y; x[6] *= g1.z; x[7] *= g1.w;
    }
    w.x = pk2(x[0] * r, x[1] * r); w.y = pk2(x[2] * r, x[3] * r); w.z = pk2(x[4] * r, x[5] * r); w.w = pk2(x[6] * r, x[7] * r);
    return w;
}
__device__ __forceinline__ void ph_post(const Frame& F, int l) {
    const float* qg = F.qk_g + (size_t)l * 6 * HD; const int lane = F.lane;
    f32x4 gq[6][2];
    { const int gi[5] = {0, 2, 4, 5, (lane < 8 ? 1 : 3)};
#pragma unroll
      for (int i = 0; i < 5; ++i) { const float* gp = qg + gi[i] * HD + 8 * (lane & 7); gq[i][0] = *(const GAS f32x4*)gp; gq[i][1] = *(const GAS f32x4*)(gp + 4); } }
    const int koff = (lane < 8 ? PA_K : PB_K) + 8 * (lane & 7);
    int m = F.gw;
    v4u wc[6];
#define POST_LOAD(mm_, W) do { const bf16* row_ = F.P + (size_t)(mm_) * NIN; W[0] = *(const GAS v4u*)(row_ + PA_Q + 8 * lane); W[1] = *(const GAS v4u*)(row_ + PB_Q + 8 * lane); W[2] = *(const GAS v4u*)(row_ + PC_Q + 8 * lane); \
        W[3] = *(const GAS v4u*)(row_ + PC_K + 8 * lane); W[4] = *(const GAS v4u*)(row_ + PD_Q + 8 * lane); W[5] = (v4u){0u, 0u, 0u, 0u}; if (lane < 16) W[5] = *(const GAS v4u*)(row_ + koff); } while (0)
    if (m < M) POST_LOAD(m, wc);
    while (m < M) {
        const int mn = m + F.NGW;
        v4u wn[6];
        if (mn < M) POST_LOAD(mn, wn);
        else {
#pragma unroll
            for (int i = 0; i < 6; ++i) wn[i] = (v4u){0u, 0u, 0u, 0u}; }
        bf16* row = F.P + (size_t)m * NIN;
        *(GAS v4u*)(row + PA_Q + 8 * lane) = headnorm8g(wc[0], gq[0][0], gq[0][1], QSCALE, true);
        *(GAS v4u*)(row + PB_Q + 8 * lane) = headnorm8g(wc[1], gq[1][0], gq[1][1], QSCALE, true);
        *(GAS v4u*)(row + PC_Q + 8 * lane) = headnorm8g(wc[2], gq[2][0], gq[2][1], QSCALE, true);
        *(GAS v4u*)(row + PC_K + 8 * lane) = headnorm8g(wc[3], gq[3][0], gq[3][1], 1.0f, true);
        *(GAS v4u*)(row + PD_Q + 8 * lane) = headnorm8g(wc[4], gq[0][0], gq[0][1], QSCALE, false);
        if (lane < 16) *(GAS v4u*)(row + koff) = headnorm8g(wc[5], gq[4][0], gq[4][1], 1.0f, true);
#pragma unroll
        for (int i = 0; i < 6; ++i) wc[i] = wn[i];
        m = mn;
    }
#undef POST_LOAD
}
__device__ __forceinline__ void ph_scan(const Frame& F, int l) {
    LAS float* wtot = (LAS float*)(F.lds + RING_OFF);
    for (int sq = blockIdx.x; sq < BATCH * NH; sq += F.G) {
        const int b = sq / NH, h = sq % NH; const float fb = F.forget_b[(size_t)l * NH + h];
        const GAS unsigned short* src = (const GAS unsigned short*)(F.P + ((size_t)b * SEQ + 16 * F.tid) * NIN + PC_F + h); float* dst = F.KB2 + (size_t)sq * SEQ + 16 * F.tid;
        float v[16]; unsigned short raw[16];
#pragma unroll
        for (int i = 0; i < 16; ++i) raw[i] = src[(size_t)i * NIN];
#pragma unroll
        for (int i = 0; i < 16; ++i) { const float y = __builtin_bit_cast(float, (unsigned)raw[i] << 16) + fb; v[i] = (y >= 0.f) ? -log1pf(__expf(-y)) : (y - log1pf(__expf(y))); }
#pragma unroll
        for (int i = 1; i < 16; ++i) v[i] += v[i - 1];
        float incl = v[15];
#pragma unroll
        for (int o = 1; o < 64; o <<= 1) { const float t = __shfl_up(incl, o); if (F.lane >= o) incl += t; }
        if (F.lane == 63) wtot[F.wave] = incl;
        __syncthreads();
        float base = incl - v[15];
        for (int w = 0; w < F.wave; ++w) base += wtot[w];
#pragma unroll
        for (int i = 0; i < 4; ++i) *(GAS f32x4*)(dst + 4 * i) = (f32x4){-(v[4 * i] + base) * LOG2E, -(v[4 * i + 1] + base) * LOG2E, -(v[4 * i + 2] + base) * LOG2E, -(v[4 * i + 3] + base) * LOG2E};
        __syncthreads();
    }
}
__device__ __forceinline__ void ph_gnorm(const Frame& F, int l) {
    const float* gg = F.group_g + (size_t)l * DM;
    f32x4 gv[4][2];
#pragma unroll
    for (int g = 0; g < 4; ++g) { gv[g][0] = *(const GAS f32x4*)(gg + g * GWID + 8 * F.lane); gv[g][1] = *(const GAS f32x4*)(gg + g * GWID + 8 * F.lane + 4); }
    int m = F.gw;
    v4u wc[4];
    if (m < M) {
#pragma unroll
        for (int g = 0; g < 4; ++g) wc[g] = *(GAS v4u*)(F.Y + (size_t)m * DM + g * GWID + 8 * F.lane); }
    while (m < M) {
        const int mn = m + F.NGW;
        v4u wn[4];
        if (mn < M) {
#pragma unroll
            for (int g = 0; g < 4; ++g) wn[g] = *(GAS v4u*)(F.Y + (size_t)mn * DM + g * GWID + 8 * F.lane); }
        else {
#pragma unroll
            for (int g = 0; g < 4; ++g) wn[g] = (v4u){0u, 0u, 0u, 0u}; }
#pragma unroll
        for (int g = 0; g < 4; ++g) {
            bf16* p = F.Y + (size_t)m * DM + g * GWID + 8 * F.lane;
            float x[8] = {bf_lo(wc[g].x), bf_hi(wc[g].x), bf_lo(wc[g].y), bf_hi(wc[g].y), bf_lo(wc[g].z), bf_hi(wc[g].z), bf_lo(wc[g].w), bf_hi(wc[g].w)};
            float s = 0.f;
#pragma unroll
            for (int i = 0; i < 8; ++i) s += x[i] * x[i];
            const float r = 1.0f / sqrtf(wave_sum(s) * (1.f / GWID) + RMS_EPS);
            const f32x4 g0 = gv[g][0], g1 = gv[g][1];
            v4u o; o.x = pk2(x[0] * r * g0.x, x[1] * r * g0.y); o.y = pk2(x[2] * r * g0.z, x[3] * r * g0.w); o.z = pk2(x[4] * r * g1.x, x[5] * r * g1.y); o.w = pk2(x[6] * r * g1.z, x[7] * r * g1.w);
            *(GAS v4u*)p = o;
        }
#pragma unroll
        for (int g = 0; g < 4; ++g) wc[g] = wn[g];
        m = mn;
    }
}


__device__ __forceinline__ unsigned short score_key(float sc) {
    const _Float16 hf = (_Float16)fminf(fmaxf(sc, -60000.f), 60000.f);
    const unsigned h = (unsigned)__builtin_bit_cast(unsigned short, hf);
    return (unsigned short)((h & 0x8000u) ? (~h & 0xffffu) : (h | 0x8000u));
}
__device__ __forceinline__ void glds16x(const void* gsrc, unsigned lds_dst) { unsigned keep;
    asm volatile("s_mov_b32 %0, m0\n\ts_mov_b32 m0, %2\n\ts_nop 0\n\tglobal_load_lds_dwordx4 %1, off\n\ts_mov_b32 m0, %0" : "=&s"(keep) : "v"(gsrc), "s"(lds_dst) : "memory"); }
__device__ __forceinline__ void ph_idx_scores(const Frame& F) {
    constexpr int UPB = 8 * (16 * 17 / 2), NU = BATCH * UPB;
    const int lane = F.lane, r32 = lane & 31, hi = lane >> 5;
    const int u_lo = (int)(((long)blockIdx.x * NU) / F.G), u_hi = (int)(((long)(blockIdx.x + 1) * NU) / F.G);
    if (u_lo >= u_hi) return;
    int b = u_lo / UPB, qb = 127, kc = 0; { int r = u_lo % UPB; for (;;) { const int n = (qb >> 3) + 1; if (r < n) { kc = r; break; } r -= n; --qb; } }
    LAS unsigned char* KL = F.lds + RING_OFF;
    const unsigned kl_lds = (unsigned)(size_t)KL;
#define X1_STAGE(bb, kk, buf) do { const bf16* ksrc_ = F.P + ((size_t)(bb) * SEQ + 512 * (kk) + 64 * F.wave + lane) * NIN + PA_IK; \
        _Pragma("unroll") for (int c_ = 0; c_ < 8; ++c_) glds16x(ksrc_ + 8 * c_, (unsigned)__builtin_amdgcn_readfirstlane(kl_lds + (buf) * 65536 + c_ * 8192 + F.wave * 1024)); } while (0)
    X1_STAGE(b, kc, 0);
    asm volatile("s_waitcnt vmcnt(0)" ::: "memory"); __syncthreads();
    bf16x8 af[4][4]; float wq[4][16]; int cb = -1, cqb = -1;
    for (int u = u_lo; u < u_hi; ++u) {
        const int cur = (u - u_lo) & 1;
        int nb = b, nqb = qb, nkc = kc + 1; if (nkc > (qb >> 3)) { nkc = 0; --nqb; if (nqb < 0) { nqb = 127; ++nb; } }
        if (u + 1 < u_hi) X1_STAGE(nb, nkc, cur ^ 1);
        const size_t rowb = (size_t)b * SEQ; const int t0 = 64 * qb + 8 * F.wave;
        if (b != cb || qb != cqb) { cb = b; cqb = qb;
#pragma unroll
            for (int pr = 0; pr < 4; ++pr) {
                const bf16* qrow = F.P + (rowb + t0 + 2 * pr + ((r32 >> 2) & 1)) * NIN + PA_IQ + ((r32 & 3) + 4 * (r32 >> 3)) * 64 + 8 * hi;
#pragma unroll
                for (int s = 0; s < 4; ++s) af[pr][s] = *(const GAS bf16x8*)(qrow + 16 * s);
                const bf16* wrow = F.P + (rowb + t0 + 2 * pr + hi) * NIN + PA_IW;
                const v4u w0 = *(const GAS v4u*)wrow, w1 = *(const GAS v4u*)(wrow + 8);
                const unsigned ww[8] = {w0.x, w0.y, w0.z, w0.w, w1.x, w1.y, w1.z, w1.w};
#pragma unroll
                for (int i = 0; i < 8; ++i) { wq[pr][2 * i] = bf_lo(ww[i]) * 0.015625f; wq[pr][2 * i + 1] = bf_hi(ww[i]) * 0.015625f; }
            }
        }
        const int kend = 64 * (qb + 1) - 512 * kc;
        const int nkt = kend >= 512 ? 16 : (kend + 31) / 32;
        const LAS unsigned char* kl = KL + cur * 65536 + hi * 8192 + r32 * 16;
        for (int kt = 0; kt < nkt; ++kt) {
            bf16x8 bfr[4];
#pragma unroll
            for (int s = 0; s < 4; ++s) bfr[s] = *(const LAS bf16x8*)(kl + s * 16384 + kt * 512);
            const int s0 = 512 * kc + 32 * kt;
#pragma unroll
            for (int pr = 0; pr < 4; ++pr) {
                f32x16 acc = {};
#pragma unroll
                for (int s = 0; s < 4; ++s) acc = __builtin_amdgcn_mfma_f32_32x32x16_bf16(af[pr][s], bfr[s], acc, 0, 0, 0);
                float sc0 = 0.f, sc1 = 0.f;
#pragma unroll
                for (int r = 0; r < 16; ++r) { sc0 = __builtin_fmaf(wq[pr][r], acc[r], sc0); sc1 = __builtin_fmaf(wq[pr][r], __builtin_fabsf(acc[r]), sc1); if ((r & 3) == 3) asm("" : "+v"(sc1)); }
                ((GAS unsigned short*)F.SC)[(rowb + t0 + 2 * pr + hi) * SEQ + s0 + r32] = score_key(sc0 + sc1);
                __builtin_amdgcn_sched_barrier(0);
            }
        }
        asm volatile("s_waitcnt vmcnt(0)" ::: "memory");
        __syncthreads();
        b = nb; qb = nqb; kc = nkc;
    }
#undef X1_STAGE
}

__device__ __forceinline__ unsigned mbcnt64(unsigned long long m) { return __builtin_amdgcn_mbcnt_hi((unsigned)(m >> 32), __builtin_amdgcn_mbcnt_lo((unsigned)m, 0u)); }
template <int SH, int PSH> __device__ __forceinline__ void sel_level(const unsigned (&v)[64], int nreg, unsigned pval, unsigned need, LAS unsigned* hist, int lane, unsigned& bin_out, unsigned& above_out) {
#pragma unroll
    for (int i = 0; i < 8; ++i) ((LAS v4u*)hist)[lane + 64 * i] = (v4u){0u, 0u, 0u, 0u};
    LDS_WAIT(); __builtin_amdgcn_wave_barrier();
    const unsigned hb = (unsigned)(size_t)hist, sink = hb + 9216u + 4u * (unsigned)lane;
#pragma unroll
    for (int g = 0; g < 8; ++g) if (8 * g < nreg) {
#pragma unroll
        for (int jj = 0; jj < 8; ++jj) { const int j = 8 * g + jj;
#pragma unroll
            for (int e = 0; e < 2; ++e) { const unsigned k = e ? (v[j] >> 16) : (v[j] & 0xffffu);
                const bool pred = (k != 0u) && (PSH >= 16 || (k >> (PSH & 15)) == pval);
                const unsigned tgt = pred ? hb + (((k >> SH) & 2047u) << 2) : sink;
                __hip_atomic_fetch_add((LAS unsigned*)tgt, 1u, __ATOMIC_RELAXED, __HIP_MEMORY_SCOPE_WAVEFRONT); }
            if ((jj & 1) == 1) __builtin_amdgcn_sched_barrier(0); }
    }
    LDS_WAIT(); __builtin_amdgcn_wave_barrier();
    unsigned S = 0u;
#pragma unroll
    for (int i = 0; i < 8; ++i) { const v4u q = ((LAS v4u*)hist)[lane * 8 + i]; S += (q.x + q.y) + (q.z + q.w); }
    unsigned T = S;
#pragma unroll
    for (int o = 1; o < 64; o <<= 1) { const unsigned t = __shfl_down(T, o); if (lane + o < 64) T += t; }
    const unsigned above_lane = T - S;
    const bool cross = (T >= need) && (above_lane < need);
    unsigned run = above_lane, bin = 0u, ab = 0u; bool found = false;
#pragma unroll
    for (int i = 7; i >= 0; --i) { const v4u q = ((LAS v4u*)hist)[lane * 8 + i]; const unsigned c4[4] = {q.x, q.y, q.z, q.w};
#pragma unroll
        for (int e = 3; e >= 0; --e) { const bool hit = !found && (run + c4[e] >= need); if (hit) { bin = 32u * lane + 4 * i + e; ab = run; found = true; } run += c4[e]; } }
    const unsigned long long cm = __ballot(cross);
    const int src = cm ? (int)__builtin_ctzll(cm) : 0;
    bin_out = __builtin_amdgcn_readlane(bin, src); above_out = __builtin_amdgcn_readlane(ab, src);
    LDS_WAIT(); __builtin_amdgcn_wave_barrier();
}
__device__ __forceinline__ void select_row(const Frame& F, int m, LAS unsigned* hist, LAS int* out) {
    int lane = F.lane; asm volatile("" : "+v"(lane));
    const int t = m % SEQ, n = t + 1;
    if (n <= TOPK) { for (int j = lane; j < TOPK; j += 64) out[j] = (j < n) ? j : 0; return; }
    const int nreg = (n + 127) >> 7;
    unsigned v[64];
    const GAS unsigned* pr = (const GAS unsigned*)(F.SC + (size_t)m * SEQ) + lane;
#pragma unroll
    for (int g = 0; g < 8; ++g) {
        if (8 * g < nreg) {
#pragma unroll
            for (int jj = 0; jj < 8; ++jj) v[8 * g + jj] = pr[jj * 64];
        } else {
#pragma unroll
            for (int jj = 0; jj < 8; ++jj) v[8 * g + jj] = 0u;
        }
        pr += 512; asm volatile("" : "+v"(pr));
    }
    const int nfull = n >> 7;
#pragma unroll
    for (int g = 0; g < 8; ++g) if (8 * g < nreg && 8 * g + 8 > nfull) {
#pragma unroll
        for (int jj = 0; jj < 8; ++jj) { const int j = 8 * g + jj; const int e0 = 128 * j + 2 * lane; const unsigned w = v[j];
            v[j] = ((e0 < n) ? (w & 0xffffu) : 0u) | ((e0 + 1 < n) ? (w & 0xffff0000u) : 0u); asm volatile("" : "+v"(v[j])); }
    }
    unsigned b1, a1, b2, a2;
    sel_level<5, 16>(v, nreg, 0u, (unsigned)TOPK, hist, lane, b1, a1);
    sel_level<0, 5>(v, nreg, b1, (unsigned)TOPK - a1, hist, lane, b2, a2);
    const unsigned tau = (b1 << 5) | (b2 & 31u);
    const unsigned quota = (unsigned)TOPK - a1 - a2;
    unsigned mg[4] = {0u, 0u, 0u, 0u}, me[4] = {0u, 0u, 0u, 0u};
#pragma unroll
    for (int g = 0; g < 8; ++g) {
        if (8 * g < nreg) {
#pragma unroll
            for (int jj = 0; jj < 8; ++jj) { const int j = 8 * g + jj;
#pragma unroll
                for (int e = 0; e < 2; ++e) { const unsigned k = e ? (v[j] >> 16) : (v[j] & 0xffffu);
                    mg[g >> 1] = mg[g >> 1] + mg[g >> 1] + ((k > tau) ? 1u : 0u); me[g >> 1] = me[g >> 1] + me[g >> 1] + ((k == tau) ? 1u : 0u); }
                if ((jj & 3) == 3) __builtin_amdgcn_sched_barrier(0); }
        } else { mg[g >> 1] <<= 16; me[g >> 1] <<= 16; }
    }
    const unsigned cg = (unsigned)(__builtin_popcount(mg[0]) + __builtin_popcount(mg[1]) + __builtin_popcount(mg[2]) + __builtin_popcount(mg[3]));
    unsigned ce = (unsigned)(__builtin_popcount(me[0]) + __builtin_popcount(me[1]) + __builtin_popcount(me[2]) + __builtin_popcount(me[3]));
    unsigned incl = cg | (ce << 16);
#pragma unroll
    for (int o = 1; o < 64; o <<= 1) { const unsigned t = (unsigned)__shfl_up((int)incl, o); if (lane >= o) incl += t; }
    const unsigned excl = incl - (cg | (ce << 16));
    const unsigned pre_g = excl & 0xffffu, pre_e = excl >> 16;
    const unsigned keep = pre_e >= quota ? 0u : ((quota - pre_e) < ce ? (quota - pre_e) : ce);
#pragma unroll
    for (int q = 3; q >= 0; --q) { while (ce > keep && me[q] != 0u) { me[q] &= me[q] - 1u; --ce; } }
    unsigned pos = pre_g + (pre_e < quota ? pre_e : quota);
    const int ilane = 2 * lane;
#pragma unroll
    for (int q = 0; q < 4; ++q) { unsigned mm = mg[q] | me[q];
        while (mm != 0u) { const int bpos = 31 - (int)__builtin_clz(mm); const int sl = 31 - bpos; mm &= ~(1u << bpos);
            const int i = 128 * (16 * q + (sl >> 1)) + ilane + (sl & 1);
            if (pos < (unsigned)TOPK) out[pos] = i;
            ++pos; } }
}


constexpr int AT_K = 0, AT_V = 16384, AT_KB = 32768, AT_WSF = 33280, AT_BT = 35328, AT_DEAD = 35840, AT_SV = 36864;
typedef short v4i16_t __attribute__((ext_vector_type(4)));
__device__ __forceinline__ s16x4 vtr(const LAS unsigned char* p) { return __builtin_bit_cast(s16x4, __builtin_amdgcn_ds_read_tr16_b64_v4i16((LAS v4i16_t*)p)); }
typedef __bf16 bfpair_t __attribute__((ext_vector_type(2))); typedef float f32pair_t __attribute__((ext_vector_type(2)));
__device__ __forceinline__ unsigned cvtpk(float lo, float hi) { const f32pair_t v = {lo, hi}; return __builtin_bit_cast(unsigned, __builtin_convertvector(v, bfpair_t)); }
#define NEG_INF (-__builtin_inff())

template <int TYPE>
__device__ __forceinline__ void dense_attn_unit(const Frame& F, int l, int b, int h, int qb) {
    constexpr int QOFF = TYPE == 1 ? PB_Q : TYPE == 2 ? PC_Q : PD_Q, KOFF = TYPE == 1 ? PB_K : TYPE == 2 ? PC_K : PD_K, VOFF = TYPE == 1 ? PB_V : TYPE == 2 ? PC_V : PD_V;
    constexpr bool MQA = TYPE == 1; constexpr int YOFF = TYPE * GWID;
    const int tid = F.tid, lane = F.lane, wid = F.wave, r32 = lane & 31, hi = lane >> 5;
    LAS unsigned char* L = F.lds + RING_OFF;
    LAS float* wsf = (LAS float*)(L + AT_WSF + wid * 256);
    LAS float* BT = (LAS float*)(L + AT_BT);
    const int hq = (TYPE == 1) ? wid : h, qoff = (TYPE == 1) ? (qb & 7) * 32 : wid * 32, qb256 = (TYPE == 1) ? (qb >> 3) : qb;
    const size_t rowb = (size_t)b * SEQ; const int q0 = qb256 * 256;
    const bf16* Pk = F.P + rowb * NIN + KOFF + (MQA ? 0 : h * 64);
    const bf16* Pv = F.P + rowb * NIN + VOFF + (MQA ? 0 : h * 64);
    const bf16* Pq = F.P + (rowb + q0 + qoff + r32) * NIN + QOFF + hq * 64 + hi * 8;
    bf16x8 qr[4];
#pragma unroll
    for (int d0 = 0; d0 < 4; ++d0) qr[d0] = *(const GAS bf16x8*)(Pq + 16 * d0);
    const int jt_hi = (TYPE == 1) ? ((q0 + qoff + 31) >> 6) : 4 * qb256 + 3, jt_lo = (TYPE == 1) ? (((q0 + qoff - (WINDOW - 1)) > 0 ? (q0 + qoff - (WINDOW - 1)) : 0) >> 6) : 0, nt = jt_hi - jt_lo + 1;
    if (TYPE == 1) { LAS float* BTall = (LAS float*)(L + AT_SV);
        for (int i = tid; i < 8 * 128; i += NTHREADS) BTall[i] = F.rel_table[(int)kBucketLut[i & 127] * 16 + 8 + (i >> 7)] * LOG2E;
        BT = BTall + 128 * wid; }
    const bf16* kgp = Pk + (size_t)(8 * wid + (lane >> 3)) * NIN + (lane & 7) * 8;
    const int vkey = tid >> 3, vch = tid & 7;
    const bf16* vgp = Pv + (size_t)vkey * NIN + vch * 8;
    const int kl = (lane & 7) * 1024 + (8 * wid + (lane >> 3)) * 16;
    const int vl = (vch >> 2) * 4096 + (vkey >> 3) * 512 + (vkey & 7) * 64 + (vch & 3) * 16;
    const float* kb2 = F.KB2 + ((size_t)b * NH + h) * SEQ;
    v4u kreg = *(const GAS v4u*)(kgp + (size_t)jt_hi * 64 * NIN), vreg = *(const GAS v4u*)(vgp + (size_t)jt_hi * 64 * NIN);
    float kbreg = 0.f; if (TYPE == 2 && tid < 64) kbreg = kb2[jt_hi * 64 + tid];
    *(LAS v4u*)(L + AT_K + kl) = kreg; *(LAS v4u*)(L + AT_V + vl) = vreg; if (TYPE == 2 && tid < 64) ((LAS float*)(L + AT_KB))[tid] = kbreg;
    __syncthreads();
    f32x16 o[2]; o[0] = f32x16{}; o[1] = f32x16{};
    float mrun = NEG_INF, lsum = 0.f, carry = 1.f;
    float qbound = 0.f;
    if (TYPE == 2) {
        float ss = 0.f;
#pragma unroll
        for (int d0 = 0; d0 < 4; ++d0)
#pragma unroll
            for (int j = 0; j < 8; ++j) { const float x = bf2f((bf16)qr[d0][j]); ss += x * x; }
        ss += __shfl_xor(ss, 32);
        float gm = fabsf(F.qk_g[((size_t)l * 6 + 5) * HD + lane]);
#pragma unroll
        for (int o = 1; o < 64; o <<= 1) gm = fmaxf(gm, __shfl_xor(gm, o));
        qbound = sqrtf(ss) * 8.08f * gm;
    }
    const int qrel = qoff + r32;
    const int vb = ((lane >> 4) & 1) * 32 + (lane & 3) * 8 + (4 * hi + ((lane & 15) >> 2)) * 64;
    LAS unsigned* deadf = (LAS unsigned*)(L + AT_DEAD);
    for (int i = 0; i < nt; ++i) {
        const int jt = jt_hi - i, cur = i & 1, jb = jt - 4 * qb256; const bool more = (i + 1 < nt);
        float kbnext = 0.f;
        if (more) { kreg = *(const GAS v4u*)(kgp + (size_t)(jt - 1) * 64 * NIN); vreg = *(const GAS v4u*)(vgp + (size_t)(jt - 1) * 64 * NIN); if (TYPE == 2 && tid < 64) kbreg = kb2[(jt - 1) * 64 + tid]; if (TYPE == 2) kbnext = kb2[jt * 64 - 1]; }
        const bool active = (64 * jb <= qoff + 31) && (TYPE != 1 || (64 * jb + 63 >= qoff - (WINDOW - 1)));
        if (active) {
            const LAS unsigned char* Kb = L + AT_K + cur * 8192; const LAS unsigned char* Vb = L + AT_V + cur * 8192;
            f32x16 p0 = f32x16{}, p1 = f32x16{};
            bf16x8 ka[4], kc[4];
#pragma unroll
            for (int d0 = 0; d0 < 4; ++d0) { ka[d0] = *(const LAS bf16x8*)(Kb + (2 * d0 + hi) * 1024 + r32 * 16); kc[d0] = *(const LAS bf16x8*)(Kb + (2 * d0 + hi) * 1024 + 512 + r32 * 16); }
            __builtin_amdgcn_sched_barrier(0);
#pragma unroll
            for (int d0 = 0; d0 < 4; ++d0) { p0 = __builtin_amdgcn_mfma_f32_32x32x16_bf16(ka[d0], qr[d0], p0, 0, 0, 0); p1 = __builtin_amdgcn_mfma_f32_32x32x16_bf16(kc[d0], qr[d0], p1, 0, 0, 0); }
            bf16x8 vfr[2][4];
#pragma unroll
            for (int d0 = 0; d0 < 2; ++d0)
#pragma unroll
                for (int ks = 0; ks < 4; ++ks) { const s16x4 lo = vtr(Vb + vb + d0 * 4096 + ks * 1024), hh = vtr(Vb + vb + d0 * 4096 + ks * 1024 + 512);
                    vfr[d0][ks] = (bf16x8){lo[0], lo[1], lo[2], lo[3], hh[0], hh[1], hh[2], hh[3]}; }
            __builtin_amdgcn_sched_barrier(0);
            bool live = true;
            const int kv0 = 64 * jb + 4 * hi;
            if (TYPE == 3) {
                float b0[16], b1[16];
#pragma unroll
                for (int r = 0; r < 16; ++r) { const int kv = kv0 + (r & 3) + 8 * (r >> 2);
                    const float e0 = fexp2(fminf(p0[r], 80.f)), e1 = fexp2(fminf(p1[r], 80.f));
                    const float m0 = frcp(1.0f + e0), m1 = frcp(1.0f + e1);
                    const bool ok0 = kv < qrel, ok1 = (kv + 32) < qrel;
                    b0[r] = ok0 ? e0 * m0 : 0.f; b1[r] = ok1 ? e1 * m1 : 0.f; p0[r] = ok0 ? m0 : 1.0f; p1[r] = ok1 ? m1 : 1.0f; }
                float gp[8], go[8], pp[8];
#pragma unroll
                for (int g = 0; g < 4; ++g) { gp[g] = (p0[4 * g] * p0[4 * g + 1]) * (p0[4 * g + 2] * p0[4 * g + 3]); gp[4 + g] = (p1[4 * g] * p1[4 * g + 1]) * (p1[4 * g + 2] * p1[4 * g + 3]); }
#pragma unroll
                for (int g = 0; g < 8; ++g) { const float oth = __shfl_xor(gp[g], 32); pp[g] = gp[g] * oth; go[g] = hi ? 1.0f : oth; }
                float sp = 1.0f;
#pragma unroll
                for (int g = 7; g >= 0; --g) { const float sg = sp * go[g] * carry;
                    if (g < 4) { const float c3 = p0[4 * g + 3], c2 = p0[4 * g + 2], c1 = p0[4 * g + 1];
                        p0[4 * g + 3] = b0[4 * g + 3] * sg; const float s2 = sg * c3; p0[4 * g + 2] = b0[4 * g + 2] * s2; const float s1 = s2 * c2; p0[4 * g + 1] = b0[4 * g + 1] * s1; p0[4 * g] = b0[4 * g] * (s1 * c1); }
                    else { const int q = g - 4; const float c3 = p1[4 * q + 3], c2 = p1[4 * q + 2], c1 = p1[4 * q + 1];
                        p1[4 * q + 3] = b1[4 * q + 3] * sg; const float s2 = sg * c3; p1[4 * q + 2] = b1[4 * q + 2] * s2; const float s1 = s2 * c2; p1[4 * q + 1] = b1[4 * q + 1] * s1; p1[4 * q] = b1[4 * q] * (s1 * c1); }
                    sp *= pp[g]; }
                carry *= sp;
            } else {
                if (TYPE == 2) {
                    const LAS f32x4* kbp = (const LAS f32x4*)(L + AT_KB + cur * 256);
#pragma unroll
                    for (int g = 0; g < 4; ++g) { const f32x4 a = kbp[2 * g + hi], c = kbp[8 + 2 * g + hi];
#pragma unroll
                        for (int e = 0; e < 4; ++e) { p0[4 * g + e] += a[e]; p1[4 * g + e] += c[e]; } }
                    if (jb >= 0) {
#pragma unroll
                        for (int r = 0; r < 16; ++r) { const int kv = kv0 + (r & 3) + 8 * (r >> 2); if (kv > qrel) p0[r] = NEG_INF; if (kv + 32 > qrel) p1[r] = NEG_INF; }
                    }
                } else {
#pragma unroll
                    for (int r = 0; r < 16; ++r) { const int d0_ = qrel - (kv0 + (r & 3) + 8 * (r >> 2)), d1_ = d0_ - 32;
                        const bool ok0 = (d0_ >= 0) && (d0_ < WINDOW), ok1 = (d1_ >= 0) && (d1_ < WINDOW);
                        const float t0 = BT[ok0 ? d0_ : 0], t1 = BT[ok1 ? d1_ : 0];
                        p0[r] = ok0 ? p0[r] + t0 : NEG_INF; p1[r] = ok1 ? p1[r] + t1 : NEG_INF; }
                }
                float rm = fmaxf(p0[0], p1[0]);
#pragma unroll
                for (int r = 1; r < 16; ++r) rm = fmaxf(rm, fmaxf(p0[r], p1[r]));
                { auto rr = __builtin_amdgcn_permlane32_swap(__float_as_uint(rm), __float_as_uint(rm), false, false); rm = fmaxf(__uint_as_float(rr[0]), __uint_as_float(rr[1])); }
                const float mn = fmaxf(mrun, rm);
                if (TYPE == 2) live = !__all(rm - mrun < -40.f);
                if (live) {
                if (__any(mn > mrun)) {
                    const float f = (mn > mrun) ? fexp2(mrun - mn) : 1.0f;
                    lsum *= f; mrun = mn;
                    if (hi == 0) wsf[r32] = f;
                    LDS_WAIT(); __builtin_amdgcn_wave_barrier();
#pragma unroll
                    for (int g = 0; g < 4; ++g) { const f32x4 fv = ((const LAS f32x4*)wsf)[2 * g + hi];
#pragma unroll
                        for (int e = 0; e < 4; ++e) { o[0][4 * g + e] *= fv[e]; o[1][4 * g + e] *= fv[e]; } }
                    LDS_WAIT(); __builtin_amdgcn_wave_barrier();
                }
                const float ms = (mrun == NEG_INF) ? 0.f : mrun;
                float ps = 0.f;
#pragma unroll
                for (int r = 0; r < 16; ++r) { p0[r] = fexp2(p0[r] - ms); p1[r] = fexp2(p1[r] - ms); ps += p0[r] + p1[r]; }
                lsum += ps;
                }
            }
            if (live) {
            bf16x8 pa[4];
#pragma unroll
            for (int ks = 0; ks < 4; ++ks) { v4u w;
                if (ks < 2) { w.x = cvtpk(p0[8 * ks], p0[8 * ks + 1]); w.y = cvtpk(p0[8 * ks + 2], p0[8 * ks + 3]); w.z = cvtpk(p0[8 * ks + 4], p0[8 * ks + 5]); w.w = cvtpk(p0[8 * ks + 6], p0[8 * ks + 7]); }
                else { const int k2 = ks - 2; w.x = cvtpk(p1[8 * k2], p1[8 * k2 + 1]); w.y = cvtpk(p1[8 * k2 + 2], p1[8 * k2 + 3]); w.z = cvtpk(p1[8 * k2 + 4], p1[8 * k2 + 5]); w.w = cvtpk(p1[8 * k2 + 6], p1[8 * k2 + 7]); }
                pa[ks] = __builtin_bit_cast(bf16x8, w); }
#pragma unroll
            for (int d0 = 0; d0 < 2; ++d0)
#pragma unroll
                for (int ks = 0; ks < 4; ++ks) o[d0] = __builtin_amdgcn_mfma_f32_32x32x16_bf16(pa[ks], vfr[d0][ks], o[d0], 0, 0, 0);
            }
        }
        if (TYPE == 2) {
            bool wdead = false;
            if (active && more) wdead = __all(qbound + kbnext - mrun < -40.f);
            if (lane == 0) deadf[cur * 8 + wid] = wdead ? 1u : 0u; }
        if (TYPE == 3) { const bool wdead = active && __all(carry < 2.3e-10f);
            if (lane == 0) deadf[cur * 8 + wid] = wdead ? 1u : 0u; }
        if (more) { *(LAS v4u*)(L + AT_K + (cur ^ 1) * 8192 + kl) = kreg; *(LAS v4u*)(L + AT_V + (cur ^ 1) * 8192 + vl) = vreg; if (TYPE == 2 && tid < 64) ((LAS float*)(L + AT_KB + (cur ^ 1) * 256))[tid] = kbreg; }
        __syncthreads();
        if (TYPE >= 2) { const v4u d0 = *(const LAS v4u*)(deadf + cur * 8), d1 = *(const LAS v4u*)(deadf + cur * 8 + 4);
            if ((d0.x & d0.y & d0.z & d0.w & d1.x & d1.y & d1.z & d1.w) != 0u) break; }
    }
    float inv[16];
    if (TYPE != 3) {
        { auto rr = __builtin_amdgcn_permlane32_swap(__float_as_uint(lsum), __float_as_uint(lsum), false, false); lsum = __uint_as_float(rr[0]) + __uint_as_float(rr[1]); }
        if (TYPE == 1) lsum += fexp2(F.sinks[l * NH + hq] * LOG2E - mrun);
        const float il = 1.0f / lsum;
        if (hi == 0) wsf[r32] = il;
        LDS_WAIT(); __builtin_amdgcn_wave_barrier();
#pragma unroll
        for (int g = 0; g < 4; ++g) { const f32x4 fv = ((const LAS f32x4*)wsf)[2 * g + hi]; inv[4 * g] = fv[0]; inv[4 * g + 1] = fv[1]; inv[4 * g + 2] = fv[2]; inv[4 * g + 3] = fv[3]; }
        LDS_WAIT(); __builtin_amdgcn_wave_barrier();
    } else {
#pragma unroll
        for (int r = 0; r < 16; ++r) inv[r] = 1.0f;
    }
    unsigned short gte[2][16];
    if (TYPE == 2) {
#pragma unroll
        for (int d0 = 0; d0 < 2; ++d0)
#pragma unroll
            for (int r = 0; r < 16; ++r) { const int q = (r & 3) + 8 * (r >> 2) + 4 * hi; const size_t mrow = rowb + q0 + qoff + q; gte[d0][r] = ((const GAS unsigned short*)F.P)[mrow * NIN + PC_G + hq * 64 + 32 * d0 + r32]; }
    }
#pragma unroll
    for (int d0 = 0; d0 < 2; ++d0)
#pragma unroll
        for (int r = 0; r < 16; ++r) { const int q = (r & 3) + 8 * (r >> 2) + 4 * hi; const size_t mrow = rowb + q0 + qoff + q; const int col = hq * 64 + 32 * d0 + r32;
            float val = o[d0][r] * inv[r];
            if (TYPE == 2) val *= frcp(1.0f + fexp2(-LOG2E * __builtin_bit_cast(float, (unsigned)gte[d0][r] << 16)));
            F.Y[mrow * DM + YOFF + col] = (bf16)f2bf(val); }
}

__device__ __forceinline__ void sparse_attn_query(const Frame& F, int m, LAS unsigned char* vch, const LAS float* TBA, const LAS int* idx) {
    int lane = F.lane; asm volatile("" : "+v"(lane));
    const int hh = lane & 15, kg = lane >> 4, t = m % SEQ, b = m / SEQ;
    const size_t rowb = (size_t)b * SEQ;
    const int nsel = (t + 1) < TOPK ? (t + 1) : TOPK, nch = (nsel + 63) >> 6;
    const bf16* qp = F.P + (size_t)m * NIN + PA_Q + (hh & 7) * 64 + 8 * kg;
    const bf16x8 qf0 = *(const GAS bf16x8*)qp, qf1 = *(const GAS bf16x8*)(qp + 32);
    float s[4][4][4];
#pragma unroll
    for (int cp = 0; cp < 2; ++cp) {
        if (2 * cp < nch) {
            bf16x8 kf[8][2];
#pragma unroll
            for (int bb = 0; bb < 8; ++bb) { const int keyA = idx[128 * cp + 16 * bb + hh];
                const bf16* kp = F.P + (rowb + keyA) * NIN + PA_K + 8 * kg;
                kf[bb][0] = *(const GAS bf16x8*)kp; kf[bb][1] = *(const GAS bf16x8*)(kp + 32); }
            __builtin_amdgcn_sched_barrier(0);
#pragma unroll
            for (int bb = 0; bb < 8; ++bb) { const int c = 2 * cp + (bb >> 2), blk = bb & 3, j0 = 64 * c + 16 * blk;
                f32x4 acc = {0.f, 0.f, 0.f, 0.f};
                acc = __builtin_amdgcn_mfma_f32_16x16x32_bf16(kf[bb][0], qf0, acc, 0, 0, 0); acc = __builtin_amdgcn_mfma_f32_16x16x32_bf16(kf[bb][1], qf1, acc, 0, 0, 0);
                const v4i id4 = *(const LAS v4i*)(idx + j0 + 4 * kg);
#pragma unroll
                for (int r = 0; r < 4; ++r) { const int j = j0 + 4 * kg + r; int dist = t - id4[r]; dist = dist < 0 ? 0 : (dist > 128 ? 128 : dist);
                    const float bias = TBA[dist * 8 + (hh & 7)];
                    s[c][blk][r] = (j < nsel) ? acc[r] + bias : NEG_INF; }
            }
        } else {
#pragma unroll
            for (int c = 2 * cp; c < 2 * cp + 2; ++c)
#pragma unroll
                for (int blk = 0; blk < 4; ++blk)
#pragma unroll
                    for (int r = 0; r < 4; ++r) s[c][blk][r] = NEG_INF;
        }
    }
    v4u xv[2][8];
#define SP_VLOAD(c_, X) do { const int keyV_ = idx[64 * (c_) + lane]; const bf16* vp_ = F.P + (rowb + keyV_) * NIN + PA_V; \
        _Pragma("unroll") for (int i_ = 0; i_ < 8; ++i_) X[i_] = *(const GAS v4u*)(vp_ + 8 * i_); } while (0)
    SP_VLOAD(0, xv[0]);
    if (1 < nch) SP_VLOAD(1, xv[1]);
    __builtin_amdgcn_sched_barrier(0);
    float mx = NEG_INF;
#pragma unroll
    for (int c = 0; c < 4; ++c)
#pragma unroll
        for (int blk = 0; blk < 4; ++blk)
#pragma unroll
            for (int r = 0; r < 4; ++r) mx = fmaxf(mx, s[c][blk][r]);
    mx = fmaxf(mx, __shfl_xor(mx, 16)); mx = fmaxf(mx, __shfl_xor(mx, 32));
    float sum = 0.f;
#pragma unroll
    for (int c = 0; c < 4; ++c)
#pragma unroll
        for (int blk = 0; blk < 4; ++blk)
#pragma unroll
            for (int r = 0; r < 4; ++r) { const float p = fexp2(s[c][blk][r] - mx); s[c][blk][r] = p; sum += p; }
    sum += __shfl_xor(sum, 16); sum += __shfl_xor(sum, 32);
    const float inv = 1.0f / sum;
    f32x4 oacc[4];
#pragma unroll
    for (int d = 0; d < 4; ++d) oacc[d] = (f32x4){0.f, 0.f, 0.f, 0.f};
    const int q4 = (lane & 15) >> 2, p4 = lane & 3;
#pragma unroll
    for (int c = 0; c < 4; ++c) {
        if (c < nch) {
#pragma unroll
            for (int i = 0; i < 8; ++i) *(LAS v4u*)(vch + (i >> 2) * 4096 + lane * 64 + (i & 3) * 16) = xv[c & 1][i];
            LDS_WAIT(); __builtin_amdgcn_wave_barrier();
            if (c + 2 < nch) SP_VLOAD(c + 2, xv[c & 1]);
            __builtin_amdgcn_sched_barrier(0);
#pragma unroll
            for (int kp = 0; kp < 2; ++kp) { v4u w; w.x = cvtpk(s[c][2 * kp][0], s[c][2 * kp][1]); w.y = cvtpk(s[c][2 * kp][2], s[c][2 * kp][3]); w.z = cvtpk(s[c][2 * kp + 1][0], s[c][2 * kp + 1][1]); w.w = cvtpk(s[c][2 * kp + 1][2], s[c][2 * kp + 1][3]);
                const bf16x8 pf = __builtin_bit_cast(bf16x8, w);
#pragma unroll
                for (int d = 0; d < 4; ++d) { const LAS unsigned char* a = vch + (d >> 1) * 4096 + (32 * kp + 4 * kg + q4) * 64 + ((d & 1) * 16 + 4 * p4) * 2;
                    const s16x4 lo = vtr(a), hv = vtr(a + 16 * 64);
                    const bf16x8 vf = {lo[0], lo[1], lo[2], lo[3], hv[0], hv[1], hv[2], hv[3]};
                    oacc[d] = __builtin_amdgcn_mfma_f32_16x16x32_bf16(vf, pf, oacc[d], 0, 0, 0); } }
            LDS_WAIT(); __builtin_amdgcn_wave_barrier();
        }
    }
#undef SP_VLOAD
    if (hh < 8) {
#pragma unroll
        for (int d = 0; d < 4; ++d) { v2u w; w.x = pk2(oacc[d][0] * inv, oacc[d][1] * inv); w.y = pk2(oacc[d][2] * inv, oacc[d][3] * inv);
            *(GAS v2u*)(F.Y + (size_t)m * DM + hh * 64 + 16 * d + 4 * kg) = w; }
    }
}

constexpr int CW_QUEUE = 8192;
constexpr int MIX_ITEMS = 2560;
template <unsigned EN> __device__ __forceinline__ void ph_attention(const Frame& F, int l, int qsel = 0) {
    LAS float* TBA = (LAS float*)(F.lds + AUX_OFF);
    for (int i = F.tid; i < 129 * 8; i += NTHREADS) { const int d = i >> 3, hq = i & 7; const int bk = d < 128 ? (int)kBucketLut[d] : 31; TBA[i] = F.rel_table[bk * 16 + hq] * LOG2E; }
    LAS unsigned* qslot = (LAS unsigned*)(F.lds + LDSCTL_OFF + 64);
    LAS unsigned char* wbuf = F.lds + RING_OFF + AT_SV + F.wave * 9472;
    LAS int* idxl = (LAS int*)(wbuf + 8192);
    __syncthreads();
#define MIX_FETCH(it) do { if (F.tid == 0) *qslot = __hip_atomic_fetch_add((unsigned*)(F.ctl + CW_QUEUE + 64 * l + 32 * qsel), 1u, __ATOMIC_RELAXED, __HIP_MEMORY_SCOPE_AGENT); \
        __syncthreads(); it = (int)*qslot; __syncthreads(); } while (0)
    for (int r = (int)blockIdx.x; r < 1024; r += F.G) {
        if (EN & 0x800) {
            const int b = r >> 9, blk = r & 511;
#pragma unroll 1
            for (int k = 0; k < 2; ++k) { const int u = 8 * blk + F.wave; const int t = k ? (SEQ - 1 - u) : u; const int m = b * SEQ + t;
                select_row(F, m, (LAS unsigned*)wbuf, idxl);
                LDS_WAIT(); __builtin_amdgcn_wave_barrier();
#ifdef PROBE_SEL2
                select_row(F, m, (LAS unsigned*)wbuf, idxl); LDS_WAIT(); __builtin_amdgcn_wave_barrier();
#endif
#ifdef PROBE_ATT2
                sparse_attn_query(F, m, wbuf, TBA, idxl); LDS_WAIT(); __builtin_amdgcn_wave_barrier();
#endif
                sparse_attn_query(F, m, wbuf, TBA, idxl);
                LDS_WAIT(); __builtin_amdgcn_wave_barrier(); }
        }
    }
    __syncthreads();
    int it; MIX_FETCH(it); it += 1024;
    while (it < 1536) { const int r = it & 511; if (EN & 0x100) dense_attn_unit<2>(F, l, (r & 15) >> 3, r & 7, 31 - (r >> 4)); MIX_FETCH(it); it += 1024; }
    while (it < 2048) { const int r = it & 511; if (EN & 0x200) dense_attn_unit<3>(F, l, (r & 15) >> 3, r & 7, 31 - (r >> 4)); MIX_FETCH(it); it += 1024; }
    while (it < MIX_ITEMS) { const int r = it & 511; if (EN & 0x400) dense_attn_unit<1>(F, l, r >> 8, 0, 255 - (r & 255)); MIX_FETCH(it); it += 1024; }
#undef MIX_FETCH
}


__device__ __forceinline__ const float* gp_(const float* p) {
#if defined(__HIP_DEVICE_COMPILE__)
    __builtin_assume(!__builtin_amdgcn_is_shared((const __attribute__((address_space(0))) void*)p)); __builtin_assume(!__builtin_amdgcn_is_private((const __attribute__((address_space(0))) void*)p));
#endif
    return p; }
#ifndef PROBE_KINDS
#define PROBE_KINDS 0u
#endif
#ifndef PROBE_ATT
#define PROBE_ATT 0xF00u
#endif
#ifndef PROBE_REPS
#define PROBE_REPS 1
#endif
#ifndef MK_ONE_LAUNCH
#define MK_ONE_LAUNCH 1
#endif
constexpr int PH_PER_LAYER = 14, N_PHASES = 1 + DEPTH * PH_PER_LAYER;
struct Args { const float* in[15]; float* out; unsigned char* ws; int ph_lo, ph_hi; };
struct ArgsG { const GAS float* in[15]; GAS float* out; GAS unsigned char* ws; int ph_lo, ph_hi; };
template <unsigned EN> __global__ void __launch_bounds__(NTHREADS, 2) trunk_fwd(Args args) {
    extern __shared__ __attribute__((aligned(16))) unsigned char lds[];
    LAS unsigned char* const ldsb = (LAS unsigned char*)lds;
    const int wave0 = __builtin_amdgcn_readfirstlane((int)threadIdx.x >> 6);
    for (int u = threadIdx.x; u < (LDS_BYTES - LDSCTL_OFF) / 4; u += NTHREADS) ((LAS unsigned*)(ldsb + LDSCTL_OFF))[u] = 0u;
    __syncthreads();
#if MK_ONE_LAUNCH
    constexpr int lo = 0, hi = N_PHASES;
#else
    const int lo = args.ph_lo, hi = args.ph_hi;
#endif
    XcdBarrier bar; bar.bar = (unsigned*)(args.ws + WS_CTL) + CW_BAR; bar.x = 0; bar.st = nullptr;
    if (hi - lo > 1) bar = xcd_barrier_post((unsigned*)(args.ws + WS_CTL) + CW_BAR, (volatile LAS unsigned*)(ldsb + LDSCTL_OFF));
#define GP(p) ((const float*)(p))
#define PH_BEGIN(k, kind) if (lo <= (k) && (k) < hi) { _Pragma("unroll 1") for (int rep_ = 0; rep_ < (((PROBE_KINDS >> (kind)) & 1u) ? PROBE_REPS : 1); ++rep_) { Frame F; { \
        const ArgsG* ka = (const ArgsG*)__builtin_amdgcn_kernarg_segment_ptr(); asm volatile("" : "+s"(ka)); \
        unsigned o_ = ~0u; asm volatile("" : "+s"(o_)); int t_ = wave0 * 64 + (int)__builtin_amdgcn_mbcnt_hi(o_, __builtin_amdgcn_mbcnt_lo(o_, 0u)); asm volatile("" : "+v"(t_)); \
        F.lds = ldsb; F.tid = t_; F.lane = t_ & 63; F.wave = wave0; int gw_ = blockIdx.x * NWAVES + wave0; asm volatile("" : "+s"(gw_)); F.G = gridDim.x; F.gw = gw_; F.NGW = F.G * NWAVES; \
        unsigned char* ws = (unsigned char*)ka->ws; F.ctl = (gu32*)(ws + WS_CTL);     \
        F.x = GP(ka->in[0]); F.c = GP(ka->in[1]); F.w_ada = GP(ka->in[2]); F.b_ada = GP(ka->in[3]); F.norm_g = GP(ka->in[4]); F.w_in = GP(ka->in[5]); F.qk_g = GP(ka->in[6]); F.forget_b = GP(ka->in[7]); \
        F.sinks = GP(ka->in[8]); F.rel_table = GP(ka->in[9]); F.group_g = GP(ka->in[10]); F.w_out = GP(ka->in[11]); F.w_gate = GP(ka->in[12]); F.w_up = GP(ka->in[13]); F.w_down = GP(ka->in[14]); F.out = (float*)ka->out; \
        F.MOD = (float*)(ws + WS_MOD); F.LF = (float*)(ws + WS_LF); F.KB2 = (float*)(ws + WS_KB2); F.SC = (unsigned short*)(ws + WS_SC); F.IDX = (int*)(ws + WS_IDX); \
        F.WGU = (bf16*)(ws + WS_WGU); F.WD = (bf16*)(ws + WS_WD); F.WIN = (bf16*)(ws + WS_WIN); F.WOUT = (bf16*)(ws + WS_WOUT); \
        F.H = (bf16*)(ws + WS_H); F.P = (bf16*)(ws + WS_P); F.Y = (bf16*)(ws + WS_Y); F.XB = (bf16*)(ws + WS_XB); }
#define PH_END(k) if ((k) + 1 < hi) xcd_barrier(bar); } }

    PH_BEGIN(0, 31) if (EN & 1) p0_prologue(F); PH_END(0)

    for (int l = 0; l < DEPTH; ++l) {
        const int base = 1 + l * PH_PER_LAYER;
        for (int sub = 0; sub < 3; ++sub) {
            if (sub != 1) {
                const int f = sub >> 1, pb = base + (f ? 11 : 0), ni = f ? 2 : 0, lf = l * 2 + f;
                PH_BEGIN(pb, (f ? 11 : 0)) if (EN & 2) { const float* modl = F.MOD + (size_t)l * BATCH * NMOD;
                    if (l == 0 && f == 0) ph_modulate<FFN_FP8, false>(F, F.x, F.norm_g + ((size_t)l * 3 + ni) * DM, modl + (3 * ni + 0) * DM, modl + (3 * ni + 1) * DM);
                    else ph_modulate<FFN_FP8, true>(F, F.XB, F.norm_g + ((size_t)l * 3 + ni) * DM, modl + (3 * ni + 0) * DM, modl + (3 * ni + 1) * DM); } PH_END(pb)
                PH_BEGIN(pb + 1, (f ? 12 : 1)) if (EN & 4) {
                    pg8::StaticOrder S; S.init(M, NGU, F.G, (int)blockIdx.x);
                    if constexpr (FFN_FP8) { pg8::Gemm g{F.H, (const bf16*)((const unsigned char*)F.WGU + (size_t)lf * NGU * DM), M, NGU, DM, 127, W8_E8M0};
                        pg8::EpiSwiGLU8 E{(unsigned char*)F.P, DFFP};
                        pg8::gemm_phase<pg8::EpiSwiGLU8, pg8::StaticOrder, true, true, true>(F.lds + RING_OFF, g, S, E, F.tid); }
                    else { pg8::Gemm g{F.H, F.WGU + (size_t)lf * NGU * DM, M, NGU, DM};
                        pg8::EpiSwiGLU E{F.P, DFF};
                        pg8::gemm_phase<pg8::EpiSwiGLU, pg8::StaticOrder, true, true>(F.lds + RING_OFF, g, S, E, F.tid); } } PH_END(pb + 1)
                PH_BEGIN(pb + 2, (f ? 13 : 2)) if (EN & 8) {
                    pg8::Gemm g{F.P, FFN_FP8 ? (const bf16*)((const unsigned char*)F.WD + (size_t)lf * DM * DFFP) : F.WD + (size_t)lf * DM * DFF, M, DM, DFF, 127, FFN_FP8 ? W8_E8M0 : 127, FFN_FP8 ? DFFP : 0, FFN_FP8 ? DFFP : 0}; pg8::StaticOrder S; S.init(M, DM, F.G, (int)blockIdx.x);
                    const float* modl = F.MOD + (size_t)l * BATCH * NMOD;
                    if (l == DEPTH - 1 && f == 1) { pg8::EpiResid<false> E{F.XB, rep_ ? (void*)F.SC : (void*)F.out, DM, modl + (3 * ni + 2) * DM, NMOD, SEQ, 0.5f};
                        pg8::gemm_phase<pg8::EpiResid<false>, pg8::StaticOrder, true, true, FFN_FP8>(F.lds + RING_OFF, g, S, E, F.tid); }
                    else { pg8::EpiResid<true> E{F.XB, rep_ ? (void*)F.SC : (void*)F.XB, DM, modl + (3 * ni + 2) * DM, NMOD, SEQ, 0.5f};
                        pg8::gemm_phase<pg8::EpiResid<true>, pg8::StaticOrder, true, true, FFN_FP8>(F.lds + RING_OFF, g, S, E, F.tid); } } PH_END(pb + 2)
            } else {
                PH_BEGIN(base + 3, 3) if (EN & 2) { const float* modl = F.MOD + (size_t)l * BATCH * NMOD; ph_modulate<false, true>(F, F.XB, F.norm_g + ((size_t)l * 3 + 1) * DM, modl + 3 * DM, modl + 4 * DM); } PH_END(base + 3)
                PH_BEGIN(base + 4, 4) if (EN & 16) {
                    pg8::Gemm g{F.H, F.WIN + (size_t)l * NIN * DM, M, NIN, DM}; pg8::StaticOrder S; S.init(M, NIN, F.G, (int)blockIdx.x);
                    pg8::EpiBf16 E{F.P, NIN};
                    pg8::gemm_phase<pg8::EpiBf16, pg8::StaticOrder, true, true>(F.lds + RING_OFF, g, S, E, F.tid); } PH_END(base + 4)
                PH_BEGIN(base + 6, 6) if (EN & 64) { ph_scan(F, l);
                    int par_ = (int)((blockIdx.x & 1u) ^ 1u); asm volatile("" : "+s"(par_));
                    _Pragma("unroll 1") for (int st_ = 0; st_ < 2; ++st_) { if ((st_ ^ par_) == 0) { if (EN & 32) ph_post(F, l); } else ph_idx_scores(F); } } PH_END(base + 6)
                PH_BEGIN(base + 8, 8) if (EN & 0xF00) { if (rep_ == 0) ph_attention<EN>(F, l, 0); else ph_attention<(PROBE_ATT)>(F, l, 1); } PH_END(base + 8)
                PH_BEGIN(base + 9, 9) if (EN & 0x1000) ph_gnorm(F, l); PH_END(base + 9)
                PH_BEGIN(base + 10, 10) if (EN & 0x2000) {
                    pg8::Gemm g{F.Y, F.WOUT + (size_t)l * DM * DM, M, DM, DM}; pg8::StaticOrder S; S.init(M, DM, F.G, (int)blockIdx.x);
                    const float* modl = F.MOD + (size_t)l * BATCH * NMOD;
                    pg8::EpiResid<true> E{F.XB, rep_ ? (void*)F.SC : (void*)F.XB, DM, modl + 5 * DM, NMOD, SEQ, 1.0f};
                    pg8::gemm_phase<pg8::EpiResid<true>, pg8::StaticOrder, true, true>(F.lds + RING_OFF, g, S, E, F.tid); } PH_END(base + 10)
            }
        }
    }
#undef PH_BEGIN
#undef PH_END
}

#ifndef EN_MASK
#define EN_MASK 0xFFFFu
#endif
template <unsigned EN> static int setup_kernel() {
    if (hipFuncSetAttribute((const void*)trunk_fwd<EN>, hipFuncAttributeMaxDynamicSharedMemorySize, LDS_BYTES) != hipSuccess) { fprintf(stderr, "kernel_launch: hipFuncSetAttribute failed\n"); return -1; }
    int per_cu = 0;
    if (hipOccupancyMaxActiveBlocksPerMultiprocessor(&per_cu, (const void*)trunk_fwd<EN>, NTHREADS, LDS_BYTES) != hipSuccess || per_cu < 1) { fprintf(stderr, "kernel_launch: occupancy query says %d\n", per_cu); }
    (void)hipGetLastError();
    return 0;
}
template <unsigned EN> static void launch_range(const Args& a0, int lo, int hi, int grid, hipStream_t stream) {
    Args a = a0; a.ph_lo = lo; a.ph_hi = hi;
    hipLaunchKernelGGL(trunk_fwd<EN>, dim3(grid), dim3(NTHREADS), LDS_BYTES, stream, a);
}
extern "C" void kernel_launch(void* const* d_in, const int* in_sizes, int n_in, void* d_out, int out_size, void* d_ws, size_t ws_size, hipStream_t stream) {
    static int grid = 0;
    if (grid == 0) {
        if (n_in != 15 || in_sizes[0] != M * DM || out_size != M * DM || ws_size < WS_END) {
            fprintf(stderr, "kernel_launch: shape/workspace mismatch: n_in %d in0 %d out %d ws %zu (need %zu); nothing launched\n", n_in, n_in > 0 ? in_sizes[0] : -1, out_size, ws_size, (size_t)WS_END); grid = -1; return; }
        int dev = 0, cus = 0;
        if (hipGetDevice(&dev) != hipSuccess || hipDeviceGetAttribute(&cus, hipDeviceAttributeMultiprocessorCount, dev) != hipSuccess) { grid = -1; return; }
#if MK_ONE_LAUNCH
        if (setup_kernel<EN_MASK>()) { grid = -1; return; }
#else
        if (setup_kernel<0x1u>() || setup_kernel<0x2u>() || setup_kernel<0x4u>() || setup_kernel<0x8u>() || setup_kernel<0x10u>() || setup_kernel<0x20u>() || setup_kernel<0x40u>() || setup_kernel<0x80u>() ||
            setup_kernel<0x100u>() || setup_kernel<0x200u>() || setup_kernel<0x400u>() || setup_kernel<0x800u>() || setup_kernel<0x1000u>() || setup_kernel<0x2000u>()) { grid = -1; return; }
#endif
        grid = cus;
    }
    if (grid < 0) return;
    if (hipMemsetAsync((char*)d_ws + WS_CTL, 0, CTL_ZERO_BYTES, stream) != hipSuccess) return;
    Args a{};
    for (int i = 0; i < 15; ++i) a.in[i] = (const float*)d_in[i];
    a.out = (float*)d_out; a.ws = (unsigned char*)d_ws;
#if MK_ONE_LAUNCH
    launch_range<EN_MASK>(a, 0, N_PHASES, grid, stream);
#else
    launch_range<0x1u>(a, 0, 1, grid, stream);
    for (int l = 0; l < DEPTH; ++l) { const int base = 1 + l * PH_PER_LAYER;
        for (int f = 0; f < 2; ++f) { const int pb = base + (f ? 11 : 0);
            if (f == 1) {
                launch_range<0x2u>(a, base + 3, base + 4, grid, stream); launch_range<0x10u>(a, base + 4, base + 5, grid, stream); launch_range<0x20u>(a, base + 5, base + 6, grid, stream);
                launch_range<0x40u>(a, base + 6, base + 7, grid, stream); launch_range<0x80u>(a, base + 7, base + 8, grid, stream);
                launch_range<0x100u>(a, base + 8, base + 9, grid, stream); launch_range<0x200u>(a, base + 8, base + 9, grid, stream); launch_range<0x400u>(a, base + 8, base + 9, grid, stream); launch_range<0x800u>(a, base + 8, base + 9, grid, stream);
                launch_range<0x1000u>(a, base + 9, base + 10, grid, stream); launch_range<0x2000u>(a, base + 10, base + 11, grid, stream);
            }
            launch_range<0x2u>(a, pb, pb + 1, grid, stream); launch_range<0x4u>(a, pb + 1, pb + 2, grid, stream); launch_range<0x8u>(a, pb + 2, pb + 3, grid, stream);
        }
    }
#endif
}
```

```cpp
#include <hip/hip_runtime.h>
#include <cstdio>
#include <cstdint>

namespace pg8 {
#define PG8_LAS __attribute__((address_space(3)))
typedef unsigned short bf16_t;
typedef short bf16x8 __attribute__((ext_vector_type(8)));
typedef float f32x4 __attribute__((ext_vector_type(4)));
typedef unsigned u32x4 __attribute__((ext_vector_type(4)));
constexpr int BM = 256, BK = 64, HALF = 128, HTB = HALF * BK * 2  , STAGE_BYTES = 8 * HTB, NXCD = 8, WGM = 8;

__host__ __device__ __forceinline__ int lds_byte(int r, int c) { const int st = (r >> 4) * 2 + (c >> 5), rr = r & 15, cc = c & 31, ob = rr * 64 + cc * 2; return st * 1024 + (ob ^ (((ob >> 9) & 1) << 5)); }
__host__ __device__ __forceinline__ void stage_rc(int b, int& R, int& C) { const int st = b / 1024, sb = b % 1024, swz = sb ^ (((sb >> 9) & 1) << 5); R = (st >> 1) * 16 + swz / 64; C = (st & 1) * 32 + (swz % 64) / 2; }
__host__ __device__ __forceinline__ int perm32(int rho) { const int n = rho >> 4, i = rho & 15; return 8 * (i >> 2) + 4 * n + (i & 3); }

struct Unit { int pm, pn; };
struct Gemm { const bf16_t* A; const bf16_t* Bt; int M, N, K; int scaleA = 127, scaleB = 127; int lda = 0, ldb = 0; int blk = 0; };
typedef int i32x8 __attribute__((ext_vector_type(8))); typedef int i32x4v __attribute__((ext_vector_type(4)));
__device__ __forceinline__ i32x8 pg8_cat(bf16x8 lo, bf16x8 hi) { return __builtin_shufflevector(__builtin_bit_cast(i32x4v, lo), __builtin_bit_cast(i32x4v, hi), 0, 1, 2, 3, 4, 5, 6, 7); }

struct StaticOrder {
    int nM, nN, nwg, G, c;
    __host__ __device__ void init(int M, int N, int G_, int c_) { nM = M / BM; nN = N / BM; nwg = nM * nN; G = G_; c = c_; }
    __host__ __device__ bool next(int i, Unit& u) const {
        const long L = (long)i * G + c; if (L >= nwg) return false;
        int wgid = (int)L; { const int q = nwg / NXCD, r = nwg % NXCD, xcd = wgid % NXCD, off = wgid / NXCD; wgid = (xcd < r ? xcd * (q + 1) : r * (q + 1) + (xcd - r) * q) + off; }
        const int nig = WGM * nN, gid = wgid / nig, fm = gid * WGM, gsz = (nM - fm) < WGM ? (nM - fm) : WGM;
        u.pm = fm + ((wgid % nig) % gsz); u.pn = (wgid % nig) / gsz; return true;
    }
    __device__ __forceinline__ void a_ready(const Unit&) const {}
    __device__ __forceinline__ void done(const Unit&) const {}
};
typedef __bf16 pg8_bfpair __attribute__((ext_vector_type(2))); typedef float pg8_f32pair __attribute__((ext_vector_type(2)));
__device__ __forceinline__ unsigned cvt_pk_bf16(float lo, float hi) { const pg8_f32pair v = {lo, hi}; return __builtin_bit_cast(unsigned, __builtin_convertvector(v, pg8_bfpair)); }
__device__ __forceinline__ unsigned cvt_pk_bf16_nv(float lo, float hi) { return cvt_pk_bf16(lo, hi); }
__device__ __forceinline__ const char* uptr(const char* p) { const unsigned long long v = (unsigned long long)p; const unsigned lo = __builtin_amdgcn_readfirstlane((unsigned)v), hi = __builtin_amdgcn_readfirstlane((unsigned)(v >> 32)); return (const char*)(((unsigned long long)hi << 32) | lo); }
struct EpiBf16 {
    static constexpr bool PERM = true, AFTER_DRAIN = false;
    bf16_t* O; int ldc;
    __device__ __forceinline__ void operator()(const f32x4 (&acc)[2][2][4][2], const Unit& u, int wr, int wc, int fr, int fq) const {
        asm volatile("" : "+v"(fr), "+v"(fq));
        const int row0 = u.pm * BM + wr * 64 + fr; const int col0 = u.pn * BM + wc * 32 + 8 * fq;
#pragma unroll
        for (int ai = 0; ai < 2; ++ai)
#pragma unroll
            for (int m = 0; m < 4; ++m) { bf16_t* rowp = O + (size_t)(row0 + ai * HALF + m * 16) * ldc + col0;
#pragma unroll
                for (int bj = 0; bj < 2; ++bj) { const f32x4 v0 = acc[ai][bj][m][0], v1 = acc[ai][bj][m][1];
                    u32x4 w; w.x = cvt_pk_bf16(v0[0], v0[1]); w.y = cvt_pk_bf16(v0[2], v0[3]); w.z = cvt_pk_bf16(v1[0], v1[1]); w.w = cvt_pk_bf16(v1[2], v1[3]);
                    *(u32x4*)(rowp + bj * HALF) = w; } }
    }
};
__device__ __forceinline__ float silu_mul(float g, float u) { return g * u * __builtin_amdgcn_rcpf(1.0f + __builtin_amdgcn_exp2f(-1.4426950408889634f * g)); }
struct EpiSwiGLU {
    static constexpr bool PERM = true, AFTER_DRAIN = false;
    bf16_t* O; int ldc;
    __device__ __forceinline__ void operator()(const f32x4 (&acc)[2][2][4][2], const Unit& u, int wr, int wc, int fr, int fq) const {
        asm volatile("" : "+v"(fr), "+v"(fq));
        const int row0 = u.pm * BM + wr * 64 + fr; const int col0 = u.pn * HALF + wc * 32 + 8 * fq;
#pragma unroll
        for (int ai = 0; ai < 2; ++ai)
#pragma unroll
            for (int m = 0; m < 4; ++m) { bf16_t* rowp = O + (size_t)(row0 + ai * HALF + m * 16) * ldc + col0;
                const f32x4 g0 = acc[ai][0][m][0], g1 = acc[ai][0][m][1], u0 = acc[ai][1][m][0], u1 = acc[ai][1][m][1];
                u32x4 w; w.x = cvt_pk_bf16(silu_mul(g0[0], u0[0]), silu_mul(g0[1], u0[1])); w.y = cvt_pk_bf16(silu_mul(g0[2], u0[2]), silu_mul(g0[3], u0[3]));
                w.z = cvt_pk_bf16(silu_mul(g1[0], u1[0]), silu_mul(g1[1], u1[1])); w.w = cvt_pk_bf16(silu_mul(g1[2], u1[2]), silu_mul(g1[3], u1[3]));
                *(u32x4*)rowp = w; }
    }
};
template <bool OUT16> struct EpiResid {
    static constexpr bool PERM = true, AFTER_DRAIN = false;
    const bf16_t* base; void* out; int ldc; const float* gv; int gstride; int rows_per_batch; float coef;
    __device__ __forceinline__ void operator()(const f32x4 (&acc)[2][2][4][2], const Unit& u, int wr, int wc, int fr, int fq) const {
        asm volatile("" : "+v"(fr), "+v"(fq));
        const int row0 = u.pm * BM + wr * 64 + fr; const int col0 = u.pn * BM + wc * 32 + 8 * fq;
        const float* gvec = gv + (size_t)((u.pm * BM) / rows_per_batch) * gstride + col0;
        f32x4 gg[2][2];
#pragma unroll
        for (int bj = 0; bj < 2; ++bj)
#pragma unroll
            for (int n = 0; n < 2; ++n) gg[bj][n] = *(const f32x4*)(gvec + bj * HALF + 4 * n) * coef;
#pragma unroll
        for (int ai = 0; ai < 2; ++ai) {
            u32x4 bwv[4][2];
#pragma unroll
            for (int m = 0; m < 4; ++m) { const size_t off = (size_t)(row0 + ai * HALF + m * 16) * ldc + col0;
#pragma unroll
                for (int bj = 0; bj < 2; ++bj) bwv[m][bj] = *(const u32x4*)(base + off + bj * HALF); }
            __builtin_amdgcn_sched_barrier(0);
#pragma unroll
            for (int m = 0; m < 4; ++m) { const size_t off = (size_t)(row0 + ai * HALF + m * 16) * ldc + col0;
#pragma unroll
                for (int bj = 0; bj < 2; ++bj) { const u32x4 bw = bwv[m][bj];
                    f32x4 b0, b1; b0[0] = __builtin_bit_cast(float, bw.x << 16); b0[1] = __builtin_bit_cast(float, bw.x & 0xffff0000u); b0[2] = __builtin_bit_cast(float, bw.y << 16); b0[3] = __builtin_bit_cast(float, bw.y & 0xffff0000u);
                    b1[0] = __builtin_bit_cast(float, bw.z << 16); b1[1] = __builtin_bit_cast(float, bw.z & 0xffff0000u); b1[2] = __builtin_bit_cast(float, bw.w << 16); b1[3] = __builtin_bit_cast(float, bw.w & 0xffff0000u);
                    const f32x4 r0 = b0 + gg[bj][0] * acc[ai][bj][m][0], r1 = b1 + gg[bj][1] * acc[ai][bj][m][1];
                    if constexpr (OUT16) { u32x4 w; w.x = cvt_pk_bf16_nv(r0[0], r0[1]); w.y = cvt_pk_bf16_nv(r0[2], r0[3]); w.z = cvt_pk_bf16_nv(r1[0], r1[1]); w.w = cvt_pk_bf16_nv(r1[2], r1[3]); *(u32x4*)((bf16_t*)out + off + bj * HALF) = w; }
                    else { *(f32x4*)((float*)out + off + bj * HALF) = r0; *(f32x4*)((float*)out + off + bj * HALF + 4) = r1; } } }
        }
    }
};
__device__ __forceinline__ unsigned pack_fp8x4(float a, float b, float c, float d) {
    a = fminf(fmaxf(a, -448.f), 448.f); b = fminf(fmaxf(b, -448.f), 448.f); c = fminf(fmaxf(c, -448.f), 448.f); d = fminf(fmaxf(d, -448.f), 448.f);
    int w = 0; w = __builtin_amdgcn_cvt_pk_fp8_f32(a, b, w, false); w = __builtin_amdgcn_cvt_pk_fp8_f32(c, d, w, true); return (unsigned)w; }
struct EpiSwiGLU8 {
    static constexpr bool PERM = true, AFTER_DRAIN = false;
    unsigned char* O; int ldc;
    __device__ __forceinline__ void operator()(const f32x4 (&acc)[2][2][4][2], const Unit& u, int wr, int wc, int fr, int fq) const {
        asm volatile("" : "+v"(fr), "+v"(fq));
        const int row0 = u.pm * BM + wr * 64 + fr; const int col0 = u.pn * HALF + wc * 32 + 8 * fq;
#pragma unroll
        for (int ai = 0; ai < 2; ++ai)
#pragma unroll
            for (int m = 0; m < 4; ++m) { unsigned char* rowp = O + (size_t)(row0 + ai * HALF + m * 16) * ldc + col0;
                const f32x4 g0 = acc[ai][0][m][0], g1 = acc[ai][0][m][1], u0 = acc[ai][1][m][0], u1 = acc[ai][1][m][1];
                typedef unsigned u32x2v __attribute__((ext_vector_type(2))); u32x2v w;
                w.x = pack_fp8x4(silu_mul(g0[0], u0[0]), silu_mul(g0[1], u0[1]), silu_mul(g0[2], u0[2]), silu_mul(g0[3], u0[3]));
                w.y = pack_fp8x4(silu_mul(g1[0], u1[0]), silu_mul(g1[1], u1[1]), silu_mul(g1[2], u1[2]), silu_mul(g1[3], u1[3]));
                *(u32x2v*)rowp = w; }
    }
};
template <class Epi, class Sched, bool ALIGN_EPI = false, bool SP2 = false, bool FP8 = false>
__device__ __forceinline__ void gemm_phase(PG8_LAS unsigned char* lds, const Gemm g, const Sched& S, const Epi& E, int tid_in) {
    int tid_ = tid_in; asm volatile("" : "+v"(tid_));
    const int tid = tid_, wid = __builtin_amdgcn_readfirstlane(tid >> 6), lane = tid & 63, wr = wid >> 2, wc = wid & 3, fr = lane & 15, fq = lane >> 4;
    const int K = g.K, nt = FP8 ? K / (2 * BK) : K / BK;
    const int pitchA = g.blk ? 2 * BK : g.lda ? g.lda : (FP8 ? K : 2 * K), pitchB = g.blk ? 2 * BK : g.ldb ? g.ldb : (FP8 ? K : 2 * K);
    unsigned voffA[2], voffB[2];
#pragma unroll
    for (int i = 0; i < 2; ++i) { int R, C; stage_rc(tid * 16 + i * 8192, R, C); const int Rb = Epi::PERM ? ((R & ~31) + perm32(R & 31)) : R;
        voffA[i] = (unsigned)(R * pitchA + C * 2); voffB[i] = (unsigned)(Rb * pitchB + C * 2); }
    const size_t kstep = g.blk ? (size_t)(512 * BK) : (size_t)(BK * 2);
    const size_t hstepA = (size_t)HALF * pitchA, hstepB = (size_t)HALF * pitchB;
    const size_t tstepA = g.blk ? (size_t)(FP8 ? K / (2 * BK) : K / BK) * kstep : 2 * hstepA, tstepB = g.blk ? tstepA : 2 * hstepB;
    const unsigned ldsw = (unsigned)wid * 1024u;
    const int aoff = lds_byte(wr * 64 + fr, fq * 8), boff = lds_byte(wc * 32 + fr, fq * 8);
    PG8_LAS unsigned char* abase = lds + aoff; PG8_LAS unsigned char* bbase = lds + boff + 4 * HTB;
#define PG8_SA(b, h) (((b) * 2 + (h)) * HTB)
#define PG8_SB(b, h) ((4 + (b) * 2 + (h)) * HTB)
#define PG8_STAGE(bufoff, gbase, voff) do { _Pragma("unroll") for (int _i = 0; _i < 2; ++_i) \
        __builtin_amdgcn_global_load_lds((const unsigned*)((const char*)(gbase) + (voff)[_i]), (PG8_LAS unsigned*)(lds + (bufoff) + ldsw + _i * 8192), 16, 0, 0); } while (0)
#define PG8_RDA(off) (*(const PG8_LAS bf16x8*)(abase + (off)))
#define PG8_RDB(off) (*(const PG8_LAS bf16x8*)(bbase + ((off) - 4 * HTB)))
#define PG8_LDA(dst, b, h) do { if constexpr (FP8) { _Pragma("unroll") for (int m = 0; m < 4; ++m) dst##8[m] = pg8_cat(PG8_RDA(PG8_SA(b, h) + m * 2048), PG8_RDA(PG8_SA(b, h) + m * 2048 + 1024)); } \
    else { _Pragma("unroll") for (int m = 0; m < 4; ++m) _Pragma("unroll") for (int k = 0; k < 2; ++k) dst[m][k] = PG8_RDA(PG8_SA(b, h) + m * 2048 + k * 1024); } } while (0)
#define PG8_LDB(dst, b, h) do { if constexpr (FP8) { _Pragma("unroll") for (int n = 0; n < 2; ++n) dst##8[n] = pg8_cat(PG8_RDB(PG8_SB(b, h) + n * 2048), PG8_RDB(PG8_SB(b, h) + n * 2048 + 1024)); } \
    else { _Pragma("unroll") for (int n = 0; n < 2; ++n) _Pragma("unroll") for (int k = 0; k < 2; ++k) dst[n][k] = PG8_RDB(PG8_SB(b, h) + n * 2048 + k * 1024); } } while (0)
#define PG8_MMA(ai, bj, At, Bt) do { __builtin_amdgcn_s_setprio(1); if constexpr (FP8) { \
        _Pragma("unroll") for (int m = 0; m < 4; ++m) _Pragma("unroll") for (int n = 0; n < 2; ++n) \
            asm volatile("v_mfma_scale_f32_16x16x128_f8f6f4 %0, %1, %2, %0, %3, %4 op_sel_hi:[0,0,0]" : "+v"(acc[ai][bj][m][n]) : "v"(Bt##8[n]), "v"(At##8[m]), "v"(sclB), "v"(sclA)); \
        } else { _Pragma("unroll") for (int m = 0; m < 4; ++m) _Pragma("unroll") for (int n = 0; n < 2; ++n) _Pragma("unroll") for (int k = 0; k < 2; ++k) \
        acc[ai][bj][m][n] = __builtin_amdgcn_mfma_f32_16x16x32_bf16(Bt[n][k], At[m][k], acc[ai][bj][m][n], 0, 0, 0); } __builtin_amdgcn_s_setprio(0); } while (0)
#define PG8_WAIT_V(n) asm volatile("s_waitcnt vmcnt(" #n ")" ::: "memory")
#define PG8_WAIT_L(n) asm volatile("s_waitcnt lgkmcnt(" #n ")" ::: "memory")
#define PG8_BAR __builtin_amdgcn_s_barrier()
#define PG8_SCHED __builtin_amdgcn_sched_barrier(0)
    Unit cur, nxt; int ui = 0;
    if (!S.next(0, cur)) return;
    f32x4 acc[2][2][4][2];
#pragma unroll
    for (int a = 0; a < 2; ++a)
#pragma unroll
        for (int b = 0; b < 2; ++b)
#pragma unroll
            for (int m = 0; m < 4; ++m)
#pragma unroll
                for (int n = 0; n < 2; ++n) acc[a][b][m][n] = (f32x4){0.f, 0.f, 0.f, 0.f};
    const int sclA = g.scaleA, sclB = g.scaleB;
    bf16x8 At[4][2], B0[2][2], B1[2][2]; i32x8 At8[4], B08[2], B18[2];
    const char* cA = uptr((const char*)g.A + (size_t)cur.pm * tstepA); const char* cB = uptr((const char*)g.Bt + (size_t)cur.pn * tstepB);
    S.a_ready(cur);
    if constexpr (SP2) {
        PG8_STAGE(PG8_SB(0, 0), cB, voffB); PG8_STAGE(PG8_SB(0, 1), cB + hstepB, voffB); PG8_STAGE(PG8_SA(0, 0), cA, voffA); PG8_STAGE(PG8_SA(0, 1), cA + hstepA, voffA);
        if (wr == 1) PG8_BAR;
        PG8_WAIT_V(2); PG8_BAR;
        PG8_STAGE(PG8_SB(1, 0), cB + kstep, voffB); PG8_STAGE(PG8_SA(1, 0), cA + kstep, voffA); PG8_STAGE(PG8_SB(1, 1), cB + hstepB + kstep, voffB);
        PG8_WAIT_V(6); PG8_BAR;
    } else {
        PG8_STAGE(PG8_SB(0, 0), cB, voffB); PG8_STAGE(PG8_SA(0, 0), cA, voffA); PG8_STAGE(PG8_SB(0, 1), cB + hstepB, voffB); PG8_STAGE(PG8_SA(0, 1), cA + hstepA, voffA);
        if (wr == 1) PG8_BAR;
        PG8_WAIT_V(4); PG8_BAR;
        PG8_STAGE(PG8_SB(1, 0), cB + kstep, voffB); PG8_STAGE(PG8_SA(1, 0), cA + kstep, voffA); PG8_STAGE(PG8_SB(1, 1), cB + hstepB + kstep, voffB);
        PG8_WAIT_V(6); PG8_BAR;
    }
    for (;;) {
        const bool has_next = S.next(ui + 1, nxt);
        const char* nA = uptr(has_next ? (const char*)g.A + (size_t)nxt.pm * tstepA : cA); const char* nB = uptr(has_next ? (const char*)g.Bt + (size_t)nxt.pn * tstepB : cB);
        for (int t = 0; t < nt; t += 2) {
            asm volatile("" : "+v"(abase), "+v"(bbase));
            const bool last = (t == nt - 2);
            const char* a1 = cA + (size_t)(t + 1) * kstep;
            const char* a2 = uptr(last ? nA : cA + (size_t)(t + 2) * kstep); const char* b2 = uptr(last ? nB : cB + (size_t)(t + 2) * kstep);
            const char* a3 = a2 + kstep; const char* b3 = b2 + kstep;
            if (last && has_next) S.a_ready(nxt);
            if constexpr (SP2) {
            PG8_LDB(B0, 0, 0); PG8_LDB(B1, 0, 1); PG8_SCHED; PG8_LDA(At, 0, 0); PG8_STAGE(PG8_SA(1, 1), a1 + hstepA, voffA);
            PG8_WAIT_V(8); PG8_WAIT_L(0); PG8_BAR; PG8_MMA(0, 0, At, B0); PG8_MMA(0, 1, At, B1); PG8_BAR; PG8_SCHED;
            PG8_LDA(At, 0, 1); PG8_STAGE(PG8_SB(0, 0), b2, voffB); PG8_STAGE(PG8_SB(0, 1), b2 + hstepB, voffB); PG8_STAGE(PG8_SA(0, 0), a2, voffA);
            PG8_WAIT_V(8); PG8_WAIT_L(0); PG8_BAR; PG8_MMA(1, 0, At, B0); PG8_MMA(1, 1, At, B1); PG8_BAR; PG8_SCHED;
            PG8_LDB(B0, 1, 0); PG8_LDB(B1, 1, 1); PG8_SCHED; PG8_LDA(At, 1, 0); PG8_STAGE(PG8_SA(0, 1), a2 + hstepA, voffA);
            PG8_WAIT_V(8); PG8_WAIT_L(0); PG8_BAR; PG8_MMA(0, 0, At, B0); PG8_MMA(0, 1, At, B1); PG8_BAR; PG8_SCHED;
            PG8_LDA(At, 1, 1); PG8_STAGE(PG8_SB(1, 0), b3, voffB); PG8_STAGE(PG8_SB(1, 1), b3 + hstepB, voffB); PG8_STAGE(PG8_SA(1, 0), a3, voffA);
            PG8_WAIT_V(8); PG8_WAIT_L(0); PG8_BAR; PG8_MMA(1, 0, At, B0); PG8_MMA(1, 1, At, B1); PG8_BAR; PG8_SCHED;
            } else {
            PG8_LDB(B0, 0, 0); PG8_SCHED; PG8_LDA(At, 0, 0); PG8_STAGE(PG8_SA(1, 1), a1 + hstepA, voffA);
            PG8_WAIT_L(8); PG8_BAR; PG8_WAIT_L(0); PG8_MMA(0, 0, At, B0); PG8_BAR; PG8_SCHED;
            PG8_LDB(B1, 0, 1); PG8_STAGE(PG8_SB(0, 0), b2, voffB);
            PG8_BAR; PG8_WAIT_L(0); PG8_MMA(0, 1, At, B1); PG8_BAR;
            PG8_LDA(At, 0, 1); PG8_STAGE(PG8_SA(0, 0), a2, voffA);
            PG8_BAR; PG8_WAIT_L(0); PG8_MMA(1, 0, At, B0); PG8_BAR; PG8_SCHED;
            PG8_STAGE(PG8_SB(0, 1), b2 + hstepB, voffB);
            PG8_WAIT_V(6); PG8_BAR; PG8_MMA(1, 1, At, B1); PG8_BAR;
            PG8_LDB(B0, 1, 0); PG8_SCHED; PG8_LDA(At, 1, 0); PG8_STAGE(PG8_SA(0, 1), a2 + hstepA, voffA);
            PG8_WAIT_L(8); PG8_BAR; PG8_WAIT_L(0); PG8_MMA(0, 0, At, B0); PG8_BAR; PG8_SCHED;
            PG8_LDB(B1, 1, 1); PG8_STAGE(PG8_SB(1, 0), b3, voffB);
            PG8_BAR; PG8_WAIT_L(0); PG8_MMA(0, 1, At, B1); PG8_BAR;
            PG8_LDA(At, 1, 1); PG8_STAGE(PG8_SA(1, 0), a3, voffA);
            PG8_BAR; PG8_WAIT_L(0); PG8_MMA(1, 0, At, B0); PG8_BAR; PG8_SCHED;
            PG8_STAGE(PG8_SB(1, 1), b3 + hstepB, voffB);
            PG8_WAIT_V(6); PG8_BAR; PG8_MMA(1, 1, At, B1); PG8_BAR;
            }
        }
        if constexpr (FP8) asm volatile("s_nop 15\n\ts_nop 7" ::: "memory");
        if constexpr (ALIGN_EPI) { if (wr == 0) PG8_BAR; }
        if constexpr (!Epi::AFTER_DRAIN) { E(acc, cur, wr, wc, fr, fq); S.done(cur); }
        if (!has_next) break;
#pragma unroll
        for (int a = 0; a < 2; ++a)
#pragma unroll
            for (int b = 0; b < 2; ++b)
#pragma unroll
                for (int m = 0; m < 4; ++m)
#pragma unroll
                    for (int n = 0; n < 2; ++n) acc[a][b][m][n] = (f32x4){0.f, 0.f, 0.f, 0.f};
        cur = nxt; cA = nA; cB = nB; ++ui;
        if constexpr (ALIGN_EPI) { if (wr == 1) PG8_BAR; }
    }
    PG8_WAIT_V(0);
    if constexpr (!ALIGN_EPI) { if (wr == 0) PG8_BAR; }
    PG8_BAR;
    if constexpr (Epi::AFTER_DRAIN) { E.fused(acc, cur, wr, wc, fr, fq, lds, wid, lane); S.done(cur); }
#undef PG8_SA
#undef PG8_SB
#undef PG8_STAGE
#undef PG8_RDA
#undef PG8_RDB
#undef PG8_LDA
#undef PG8_LDB
#undef PG8_MMA
#undef PG8_WAIT_V
#undef PG8_WAIT_L
#undef PG8_BAR
#undef PG8_SCHED
}
}

#ifndef MK_FFN_FP8
#define MK_FFN_FP8 1
#endif
constexpr bool FFN_FP8 = MK_FFN_FP8;
constexpr int NWAVES = 8, NTHREADS = NWAVES * 64;
constexpr int BATCH = 2, SEQ = 8192, M = BATCH * SEQ, DM = 2048, DEPTH = 4, DFF = 5632, NGU = 2 * DFF, INC = 5976, NIN = 6144, NMOD = 9 * DM;
constexpr int DFFP = DFF + 128;
constexpr int NH = 8, HD = 64, GWID = 512, TOPK = 256, WINDOW = 128;
constexpr int PA_Q = 0, PA_K = 512, PA_V = 576, PA_IQ = 640, PA_IK = 1664, PB_Q = 1728, PB_K = 2240, PB_V = 2304, PC_Q = 2368, PC_K = 2880, PC_V = 3392, PC_G = 3904,
              PD_Q = 4416, PD_K = 4928, PD_V = 5440, PA_IW = 5952, PC_F = 5968;
constexpr float RMS_EPS = 1e-6f, LOG2E = 1.4426950408889634f, QSCALE = 0.125f * LOG2E;

constexpr size_t MiB = 1u << 20;
constexpr size_t WS_CTL = 0, CTL_ZERO_BYTES = 64 * 1024;
constexpr size_t WS_MOD = 1 * MiB;
constexpr size_t WS_LF = 2 * MiB;
constexpr size_t WS_KB2 = 3 * MiB;
constexpr size_t WS_WGU = 4 * MiB;
constexpr size_t SZ_WGU = (size_t)NGU * DM * 2;
constexpr size_t WS_WD = WS_WGU + 8 * SZ_WGU;
constexpr size_t SZ_WD = (size_t)DM * DFF * 2;
constexpr size_t WS_WIN = WS_WD + 8 * SZ_WD;
constexpr size_t SZ_WIN = (size_t)NIN * DM * 2;
constexpr size_t WS_WOUT = WS_WIN + 4 * SZ_WIN;
constexpr size_t SZ_WOUT = (size_t)DM * DM * 2;
constexpr size_t WS_H = WS_WOUT + 4 * SZ_WOUT;
constexpr size_t WS_P = WS_H + (size_t)M * DM * 2;
constexpr size_t WS_Y = WS_P + (size_t)M * NIN * 2;
constexpr size_t WS_IDX = WS_Y + (size_t)M * DM * 2;
constexpr size_t WS_SC = WS_IDX + (size_t)M * TOPK * 4;
constexpr size_t WS_XB = WS_SC + (size_t)BATCH * SEQ * SEQ * 2;
constexpr size_t WS_END = WS_XB + (size_t)M * DM * 2;
static_assert(WS_WGU % MiB == 0 && WS_WD % MiB == 0 && WS_WIN % MiB == 0 && WS_WOUT % MiB == 0 && WS_H % MiB == 0 && WS_P % MiB == 0 && WS_Y % MiB == 0 && WS_IDX % MiB == 0 && WS_SC % MiB == 0, "d_ws map alignment");
constexpr int CW_BAR = 4096;

constexpr int RING_OFF = 0, RING_BYTES = 131072;
constexpr int AUX_OFF = RING_BYTES, AUX_BYTES = 16384;
constexpr int LDSCTL_OFF = AUX_OFF + AUX_BYTES;
constexpr int LDS_BYTES = LDSCTL_OFF + 256;

#define GAS __attribute__((address_space(1)))
#define LAS __attribute__((address_space(3)))
typedef unsigned short bf16;
typedef unsigned v4u __attribute__((ext_vector_type(4)));
typedef unsigned v2u __attribute__((ext_vector_type(2)));
typedef int v4i __attribute__((ext_vector_type(4)));
typedef float f32x4 __attribute__((ext_vector_type(4)));
typedef float f32x16 __attribute__((ext_vector_type(16)));
typedef short bf16x8 __attribute__((ext_vector_type(8)));
typedef short s16x4 __attribute__((ext_vector_type(4)));
typedef GAS unsigned gu32;
#define RLX_AGENT __ATOMIC_RELAXED, __HIP_MEMORY_SCOPE_AGENT
#define LDS_WAIT() asm volatile("s_waitcnt lgkmcnt(0)" ::: "memory")
#define VM_WAIT() asm volatile("s_waitcnt vmcnt(0)" ::: "memory")
__device__ __forceinline__ unsigned f2bf(float f) { unsigned u = __builtin_bit_cast(unsigned, f); return (u + 0x7fffu + ((u >> 16) & 1u)) >> 16; }
__device__ __forceinline__ unsigned pk2(float lo, float hi) { return f2bf(lo) | (f2bf(hi) << 16); }
__device__ __forceinline__ float bf_lo(unsigned w) { return __builtin_bit_cast(float, w << 16); }
__device__ __forceinline__ float bf_hi(unsigned w) { return __builtin_bit_cast(float, w & 0xffff0000u); }
__device__ __forceinline__ float bf2f(bf16 h) { return __builtin_bit_cast(float, (unsigned)h << 16); }
__device__ __forceinline__ float wave_sum(float v) {
#pragma unroll
    for (int o = 1; o < 64; o <<= 1) v += __shfl_xor(v, o);
    return v;
}
__device__ __forceinline__ float fexp2(float x) { return __builtin_amdgcn_exp2f(x); }
__device__ __forceinline__ float frcp(float x) { return __builtin_amdgcn_rcpf(x); }
__device__ const unsigned char kBucketLut[128] = {0, 1, 2, 3, 4, 5, 6, 7, 8, 9, 10, 11, 12, 13, 14, 15, 16, 16, 16, 17, 17, 18, 18, 18, 19, 19, 19, 20, 20, 20, 20, 21, 21, 21, 21, 22, 22, 22, 22, 22,
    23, 23, 23, 23, 23, 23, 24, 24, 24, 24, 24, 24, 25, 25, 25, 25, 25, 25, 25, 26, 26, 26, 26, 26, 26, 26, 26, 27, 27, 27, 27, 27, 27, 27, 27, 27, 27, 28, 28, 28, 28, 28, 28, 28, 28, 28, 28,
    29, 29, 29, 29, 29, 29, 29, 29, 29, 29, 29, 29, 30, 30, 30, 30, 30, 30, 30, 30, 30, 30, 30, 30, 30, 30, 31, 31, 31, 31, 31, 31, 31, 31, 31, 31, 31, 31, 31, 31, 31};

#define XB_TMO      128
#define XB_XCNT(j)  (256  + 64 * (j))
#define XB_XSUB(j)  (1280 + 64 * (j))
#define XB_XGEN(j)  (2304 + 64 * (j))
#define XB_TOP      3328
#define XB_TOPGEN   3392
#define XCD_BAR_WORDS 3456
#define XB_SPIN_CAP (1u << 18)

__device__ __forceinline__ unsigned xb_ld(unsigned* p)              { return __hip_atomic_load((GAS unsigned*)p, __ATOMIC_RELAXED, __HIP_MEMORY_SCOPE_AGENT); }
__device__ __forceinline__ unsigned xb_add(unsigned* p, unsigned v) { return __hip_atomic_fetch_add((GAS unsigned*)p, v, __ATOMIC_RELAXED, __HIP_MEMORY_SCOPE_AGENT); }
__device__ __forceinline__ unsigned xb_xcc_id() { return (unsigned)__builtin_amdgcn_s_getreg((3 << 11) | 20) & 0xFu; }
#define XB_SPIN(cond, bar) do { unsigned _sp = 0; while (cond) { __builtin_amdgcn_s_sleep(1); \
    if ((++_sp & 255u) == 0u) { if (xb_ld(&(bar)[XB_TMO])) break; if (_sp > XB_SPIN_CAP) { xb_add(&(bar)[XB_TMO], 1u); break; } } } } while (0)

struct XcdBarrier {
    unsigned* bar; unsigned x;
    volatile LAS unsigned* st;
};

__device__ __forceinline__ XcdBarrier xcd_barrier_post(unsigned* bar, volatile LAS unsigned* st) {
    XcdBarrier b; b.bar = bar; b.x = xb_xcc_id(); b.st = st;
    if (threadIdx.x == 0) (void)xb_add(&bar[XB_XCNT(b.x)], 1u);
    return b;
}
__device__ __forceinline__ void xcd_barrier_complete(unsigned* bar, unsigned x, unsigned& nloc, unsigned& nx) {
    const unsigned G = gridDim.x * gridDim.y * gridDim.z;
    unsigned sum, cnt, mine, sp = 0u;
    for (;;) {
        sum = 0u; cnt = 0u; mine = 0u;
#pragma unroll
        for (unsigned j = 0; j < 16; ++j) { const unsigned c = xb_ld(&bar[XB_XCNT(j)]); sum += c; cnt += (c > 0u) ? 1u : 0u; mine = (j == x) ? c : mine; }
        if (sum == G) break;
        __builtin_amdgcn_s_sleep(1);
        if ((++sp & 255u) == 0u) { if (xb_ld(&bar[XB_TMO])) break; if (sp > XB_SPIN_CAP) { xb_add(&bar[XB_TMO], 1u); break; } }
    }
    nloc = mine > 0u ? mine : 1u; nx = cnt > 0u ? cnt : 1u;
}

__device__ __forceinline__ void xcd_barrier(const XcdBarrier& b) {
    asm volatile("s_waitcnt vmcnt(0)" ::: "memory");
    __syncthreads();
    if (threadIdx.x == 0) {
        unsigned* bar = b.bar; asm volatile("" : "+s"(bar));
        __builtin_amdgcn_s_waitcnt(0);
        unsigned nloc = b.st[0], nx = b.st[1];
        if (nloc == 0u) { xcd_barrier_complete(bar, b.x, nloc, nx); b.st[0] = nloc; b.st[1] = nx; }
        const unsigned old = xb_add(&bar[XB_XSUB(b.x)], 1u);
        const unsigned gen = old / nloc;
        if (old + 1u == (gen + 1u) * nloc) {
            __builtin_amdgcn_fence(__ATOMIC_RELEASE, "agent");
            asm volatile("s_waitcnt vmcnt(0)" ::: "memory");
            const unsigned og = xb_add(&bar[XB_TOP], 1u);
            const unsigned tg = og / nx;
            if (og + 1u == (tg + 1u) * nx) xb_add(&bar[XB_TOPGEN], 1u);
            else XB_SPIN(xb_ld(&bar[XB_TOPGEN]) == tg, bar);
            __builtin_amdgcn_fence(__ATOMIC_ACQUIRE, "agent");
            xb_add(&bar[XB_XGEN(b.x)], 1u);
            asm volatile("s_waitcnt vmcnt(0)" ::: "memory");
        } else {
            XB_SPIN(xb_ld(&bar[XB_XGEN(b.x)]) == gen, bar);
            __builtin_amdgcn_fence(__ATOMIC_ACQUIRE, "agent");
            asm volatile("s_waitcnt vmcnt(0)" ::: "memory");
        }
    }
    __syncthreads();
}

struct Frame {
    LAS unsigned char* lds;
    gu32* ctl;
    int tid, lane, wave, G, gw, NGW;
    const float *x, *c, *w_ada, *b_ada, *norm_g, *w_in, *qk_g, *forget_b, *sinks, *rel_table, *group_g, *w_out, *w_gate, *w_up, *w_down;
    float* out;
    float *MOD, *LF, *KB2; unsigned short* SC; int* IDX;
    bf16 *WGU, *WD, *WIN, *WOUT, *H, *P, *Y, *XB;
};

template <int MAP> __device__ __forceinline__ int w_rowmap(int n) {
    if (MAP == 1) return 256 * (n >> 7) + (n & 127);
    if (MAP == 2) return 256 * (n >> 7) + 128 + (n & 127);
    if (MAP == 3) { if (n < 1728) return n; if (n < 1744) return PA_IW + (n - 1728); if (n < 3920) return n - 16; if (n < 3928) return PC_F + (n - 3920); return n - 24; }
    return n;
}
template <int MAP> __device__ __forceinline__ void p0_transpose_item(const float* W, int K, int N, bf16* WT, LAS unsigned* T, int item, int lane) {
    const int nblk = (N + 63) / 64, kb = item / nblk, nb = item % nblk, k0 = 64 * kb, n0 = 64 * nb;
    const int r = lane >> 4, c = lane & 15;
    const bool nok = (n0 + 4 * c) < N;
    const float* src = W + (size_t)(k0 + 2 * r) * N + n0 + 4 * c;
    f32x4 a[8], b[8];
#pragma unroll
    for (int i = 0; i < 8; ++i) { a[i] = nok ? *(const GAS f32x4*)(src + (size_t)(8 * i) * N) : (f32x4){0.f, 0.f, 0.f, 0.f}; b[i] = nok ? *(const GAS f32x4*)(src + (size_t)(8 * i + 1) * N) : (f32x4){0.f, 0.f, 0.f, 0.f}; }
#pragma unroll
    for (int i = 0; i < 8; ++i)
#pragma unroll
        for (int e = 0; e < 4; ++e) T[(4 * c + e) * 36 + 4 * i + r] = pk2(a[i][e], b[i][e]);
    LDS_WAIT(); asm volatile("" ::: "memory");
    const int rr = lane >> 3, ch = lane & 7;
#pragma unroll
    for (int j = 0; j < 8; ++j) { const int n = 8 * j + rr; const v4u o = *(const LAS v4u*)(T + n * 36 + 4 * ch);
        if (n0 + n < N) *(GAS v4u*)(WT + (size_t)w_rowmap<MAP>(n0 + n) * K + k0 + 8 * ch) = o; }
    LDS_WAIT(); asm volatile("" ::: "memory");
}
constexpr float W8_SCALE = 64.0f; constexpr int W8_E8M0 = 127 - 6;
__device__ __forceinline__ unsigned pk_fp8x4(float a, float b, float c, float d) {
    a = fminf(fmaxf(a, -448.f), 448.f); b = fminf(fmaxf(b, -448.f), 448.f); c = fminf(fmaxf(c, -448.f), 448.f); d = fminf(fmaxf(d, -448.f), 448.f);
    int w = 0; w = __builtin_amdgcn_cvt_pk_fp8_f32(a, b, w, false); w = __builtin_amdgcn_cvt_pk_fp8_f32(c, d, w, true); return (unsigned)w; }
template <int MAP> __device__ __forceinline__ void p0_transpose8_item(const float* W, int K, int N, unsigned char* WT, int ldw, LAS unsigned* T, int item, int lane) {
    const int nblk = (N + 63) / 64, kb = item / nblk, nb = item % nblk, k0 = 64 * kb, n0 = 64 * nb;
    const int r = lane >> 4, c = lane & 15;
    const bool nok = (n0 + 4 * c) < N;
    const float* src = W + (size_t)(k0 + 4 * r) * N + n0 + 4 * c;
    f32x4 q[4][4];
#pragma unroll
    for (int i = 0; i < 4; ++i)
#pragma unroll
        for (int d = 0; d < 4; ++d) q[i][d] = nok ? *(const GAS f32x4*)(src + (size_t)(16 * i + d) * N) : (f32x4){0.f, 0.f, 0.f, 0.f};
#pragma unroll
    for (int i = 0; i < 4; ++i)
#pragma unroll
        for (int e = 0; e < 4; ++e) T[(4 * c + e) * 20 + 4 * i + r] = pk_fp8x4(q[i][0][e] * W8_SCALE, q[i][1][e] * W8_SCALE, q[i][2][e] * W8_SCALE, q[i][3][e] * W8_SCALE);
    LDS_WAIT(); asm volatile("" ::: "memory");
    const int rr = lane >> 2, ch = lane & 3;
#pragma unroll
    for (int j = 0; j < 4; ++j) { const int n = 16 * j + rr; const v4u o = *(const LAS v4u*)(T + n * 20 + 4 * ch);
        if (n0 + n < N) *(GAS v4u*)(WT + (size_t)w_rowmap<MAP>(n0 + n) * ldw + k0 + 16 * ch) = o; }
    LDS_WAIT(); asm volatile("" ::: "memory");
}
template <int MAP> __device__ __forceinline__ void p0_transpose8(const Frame& F, const float* W, int K, int N, unsigned char* WT, int ldw, LAS unsigned* scr) {
    const int nitems = (K / 64) * ((N + 63) / 64);
    for (int it = F.gw; it < nitems; it += F.NGW) p0_transpose8_item<MAP>(W, K, N, WT, ldw, scr, it, F.lane);
}
template <int MAP> __device__ __forceinline__ void p0_transpose(const Frame& F, const float* W, int K, int N, bf16* WT, LAS unsigned* scr) {
    const int nitems = (K / 64) * ((N + 63) / 64);
    for (int it = F.gw; it < nitems; it += F.NGW) p0_transpose_item<MAP>(W, K, N, WT, scr, it, F.lane);
}
__device__ __forceinline__ void p0_prologue(const Frame& F) {
    LAS unsigned* scr = (LAS unsigned*)(F.lds + RING_OFF + F.wave * 16384);
    LAS float* cond = (LAS float*)(F.lds + AUX_OFF);
    LAS float* red = (LAS float*)(F.lds + RING_OFF);
    for (int i = F.tid; i < BATCH * DM; i += NTHREADS) { const float v = F.c[i]; cond[i] = v / (1.0f + __expf(-v)); }
    __syncthreads();
    for (int it = blockIdx.x; it < DEPTH * (NMOD / 64); it += F.G) {
        const int l = it / (NMOD / 64), n = (it % (NMOD / 64)) * 64 + F.lane;
        const float* w = F.w_ada + (size_t)l * DM * NMOD + (size_t)(256 * F.wave) * NMOD + n;
        const LAS float* c0 = cond + 256 * F.wave; const LAS float* c1 = cond + DM + 256 * F.wave;
        float a0 = 0.f, a1 = 0.f;
#pragma unroll 32
        for (int k = 0; k < 256; ++k) { const float wv = w[(size_t)k * NMOD]; a0 += c0[k] * wv; a1 += c1[k] * wv; }
        red[F.wave * 128 + F.lane] = a0; red[F.wave * 128 + 64 + F.lane] = a1;
        __syncthreads();
        if (F.tid < 128) { float sacc = 0.f;
#pragma unroll
            for (int wv = 0; wv < 8; ++wv) sacc += red[wv * 128 + F.tid];
            const int bsel = F.tid >> 6, nn = (it % (NMOD / 64)) * 64 + (F.tid & 63);
            F.MOD[((size_t)l * BATCH + bsel) * NMOD + nn] = sacc + F.b_ada[(size_t)l * NMOD + nn]; }
        __syncthreads();
    }
    for (int lf = 0; lf < DEPTH * 2; ++lf) {
        if (FFN_FP8) {
            p0_transpose8<1>(F, F.w_gate + (size_t)lf * DM * DFF, DM, DFF, (unsigned char*)F.WGU + (size_t)lf * NGU * DM, DM, scr);
            p0_transpose8<2>(F, F.w_up + (size_t)lf * DM * DFF, DM, DFF, (unsigned char*)F.WGU + (size_t)lf * NGU * DM, DM, scr);
            p0_transpose8<0>(F, F.w_down + (size_t)lf * DFF * DM, DFF, DM, (unsigned char*)F.WD + (size_t)lf * DM * DFFP, DFFP, scr);
        } else {
            p0_transpose<1>(F, F.w_gate + (size_t)lf * DM * DFF, DM, DFF, F.WGU + (size_t)lf * NGU * DM, scr);
            p0_transpose<2>(F, F.w_up + (size_t)lf * DM * DFF, DM, DFF, F.WGU + (size_t)lf * NGU * DM, scr);
            p0_transpose<0>(F, F.w_down + (size_t)lf * DFF * DM, DFF, DM, F.WD + (size_t)lf * DM * DFF, scr);
        }
    }
    for (int l = 0; l < DEPTH; ++l) {
        p0_transpose<3>(F, F.w_in + (size_t)l * DM * INC, DM, INC, F.WIN + (size_t)l * NIN * DM, scr);
        p0_transpose<0>(F, F.w_out + (size_t)l * DM * DM, DM, DM, F.WOUT + (size_t)l * DM * DM, scr);
        GAS v4u* z = (GAS v4u*)(F.WIN + (size_t)l * NIN * DM + (size_t)INC * DM);
        for (int i = F.gw * 64 + F.lane; i < (NIN - INC) * DM / 8; i += F.NGW * 64) z[i] = (v4u){0u, 0u, 0u, 0u};
    }
}

template <bool OUT8, bool IN16> __device__ __forceinline__ void ph_modulate(const Frame& F, const void* xin, const float* g, const float* shift, const float* scale) {
    if constexpr (IN16) {
        f32x4 av[4][2], hv[4][2]; int cb = -1;
        int m = F.gw;
        v4u wc[4];
        if (m < M) { const GAS v4u* xr = (const GAS v4u*)((const bf16*)xin + (size_t)m * DM) + F.lane;
#pragma unroll
            for (int j = 0; j < 4; ++j) wc[j] = xr[64 * j]; }
        while (m < M) {
            const int mn = m + F.NGW; const int b = m / SEQ;
            v4u wn[4];
            if (mn < M) { const GAS v4u* xr = (const GAS v4u*)((const bf16*)xin + (size_t)mn * DM) + F.lane;
#pragma unroll
                for (int j = 0; j < 4; ++j) wn[j] = xr[64 * j]; }
            else {
#pragma unroll
                for (int j = 0; j < 4; ++j) wn[j] = (v4u){0u, 0u, 0u, 0u}; }
            if (b != cb) { cb = b;
                const GAS f32x4* gp = (const GAS f32x4*)g + 2 * F.lane; const GAS f32x4* sh = (const GAS f32x4*)(shift + (size_t)b * NMOD) + 2 * F.lane; const GAS f32x4* sc = (const GAS f32x4*)(scale + (size_t)b * NMOD) + 2 * F.lane;
#pragma unroll
                for (int j = 0; j < 4; ++j)
#pragma unroll
                    for (int h = 0; h < 2; ++h) { const f32x4 gg = gp[128 * j + h], ss = sc[128 * j + h]; hv[j][h] = sh[128 * j + h]; av[j][h] = gg * (ss + 1.0f); } }
            float x[4][8]; float s = 0.f;
#pragma unroll
            for (int j = 0; j < 4; ++j) { x[j][0] = bf_lo(wc[j].x); x[j][1] = bf_hi(wc[j].x); x[j][2] = bf_lo(wc[j].y); x[j][3] = bf_hi(wc[j].y); x[j][4] = bf_lo(wc[j].z); x[j][5] = bf_hi(wc[j].z); x[j][6] = bf_lo(wc[j].w); x[j][7] = bf_hi(wc[j].w); }
#pragma unroll
            for (int j = 0; j < 4; ++j) s += ((x[j][0] * x[j][0] + x[j][1] * x[j][1]) + (x[j][2] * x[j][2] + x[j][3] * x[j][3])) + ((x[j][4] * x[j][4] + x[j][5] * x[j][5]) + (x[j][6] * x[j][6] + x[j][7] * x[j][7]));
            const float rstd = 1.0f / sqrtf(wave_sum(s) * (1.f / DM) + RMS_EPS);
            GAS v4u* o16 = (GAS v4u*)(F.H + (size_t)m * DM) + F.lane;
            GAS v2u* o8 = (GAS v2u*)((unsigned char*)F.H + (size_t)m * DM) + F.lane;
#pragma unroll
            for (int j = 0; j < 4; ++j) { float y[8];
#pragma unroll
                for (int h = 0; h < 2; ++h) { const f32x4 aa = av[j][h], hh = hv[j][h];
                    y[4 * h + 0] = x[j][4 * h + 0] * rstd * aa.x + hh.x; y[4 * h + 1] = x[j][4 * h + 1] * rstd * aa.y + hh.y;
                    y[4 * h + 2] = x[j][4 * h + 2] * rstd * aa.z + hh.z; y[4 * h + 3] = x[j][4 * h + 3] * rstd * aa.w + hh.w; }
                if (OUT8) { v2u w; w.x = pk_fp8x4(y[0], y[1], y[2], y[3]); w.y = pk_fp8x4(y[4], y[5], y[6], y[7]); o8[64 * j] = w; }
                else { v4u w; w.x = pk2(y[0], y[1]); w.y = pk2(y[2], y[3]); w.z = pk2(y[4], y[5]); w.w = pk2(y[6], y[7]); o16[64 * j] = w; } }
#pragma unroll
            for (int j = 0; j < 4; ++j) wc[j] = wn[j];
            m = mn;
        }
        return;
    }
    for (int m = F.gw; m < M; m += F.NGW) {
        const int b = m / SEQ;
        float x[4][8]; float s = 0.f;
        if constexpr (IN16) {
            const GAS v4u* xr = (const GAS v4u*)((const bf16*)xin + (size_t)m * DM) + F.lane;
            v4u w[4];
#pragma unroll
            for (int j = 0; j < 4; ++j) w[j] = xr[64 * j];
#pragma unroll
            for (int j = 0; j < 4; ++j) { x[j][0] = bf_lo(w[j].x); x[j][1] = bf_hi(w[j].x); x[j][2] = bf_lo(w[j].y); x[j][3] = bf_hi(w[j].y); x[j][4] = bf_lo(w[j].z); x[j][5] = bf_hi(w[j].z); x[j][6] = bf_lo(w[j].w); x[j][7] = bf_hi(w[j].w); }
        } else {
            const GAS f32x4* xr = (const GAS f32x4*)((const float*)xin + (size_t)m * DM) + 2 * F.lane;
            f32x4 a[4][2];
#pragma unroll
            for (int j = 0; j < 4; ++j) { a[j][0] = xr[128 * j]; a[j][1] = xr[128 * j + 1]; }
            GAS v4u* xo = (GAS v4u*)(F.XB + (size_t)m * DM) + F.lane;
#pragma unroll
            for (int j = 0; j < 4; ++j) { x[j][0] = a[j][0].x; x[j][1] = a[j][0].y; x[j][2] = a[j][0].z; x[j][3] = a[j][0].w; x[j][4] = a[j][1].x; x[j][5] = a[j][1].y; x[j][6] = a[j][1].z; x[j][7] = a[j][1].w;
                v4u w; w.x = pk2(x[j][0], x[j][1]); w.y = pk2(x[j][2], x[j][3]); w.z = pk2(x[j][4], x[j][5]); w.w = pk2(x[j][6], x[j][7]); xo[64 * j] = w; }
        }
#pragma unroll
        for (int j = 0; j < 4; ++j) s += ((x[j][0] * x[j][0] + x[j][1] * x[j][1]) + (x[j][2] * x[j][2] + x[j][3] * x[j][3])) + ((x[j][4] * x[j][4] + x[j][5] * x[j][5]) + (x[j][6] * x[j][6] + x[j][7] * x[j][7]));
        const float rstd = 1.0f / sqrtf(wave_sum(s) * (1.f / DM) + RMS_EPS);
        const GAS f32x4* gp = (const GAS f32x4*)g + 2 * F.lane; const GAS f32x4* sh = (const GAS f32x4*)(shift + (size_t)b * NMOD) + 2 * F.lane; const GAS f32x4* sc = (const GAS f32x4*)(scale + (size_t)b * NMOD) + 2 * F.lane;
        GAS v4u* o16 = (GAS v4u*)(F.H + (size_t)m * DM) + F.lane;
        GAS v2u* o8 = (GAS v2u*)((unsigned char*)F.H + (size_t)m * DM) + F.lane;
#pragma unroll
        for (int j = 0; j < 4; ++j) { float y[8];
#pragma unroll
            for (int h = 0; h < 2; ++h) { const f32x4 gg = gp[128 * j + h], ss = sc[128 * j + h], hh = sh[128 * j + h];
                y[4 * h + 0] = x[j][4 * h + 0] * rstd * gg.x * (ss.x + 1.0f) + hh.x; y[4 * h + 1] = x[j][4 * h + 1] * rstd * gg.y * (ss.y + 1.0f) + hh.y;
                y[4 * h + 2] = x[j][4 * h + 2] * rstd * gg.z * (ss.z + 1.0f) + hh.z; y[4 * h + 3] = x[j][4 * h + 3] * rstd * gg.w * (ss.w + 1.0f) + hh.w; }
            if (OUT8) { v2u w; w.x = pk_fp8x4(y[0], y[1], y[2], y[3]); w.y = pk_fp8x4(y[4], y[5], y[6], y[7]); o8[64 * j] = w; }
            else { v4u w; w.x = pk2(y[0], y[1]); w.y = pk2(y[2], y[3]); w.z = pk2(y[4], y[5]); w.w = pk2(y[6], y[7]); o16[64 * j] = w; } }
    }
}
__device__ __forceinline__ v4u headnorm8(v4u w, const float* g, float mul, int lane, bool normalize) {
    float x[8] = {bf_lo(w.x), bf_hi(w.x), bf_lo(w.y), bf_hi(w.y), bf_lo(w.z), bf_hi(w.z), bf_lo(w.w), bf_hi(w.w)};
    float r = mul;
    if (normalize) {
        float s = 0.f;
#pragma unroll
        for (int i = 0; i < 8; ++i) s += x[i] * x[i];
        s += __shfl_xor(s, 1); s += __shfl_xor(s, 2); s += __shfl_xor(s, 4);
        r = mul / sqrtf(s * (1.f / 64.f) + RMS_EPS);
        const f32x4 g0 = *(const GAS f32x4*)(g + 8 * (lane & 7)), g1 = *(const GAS f32x4*)(g + 8 * (lane & 7) + 4);
        x[0] *= g0.x; x[1] *= g0.y; x[2] *= g0.z; x[3] *= g0.w; x[4] *= g1.x; x[5] *= g1.y; x[6] *= g1.z; x[7] *= g1.w;
    }
    w.x = pk2(x[0] * r, x[1] * r); w.y = pk2(x[2] * r, x[3] * r); w.z = pk2(x[4] * r, x[5] * r); w.w = pk2(x[6] * r, x[7] * r);
    return w;
}
__device__ __forceinline__ v4u headnorm8g(v4u w, f32x4 g0, f32x4 g1, float mul, bool normalize) {
    float x[8] = {bf_lo(w.x), bf_hi(w.x), bf_lo(w.y), bf_hi(w.y), bf_lo(w.z), bf_hi(w.z), bf_lo(w.w), bf_hi(w.w)};
    float r = mul;
    if (normalize) {
        float s = 0.f;
#pragma unroll
        for (int i = 0; i < 8; ++i) s += x[i] * x[i];
        s += __shfl_xor(s, 1); s += __shfl_xor(s, 2); s += __shfl_xor(s, 4);
        r = mul / sqrtf(s * (1.f / 64.f) + RMS_EPS);
        x[0] *= g0.x; x[1] *= g0.y; x[2] *= g0.z; x[3] *= g0.w; x[4] *= g1.x; x[5] *= g1.y; x[6] *= g1.z; x[7] *= g1.w;
    }
    w.x = pk2(x[0] * r, x[1] * r); w.y = pk2(x[2] * r, x[3] * r); w.z = pk2(x[4] * r, x[5] * r); w.w = pk2(x[6] * r, x[7] * r);
    return w;
}
__device__ __forceinline__ void ph_post(const Frame& F, int l) {
    const float* qg = F.qk_g + (size_t)l * 6 * HD; const int lane = F.lane;
    f32x4 gq[6][2];
    { const int gi[5] = {0, 2, 4, 5, (lane < 8 ? 1 : 3)};
#pragma unroll
      for (int i = 0; i < 5; ++i) { const float* gp = qg + gi[i] * HD + 8 * (lane & 7); gq[i][0] = *(const GAS f32x4*)gp; gq[i][1] = *(const GAS f32x4*)(gp + 4); } }
    const int koff = (lane < 8 ? PA_K : PB_K) + 8 * (lane & 7);
    int m = F.gw;
    v4u wc[6];
#define POST_LOAD(mm_, W) do { const bf16* row_ = F.P + (size_t)(mm_) * NIN; W[0] = *(const GAS v4u*)(row_ + PA_Q + 8 * lane); W[1] = *(const GAS v4u*)(row_ + PB_Q + 8 * lane); W[2] = *(const GAS v4u*)(row_ + PC_Q + 8 * lane); \
        W[3] = *(const GAS v4u*)(row_ + PC_K + 8 * lane); W[4] = *(const GAS v4u*)(row_ + PD_Q + 8 * lane); W[5] = (v4u){0u, 0u, 0u, 0u}; if (lane < 16) W[5] = *(const GAS v4u*)(row_ + koff); } while (0)
    if (m < M) POST_LOAD(m, wc);
    while (m < M) {
        const int mn = m + F.NGW;
        v4u wn[6];
        if (mn < M) POST_LOAD(mn, wn);
        else {
#pragma unroll
            for (int i = 0; i < 6; ++i) wn[i] = (v4u){0u, 0u, 0u, 0u}; }
        bf16* row = F.P + (size_t)m * NIN;
        *(GAS v4u*)(row + PA_Q + 8 * lane) = headnorm8g(wc[0], gq[0][0], gq[0][1], QSCALE, true);
        *(GAS v4u*)(row + PB_Q + 8 * lane) = headnorm8g(wc[1], gq[1][0], gq[1][1], QSCALE, true);
        *(GAS v4u*)(row + PC_Q + 8 * lane) = headnorm8g(wc[2], gq[2][0], gq[2][1], QSCALE, true);
        *(GAS v4u*)(row + PC_K + 8 * lane) = headnorm8g(wc[3], gq[3][0], gq[3][1], 1.0f, true);
        *(GAS v4u*)(row + PD_Q + 8 * lane) = headnorm8g(wc[4], gq[0][0], gq[0][1], QSCALE, false);
        if (lane < 16) *(GAS v4u*)(row + koff) = headnorm8g(wc[5], gq[4][0], gq[4][1], 1.0f, true);
#pragma unroll
        for (int i = 0; i < 6; ++i) wc[i] = wn[i];
        m = mn;
    }
#undef POST_LOAD
}
__device__ __forceinline__ void ph_scan(const Frame& F, int l) {
    LAS float* wtot = (LAS float*)(F.lds + RING_OFF);
    for (int sq = blockIdx.x; sq < BATCH * NH; sq += F.G) {
        const int b = sq / NH, h = sq % NH; const float fb = F.forget_b[(size_t)l * NH + h];
        const GAS unsigned short* src = (const GAS unsigned short*)(F.P + ((size_t)b * SEQ + 16 * F.tid) * NIN + PC_F + h); float* dst = F.KB2 + (size_t)sq * SEQ + 16 * F.tid;
        float v[16]; unsigned short raw[16];
#pragma unroll
        for (int i = 0; i < 16; ++i) raw[i] = src[(size_t)i * NIN];
#pragma unroll
        for (int i = 0; i < 16; ++i) { const float y = __builtin_bit_cast(float, (unsigned)raw[i] << 16) + fb; v[i] = (y >= 0.f) ? -log1pf(__expf(-y)) : (y - log1pf(__expf(y))); }
#pragma unroll
        for (int i = 1; i < 16; ++i) v[i] += v[i - 1];
        float incl = v[15];
#pragma unroll
        for (int o = 1; o < 64; o <<= 1) { const float t = __shfl_up(incl, o); if (F.lane >= o) incl += t; }
        if (F.lane == 63) wtot[F.wave] = incl;
        __syncthreads();
        float base = incl - v[15];
        for (int w = 0; w < F.wave; ++w) base += wtot[w];
#pragma unroll
        for (int i = 0; i < 4; ++i) *(GAS f32x4*)(dst + 4 * i) = (f32x4){-(v[4 * i] + base) * LOG2E, -(v[4 * i + 1] + base) * LOG2E, -(v[4 * i + 2] + base) * LOG2E, -(v[4 * i + 3] + base) * LOG2E};
        __syncthreads();
    }
}
__device__ __forceinline__ void ph_gnorm(const Frame& F, int l) {
    const float* gg = F.group_g + (size_t)l * DM;
    f32x4 gv[4][2];
#pragma unroll
    for (int g = 0; g < 4; ++g) { gv[g][0] = *(const GAS f32x4*)(gg + g * GWID + 8 * F.lane); gv[g][1] = *(const GAS f32x4*)(gg + g * GWID + 8 * F.lane + 4); }
    int m = F.gw;
    v4u wc[4];
    if (m < M) {
#pragma unroll
        for (int g = 0; g < 4; ++g) wc[g] = *(GAS v4u*)(F.Y + (size_t)m * DM + g * GWID + 8 * F.lane); }
    while (m < M) {
        const int mn = m + F.NGW;
        v4u wn[4];
        if (mn < M) {
#pragma unroll
            for (int g = 0; g < 4; ++g) wn[g] = *(GAS v4u*)(F.Y + (size_t)mn * DM + g * GWID + 8 * F.lane); }
        else {
#pragma unroll
            for (int g = 0; g < 4; ++g) wn[g] = (v4u){0u, 0u, 0u, 0u}; }
#pragma unroll
        for (int g = 0; g < 4; ++g) {
            bf16* p = F.Y + (size_t)m * DM + g * GWID + 8 * F.lane;
            float x[8] = {bf_lo(wc[g].x), bf_hi(wc[g].x), bf_lo(wc[g].y), bf_hi(wc[g].y), bf_lo(wc[g].z), bf_hi(wc[g].z), bf_lo(wc[g].w), bf_hi(wc[g].w)};
            float s = 0.f;
#pragma unroll
            for (int i = 0; i < 8; ++i) s += x[i] * x[i];
            const float r = 1.0f / sqrtf(wave_sum(s) * (1.f / GWID) + RMS_EPS);
            const f32x4 g0 = gv[g][0], g1 = gv[g][1];
            v4u o; o.x = pk2(x[0] * r * g0.x, x[1] * r * g0.y); o.y = pk2(x[2] * r * g0.z, x[3] * r * g0.w); o.z = pk2(x[4] * r * g1.x, x[5] * r * g1.y); o.w = pk2(x[6] * r * g1.z, x[7] * r * g1.w);
            *(GAS v4u*)p = o;
        }
#pragma unroll
        for (int g = 0; g < 4; ++g) wc[g] = wn[g];
        m = mn;
    }
}


__device__ __forceinline__ unsigned short score_key(float sc) {
    const _Float16 hf = (_Float16)fminf(fmaxf(sc, -60000.f), 60000.f);
    const unsigned h = (unsigned)__builtin_bit_cast(unsigned short, hf);
    return (unsigned short)((h & 0x8000u) ? (~h & 0xffffu) : (h | 0x8000u));
}
__device__ __forceinline__ void glds16x(const void* gsrc, unsigned lds_dst) { unsigned keep;
    asm volatile("s_mov_b32 %0, m0\n\ts_mov_b32 m0, %2\n\ts_nop 0\n\tglobal_load_lds_dwordx4 %1, off\n\ts_mov_b32 m0, %0" : "=&s"(keep) : "v"(gsrc), "s"(lds_dst) : "memory"); }
__device__ __forceinline__ void ph_idx_scores(const Frame& F) {
    constexpr int UPB = 8 * (16 * 17 / 2), NU = BATCH * UPB;
    const int lane = F.lane, r32 = lane & 31, hi = lane >> 5;
    const int u_lo = (int)(((long)blockIdx.x * NU) / F.G), u_hi = (int)(((long)(blockIdx.x + 1) * NU) / F.G);
    if (u_lo >= u_hi) return;
    int b = u_lo / UPB, qb = 127, kc = 0; { int r = u_lo % UPB; for (;;) { const int n = (qb >> 3) + 1; if (r < n) { kc = r; break; } r -= n; --qb; } }
    LAS unsigned char* KL = F.lds + RING_OFF;
    const unsigned kl_lds = (unsigned)(size_t)KL;
#define X1_STAGE(bb, kk, buf) do { const bf16* ksrc_ = F.P + ((size_t)(bb) * SEQ + 512 * (kk) + 64 * F.wave + lane) * NIN + PA_IK; \
        _Pragma("unroll") for (int c_ = 0; c_ < 8; ++c_) glds16x(ksrc_ + 8 * c_, (unsigned)__builtin_amdgcn_readfirstlane(kl_lds + (buf) * 65536 + c_ * 8192 + F.wave * 1024)); } while (0)
    X1_STAGE(b, kc, 0);
    asm volatile("s_waitcnt vmcnt(0)" ::: "memory"); __syncthreads();
    bf16x8 af[4][4]; float wq[4][16]; int cb = -1, cqb = -1;
    for (int u = u_lo; u < u_hi; ++u) {
        const int cur = (u - u_lo) & 1;
        int nb = b, nqb = qb, nkc = kc + 1; if (nkc > (qb >> 3)) { nkc = 0; --nqb; if (nqb < 0) { nqb = 127; ++nb; } }
        if (u + 1 < u_hi) X1_STAGE(nb, nkc, cur ^ 1);
        const size_t rowb = (size_t)b * SEQ; const int t0 = 64 * qb + 8 * F.wave;
        if (b != cb || qb != cqb) { cb = b; cqb = qb;
#pragma unroll
            for (int pr = 0; pr < 4; ++pr) {
                const bf16* qrow = F.P + (rowb + t0 + 2 * pr + ((r32 >> 2) & 1)) * NIN + PA_IQ + ((r32 & 3) + 4 * (r32 >> 3)) * 64 + 8 * hi;
#pragma unroll
                for (int s = 0; s < 4; ++s) af[pr][s] = *(const GAS bf16x8*)(qrow + 16 * s);
                const bf16* wrow = F.P + (rowb + t0 + 2 * pr + hi) * NIN + PA_IW;
                const v4u w0 = *(const GAS v4u*)wrow, w1 = *(const GAS v4u*)(wrow + 8);
                const unsigned ww[8] = {w0.x, w0.y, w0.z, w0.w, w1.x, w1.y, w1.z, w1.w};
#pragma unroll
                for (int i = 0; i < 8; ++i) { wq[pr][2 * i] = bf_lo(ww[i]) * 0.015625f; wq[pr][2 * i + 1] = bf_hi(ww[i]) * 0.015625f; }
            }
        }
        const int kend = 64 * (qb + 1) - 512 * kc;
        const int nkt = kend >= 512 ? 16 : (kend + 31) / 32;
        const LAS unsigned char* kl = KL + cur * 65536 + hi * 8192 + r32 * 16;
        for (int kt = 0; kt < nkt; ++kt) {
            bf16x8 bfr[4];
#pragma unroll
            for (int s = 0; s < 4; ++s) bfr[s] = *(const LAS bf16x8*)(kl + s * 16384 + kt * 512);
            const int s0 = 512 * kc + 32 * kt;
#pragma unroll
            for (int pr = 0; pr < 4; ++pr) {
                f32x16 acc = {};
#pragma unroll
                for (int s = 0; s < 4; ++s) acc = __builtin_amdgcn_mfma_f32_32x32x16_bf16(af[pr][s], bfr[s], acc, 0, 0, 0);
                float sc0 = 0.f, sc1 = 0.f;
#pragma unroll
                for (int r = 0; r < 16; ++r) { sc0 = __builtin_fmaf(wq[pr][r], acc[r], sc0); sc1 = __builtin_fmaf(wq[pr][r], __builtin_fabsf(acc[r]), sc1); if ((r & 3) == 3) asm("" : "+v"(sc1)); }
                ((GAS unsigned short*)F.SC)[(rowb + t0 + 2 * pr + hi) * SEQ + s0 + r32] = score_key(sc0 + sc1);
                __builtin_amdgcn_sched_barrier(0);
            }
        }
        asm volatile("s_waitcnt vmcnt(0)" ::: "memory");
        __syncthreads();
        b = nb; qb = nqb; kc = nkc;
    }
#undef X1_STAGE
}

__device__ __forceinline__ unsigned mbcnt64(unsigned long long m) { return __builtin_amdgcn_mbcnt_hi((unsigned)(m >> 32), __builtin_amdgcn_mbcnt_lo((unsigned)m, 0u)); }
template <int SH, int PSH> __device__ __forceinline__ void sel_level(const unsigned (&v)[64], int nreg, unsigned pval, unsigned need, LAS unsigned* hist, int lane, unsigned& bin_out, unsigned& above_out) {
#pragma unroll
    for (int i = 0; i < 8; ++i) ((LAS v4u*)hist)[lane + 64 * i] = (v4u){0u, 0u, 0u, 0u};
    LDS_WAIT(); __builtin_amdgcn_wave_barrier();
    const unsigned hb = (unsigned)(size_t)hist, sink = hb + 9216u + 4u * (unsigned)lane;
#pragma unroll
    for (int g = 0; g < 8; ++g) if (8 * g < nreg) {
#pragma unroll
        for (int jj = 0; jj < 8; ++jj) { const int j = 8 * g + jj;
#pragma unroll
            for (int e = 0; e < 2; ++e) { const unsigned k = e ? (v[j] >> 16) : (v[j] & 0xffffu);
                const bool pred = (k != 0u) && (PSH >= 16 || (k >> (PSH & 15)) == pval);
                const unsigned tgt = pred ? hb + (((k >> SH) & 2047u) << 2) : sink;
                __hip_atomic_fetch_add((LAS unsigned*)tgt, 1u, __ATOMIC_RELAXED, __HIP_MEMORY_SCOPE_WAVEFRONT); }
            if ((jj & 1) == 1) __builtin_amdgcn_sched_barrier(0); }
    }
    LDS_WAIT(); __builtin_amdgcn_wave_barrier();
    unsigned S = 0u;
#pragma unroll
    for (int i = 0; i < 8; ++i) { const v4u q = ((LAS v4u*)hist)[lane * 8 + i]; S += (q.x + q.y) + (q.z + q.w); }
    unsigned T = S;
#pragma unroll
    for (int o = 1; o < 64; o <<= 1) { const unsigned t = __shfl_down(T, o); if (lane + o < 64) T += t; }
    const unsigned above_lane = T - S;
    const bool cross = (T >= need) && (above_lane < need);
    unsigned run = above_lane, bin = 0u, ab = 0u; bool found = false;
#pragma unroll
    for (int i = 7; i >= 0; --i) { const v4u q = ((LAS v4u*)hist)[lane * 8 + i]; const unsigned c4[4] = {q.x, q.y, q.z, q.w};
#pragma unroll
        for (int e = 3; e >= 0; --e) { const bool hit = !found && (run + c4[e] >= need); if (hit) { bin = 32u * lane + 4 * i + e; ab = run; found = true; } run += c4[e]; } }
    const unsigned long long cm = __ballot(cross);
    const int src = cm ? (int)__builtin_ctzll(cm) : 0;
    bin_out = __builtin_amdgcn_readlane(bin, src); above_out = __builtin_amdgcn_readlane(ab, src);
    LDS_WAIT(); __builtin_amdgcn_wave_barrier();
}
__device__ __forceinline__ void select_row(const Frame& F, int m, LAS unsigned* hist, LAS int* out) {
    int lane = F.lane; asm volatile("" : "+v"(lane));
    const int t = m % SEQ, n = t + 1;
    if (n <= TOPK) { for (int j = lane; j < TOPK; j += 64) out[j] = (j < n) ? j : 0; return; }
    const int nreg = (n + 127) >> 7;
    unsigned v[64];
    const GAS unsigned* pr = (const GAS unsigned*)(F.SC + (size_t)m * SEQ) + lane;
#pragma unroll
    for (int g = 0; g < 8; ++g) {
        if (8 * g < nreg) {
#pragma unroll
            for (int jj = 0; jj < 8; ++jj) v[8 * g + jj] = pr[jj * 64];
        } else {
#pragma unroll
            for (int jj = 0; jj < 8; ++jj) v[8 * g + jj] = 0u;
        }
        pr += 512; asm volatile("" : "+v"(pr));
    }
    const int nfull = n >> 7;
#pragma unroll
    for (int g = 0; g < 8; ++g) if (8 * g < nreg && 8 * g + 8 > nfull) {
#pragma unroll
        for (int jj = 0; jj < 8; ++jj) { const int j = 8 * g + jj; const int e0 = 128 * j + 2 * lane; const unsigned w = v[j];
            v[j] = ((e0 < n) ? (w & 0xffffu) : 0u) | ((e0 + 1 < n) ? (w & 0xffff0000u) : 0u); asm volatile("" : "+v"(v[j])); }
    }
    unsigned b1, a1, b2, a2;
    sel_level<5, 16>(v, nreg, 0u, (unsigned)TOPK, hist, lane, b1, a1);
    sel_level<0, 5>(v, nreg, b1, (unsigned)TOPK - a1, hist, lane, b2, a2);
    const unsigned tau = (b1 << 5) | (b2 & 31u);
    const unsigned quota = (unsigned)TOPK - a1 - a2;
    unsigned mg[4] = {0u, 0u, 0u, 0u}, me[4] = {0u, 0u, 0u, 0u};
#pragma unroll
    for (int g = 0; g < 8; ++g) {
        if (8 * g < nreg) {
#pragma unroll
            for (int jj = 0; jj < 8; ++jj) { const int j = 8 * g + jj;
#pragma unroll
                for (int e = 0; e < 2; ++e) { const unsigned k = e ? (v[j] >> 16) : (v[j] & 0xffffu);
                    mg[g >> 1] = mg[g >> 1] + mg[g >> 1] + ((k > tau) ? 1u : 0u); me[g >> 1] = me[g >> 1] + me[g >> 1] + ((k == tau) ? 1u : 0u); }
                if ((jj & 3) == 3) __builtin_amdgcn_sched_barrier(0); }
        } else { mg[g >> 1] <<= 16; me[g >> 1] <<= 16; }
    }
    const unsigned cg = (unsigned)(__builtin_popcount(mg[0]) + __builtin_popcount(mg[1]) + __builtin_popcount(mg[2]) + __builtin_popcount(mg[3]));
    unsigned ce = (unsigned)(__builtin_popcount(me[0]) + __builtin_popcount(me[1]) + __builtin_popcount(me[2]) + __builtin_popcount(me[3]));
    unsigned incl = cg | (ce << 16);
#pragma unroll
    for (int o = 1; o < 64; o <<= 1) { const unsigned t = (unsigned)__shfl_up((int)incl, o); if (lane >= o) incl += t; }
    const unsigned excl = incl - (cg | (ce << 16));
    const unsigned pre_g = excl & 0xffffu, pre_e = excl >> 16;
    const unsigned keep = pre_e >= quota ? 0u : ((quota - pre_e) < ce ? (quota - pre_e) : ce);
#pragma unroll
    for (int q = 3; q >= 0; --q) { while (ce > keep && me[q] != 0u) { me[q] &= me[q] - 1u; --ce; } }
    unsigned pos = pre_g + (pre_e < quota ? pre_e : quota);
    const int ilane = 2 * lane;
#pragma unroll
    for (int q = 0; q < 4; ++q) { unsigned mm = mg[q] | me[q];
        while (mm != 0u) { const int bpos = 31 - (int)__builtin_clz(mm); const int sl = 31 - bpos; mm &= ~(1u << bpos);
            const int i = 128 * (16 * q + (sl >> 1)) + ilane + (sl & 1);
            if (pos < (unsigned)TOPK) out[pos] = i;
            ++pos; } }
}


constexpr int AT_K = 0, AT_V = 16384, AT_KB = 32768, AT_WSF = 33280, AT_BT = 35328, AT_DEAD = 35840, AT_SV = 36864;
typedef short v4i16_t __attribute__((ext_vector_type(4)));
__device__ __forceinline__ s16x4 vtr(const LAS unsigned char* p) { return __builtin_bit_cast(s16x4, __builtin_amdgcn_ds_read_tr16_b64_v4i16((LAS v4i16_t*)p)); }
typedef __bf16 bfpair_t __attribute__((ext_vector_type(2))); typedef float f32pair_t __attribute__((ext_vector_type(2)));
__device__ __forceinline__ unsigned cvtpk(float lo, float hi) { const f32pair_t v = {lo, hi}; return __builtin_bit_cast(unsigned, __builtin_convertvector(v, bfpair_t)); }
#define NEG_INF (-__builtin_inff())

template <int TYPE>
__device__ __forceinline__ void dense_attn_unit(const Frame& F, int l, int b, int h, int qb) {
    constexpr int QOFF = TYPE == 1 ? PB_Q : TYPE == 2 ? PC_Q : PD_Q, KOFF = TYPE == 1 ? PB_K : TYPE == 2 ? PC_K : PD_K, VOFF = TYPE == 1 ? PB_V : TYPE == 2 ? PC_V : PD_V;
    constexpr bool MQA = TYPE == 1; constexpr int YOFF = TYPE * GWID;
    const int tid = F.tid, lane = F.lane, wid = F.wave, r32 = lane & 31, hi = lane >> 5;
    LAS unsigned char* L = F.lds + RING_OFF;
    LAS float* wsf = (LAS float*)(L + AT_WSF + wid * 256);
    LAS float* BT = (LAS float*)(L + AT_BT);
    const int hq = (TYPE == 1) ? wid : h, qoff = (TYPE == 1) ? (qb & 7) * 32 : wid * 32, qb256 = (TYPE == 1) ? (qb >> 3) : qb;
    const size_t rowb = (size_t)b * SEQ; const int q0 = qb256 * 256;
    const bf16* Pk = F.P + rowb * NIN + KOFF + (MQA ? 0 : h * 64);
    const bf16* Pv = F.P + rowb * NIN + VOFF + (MQA ? 0 : h * 64);
    const bf16* Pq = F.P + (rowb + q0 + qoff + r32) * NIN + QOFF + hq * 64 + hi * 8;
    bf16x8 qr[4];
#pragma unroll
    for (int d0 = 0; d0 < 4; ++d0) qr[d0] = *(const GAS bf16x8*)(Pq + 16 * d0);
    const int jt_hi = (TYPE == 1) ? ((q0 + qoff + 31) >> 6) : 4 * qb256 + 3, jt_lo = (TYPE == 1) ? (((q0 + qoff - (WINDOW - 1)) > 0 ? (q0 + qoff - (WINDOW - 1)) : 0) >> 6) : 0, nt = jt_hi - jt_lo + 1;
    if (TYPE == 1) { LAS float* BTall = (LAS float*)(L + AT_SV);
        for (int i = tid; i < 8 * 128; i += NTHREADS) BTall[i] = F.rel_table[(int)kBucketLut[i & 127] * 16 + 8 + (i >> 7)] * LOG2E;
        BT = BTall + 128 * wid; }
    const bf16* kgp = Pk + (size_t)(8 * wid + (lane >> 3)) * NIN + (lane & 7) * 8;
    const int vkey = tid >> 3, vch = tid & 7;
    const bf16* vgp = Pv + (size_t)vkey * NIN + vch * 8;
    const int kl = (lane & 7) * 1024 + (8 * wid + (lane >> 3)) * 16;
    const int vl = (vch >> 2) * 4096 + (vkey >> 3) * 512 + (vkey & 7) * 64 + (vch & 3) * 16;
    const float* kb2 = F.KB2 + ((size_t)b * NH + h) * SEQ;
    v4u kreg = *(const GAS v4u*)(kgp + (size_t)jt_hi * 64 * NIN), vreg = *(const GAS v4u*)(vgp + (size_t)jt_hi * 64 * NIN);
    float kbreg = 0.f; if (TYPE == 2 && tid < 64) kbreg = kb2[jt_hi * 64 + tid];
    *(LAS v4u*)(L + AT_K + kl) = kreg; *(LAS v4u*)(L + AT_V + vl) = vreg; if (TYPE == 2 && tid < 64) ((LAS float*)(L + AT_KB))[tid] = kbreg;
    __syncthreads();
    f32x16 o[2]; o[0] = f32x16{}; o[1] = f32x16{};
    float mrun = NEG_INF, lsum = 0.f, carry = 1.f;
    float qbound = 0.f;
    if (TYPE == 2) {
        float ss = 0.f;
#pragma unroll
        for (int d0 = 0; d0 < 4; ++d0)
#pragma unroll
            for (int j = 0; j < 8; ++j) { const float x = bf2f((bf16)qr[d0][j]); ss += x * x; }
        ss += __shfl_xor(ss, 32);
        float gm = fabsf(F.qk_g[((size_t)l * 6 + 5) * HD + lane]);
#pragma unroll
        for (int o = 1; o < 64; o <<= 1) gm = fmaxf(gm, __shfl_xor(gm, o));
        qbound = sqrtf(ss) * 8.08f * gm;
    }
    const int qrel = qoff + r32;
    const int vb = ((lane >> 4) & 1) * 32 + (lane & 3) * 8 + (4 * hi + ((lane & 15) >> 2)) * 64;
    LAS unsigned* deadf = (LAS unsigned*)(L + AT_DEAD);
    for (int i = 0; i < nt; ++i) {
        const int jt = jt_hi - i, cur = i & 1, jb = jt - 4 * qb256; const bool more = (i + 1 < nt);
        float kbnext = 0.f;
        if (more) { kreg = *(const GAS v4u*)(kgp + (size_t)(jt - 1) * 64 * NIN); vreg = *(const GAS v4u*)(vgp + (size_t)(jt - 1) * 64 * NIN); if (TYPE == 2 && tid < 64) kbreg = kb2[(jt - 1) * 64 + tid]; if (TYPE == 2) kbnext = kb2[jt * 64 - 1]; }
        const bool active = (64 * jb <= qoff + 31) && (TYPE != 1 || (64 * jb + 63 >= qoff - (WINDOW - 1)));
        if (active) {
            const LAS unsigned char* Kb = L + AT_K + cur * 8192; const LAS unsigned char* Vb = L + AT_V + cur * 8192;
            f32x16 p0 = f32x16{}, p1 = f32x16{};
            bf16x8 ka[4], kc[4];
#pragma unroll
            for (int d0 = 0; d0 < 4; ++d0) { ka[d0] = *(const LAS bf16x8*)(Kb + (2 * d0 + hi) * 1024 + r32 * 16); kc[d0] = *(const LAS bf16x8*)(Kb + (2 * d0 + hi) * 1024 + 512 + r32 * 16); }
            __builtin_amdgcn_sched_barrier(0);
#pragma unroll
            for (int d0 = 0; d0 < 4; ++d0) { p0 = __builtin_amdgcn_mfma_f32_32x32x16_bf16(ka[d0], qr[d0], p0, 0, 0, 0); p1 = __builtin_amdgcn_mfma_f32_32x32x16_bf16(kc[d0], qr[d0], p1, 0, 0, 0); }
            bf16x8 vfr[2][4];
#pragma unroll
            for (int d0 = 0; d0 < 2; ++d0)
#pragma unroll
                for (int ks = 0; ks < 4; ++ks) { const s16x4 lo = vtr(Vb + vb + d0 * 4096 + ks * 1024), hh = vtr(Vb + vb + d0 * 4096 + ks * 1024 + 512);
                    vfr[d0][ks] = (bf16x8){lo[0], lo[1], lo[2], lo[3], hh[0], hh[1], hh[2], hh[3]}; }
            __builtin_amdgcn_sched_barrier(0);
            bool live = true;
            const int kv0 = 64 * jb + 4 * hi;
            if (TYPE == 3) {
                float b0[16], b1[16];
#pragma unroll
                for (int r = 0; r < 16; ++r) { const int kv = kv0 + (r & 3) + 8 * (r >> 2);
                    const float e0 = fexp2(fminf(p0[r], 80.f)), e1 = fexp2(fminf(p1[r], 80.f));
                    const float m0 = frcp(1.0f + e0), m1 = frcp(1.0f + e1);
                    const bool ok0 = kv < qrel, ok1 = (kv + 32) < qrel;
                    b0[r] = ok0 ? e0 * m0 : 0.f; b1[r] = ok1 ? e1 * m1 : 0.f; p0[r] = ok0 ? m0 : 1.0f; p1[r] = ok1 ? m1 : 1.0f; }
                float gp[8], go[8], pp[8];
#pragma unroll
                for (int g = 0; g < 4; ++g) { gp[g] = (p0[4 * g] * p0[4 * g + 1]) * (p0[4 * g + 2] * p0[4 * g + 3]); gp[4 + g] = (p1[4 * g] * p1[4 * g + 1]) * (p1[4 * g + 2] * p1[4 * g + 3]); }
#pragma unroll
                for (int g = 0; g < 8; ++g) { const float oth = __shfl_xor(gp[g], 32); pp[g] = gp[g] * oth; go[g] = hi ? 1.0f : oth; }
                float sp = 1.0f;
#pragma unroll
                for (int g = 7; g >= 0; --g) { const float sg = sp * go[g] * carry;
                    if (g < 4) { const float c3 = p0[4 * g + 3], c2 = p0[4 * g + 2], c1 = p0[4 * g + 1];
                        p0[4 * g + 3] = b0[4 * g + 3] * sg; const float s2 = sg * c3; p0[4 * g + 2] = b0[4 * g + 2] * s2; const float s1 = s2 * c2; p0[4 * g + 1] = b0[4 * g + 1] * s1; p0[4 * g] = b0[4 * g] * (s1 * c1); }
                    else { const int q = g - 4; const float c3 = p1[4 * q + 3], c2 = p1[4 * q + 2], c1 = p1[4 * q + 1];
                        p1[4 * q + 3] = b1[4 * q + 3] * sg; const float s2 = sg * c3; p1[4 * q + 2] = b1[4 * q + 2] * s2; const float s1 = s2 * c2; p1[4 * q + 1] = b1[4 * q + 1] * s1; p1[4 * q] = b1[4 * q] * (s1 * c1); }
                    sp *= pp[g]; }
                carry *= sp;
            } else {
                if (TYPE == 2) {
                    const LAS f32x4* kbp = (const LAS f32x4*)(L + AT_KB + cur * 256);
#pragma unroll
                    for (int g = 0; g < 4; ++g) { const f32x4 a = kbp[2 * g + hi], c = kbp[8 + 2 * g + hi];
#pragma unroll
                        for (int e = 0; e < 4; ++e) { p0[4 * g + e] += a[e]; p1[4 * g + e] += c[e]; } }
                    if (jb >= 0) {
#pragma unroll
                        for (int r = 0; r < 16; ++r) { const int kv = kv0 + (r & 3) + 8 * (r >> 2); if (kv > qrel) p0[r] = NEG_INF; if (kv + 32 > qrel) p1[r] = NEG_INF; }
                    }
                } else {
#pragma unroll
                    for (int r = 0; r < 16; ++r) { const int d0_ = qrel - (kv0 + (r & 3) + 8 * (r >> 2)), d1_ = d0_ - 32;
                        const bool ok0 = (d0_ >= 0) && (d0_ < WINDOW), ok1 = (d1_ >= 0) && (d1_ < WINDOW);
                        const float t0 = BT[ok0 ? d0_ : 0], t1 = BT[ok1 ? d1_ : 0];
                        p0[r] = ok0 ? p0[r] + t0 : NEG_INF; p1[r] = ok1 ? p1[r] + t1 : NEG_INF; }
                }
                float rm = fmaxf(p0[0], p1[0]);
#pragma unroll
                for (int r = 1; r < 16; ++r) rm = fmaxf(rm, fmaxf(p0[r], p1[r]));
                { auto rr = __builtin_amdgcn_permlane32_swap(__float_as_uint(rm), __float_as_uint(rm), false, false); rm = fmaxf(__uint_as_float(rr[0]), __uint_as_float(rr[1])); }
                const float mn = fmaxf(mrun, rm);
                if (TYPE == 2) live = !__all(rm - mrun < -40.f);
                if (live) {
                if (__any(mn > mrun)) {
                    const float f = (mn > mrun) ? fexp2(mrun - mn) : 1.0f;
                    lsum *= f; mrun = mn;
                    if (hi == 0) wsf[r32] = f;
                    LDS_WAIT(); __builtin_amdgcn_wave_barrier();
#pragma unroll
                    for (int g = 0; g < 4; ++g) { const f32x4 fv = ((const LAS f32x4*)wsf)[2 * g + hi];
#pragma unroll
                        for (int e = 0; e < 4; ++e) { o[0][4 * g + e] *= fv[e]; o[1][4 * g + e] *= fv[e]; } }
                    LDS_WAIT(); __builtin_amdgcn_wave_barrier();
                }
                const float ms = (mrun == NEG_INF) ? 0.f : mrun;
                float ps = 0.f;
#pragma unroll
                for (int r = 0; r < 16; ++r) { p0[r] = fexp2(p0[r] - ms); p1[r] = fexp2(p1[r] - ms); ps += p0[r] + p1[r]; }
                lsum += ps;
                }
            }
            if (live) {
            bf16x8 pa[4];
#pragma unroll
            for (int ks = 0; ks < 4; ++ks) { v4u w;
                if (ks < 2) { w.x = cvtpk(p0[8 * ks], p0[8 * ks + 1]); w.y = cvtpk(p0[8 * ks + 2], p0[8 * ks + 3]); w.z = cvtpk(p0[8 * ks + 4], p0[8 * ks + 5]); w.w = cvtpk(p0[8 * ks + 6], p0[8 * ks + 7]); }
                else { const int k2 = ks - 2; w.x = cvtpk(p1[8 * k2], p1[8 * k2 + 1]); w.y = cvtpk(p1[8 * k2 + 2], p1[8 * k2 + 3]); w.z = cvtpk(p1[8 * k2 + 4], p1[8 * k2 + 5]); w.w = cvtpk(p1[8 * k2 + 6], p1[8 * k2 + 7]); }
                pa[ks] = __builtin_bit_cast(bf16x8, w); }
#pragma unroll
            for (int d0 = 0; d0 < 2; ++d0)
#pragma unroll
                for (int ks = 0; ks < 4; ++ks) o[d0] = __builtin_amdgcn_mfma_f32_32x32x16_bf16(pa[ks], vfr[d0][ks], o[d0], 0, 0, 0);
            }
        }
        if (TYPE == 2) {
            bool wdead = false;
            if (active && more) wdead = __all(qbound + kbnext - mrun < -40.f);
            if (lane == 0) deadf[cur * 8 + wid] = wdead ? 1u : 0u; }
        if (TYPE == 3) { const bool wdead = active && __all(carry < 2.3e-10f);
            if (lane == 0) deadf[cur * 8 + wid] = wdead ? 1u : 0u; }
        if (more) { *(LAS v4u*)(L + AT_K + (cur ^ 1) * 8192 + kl) = kreg; *(LAS v4u*)(L + AT_V + (cur ^ 1) * 8192 + vl) = vreg; if (TYPE == 2 && tid < 64) ((LAS float*)(L + AT_KB + (cur ^ 1) * 256))[tid] = kbreg; }
        __syncthreads();
        if (TYPE >= 2) { const v4u d0 = *(const LAS v4u*)(deadf + cur * 8), d1 = *(const LAS v4u*)(deadf + cur * 8 + 4);
            if ((d0.x & d0.y & d0.z & d0.w & d1.x & d1.y & d1.z & d1.w) != 0u) break; }
    }
    float inv[16];
    if (TYPE != 3) {
        { auto rr = __builtin_amdgcn_permlane32_swap(__float_as_uint(lsum), __float_as_uint(lsum), false, false); lsum = __uint_as_float(rr[0]) + __uint_as_float(rr[1]); }
        if (TYPE == 1) lsum += fexp2(F.sinks[l * NH + hq] * LOG2E - mrun);
        const float il = 1.0f / lsum;
        if (hi == 0) wsf[r32] = il;
        LDS_WAIT(); __builtin_amdgcn_wave_barrier();
#pragma unroll
        for (int g = 0; g < 4; ++g) { const f32x4 fv = ((const LAS f32x4*)wsf)[2 * g + hi]; inv[4 * g] = fv[0]; inv[4 * g + 1] = fv[1]; inv[4 * g + 2] = fv[2]; inv[4 * g + 3] = fv[3]; }
        LDS_WAIT(); __builtin_amdgcn_wave_barrier();
    } else {
#pragma unroll
        for (int r = 0; r < 16; ++r) inv[r] = 1.0f;
    }
    unsigned short gte[2][16];
    if (TYPE == 2) {
#pragma unroll
        for (int d0 = 0; d0 < 2; ++d0)
#pragma unroll
            for (int r = 0; r < 16; ++r) { const int q = (r & 3) + 8 * (r >> 2) + 4 * hi; const size_t mrow = rowb + q0 + qoff + q; gte[d0][r] = ((const GAS unsigned short*)F.P)[mrow * NIN + PC_G + hq * 64 + 32 * d0 + r32]; }
    }
#pragma unroll
    for (int d0 = 0; d0 < 2; ++d0)
#pragma unroll
        for (int r = 0; r < 16; ++r) { const int q = (r & 3) + 8 * (r >> 2) + 4 * hi; const size_t mrow = rowb + q0 + qoff + q; const int col = hq * 64 + 32 * d0 + r32;
            float val = o[d0][r] * inv[r];
            if (TYPE == 2) val *= frcp(1.0f + fexp2(-LOG2E * __builtin_bit_cast(float, (unsigned)gte[d0][r] << 16)));
            F.Y[mrow * DM + YOFF + col] = (bf16)f2bf(val); }
}

__device__ __forceinline__ void sparse_attn_query(const Frame& F, int m, LAS unsigned char* vch, const LAS float* TBA, const LAS int* idx) {
    int lane = F.lane; asm volatile("" : "+v"(lane));
    const int hh = lane & 15, kg = lane >> 4, t = m % SEQ, b = m / SEQ;
    const size_t rowb = (size_t)b * SEQ;
    const int nsel = (t + 1) < TOPK ? (t + 1) : TOPK, nch = (nsel + 63) >> 6;
    const bf16* qp = F.P + (size_t)m * NIN + PA_Q + (hh & 7) * 64 + 8 * kg;
    const bf16x8 qf0 = *(const GAS bf16x8*)qp, qf1 = *(const GAS bf16x8*)(qp + 32);
    float s[4][4][4];
#pragma unroll
    for (int cp = 0; cp < 2; ++cp) {
        if (2 * cp < nch) {
            bf16x8 kf[8][2];
#pragma unroll
            for (int bb = 0; bb < 8; ++bb) { const int keyA = idx[128 * cp + 16 * bb + hh];
                const bf16* kp = F.P + (rowb + keyA) * NIN + PA_K + 8 * kg;
                kf[bb][0] = *(const GAS bf16x8*)kp; kf[bb][1] = *(const GAS bf16x8*)(kp + 32); }
            __builtin_amdgcn_sched_barrier(0);
#pragma unroll
            for (int bb = 0; bb < 8; ++bb) { const int c = 2 * cp + (bb >> 2), blk = bb & 3, j0 = 64 * c + 16 * blk;
                f32x4 acc = {0.f, 0.f, 0.f, 0.f};
                acc = __builtin_amdgcn_mfma_f32_16x16x32_bf16(kf[bb][0], qf0, acc, 0, 0, 0); acc = __builtin_amdgcn_mfma_f32_16x16x32_bf16(kf[bb][1], qf1, acc, 0, 0, 0);
                const v4i id4 = *(const LAS v4i*)(idx + j0 + 4 * kg);
#pragma unroll
                for (int r = 0; r < 4; ++r) { const int j = j0 + 4 * kg + r; int dist = t - id4[r]; dist = dist < 0 ? 0 : (dist > 128 ? 128 : dist);
                    const float bias = TBA[dist * 8 + (hh & 7)];
                    s[c][blk][r] = (j < nsel) ? acc[r] + bias : NEG_INF; }
            }
        } else {
#pragma unroll
            for (int c = 2 * cp; c < 2 * cp + 2; ++c)
#pragma unroll
                for (int blk = 0; blk < 4; ++blk)
#pragma unroll
                    for (int r = 0; r < 4; ++r) s[c][blk][r] = NEG_INF;
        }
    }
    v4u xv[2][8];
#define SP_VLOAD(c_, X) do { _Pragma("unroll") for (int i_ = 0; i_ < 8; ++i_) { const int keyV_ = idx[64 * (c_) + 8 * i_ + (lane >> 3)]; \
        X[i_] = *(const GAS v4u*)(F.P + (rowb + keyV_) * NIN + PA_V + 8 * (lane & 7)); } } while (0)
    SP_VLOAD(0, xv[0]);
    if (1 < nch) SP_VLOAD(1, xv[1]);
    __builtin_amdgcn_sched_barrier(0);
    float mx = NEG_INF;
#pragma unroll
    for (int c = 0; c < 4; ++c)
#pragma unroll
        for (int blk = 0; blk < 4; ++blk)
#pragma unroll
            for (int r = 0; r < 4; ++r) mx = fmaxf(mx, s[c][blk][r]);
    mx = fmaxf(mx, __shfl_xor(mx, 16)); mx = fmaxf(mx, __shfl_xor(mx, 32));
    float sum = 0.f;
#pragma unroll
    for (int c = 0; c < 4; ++c)
#pragma unroll
        for (int blk = 0; blk < 4; ++blk)
#pragma unroll
            for (int r = 0; r < 4; ++r) { const float p = fexp2(s[c][blk][r] - mx); s[c][blk][r] = p; sum += p; }
    sum += __shfl_xor(sum, 16); sum += __shfl_xor(sum, 32);
    const float inv = 1.0f / sum;
    f32x4 oacc[4];
#pragma unroll
    for (int d = 0; d < 4; ++d) oacc[d] = (f32x4){0.f, 0.f, 0.f, 0.f};
    const int q4 = (lane & 15) >> 2, p4 = lane & 3;
#pragma unroll
    for (int c = 0; c < 4; ++c) {
        if (c < nch) {
#pragma unroll
            for (int i = 0; i < 8; ++i) *(LAS v4u*)(vch + ((lane & 7) >> 2) * 4096 + (8 * i + (lane >> 3)) * 64 + (lane & 3) * 16) = xv[c & 1][i];
            LDS_WAIT(); __builtin_amdgcn_wave_barrier();
            if (c + 2 < nch) SP_VLOAD(c + 2, xv[c & 1]);
            __builtin_amdgcn_sched_barrier(0);
#pragma unroll
            for (int kp = 0; kp < 2; ++kp) { v4u w; w.x = cvtpk(s[c][2 * kp][0], s[c][2 * kp][1]); w.y = cvtpk(s[c][2 * kp][2], s[c][2 * kp][3]); w.z = cvtpk(s[c][2 * kp + 1][0], s[c][2 * kp + 1][1]); w.w = cvtpk(s[c][2 * kp + 1][2], s[c][2 * kp + 1][3]);
                const bf16x8 pf = __builtin_bit_cast(bf16x8, w);
#pragma unroll
                for (int d = 0; d < 4; ++d) { const LAS unsigned char* a = vch + (d >> 1) * 4096 + (32 * kp + 4 * kg + q4) * 64 + ((d & 1) * 16 + 4 * p4) * 2;
                    const s16x4 lo = vtr(a), hv = vtr(a + 16 * 64);
                    const bf16x8 vf = {lo[0], lo[1], lo[2], lo[3], hv[0], hv[1], hv[2], hv[3]};
                    oacc[d] = __builtin_amdgcn_mfma_f32_16x16x32_bf16(vf, pf, oacc[d], 0, 0, 0); } }
            LDS_WAIT(); __builtin_amdgcn_wave_barrier();
        }
    }
#undef SP_VLOAD
    if (hh < 8) {
#pragma unroll
        for (int d = 0; d < 4; ++d) { v2u w; w.x = pk2(oacc[d][0] * inv, oacc[d][1] * inv); w.y = pk2(oacc[d][2] * inv, oacc[d][3] * inv);
            *(GAS v2u*)(F.Y + (size_t)m * DM + hh * 64 + 16 * d + 4 * kg) = w; }
    }
}

constexpr int CW_QUEUE = 8192;
constexpr int MIX_ITEMS = 2560;
template <unsigned EN> __device__ __forceinline__ void ph_attention(const Frame& F, int l, int qsel = 0) {
    LAS float* TBA = (LAS float*)(F.lds + AUX_OFF);
    for (int i = F.tid; i < 129 * 8; i += NTHREADS) { const int d = i >> 3, hq = i & 7; const int bk = d < 128 ? (int)kBucketLut[d] : 31; TBA[i] = F.rel_table[bk * 16 + hq] * LOG2E; }
    LAS unsigned* qslot = (LAS unsigned*)(F.lds + LDSCTL_OFF + 64);
    LAS unsigned char* wbuf = F.lds + RING_OFF + AT_SV + F.wave * 9472;
    LAS int* idxl = (LAS int*)(wbuf + 8192);
    __syncthreads();
#define MIX_FETCH(it) do { if (F.tid == 0) *qslot = __hip_atomic_fetch_add((unsigned*)(F.ctl + CW_QUEUE + 64 * l + 32 * qsel), 1u, __ATOMIC_RELAXED, __HIP_MEMORY_SCOPE_AGENT); \
        __syncthreads(); it = (int)*qslot; __syncthreads(); } while (0)
    for (int r = (int)blockIdx.x; r < 1024; r += F.G) {
        if (EN & 0x800) {
            const int b = r >> 9, blk = r & 511;
#pragma unroll 1
            for (int k = 0; k < 2; ++k) { const int u = 8 * blk + F.wave; const int t = k ? (SEQ - 1 - u) : u; const int m = b * SEQ + t;
                select_row(F, m, (LAS unsigned*)wbuf, idxl);
                LDS_WAIT(); __builtin_amdgcn_wave_barrier();
#ifdef PROBE_SEL2
                select_row(F, m, (LAS unsigned*)wbuf, idxl); LDS_WAIT(); __builtin_amdgcn_wave_barrier();
#endif
#ifdef PROBE_ATT2
                sparse_attn_query(F, m, wbuf, TBA, idxl); LDS_WAIT(); __builtin_amdgcn_wave_barrier();
#endif
                sparse_attn_query(F, m, wbuf, TBA, idxl);
                LDS_WAIT(); __builtin_amdgcn_wave_barrier(); }
        }
    }
    __syncthreads();
    int it; MIX_FETCH(it); it += 1024;
    while (it < 1536) { const int r = it & 511; if (EN & 0x100) dense_attn_unit<2>(F, l, (r & 15) >> 3, r & 7, 31 - (r >> 4)); MIX_FETCH(it); it += 1024; }
    while (it < 2048) { const int r = it & 511; if (EN & 0x200) dense_attn_unit<3>(F, l, (r & 15) >> 3, r & 7, 31 - (r >> 4)); MIX_FETCH(it); it += 1024; }
    while (it < MIX_ITEMS) { const int r = it & 511; if (EN & 0x400) dense_attn_unit<1>(F, l, r >> 8, 0, 255 - (r & 255)); MIX_FETCH(it); it += 1024; }
#undef MIX_FETCH
}


__device__ __forceinline__ const float* gp_(const float* p) {
#if defined(__HIP_DEVICE_COMPILE__)
    __builtin_assume(!__builtin_amdgcn_is_shared((const __attribute__((address_space(0))) void*)p)); __builtin_assume(!__builtin_amdgcn_is_private((const __attribute__((address_space(0))) void*)p));
#endif
    return p; }
#ifndef PROBE_KINDS
#define PROBE_KINDS 0u
#endif
#ifndef PROBE_ATT
#define PROBE_ATT 0xF00u
#endif
#ifndef PROBE_REPS
#define PROBE_REPS 1
#endif
#ifndef MK_ONE_LAUNCH
#define MK_ONE_LAUNCH 1
#endif
constexpr int PH_PER_LAYER = 14, N_PHASES = 1 + DEPTH * PH_PER_LAYER;
struct Args { const float* in[15]; float* out; unsigned char* ws; int ph_lo, ph_hi; };
struct ArgsG { const GAS float* in[15]; GAS float* out; GAS unsigned char* ws; int ph_lo, ph_hi; };
template <unsigned EN> __global__ void __launch_bounds__(NTHREADS, 2) trunk_fwd(Args args) {
    extern __shared__ __attribute__((aligned(16))) unsigned char lds[];
    LAS unsigned char* const ldsb = (LAS unsigned char*)lds;
    const int wave0 = __builtin_amdgcn_readfirstlane((int)threadIdx.x >> 6);
    for (int u = threadIdx.x; u < (LDS_BYTES - LDSCTL_OFF) / 4; u += NTHREADS) ((LAS unsigned*)(ldsb + LDSCTL_OFF))[u] = 0u;
    __syncthreads();
#if MK_ONE_LAUNCH
    constexpr int lo = 0, hi = N_PHASES;
#else
    const int lo = args.ph_lo, hi = args.ph_hi;
#endif
    XcdBarrier bar; bar.bar = (unsigned*)(args.ws + WS_CTL) + CW_BAR; bar.x = 0; bar.st = nullptr;
    if (hi - lo > 1) bar = xcd_barrier_post((unsigned*)(args.ws + WS_CTL) + CW_BAR, (volatile LAS unsigned*)(ldsb + LDSCTL_OFF));
#define GP(p) ((const float*)(p))
#define PH_BEGIN(k, kind) if (lo <= (k) && (k) < hi) { _Pragma("unroll 1") for (int rep_ = 0; rep_ < (((PROBE_KINDS >> (kind)) & 1u) ? PROBE_REPS : 1); ++rep_) { Frame F; { \
        const ArgsG* ka = (const ArgsG*)__builtin_amdgcn_kernarg_segment_ptr(); asm volatile("" : "+s"(ka)); \
        unsigned o_ = ~0u; asm volatile("" : "+s"(o_)); int t_ = wave0 * 64 + (int)__builtin_amdgcn_mbcnt_hi(o_, __builtin_amdgcn_mbcnt_lo(o_, 0u)); asm volatile("" : "+v"(t_)); \
        F.lds = ldsb; F.tid = t_; F.lane = t_ & 63; F.wave = wave0; int gw_ = blockIdx.x * NWAVES + wave0; asm volatile("" : "+s"(gw_)); F.G = gridDim.x; F.gw = gw_; F.NGW = F.G * NWAVES; \
        unsigned char* ws = (unsigned char*)ka->ws; F.ctl = (gu32*)(ws + WS_CTL);     \
        F.x = GP(ka->in[0]); F.c = GP(ka->in[1]); F.w_ada = GP(ka->in[2]); F.b_ada = GP(ka->in[3]); F.norm_g = GP(ka->in[4]); F.w_in = GP(ka->in[5]); F.qk_g = GP(ka->in[6]); F.forget_b = GP(ka->in[7]); \
        F.sinks = GP(ka->in[8]); F.rel_table = GP(ka->in[9]); F.group_g = GP(ka->in[10]); F.w_out = GP(ka->in[11]); F.w_gate = GP(ka->in[12]); F.w_up = GP(ka->in[13]); F.w_down = GP(ka->in[14]); F.out = (float*)ka->out; \
        F.MOD = (float*)(ws + WS_MOD); F.LF = (float*)(ws + WS_LF); F.KB2 = (float*)(ws + WS_KB2); F.SC = (unsigned short*)(ws + WS_SC); F.IDX = (int*)(ws + WS_IDX); \
        F.WGU = (bf16*)(ws + WS_WGU); F.WD = (bf16*)(ws + WS_WD); F.WIN = (bf16*)(ws + WS_WIN); F.WOUT = (bf16*)(ws + WS_WOUT); \
        F.H = (bf16*)(ws + WS_H); F.P = (bf16*)(ws + WS_P); F.Y = (bf16*)(ws + WS_Y); F.XB = (bf16*)(ws + WS_XB); }
#define PH_END(k) if ((k) + 1 < hi) xcd_barrier(bar); } }

    PH_BEGIN(0, 31) if (EN & 1) p0_prologue(F); PH_END(0)

    for (int l = 0; l < DEPTH; ++l) {
        const int base = 1 + l * PH_PER_LAYER;
        for (int sub = 0; sub < 3; ++sub) {
            if (sub != 1) {
                const int f = sub >> 1, pb = base + (f ? 11 : 0), ni = f ? 2 : 0, lf = l * 2 + f;
                PH_BEGIN(pb, (f ? 11 : 0)) if (EN & 2) { const float* modl = F.MOD + (size_t)l * BATCH * NMOD;
                    if (l == 0 && f == 0) ph_modulate<FFN_FP8, false>(F, F.x, F.norm_g + ((size_t)l * 3 + ni) * DM, modl + (3 * ni + 0) * DM, modl + (3 * ni + 1) * DM);
                    else ph_modulate<FFN_FP8, true>(F, F.XB, F.norm_g + ((size_t)l * 3 + ni) * DM, modl + (3 * ni + 0) * DM, modl + (3 * ni + 1) * DM); } PH_END(pb)
                PH_BEGIN(pb + 1, (f ? 12 : 1)) if (EN & 4) {
                    pg8::StaticOrder S; S.init(M, NGU, F.G, (int)blockIdx.x);
                    if constexpr (FFN_FP8) { pg8::Gemm g{F.H, (const bf16*)((const unsigned char*)F.WGU + (size_t)lf * NGU * DM), M, NGU, DM, 127, W8_E8M0};
                        pg8::EpiSwiGLU8 E{(unsigned char*)F.P, DFFP};
                        pg8::gemm_phase<pg8::EpiSwiGLU8, pg8::StaticOrder, true, true, true>(F.lds + RING_OFF, g, S, E, F.tid); }
                    else { pg8::Gemm g{F.H, F.WGU + (size_t)lf * NGU * DM, M, NGU, DM};
                        pg8::EpiSwiGLU E{F.P, DFF};
                        pg8::gemm_phase<pg8::EpiSwiGLU, pg8::StaticOrder, true, true>(F.lds + RING_OFF, g, S, E, F.tid); } } PH_END(pb + 1)
                PH_BEGIN(pb + 2, (f ? 13 : 2)) if (EN & 8) {
                    pg8::Gemm g{F.P, FFN_FP8 ? (const bf16*)((const unsigned char*)F.WD + (size_t)lf * DM * DFFP) : F.WD + (size_t)lf * DM * DFF, M, DM, DFF, 127, FFN_FP8 ? W8_E8M0 : 127, FFN_FP8 ? DFFP : 0, FFN_FP8 ? DFFP : 0}; pg8::StaticOrder S; S.init(M, DM, F.G, (int)blockIdx.x);
                    const float* modl = F.MOD + (size_t)l * BATCH * NMOD;
                    if (l == DEPTH - 1 && f == 1) { pg8::EpiResid<false> E{F.XB, rep_ ? (void*)F.SC : (void*)F.out, DM, modl + (3 * ni + 2) * DM, NMOD, SEQ, 0.5f};
                        pg8::gemm_phase<pg8::EpiResid<false>, pg8::StaticOrder, true, true, FFN_FP8>(F.lds + RING_OFF, g, S, E, F.tid); }
                    else { pg8::EpiResid<true> E{F.XB, rep_ ? (void*)F.SC : (void*)F.XB, DM, modl + (3 * ni + 2) * DM, NMOD, SEQ, 0.5f};
                        pg8::gemm_phase<pg8::EpiResid<true>, pg8::StaticOrder, true, true, FFN_FP8>(F.lds + RING_OFF, g, S, E, F.tid); } } PH_END(pb + 2)
            } else {
                PH_BEGIN(base + 3, 3) if (EN & 2) { const float* modl = F.MOD + (size_t)l * BATCH * NMOD; ph_modulate<false, true>(F, F.XB, F.norm_g + ((size_t)l * 3 + 1) * DM, modl + 3 * DM, modl + 4 * DM); } PH_END(base + 3)
                PH_BEGIN(base + 4, 4) if (EN & 16) {
                    pg8::Gemm g{F.H, F.WIN + (size_t)l * NIN * DM, M, NIN, DM}; pg8::StaticOrder S; S.init(M, NIN, F.G, (int)blockIdx.x);
                    pg8::EpiBf16 E{F.P, NIN};
                    pg8::gemm_phase<pg8::EpiBf16, pg8::StaticOrder, true, true>(F.lds + RING_OFF, g, S, E, F.tid); } PH_END(base + 4)
                PH_BEGIN(base + 6, 6) if (EN & 64) { ph_scan(F, l);
                    int par_ = (int)((blockIdx.x & 1u) ^ 1u); asm volatile("" : "+s"(par_));
                    _Pragma("unroll 1") for (int st_ = 0; st_ < 2; ++st_) { if ((st_ ^ par_) == 0) { if (EN & 32) ph_post(F, l); } else ph_idx_scores(F); } } PH_END(base + 6)
                PH_BEGIN(base + 8, 8) if (EN & 0xF00) { if (rep_ == 0) ph_attention<EN>(F, l, 0); else ph_attention<(PROBE_ATT)>(F, l, 1); } PH_END(base + 8)
                PH_BEGIN(base + 9, 9) if (EN & 0x1000) ph_gnorm(F, l); PH_END(base + 9)
                PH_BEGIN(base + 10, 10) if (EN & 0x2000) {
                    pg8::Gemm g{F.Y, F.WOUT + (size_t)l * DM * DM, M, DM, DM}; pg8::StaticOrder S; S.init(M, DM, F.G, (int)blockIdx.x);
                    const float* modl = F.MOD + (size_t)l * BATCH * NMOD;
                    pg8::EpiResid<true> E{F.XB, rep_ ? (void*)F.SC : (void*)F.XB, DM, modl + 5 * DM, NMOD, SEQ, 1.0f};
                    pg8::gemm_phase<pg8::EpiResid<true>, pg8::StaticOrder, true, true>(F.lds + RING_OFF, g, S, E, F.tid); } PH_END(base + 10)
            }
        }
    }
#undef PH_BEGIN
#undef PH_END
}

#ifndef EN_MASK
#define EN_MASK 0xFFFFu
#endif
template <unsigned EN> static int setup_kernel() {
    if (hipFuncSetAttribute((const void*)trunk_fwd<EN>, hipFuncAttributeMaxDynamicSharedMemorySize, LDS_BYTES) != hipSuccess) { fprintf(stderr, "kernel_launch: hipFuncSetAttribute failed\n"); return -1; }
    int per_cu = 0;
    if (hipOccupancyMaxActiveBlocksPerMultiprocessor(&per_cu, (const void*)trunk_fwd<EN>, NTHREADS, LDS_BYTES) != hipSuccess || per_cu < 1) { fprintf(stderr, "kernel_launch: occupancy query says %d\n", per_cu); }
    (void)hipGetLastError();
    return 0;
}
template <unsigned EN> static void launch_range(const Args& a0, int lo, int hi, int grid, hipStream_t stream) {
    Args a = a0; a.ph_lo = lo; a.ph_hi = hi;
    hipLaunchKernelGGL(trunk_fwd<EN>, dim3(grid), dim3(NTHREADS), LDS_BYTES, stream, a);
}
extern "C" void kernel_launch(void* const* d_in, const int* in_sizes, int n_in, void* d_out, int out_size, void* d_ws, size_t ws_size, hipStream_t stream) {
    static int grid = 0;
    if (grid == 0) {
        if (n_in != 15 || in_sizes[0] != M * DM || out_size != M * DM || ws_size < WS_END) {
            fprintf(stderr, "kernel_launch: shape/workspace mismatch: n_in %d in0 %d out %d ws %zu (need %zu); nothing launched\n", n_in, n_in > 0 ? in_sizes[0] : -1, out_size, ws_size, (size_t)WS_END); grid = -1; return; }
        int dev = 0, cus = 0;
        if (hipGetDevice(&dev) != hipSuccess || hipDeviceGetAttribute(&cus, hipDeviceAttributeMultiprocessorCount, dev) != hipSuccess) { grid = -1; return; }
#if MK_ONE_LAUNCH
        if (setup_kernel<EN_MASK>()) { grid = -1; return; }
#else
        if (setup_kernel<0x1u>() || setup_kernel<0x2u>() || setup_kernel<0x4u>() || setup_kernel<0x8u>() || setup_kernel<0x10u>() || setup_kernel<0x20u>() || setup_kernel<0x40u>() || setup_kernel<0x80u>() ||
            setup_kernel<0x100u>() || setup_kernel<0x200u>() || setup_kernel<0x400u>() || setup_kernel<0x800u>() || setup_kernel<0x1000u>() || setup_kernel<0x2000u>()) { grid = -1; return; }
#endif
        grid = cus;
    }
    if (grid < 0) return;
    if (hipMemsetAsync((char*)d_ws + WS_CTL, 0, CTL_ZERO_BYTES, stream) != hipSuccess) return;
    Args a{};
    for (int i = 0; i < 15; ++i) a.in[i] = (const float*)d_in[i];
    a.out = (float*)d_out; a.ws = (unsigned char*)d_ws;
#if MK_ONE_LAUNCH
    launch_range<EN_MASK>(a, 0, N_PHASES, grid, stream);
#else
    launch_range<0x1u>(a, 0, 1, grid, stream);
    for (int l = 0; l < DEPTH; ++l) { const int base = 1 + l * PH_PER_LAYER;
        for (int f = 0; f < 2; ++f) { const int pb = base + (f ? 11 : 0);
            if (f == 1) {
                launch_range<0x2u>(a, base + 3, base + 4, grid, stream); launch_range<0x10u>(a, base + 4, base + 5, grid, stream); launch_range<0x20u>(a, base + 5, base + 6, grid, stream);
                launch_range<0x40u>(a, base + 6, base + 7, grid, stream); launch_range<0x80u>(a, base + 7, base + 8, grid, stream);
                launch_range<0x100u>(a, base + 8, base + 9, grid, stream); launch_range<0x200u>(a, base + 8, base + 9, grid, stream); launch_range<0x400u>(a, base + 8, base + 9, grid, stream); launch_range<0x800u>(a, base + 8, base + 9, grid, stream);
                launch_range<0x1000u>(a, base + 9, base + 10, grid, stream); launch_range<0x2000u>(a, base + 10, base + 11, grid, stream);
            }
            launch_range<0x2u>(a, pb, pb + 1, grid, stream); launch_range<0x4u>(a, pb + 1, pb + 2, grid, stream); launch_range<0x8u>(a, pb + 2, pb + 3, grid, stream);
        }
    }
#endif
}
```

```cpp
#include <hip/hip_runtime.h>
#include <cstdio>
#include <cstdint>

namespace pg8 {
#define PG8_LAS __attribute__((address_space(3)))
typedef unsigned short bf16_t;
typedef short bf16x8 __attribute__((ext_vector_type(8)));
typedef float f32x4 __attribute__((ext_vector_type(4)));
typedef unsigned u32x4 __attribute__((ext_vector_type(4)));
constexpr int BM = 256, BK = 64, HALF = 128, HTB = HALF * BK * 2  , STAGE_BYTES = 8 * HTB, NXCD = 8, WGM = 8;

__host__ __device__ __forceinline__ int lds_byte(int r, int c) { const int st = (r >> 4) * 2 + (c >> 5), rr = r & 15, cc = c & 31, ob = rr * 64 + cc * 2; return st * 1024 + (ob ^ (((ob >> 9) & 1) << 5)); }
__host__ __device__ __forceinline__ void stage_rc(int b, int& R, int& C) { const int st = b / 1024, sb = b % 1024, swz = sb ^ (((sb >> 9) & 1) << 5); R = (st >> 1) * 16 + swz / 64; C = (st & 1) * 32 + (swz % 64) / 2; }
__host__ __device__ __forceinline__ int perm32(int rho) { const int n = rho >> 4, i = rho & 15; return 8 * (i >> 2) + 4 * n + (i & 3); }

struct Unit { int pm, pn; };
struct Gemm { const bf16_t* A; const bf16_t* Bt; int M, N, K; int scaleA = 127, scaleB = 127; int lda = 0, ldb = 0; int blk = 0; };
typedef int i32x8 __attribute__((ext_vector_type(8))); typedef int i32x4v __attribute__((ext_vector_type(4)));
__device__ __forceinline__ i32x8 pg8_cat(bf16x8 lo, bf16x8 hi) { return __builtin_shufflevector(__builtin_bit_cast(i32x4v, lo), __builtin_bit_cast(i32x4v, hi), 0, 1, 2, 3, 4, 5, 6, 7); }

struct StaticOrder {
    int nM, nN, nwg, G, c;
    __host__ __device__ void init(int M, int N, int G_, int c_) { nM = M / BM; nN = N / BM; nwg = nM * nN; G = G_; c = c_; }
    __host__ __device__ bool next(int i, Unit& u) const {
        const long L = (long)i * G + c; if (L >= nwg) return false;
        int wgid = (int)L; { const int q = nwg / NXCD, r = nwg % NXCD, xcd = wgid % NXCD, off = wgid / NXCD; wgid = (xcd < r ? xcd * (q + 1) : r * (q + 1) + (xcd - r) * q) + off; }
        const int nig = WGM * nN, gid = wgid / nig, fm = gid * WGM, gsz = (nM - fm) < WGM ? (nM - fm) : WGM;
        u.pm = fm + ((wgid % nig) % gsz); u.pn = (wgid % nig) / gsz; return true;
    }
    __device__ __forceinline__ void a_ready(const Unit&) const {}
    __device__ __forceinline__ void done(const Unit&) const {}
};
typedef __bf16 pg8_bfpair __attribute__((ext_vector_type(2))); typedef float pg8_f32pair __attribute__((ext_vector_type(2)));
__device__ __forceinline__ unsigned cvt_pk_bf16(float lo, float hi) { const pg8_f32pair v = {lo, hi}; return __builtin_bit_cast(unsigned, __builtin_convertvector(v, pg8_bfpair)); }
__device__ __forceinline__ unsigned cvt_pk_bf16_nv(float lo, float hi) { return cvt_pk_bf16(lo, hi); }
__device__ __forceinline__ const char* uptr(const char* p) { const unsigned long long v = (unsigned long long)p; const unsigned lo = __builtin_amdgcn_readfirstlane((unsigned)v), hi = __builtin_amdgcn_readfirstlane((unsigned)(v >> 32)); return (const char*)(((unsigned long long)hi << 32) | lo); }
struct EpiBf16 {
    static constexpr bool PERM = true, AFTER_DRAIN = false;
    bf16_t* O; int ldc;
    __device__ __forceinline__ void operator()(const f32x4 (&acc)[2][2][4][2], const Unit& u, int wr, int wc, int fr, int fq) const {
        asm volatile("" : "+v"(fr), "+v"(fq));
        const int row0 = u.pm * BM + wr * 64 + fr; const int col0 = u.pn * BM + wc * 32 + 8 * fq;
#pragma unroll
        for (int ai = 0; ai < 2; ++ai)
#pragma unroll
            for (int m = 0; m < 4; ++m) { bf16_t* rowp = O + (size_t)(row0 + ai * HALF + m * 16) * ldc + col0;
#pragma unroll
                for (int bj = 0; bj < 2; ++bj) { const f32x4 v0 = acc[ai][bj][m][0], v1 = acc[ai][bj][m][1];
                    u32x4 w; w.x = cvt_pk_bf16(v0[0], v0[1]); w.y = cvt_pk_bf16(v0[2], v0[3]); w.z = cvt_pk_bf16(v1[0], v1[1]); w.w = cvt_pk_bf16(v1[2], v1[3]);
                    *(u32x4*)(rowp + bj * HALF) = w; } }
    }
};
__device__ __forceinline__ float silu_mul(float g, float u) { return g * u * __builtin_amdgcn_rcpf(1.0f + __builtin_amdgcn_exp2f(-1.4426950408889634f * g)); }
struct EpiSwiGLU {
    static constexpr bool PERM = true, AFTER_DRAIN = false;
    bf16_t* O; int ldc;
    __device__ __forceinline__ void operator()(const f32x4 (&acc)[2][2][4][2], const Unit& u, int wr, int wc, int fr, int fq) const {
        asm volatile("" : "+v"(fr), "+v"(fq));
        const int row0 = u.pm * BM + wr * 64 + fr; const int col0 = u.pn * HALF + wc * 32 + 8 * fq;
#pragma unroll
        for (int ai = 0; ai < 2; ++ai)
#pragma unroll
            for (int m = 0; m < 4; ++m) { bf16_t* rowp = O + (size_t)(row0 + ai * HALF + m * 16) * ldc + col0;
                const f32x4 g0 = acc[ai][0][m][0], g1 = acc[ai][0][m][1], u0 = acc[ai][1][m][0], u1 = acc[ai][1][m][1];
                u32x4 w; w.x = cvt_pk_bf16(silu_mul(g0[0], u0[0]), silu_mul(g0[1], u0[1])); w.y = cvt_pk_bf16(silu_mul(g0[2], u0[2]), silu_mul(g0[3], u0[3]));
                w.z = cvt_pk_bf16(silu_mul(g1[0], u1[0]), silu_mul(g1[1], u1[1])); w.w = cvt_pk_bf16(silu_mul(g1[2], u1[2]), silu_mul(g1[3], u1[3]));
                *(u32x4*)rowp = w; }
    }
};
template <bool OUT16> struct EpiResid {
    static constexpr bool PERM = true, AFTER_DRAIN = false;
    const bf16_t* base; void* out; int ldc; const float* gv; int gstride; int rows_per_batch; float coef;
    __device__ __forceinline__ void operator()(const f32x4 (&acc)[2][2][4][2], const Unit& u, int wr, int wc, int fr, int fq) const {
        asm volatile("" : "+v"(fr), "+v"(fq));
        const int row0 = u.pm * BM + wr * 64 + fr; const int col0 = u.pn * BM + wc * 32 + 8 * fq;
        const float* gvec = gv + (size_t)((u.pm * BM) / rows_per_batch) * gstride + col0;
        f32x4 gg[2][2];
#pragma unroll
        for (int bj = 0; bj < 2; ++bj)
#pragma unroll
            for (int n = 0; n < 2; ++n) gg[bj][n] = *(const f32x4*)(gvec + bj * HALF + 4 * n) * coef;
#pragma unroll
        for (int ai = 0; ai < 2; ++ai) {
            u32x4 bwv[4][2];
#pragma unroll
            for (int m = 0; m < 4; ++m) { const size_t off = (size_t)(row0 + ai * HALF + m * 16) * ldc + col0;
#pragma unroll
                for (int bj = 0; bj < 2; ++bj) bwv[m][bj] = *(const u32x4*)(base + off + bj * HALF); }
            __builtin_amdgcn_sched_barrier(0);
#pragma unroll
            for (int m = 0; m < 4; ++m) { const size_t off = (size_t)(row0 + ai * HALF + m * 16) * ldc + col0;
#pragma unroll
                for (int bj = 0; bj < 2; ++bj) { const u32x4 bw = bwv[m][bj];
                    f32x4 b0, b1; b0[0] = __builtin_bit_cast(float, bw.x << 16); b0[1] = __builtin_bit_cast(float, bw.x & 0xffff0000u); b0[2] = __builtin_bit_cast(float, bw.y << 16); b0[3] = __builtin_bit_cast(float, bw.y & 0xffff0000u);
                    b1[0] = __builtin_bit_cast(float, bw.z << 16); b1[1] = __builtin_bit_cast(float, bw.z & 0xffff0000u); b1[2] = __builtin_bit_cast(float, bw.w << 16); b1[3] = __builtin_bit_cast(float, bw.w & 0xffff0000u);
                    const f32x4 r0 = b0 + gg[bj][0] * acc[ai][bj][m][0], r1 = b1 + gg[bj][1] * acc[ai][bj][m][1];
                    if constexpr (OUT16) { u32x4 w; w.x = cvt_pk_bf16_nv(r0[0], r0[1]); w.y = cvt_pk_bf16_nv(r0[2], r0[3]); w.z = cvt_pk_bf16_nv(r1[0], r1[1]); w.w = cvt_pk_bf16_nv(r1[2], r1[3]); *(u32x4*)((bf16_t*)out + off + bj * HALF) = w; }
                    else { *(f32x4*)((float*)out + off + bj * HALF) = r0; *(f32x4*)((float*)out + off + bj * HALF + 4) = r1; } } }
        }
    }
};
__device__ __forceinline__ unsigned pack_fp8x4(float a, float b, float c, float d) {
    a = fminf(fmaxf(a, -448.f), 448.f); b = fminf(fmaxf(b, -448.f), 448.f); c = fminf(fmaxf(c, -448.f), 448.f); d = fminf(fmaxf(d, -448.f), 448.f);
    int w = 0; w = __builtin_amdgcn_cvt_pk_fp8_f32(a, b, w, false); w = __builtin_amdgcn_cvt_pk_fp8_f32(c, d, w, true); return (unsigned)w; }
struct EpiSwiGLU8 {
    static constexpr bool PERM = true, AFTER_DRAIN = false;
    unsigned char* O; int ldc;
    __device__ __forceinline__ void operator()(const f32x4 (&acc)[2][2][4][2], const Unit& u, int wr, int wc, int fr, int fq) const {
        asm volatile("" : "+v"(fr), "+v"(fq));
        const int row0 = u.pm * BM + wr * 64 + fr; const int col0 = u.pn * HALF + wc * 32 + 8 * fq;
#pragma unroll
        for (int ai = 0; ai < 2; ++ai)
#pragma unroll
            for (int m = 0; m < 4; ++m) { unsigned char* rowp = O + (size_t)(row0 + ai * HALF + m * 16) * ldc + col0;
                const f32x4 g0 = acc[ai][0][m][0], g1 = acc[ai][0][m][1], u0 = acc[ai][1][m][0], u1 = acc[ai][1][m][1];
                typedef unsigned u32x2v __attribute__((ext_vector_type(2))); u32x2v w;
                w.x = pack_fp8x4(silu_mul(g0[0], u0[0]), silu_mul(g0[1], u0[1]), silu_mul(g0[2], u0[2]), silu_mul(g0[3], u0[3]));
                w.y = pack_fp8x4(silu_mul(g1[0], u1[0]), silu_mul(g1[1], u1[1]), silu_mul(g1[2], u1[2]), silu_mul(g1[3], u1[3]));
                *(u32x2v*)rowp = w; }
    }
};
template <class Epi, class Sched, bool ALIGN_EPI = false, bool SP2 = false, bool FP8 = false>
__device__ __forceinline__ void gemm_phase(PG8_LAS unsigned char* lds, const Gemm g, const Sched& S, const Epi& E, int tid_in) {
    int tid_ = tid_in; asm volatile("" : "+v"(tid_));
    const int tid = tid_, wid = __builtin_amdgcn_readfirstlane(tid >> 6), lane = tid & 63, wr = wid >> 2, wc = wid & 3, fr = lane & 15, fq = lane >> 4;
    const int K = g.K, nt = FP8 ? K / (2 * BK) : K / BK;
    const int pitchA = g.blk ? 2 * BK : g.lda ? g.lda : (FP8 ? K : 2 * K), pitchB = g.blk ? 2 * BK : g.ldb ? g.ldb : (FP8 ? K : 2 * K);
    unsigned voffA[2], voffB[2];
#pragma unroll
    for (int i = 0; i < 2; ++i) { int R, C; stage_rc(tid * 16 + i * 8192, R, C); const int Rb = Epi::PERM ? ((R & ~31) + perm32(R & 31)) : R;
        voffA[i] = (unsigned)(R * pitchA + C * 2); voffB[i] = (unsigned)(Rb * pitchB + C * 2); }
    const size_t kstep = g.blk ? (size_t)(512 * BK) : (size_t)(BK * 2);
    const size_t hstepA = (size_t)HALF * pitchA, hstepB = (size_t)HALF * pitchB;
    const size_t tstepA = g.blk ? (size_t)(FP8 ? K / (2 * BK) : K / BK) * kstep : 2 * hstepA, tstepB = g.blk ? tstepA : 2 * hstepB;
    const unsigned ldsw = (unsigned)wid * 1024u;
    const int aoff = lds_byte(wr * 64 + fr, fq * 8), boff = lds_byte(wc * 32 + fr, fq * 8);
    PG8_LAS unsigned char* abase = lds + aoff; PG8_LAS unsigned char* bbase = lds + boff + 4 * HTB;
#define PG8_SA(b, h) (((b) * 2 + (h)) * HTB)
#define PG8_SB(b, h) ((4 + (b) * 2 + (h)) * HTB)
#define PG8_STAGE(bufoff, gbase, voff) do { _Pragma("unroll") for (int _i = 0; _i < 2; ++_i) \
        __builtin_amdgcn_global_load_lds((const unsigned*)((const char*)(gbase) + (voff)[_i]), (PG8_LAS unsigned*)(lds + (bufoff) + ldsw + _i * 8192), 16, 0, 0); } while (0)
#define PG8_RDA(off) (*(const PG8_LAS bf16x8*)(abase + (off)))
#define PG8_RDB(off) (*(const PG8_LAS bf16x8*)(bbase + ((off) - 4 * HTB)))
#define PG8_LDA(dst, b, h) do { if constexpr (FP8) { _Pragma("unroll") for (int m = 0; m < 4; ++m) dst##8[m] = pg8_cat(PG8_RDA(PG8_SA(b, h) + m * 2048), PG8_RDA(PG8_SA(b, h) + m * 2048 + 1024)); } \
    else { _Pragma("unroll") for (int m = 0; m < 4; ++m) _Pragma("unroll") for (int k = 0; k < 2; ++k) dst[m][k] = PG8_RDA(PG8_SA(b, h) + m * 2048 + k * 1024); } } while (0)
#define PG8_LDB(dst, b, h) do { if constexpr (FP8) { _Pragma("unroll") for (int n = 0; n < 2; ++n) dst##8[n] = pg8_cat(PG8_RDB(PG8_SB(b, h) + n * 2048), PG8_RDB(PG8_SB(b, h) + n * 2048 + 1024)); } \
    else { _Pragma("unroll") for (int n = 0; n < 2; ++n) _Pragma("unroll") for (int k = 0; k < 2; ++k) dst[n][k] = PG8_RDB(PG8_SB(b, h) + n * 2048 + k * 1024); } } while (0)
#define PG8_MMA(ai, bj, At, Bt) do { __builtin_amdgcn_s_setprio(1); if constexpr (FP8) { \
        _Pragma("unroll") for (int m = 0; m < 4; ++m) _Pragma("unroll") for (int n = 0; n < 2; ++n) \
            asm volatile("v_mfma_scale_f32_16x16x128_f8f6f4 %0, %1, %2, %0, %3, %4 op_sel_hi:[0,0,0]" : "+v"(acc[ai][bj][m][n]) : "v"(Bt##8[n]), "v"(At##8[m]), "v"(sclB), "v"(sclA)); \
        } else { _Pragma("unroll") for (int m = 0; m < 4; ++m) _Pragma("unroll") for (int n = 0; n < 2; ++n) _Pragma("unroll") for (int k = 0; k < 2; ++k) \
        acc[ai][bj][m][n] = __builtin_amdgcn_mfma_f32_16x16x32_bf16(Bt[n][k], At[m][k], acc[ai][bj][m][n], 0, 0, 0); } __builtin_amdgcn_s_setprio(0); } while (0)
#define PG8_WAIT_V(n) asm volatile("s_waitcnt vmcnt(" #n ")" ::: "memory")
#define PG8_WAIT_L(n) asm volatile("s_waitcnt lgkmcnt(" #n ")" ::: "memory")
#define PG8_BAR __builtin_amdgcn_s_barrier()
#define PG8_SCHED __builtin_amdgcn_sched_barrier(0)
    Unit cur, nxt; int ui = 0;
    if (!S.next(0, cur)) return;
    f32x4 acc[2][2][4][2];
#pragma unroll
    for (int a = 0; a < 2; ++a)
#pragma unroll
        for (int b = 0; b < 2; ++b)
#pragma unroll
            for (int m = 0; m < 4; ++m)
#pragma unroll
                for (int n = 0; n < 2; ++n) acc[a][b][m][n] = (f32x4){0.f, 0.f, 0.f, 0.f};
    const int sclA = g.scaleA, sclB = g.scaleB;
    bf16x8 At[4][2], B0[2][2], B1[2][2]; i32x8 At8[4], B08[2], B18[2];
    const char* cA = uptr((const char*)g.A + (size_t)cur.pm * tstepA); const char* cB = uptr((const char*)g.Bt + (size_t)cur.pn * tstepB);
    S.a_ready(cur);
    if constexpr (SP2) {
        PG8_STAGE(PG8_SB(0, 0), cB, voffB); PG8_STAGE(PG8_SB(0, 1), cB + hstepB, voffB); PG8_STAGE(PG8_SA(0, 0), cA, voffA); PG8_STAGE(PG8_SA(0, 1), cA + hstepA, voffA);
        if (wr == 1) PG8_BAR;
        PG8_WAIT_V(2); PG8_BAR;
        PG8_STAGE(PG8_SB(1, 0), cB + kstep, voffB); PG8_STAGE(PG8_SA(1, 0), cA + kstep, voffA); PG8_STAGE(PG8_SB(1, 1), cB + hstepB + kstep, voffB);
        PG8_WAIT_V(6); PG8_BAR;
    } else {
        PG8_STAGE(PG8_SB(0, 0), cB, voffB); PG8_STAGE(PG8_SA(0, 0), cA, voffA); PG8_STAGE(PG8_SB(0, 1), cB + hstepB, voffB); PG8_STAGE(PG8_SA(0, 1), cA + hstepA, voffA);
        if (wr == 1) PG8_BAR;
        PG8_WAIT_V(4); PG8_BAR;
        PG8_STAGE(PG8_SB(1, 0), cB + kstep, voffB); PG8_STAGE(PG8_SA(1, 0), cA + kstep, voffA); PG8_STAGE(PG8_SB(1, 1), cB + hstepB + kstep, voffB);
        PG8_WAIT_V(6); PG8_BAR;
    }
    for (;;) {
        const bool has_next = S.next(ui + 1, nxt);
        const char* nA = uptr(has_next ? (const char*)g.A + (size_t)nxt.pm * tstepA : cA); const char* nB = uptr(has_next ? (const char*)g.Bt + (size_t)nxt.pn * tstepB : cB);
        for (int t = 0; t < nt; t += 2) {
            asm volatile("" : "+v"(abase), "+v"(bbase));
            const bool last = (t == nt - 2);
            const char* a1 = cA + (size_t)(t + 1) * kstep;
            const char* a2 = uptr(last ? nA : cA + (size_t)(t + 2) * kstep); const char* b2 = uptr(last ? nB : cB + (size_t)(t + 2) * kstep);
            const char* a3 = a2 + kstep; const char* b3 = b2 + kstep;
            if (last && has_next) S.a_ready(nxt);
            if constexpr (SP2) {
            PG8_LDB(B0, 0, 0); PG8_LDB(B1, 0, 1); PG8_SCHED; PG8_LDA(At, 0, 0); PG8_STAGE(PG8_SA(1, 1), a1 + hstepA, voffA);
            PG8_WAIT_V(8); PG8_WAIT_L(0); PG8_BAR; PG8_MMA(0, 0, At, B0); PG8_MMA(0, 1, At, B1); PG8_BAR; PG8_SCHED;
            PG8_LDA(At, 0, 1); PG8_STAGE(PG8_SB(0, 0), b2, voffB); PG8_STAGE(PG8_SB(0, 1), b2 + hstepB, voffB); PG8_STAGE(PG8_SA(0, 0), a2, voffA);
            PG8_WAIT_V(8); PG8_WAIT_L(0); PG8_BAR; PG8_MMA(1, 0, At, B0); PG8_MMA(1, 1, At, B1); PG8_BAR; PG8_SCHED;
            PG8_LDB(B0, 1, 0); PG8_LDB(B1, 1, 1); PG8_SCHED; PG8_LDA(At, 1, 0); PG8_STAGE(PG8_SA(0, 1), a2 + hstepA, voffA);
            PG8_WAIT_V(8); PG8_WAIT_L(0); PG8_BAR; PG8_MMA(0, 0, At, B0); PG8_MMA(0, 1, At, B1); PG8_BAR; PG8_SCHED;
            PG8_LDA(At, 1, 1); PG8_STAGE(PG8_SB(1, 0), b3, voffB); PG8_STAGE(PG8_SB(1, 1), b3 + hstepB, voffB); PG8_STAGE(PG8_SA(1, 0), a3, voffA);
            PG8_WAIT_V(8); PG8_WAIT_L(0); PG8_BAR; PG8_MMA(1, 0, At, B0); PG8_MMA(1, 1, At, B1); PG8_BAR; PG8_SCHED;
            } else {
            PG8_LDB(B0, 0, 0); PG8_SCHED; PG8_LDA(At, 0, 0); PG8_STAGE(PG8_SA(1, 1), a1 + hstepA, voffA);
            PG8_WAIT_L(8); PG8_BAR; PG8_WAIT_L(0); PG8_MMA(0, 0, At, B0); PG8_BAR; PG8_SCHED;
            PG8_LDB(B1, 0, 1); PG8_STAGE(PG8_SB(0, 0), b2, voffB);
            PG8_BAR; PG8_WAIT_L(0); PG8_MMA(0, 1, At, B1); PG8_BAR;
            PG8_LDA(At, 0, 1); PG8_STAGE(PG8_SA(0, 0), a2, voffA);
            PG8_BAR; PG8_WAIT_L(0); PG8_MMA(1, 0, At, B0); PG8_BAR; PG8_SCHED;
            PG8_STAGE(PG8_SB(0, 1), b2 + hstepB, voffB);
            PG8_WAIT_V(6); PG8_BAR; PG8_MMA(1, 1, At, B1); PG8_BAR;
            PG8_LDB(B0, 1, 0); PG8_SCHED; PG8_LDA(At, 1, 0); PG8_STAGE(PG8_SA(0, 1), a2 + hstepA, voffA);
            PG8_WAIT_L(8); PG8_BAR; PG8_WAIT_L(0); PG8_MMA(0, 0, At, B0); PG8_BAR; PG8_SCHED;
            PG8_LDB(B1, 1, 1); PG8_STAGE(PG8_SB(1, 0), b3, voffB);
            PG8_BAR; PG8_WAIT_L(0); PG8_MMA(0, 1, At, B1); PG8_BAR;
            PG8_LDA(At, 1, 1); PG8_STAGE(PG8_SA(1, 0), a3, voffA);
            PG8_BAR; PG8_WAIT_L(0); PG8_MMA(1, 0, At, B0); PG8_BAR; PG8_SCHED;
            PG8_STAGE(PG8_SB(1, 1), b3 + hstepB, voffB);
            PG8_WAIT_V(6); PG8_BAR; PG8_MMA(1, 1, At, B1); PG8_BAR;
            }
        }
        if constexpr (FP8) asm volatile("s_nop 15\n\ts_nop 7" ::: "memory");
        if constexpr (ALIGN_EPI) { if (wr == 0) PG8_BAR; }
        if constexpr (!Epi::AFTER_DRAIN) { E(acc, cur, wr, wc, fr, fq); S.done(cur); }
        if (!has_next) break;
#pragma unroll
        for (int a = 0; a < 2; ++a)
#pragma unroll
            for (int b = 0; b < 2; ++b)
#pragma unroll
                for (int m = 0; m < 4; ++m)
#pragma unroll
                    for (int n = 0; n < 2; ++n) acc[a][b][m][n] = (f32x4){0.f, 0.f, 0.f, 0.f};
        cur = nxt; cA = nA; cB = nB; ++ui;
        if constexpr (ALIGN_EPI) { if (wr == 1) PG8_BAR; }
    }
    PG8_WAIT_V(0);
    if constexpr (!ALIGN_EPI) { if (wr == 0) PG8_BAR; }
    PG8_BAR;
    if constexpr (Epi::AFTER_DRAIN) { E.fused(acc, cur, wr, wc, fr, fq, lds, wid, lane); S.done(cur); }
#undef PG8_SA
#undef PG8_SB
#undef PG8_STAGE
#undef PG8_RDA
#undef PG8_RDB
#undef PG8_LDA
#undef PG8_LDB
#undef PG8_MMA
#undef PG8_WAIT_V
#undef PG8_WAIT_L
#undef PG8_BAR
#undef PG8_SCHED
}
}

#ifndef MK_FFN_FP8
#define MK_FFN_FP8 1
#endif
constexpr bool FFN_FP8 = MK_FFN_FP8;
constexpr int NWAVES = 8, NTHREADS = NWAVES * 64;
constexpr int BATCH = 2, SEQ = 8192, M = BATCH * SEQ, DM = 2048, DEPTH = 4, DFF = 5632, NGU = 2 * DFF, INC = 5976, NIN = 6144, NMOD = 9 * DM;
constexpr int DFFP = DFF + 128;
constexpr int NH = 8, HD = 64, GWID = 512, TOPK = 256, WINDOW = 128;
constexpr int PA_Q = 0, PA_K = 512, PA_V = 576, PA_IQ = 640, PA_IK = 1664, PB_Q = 1728, PB_K = 2240, PB_V = 2304, PC_Q = 2368, PC_K = 2880, PC_V = 3392, PC_G = 3904,
              PD_Q = 4416, PD_K = 4928, PD_V = 5440, PA_IW = 5952, PC_F = 5968;
constexpr float RMS_EPS = 1e-6f, LOG2E = 1.4426950408889634f, QSCALE = 0.125f * LOG2E;

constexpr size_t MiB = 1u << 20;
constexpr size_t WS_CTL = 0, CTL_ZERO_BYTES = 64 * 1024;
constexpr size_t WS_MOD = 1 * MiB;
constexpr size_t WS_LF = 2 * MiB;
constexpr size_t WS_KB2 = 3 * MiB;
constexpr size_t WS_WGU = 4 * MiB;
constexpr size_t SZ_WGU = (size_t)NGU * DM * 2;
constexpr size_t WS_WD = WS_WGU + 8 * SZ_WGU;
constexpr size_t SZ_WD = (size_t)DM * DFF * 2;
constexpr size_t WS_WIN = WS_WD + 8 * SZ_WD;
constexpr size_t SZ_WIN = (size_t)NIN * DM * 2;
constexpr size_t WS_WOUT = WS_WIN + 4 * SZ_WIN;
constexpr size_t SZ_WOUT = (size_t)DM * DM * 2;
constexpr size_t WS_H = WS_WOUT + 4 * SZ_WOUT;
constexpr size_t WS_P = WS_H + (size_t)M * DM * 2;
constexpr size_t WS_Y = WS_P + (size_t)M * NIN * 2;
constexpr size_t WS_IDX = WS_Y + (size_t)M * DM * 2;
constexpr size_t WS_SC = WS_IDX + (size_t)M * TOPK * 4;
constexpr size_t WS_XB = WS_SC + (size_t)BATCH * SEQ * SEQ * 2;
constexpr size_t WS_END = WS_XB + (size_t)M * DM * 2;
static_assert(WS_WGU % MiB == 0 && WS_WD % MiB == 0 && WS_WIN % MiB == 0 && WS_WOUT % MiB == 0 && WS_H % MiB == 0 && WS_P % MiB == 0 && WS_Y % MiB == 0 && WS_IDX % MiB == 0 && WS_SC % MiB == 0, "d_ws map alignment");
constexpr int CW_BAR = 4096;

constexpr int RING_OFF = 0, RING_BYTES = 131072;
constexpr int AUX_OFF = RING_BYTES, AUX_BYTES = 16384;
constexpr int LDSCTL_OFF = AUX_OFF + AUX_BYTES;
constexpr int LDS_BYTES = LDSCTL_OFF + 256;

#define GAS __attribute__((address_space(1)))
#define LAS __attribute__((address_space(3)))
typedef unsigned short bf16;
typedef unsigned v4u __attribute__((ext_vector_type(4)));
typedef unsigned v2u __attribute__((ext_vector_type(2)));
typedef int v4i __attribute__((ext_vector_type(4)));
typedef float f32x4 __attribute__((ext_vector_type(4)));
typedef float f32x16 __attribute__((ext_vector_type(16)));
typedef short bf16x8 __attribute__((ext_vector_type(8)));
typedef short s16x4 __attribute__((ext_vector_type(4)));
typedef GAS unsigned gu32;
#define RLX_AGENT __ATOMIC_RELAXED, __HIP_MEMORY_SCOPE_AGENT
#define LDS_WAIT() asm volatile("s_waitcnt lgkmcnt(0)" ::: "memory")
#define VM_WAIT() asm volatile("s_waitcnt vmcnt(0)" ::: "memory")
__device__ __forceinline__ unsigned f2bf(float f) { unsigned u = __builtin_bit_cast(unsigned, f); return (u + 0x7fffu + ((u >> 16) & 1u)) >> 16; }
__device__ __forceinline__ unsigned pk2(float lo, float hi) { return f2bf(lo) | (f2bf(hi) << 16); }
__device__ __forceinline__ float bf_lo(unsigned w) { return __builtin_bit_cast(float, w << 16); }
__device__ __forceinline__ float bf_hi(unsigned w) { return __builtin_bit_cast(float, w & 0xffff0000u); }
__device__ __forceinline__ float bf2f(bf16 h) { return __builtin_bit_cast(float, (unsigned)h << 16); }
__device__ __forceinline__ float wave_sum(float v) {
#pragma unroll
    for (int o = 1; o < 64; o <<= 1) v += __shfl_xor(v, o);
    return v;
}
__device__ __forceinline__ float fexp2(float x) { return __builtin_amdgcn_exp2f(x); }
__device__ __forceinline__ float frcp(float x) { return __builtin_amdgcn_rcpf(x); }
__device__ const unsigned char kBucketLut[128] = {0, 1, 2, 3, 4, 5, 6, 7, 8, 9, 10, 11, 12, 13, 14, 15, 16, 16, 16, 17, 17, 18, 18, 18, 19, 19, 19, 20, 20, 20, 20, 21, 21, 21, 21, 22, 22, 22, 22, 22,
    23, 23, 23, 23, 23, 23, 24, 24, 24, 24, 24, 24, 25, 25, 25, 25, 25, 25, 25, 26, 26, 26, 26, 26, 26, 26, 26, 27, 27, 27, 27, 27, 27, 27, 27, 27, 27, 28, 28, 28, 28, 28, 28, 28, 28, 28, 28,
    29, 29, 29, 29, 29, 29, 29, 29, 29, 29, 29, 29, 30, 30, 30, 30, 30, 30, 30, 30, 30, 30, 30, 30, 30, 30, 31, 31, 31, 31, 31, 31, 31, 31, 31, 31, 31, 31, 31, 31, 31};

#define XB_TMO      128
#define XB_XCNT(j)  (256  + 64 * (j))
#define XB_XSUB(j)  (1280 + 64 * (j))
#define XB_XGEN(j)  (2304 + 64 * (j))
#define XB_TOP      3328
#define XB_TOPGEN   3392
#define XCD_BAR_WORDS 3456
#define XB_SPIN_CAP (1u << 18)

__device__ __forceinline__ unsigned xb_ld(unsigned* p)              { return __hip_atomic_load((GAS unsigned*)p, __ATOMIC_RELAXED, __HIP_MEMORY_SCOPE_AGENT); }
__device__ __forceinline__ unsigned xb_add(unsigned* p, unsigned v) { return __hip_atomic_fetch_add((GAS unsigned*)p, v, __ATOMIC_RELAXED, __HIP_MEMORY_SCOPE_AGENT); }
__device__ __forceinline__ unsigned xb_xcc_id() { return (unsigned)__builtin_amdgcn_s_getreg((3 << 11) | 20) & 0xFu; }
#define XB_SPIN(cond, bar) do { unsigned _sp = 0; while (cond) { __builtin_amdgcn_s_sleep(1); \
    if ((++_sp & 255u) == 0u) { if (xb_ld(&(bar)[XB_TMO])) break; if (_sp > XB_SPIN_CAP) { xb_add(&(bar)[XB_TMO], 1u); break; } } } } while (0)

struct XcdBarrier {
    unsigned* bar; unsigned x;
    volatile LAS unsigned* st;
};

__device__ __forceinline__ XcdBarrier xcd_barrier_post(unsigned* bar, volatile LAS unsigned* st) {
    XcdBarrier b; b.bar = bar; b.x = xb_xcc_id(); b.st = st;
    if (threadIdx.x == 0) (void)xb_add(&bar[XB_XCNT(b.x)], 1u);
    return b;
}
__device__ __forceinline__ void xcd_barrier_complete(unsigned* bar, unsigned x, unsigned& nloc, unsigned& nx) {
    const unsigned G = gridDim.x * gridDim.y * gridDim.z;
    unsigned sum, cnt, mine, sp = 0u;
    for (;;) {
        sum = 0u; cnt = 0u; mine = 0u;
#pragma unroll
        for (unsigned j = 0; j < 16; ++j) { const unsigned c = xb_ld(&bar[XB_XCNT(j)]); sum += c; cnt += (c > 0u) ? 1u : 0u; mine = (j == x) ? c : mine; }
        if (sum == G) break;
        __builtin_amdgcn_s_sleep(1);
        if ((++sp & 255u) == 0u) { if (xb_ld(&bar[XB_TMO])) break; if (sp > XB_SPIN_CAP) { xb_add(&bar[XB_TMO], 1u); break; } }
    }
    nloc = mine > 0u ? mine : 1u; nx = cnt > 0u ? cnt : 1u;
}

__device__ __forceinline__ void xcd_barrier(const XcdBarrier& b) {
    asm volatile("s_waitcnt vmcnt(0)" ::: "memory");
    __syncthreads();
    if (threadIdx.x == 0) {
        unsigned* bar = b.bar; asm volatile("" : "+s"(bar));
        __builtin_amdgcn_s_waitcnt(0);
        unsigned nloc = b.st[0], nx = b.st[1];
        if (nloc == 0u) { xcd_barrier_complete(bar, b.x, nloc, nx); b.st[0] = nloc; b.st[1] = nx; }
        const unsigned old = xb_add(&bar[XB_XSUB(b.x)], 1u);
        const unsigned gen = old / nloc;
        if (old + 1u == (gen + 1u) * nloc) {
            __builtin_amdgcn_fence(__ATOMIC_RELEASE, "agent");
            asm volatile("s_waitcnt vmcnt(0)" ::: "memory");
            const unsigned og = xb_add(&bar[XB_TOP], 1u);
            const unsigned tg = og / nx;
            if (og + 1u == (tg + 1u) * nx) xb_add(&bar[XB_TOPGEN], 1u);
            else XB_SPIN(xb_ld(&bar[XB_TOPGEN]) == tg, bar);
            __builtin_amdgcn_fence(__ATOMIC_ACQUIRE, "agent");
            xb_add(&bar[XB_XGEN(b.x)], 1u);
            asm volatile("s_waitcnt vmcnt(0)" ::: "memory");
        } else {
            XB_SPIN(xb_ld(&bar[XB_XGEN(b.x)]) == gen, bar);
            __builtin_amdgcn_fence(__ATOMIC_ACQUIRE, "agent");
            asm volatile("s_waitcnt vmcnt(0)" ::: "memory");
        }
    }
    __syncthreads();
}

struct Frame {
    LAS unsigned char* lds;
    gu32* ctl;
    int tid, lane, wave, G, gw, NGW;
    const float *x, *c, *w_ada, *b_ada, *norm_g, *w_in, *qk_g, *forget_b, *sinks, *rel_table, *group_g, *w_out, *w_gate, *w_up, *w_down;
    float* out;
    float *MOD, *LF, *KB2; unsigned short* SC; int* IDX;
    bf16 *WGU, *WD, *WIN, *WOUT, *H, *P, *Y, *XB;
};

template <int MAP> __device__ __forceinline__ int w_rowmap(int n) {
    if (MAP == 1) return 256 * (n >> 7) + (n & 127);
    if (MAP == 2) return 256 * (n >> 7) + 128 + (n & 127);
    if (MAP == 3) { if (n < 1728) return n; if (n < 1744) return PA_IW + (n - 1728); if (n < 3920) return n - 16; if (n < 3928) return PC_F + (n - 3920); return n - 24; }
    return n;
}
template <int MAP> __device__ __forceinline__ void p0_transpose_item(const float* W, int K, int N, bf16* WT, LAS unsigned* T, int item, int lane) {
    const int nblk = (N + 63) / 64, kb = item / nblk, nb = item % nblk, k0 = 64 * kb, n0 = 64 * nb;
    const int r = lane >> 4, c = lane & 15;
    const bool nok = (n0 + 4 * c) < N;
    const float* src = W + (size_t)(k0 + 2 * r) * N + n0 + 4 * c;
    f32x4 a[8], b[8];
#pragma unroll
    for (int i = 0; i < 8; ++i) { a[i] = nok ? *(const GAS f32x4*)(src + (size_t)(8 * i) * N) : (f32x4){0.f, 0.f, 0.f, 0.f}; b[i] = nok ? *(const GAS f32x4*)(src + (size_t)(8 * i + 1) * N) : (f32x4){0.f, 0.f, 0.f, 0.f}; }
#pragma unroll
    for (int i = 0; i < 8; ++i)
#pragma unroll
        for (int e = 0; e < 4; ++e) T[(4 * c + e) * 36 + 4 * i + r] = pk2(a[i][e], b[i][e]);
    LDS_WAIT(); asm volatile("" ::: "memory");
    const int rr = lane >> 3, ch = lane & 7;
#pragma unroll
    for (int j = 0; j < 8; ++j) { const int n = 8 * j + rr; const v4u o = *(const LAS v4u*)(T + n * 36 + 4 * ch);
        if (n0 + n < N) *(GAS v4u*)(WT + (size_t)w_rowmap<MAP>(n0 + n) * K + k0 + 8 * ch) = o; }
    LDS_WAIT(); asm volatile("" ::: "memory");
}
constexpr float W8_SCALE = 64.0f; constexpr int W8_E8M0 = 127 - 6;
__device__ __forceinline__ unsigned pk_fp8x4(float a, float b, float c, float d) {
    a = fminf(fmaxf(a, -448.f), 448.f); b = fminf(fmaxf(b, -448.f), 448.f); c = fminf(fmaxf(c, -448.f), 448.f); d = fminf(fmaxf(d, -448.f), 448.f);
    int w = 0; w = __builtin_amdgcn_cvt_pk_fp8_f32(a, b, w, false); w = __builtin_amdgcn_cvt_pk_fp8_f32(c, d, w, true); return (unsigned)w; }
template <int MAP> __device__ __forceinline__ void p0_transpose8_item(const float* W, int K, int N, unsigned char* WT, int ldw, LAS unsigned* T, int item, int lane) {
    const int nblk = (N + 63) / 64, kb = item / nblk, nb = item % nblk, k0 = 64 * kb, n0 = 64 * nb;
    const int r = lane >> 4, c = lane & 15;
    const bool nok = (n0 + 4 * c) < N;
    const float* src = W + (size_t)(k0 + 4 * r) * N + n0 + 4 * c;
    f32x4 q[4][4];
#pragma unroll
    for (int i = 0; i < 4; ++i)
#pragma unroll
        for (int d = 0; d < 4; ++d) q[i][d] = nok ? *(const GAS f32x4*)(src + (size_t)(16 * i + d) * N) : (f32x4){0.f, 0.f, 0.f, 0.f};
#pragma unroll
    for (int i = 0; i < 4; ++i)
#pragma unroll
        for (int e = 0; e < 4; ++e) T[(4 * c + e) * 20 + 4 * i + r] = pk_fp8x4(q[i][0][e] * W8_SCALE, q[i][1][e] * W8_SCALE, q[i][2][e] * W8_SCALE, q[i][3][e] * W8_SCALE);
    LDS_WAIT(); asm volatile("" ::: "memory");
    const int rr = lane >> 2, ch = lane & 3;
#pragma unroll
    for (int j = 0; j < 4; ++j) { const int n = 16 * j + rr; const v4u o = *(const LAS v4u*)(T + n * 20 + 4 * ch);
        if (n0 + n < N) *(GAS v4u*)(WT + (size_t)w_rowmap<MAP>(n0 + n) * ldw + k0 + 16 * ch) = o; }
    LDS_WAIT(); asm volatile("" ::: "memory");
}
template <int MAP> __device__ __forceinline__ void p0_transpose8(const Frame& F, const float* W, int K, int N, unsigned char* WT, int ldw, LAS unsigned* scr) {
    const int nitems = (K / 64) * ((N + 63) / 64);
    for (int it = F.gw; it < nitems; it += F.NGW) p0_transpose8_item<MAP>(W, K, N, WT, ldw, scr, it, F.lane);
}
template <int MAP> __device__ __forceinline__ void p0_transpose(const Frame& F, const float* W, int K, int N, bf16* WT, LAS unsigned* scr) {
    const int nitems = (K / 64) * ((N + 63) / 64);
    for (int it = F.gw; it < nitems; it += F.NGW) p0_transpose_item<MAP>(W, K, N, WT, scr, it, F.lane);
}
__device__ __forceinline__ void p0_prologue(const Frame& F) {
    LAS unsigned* scr = (LAS unsigned*)(F.lds + RING_OFF + F.wave * 16384);
    LAS float* cond = (LAS float*)(F.lds + AUX_OFF);
    LAS float* red = (LAS float*)(F.lds + RING_OFF);
    for (int i = F.tid; i < BATCH * DM; i += NTHREADS) { const float v = F.c[i]; cond[i] = v / (1.0f + __expf(-v)); }
    __syncthreads();
    for (int it = blockIdx.x; it < DEPTH * (NMOD / 64); it += F.G) {
        const int l = it / (NMOD / 64), n = (it % (NMOD / 64)) * 64 + F.lane;
        const float* w = F.w_ada + (size_t)l * DM * NMOD + (size_t)(256 * F.wave) * NMOD + n;
        const LAS float* c0 = cond + 256 * F.wave; const LAS float* c1 = cond + DM + 256 * F.wave;
        float a0 = 0.f, a1 = 0.f;
#pragma unroll 32
        for (int k = 0; k < 256; ++k) { const float wv = w[(size_t)k * NMOD]; a0 += c0[k] * wv; a1 += c1[k] * wv; }
        red[F.wave * 128 + F.lane] = a0; red[F.wave * 128 + 64 + F.lane] = a1;
        __syncthreads();
        if (F.tid < 128) { float sacc = 0.f;
#pragma unroll
            for (int wv = 0; wv < 8; ++wv) sacc += red[wv * 128 + F.tid];
            const int bsel = F.tid >> 6, nn = (it % (NMOD / 64)) * 64 + (F.tid & 63);
            F.MOD[((size_t)l * BATCH + bsel) * NMOD + nn] = sacc + F.b_ada[(size_t)l * NMOD + nn]; }
        __syncthreads();
    }
    for (int lf = 0; lf < DEPTH * 2; ++lf) {
        if (FFN_FP8) {
            p0_transpose8<1>(F, F.w_gate + (size_t)lf * DM * DFF, DM, DFF, (unsigned char*)F.WGU + (size_t)lf * NGU * DM, DM, scr);
            p0_transpose8<2>(F, F.w_up + (size_t)lf * DM * DFF, DM, DFF, (unsigned char*)F.WGU + (size_t)lf * NGU * DM, DM, scr);
            p0_transpose8<0>(F, F.w_down + (size_t)lf * DFF * DM, DFF, DM, (unsigned char*)F.WD + (size_t)lf * DM * DFFP, DFFP, scr);
        } else {
            p0_transpose<1>(F, F.w_gate + (size_t)lf * DM * DFF, DM, DFF, F.WGU + (size_t)lf * NGU * DM, scr);
            p0_transpose<2>(F, F.w_up + (size_t)lf * DM * DFF, DM, DFF, F.WGU + (size_t)lf * NGU * DM, scr);
            p0_transpose<0>(F, F.w_down + (size_t)lf * DFF * DM, DFF, DM, F.WD + (size_t)lf * DM * DFF, scr);
        }
    }
    for (int l = 0; l < DEPTH; ++l) {
        p0_transpose<3>(F, F.w_in + (size_t)l * DM * INC, DM, INC, F.WIN + (size_t)l * NIN * DM, scr);
        p0_transpose<0>(F, F.w_out + (size_t)l * DM * DM, DM, DM, F.WOUT + (size_t)l * DM * DM, scr);
        GAS v4u* z = (GAS v4u*)(F.WIN + (size_t)l * NIN * DM + (size_t)INC * DM);
        for (int i = F.gw * 64 + F.lane; i < (NIN - INC) * DM / 8; i += F.NGW * 64) z[i] = (v4u){0u, 0u, 0u, 0u};
    }
}

template <bool OUT8, bool IN16> __device__ __forceinline__ void ph_modulate(const Frame& F, const void* xin, const float* g, const float* shift, const float* scale) {
    if constexpr (IN16) {
        f32x4 av[4][2], hv[4][2]; int cb = -1;
        int m = F.gw;
        v4u wc[4];
        if (m < M) { const GAS v4u* xr = (const GAS v4u*)((const bf16*)xin + (size_t)m * DM) + F.lane;
#pragma unroll
            for (int j = 0; j < 4; ++j) wc[j] = xr[64 * j]; }
        while (m < M) {
            const int mn = m + F.NGW; const int b = m / SEQ;
            v4u wn[4];
            if (mn < M) { const GAS v4u* xr = (const GAS v4u*)((const bf16*)xin + (size_t)mn * DM) + F.lane;
#pragma unroll
                for (int j = 0; j < 4; ++j) wn[j] = xr[64 * j]; }
            else {
#pragma unroll
                for (int j = 0; j < 4; ++j) wn[j] = (v4u){0u, 0u, 0u, 0u}; }
            if (b != cb) { cb = b;
                const GAS f32x4* gp = (const GAS f32x4*)g + 2 * F.lane; const GAS f32x4* sh = (const GAS f32x4*)(shift + (size_t)b * NMOD) + 2 * F.lane; const GAS f32x4* sc = (const GAS f32x4*)(scale + (size_t)b * NMOD) + 2 * F.lane;
#pragma unroll
                for (int j = 0; j < 4; ++j)
#pragma unroll
                    for (int h = 0; h < 2; ++h) { const f32x4 gg = gp[128 * j + h], ss = sc[128 * j + h]; hv[j][h] = sh[128 * j + h]; av[j][h] = gg * (ss + 1.0f); } }
            float x[4][8]; float s = 0.f;
#pragma unroll
            for (int j = 0; j < 4; ++j) { x[j][0] = bf_lo(wc[j].x); x[j][1] = bf_hi(wc[j].x); x[j][2] = bf_lo(wc[j].y); x[j][3] = bf_hi(wc[j].y); x[j][4] = bf_lo(wc[j].z); x[j][5] = bf_hi(wc[j].z); x[j][6] = bf_lo(wc[j].w); x[j][7] = bf_hi(wc[j].w); }
#pragma unroll
            for (int j = 0; j < 4; ++j) s += ((x[j][0] * x[j][0] + x[j][1] * x[j][1]) + (x[j][2] * x[j][2] + x[j][3] * x[j][3])) + ((x[j][4] * x[j][4] + x[j][5] * x[j][5]) + (x[j][6] * x[j][6] + x[j][7] * x[j][7]));
            const float rstd = 1.0f / sqrtf(wave_sum(s) * (1.f / DM) + RMS_EPS);
            GAS v4u* o16 = (GAS v4u*)(F.H + (size_t)m * DM) + F.lane;
            GAS v2u* o8 = (GAS v2u*)((unsigned char*)F.H + (size_t)m * DM) + F.lane;
#pragma unroll
            for (int j = 0; j < 4; ++j) { float y[8];
#pragma unroll
                for (int h = 0; h < 2; ++h) { const f32x4 aa = av[j][h], hh = hv[j][h];
                    y[4 * h + 0] = x[j][4 * h + 0] * rstd * aa.x + hh.x; y[4 * h + 1] = x[j][4 * h + 1] * rstd * aa.y + hh.y;
                    y[4 * h + 2] = x[j][4 * h + 2] * rstd * aa.z + hh.z; y[4 * h + 3] = x[j][4 * h + 3] * rstd * aa.w + hh.w; }
                if (OUT8) { v2u w; w.x = pk_fp8x4(y[0], y[1], y[2], y[3]); w.y = pk_fp8x4(y[4], y[5], y[6], y[7]); o8[64 * j] = w; }
                else { v4u w; w.x = pk2(y[0], y[1]); w.y = pk2(y[2], y[3]); w.z = pk2(y[4], y[5]); w.w = pk2(y[6], y[7]); o16[64 * j] = w; } }
#pragma unroll
            for (int j = 0; j < 4; ++j) wc[j] = wn[j];
            m = mn;
        }
        return;
    }
    for (int m = F.gw; m < M; m += F.NGW) {
        const int b = m / SEQ;
        float x[4][8]; float s = 0.f;
        if constexpr (IN16) {
            const GAS v4u* xr = (const GAS v4u*)((const bf16*)xin + (size_t)m * DM) + F.lane;
            v4u w[4];
#pragma unroll
            for (int j = 0; j < 4; ++j) w[j] = xr[64 * j];
#pragma unroll
            for (int j = 0; j < 4; ++j) { x[j][0] = bf_lo(w[j].x); x[j][1] = bf_hi(w[j].x); x[j][2] = bf_lo(w[j].y); x[j][3] = bf_hi(w[j].y); x[j][4] = bf_lo(w[j].z); x[j][5] = bf_hi(w[j].z); x[j][6] = bf_lo(w[j].w); x[j][7] = bf_hi(w[j].w); }
        } else {
            const GAS f32x4* xr = (const GAS f32x4*)((const float*)xin + (size_t)m * DM) + 2 * F.lane;
            f32x4 a[4][2];
#pragma unroll
            for (int j = 0; j < 4; ++j) { a[j][0] = xr[128 * j]; a[j][1] = xr[128 * j + 1]; }
            GAS v4u* xo = (GAS v4u*)(F.XB + (size_t)m * DM) + F.lane;
#pragma unroll
            for (int j = 0; j < 4; ++j) { x[j][0] = a[j][0].x; x[j][1] = a[j][0].y; x[j][2] = a[j][0].z; x[j][3] = a[j][0].w; x[j][4] = a[j][1].x; x[j][5] = a[j][1].y; x[j][6] = a[j][1].z; x[j][7] = a[j][1].w;
                v4u w; w.x = pk2(x[j][0], x[j][1]); w.y = pk2(x[j][2], x[j][3]); w.z = pk2(x[j][4], x[j][5]); w.w = pk2(x[j][6], x[j][7]); xo[64 * j] = w; }
        }
#pragma unroll
        for (int j = 0; j < 4; ++j) s += ((x[j][0] * x[j][0] + x[j][1] * x[j][1]) + (x[j][2] * x[j][2] + x[j][3] * x[j][3])) + ((x[j][4] * x[j][4] + x[j][5] * x[j][5]) + (x[j][6] * x[j][6] + x[j][7] * x[j][7]));
        const float rstd = 1.0f / sqrtf(wave_sum(s) * (1.f / DM) + RMS_EPS);
        const GAS f32x4* gp = (const GAS f32x4*)g + 2 * F.lane; const GAS f32x4* sh = (const GAS f32x4*)(shift + (size_t)b * NMOD) + 2 * F.lane; const GAS f32x4* sc = (const GAS f32x4*)(scale + (size_t)b * NMOD) + 2 * F.lane;
        GAS v4u* o16 = (GAS v4u*)(F.H + (size_t)m * DM) + F.lane;
        GAS v2u* o8 = (GAS v2u*)((unsigned char*)F.H + (size_t)m * DM) + F.lane;
#pragma unroll
        for (int j = 0; j < 4; ++j) { float y[8];
#pragma unroll
            for (int h = 0; h < 2; ++h) { const f32x4 gg = gp[128 * j + h], ss = sc[128 * j + h], hh = sh[128 * j + h];
                y[4 * h + 0] = x[j][4 * h + 0] * rstd * gg.x * (ss.x + 1.0f) + hh.x; y[4 * h + 1] = x[j][4 * h + 1] * rstd * gg.y * (ss.y + 1.0f) + hh.y;
                y[4 * h + 2] = x[j][4 * h + 2] * rstd * gg.z * (ss.z + 1.0f) + hh.z; y[4 * h + 3] = x[j][4 * h + 3] * rstd * gg.w * (ss.w + 1.0f) + hh.w; }
            if (OUT8) { v2u w; w.x = pk_fp8x4(y[0], y[1], y[2], y[3]); w.y = pk_fp8x4(y[4], y[5], y[6], y[7]); o8[64 * j] = w; }
            else { v4u w; w.x = pk2(y[0], y[1]); w.y = pk2(y[2], y[3]); w.z = pk2(y[4], y[5]); w.w = pk2(y[6], y[7]); o16[64 * j] = w; } }
    }
}
__device__ __forceinline__ v4u headnorm8(v4u w, const float* g, float mul, int lane, bool normalize) {
    float x[8] = {bf_lo(w.x), bf_hi(w.x), bf_lo(w.y), bf_hi(w.y), bf_lo(w.z), bf_hi(w.z), bf_lo(w.w), bf_hi(w.w)};
    float r = mul;
    if (normalize) {
        float s = 0.f;
#pragma unroll
        for (int i = 0; i < 8; ++i) s += x[i] * x[i];
        s += __shfl_xor(s, 1); s += __shfl_xor(s, 2); s += __shfl_xor(s, 4);
        r = mul / sqrtf(s * (1.f / 64.f) + RMS_EPS);
        const f32x4 g0 = *(const GAS f32x4*)(g + 8 * (lane & 7)), g1 = *(const GAS f32x4*)(g + 8 * (lane & 7) + 4);
        x[0] *= g0.x; x[1] *= g0.y; x[2] *= g0.z; x[3] *= g0.w; x[4] *= g1.x; x[5] *= g1.y; x[6] *= g1.z; x[7] *= g1.w;
    }
    w.x = pk2(x[0] * r, x[1] * r); w.y = pk2(x[2] * r, x[3] * r); w.z = pk2(x[4] * r, x[5] * r); w.w = pk2(x[6] * r, x[7] * r);
    return w;
}
__device__ __forceinline__ v4u headnorm8g(v4u w, f32x4 g0, f32x4 g1, float mul, bool normalize) {
    float x[8] = {bf_lo(w.x), bf_hi(w.x), bf_lo(w.y), bf_hi(w.y), bf_lo(w.z), bf_hi(w.z), bf_lo(w.w), bf_hi(w.w)};
    float r = mul;
    if (normalize) {
        float s = 0.f;
#pragma unroll
        for (int i = 0; i < 8; ++i) s += x[i] * x[i];
        s += __shfl_xor(s, 1); s += __shfl_xor(s, 2); s += __shfl_xor(s, 4);
        r = mul / sqrtf(s * (1.f / 64.f) + RMS_EPS);
        x[0] *= g0.x; x[1] *= g0.y; x[2] *= g0.z; x[3] *= g0.w; x[4] *= g1.x; x[5] *= g1.y; x[6] *= g1.z; x[7] *= g1.w;
    }
    w.x = pk2(x[0] * r, x[1] * r); w.y = pk2(x[2] * r, x[3] * r); w.z = pk2(x[4] * r, x[5] * r); w.w = pk2(x[6] * r, x[7] * r);
    return w;
}
__device__ __forceinline__ void ph_post(const Frame& F, int l) {
    const float* qg = F.qk_g + (size_t)l * 6 * HD; const int lane = F.lane;
    f32x4 gq[6][2];
    { const int gi[5] = {0, 2, 4, 5, (lane < 8 ? 1 : 3)};
#pragma unroll
      for (int i = 0; i < 5; ++i) { const float* gp = qg + gi[i] * HD + 8 * (lane & 7); gq[i][0] = *(const GAS f32x4*)gp; gq[i][1] = *(const GAS f32x4*)(gp + 4); } }
    const int koff = (lane < 8 ? PA_K : PB_K) + 8 * (lane & 7);
    int m = F.gw;
    v4u wc[6];
#define POST_LOAD(mm_, W) do { const bf16* row_ = F.P + (size_t)(mm_) * NIN; W[0] = *(const GAS v4u*)(row_ + PA_Q + 8 * lane); W[1] = *(const GAS v4u*)(row_ + PB_Q + 8 * lane); W[2] = *(const GAS v4u*)(row_ + PC_Q + 8 * lane); \
        W[3] = *(const GAS v4u*)(row_ + PC_K + 8 * lane); W[4] = (v4u){0u, 0u, 0u, 0u}; W[5] = (v4u){0u, 0u, 0u, 0u};     if (lane < 16) W[5] = *(const GAS v4u*)(row_ + koff); } while (0)
    if (m < M) POST_LOAD(m, wc);
    while (m < M) {
        const int mn = m + F.NGW;
        v4u wn[6];
        if (mn < M) POST_LOAD(mn, wn);
        else {
#pragma unroll
            for (int i = 0; i < 6; ++i) wn[i] = (v4u){0u, 0u, 0u, 0u}; }
        bf16* row = F.P + (size_t)m * NIN;
        *(GAS v4u*)(row + PA_Q + 8 * lane) = headnorm8g(wc[0], gq[0][0], gq[0][1], QSCALE, true);
        *(GAS v4u*)(row + PB_Q + 8 * lane) = headnorm8g(wc[1], gq[1][0], gq[1][1], QSCALE, true);
        *(GAS v4u*)(row + PC_Q + 8 * lane) = headnorm8g(wc[2], gq[2][0], gq[2][1], QSCALE, true);
        *(GAS v4u*)(row + PC_K + 8 * lane) = headnorm8g(wc[3], gq[3][0], gq[3][1], 1.0f, true);
        if (lane < 16) *(GAS v4u*)(row + koff) = headnorm8g(wc[5], gq[4][0], gq[4][1], 1.0f, true);
#pragma unroll
        for (int i = 0; i < 6; ++i) wc[i] = wn[i];
        m = mn;
    }
#undef POST_LOAD
}
__device__ __forceinline__ void ph_scan(const Frame& F, int l) {
    LAS float* wtot = (LAS float*)(F.lds + RING_OFF);
    for (int sq = blockIdx.x; sq < BATCH * NH; sq += F.G) {
        const int b = sq / NH, h = sq % NH; const float fb = F.forget_b[(size_t)l * NH + h];
        const GAS unsigned short* src = (const GAS unsigned short*)(F.P + ((size_t)b * SEQ + 16 * F.tid) * NIN + PC_F + h); float* dst = F.KB2 + (size_t)sq * SEQ + 16 * F.tid;
        float v[16]; unsigned short raw[16];
#pragma unroll
        for (int i = 0; i < 16; ++i) raw[i] = src[(size_t)i * NIN];
#pragma unroll
        for (int i = 0; i < 16; ++i) { const float y = __builtin_bit_cast(float, (unsigned)raw[i] << 16) + fb; v[i] = (y >= 0.f) ? -log1pf(__expf(-y)) : (y - log1pf(__expf(y))); }
#pragma unroll
        for (int i = 1; i < 16; ++i) v[i] += v[i - 1];
        float incl = v[15];
#pragma unroll
        for (int o = 1; o < 64; o <<= 1) { const float t = __shfl_up(incl, o); if (F.lane >= o) incl += t; }
        if (F.lane == 63) wtot[F.wave] = incl;
        __syncthreads();
        float base = incl - v[15];
        for (int w = 0; w < F.wave; ++w) base += wtot[w];
#pragma unroll
        for (int i = 0; i < 4; ++i) *(GAS f32x4*)(dst + 4 * i) = (f32x4){-(v[4 * i] + base) * LOG2E, -(v[4 * i + 1] + base) * LOG2E, -(v[4 * i + 2] + base) * LOG2E, -(v[4 * i + 3] + base) * LOG2E};
        __syncthreads();
    }
}
__device__ __forceinline__ void ph_gnorm(const Frame& F, int l) {
    const float* gg = F.group_g + (size_t)l * DM;
    f32x4 gv[4][2];
#pragma unroll
    for (int g = 0; g < 4; ++g) { gv[g][0] = *(const GAS f32x4*)(gg + g * GWID + 8 * F.lane); gv[g][1] = *(const GAS f32x4*)(gg + g * GWID + 8 * F.lane + 4); }
    int m = F.gw;
    v4u wc[4];
    if (m < M) {
#pragma unroll
        for (int g = 0; g < 4; ++g) wc[g] = *(GAS v4u*)(F.Y + (size_t)m * DM + g * GWID + 8 * F.lane); }
    while (m < M) {
        const int mn = m + F.NGW;
        v4u wn[4];
        if (mn < M) {
#pragma unroll
            for (int g = 0; g < 4; ++g) wn[g] = *(GAS v4u*)(F.Y + (size_t)mn * DM + g * GWID + 8 * F.lane); }
        else {
#pragma unroll
            for (int g = 0; g < 4; ++g) wn[g] = (v4u){0u, 0u, 0u, 0u}; }
#pragma unroll
        for (int g = 0; g < 4; ++g) {
            bf16* p = F.Y + (size_t)m * DM + g * GWID + 8 * F.lane;
            float x[8] = {bf_lo(wc[g].x), bf_hi(wc[g].x), bf_lo(wc[g].y), bf_hi(wc[g].y), bf_lo(wc[g].z), bf_hi(wc[g].z), bf_lo(wc[g].w), bf_hi(wc[g].w)};
            float s = 0.f;
#pragma unroll
            for (int i = 0; i < 8; ++i) s += x[i] * x[i];
            const float r = 1.0f / sqrtf(wave_sum(s) * (1.f / GWID) + RMS_EPS);
            const f32x4 g0 = gv[g][0], g1 = gv[g][1];
            v4u o; o.x = pk2(x[0] * r * g0.x, x[1] * r * g0.y); o.y = pk2(x[2] * r * g0.z, x[3] * r * g0.w); o.z = pk2(x[4] * r * g1.x, x[5] * r * g1.y); o.w = pk2(x[6] * r * g1.z, x[7] * r * g1.w);
            *(GAS v4u*)p = o;
        }
#pragma unroll
        for (int g = 0; g < 4; ++g) wc[g] = wn[g];
        m = mn;
    }
}


__device__ __forceinline__ unsigned short score_key(float sc) {
    const _Float16 hf = (_Float16)fminf(fmaxf(sc, -60000.f), 60000.f);
    const unsigned h = (unsigned)__builtin_bit_cast(unsigned short, hf);
    return (unsigned short)((h & 0x8000u) ? (~h & 0xffffu) : (h | 0x8000u));
}
__device__ __forceinline__ void glds16x(const void* gsrc, unsigned lds_dst) { unsigned keep;
    asm volatile("s_mov_b32 %0, m0\n\ts_mov_b32 m0, %2\n\ts_nop 0\n\tglobal_load_lds_dwordx4 %1, off\n\ts_mov_b32 m0, %0" : "=&s"(keep) : "v"(gsrc), "s"(lds_dst) : "memory"); }
__device__ __forceinline__ void ph_idx_scores(const Frame& F) {
    constexpr int UPB = 8 * (16 * 17 / 2), NU = BATCH * UPB;
    const int lane = F.lane, r32 = lane & 31, hi = lane >> 5;
    const int u_lo = (int)(((long)blockIdx.x * NU) / F.G), u_hi = (int)(((long)(blockIdx.x + 1) * NU) / F.G);
    if (u_lo >= u_hi) return;
    int b = u_lo / UPB, qb = 127, kc = 0; { int r = u_lo % UPB; for (;;) { const int n = (qb >> 3) + 1; if (r < n) { kc = r; break; } r -= n; --qb; } }
    LAS unsigned char* KL = F.lds + RING_OFF;
    const unsigned kl_lds = (unsigned)(size_t)KL;
#define X1_STAGE(bb, kk, buf) do { const bf16* ksrc_ = F.P + ((size_t)(bb) * SEQ + 512 * (kk) + 64 * F.wave + lane) * NIN + PA_IK; \
        _Pragma("unroll") for (int c_ = 0; c_ < 8; ++c_) glds16x(ksrc_ + 8 * c_, (unsigned)__builtin_amdgcn_readfirstlane(kl_lds + (buf) * 65536 + c_ * 8192 + F.wave * 1024)); } while (0)
    X1_STAGE(b, kc, 0);
    asm volatile("s_waitcnt vmcnt(0)" ::: "memory"); __syncthreads();
    bf16x8 af[4][4]; float wq[4][16]; int cb = -1, cqb = -1;
    for (int u = u_lo; u < u_hi; ++u) {
        const int cur = (u - u_lo) & 1;
        int nb = b, nqb = qb, nkc = kc + 1; if (nkc > (qb >> 3)) { nkc = 0; --nqb; if (nqb < 0) { nqb = 127; ++nb; } }
        if (u + 1 < u_hi) X1_STAGE(nb, nkc, cur ^ 1);
        const size_t rowb = (size_t)b * SEQ; const int t0 = 64 * qb + 8 * F.wave;
        if (b != cb || qb != cqb) { cb = b; cqb = qb;
#pragma unroll
            for (int pr = 0; pr < 4; ++pr) {
                const bf16* qrow = F.P + (rowb + t0 + 2 * pr + ((r32 >> 2) & 1)) * NIN + PA_IQ + ((r32 & 3) + 4 * (r32 >> 3)) * 64 + 8 * hi;
#pragma unroll
                for (int s = 0; s < 4; ++s) af[pr][s] = *(const GAS bf16x8*)(qrow + 16 * s);
                const bf16* wrow = F.P + (rowb + t0 + 2 * pr + hi) * NIN + PA_IW;
                const v4u w0 = *(const GAS v4u*)wrow, w1 = *(const GAS v4u*)(wrow + 8);
                const unsigned ww[8] = {w0.x, w0.y, w0.z, w0.w, w1.x, w1.y, w1.z, w1.w};
#pragma unroll
                for (int i = 0; i < 8; ++i) { wq[pr][2 * i] = bf_lo(ww[i]) * 0.015625f; wq[pr][2 * i + 1] = bf_hi(ww[i]) * 0.015625f; }
            }
        }
        const int kend = 64 * (qb + 1) - 512 * kc;
        const int nkt = kend >= 512 ? 16 : (kend + 31) / 32;
        const LAS unsigned char* kl = KL + cur * 65536 + hi * 8192 + r32 * 16;
        for (int kt = 0; kt < nkt; ++kt) {
            bf16x8 bfr[4];
#pragma unroll
            for (int s = 0; s < 4; ++s) bfr[s] = *(const LAS bf16x8*)(kl + s * 16384 + kt * 512);
            const int s0 = 512 * kc + 32 * kt;
#pragma unroll
            for (int pr = 0; pr < 4; ++pr) {
                f32x16 acc = {};
#pragma unroll
                for (int s = 0; s < 4; ++s) acc = __builtin_amdgcn_mfma_f32_32x32x16_bf16(af[pr][s], bfr[s], acc, 0, 0, 0);
                float sc0 = 0.f, sc1 = 0.f;
#pragma unroll
                for (int r = 0; r < 16; ++r) { sc0 = __builtin_fmaf(wq[pr][r], acc[r], sc0); sc1 = __builtin_fmaf(wq[pr][r], __builtin_fabsf(acc[r]), sc1); if ((r & 3) == 3) asm("" : "+v"(sc1)); }
                ((GAS unsigned short*)F.SC)[(rowb + t0 + 2 * pr + hi) * SEQ + s0 + r32] = score_key(sc0 + sc1);
                __builtin_amdgcn_sched_barrier(0);
            }
        }
        asm volatile("s_waitcnt vmcnt(0)" ::: "memory");
        __syncthreads();
        b = nb; qb = nqb; kc = nkc;
    }
#undef X1_STAGE
}

__device__ __forceinline__ unsigned mbcnt64(unsigned long long m) { return __builtin_amdgcn_mbcnt_hi((unsigned)(m >> 32), __builtin_amdgcn_mbcnt_lo((unsigned)m, 0u)); }
template <int SH, int PSH> __device__ __forceinline__ void sel_level(const unsigned (&v)[64], int nreg, unsigned pval, unsigned need, LAS unsigned* hist, int lane, unsigned& bin_out, unsigned& above_out) {
#pragma unroll
    for (int i = 0; i < 8; ++i) ((LAS v4u*)hist)[lane + 64 * i] = (v4u){0u, 0u, 0u, 0u};
    LDS_WAIT(); __builtin_amdgcn_wave_barrier();
    const unsigned hb = (unsigned)(size_t)hist, sink = hb + 9216u + 4u * (unsigned)lane;
#pragma unroll
    for (int g = 0; g < 8; ++g) if (8 * g < nreg) {
#pragma unroll
        for (int jj = 0; jj < 8; ++jj) { const int j = 8 * g + jj;
#pragma unroll
            for (int e = 0; e < 2; ++e) { const unsigned k = e ? (v[j] >> 16) : (v[j] & 0xffffu);
                const bool pred = (k != 0u) && (PSH >= 16 || (k >> (PSH & 15)) == pval);
                const unsigned tgt = pred ? hb + (((k >> SH) & 2047u) << 2) : sink;
                __hip_atomic_fetch_add((LAS unsigned*)tgt, 1u, __ATOMIC_RELAXED, __HIP_MEMORY_SCOPE_WAVEFRONT); }
            if ((jj & 1) == 1) __builtin_amdgcn_sched_barrier(0); }
    }
    LDS_WAIT(); __builtin_amdgcn_wave_barrier();
    unsigned S = 0u;
#pragma unroll
    for (int i = 0; i < 8; ++i) { const v4u q = ((LAS v4u*)hist)[lane * 8 + i]; S += (q.x + q.y) + (q.z + q.w); }
    unsigned T = S;
#pragma unroll
    for (int o = 1; o < 64; o <<= 1) { const unsigned t = __shfl_down(T, o); if (lane + o < 64) T += t; }
    const unsigned above_lane = T - S;
    const bool cross = (T >= need) && (above_lane < need);
    unsigned run = above_lane, bin = 0u, ab = 0u; bool found = false;
#pragma unroll
    for (int i = 7; i >= 0; --i) { const v4u q = ((LAS v4u*)hist)[lane * 8 + i]; const unsigned c4[4] = {q.x, q.y, q.z, q.w};
#pragma unroll
        for (int e = 3; e >= 0; --e) { const bool hit = !found && (run + c4[e] >= need); if (hit) { bin = 32u * lane + 4 * i + e; ab = run; found = true; } run += c4[e]; } }
    const unsigned long long cm = __ballot(cross);
    const int src = cm ? (int)__builtin_ctzll(cm) : 0;
    bin_out = __builtin_amdgcn_readlane(bin, src); above_out = __builtin_amdgcn_readlane(ab, src);
    LDS_WAIT(); __builtin_amdgcn_wave_barrier();
}
__device__ __forceinline__ void select_row(const Frame& F, int m, LAS unsigned* hist, LAS int* out) {
    int lane = F.lane; asm volatile("" : "+v"(lane));
    const int t = m % SEQ, n = t + 1;
    if (n <= TOPK) { for (int j = lane; j < TOPK; j += 64) out[j] = (j < n) ? j : 0; return; }
    const int nreg = (n + 127) >> 7;
    unsigned v[64];
    const GAS unsigned* pr = (const GAS unsigned*)(F.SC + (size_t)m * SEQ) + lane;
#pragma unroll
    for (int g = 0; g < 8; ++g) {
        if (8 * g < nreg) {
#pragma unroll
            for (int jj = 0; jj < 8; ++jj) v[8 * g + jj] = pr[jj * 64];
        } else {
#pragma unroll
            for (int jj = 0; jj < 8; ++jj) v[8 * g + jj] = 0u;
        }
        pr += 512; asm volatile("" : "+v"(pr));
    }
    const int nfull = n >> 7;
#pragma unroll
    for (int g = 0; g < 8; ++g) if (8 * g < nreg && 8 * g + 8 > nfull) {
#pragma unroll
        for (int jj = 0; jj < 8; ++jj) { const int j = 8 * g + jj; const int e0 = 128 * j + 2 * lane; const unsigned w = v[j];
            v[j] = ((e0 < n) ? (w & 0xffffu) : 0u) | ((e0 + 1 < n) ? (w & 0xffff0000u) : 0u); asm volatile("" : "+v"(v[j])); }
    }
    unsigned b1, a1, b2, a2;
    sel_level<5, 16>(v, nreg, 0u, (unsigned)TOPK, hist, lane, b1, a1);
    sel_level<0, 5>(v, nreg, b1, (unsigned)TOPK - a1, hist, lane, b2, a2);
    const unsigned tau = (b1 << 5) | (b2 & 31u);
    const unsigned quota = (unsigned)TOPK - a1 - a2;
    unsigned mg[4] = {0u, 0u, 0u, 0u}, me[4] = {0u, 0u, 0u, 0u};
#pragma unroll
    for (int g = 0; g < 8; ++g) {
        if (8 * g < nreg) {
#pragma unroll
            for (int jj = 0; jj < 8; ++jj) { const int j = 8 * g + jj;
#pragma unroll
                for (int e = 0; e < 2; ++e) { const unsigned k = e ? (v[j] >> 16) : (v[j] & 0xffffu);
                    mg[g >> 1] = mg[g >> 1] + mg[g >> 1] + ((k > tau) ? 1u : 0u); me[g >> 1] = me[g >> 1] + me[g >> 1] + ((k == tau) ? 1u : 0u); }
                if ((jj & 3) == 3) __builtin_amdgcn_sched_barrier(0); }
        } else { mg[g >> 1] <<= 16; me[g >> 1] <<= 16; }
    }
    const unsigned cg = (unsigned)(__builtin_popcount(mg[0]) + __builtin_popcount(mg[1]) + __builtin_popcount(mg[2]) + __builtin_popcount(mg[3]));
    unsigned ce = (unsigned)(__builtin_popcount(me[0]) + __builtin_popcount(me[1]) + __builtin_popcount(me[2]) + __builtin_popcount(me[3]));
    unsigned incl = cg | (ce << 16);
#pragma unroll
    for (int o = 1; o < 64; o <<= 1) { const unsigned t = (unsigned)__shfl_up((int)incl, o); if (lane >= o) incl += t; }
    const unsigned excl = incl - (cg | (ce << 16));
    const unsigned pre_g = excl & 0xffffu, pre_e = excl >> 16;
    const unsigned keep = pre_e >= quota ? 0u : ((quota - pre_e) < ce ? (quota - pre_e) : ce);
#pragma unroll
    for (int q = 3; q >= 0; --q) { while (ce > keep && me[q] != 0u) { me[q] &= me[q] - 1u; --ce; } }
    unsigned pos = pre_g + (pre_e < quota ? pre_e : quota);
    const int ilane = 2 * lane;
#pragma unroll
    for (int q = 0; q < 4; ++q) { unsigned mm = mg[q] | me[q];
        while (mm != 0u) { const int bpos = 31 - (int)__builtin_clz(mm); const int sl = 31 - bpos; mm &= ~(1u << bpos);
            const int i = 128 * (16 * q + (sl >> 1)) + ilane + (sl & 1);
            if (pos < (unsigned)TOPK) out[pos] = i;
            ++pos; } }
}


constexpr int AT_K = 0, AT_V = 16384, AT_KB = 32768, AT_WSF = 33280, AT_BT = 35328, AT_DEAD = 35840, AT_SV = 36864;
typedef short v4i16_t __attribute__((ext_vector_type(4)));
__device__ __forceinline__ s16x4 vtr(const LAS unsigned char* p) { return __builtin_bit_cast(s16x4, __builtin_amdgcn_ds_read_tr16_b64_v4i16((LAS v4i16_t*)p)); }
typedef __bf16 bfpair_t __attribute__((ext_vector_type(2))); typedef float f32pair_t __attribute__((ext_vector_type(2)));
__device__ __forceinline__ unsigned cvtpk(float lo, float hi) { const f32pair_t v = {lo, hi}; return __builtin_bit_cast(unsigned, __builtin_convertvector(v, bfpair_t)); }
#define NEG_INF (-__builtin_inff())

template <int TYPE>
__device__ __forceinline__ void dense_attn_unit(const Frame& F, int l, int b, int h, int qb) {
    constexpr int QOFF = TYPE == 1 ? PB_Q : TYPE == 2 ? PC_Q : PD_Q, KOFF = TYPE == 1 ? PB_K : TYPE == 2 ? PC_K : PD_K, VOFF = TYPE == 1 ? PB_V : TYPE == 2 ? PC_V : PD_V;
    constexpr bool MQA = TYPE == 1; constexpr int YOFF = TYPE * GWID;
    const int tid = F.tid, lane = F.lane, wid = F.wave, r32 = lane & 31, hi = lane >> 5;
    LAS unsigned char* L = F.lds + RING_OFF;
    LAS float* wsf = (LAS float*)(L + AT_WSF + wid * 256);
    LAS float* BT = (LAS float*)(L + AT_BT);
    const int hq = (TYPE == 1) ? wid : h, qoff = (TYPE == 1) ? (qb & 7) * 32 : wid * 32, qb256 = (TYPE == 1) ? (qb >> 3) : qb;
    const size_t rowb = (size_t)b * SEQ; const int q0 = qb256 * 256;
    const bf16* Pk = F.P + rowb * NIN + KOFF + (MQA ? 0 : h * 64);
    const bf16* Pv = F.P + rowb * NIN + VOFF + (MQA ? 0 : h * 64);
    const bf16* Pq = F.P + (rowb + q0 + qoff + r32) * NIN + QOFF + hq * 64 + hi * 8;
    bf16x8 qr[4];
#pragma unroll
    for (int d0 = 0; d0 < 4; ++d0) qr[d0] = *(const GAS bf16x8*)(Pq + 16 * d0);
    const int jt_hi = (TYPE == 1) ? ((q0 + qoff + 31) >> 6) : 4 * qb256 + 3, jt_lo = (TYPE == 1) ? (((q0 + qoff - (WINDOW - 1)) > 0 ? (q0 + qoff - (WINDOW - 1)) : 0) >> 6) : 0, nt = jt_hi - jt_lo + 1;
    if (TYPE == 1) { LAS float* BTall = (LAS float*)(L + AT_SV);
        for (int i = tid; i < 8 * 128; i += NTHREADS) BTall[i] = F.rel_table[(int)kBucketLut[i & 127] * 16 + 8 + (i >> 7)] * LOG2E;
        BT = BTall + 128 * wid; }
    const bf16* kgp = Pk + (size_t)(8 * wid + (lane >> 3)) * NIN + (lane & 7) * 8;
    const int vkey = tid >> 3, vch = tid & 7;
    const bf16* vgp = Pv + (size_t)vkey * NIN + vch * 8;
    const int kl = (lane & 7) * 1024 + (8 * wid + (lane >> 3)) * 16;
    const int vl = (vch >> 2) * 4096 + (vkey >> 3) * 512 + (vkey & 7) * 64 + (vch & 3) * 16;
    const float* kb2 = F.KB2 + ((size_t)b * NH + h) * SEQ;
    v4u kreg = *(const GAS v4u*)(kgp + (size_t)jt_hi * 64 * NIN), vreg = *(const GAS v4u*)(vgp + (size_t)jt_hi * 64 * NIN);
    float kbreg = 0.f; if (TYPE == 2 && tid < 64) kbreg = kb2[jt_hi * 64 + tid];
    *(LAS v4u*)(L + AT_K + kl) = kreg; *(LAS v4u*)(L + AT_V + vl) = vreg; if (TYPE == 2 && tid < 64) ((LAS float*)(L + AT_KB))[tid] = kbreg;
    __syncthreads();
    f32x16 o[2]; o[0] = f32x16{}; o[1] = f32x16{};
    float mrun = NEG_INF, lsum = 0.f, carry = 1.f;
    float qbound = 0.f;
    if (TYPE == 2) {
        float ss = 0.f;
#pragma unroll
        for (int d0 = 0; d0 < 4; ++d0)
#pragma unroll
            for (int j = 0; j < 8; ++j) { const float x = bf2f((bf16)qr[d0][j]); ss += x * x; }
        ss += __shfl_xor(ss, 32);
        float gm = fabsf(F.qk_g[((size_t)l * 6 + 5) * HD + lane]);
#pragma unroll
        for (int o = 1; o < 64; o <<= 1) gm = fmaxf(gm, __shfl_xor(gm, o));
        qbound = sqrtf(ss) * 8.08f * gm;
    }
    const int qrel = qoff + r32;
    const int vb = ((lane >> 4) & 1) * 32 + (lane & 3) * 8 + (4 * hi + ((lane & 15) >> 2)) * 64;
    LAS unsigned* deadf = (LAS unsigned*)(L + AT_DEAD);
    for (int i = 0; i < nt; ++i) {
        const int jt = jt_hi - i, cur = i & 1, jb = jt - 4 * qb256; const bool more = (i + 1 < nt);
        float kbnext = 0.f;
        if (more) { kreg = *(const GAS v4u*)(kgp + (size_t)(jt - 1) * 64 * NIN); vreg = *(const GAS v4u*)(vgp + (size_t)(jt - 1) * 64 * NIN); if (TYPE == 2 && tid < 64) kbreg = kb2[(jt - 1) * 64 + tid]; if (TYPE == 2) kbnext = kb2[jt * 64 - 1]; }
        const bool active = (64 * jb <= qoff + 31) && (TYPE != 1 || (64 * jb + 63 >= qoff - (WINDOW - 1)));
        if (active) {
            const LAS unsigned char* Kb = L + AT_K + cur * 8192; const LAS unsigned char* Vb = L + AT_V + cur * 8192;
            f32x16 p0 = f32x16{}, p1 = f32x16{};
            bf16x8 ka[4], kc[4];
#pragma unroll
            for (int d0 = 0; d0 < 4; ++d0) { ka[d0] = *(const LAS bf16x8*)(Kb + (2 * d0 + hi) * 1024 + r32 * 16); kc[d0] = *(const LAS bf16x8*)(Kb + (2 * d0 + hi) * 1024 + 512 + r32 * 16); }
            __builtin_amdgcn_sched_barrier(0);
#pragma unroll
            for (int d0 = 0; d0 < 4; ++d0) { p0 = __builtin_amdgcn_mfma_f32_32x32x16_bf16(ka[d0], qr[d0], p0, 0, 0, 0); p1 = __builtin_amdgcn_mfma_f32_32x32x16_bf16(kc[d0], qr[d0], p1, 0, 0, 0); }
            bf16x8 vfr[2][4];
#pragma unroll
            for (int d0 = 0; d0 < 2; ++d0)
#pragma unroll
                for (int ks = 0; ks < 4; ++ks) { const s16x4 lo = vtr(Vb + vb + d0 * 4096 + ks * 1024), hh = vtr(Vb + vb + d0 * 4096 + ks * 1024 + 512);
                    vfr[d0][ks] = (bf16x8){lo[0], lo[1], lo[2], lo[3], hh[0], hh[1], hh[2], hh[3]}; }
            __builtin_amdgcn_sched_barrier(0);
            bool live = true;
            const int kv0 = 64 * jb + 4 * hi;
            if (TYPE == 3) {
                float b0[16], b1[16];
#pragma unroll
                for (int r = 0; r < 16; ++r) { const int kv = kv0 + (r & 3) + 8 * (r >> 2);
                    const float e0 = fexp2(fminf(p0[r] * QSCALE, 80.f)), e1 = fexp2(fminf(p1[r] * QSCALE, 80.f));
                    const float m0 = frcp(1.0f + e0), m1 = frcp(1.0f + e1);
                    const bool ok0 = kv < qrel, ok1 = (kv + 32) < qrel;
                    b0[r] = ok0 ? e0 * m0 : 0.f; b1[r] = ok1 ? e1 * m1 : 0.f; p0[r] = ok0 ? m0 : 1.0f; p1[r] = ok1 ? m1 : 1.0f; }
                float gp[8], go[8], pp[8];
#pragma unroll
                for (int g = 0; g < 4; ++g) { gp[g] = (p0[4 * g] * p0[4 * g + 1]) * (p0[4 * g + 2] * p0[4 * g + 3]); gp[4 + g] = (p1[4 * g] * p1[4 * g + 1]) * (p1[4 * g + 2] * p1[4 * g + 3]); }
#pragma unroll
                for (int g = 0; g < 8; ++g) { const float oth = __shfl_xor(gp[g], 32); pp[g] = gp[g] * oth; go[g] = hi ? 1.0f : oth; }
                float sp = 1.0f;
#pragma unroll
                for (int g = 7; g >= 0; --g) { const float sg = sp * go[g] * carry;
                    if (g < 4) { const float c3 = p0[4 * g + 3], c2 = p0[4 * g + 2], c1 = p0[4 * g + 1];
                        p0[4 * g + 3] = b0[4 * g + 3] * sg; const float s2 = sg * c3; p0[4 * g + 2] = b0[4 * g + 2] * s2; const float s1 = s2 * c2; p0[4 * g + 1] = b0[4 * g + 1] * s1; p0[4 * g] = b0[4 * g] * (s1 * c1); }
                    else { const int q = g - 4; const float c3 = p1[4 * q + 3], c2 = p1[4 * q + 2], c1 = p1[4 * q + 1];
                        p1[4 * q + 3] = b1[4 * q + 3] * sg; const float s2 = sg * c3; p1[4 * q + 2] = b1[4 * q + 2] * s2; const float s1 = s2 * c2; p1[4 * q + 1] = b1[4 * q + 1] * s1; p1[4 * q] = b1[4 * q] * (s1 * c1); }
                    sp *= pp[g]; }
                carry *= sp;
            } else {
                if (TYPE == 2) {
                    const LAS f32x4* kbp = (const LAS f32x4*)(L + AT_KB + cur * 256);
#pragma unroll
                    for (int g = 0; g < 4; ++g) { const f32x4 a = kbp[2 * g + hi], c = kbp[8 + 2 * g + hi];
#pragma unroll
                        for (int e = 0; e < 4; ++e) { p0[4 * g + e] += a[e]; p1[4 * g + e] += c[e]; } }
                    if (jb >= 0) {
#pragma unroll
                        for (int r = 0; r < 16; ++r) { const int kv = kv0 + (r & 3) + 8 * (r >> 2); if (kv > qrel) p0[r] = NEG_INF; if (kv + 32 > qrel) p1[r] = NEG_INF; }
                    }
                } else {
#pragma unroll
                    for (int r = 0; r < 16; ++r) { const int d0_ = qrel - (kv0 + (r & 3) + 8 * (r >> 2)), d1_ = d0_ - 32;
                        const bool ok0 = (d0_ >= 0) && (d0_ < WINDOW), ok1 = (d1_ >= 0) && (d1_ < WINDOW);
                        const float t0 = BT[ok0 ? d0_ : 0], t1 = BT[ok1 ? d1_ : 0];
                        p0[r] = ok0 ? p0[r] + t0 : NEG_INF; p1[r] = ok1 ? p1[r] + t1 : NEG_INF; }
                }
                float rm = fmaxf(p0[0], p1[0]);
#pragma unroll
                for (int r = 1; r < 16; ++r) rm = fmaxf(rm, fmaxf(p0[r], p1[r]));
                { auto rr = __builtin_amdgcn_permlane32_swap(__float_as_uint(rm), __float_as_uint(rm), false, false); rm = fmaxf(__uint_as_float(rr[0]), __uint_as_float(rr[1])); }
                const float mn = fmaxf(mrun, rm);
                if (TYPE == 2) live = !__all(rm - mrun < -40.f);
                if (live) {
                if (__any(mn > mrun)) {
                    const float f = (mn > mrun) ? fexp2(mrun - mn) : 1.0f;
                    lsum *= f; mrun = mn;
                    if (hi == 0) wsf[r32] = f;
                    LDS_WAIT(); __builtin_amdgcn_wave_barrier();
#pragma unroll
                    for (int g = 0; g < 4; ++g) { const f32x4 fv = ((const LAS f32x4*)wsf)[2 * g + hi];
#pragma unroll
                        for (int e = 0; e < 4; ++e) { o[0][4 * g + e] *= fv[e]; o[1][4 * g + e] *= fv[e]; } }
                    LDS_WAIT(); __builtin_amdgcn_wave_barrier();
                }
                const float ms = (mrun == NEG_INF) ? 0.f : mrun;
                float ps = 0.f;
#pragma unroll
                for (int r = 0; r < 16; ++r) { p0[r] = fexp2(p0[r] - ms); p1[r] = fexp2(p1[r] - ms); ps += p0[r] + p1[r]; }
                lsum += ps;
                }
            }
            if (live) {
            bf16x8 pa[4];
#pragma unroll
            for (int ks = 0; ks < 4; ++ks) { v4u w;
                if (ks < 2) { w.x = cvtpk(p0[8 * ks], p0[8 * ks + 1]); w.y = cvtpk(p0[8 * ks + 2], p0[8 * ks + 3]); w.z = cvtpk(p0[8 * ks + 4], p0[8 * ks + 5]); w.w = cvtpk(p0[8 * ks + 6], p0[8 * ks + 7]); }
                else { const int k2 = ks - 2; w.x = cvtpk(p1[8 * k2], p1[8 * k2 + 1]); w.y = cvtpk(p1[8 * k2 + 2], p1[8 * k2 + 3]); w.z = cvtpk(p1[8 * k2 + 4], p1[8 * k2 + 5]); w.w = cvtpk(p1[8 * k2 + 6], p1[8 * k2 + 7]); }
                pa[ks] = __builtin_bit_cast(bf16x8, w); }
#pragma unroll
            for (int d0 = 0; d0 < 2; ++d0)
#pragma unroll
                for (int ks = 0; ks < 4; ++ks) o[d0] = __builtin_amdgcn_mfma_f32_32x32x16_bf16(pa[ks], vfr[d0][ks], o[d0], 0, 0, 0);
            }
        }
        if (TYPE == 2) {
            bool wdead = false;
            if (active && more) wdead = __all(qbound + kbnext - mrun < -40.f);
            if (lane == 0) deadf[cur * 8 + wid] = wdead ? 1u : 0u; }
        if (TYPE == 3) { const bool wdead = active && __all(carry < 2.3e-10f);
            if (lane == 0) deadf[cur * 8 + wid] = wdead ? 1u : 0u; }
        if (more) { *(LAS v4u*)(L + AT_K + (cur ^ 1) * 8192 + kl) = kreg; *(LAS v4u*)(L + AT_V + (cur ^ 1) * 8192 + vl) = vreg; if (TYPE == 2 && tid < 64) ((LAS float*)(L + AT_KB + (cur ^ 1) * 256))[tid] = kbreg; }
        __syncthreads();
        if (TYPE >= 2) { const v4u d0 = *(const LAS v4u*)(deadf + cur * 8), d1 = *(const LAS v4u*)(deadf + cur * 8 + 4);
            if ((d0.x & d0.y & d0.z & d0.w & d1.x & d1.y & d1.z & d1.w) != 0u) break; }
    }
    float inv[16];
    if (TYPE != 3) {
        { auto rr = __builtin_amdgcn_permlane32_swap(__float_as_uint(lsum), __float_as_uint(lsum), false, false); lsum = __uint_as_float(rr[0]) + __uint_as_float(rr[1]); }
        if (TYPE == 1) lsum += fexp2(F.sinks[l * NH + hq] * LOG2E - mrun);
        const float il = 1.0f / lsum;
        if (hi == 0) wsf[r32] = il;
        LDS_WAIT(); __builtin_amdgcn_wave_barrier();
#pragma unroll
        for (int g = 0; g < 4; ++g) { const f32x4 fv = ((const LAS f32x4*)wsf)[2 * g + hi]; inv[4 * g] = fv[0]; inv[4 * g + 1] = fv[1]; inv[4 * g + 2] = fv[2]; inv[4 * g + 3] = fv[3]; }
        LDS_WAIT(); __builtin_amdgcn_wave_barrier();
    } else {
#pragma unroll
        for (int r = 0; r < 16; ++r) inv[r] = 1.0f;
    }
    unsigned short gte[2][16];
    if (TYPE == 2) {
#pragma unroll
        for (int d0 = 0; d0 < 2; ++d0)
#pragma unroll
            for (int r = 0; r < 16; ++r) { const int q = (r & 3) + 8 * (r >> 2) + 4 * hi; const size_t mrow = rowb + q0 + qoff + q; gte[d0][r] = ((const GAS unsigned short*)F.P)[mrow * NIN + PC_G + hq * 64 + 32 * d0 + r32]; }
    }
#pragma unroll
    for (int d0 = 0; d0 < 2; ++d0)
#pragma unroll
        for (int r = 0; r < 16; ++r) { const int q = (r & 3) + 8 * (r >> 2) + 4 * hi; const size_t mrow = rowb + q0 + qoff + q; const int col = hq * 64 + 32 * d0 + r32;
            float val = o[d0][r] * inv[r];
            if (TYPE == 2) val *= frcp(1.0f + fexp2(-LOG2E * __builtin_bit_cast(float, (unsigned)gte[d0][r] << 16)));
            F.Y[mrow * DM + YOFF + col] = (bf16)f2bf(val); }
}

__device__ __forceinline__ void sparse_attn_query(const Frame& F, int m, LAS unsigned char* vch, const LAS float* TBA, const LAS int* idx) {
    int lane = F.lane; asm volatile("" : "+v"(lane));
    const int hh = lane & 15, kg = lane >> 4, t = m % SEQ, b = m / SEQ;
    const size_t rowb = (size_t)b * SEQ;
    const int nsel = (t + 1) < TOPK ? (t + 1) : TOPK, nch = (nsel + 63) >> 6;
    const bf16* qp = F.P + (size_t)m * NIN + PA_Q + (hh & 7) * 64 + 8 * kg;
    const bf16x8 qf0 = *(const GAS bf16x8*)qp, qf1 = *(const GAS bf16x8*)(qp + 32);
    float s[4][4][4];
#pragma unroll
    for (int cp = 0; cp < 2; ++cp) {
        if (2 * cp < nch) {
            bf16x8 kf[8][2];
#pragma unroll
            for (int bb = 0; bb < 8; ++bb) { const int keyA = idx[128 * cp + 16 * bb + hh];
                const bf16* kp = F.P + (rowb + keyA) * NIN + PA_K + 8 * kg;
                kf[bb][0] = *(const GAS bf16x8*)kp; kf[bb][1] = *(const GAS bf16x8*)(kp + 32); }
            __builtin_amdgcn_sched_barrier(0);
#pragma unroll
            for (int bb = 0; bb < 8; ++bb) { const int c = 2 * cp + (bb >> 2), blk = bb & 3, j0 = 64 * c + 16 * blk;
                f32x4 acc = {0.f, 0.f, 0.f, 0.f};
                acc = __builtin_amdgcn_mfma_f32_16x16x32_bf16(kf[bb][0], qf0, acc, 0, 0, 0); acc = __builtin_amdgcn_mfma_f32_16x16x32_bf16(kf[bb][1], qf1, acc, 0, 0, 0);
                const v4i id4 = *(const LAS v4i*)(idx + j0 + 4 * kg);
#pragma unroll
                for (int r = 0; r < 4; ++r) { const int j = j0 + 4 * kg + r; int dist = t - id4[r]; dist = dist < 0 ? 0 : (dist > 128 ? 128 : dist);
                    const float bias = TBA[dist * 8 + (hh & 7)];
                    s[c][blk][r] = (j < nsel) ? acc[r] + bias : NEG_INF; }
            }
        } else {
#pragma unroll
            for (int c = 2 * cp; c < 2 * cp + 2; ++c)
#pragma unroll
                for (int blk = 0; blk < 4; ++blk)
#pragma unroll
                    for (int r = 0; r < 4; ++r) s[c][blk][r] = NEG_INF;
        }
    }
    v4u xv[2][8];
#define SP_VLOAD(c_, X) do { _Pragma("unroll") for (int i_ = 0; i_ < 8; ++i_) { const int keyV_ = idx[64 * (c_) + 8 * i_ + (lane >> 3)]; \
        X[i_] = *(const GAS v4u*)(F.P + (rowb + keyV_) * NIN + PA_V + 8 * (lane & 7)); } } while (0)
    SP_VLOAD(0, xv[0]);
    if (1 < nch) SP_VLOAD(1, xv[1]);
    __builtin_amdgcn_sched_barrier(0);
    float mx = NEG_INF;
#pragma unroll
    for (int c = 0; c < 4; ++c)
#pragma unroll
        for (int blk = 0; blk < 4; ++blk)
#pragma unroll
            for (int r = 0; r < 4; ++r) mx = fmaxf(mx, s[c][blk][r]);
    mx = fmaxf(mx, __shfl_xor(mx, 16)); mx = fmaxf(mx, __shfl_xor(mx, 32));
    float sum = 0.f;
#pragma unroll
    for (int c = 0; c < 4; ++c)
#pragma unroll
        for (int blk = 0; blk < 4; ++blk)
#pragma unroll
            for (int r = 0; r < 4; ++r) { const float p = fexp2(s[c][blk][r] - mx); s[c][blk][r] = p; sum += p; }
    sum += __shfl_xor(sum, 16); sum += __shfl_xor(sum, 32);
    const float inv = 1.0f / sum;
    f32x4 oacc[4];
#pragma unroll
    for (int d = 0; d < 4; ++d) oacc[d] = (f32x4){0.f, 0.f, 0.f, 0.f};
    const int q4 = (lane & 15) >> 2, p4 = lane & 3;
#pragma unroll
    for (int c = 0; c < 4; ++c) {
        if (c < nch) {
#pragma unroll
            for (int i = 0; i < 8; ++i) *(LAS v4u*)(vch + ((lane & 7) >> 2) * 4096 + (8 * i + (lane >> 3)) * 64 + (lane & 3) * 16) = xv[c & 1][i];
            LDS_WAIT(); __builtin_amdgcn_wave_barrier();
            if (c + 2 < nch) SP_VLOAD(c + 2, xv[c & 1]);
            __builtin_amdgcn_sched_barrier(0);
#pragma unroll
            for (int kp = 0; kp < 2; ++kp) { v4u w; w.x = cvtpk(s[c][2 * kp][0], s[c][2 * kp][1]); w.y = cvtpk(s[c][2 * kp][2], s[c][2 * kp][3]); w.z = cvtpk(s[c][2 * kp + 1][0], s[c][2 * kp + 1][1]); w.w = cvtpk(s[c][2 * kp + 1][2], s[c][2 * kp + 1][3]);
                const bf16x8 pf = __builtin_bit_cast(bf16x8, w);
#pragma unroll
                for (int d = 0; d < 4; ++d) { const LAS unsigned char* a = vch + (d >> 1) * 4096 + (32 * kp + 4 * kg + q4) * 64 + ((d & 1) * 16 + 4 * p4) * 2;
                    const s16x4 lo = vtr(a), hv = vtr(a + 16 * 64);
                    const bf16x8 vf = {lo[0], lo[1], lo[2], lo[3], hv[0], hv[1], hv[2], hv[3]};
                    oacc[d] = __builtin_amdgcn_mfma_f32_16x16x32_bf16(vf, pf, oacc[d], 0, 0, 0); } }
            LDS_WAIT(); __builtin_amdgcn_wave_barrier();
        }
    }
#undef SP_VLOAD
    if (hh < 8) {
#pragma unroll
        for (int d = 0; d < 4; ++d) { v2u w; w.x = pk2(oacc[d][0] * inv, oacc[d][1] * inv); w.y = pk2(oacc[d][2] * inv, oacc[d][3] * inv);
            *(GAS v2u*)(F.Y + (size_t)m * DM + hh * 64 + 16 * d + 4 * kg) = w; }
    }
}

constexpr int CW_QUEUE = 8192;
constexpr int MIX_ITEMS = 2560;
template <unsigned EN> __device__ __forceinline__ void ph_attention(const Frame& F, int l, int qsel = 0) {
    LAS float* TBA = (LAS float*)(F.lds + AUX_OFF);
    for (int i = F.tid; i < 129 * 8; i += NTHREADS) { const int d = i >> 3, hq = i & 7; const int bk = d < 128 ? (int)kBucketLut[d] : 31; TBA[i] = F.rel_table[bk * 16 + hq] * LOG2E; }
    LAS unsigned* qslot = (LAS unsigned*)(F.lds + LDSCTL_OFF + 64);
    LAS unsigned char* wbuf = F.lds + RING_OFF + AT_SV + F.wave * 9472;
    LAS int* idxl = (LAS int*)(wbuf + 8192);
    __syncthreads();
#define MIX_FETCH(it) do { if (F.tid == 0) *qslot = __hip_atomic_fetch_add((unsigned*)(F.ctl + CW_QUEUE + 64 * l + 32 * qsel), 1u, __ATOMIC_RELAXED, __HIP_MEMORY_SCOPE_AGENT); \
        __syncthreads(); it = (int)*qslot; __syncthreads(); } while (0)
    for (int r = (int)blockIdx.x; r < 1024; r += F.G) {
        if (EN & 0x800) {
            const int b = r >> 9, blk = r & 511;
#pragma unroll 1
            for (int k = 0; k < 2; ++k) { const int u = 8 * blk + F.wave; const int t = k ? (SEQ - 1 - u) : u; const int m = b * SEQ + t;
                select_row(F, m, (LAS unsigned*)wbuf, idxl);
                LDS_WAIT(); __builtin_amdgcn_wave_barrier();
#ifdef PROBE_SEL2
                select_row(F, m, (LAS unsigned*)wbuf, idxl); LDS_WAIT(); __builtin_amdgcn_wave_barrier();
#endif
#ifdef PROBE_ATT2
                sparse_attn_query(F, m, wbuf, TBA, idxl); LDS_WAIT(); __builtin_amdgcn_wave_barrier();
#endif
                sparse_attn_query(F, m, wbuf, TBA, idxl);
                LDS_WAIT(); __builtin_amdgcn_wave_barrier(); }
        }
    }
    __syncthreads();
    int it; MIX_FETCH(it); it += 1024;
    while (it < 1536) { const int r = it & 511; if (EN & 0x100) dense_attn_unit<2>(F, l, (r & 15) >> 3, r & 7, 31 - (r >> 4)); MIX_FETCH(it); it += 1024; }
    while (it < 2048) { const int r = it & 511; if (EN & 0x200) dense_attn_unit<3>(F, l, (r & 15) >> 3, r & 7, 31 - (r >> 4)); MIX_FETCH(it); it += 1024; }
    while (it < MIX_ITEMS) { const int r = it & 511; if (EN & 0x400) dense_attn_unit<1>(F, l, r >> 8, 0, 255 - (r & 255)); MIX_FETCH(it); it += 1024; }
#undef MIX_FETCH
}


__device__ __forceinline__ const float* gp_(const float* p) {
#if defined(__HIP_DEVICE_COMPILE__)
    __builtin_assume(!__builtin_amdgcn_is_shared((const __attribute__((address_space(0))) void*)p)); __builtin_assume(!__builtin_amdgcn_is_private((const __attribute__((address_space(0))) void*)p));
#endif
    return p; }
#ifndef PROBE_KINDS
#define PROBE_KINDS 0u
#endif
#ifndef PROBE_ATT
#define PROBE_ATT 0xF00u
#endif
#ifndef PROBE_REPS
#define PROBE_REPS 1
#endif
#ifndef MK_ONE_LAUNCH
#define MK_ONE_LAUNCH 1
#endif
constexpr int PH_PER_LAYER = 14, N_PHASES = 1 + DEPTH * PH_PER_LAYER;
struct Args { const float* in[15]; float* out; unsigned char* ws; int ph_lo, ph_hi; };
struct ArgsG { const GAS float* in[15]; GAS float* out; GAS unsigned char* ws; int ph_lo, ph_hi; };
template <unsigned EN> __global__ void __launch_bounds__(NTHREADS, 2) trunk_fwd(Args args) {
    extern __shared__ __attribute__((aligned(16))) unsigned char lds[];
    LAS unsigned char* const ldsb = (LAS unsigned char*)lds;
    const int wave0 = __builtin_amdgcn_readfirstlane((int)threadIdx.x >> 6);
    for (int u = threadIdx.x; u < (LDS_BYTES - LDSCTL_OFF) / 4; u += NTHREADS) ((LAS unsigned*)(ldsb + LDSCTL_OFF))[u] = 0u;
    __syncthreads();
#if MK_ONE_LAUNCH
    constexpr int lo = 0, hi = N_PHASES;
#else
    const int lo = args.ph_lo, hi = args.ph_hi;
#endif
    XcdBarrier bar; bar.bar = (unsigned*)(args.ws + WS_CTL) + CW_BAR; bar.x = 0; bar.st = nullptr;
    if (hi - lo > 1) bar = xcd_barrier_post((unsigned*)(args.ws + WS_CTL) + CW_BAR, (volatile LAS unsigned*)(ldsb + LDSCTL_OFF));
#define GP(p) ((const float*)(p))
#define PH_BEGIN(k, kind) if (lo <= (k) && (k) < hi) { _Pragma("unroll 1") for (int rep_ = 0; rep_ < (((PROBE_KINDS >> (kind)) & 1u) ? PROBE_REPS : 1); ++rep_) { Frame F; { \
        const ArgsG* ka = (const ArgsG*)__builtin_amdgcn_kernarg_segment_ptr(); asm volatile("" : "+s"(ka)); \
        unsigned o_ = ~0u; asm volatile("" : "+s"(o_)); int t_ = wave0 * 64 + (int)__builtin_amdgcn_mbcnt_hi(o_, __builtin_amdgcn_mbcnt_lo(o_, 0u)); asm volatile("" : "+v"(t_)); \
        F.lds = ldsb; F.tid = t_; F.lane = t_ & 63; F.wave = wave0; int gw_ = blockIdx.x * NWAVES + wave0; asm volatile("" : "+s"(gw_)); F.G = gridDim.x; F.gw = gw_; F.NGW = F.G * NWAVES; \
        unsigned char* ws = (unsigned char*)ka->ws; F.ctl = (gu32*)(ws + WS_CTL);     \
        F.x = GP(ka->in[0]); F.c = GP(ka->in[1]); F.w_ada = GP(ka->in[2]); F.b_ada = GP(ka->in[3]); F.norm_g = GP(ka->in[4]); F.w_in = GP(ka->in[5]); F.qk_g = GP(ka->in[6]); F.forget_b = GP(ka->in[7]); \
        F.sinks = GP(ka->in[8]); F.rel_table = GP(ka->in[9]); F.group_g = GP(ka->in[10]); F.w_out = GP(ka->in[11]); F.w_gate = GP(ka->in[12]); F.w_up = GP(ka->in[13]); F.w_down = GP(ka->in[14]); F.out = (float*)ka->out; \
        F.MOD = (float*)(ws + WS_MOD); F.LF = (float*)(ws + WS_LF); F.KB2 = (float*)(ws + WS_KB2); F.SC = (unsigned short*)(ws + WS_SC); F.IDX = (int*)(ws + WS_IDX); \
        F.WGU = (bf16*)(ws + WS_WGU); F.WD = (bf16*)(ws + WS_WD); F.WIN = (bf16*)(ws + WS_WIN); F.WOUT = (bf16*)(ws + WS_WOUT); \
        F.H = (bf16*)(ws + WS_H); F.P = (bf16*)(ws + WS_P); F.Y = (bf16*)(ws + WS_Y); F.XB = (bf16*)(ws + WS_XB); }
#define PH_END(k) if ((k) + 1 < hi) xcd_barrier(bar); } }

    PH_BEGIN(0, 31) if (EN & 1) p0_prologue(F); PH_END(0)

    for (int l = 0; l < DEPTH; ++l) {
        const int base = 1 + l * PH_PER_LAYER;
        for (int sub = 0; sub < 3; ++sub) {
            if (sub != 1) {
                const int f = sub >> 1, pb = base + (f ? 11 : 0), ni = f ? 2 : 0, lf = l * 2 + f;
                PH_BEGIN(pb, (f ? 11 : 0)) if (EN & 2) { const float* modl = F.MOD + (size_t)l * BATCH * NMOD;
                    if (l == 0 && f == 0) ph_modulate<FFN_FP8, false>(F, F.x, F.norm_g + ((size_t)l * 3 + ni) * DM, modl + (3 * ni + 0) * DM, modl + (3 * ni + 1) * DM);
                    else ph_modulate<FFN_FP8, true>(F, F.XB, F.norm_g + ((size_t)l * 3 + ni) * DM, modl + (3 * ni + 0) * DM, modl + (3 * ni + 1) * DM); } PH_END(pb)
                PH_BEGIN(pb + 1, (f ? 12 : 1)) if (EN & 4) {
                    pg8::StaticOrder S; S.init(M, NGU, F.G, (int)blockIdx.x);
                    if constexpr (FFN_FP8) { pg8::Gemm g{F.H, (const bf16*)((const unsigned char*)F.WGU + (size_t)lf * NGU * DM), M, NGU, DM, 127, W8_E8M0};
                        pg8::EpiSwiGLU8 E{(unsigned char*)F.P, DFFP};
                        pg8::gemm_phase<pg8::EpiSwiGLU8, pg8::StaticOrder, true, true, true>(F.lds + RING_OFF, g, S, E, F.tid); }
                    else { pg8::Gemm g{F.H, F.WGU + (size_t)lf * NGU * DM, M, NGU, DM};
                        pg8::EpiSwiGLU E{F.P, DFF};
                        pg8::gemm_phase<pg8::EpiSwiGLU, pg8::StaticOrder, true, true>(F.lds + RING_OFF, g, S, E, F.tid); } } PH_END(pb + 1)
                PH_BEGIN(pb + 2, (f ? 13 : 2)) if (EN & 8) {
                    pg8::Gemm g{F.P, FFN_FP8 ? (const bf16*)((const unsigned char*)F.WD + (size_t)lf * DM * DFFP) : F.WD + (size_t)lf * DM * DFF, M, DM, DFF, 127, FFN_FP8 ? W8_E8M0 : 127, FFN_FP8 ? DFFP : 0, FFN_FP8 ? DFFP : 0}; pg8::StaticOrder S; S.init(M, DM, F.G, (int)blockIdx.x);
                    const float* modl = F.MOD + (size_t)l * BATCH * NMOD;
                    if (l == DEPTH - 1 && f == 1) { pg8::EpiResid<false> E{F.XB, rep_ ? (void*)F.SC : (void*)F.out, DM, modl + (3 * ni + 2) * DM, NMOD, SEQ, 0.5f};
                        pg8::gemm_phase<pg8::EpiResid<false>, pg8::StaticOrder, true, true, FFN_FP8>(F.lds + RING_OFF, g, S, E, F.tid); }
                    else { pg8::EpiResid<true> E{F.XB, rep_ ? (void*)F.SC : (void*)F.XB, DM, modl + (3 * ni + 2) * DM, NMOD, SEQ, 0.5f};
                        pg8::gemm_phase<pg8::EpiResid<true>, pg8::StaticOrder, true, true, FFN_FP8>(F.lds + RING_OFF, g, S, E, F.tid); } } PH_END(pb + 2)
            } else {
                PH_BEGIN(base + 3, 3) if (EN & 2) { const float* modl = F.MOD + (size_t)l * BATCH * NMOD; ph_modulate<false, true>(F, F.XB, F.norm_g + ((size_t)l * 3 + 1) * DM, modl + 3 * DM, modl + 4 * DM); } PH_END(base + 3)
                PH_BEGIN(base + 4, 4) if (EN & 16) {
                    pg8::Gemm g{F.H, F.WIN + (size_t)l * NIN * DM, M, NIN, DM}; pg8::StaticOrder S; S.init(M, NIN, F.G, (int)blockIdx.x);
                    pg8::EpiBf16 E{F.P, NIN};
                    pg8::gemm_phase<pg8::EpiBf16, pg8::StaticOrder, true, true>(F.lds + RING_OFF, g, S, E, F.tid); } PH_END(base + 4)
                PH_BEGIN(base + 6, 6) if (EN & 64) { ph_scan(F, l);
                    int par_ = (int)((blockIdx.x & 1u) ^ 1u); asm volatile("" : "+s"(par_));
                    _Pragma("unroll 1") for (int st_ = 0; st_ < 2; ++st_) { if ((st_ ^ par_) == 0) { if (EN & 32) ph_post(F, l); } else ph_idx_scores(F); } } PH_END(base + 6)
                PH_BEGIN(base + 8, 8) if (EN & 0xF00) { if (rep_ == 0) ph_attention<EN>(F, l, 0); else ph_attention<(PROBE_ATT)>(F, l, 1); } PH_END(base + 8)
                PH_BEGIN(base + 9, 9) if (EN & 0x1000) ph_gnorm(F, l); PH_END(base + 9)
                PH_BEGIN(base + 10, 10) if (EN & 0x2000) {
                    pg8::Gemm g{F.Y, F.WOUT + (size_t)l * DM * DM, M, DM, DM}; pg8::StaticOrder S; S.init(M, DM, F.G, (int)blockIdx.x);
                    const float* modl = F.MOD + (size_t)l * BATCH * NMOD;
                    pg8::EpiResid<true> E{F.XB, rep_ ? (void*)F.SC : (void*)F.XB, DM, modl + 5 * DM, NMOD, SEQ, 1.0f};
                    pg8::gemm_phase<pg8::EpiResid<true>, pg8::StaticOrder, true, true>(F.lds + RING_OFF, g, S, E, F.tid); } PH_END(base + 10)
            }
        }
    }
#undef PH_BEGIN
#undef PH_END
}

#ifndef EN_MASK
#define EN_MASK 0xFFFFu
#endif
template <unsigned EN> static int setup_kernel() {
    if (hipFuncSetAttribute((const void*)trunk_fwd<EN>, hipFuncAttributeMaxDynamicSharedMemorySize, LDS_BYTES) != hipSuccess) { fprintf(stderr, "kernel_launch: hipFuncSetAttribute failed\n"); return -1; }
    int per_cu = 0;
    if (hipOccupancyMaxActiveBlocksPerMultiprocessor(&per_cu, (const void*)trunk_fwd<EN>, NTHREADS, LDS_BYTES) != hipSuccess || per_cu < 1) { fprintf(stderr, "kernel_launch: occupancy query says %d\n", per_cu); }
    (void)hipGetLastError();
    return 0;
}
template <unsigned EN> static void launch_range(const Args& a0, int lo, int hi, int grid, hipStream_t stream) {
    Args a = a0; a.ph_lo = lo; a.ph_hi = hi;
    hipLaunchKernelGGL(trunk_fwd<EN>, dim3(grid), dim3(NTHREADS), LDS_BYTES, stream, a);
}
extern "C" void kernel_launch(void* const* d_in, const int* in_sizes, int n_in, void* d_out, int out_size, void* d_ws, size_t ws_size, hipStream_t stream) {
    static int grid = 0;
    if (grid == 0) {
        if (n_in != 15 || in_sizes[0] != M * DM || out_size != M * DM || ws_size < WS_END) {
            fprintf(stderr, "kernel_launch: shape/workspace mismatch: n_in %d in0 %d out %d ws %zu (need %zu); nothing launched\n", n_in, n_in > 0 ? in_sizes[0] : -1, out_size, ws_size, (size_t)WS_END); grid = -1; return; }
        int dev = 0, cus = 0;
        if (hipGetDevice(&dev) != hipSuccess || hipDeviceGetAttribute(&cus, hipDeviceAttributeMultiprocessorCount, dev) != hipSuccess) { grid = -1; return; }
#if MK_ONE_LAUNCH
        if (setup_kernel<EN_MASK>()) { grid = -1; return; }
#else
        if (setup_kernel<0x1u>() || setup_kernel<0x2u>() || setup_kernel<0x4u>() || setup_kernel<0x8u>() || setup_kernel<0x10u>() || setup_kernel<0x20u>() || setup_kernel<0x40u>() || setup_kernel<0x80u>() ||
            setup_kernel<0x100u>() || setup_kernel<0x200u>() || setup_kernel<0x400u>() || setup_kernel<0x800u>() || setup_kernel<0x1000u>() || setup_kernel<0x2000u>()) { grid = -1; return; }
#endif
        grid = cus;
    }
    if (grid < 0) return;
    if (hipMemsetAsync((char*)d_ws + WS_CTL, 0, CTL_ZERO_BYTES, stream) != hipSuccess) return;
    Args a{};
    for (int i = 0; i < 15; ++i) a.in[i] = (const float*)d_in[i];
    a.out = (float*)d_out; a.ws = (unsigned char*)d_ws;
#if MK_ONE_LAUNCH
    launch_range<EN_MASK>(a, 0, N_PHASES, grid, stream);
#else
    launch_range<0x1u>(a, 0, 1, grid, stream);
    for (int l = 0; l < DEPTH; ++l) { const int base = 1 + l * PH_PER_LAYER;
        for (int f = 0; f < 2; ++f) { const int pb = base + (f ? 11 : 0);
            if (f == 1) {
                launch_range<0x2u>(a, base + 3, base + 4, grid, stream); launch_range<0x10u>(a, base + 4, base + 5, grid, stream); launch_range<0x20u>(a, base + 5, base + 6, grid, stream);
                launch_range<0x40u>(a, base + 6, base + 7, grid, stream); launch_range<0x80u>(a, base + 7, base + 8, grid, stream);
                launch_range<0x100u>(a, base + 8, base + 9, grid, stream); launch_range<0x200u>(a, base + 8, base + 9, grid, stream); launch_range<0x400u>(a, base + 8, base + 9, grid, stream); launch_range<0x800u>(a, base + 8, base + 9, grid, stream);
                launch_range<0x1000u>(a, base + 9, base + 10, grid, stream); launch_range<0x2000u>(a, base + 10, base + 11, grid, stream);
            }
            launch_range<0x2u>(a, pb, pb + 1, grid, stream); launch_range<0x4u>(a, pb + 1, pb + 2, grid, stream); launch_range<0x8u>(a, pb + 2, pb + 3, grid, stream);
        }
    }
#endif
}
```
